# Optimizing an MI355X kernel written in HIP

```python
import math
import jax, jax.numpy as jnp
from jax import lax
import numpy as np

D_MODEL = 1024
BATCH = 16
SEQ = 4096
DEPTH = 4

GRID_W = 64
CTX_LEN = 256
EPS = 1e-6
N_MOD = 6

SSD_EXPAND = 2
D_INNER = SSD_EXPAND * D_MODEL
SSD_HEAD_DIM = 64
SSD_HEADS = D_INNER // SSD_HEAD_DIM
SSD_GROUPS = 8
D_STATE = 128
CONV_K = 5
CHUNK = 128
GN = SSD_GROUPS * D_STATE
CONV_CH = D_INNER + 2 * GN
SSD_IN = D_INNER + CONV_CH + 2 * SSD_HEADS

Q_HEADS = 16
KV_HEADS = 4
Q_PER_KV = Q_HEADS // KV_HEADS
HEAD_DIM = 64
Q_W = Q_HEADS * HEAD_DIM
KV_W = KV_HEADS * HEAD_DIM
WINDOW = 128
BLOCK = 128
ROPE_BASE = 10000.0
AXIS_DIM = HEAD_DIM // 2
ROPE_FREQS = AXIS_DIM // 2

D_FF = 2816
N_EXPERTS = 8
TOP_K = 2
D_FF_EXPERT = 3584

N_SSD = (DEPTH + 1) // 2
N_ATTN = DEPTH // 2
N_DENSE = (DEPTH + 1) // 2
N_MOE = DEPTH // 2

kernel_name = 'hybrid_ssd_swa_moe_dit_block'

F32 = jnp.float32


def rmsnorm(x, w):
    xf = x.astype(F32)
    y = xf * lax.rsqrt(jnp.mean(xf * xf, axis=-1, keepdims=True) + EPS)
    return (y * w.astype(F32)).astype(x.dtype)


def modulate(h, shift, scale):
    return h * (1 + scale[:, None, :]) + shift[:, None, :]


def swiglu(h, w1, w3, w2):
    return (jax.nn.silu(h @ w1) * (h @ w3)) @ w2


def moe_swiglu(h, router, w1, w3, w2):
    shp = h.shape
    t = h.reshape(-1, shp[-1])
    logits = (t @ router).astype(F32)
    top_v, top_i = lax.top_k(logits, TOP_K)
    gates = jax.nn.softmax(top_v, axis=-1)
    combine = jnp.einsum('tk,tke->te', gates, jax.nn.one_hot(top_i, N_EXPERTS, dtype=F32)).astype(h.dtype)
    out = jnp.zeros_like(t)
    for e in range(N_EXPERTS):
        out = out + combine[:, e:e + 1] * swiglu(t, w1[e], w3[e], w2[e])
    return out.reshape(shp)


def depthwise_conv_same(x, w, b):
    pad = CONV_K // 2
    n = x.shape[1]
    xp = jnp.pad(x, ((0, 0), (pad, pad), (0, 0)))
    return sum(xp[:, k:k + n] * w[k] for k in range(CONV_K)) + b


def ssd_chunked(xs, dt, a_diag, bm, cm):
    b, t, h, p = xs.shape
    g, n = bm.shape[2], bm.shape[3]
    r = h // g
    nc = t // CHUNK

    def chunks(a):
        return jnp.moveaxis(a.astype(F32).reshape((b, nc, CHUNK) + a.shape[2:]), 1, 0)

    xc = chunks(xs.reshape(b, t, g, r, p))
    dtc = chunks(dt.reshape(b, t, g, r))
    ac = dtc * a_diag.astype(F32).reshape(g, r)
    bc = chunks(bm)
    cc = chunks(cm)
    lower = jnp.tril(jnp.ones((CHUNK, CHUNK), dtype=bool))[None, :, :, None, None]

    def step(state, inp):
        x_, dt_, a_, b_, c_ = inp
        acum = jnp.cumsum(a_, axis=1)
        seg = acum[:, :, None] - acum[:, None, :]
        decay = jnp.exp(jnp.where(lower, seg, -jnp.inf))
        cb = jnp.einsum('bign,bjgn->bijg', c_, b_)
        y_intra = jnp.einsum('bijg,bijgr,bjgr,bjgrp->bigrp', cb, decay, dt_, x_)
        y_state = jnp.einsum('bign,bgrpn->bigrp', c_, state) * jnp.exp(acum)[..., None]
        tail = jnp.exp(acum[:, -1:] - acum) * dt_
        new_state = state * jnp.exp(acum[:, -1])[..., None, None] + jnp.einsum('bjgn,bjgr,bjgrp->bgrpn', b_, tail, x_)
        return new_state, y_intra + y_state

    state0 = jnp.zeros((b, g, r, p, n), F32)
    _, y = lax.scan(step, state0, (xc, dtc, ac, bc, cc))
    return jnp.moveaxis(y, 0, 1).reshape(b, t, h, p)


def gated_rmsnorm(y, z, w):
    g = (y * jax.nn.silu(z)).astype(F32)
    shp = g.shape
    g = g.reshape(shp[:-1] + (SSD_GROUPS, D_INNER // SSD_GROUPS))
    g = g * lax.rsqrt(jnp.mean(g * g, axis=-1, keepdims=True) + EPS)
    return (g.reshape(shp) * w.astype(F32)).astype(y.dtype)


def ssd_mixer(hx, hc, w_in, conv_w, conv_b, dt_bias, a_log, d_skip, norm_w, w_out):
    bsz, n_lat, _ = hx.shape
    n_ctx = hc.shape[1]

    def project(h):
        zxbcdt = h @ w_in
        z = zxbcdt[..., :D_INNER]
        xbc = jax.nn.silu(depthwise_conv_same(zxbcdt[..., D_INNER:D_INNER + CONV_CH], conv_w, conv_b))
        dt = zxbcdt[..., D_INNER + CONV_CH:]
        return z, xbc, dt

    zc, xbcc, dtc = project(hc)
    zx, xbcx, dtx = project(hx)
    z = jnp.concatenate([zc, zx], axis=1)
    xbc = jnp.concatenate([xbcc, xbcx], axis=1)
    dt_raw = jnp.concatenate([dtc, dtx], axis=1)
    total = n_ctx + n_lat
    xs = xbc[..., :D_INNER].reshape(bsz, total, SSD_HEADS, SSD_HEAD_DIM)
    bm = xbc[..., D_INNER:D_INNER + GN].reshape(bsz, total, SSD_GROUPS, D_STATE)
    cm = xbc[..., D_INNER + GN:].reshape(bsz, total, SSD_GROUPS, D_STATE)

    def reverse_segments(t):
        return jnp.concatenate([jnp.flip(t[:, :n_ctx], axis=1), jnp.flip(t[:, n_ctx:], axis=1)], axis=1)

    def direction(d, xs_d, bm_d, cm_d, dt_raw_d):
        dt_d = jax.nn.softplus((dt_raw_d[..., d * SSD_HEADS:(d + 1) * SSD_HEADS] + dt_bias[d]).astype(F32))
        a_d = -jnp.exp(a_log[d].astype(F32))
        y_d = ssd_chunked(xs_d, dt_d, a_d, bm_d, cm_d)
        return y_d + d_skip[d].astype(F32)[:, None] * xs_d.astype(F32)

    y_fwd = direction(0, xs, bm, cm, dt_raw)
    y_bwd = reverse_segments(direction(1, reverse_segments(xs), reverse_segments(bm),
                                       reverse_segments(cm), reverse_segments(dt_raw)))
    y = (y_fwd + y_bwd).reshape(bsz, total, D_INNER).astype(hx.dtype)
    out = gated_rmsnorm(y, z, norm_w) @ w_out
    return out[:, n_ctx:], out[:, :n_ctx]


def axial_rope(x, cos, sin):
    shp = x.shape
    xr = x.astype(F32).reshape(shp[:-1] + (2, 2, ROPE_FREQS))
    bshape = (1, shp[1]) + (1,) * (len(shp) - 3) + (2, 1, ROPE_FREQS)
    c = cos.reshape(bshape)
    s = sin.reshape(bshape)
    rot = jnp.stack([-xr[..., 1, :], xr[..., 0, :]], axis=-2)
    return (xr * c + rot * s).reshape(shp).astype(x.dtype)


def sink_attention(q, ks, vs, masks, sink):
    scores = []
    for k, m in zip(ks, masks):
        s = jnp.einsum('bqgrd,bkgd->bgrqk', q, k).astype(F32)
        if m is not None:
            s = jnp.where(m, s, -jnp.inf)
        scores.append(s)
    sink_col = jnp.broadcast_to(sink.astype(F32)[None, :, :, None, None], scores[0].shape[:-1] + (1,))
    p = jax.nn.softmax(jnp.concatenate(scores + [sink_col], axis=-1), axis=-1)
    out = 0
    off = 0
    for k, v in zip(ks, vs):
        n = k.shape[1]
        out = out + jnp.einsum('bgrqk,bkgd->bqgrd', p[..., off:off + n].astype(v.dtype), v)
        off += n
    return out


def window_attention(hx, hc, w_qkv, b_qkv, sink, w_o, b_o, cos, sin, need_ctx):
    bsz, n_lat, _ = hx.shape
    n_ctx = hc.shape[1]
    n_blk = n_lat // BLOCK
    scale = 1.0 / math.sqrt(HEAD_DIM)

    def project(h):
        t = h @ w_qkv + b_qkv
        l = h.shape[1]
        q = t[..., :Q_W].reshape(bsz, l, KV_HEADS, Q_PER_KV, HEAD_DIM) * scale
        k = t[..., Q_W:Q_W + KV_W].reshape(bsz, l, KV_HEADS, HEAD_DIM)
        v = t[..., Q_W + KV_W:].reshape(bsz, l, KV_HEADS, HEAD_DIM)
        return q, k, v

    qx, kx, vx = project(hx)
    qc, kc, vc = project(hc)
    qx = axial_rope(qx, cos, sin)
    kx = axial_rope(kx, cos, sin)
    pad = ((0, 0), (BLOCK, BLOCK), (0, 0), (0, 0))
    kp = jnp.pad(kx, pad)
    vp = jnp.pad(vx, pad)
    sink_gr = sink.reshape(KV_HEADS, Q_PER_KV)

    def latent_block(n):
        start = n * BLOCK
        qb = lax.dynamic_slice_in_dim(qx, start, BLOCK, axis=1)
        kb = lax.dynamic_slice_in_dim(kp, start, 3 * BLOCK, axis=1)
        vb = lax.dynamic_slice_in_dim(vp, start, 3 * BLOCK, axis=1)
        qpos = start + jnp.arange(BLOCK)
        kpos = start - BLOCK + jnp.arange(3 * BLOCK)
        mask = ((jnp.abs(qpos[:, None] - kpos[None, :]) <= WINDOW)
                & (kpos >= 0)[None, :] & (kpos < n_lat)[None, :])
        return sink_attention(qb, (kb, kc), (vb, vc), (mask, None), sink_gr)

    o = lax.map(latent_block, jnp.arange(n_blk))
    o = jnp.moveaxis(o, 0, 1).reshape(bsz, n_lat, Q_W)
    yx = o @ w_o + b_o
    if not need_ctx:
        return yx, None
    oc = sink_attention(qc, (kc,), (vc,), (None,), sink_gr).reshape(bsz, n_ctx, Q_W)
    return yx, oc @ w_o + b_o


def setup_inputs(seed: int = 0) -> dict:
    key = jax.random.key(seed)
    ks = iter(jax.random.split(key, 40))

    def nrm(shape, scale):
        return jax.random.normal(next(ks), shape, F32) * scale

    u = jax.random.uniform(next(ks), (N_SSD, 2, SSD_HEADS), F32)
    dt0 = jnp.exp(u * (math.log(0.1) - math.log(1e-3)) + math.log(1e-3))
    dt_bias = dt0 + jnp.log(-jnp.expm1(-dt0))
    a_log = jnp.log(jax.random.uniform(next(ks), (N_SSD, 2, SSD_HEADS), F32, minval=1.0, maxval=16.0))
    return {
        'x': nrm((BATCH, SEQ, D_MODEL), 1.0),
        'c': nrm((BATCH, D_MODEL), 1.0),
        'ctx': nrm((BATCH, CTX_LEN, D_MODEL), 1.0),
        'c_ctx': nrm((D_MODEL,), 1.0),
        'w_mod': nrm((DEPTH, D_MODEL, N_MOD * D_MODEL), 0.5 * D_MODEL ** -0.5),
        'b_mod': nrm((DEPTH, N_MOD * D_MODEL), 0.02),
        'norm1_w': 1.0 + nrm((DEPTH, D_MODEL), 0.02),
        'norm2_w': 1.0 + nrm((DEPTH, D_MODEL), 0.02),
        'ssd_w_in': nrm((N_SSD, D_MODEL, SSD_IN), D_MODEL ** -0.5),
        'ssd_conv_w': nrm((N_SSD, CONV_K, CONV_CH), CONV_K ** -0.5),
        'ssd_conv_b': nrm((N_SSD, CONV_CH), 0.02),
        'ssd_dt_bias': dt_bias,
        'ssd_a_log': a_log,
        'ssd_d': 1.0 + nrm((N_SSD, 2, SSD_HEADS), 0.1),
        'ssd_norm_w': 1.0 + nrm((N_SSD, D_INNER), 0.02),
        'ssd_w_out': nrm((N_SSD, D_INNER, D_MODEL), D_INNER ** -0.5),
        'attn_w_qkv': nrm((N_ATTN, D_MODEL, Q_W + 2 * KV_W), D_MODEL ** -0.5),
        'attn_b_qkv': nrm((N_ATTN, Q_W + 2 * KV_W), 0.02),
        'attn_sink': nrm((N_ATTN, Q_HEADS), 0.5),
        'attn_w_o': nrm((N_ATTN, Q_W, D_MODEL), Q_W ** -0.5),
        'attn_b_o': nrm((N_ATTN, D_MODEL), 0.02),
        'ffn_w1': nrm((N_DENSE, D_MODEL, D_FF), D_MODEL ** -0.5),
        'ffn_w3': nrm((N_DENSE, D_MODEL, D_FF), D_MODEL ** -0.5),
        'ffn_w2': nrm((N_DENSE, D_FF, D_MODEL), D_FF ** -0.5),
        'moe_router': nrm((N_MOE, D_MODEL, N_EXPERTS), D_MODEL ** -0.5),
        'moe_w1': nrm((N_MOE, N_EXPERTS, D_MODEL, D_FF_EXPERT), D_MODEL ** -0.5),
        'moe_w3': nrm((N_MOE, N_EXPERTS, D_MODEL, D_FF_EXPERT), D_MODEL ** -0.5),
        'moe_w2': nrm((N_MOE, N_EXPERTS, D_FF_EXPERT, D_MODEL), D_FF_EXPERT ** -0.5),
        'final_norm_w': 1.0 + nrm((D_MODEL,), 0.02),
    }


def reference(x, c, ctx, c_ctx, w_mod, b_mod, norm1_w, norm2_w, ssd_w_in, ssd_conv_w, ssd_conv_b,
              ssd_dt_bias, ssd_a_log, ssd_d, ssd_norm_w, ssd_w_out, attn_w_qkv, attn_b_qkv, attn_sink,
              attn_w_o, attn_b_o, ffn_w1, ffn_w3, ffn_w2, moe_router, moe_w1, moe_w3, moe_w2, final_norm_w):
    n_lat = x.shape[1]
    rows = n_lat // GRID_W
    row_ids = jnp.repeat(jnp.arange(rows), GRID_W).astype(F32)
    col_ids = jnp.tile(jnp.arange(GRID_W), rows).astype(F32)
    inv_freq = ROPE_BASE ** (-jnp.arange(ROPE_FREQS, dtype=F32) * 2.0 / AXIS_DIM)
    ang = jnp.stack([row_ids[:, None] * inv_freq, col_ids[:, None] * inv_freq], axis=1)[:, :, None, :]
    cos = jnp.cos(ang)
    sin = jnp.sin(ang)

    cx = ctx
    for i in range(DEPTH):
        last = i == DEPTH - 1
        j = i // 2
        mod_x = (jax.nn.silu(c) @ w_mod[i] + b_mod[i]).reshape(-1, N_MOD, D_MODEL)
        mod_c = (jax.nn.silu(c_ctx[None]) @ w_mod[i] + b_mod[i]).reshape(1, N_MOD, D_MODEL)

        hx = modulate(rmsnorm(x, norm1_w[i]), mod_x[:, 0], mod_x[:, 1])
        hc = modulate(rmsnorm(cx, norm1_w[i]), mod_c[:, 0], mod_c[:, 1])
        if i % 2 == 0:
            yx, yc = ssd_mixer(hx, hc, ssd_w_in[j], ssd_conv_w[j], ssd_conv_b[j], ssd_dt_bias[j],
                               ssd_a_log[j], ssd_d[j], ssd_norm_w[j], ssd_w_out[j])
        else:
            yx, yc = window_attention(hx, hc, attn_w_qkv[j], attn_b_qkv[j], attn_sink[j], attn_w_o[j],
                                      attn_b_o[j], cos, sin, not last)
        x = x + mod_x[:, 2][:, None] * yx

        hx = modulate(rmsnorm(x, norm2_w[i]), mod_x[:, 3], mod_x[:, 4])
        if last:
            h = hx
            n_ctx = 0
        else:
            cx = cx + mod_c[:, 2][:, None] * yc
            hc = modulate(rmsnorm(cx, norm2_w[i]), mod_c[:, 3], mod_c[:, 4])
            h = jnp.concatenate([hc, hx], axis=1)
            n_ctx = cx.shape[1]
        if i % 2 == 0:
            f = swiglu(h, ffn_w1[j], ffn_w3[j], ffn_w2[j])
        else:
            f = moe_swiglu(h, moe_router[j], moe_w1[j], moe_w3[j], moe_w2[j])
        x = x + mod_x[:, 5][:, None] * f[:, n_ctx:]
        if not last:
            cx = cx + mod_c[:, 5][:, None] * f[:, :n_ctx]
    return rmsnorm(x, final_norm_w)
```

```cpp
#include <hip/hip_runtime.h>
#include <cstdio>
#include <cstdint>

#define LAS __attribute__((address_space(3)))
#define GAS __attribute__((address_space(1)))
typedef unsigned short bf16_t;
typedef short bf16x8 __attribute__((ext_vector_type(8)));
typedef short s16x4 __attribute__((ext_vector_type(4)));
typedef float f32x4 __attribute__((ext_vector_type(4)));
typedef float f32x2 __attribute__((ext_vector_type(2)));
typedef float f32x16 __attribute__((ext_vector_type(16)));
typedef unsigned u32x4 __attribute__((ext_vector_type(4)));
typedef unsigned u32x2 __attribute__((ext_vector_type(2)));
typedef GAS unsigned gu32;

namespace pg8 {
constexpr int BM = 256, BK = 64, HALF = 128, HTB = HALF * BK * 2  , STAGE_BYTES = 8 * HTB, NXCD = 8, WGM = 8;

__host__ __device__ __forceinline__ int lds_byte(int r, int c) { const int st = (r >> 4) * 2 + (c >> 5), rr = r & 15, cc = c & 31, ob = rr * 64 + cc * 2; return st * 1024 + (ob ^ (((ob >> 9) & 1) << 5)); }
__host__ __device__ __forceinline__ void stage_rc(int b, int& R, int& C) { const int st = b / 1024, sb = b % 1024, swz = sb ^ (((sb >> 9) & 1) << 5); R = (st >> 1) * 16 + swz / 64; C = (st & 1) * 32 + (swz % 64) / 2; }
__host__ __device__ __forceinline__ int perm32(int rho) { const int n = rho >> 4, i = rho & 15; return 8 * (i >> 2) + 4 * n + (i & 3); }

struct Unit { int pm, pn; };
struct Gemm { const bf16_t* A; const bf16_t* Bt; int lda, K; };

struct StaticOrder {
    int nM, nN, nwg, G, c;
    __device__ void init(int nM_, int nN_, int G_, int c_) { nM = nM_; nN = nN_; nwg = nM * nN; G = G_; c = c_; }
    __device__ bool next(int i, Unit& u) const {
        const long L = (long)i * G + c; if (L >= nwg) return false;
        int wgid = (int)L; { const int q = nwg / NXCD, r = nwg % NXCD, xcd = wgid % NXCD, off = wgid / NXCD; wgid = (xcd < r ? xcd * (q + 1) : r * (q + 1) + (xcd - r) * q) + off; }
        const int nig = WGM * nN, gid = wgid / nig, fm = gid * WGM, gsz = (nM - fm) < WGM ? (nM - fm) : WGM;
        u.pm = fm + ((wgid % nig) % gsz); u.pn = (wgid % nig) / gsz; return true;
    }
    __device__ __forceinline__ const char* a_base(const Gemm& g, const Unit& u) const { return (const char*)g.A + (size_t)u.pm * (size_t)(BM * 2) * g.lda; }
    __device__ __forceinline__ const char* b_base(const Gemm& g, const Unit& u) const { return (const char*)g.Bt + (size_t)u.pn * (size_t)(BM * 2) * g.K; }
    __device__ __forceinline__ unsigned row_off(const Gemm& g, const Unit&, int r) const { return (unsigned)r * (unsigned)g.lda * 2u; }
};

__device__ __forceinline__ unsigned cvt_pk_bf16(float lo, float hi) { unsigned r; asm volatile("v_cvt_pk_bf16_f32 %0, %1, %2" : "=v"(r) : "v"(lo), "v"(hi)); return r; }

template <class Epi, class Sched, bool ALIGN_EPI, bool GATHER>
__device__ __forceinline__ void gemm_phase(LAS unsigned char* lds, const Gemm g, const Sched& S, const Epi& E, const int wave0) {
    int tid_ = wave0 * 64 + (int)__builtin_amdgcn_mbcnt_hi(~0u, __builtin_amdgcn_mbcnt_lo(~0u, 0u)); asm volatile("" : "+v"(tid_));
    const int tid = tid_, wid = __builtin_amdgcn_readfirstlane(tid >> 6), lane = tid & 63, wr = wid >> 2, wc = wid & 3, fr = lane & 15, fq = lane >> 4;
    const int K = g.K, nt = K / BK;
    unsigned voffB[2];
#pragma unroll
    for (int i = 0; i < 2; ++i) { int R, C; stage_rc(tid * 16 + i * 8192, R, C); const int Rb = Epi::PERM ? ((R & ~31) + perm32(R & 31)) : R; voffB[i] = (unsigned)(Rb * K + C) * 2u; }
    const size_t kstep = (size_t)(BK * 2);
    const size_t hstepB = (size_t)HALF * K * 2;
    const unsigned ldsw = (unsigned)wid * 1024u;
    const int aoff = lds_byte(wr * 64 + fr, fq * 8), boff = lds_byte(wc * 32 + fr, fq * 8);
#define PG8_SA(b, h) (((b) * 2 + (h)) * HTB)
#define PG8_SB(b, h) ((4 + (b) * 2 + (h)) * HTB)
#define PG8_STAGE(bufoff, gbase, voff) do { _Pragma("unroll") for (int _i = 0; _i < 2; ++_i) \
        __builtin_amdgcn_global_load_lds((const unsigned*)((const char*)(gbase) + (voff)[_i]), (LAS unsigned*)(lds + (bufoff) + ldsw + _i * 8192), 16, 0, 0); } while (0)
#define PG8_LDA(dst, b, h) do { _Pragma("unroll") for (int m = 0; m < 4; ++m) _Pragma("unroll") for (int k = 0; k < 2; ++k) dst[m][k] = *(const LAS bf16x8*)(lds + PG8_SA(b, h) + aoff + m * 2048 + k * 1024); } while (0)
#define PG8_LDB(dst, b, h) do { _Pragma("unroll") for (int n = 0; n < 2; ++n) _Pragma("unroll") for (int k = 0; k < 2; ++k) dst[n][k] = *(const LAS bf16x8*)(lds + PG8_SB(b, h) + boff + n * 2048 + k * 1024); } while (0)
#define PG8_MMA(ai, bj, At, Bt) do { __builtin_amdgcn_s_setprio(1); _Pragma("unroll") for (int m = 0; m < 4; ++m) _Pragma("unroll") for (int n = 0; n < 2; ++n) _Pragma("unroll") for (int k = 0; k < 2; ++k) \
        acc[ai][bj][m][n] = __builtin_amdgcn_mfma_f32_16x16x32_bf16(Bt[n][k], At[m][k], acc[ai][bj][m][n], 0, 0, 0); __builtin_amdgcn_s_setprio(0); } while (0)
#define PG8_WAIT_V(n) asm volatile("s_waitcnt vmcnt(" #n ")" ::: "memory")
#define PG8_WAIT_L(n) asm volatile("s_waitcnt lgkmcnt(" #n ")" ::: "memory")
#define PG8_BAR __builtin_amdgcn_s_barrier()
#define PG8_SCHED __builtin_amdgcn_sched_barrier(0)
    Unit cur, nxt; int ui = 0;
    if (!S.next(0, cur)) return;
    f32x4 acc[2][2][4][2];
#pragma unroll
    for (int a = 0; a < 2; ++a)
#pragma unroll
        for (int b = 0; b < 2; ++b)
#pragma unroll
            for (int m = 0; m < 4; ++m)
#pragma unroll
                for (int n = 0; n < 2; ++n) acc[a][b][m][n] = (f32x4){0.f, 0.f, 0.f, 0.f};
    bf16x8 At[4][2], B0[2][2], B1[2][2];
    const char* cA = S.a_base(g, cur); const char* cB = S.b_base(g, cur);
    unsigned va[2][2], vn[2][2];
#pragma unroll
    for (int h = 0; h < 2; ++h)
#pragma unroll
        for (int i = 0; i < 2; ++i) { int R, C; stage_rc(tid * 16 + i * 8192, R, C); va[h][i] = S.row_off(g, cur, h * HALF + R) + (unsigned)C * 2u; vn[h][i] = va[h][i]; }
    PG8_STAGE(PG8_SB(0, 0), cB, voffB); PG8_STAGE(PG8_SB(0, 1), cB + hstepB, voffB); PG8_STAGE(PG8_SA(0, 0), cA, va[0]); PG8_STAGE(PG8_SA(0, 1), cA, va[1]);
    if (wr == 1) PG8_BAR;
    PG8_WAIT_V(2); PG8_BAR;
    PG8_STAGE(PG8_SB(1, 0), cB + kstep, voffB); PG8_STAGE(PG8_SA(1, 0), cA + kstep, va[0]); PG8_STAGE(PG8_SB(1, 1), cB + hstepB + kstep, voffB);
    PG8_WAIT_V(6); PG8_BAR;
    for (;;) {
        const bool has_next = S.next(ui + 1, nxt);
        const char* nA = has_next ? S.a_base(g, nxt) : cA; const char* nB = has_next ? S.b_base(g, nxt) : cB;
        if (GATHER) {
            if (has_next) {
#pragma unroll
                for (int h = 0; h < 2; ++h)
#pragma unroll
                    for (int i = 0; i < 2; ++i) { int R, C; stage_rc(tid * 16 + i * 8192, R, C); vn[h][i] = S.row_off(g, nxt, h * HALF + R) + (unsigned)C * 2u; }
            } else {
#pragma unroll
                for (int h = 0; h < 2; ++h)
#pragma unroll
                    for (int i = 0; i < 2; ++i) vn[h][i] = va[h][i];
            }
        }
        for (int t = 0; t < nt; t += 2) {
            const bool last = (t == nt - 2);
            const char* a1 = cA + (size_t)(t + 1) * kstep;
            const char* a2 = last ? nA : cA + (size_t)(t + 2) * kstep; const char* b2 = last ? nB : cB + (size_t)(t + 2) * kstep;
            const char* a3 = a2 + kstep; const char* b3 = b2 + kstep;
            unsigned v2[2][2];
#pragma unroll
            for (int h = 0; h < 2; ++h)
#pragma unroll
                for (int i = 0; i < 2; ++i) v2[h][i] = (GATHER && last) ? vn[h][i] : va[h][i];
            PG8_LDB(B0, 0, 0); PG8_LDB(B1, 0, 1); PG8_SCHED; PG8_LDA(At, 0, 0); PG8_STAGE(PG8_SA(1, 1), a1, va[1]);
            PG8_WAIT_V(8); PG8_WAIT_L(0); PG8_BAR; PG8_MMA(0, 0, At, B0); PG8_MMA(0, 1, At, B1); PG8_BAR; PG8_SCHED;
            PG8_LDA(At, 0, 1); PG8_STAGE(PG8_SB(0, 0), b2, voffB); PG8_STAGE(PG8_SB(0, 1), b2 + hstepB, voffB); PG8_STAGE(PG8_SA(0, 0), a2, v2[0]);
            PG8_WAIT_V(8); PG8_WAIT_L(0); PG8_BAR; PG8_MMA(1, 0, At, B0); PG8_MMA(1, 1, At, B1); PG8_BAR; PG8_SCHED;
            PG8_LDB(B0, 1, 0); PG8_LDB(B1, 1, 1); PG8_SCHED; PG8_LDA(At, 1, 0); PG8_STAGE(PG8_SA(0, 1), a2, v2[1]);
            PG8_WAIT_V(8); PG8_WAIT_L(0); PG8_BAR; PG8_MMA(0, 0, At, B0); PG8_MMA(0, 1, At, B1); PG8_BAR; PG8_SCHED;
            PG8_LDA(At, 1, 1); PG8_STAGE(PG8_SB(1, 0), b3, voffB); PG8_STAGE(PG8_SB(1, 1), b3 + hstepB, voffB); PG8_STAGE(PG8_SA(1, 0), a3, v2[0]);
            PG8_WAIT_V(8); PG8_WAIT_L(0); PG8_BAR; PG8_MMA(1, 0, At, B0); PG8_MMA(1, 1, At, B1); PG8_BAR; PG8_SCHED;
        }
        if constexpr (ALIGN_EPI) { if (wr == 0) PG8_BAR; }
        { int l2 = (int)__builtin_amdgcn_mbcnt_hi(~0u, __builtin_amdgcn_mbcnt_lo(~0u, 0u)); asm volatile("" : "+v"(l2)); E(acc, cur, wr, wc, l2 & 15, l2 >> 4); }
        if (!has_next) break;
#pragma unroll
        for (int a = 0; a < 2; ++a)
#pragma unroll
            for (int b = 0; b < 2; ++b)
#pragma unroll
                for (int m = 0; m < 4; ++m)
#pragma unroll
                    for (int n = 0; n < 2; ++n) acc[a][b][m][n] = (f32x4){0.f, 0.f, 0.f, 0.f};
        cur = nxt; cA = nA; cB = nB; ++ui;
        if (GATHER) {
#pragma unroll
            for (int h = 0; h < 2; ++h)
#pragma unroll
                for (int i = 0; i < 2; ++i) va[h][i] = vn[h][i];
        }
        if constexpr (ALIGN_EPI) { if (wr == 1) PG8_BAR; }
    }
    PG8_WAIT_V(0);
    if constexpr (!ALIGN_EPI) { if (wr == 0) PG8_BAR; }
    PG8_BAR;
#undef PG8_SA
#undef PG8_SB
#undef PG8_STAGE
#undef PG8_LDA
#undef PG8_LDB
#undef PG8_MMA
#undef PG8_WAIT_V
#undef PG8_WAIT_L
#undef PG8_BAR
#undef PG8_SCHED
}
}

constexpr int DM = 1024, NB = 16, SEQ = 4096, NCTX = 256, SROW = SEQ + NCTX  , MROWS = NB * SROW  , NPAN = MROWS / 256  ;
constexpr int DIN = 2048, CONVCH = 4096, SSD_IN = 6208, NXBC = 4352  ;
constexpr int QW = 1024, KVW = 256, NQKV = 1536;
constexpr int DFF = 2816, NEXP = 8, DFFE = 3584;
constexpr float EPS = 1e-6f;
constexpr int MOE_CHUNK = 184;
constexpr int NWAVES = 8;

constexpr size_t MiB = 1u << 20;
constexpr size_t WS_CTL = 0, CTL_ZERO_BYTES = 1 * MiB;
constexpr size_t WS_MODV = 2 * MiB;
constexpr size_t WS_ROPE = 4 * MiB;
constexpr size_t WS_GATE = 5 * MiB;
constexpr size_t WS_RLIST = 6 * MiB;
constexpr size_t WS_CX = 10 * MiB;
constexpr size_t WS_W = 26 * MiB;
constexpr size_t W_SSD_STRIDE = 33 * MiB, W_WZ = 0, W_WIN = 4 * MiB, W_WOUT = 12 * MiB + MiB / 2, W_WUP = 16 * MiB + MiB / 2, W_WDN = 27 * MiB + MiB / 2;
constexpr size_t W_ATT0 = 66 * MiB, W_ATT_STRIDE = 5 * MiB, W_WQKV = 0, W_WO = 3 * MiB;
constexpr size_t WS_H = 102 * MiB;
constexpr size_t WS_BIG = 238 * MiB;
constexpr size_t BIG_K = 136 * MiB, BIG_V = 170 * MiB, BIG_MW13 = 322 * MiB, BIG_MW2 = 434 * MiB;
constexpr size_t WS_Y = 782 * MiB;
constexpr size_t WS_DT = 1054 * MiB;
constexpr size_t WS_END = 1071 * MiB;
constexpr int CW_BAR = 4096;
constexpr int CW_CNT = 16384;

constexpr int RING_BYTES = 131072;
constexpr int PSCR_OFF = 131072;
constexpr int LDSCTL_OFF = 151552, MISC_OFF = LDSCTL_OFF + 320;
constexpr int LDS_BYTES = 155648;

#define RLX_AGENT __ATOMIC_RELAXED, __HIP_MEMORY_SCOPE_AGENT
#define LDS_WAIT() asm volatile("s_waitcnt lgkmcnt(0)" ::: "memory")
#define VM_WAIT() asm volatile("s_waitcnt vmcnt(0)" ::: "memory")
__device__ __forceinline__ unsigned f2bf(float f) { unsigned u = __builtin_bit_cast(unsigned, f); return (u + 0x7fffu + ((u >> 16) & 1u)) >> 16; }
__device__ __forceinline__ unsigned pk2(float lo, float hi) { return f2bf(lo) | (f2bf(hi) << 16); }
__device__ __forceinline__ float bf_lo(unsigned u) { return __builtin_bit_cast(float, u << 16); }
__device__ __forceinline__ float bf_hi(unsigned u) { return __builtin_bit_cast(float, u & 0xffff0000u); }
__device__ __forceinline__ float bf1(bf16_t h) { return __builtin_bit_cast(float, (unsigned)h << 16); }
__device__ __forceinline__ float siluf(float v) { return v * __builtin_amdgcn_rcpf(1.0f + __expf(-v)); }
__device__ __forceinline__ float shx(float v, int mask, int lane) { return __builtin_bit_cast(float, __builtin_amdgcn_ds_bpermute((lane ^ mask) << 2, __builtin_bit_cast(int, v))); }
__device__ __forceinline__ float wave_sum(float v, int lane) {
#pragma unroll
    for (int o = 1; o < 64; o <<= 1) v += shx(v, o, lane);
    return v;
}

__device__ __forceinline__ int lane_id() { return (int)__builtin_amdgcn_mbcnt_hi(~0u, __builtin_amdgcn_mbcnt_lo(~0u, 0u)); }
#define XB_TMO      128
#define XB_XCNT(j)  (256  + 64 * (j))
#define XB_XSUB(j)  (1280 + 64 * (j))
#define XB_XGEN(j)  (2304 + 64 * (j))
#define XB_TOP      3328
#define XB_TOPGEN   3392
#define XCD_BAR_WORDS 3456
#define XB_SPIN_CAP (1u << 18)

__device__ __forceinline__ unsigned xb_ld(unsigned* p)              { return __hip_atomic_load(p, __ATOMIC_RELAXED, __HIP_MEMORY_SCOPE_AGENT); }
__device__ __forceinline__ unsigned xb_add(unsigned* p, unsigned v) { return __hip_atomic_fetch_add(p, v, __ATOMIC_RELAXED, __HIP_MEMORY_SCOPE_AGENT); }
__device__ __forceinline__ unsigned xb_xcc_id() { return (unsigned)__builtin_amdgcn_s_getreg((3 << 11) | 20) & 0xFu; }
#define XB_SPIN(cond, bar) do { unsigned _sp = 0; while (cond) { __builtin_amdgcn_s_sleep(1); \
    if ((++_sp & 255u) == 0u) { if (xb_ld(&(bar)[XB_TMO])) break; if (_sp > XB_SPIN_CAP) { atomicAdd(&(bar)[XB_TMO], 1u); break; } } } } while (0)

struct XcdBarrier {
    unsigned* bar; unsigned x;
    volatile LAS unsigned* st;
    int wave0;
};
__device__ __forceinline__ XcdBarrier xcd_barrier_post(unsigned* bar, volatile LAS unsigned* st, int wave0) {
    XcdBarrier b; b.bar = bar; b.x = xb_xcc_id(); b.st = st; b.wave0 = wave0;
    if (wave0 == 0 && lane_id() == 0) (void)xb_add(&bar[XB_XCNT(b.x)], 1u);
    return b;
}
__device__ __forceinline__ void xcd_barrier_complete(unsigned* bar, unsigned x, unsigned& nloc, unsigned& nx) {
    const unsigned G = gridDim.x * gridDim.y * gridDim.z;
    unsigned sum, cnt, mine, sp = 0u;
    for (;;) {
        sum = 0u; cnt = 0u; mine = 0u;
#pragma unroll
        for (unsigned j = 0; j < 16; ++j) { const unsigned c = xb_ld(&bar[XB_XCNT(j)]); sum += c; cnt += (c > 0u) ? 1u : 0u; mine = (j == x) ? c : mine; }
        if (sum == G) break;
        __builtin_amdgcn_s_sleep(1);
        if ((++sp & 255u) == 0u) { if (xb_ld(&bar[XB_TMO])) break; if (sp > XB_SPIN_CAP) { atomicAdd(&bar[XB_TMO], 1u); break; } }
    }
    nloc = mine > 0u ? mine : 1u; nx = cnt > 0u ? cnt : 1u;
}
__device__ __forceinline__ void xcd_barrier(const XcdBarrier& b) {
    asm volatile("s_waitcnt vmcnt(0)" ::: "memory");
    __syncthreads();
    if (b.wave0 == 0 && lane_id() == 0) {
        unsigned* bar = b.bar;
        __builtin_amdgcn_s_waitcnt(0);
        unsigned nloc = b.st[0], nx = b.st[1];
        if (nloc == 0u) { xcd_barrier_complete(bar, b.x, nloc, nx); b.st[0] = nloc; b.st[1] = nx; }
        const unsigned old = xb_add(&bar[XB_XSUB(b.x)], 1u);
        const unsigned gen = old / nloc;
        if (old + 1u == (gen + 1u) * nloc) {
            __builtin_amdgcn_fence(__ATOMIC_RELEASE, "agent");
            asm volatile("s_waitcnt vmcnt(0)" ::: "memory");
            const unsigned og = xb_add(&bar[XB_TOP], 1u);
            const unsigned tg = og / nx;
            if (og + 1u == (tg + 1u) * nx) xb_add(&bar[XB_TOPGEN], 1u);
            else XB_SPIN(xb_ld(&bar[XB_TOPGEN]) == tg, bar);
            __builtin_amdgcn_fence(__ATOMIC_ACQUIRE, "agent");
            xb_add(&bar[XB_XGEN(b.x)], 1u);
            asm volatile("s_waitcnt vmcnt(0)" ::: "memory");
        } else {
            XB_SPIN(xb_ld(&bar[XB_XGEN(b.x)]) == gen, bar);
            __builtin_amdgcn_fence(__ATOMIC_ACQUIRE, "agent");
            asm volatile("s_waitcnt vmcnt(0)" ::: "memory");
        }
    }
    __syncthreads();
}

struct Args {
    const float *x, *c, *ctx, *c_ctx, *w_mod, *b_mod, *norm1_w, *norm2_w, *ssd_w_in, *ssd_conv_w, *ssd_conv_b, *ssd_dt_bias, *ssd_a_log, *ssd_d, *ssd_norm_w, *ssd_w_out,
                *attn_w_qkv, *attn_b_qkv, *attn_sink, *attn_w_o, *attn_b_o, *ffn_w1, *ffn_w3, *ffn_w2, *moe_router, *moe_w1, *moe_w3, *moe_w2, *final_norm_w;
    float* out; unsigned char* ws; int ph_lo, ph_hi;
};
struct Frame {
    LAS unsigned char* lds;
    int tid, lane, wave, G;
    unsigned char* ws; gu32* ctl; float* out;
    unsigned char* ws0; float* out0; int wave0;
};
__device__ __forceinline__ void phase_enter(Frame& F) { int l = lane_id(); asm volatile("" : "+v"(l)); F.lane = l; F.wave = F.wave0; F.tid = F.wave0 * 64 + l;
    unsigned char* w = F.ws0; float* o = F.out0; asm volatile("" : "+s"(w), "+s"(o)); F.ws = w; F.ctl = (gu32*)(w + WS_CTL); F.out = o; }
__device__ __forceinline__ float* resid_row(const Frame& F, int R) {
    const int b = R / SROW, s = R - b * SROW;
    return s < NCTX ? (float*)(F.ws + WS_CX) + (size_t)(b * NCTX + s) * DM : F.out + (size_t)(b * SEQ + s - NCTX) * DM;
}
__device__ __forceinline__ float* resid_panel(const Frame& F, int pm, int& cond) {
    const int b = pm / 17, j = pm - b * 17; cond = j == 0 ? 16 : b;
    return j == 0 ? (float*)(F.ws + WS_CX) + (size_t)(b * NCTX) * DM : F.out + (size_t)(b * SEQ + (j - 1) * 256) * DM;
}

__device__ __forceinline__ void transpose_item(const float* W, int ldw, int col0, int ncb, int K, bf16_t* WT, int mode, int half, LAS float* scr, int item, int lane) {
    const int kb = item / ncb, nb = item - kb * ncb, k0 = 64 * kb, n0 = 32 * nb;
#pragma unroll 8
    for (int i = 0; i < 32; ++i) { const int kk = 2 * i + (lane >> 5); scr[kk * 33 + (lane & 31)] = W[(size_t)(k0 + kk) * ldw + col0 + n0 + (lane & 31)]; }
    LDS_WAIT(); asm volatile("" ::: "memory");
    const int c = lane & 7;
#pragma unroll
    for (int j = 0; j < 4; ++j) { const int n = (lane >> 3) + 8 * j; const LAS float* s = scr + (8 * c) * 33 + n;
        u32x4 o; o.x = pk2(s[0 * 33], s[1 * 33]); o.y = pk2(s[2 * 33], s[3 * 33]); o.z = pk2(s[4 * 33], s[5 * 33]); o.w = pk2(s[6 * 33], s[7 * 33]);
        const int cl = n0 + n; const int drow = mode == 0 ? cl : ((cl >> 7) * 256 + half * 128 + (cl & 127));
        *(GAS u32x4*)(WT + (size_t)drow * K + k0 + 8 * c) = o; }
    LDS_WAIT(); asm volatile("" ::: "memory");
}
__device__ __forceinline__ void p0_prologue(Frame& F, const Args& A) {
    phase_enter(F);
    {
        LAS float* sc = (LAS float*)F.lds;
        LAS float* red = (LAS float*)(F.lds + 81920);
        for (int idx = F.tid; idx < 17 * 1024; idx += 512) { const int cb = idx >> 10, k = idx & 1023; const float v = cb < 16 ? A.c[cb * 1024 + k] : A.c_ctx[k]; sc[k * 20 + cb] = v / (1.0f + expf(-v)); }
        __syncthreads();
        float* MODV = (float*)(F.ws + WS_MODV);
        for (int item = blockIdx.x; item < 4 * 96; item += F.G) {
            const int i = item / 96, cblk = item - i * 96;
            const float* Wm = A.w_mod + (size_t)i * 1024 * 6144 + cblk * 64 + F.lane;
            float acc[17];
#pragma unroll
            for (int cb = 0; cb < 17; ++cb) acc[cb] = 0.f;
            const int k0 = F.wave * 128;
#pragma unroll 4
            for (int kk = 0; kk < 128; ++kk) { const int k = k0 + kk; const float w = Wm[(size_t)k * 6144]; const LAS float* s = sc + k * 20;
#pragma unroll
                for (int cb = 0; cb < 17; ++cb) acc[cb] += s[cb] * w; }
#pragma unroll
            for (int cb = 0; cb < 17; ++cb) red[(F.wave * 17 + cb) * 64 + F.lane] = acc[cb];
            __syncthreads();
            for (int idx = F.tid; idx < 17 * 64; idx += 512) { const int cb = idx >> 6, l = idx & 63; float s = 0.f;
#pragma unroll
                for (int w = 0; w < 8; ++w) s += red[(w * 17 + cb) * 64 + l];
                MODV[(size_t)(i * 17 + cb) * 6144 + cblk * 64 + l] = s + A.b_mod[i * 6144 + cblk * 64 + l]; }
            __syncthreads();
        }
    }
    if (blockIdx.x == 0) { float* RT = (float*)(F.ws + WS_ROPE);
        for (int idx = F.tid; idx < 1024; idx += 512) { const int id = idx >> 4, f = idx & 15; const float inv = __builtin_amdgcn_exp2f(-(float)f * (13.287712379549449f / 16.0f)); const float ang = (float)id * inv;
            RT[idx] = __cosf(ang); RT[1024 + idx] = __sinf(ang); } }
    __syncthreads();
    {
        LAS float* scr = (LAS float*)(F.lds + F.wave * 16384);
        const int gw = blockIdx.x * NWAVES + F.wave, NGW = F.G * NWAVES;
        constexpr int I1 = 16 * 64, I2 = 16 * 130, I3 = 32 * 32, I4 = 16 * 88, I5 = 16 * 88, I6 = 44 * 32, I7 = 16 * 48, I8 = 16 * 32, IPER = I1 + I2 + I3 + I4 + I5 + I6 + I7 + I8;
        for (int it = gw; it < 2 * IPER; it += NGW) {
            const int j = it / IPER; int r = it - j * IPER;
            unsigned char* wss = F.ws + WS_W + (size_t)j * W_SSD_STRIDE; unsigned char* wsa = F.ws + WS_W + W_ATT0 + (size_t)j * W_ATT_STRIDE;
            if (r < I1) { transpose_item(A.ssd_w_in + (size_t)j * 1024 * SSD_IN, SSD_IN, 0, 64, 1024, (bf16_t*)(wss + W_WZ), 0, 0, scr, r, F.lane); continue; } r -= I1;
            if (r < I2) { transpose_item(A.ssd_w_in + (size_t)j * 1024 * SSD_IN, SSD_IN, 2048, 130, 1024, (bf16_t*)(wss + W_WIN), 0, 0, scr, r, F.lane); continue; } r -= I2;
            if (r < I3) { transpose_item(A.ssd_w_out + (size_t)j * 2048 * 1024, 1024, 0, 32, 2048, (bf16_t*)(wss + W_WOUT), 0, 0, scr, r, F.lane); continue; } r -= I3;
            if (r < I4) { transpose_item(A.ffn_w1 + (size_t)j * 1024 * DFF, DFF, 0, 88, 1024, (bf16_t*)(wss + W_WUP), 1, 0, scr, r, F.lane); continue; } r -= I4;
            if (r < I5) { transpose_item(A.ffn_w3 + (size_t)j * 1024 * DFF, DFF, 0, 88, 1024, (bf16_t*)(wss + W_WUP), 1, 1, scr, r, F.lane); continue; } r -= I5;
            if (r < I6) { transpose_item(A.ffn_w2 + (size_t)j * DFF * 1024, 1024, 0, 32, DFF, (bf16_t*)(wss + W_WDN), 0, 0, scr, r, F.lane); continue; } r -= I6;
            if (r < I7) { transpose_item(A.attn_w_qkv + (size_t)j * 1024 * NQKV, NQKV, 0, 48, 1024, (bf16_t*)(wsa + W_WQKV), 0, 0, scr, r, F.lane); continue; } r -= I7;
            transpose_item(A.attn_w_o + (size_t)j * 1024 * 1024, 1024, 0, 32, 1024, (bf16_t*)(wsa + W_WO), 0, 0, scr, r, F.lane);
        }
        for (int j = 0; j < 2; ++j) { u32x4* z = (u32x4*)(F.ws + WS_W + (size_t)j * W_SSD_STRIDE + W_WIN + (size_t)4160 * 1024 * 2);
            for (int idx = blockIdx.x * 512 + F.tid; idx < 192 * 1024 * 2 / 16; idx += F.G * 512) z[idx] = (u32x4){0u, 0u, 0u, 0u}; }
    }
}
__device__ __forceinline__ void moe_convert(Frame& F, const Args& A, int j) {
    phase_enter(F);
    LAS float* scr = (LAS float*)(F.lds + F.wave * 16384);
    const int gw = blockIdx.x * NWAVES + F.wave, NGW = F.G * NWAVES;
    constexpr int IE = 16 * 112, I2 = 56 * 32;
    bf16_t* MW13 = (bf16_t*)(F.ws + WS_BIG + BIG_MW13); bf16_t* MW2 = (bf16_t*)(F.ws + WS_BIG + BIG_MW2);
    for (int it = gw; it < 8 * (2 * IE + I2); it += NGW) {
        const int e = it / (2 * IE + I2); int r = it - e * (2 * IE + I2);
        const size_t we = (size_t)(j * 8 + e) * 1024 * DFFE;
        if (r < IE) { transpose_item(A.moe_w1 + we, DFFE, 0, 112, 1024, MW13 + (size_t)e * 7168 * 1024, 1, 0, scr, r, F.lane); continue; } r -= IE;
        if (r < IE) { transpose_item(A.moe_w3 + we, DFFE, 0, 112, 1024, MW13 + (size_t)e * 7168 * 1024, 1, 1, scr, r, F.lane); continue; } r -= IE;
        transpose_item(A.moe_w2 + we, 1024, 0, 32, DFFE, MW2 + (size_t)e * 1024 * DFFE, 0, 0, scr, r, F.lane);
    }
}

__device__ __forceinline__ void norm_phase(Frame& F, const Args& A, int i, int which, int mode) {
    phase_enter(F);
    const bool first = mode & 1, combine = mode & 2, route = mode & 4, fin = mode & 8, lastl = mode & 16;
    const float* MODV = (const float*)(F.ws + WS_MODV);
    bf16_t* H = (bf16_t*)(F.ws + WS_H);
    const bf16_t* EO = (const bf16_t*)(F.ws + WS_Y);
    LAS float* rt = (LAS float*)F.lds;
    LAS int* ents = (LAS int*)(F.lds + 32768);
    const int jm = i >> 1;
    if (route) { const float* rg = A.moe_router + (size_t)jm * 1024 * 8; for (int idx = F.tid; idx < 8192; idx += 512) rt[idx] = rg[idx]; }
    __syncthreads();
    const float* nw = fin ? A.final_norm_w : ((which == 0 ? A.norm1_w : A.norm2_w) + i * 1024);
    unsigned* cnt = (unsigned*)(F.ctl + CW_CNT + (size_t)jm * 8 * 64);
    int* rlist = (int*)(F.ws + WS_RLIST); float* GATE = (float*)(F.ws + WS_GATE);
    for (int ch = blockIdx.x; ch < MROWS / 32; ch += F.G) {
        const int R0 = ch * 32, b = R0 / SROW, s0 = R0 - b * SROW; const bool isctx = s0 < NCTX; const int cond = isctx ? 16 : b;
        if (fin && isctx) continue;
        const bool do_route = route && !(lastl && isctx);
        const float* mv = MODV + (size_t)(i * 17 + cond) * 6144;
        f32x4 wv[4], shv[4], scv[4], g5[4];
#pragma unroll
        for (int j = 0; j < 4; ++j) { const int col = 4 * F.lane + 256 * j; wv[j] = *(const f32x4*)(nw + col);
            if (!fin) { shv[j] = *(const f32x4*)(mv + (which ? 3 : 0) * 1024 + col); scv[j] = *(const f32x4*)(mv + (which ? 4 : 1) * 1024 + col); }
            if (combine) g5[j] = *(const f32x4*)(MODV + (size_t)((i - 1) * 17 + cond) * 6144 + 5 * 1024 + col); }
        for (int rr = 0; rr < 4; ++rr) {
            const int R = R0 + F.wave * 4 + rr, s = s0 + F.wave * 4 + rr;
            float* res = isctx ? (float*)(F.ws + WS_CX) + (size_t)(b * NCTX + s) * DM : F.out + (size_t)(b * SEQ + s - NCTX) * DM;
            const float* src = first ? (isctx ? A.ctx + (size_t)(b * NCTX + s) * DM : A.x + (size_t)(b * SEQ + s - NCTX) * DM) : res;
            f32x4 v[4]; float ss = 0.f;
#pragma unroll
            for (int j = 0; j < 4; ++j) v[j] = *(const f32x4*)(src + 4 * F.lane + 256 * j);
            if (combine) {
#pragma unroll
                for (int j = 0; j < 4; ++j) { const u32x2 e0 = *(const u32x2*)(EO + (size_t)(2 * R) * DM + 4 * F.lane + 256 * j), e1 = *(const u32x2*)(EO + (size_t)(2 * R + 1) * DM + 4 * F.lane + 256 * j);
                    f32x4 ev; ev.x = bf_lo(e0.x) + bf_lo(e1.x); ev.y = bf_hi(e0.x) + bf_hi(e1.x); ev.z = bf_lo(e0.y) + bf_lo(e1.y); ev.w = bf_hi(e0.y) + bf_hi(e1.y);
                    v[j] = v[j] + g5[j] * ev; }
            }
            if (first || combine) {
#pragma unroll
                for (int j = 0; j < 4; ++j) *(f32x4*)(res + 4 * F.lane + 256 * j) = v[j];
            }
#pragma unroll
            for (int j = 0; j < 4; ++j) ss += (v[j].x * v[j].x + v[j].y * v[j].y) + (v[j].z * v[j].z + v[j].w * v[j].w);
            const float rstd = 1.0f / sqrtf(wave_sum(ss, F.lane) * (1.0f / DM) + EPS);
            if (fin) {
#pragma unroll
                for (int j = 0; j < 4; ++j) *(f32x4*)(res + 4 * F.lane + 256 * j) = v[j] * rstd * wv[j];
                continue;
            }
#pragma unroll
            for (int j = 0; j < 4; ++j) { v[j] = v[j] * rstd * wv[j] * (scv[j] + 1.0f) + shv[j];
                u32x2 o; o.x = pk2(v[j].x, v[j].y); o.y = pk2(v[j].z, v[j].w); *(u32x2*)(H + (size_t)R * DM + 4 * F.lane + 256 * j) = o; }
            if (do_route) {
                float lg[8];
#pragma unroll
                for (int e = 0; e < 8; ++e) lg[e] = 0.f;
#pragma unroll
                for (int j = 0; j < 4; ++j)
#pragma unroll
                    for (int q = 0; q < 4; ++q) { const int col = 4 * F.lane + 256 * j + q; const f32x4 r0 = *(const LAS f32x4*)(rt + col * 8), r1 = *(const LAS f32x4*)(rt + col * 8 + 4); const float y = v[j][q];
                        lg[0] += y * r0.x; lg[1] += y * r0.y; lg[2] += y * r0.z; lg[3] += y * r0.w; lg[4] += y * r1.x; lg[5] += y * r1.y; lg[6] += y * r1.z; lg[7] += y * r1.w; }
#pragma unroll
                for (int e = 0; e < 8; ++e) lg[e] = wave_sum(lg[e], F.lane);
                int i1 = 0; float v1 = lg[0];
#pragma unroll
                for (int e = 1; e < 8; ++e) if (lg[e] > v1) { v1 = lg[e]; i1 = e; }
                int i2 = -1; float v2 = -3.0e38f;
#pragma unroll
                for (int e = 0; e < 8; ++e) if (e != i1 && lg[e] > v2) { v2 = lg[e]; i2 = e; }
                const float g1 = 1.0f / (1.0f + expf(v2 - v1)), g2 = 1.0f - g1;
                if (F.lane == 0) { ents[(F.wave * 4 + rr) * 2] = i1; ents[(F.wave * 4 + rr) * 2 + 1] = i2; GATE[(size_t)R * 2] = g1; GATE[(size_t)R * 2 + 1] = g2; }
            }
        }
        if (do_route) {
            __syncthreads();
            if (F.wave == 0) {
                const int e = ents[F.lane];
#pragma unroll
                for (int ee = 0; ee < 8; ++ee) { const unsigned long long m = __ballot(e == ee); const int n = __popcll(m);
                    if (n) { unsigned base = 0; if (F.lane == 0) base = __hip_atomic_fetch_add(cnt + ee * 64, (unsigned)n, RLX_AGENT); base = __builtin_amdgcn_readfirstlane(base);
                        if (e == ee) { const int pos = (int)base + __popcll(m & ((1ull << F.lane) - 1ull)); rlist[(size_t)ee * MROWS + pos] = (R0 + (F.lane >> 1)) * 2 + (F.lane & 1); } } }
            }
            __syncthreads();
        }
    }
}

struct EpiXbc {
    static constexpr bool PERM = true;
    bf16_t* XBC; float* DT;
    __device__ __forceinline__ void operator()(const f32x4 (&acc)[2][2][4][2], const pg8::Unit& u, int wr, int wc, int fr, int fq) const {
        const int row0 = u.pm * 256 + wr * 64 + fr;
        if (u.pn < 16) { const int col0 = u.pn * 256 + wc * 32 + 8 * fq;
#pragma unroll
            for (int ai = 0; ai < 2; ++ai)
#pragma unroll
                for (int m = 0; m < 4; ++m) { bf16_t* rowp = XBC + (size_t)(row0 + ai * 128 + m * 16) * CONVCH + col0;
#pragma unroll
                    for (int bj = 0; bj < 2; ++bj) { const f32x4 v0 = acc[ai][bj][m][0], v1 = acc[ai][bj][m][1]; u32x4 w; w.x = pg8::cvt_pk_bf16(v0[0], v0[1]); w.y = pg8::cvt_pk_bf16(v0[2], v0[3]); w.z = pg8::cvt_pk_bf16(v1[0], v1[1]); w.w = pg8::cvt_pk_bf16(v1[2], v1[3]);
                        *(u32x4*)(rowp + bj * 128) = w; } }
        } else if (wc < 2) { const int c0 = wc * 32 + 8 * fq;
#pragma unroll
            for (int ai = 0; ai < 2; ++ai)
#pragma unroll
                for (int m = 0; m < 4; ++m) { float* p = DT + (size_t)(row0 + ai * 128 + m * 16) * 64 + c0; *(f32x4*)p = acc[ai][0][m][0]; *(f32x4*)(p + 4) = acc[ai][0][m][1]; }
        }
    }
};
struct EpiGate {
    static constexpr bool PERM = true;
    const bf16_t* Y; bf16_t* Gt; const float* nw; LAS float* P;
    __device__ __forceinline__ void operator()(f32x4 (&acc)[2][2][4][2], const pg8::Unit& u, int wr, int wc, int fr, int fq) const {
        const int row0 = u.pm * 256 + wr * 64 + fr, col0 = u.pn * 256 + wc * 32 + 8 * fq;
#pragma unroll
        for (int ai = 0; ai < 2; ++ai)
#pragma unroll
            for (int m = 0; m < 4; ++m) { const bf16_t* yp = Y + (size_t)(row0 + ai * 128 + m * 16) * DIN + col0; float ssq = 0.f;
#pragma unroll
                for (int bj = 0; bj < 2; ++bj) { const u32x4 yv = *(const u32x4*)(yp + bj * 128); f32x4 z0 = acc[ai][bj][m][0], z1 = acc[ai][bj][m][1];
                    z0[0] = bf_lo(yv.x) * siluf(z0[0]); z0[1] = bf_hi(yv.x) * siluf(z0[1]); z0[2] = bf_lo(yv.y) * siluf(z0[2]); z0[3] = bf_hi(yv.y) * siluf(z0[3]);
                    z1[0] = bf_lo(yv.z) * siluf(z1[0]); z1[1] = bf_hi(yv.z) * siluf(z1[1]); z1[2] = bf_lo(yv.w) * siluf(z1[2]); z1[3] = bf_hi(yv.w) * siluf(z1[3]);
                    ssq += (z0[0] * z0[0] + z0[1] * z0[1]) + (z0[2] * z0[2] + z0[3] * z0[3]) + (z1[0] * z1[0] + z1[1] * z1[1]) + (z1[2] * z1[2] + z1[3] * z1[3]);
                    acc[ai][bj][m][0] = z0; acc[ai][bj][m][1] = z1; }
                ssq += shx(ssq, 16, fq * 16 + fr); ssq += shx(ssq, 32, fq * 16 + fr);
                if (fq == 0) P[(ai * 128 + wr * 64 + m * 16 + fr) * 4 + wc] = ssq; }
        asm volatile("s_waitcnt lgkmcnt(0)" ::: "memory"); __builtin_amdgcn_s_barrier(); asm volatile("" ::: "memory");
        f32x4 nv[2][2];
#pragma unroll
        for (int bj = 0; bj < 2; ++bj) { nv[bj][0] = *(const f32x4*)(nw + col0 + bj * 128); nv[bj][1] = *(const f32x4*)(nw + col0 + bj * 128 + 4); }
#pragma unroll
        for (int ai = 0; ai < 2; ++ai)
#pragma unroll
            for (int m = 0; m < 4; ++m) { const f32x4 pp = *(const LAS f32x4*)(P + (ai * 128 + wr * 64 + m * 16 + fr) * 4); const float rstd = 1.0f / sqrtf(((pp.x + pp.y) + (pp.z + pp.w)) * (1.0f / 256.0f) + EPS);
                bf16_t* gp = Gt + (size_t)(row0 + ai * 128 + m * 16) * DIN + col0;
#pragma unroll
                for (int bj = 0; bj < 2; ++bj) { const f32x4 v0 = acc[ai][bj][m][0] * rstd * nv[bj][0], v1 = acc[ai][bj][m][1] * rstd * nv[bj][1];
                    u32x4 w; w.x = pg8::cvt_pk_bf16(v0[0], v0[1]); w.y = pg8::cvt_pk_bf16(v0[2], v0[3]); w.z = pg8::cvt_pk_bf16(v1[0], v1[1]); w.w = pg8::cvt_pk_bf16(v1[2], v1[3]);
                    *(u32x4*)(gp + bj * 128) = w; } }
        asm volatile("s_waitcnt lgkmcnt(0)" ::: "memory");
    }
};
struct EpiResid {
    static constexpr bool PERM = false;
    unsigned char* ws; float* out; const float* modl; int gidx; const float* bias;
    __device__ __forceinline__ void operator()(const f32x4 (&acc)[2][2][4][2], const pg8::Unit& u, int wr, int wc, int fr, int fq) const {
        const int b = u.pm / 17, j = u.pm - b * 17, cond = j == 0 ? 16 : b;
        float* res = (j == 0 ? (float*)(ws + WS_CX) + (size_t)(b * NCTX) * DM : out + (size_t)(b * SEQ + (j - 1) * 256) * DM) + (size_t)(wr * 64 + fr) * DM + u.pn * 256 + wc * 32 + 4 * fq;
        const float* gv = modl + (size_t)cond * 6144 + gidx * 1024 + u.pn * 256 + wc * 32 + 4 * fq;
        const float* bp = bias ? bias + u.pn * 256 + wc * 32 + 4 * fq : nullptr;
#pragma unroll
        for (int bj = 0; bj < 2; ++bj) {
            f32x4 g[2], bv[2];
#pragma unroll
            for (int n = 0; n < 2; ++n) { g[n] = *(const f32x4*)(gv + bj * 128 + n * 16); bv[n] = bp ? *(const f32x4*)(bp + bj * 128 + n * 16) : (f32x4){0.f, 0.f, 0.f, 0.f}; }
#pragma unroll
            for (int ai = 0; ai < 2; ++ai)
#pragma unroll
                for (int m = 0; m < 4; ++m) { float* p = res + (size_t)(ai * 128 + m * 16) * DM + bj * 128;
                    const f32x4 o0 = *(const f32x4*)p, o1 = *(const f32x4*)(p + 16);
                    *(f32x4*)p = o0 + g[0] * (acc[ai][bj][m][0] + bv[0]); *(f32x4*)(p + 16) = o1 + g[1] * (acc[ai][bj][m][1] + bv[1]);
                    if (m & 1) asm volatile("" ::: "memory"); }
        }
    }
};
struct EpiSwiglu {
    static constexpr bool PERM = true;
    bf16_t* ACT; int ldc;
    __device__ __forceinline__ void operator()(const f32x4 (&acc)[2][2][4][2], const pg8::Unit& u, int wr, int wc, int fr, int fq) const {
        const int row0 = u.pm * 256 + wr * 64 + fr, col0 = u.pn * 128 + wc * 32 + 8 * fq;
#pragma unroll
        for (int ai = 0; ai < 2; ++ai)
#pragma unroll
            for (int m = 0; m < 4; ++m) { const f32x4 g0 = acc[ai][0][m][0], g1 = acc[ai][0][m][1], u0 = acc[ai][1][m][0], u1 = acc[ai][1][m][1];
                u32x4 w; w.x = pg8::cvt_pk_bf16(siluf(g0[0]) * u0[0], siluf(g0[1]) * u0[1]); w.y = pg8::cvt_pk_bf16(siluf(g0[2]) * u0[2], siluf(g0[3]) * u0[3]);
                w.z = pg8::cvt_pk_bf16(siluf(g1[0]) * u1[0], siluf(g1[1]) * u1[1]); w.w = pg8::cvt_pk_bf16(siluf(g1[2]) * u1[2], siluf(g1[3]) * u1[3]);
                *(u32x4*)(ACT + (size_t)(row0 + ai * 128 + m * 16) * ldc + col0) = w; }
    }
};
struct EpiQkv {
    static constexpr bool PERM = false;
    bf16_t *Q, *Kb, *Vb; const float* bias; const float* rope;
    __device__ __forceinline__ void operator()(const f32x4 (&acc)[2][2][4][2], const pg8::Unit& u, int wr, int wc, int fr, int fq) const {
        const int b = u.pm / 17, j = u.pm - b * 17; const bool isctx = j == 0; const int pos0 = (j - 1) * 256;
        bf16_t* dst; int ld, cbase; float sc = 1.0f;
        if (u.pn < 4) { dst = Q; ld = QW; cbase = u.pn * 256; sc = 0.125f; } else if (u.pn == 4) { dst = Kb; ld = KVW; cbase = 0; } else { dst = Vb; ld = KVW; cbase = 0; }
        const bool dorope = !isctx && u.pn < 5; const int axis = wc & 1;
        const float* bp = bias + u.pn * 256 + wc * 32 + 4 * fq;
#pragma unroll
        for (int ai = 0; ai < 2; ++ai)
#pragma unroll
            for (int m = 0; m < 4; ++m) { const int r = ai * 128 + wr * 64 + m * 16 + fr; const int pos = pos0 + r; const int id = axis ? (pos & 63) : (pos >> 6);
                f32x4 cs = (f32x4){1.f, 1.f, 1.f, 1.f}, sn = (f32x4){0.f, 0.f, 0.f, 0.f};
                if (dorope) { cs = *(const f32x4*)(rope + id * 16 + 4 * fq); sn = *(const f32x4*)(rope + 1024 + id * 16 + 4 * fq); }
                bf16_t* rowp = dst + (size_t)(u.pm * 256 + r) * ld + cbase + wc * 32 + 4 * fq;
#pragma unroll
                for (int bj = 0; bj < 2; ++bj) { const f32x4 x0 = (acc[ai][bj][m][0] + *(const f32x4*)(bp + bj * 128)) * sc, x1 = (acc[ai][bj][m][1] + *(const f32x4*)(bp + bj * 128 + 16)) * sc;
                    const f32x4 o0 = x0 * cs - x1 * sn, o1 = x1 * cs + x0 * sn;
                    u32x2 w0, w1; w0.x = pg8::cvt_pk_bf16(o0[0], o0[1]); w0.y = pg8::cvt_pk_bf16(o0[2], o0[3]); w1.x = pg8::cvt_pk_bf16(o1[0], o1[1]); w1.y = pg8::cvt_pk_bf16(o1[2], o1[3]);
                    *(u32x2*)(rowp + bj * 128) = w0; *(u32x2*)(rowp + bj * 128 + 16) = w1; }
                if (m & 1) asm volatile("" ::: "memory"); }
    }
};

struct MoeOrder {
    pg8::StaticOrder so; int cs; int pp[9]; int cnt[8]; const int* rlist; size_t bstride; bool GATHER_A;
    __device__ __forceinline__ void locate(int pm, int& e, int& p, int& cn) const { const int gp = cs + pm; e = 0; int pbase = 0; cn = cnt[0];
#pragma unroll
        for (int k = 1; k < 8; ++k) { const bool ge = gp >= pp[k]; e += ge ? 1 : 0; pbase = ge ? pp[k] : pbase; cn = ge ? cnt[k] : cn; }
        p = gp - pbase; }
    __device__ bool next(int i, pg8::Unit& u) const { return so.next(i, u); }
    __device__ __forceinline__ const char* a_base(const pg8::Gemm& g, const pg8::Unit& u) const { return GATHER_A ? (const char*)g.A : (const char*)g.A + (size_t)u.pm * (size_t)(256 * 2) * g.lda; }
    __device__ __forceinline__ const char* b_base(const pg8::Gemm& g, const pg8::Unit& u) const { int e, p, cn; locate(u.pm, e, p, cn); return (const char*)g.Bt + (size_t)e * bstride + (size_t)u.pn * (size_t)(256 * 2) * g.K; }
    __device__ __forceinline__ unsigned row_off(const pg8::Gemm& g, const pg8::Unit& u, int r) const {
        if (!GATHER_A) return (unsigned)r * (unsigned)g.lda * 2u;
        int e, p, cn; locate(u.pm, e, p, cn); const int idx = p * 256 + r; const int tok = idx < cn ? (rlist[(size_t)e * MROWS + idx] >> 1) : 0; return (unsigned)tok * (unsigned)g.lda * 2u; }
};
struct EpiMoeDown {
    static constexpr bool PERM = true;
    MoeOrder mo; bf16_t* EO; const float* GATE;
    __device__ __forceinline__ void operator()(const f32x4 (&acc)[2][2][4][2], const pg8::Unit& u, int wr, int wc, int fr, int fq) const {
        int e, p, cn; mo.locate(u.pm, e, p, cn); const int* rl = mo.rlist + (size_t)e * MROWS + p * 256;
        const int col0 = u.pn * 256 + wc * 32 + 8 * fq;
#pragma unroll
        for (int ai = 0; ai < 2; ++ai)
#pragma unroll
            for (int m = 0; m < 4; ++m) { const int r = ai * 128 + wr * 64 + m * 16 + fr;
                if (p * 256 + r < cn) { const int ent = rl[r]; const float gt = GATE[ent]; bf16_t* dp = EO + (size_t)ent * DM + col0;
#pragma unroll
                    for (int bj = 0; bj < 2; ++bj) { const f32x4 v0 = acc[ai][bj][m][0] * gt, v1 = acc[ai][bj][m][1] * gt; u32x4 w; w.x = pg8::cvt_pk_bf16(v0[0], v0[1]); w.y = pg8::cvt_pk_bf16(v0[2], v0[3]); w.z = pg8::cvt_pk_bf16(v1[0], v1[1]); w.w = pg8::cvt_pk_bf16(v1[2], v1[3]);
                        *(u32x4*)(dp + bj * 128) = w; } } }
    }
};

__device__ __forceinline__ void scan_phase(Frame& F, const Args& A, int j) {
    phase_enter(F);
    const bf16_t* XBC = (const bf16_t*)(F.ws + WS_BIG); const float* DT = (const float*)(F.ws + WS_DT); bf16_t* Y = (bf16_t*)(F.ws + WS_Y);
    LAS float* dts = (LAS float*)(F.lds + 81920);
    const int lane = F.lane, wave = F.wave;
    for (int unit = blockIdx.x; unit < 256; unit += F.G) {
        const int b = unit >> 4, g = (unit >> 1) & 7, ph = unit & 1;
        int gcol, lcol, kind;
        if (lane < 16) { const int h4 = lane >> 2, sub = lane & 3; gcol = g * 256 + h4 * 64 + ph * 32 + sub * 8; lcol = h4 * 32 + sub * 8; kind = 0; }
        else if (lane < 32) { gcol = 2048 + g * 128 + (lane - 16) * 8; lcol = (lane - 16) * 8; kind = 1; }
        else if (lane < 48) { gcol = 3072 + g * 128 + (lane - 32) * 8; lcol = (lane - 32) * 8; kind = 2; }
        else { gcol = 0; lcol = 0; kind = 3; }
        float cw[5][8], cbias[8];
#pragma unroll
        for (int k = 0; k < 5; ++k) { const f32x4 a0 = *(const f32x4*)(A.ssd_conv_w + (size_t)(j * 5 + k) * CONVCH + gcol), a1 = *(const f32x4*)(A.ssd_conv_w + (size_t)(j * 5 + k) * CONVCH + gcol + 4);
            cw[k][0] = a0.x; cw[k][1] = a0.y; cw[k][2] = a0.z; cw[k][3] = a0.w; cw[k][4] = a1.x; cw[k][5] = a1.y; cw[k][6] = a1.z; cw[k][7] = a1.w; }
        { const f32x4 a0 = *(const f32x4*)(A.ssd_conv_b + (size_t)j * CONVCH + gcol), a1 = *(const f32x4*)(A.ssd_conv_b + (size_t)j * CONVCH + gcol + 4);
            cbias[0] = a0.x; cbias[1] = a0.y; cbias[2] = a0.z; cbias[3] = a0.w; cbias[4] = a1.x; cbias[5] = a1.y; cbias[6] = a1.z; cbias[7] = a1.w; }
        const int hh = wave >> 1, dir = wave & 1, p = lane & 31, nh = lane >> 5;
        const float Dk = A.ssd_d[(j * 2 + dir) * 32 + g * 4 + hh];
        f32x2 S[32];
#pragma unroll
        for (int q = 0; q < 32; ++q) S[q] = (f32x2){0.f, 0.f};
        for (int step = 0; step < 136; ++step) {
            const int cf = step, cbk = step < 8 ? 7 - step : 143 - step;
#pragma unroll
            for (int T = 0; T < 2; ++T) {
                const int chunk = T ? cbk : cf, t0 = chunk * 32, seg_lo = chunk < 8 ? 0 : NCTX, seg_hi = chunk < 8 ? NCTX : SROW;
                LAS unsigned char* tb_ = F.lds + T * 40960;
                if (kind < 3) {
                    const int tb = t0 + wave * 4;
                    u32x4 raw[8];
#pragma unroll
                    for (int q = 0; q < 8; ++q) { const int tt = tb - 2 + q; raw[q] = (tt >= seg_lo && tt < seg_hi) ? *(const u32x4*)(XBC + (size_t)(b * SROW + tt) * CONVCH + gcol) : (u32x4){0u, 0u, 0u, 0u}; }
#pragma unroll
                    for (int o = 0; o < 4; ++o) {
                        float r[8];
#pragma unroll
                        for (int c = 0; c < 8; ++c) r[c] = cbias[c];
#pragma unroll
                        for (int k = 0; k < 5; ++k) { const u32x4 w = raw[o + k];
                            r[0] += cw[k][0] * bf_lo(w.x); r[1] += cw[k][1] * bf_hi(w.x); r[2] += cw[k][2] * bf_lo(w.y); r[3] += cw[k][3] * bf_hi(w.y);
                            r[4] += cw[k][4] * bf_lo(w.z); r[5] += cw[k][5] * bf_hi(w.z); r[6] += cw[k][6] * bf_lo(w.w); r[7] += cw[k][7] * bf_hi(w.w); }
#pragma unroll
                        for (int c = 0; c < 8; ++c) r[c] = siluf(r[c]);
                        const int tok = wave * 4 + o;
                        if (kind == 0) { u32x4 w; w.x = pk2(r[0], r[1]); w.y = pk2(r[2], r[3]); w.z = pk2(r[4], r[5]); w.w = pk2(r[6], r[7]); *(LAS u32x4*)(tb_ + 32768 + tok * 256 + lcol * 2) = w; }
                        else { LAS float* dp = (LAS float*)(tb_ + (kind == 1 ? 0 : 16384)) + tok * 128 + lcol; *(LAS f32x4*)dp = (f32x4){r[0], r[1], r[2], r[3]}; *(LAS f32x4*)(dp + 4) = (f32x4){r[4], r[5], r[6], r[7]}; }
                    }
                }
            }
            if (F.tid < 256) { const int T = F.tid >> 7, tok = (F.tid >> 2) & 31, h4 = F.tid & 3, chunk = T ? cbk : cf, hd = g * 4 + h4;
                const float xb = DT[(size_t)(b * SROW + chunk * 32 + tok) * 64 + T * 32 + hd] + A.ssd_dt_bias[(j * 2 + T) * 32 + hd];
                const float dt = xb > 20.f ? xb : log1pf(expf(xb)); const float a = -expf(A.ssd_a_log[(j * 2 + T) * 32 + hd]);
                dts[((T * 32 + tok) * 4 + h4) * 2] = dt; dts[((T * 32 + tok) * 4 + h4) * 2 + 1] = expf(dt * a); }
            __syncthreads();
            {
                const LAS unsigned char* tb_ = F.lds + dir * 40960;
                const LAS float* Bs = (const LAS float*)tb_; const LAS float* Cs = (const LAS float*)(tb_ + 16384); const LAS bf16_t* xs = (const LAS bf16_t*)(tb_ + 32768);
                LAS bf16_t* ys = (LAS bf16_t*)(F.lds + 83968 + dir * 8192);
                for (int ii = 0; ii < 32; ++ii) {
                    const int tok = dir ? 31 - ii : ii;
                    const f32x2 dd = *(const LAS f32x2*)(dts + ((dir * 32 + tok) * 4 + hh) * 2);
                    const float xv = bf1(xs[tok * 128 + hh * 32 + p]); const float xdt = xv * dd.x, dec = dd.y;
                    const LAS f32x4* Bp = (const LAS f32x4*)(Bs + tok * 128 + 64 * nh); const LAS f32x4* Cp = (const LAS f32x4*)(Cs + tok * 128 + 64 * nh);
                    f32x2 ya = (f32x2){0.f, 0.f};
#pragma unroll
                    for (int q = 0; q < 16; ++q) { const f32x4 bq = Bp[q], cq = Cp[q];
                        S[2 * q] = S[2 * q] * dec + (f32x2){bq.x, bq.y} * xdt; S[2 * q + 1] = S[2 * q + 1] * dec + (f32x2){bq.z, bq.w} * xdt;
                        ya += (f32x2){cq.x, cq.y} * S[2 * q]; ya += (f32x2){cq.z, cq.w} * S[2 * q + 1]; }
                    float y = ya.x + ya.y; y += shx(y, 32, lane);
                    if (nh == 0) ys[tok * 128 + hh * 32 + p] = (bf16_t)f2bf(y + Dk * xv);
                }
            }
            __syncthreads();
#pragma unroll
            for (int T = 0; T < 2; ++T) {
                const int tok = F.tid >> 4, h4 = (F.tid >> 2) & 3, q4 = F.tid & 3, chunk = T ? cbk : cf;
                const int other = T == 0 ? (chunk < 8 ? 7 - chunk : 143 - chunk) : chunk;
                u32x4 v = *(const LAS u32x4*)(F.lds + 83968 + T * 8192 + (tok * 128 + h4 * 32 + q4 * 8) * 2);
                bf16_t* yp = Y + (size_t)(b * SROW + chunk * 32 + tok) * DIN + g * 256 + h4 * 64 + ph * 32 + q4 * 8;
                if (step > other) { const u32x4 o = *(const u32x4*)yp;
                    v.x = pk2(bf_lo(o.x) + bf_lo(v.x), bf_hi(o.x) + bf_hi(v.x)); v.y = pk2(bf_lo(o.y) + bf_lo(v.y), bf_hi(o.y) + bf_hi(v.y));
                    v.z = pk2(bf_lo(o.z) + bf_lo(v.z), bf_hi(o.z) + bf_hi(v.z)); v.w = pk2(bf_lo(o.w) + bf_lo(v.w), bf_hi(o.w) + bf_hi(v.w)); }
                *(u32x4*)yp = v;
            }
        }
        __syncthreads();
    }
}

typedef __bf16 bf16x2_t __attribute__((ext_vector_type(2)));
typedef short v4i16_t __attribute__((ext_vector_type(4)));
__device__ __forceinline__ unsigned cvtpk(float lo, float hi) { f32x2 v = {lo, hi}; bf16x2_t b = __builtin_convertvector(v, bf16x2_t); return __builtin_bit_cast(unsigned, b); }
__device__ __forceinline__ int crow(int r, int hi) { return (r & 3) + 8 * (r >> 2) + 4 * hi; }
__device__ __forceinline__ s16x4 vtr(const LAS unsigned char* p) { return __builtin_bit_cast(s16x4, __builtin_amdgcn_ds_read_tr16_b64_v4i16((LAS v4i16_t*)p)); }
#define MFMA32(a, b, c) __builtin_amdgcn_mfma_f32_32x32x16_bf16((a), (b), (c), 0, 0, 0)
__device__ __forceinline__ void attn_phase(Frame& F, const Args& A, int ja, bool need_ctx) {
    phase_enter(F);
    bf16_t* Q = (bf16_t*)(F.ws + WS_BIG); const bf16_t* Kb = (const bf16_t*)(F.ws + WS_BIG + BIG_K); const bf16_t* Vb = (const bf16_t*)(F.ws + WS_BIG + BIG_V);
    LAS unsigned char* Kl = F.lds; LAS unsigned char* Vl = F.lds + 9216;
    const int nunits = 2048 + (need_ctx ? 128 : 0);
    const int lane = F.lane, r = F.wave >> 1, rh = F.wave & 1, c31 = lane & 31, hl = lane >> 5;
    const int prow = F.tid >> 3, ppc = F.tid & 7;
    const int trq = (lane & 15) >> 2, trp = lane & 3, trb = (lane >> 4) & 1;
    for (int unit = blockIdx.x; unit < nunits; unit += F.G) {
        int b, g, nblk; bool cq;
        if (unit < 2048) { b = unit >> 7; nblk = (unit >> 2) & 31; g = unit & 3; cq = false; } else { const int u2 = unit - 2048; b = u2 >> 3; nblk = (u2 >> 2) & 1; g = u2 & 3; cq = true; }
        const int qrow0 = b * SROW + (cq ? 128 * nblk : NCTX + 128 * nblk);
        const int start = 128 * nblk;
        bf16x8 qf[2][4];
#pragma unroll
        for (int qb = 0; qb < 2; ++qb)
#pragma unroll
            for (int s = 0; s < 4; ++s) qf[qb][s] = *(const bf16x8*)(Q + (size_t)(qrow0 + 64 * rh + 32 * qb + c31) * QW + g * 256 + r * 64 + 16 * s + 8 * hl);
        const float sink = A.attn_sink[ja * 16 + g * 4 + r];
        float mrun[2] = {sink, sink}, lrun[2] = {1.f, 1.f};
        f32x16 ot[2][2];
#pragma unroll
        for (int db = 0; db < 2; ++db)
#pragma unroll
            for (int qb = 0; qb < 2; ++qb)
#pragma unroll
                for (int e = 0; e < 16; ++e) ot[db][qb][e] = 0.f;
        const int tt_lo = cq ? 0 : (nblk == 0 ? 2 : 0), tt_hi = cq ? 0 : (nblk == 31 ? 4 : 6);
        const int ntile = 4 + (tt_hi - tt_lo);
#define TILE_ROW0(t) ((t) < 4 ? b * SROW + 64 * (t) : b * SROW + NCTX + start - 128 + 64 * (tt_lo + (t) - 4))
        u32x4 kreg, vreg;
        { const int r0 = TILE_ROW0(0); kreg = *(const u32x4*)(Kb + (size_t)(r0 + prow) * KVW + g * 64 + ppc * 8); vreg = *(const u32x4*)(Vb + (size_t)(r0 + prow) * KVW + g * 64 + ppc * 8); }
        for (int t = 0; t < ntile; ++t) {
            __syncthreads();
            *(LAS u32x4*)(Kl + prow * 144 + ppc * 16) = kreg; *(LAS u32x4*)(Vl + prow * 144 + ppc * 16) = vreg;
            __syncthreads();
            if (t + 1 < ntile) { const int r0 = TILE_ROW0(t + 1); kreg = *(const u32x4*)(Kb + (size_t)(r0 + prow) * KVW + g * 64 + ppc * 8); vreg = *(const u32x4*)(Vb + (size_t)(r0 + prow) * KVW + g * 64 + ppc * 8); }
            f32x16 st[2][2];
#pragma unroll
            for (int kb = 0; kb < 2; ++kb) {
#pragma unroll
                for (int qb = 0; qb < 2; ++qb)
#pragma unroll
                    for (int e = 0; e < 16; ++e) st[kb][qb][e] = 0.f;
#pragma unroll
                for (int s = 0; s < 4; ++s) { const bf16x8 a = *(const LAS bf16x8*)(Kl + (32 * kb + c31) * 144 + (16 * s + 8 * hl) * 2);
                    st[kb][0] = MFMA32(a, qf[0][s], st[kb][0]); st[kb][1] = MFMA32(a, qf[1][s], st[kb][1]); }
            }
            if (t >= 4) { const int kpos0 = start - 128 + 64 * (tt_lo + t - 4);
#pragma unroll
                for (int kb = 0; kb < 2; ++kb)
#pragma unroll
                    for (int qb = 0; qb < 2; ++qb) { const int qpos = start + 64 * rh + 32 * qb + c31;
#pragma unroll
                        for (int e = 0; e < 16; ++e) { const int d = qpos - (kpos0 + 32 * kb + crow(e, hl)); if (d > 128 || d < -128) st[kb][qb][e] = -INFINITY; } }
            }
#pragma unroll
            for (int qb = 0; qb < 2; ++qb) {
                float mx = st[0][qb][0];
#pragma unroll
                for (int kb = 0; kb < 2; ++kb)
#pragma unroll
                    for (int e = 0; e < 16; ++e) mx = fmaxf(mx, st[kb][qb][e]);
                mx = fmaxf(mx, shx(mx, 32, lane));
                const float mn = fmaxf(mrun[qb], mx), alpha = __expf(mrun[qb] - mn); mrun[qb] = mn;
                float rs = 0.f;
#pragma unroll
                for (int kb = 0; kb < 2; ++kb)
#pragma unroll
                    for (int e = 0; e < 16; ++e) { const float pv = __expf(st[kb][qb][e] - mn); st[kb][qb][e] = pv; rs += pv; }
                rs += shx(rs, 32, lane);
                lrun[qb] = lrun[qb] * alpha + rs;
#pragma unroll
                for (int db = 0; db < 2; ++db)
#pragma unroll
                    for (int e = 0; e < 16; ++e) ot[db][qb][e] *= alpha;
            }
#pragma unroll
            for (int kb = 0; kb < 2; ++kb)
#pragma unroll
                for (int s2 = 0; s2 < 2; ++s2) {
                    bf16x8 pk[2];
#pragma unroll
                    for (int qb = 0; qb < 2; ++qb) { u32x4 w; w.x = cvtpk(st[kb][qb][8 * s2 + 0], st[kb][qb][8 * s2 + 1]); w.y = cvtpk(st[kb][qb][8 * s2 + 2], st[kb][qb][8 * s2 + 3]);
                        w.z = cvtpk(st[kb][qb][8 * s2 + 4], st[kb][qb][8 * s2 + 5]); w.w = cvtpk(st[kb][qb][8 * s2 + 6], st[kb][qb][8 * s2 + 7]); pk[qb] = __builtin_bit_cast(bf16x8, w); }
#pragma unroll
                    for (int db = 0; db < 2; ++db) {
                        const LAS unsigned char* vp = Vl + (32 * kb + 16 * s2 + 4 * hl + trq) * 144 + (32 * db + 16 * trb + 4 * trp) * 2;
                        const s16x4 lo = vtr(vp), hi = vtr(vp + 8 * 144);
                        const bf16x8 va = (bf16x8){lo[0], lo[1], lo[2], lo[3], hi[0], hi[1], hi[2], hi[3]};
                        ot[db][0] = MFMA32(va, pk[0], ot[db][0]); ot[db][1] = MFMA32(va, pk[1], ot[db][1]);
                    }
                }
        }
#undef TILE_ROW0
#pragma unroll
        for (int qb = 0; qb < 2; ++qb) { const float inv = 1.0f / lrun[qb]; bf16_t* op = Q + (size_t)(qrow0 + 64 * rh + 32 * qb + c31) * QW + g * 256 + r * 64;
#pragma unroll
            for (int db = 0; db < 2; ++db)
#pragma unroll
                for (int gq = 0; gq < 4; ++gq) { u32x2 w; w.x = cvtpk(ot[db][qb][4 * gq] * inv, ot[db][qb][4 * gq + 1] * inv); w.y = cvtpk(ot[db][qb][4 * gq + 2] * inv, ot[db][qb][4 * gq + 3] * inv);
                    *(u32x2*)(op + 32 * db + 8 * gq + 4 * hl) = w; } }
    }
    __syncthreads();
}

#ifndef PHMASK
#define PHMASK 0xFFFF
#endif
#define PHON(k) (((PHMASK) >> (k)) & 1)
#ifndef MK_PER_PHASE
#define MK_PER_PHASE 0
#endif
#define IN(k) (lo <= (k) && (k) < hi)
#define SEAM(k) do { if (IN(k) && IN((k) + 1)) xcd_barrier(bar); } while (0)
#define SITE_PTRS phase_enter(F); unsigned char* ws = F.ws; bf16_t* H = (bf16_t*)(ws + WS_H); bf16_t* BIG = (bf16_t*)(ws + WS_BIG); const float* MODV = (const float*)(ws + WS_MODV); (void)H; (void)BIG; (void)MODV; \
        unsigned char* wss = ws + WS_W + (size_t)lp * W_SSD_STRIDE; unsigned char* wsa = ws + WS_W + W_ATT0 + (size_t)lp * W_ATT_STRIDE; (void)wss; (void)wsa;
template <int lp, int c> __device__ __forceinline__ void moe_chunk(Frame& F, const Args& A, const int lo, const int hi, const XcdBarrier& bar, LAS unsigned char* ring) {
    constexpr int pb = 1 + lp * 19;
            const int pu = pb + 13 + 2 * c, pd = pu + 1;
            if (IN(pu) || IN(pd)) {
                SITE_PTRS
                MoeOrder mo;
                mo.pp[0] = 0;
#pragma unroll
                for (int e = 0; e < 8; ++e) { const int cn = (int)__hip_atomic_load((unsigned*)(F.ctl + CW_CNT + (size_t)(lp * 8 + e) * 64), RLX_AGENT); mo.cnt[e] = cn; mo.pp[e + 1] = mo.pp[e] + ((cn + 255) >> 8); }
                const int Ptot = mo.pp[8]; int nP = Ptot - c * MOE_CHUNK; nP = nP < 0 ? 0 : (nP > MOE_CHUNK ? MOE_CHUNK : nP);
                mo.cs = c * MOE_CHUNK; mo.rlist = (const int*)(ws + WS_RLIST);
                if (PHON(10) && IN(pu)) { mo.so.init(nP, 2 * DFFE / 256, F.G, (int)blockIdx.x); mo.GATHER_A = true; mo.bstride = (size_t)2 * DFFE * 1024 * 2;
                    pg8::Gemm g{H, (const bf16_t*)(ws + WS_BIG + BIG_MW13), 1024, 1024}; EpiSwiglu E{BIG, DFFE}; pg8::gemm_phase<EpiSwiglu, MoeOrder, true, true>(ring, g, mo, E, F.wave0); }
                SEAM(pu);
                if (PHON(11) && IN(pd)) { mo.so.init(nP, 4, F.G, (int)blockIdx.x); mo.GATHER_A = false; mo.bstride = (size_t)1024 * DFFE * 2;
                    pg8::Gemm g{BIG, (const bf16_t*)(ws + WS_BIG + BIG_MW2), DFFE, DFFE}; EpiMoeDown E{mo, (bf16_t*)(ws + WS_Y), (const float*)(ws + WS_GATE)}; pg8::gemm_phase<EpiMoeDown, MoeOrder, true, false>(ring, g, mo, E, F.wave0); }
            }
            SEAM(pd);
        }
template <int lp> __device__ __forceinline__ void layer_pair(Frame& F, const Args& A, const int lo, const int hi, const XcdBarrier& bar, LAS unsigned char* ring) {
        const int pb = 1 + lp * 19, i0 = 2 * lp, i1 = 2 * lp + 1;
        if (PHON(1) && IN(pb + 0)) norm_phase(F, A, i0, 0, lp == 0 ? 1 : 2);
        SEAM(pb + 0);
        if (PHON(2) && IN(pb + 1)) { SITE_PTRS pg8::Gemm g{H, (const bf16_t*)(wss + W_WIN), 1024, 1024}; pg8::StaticOrder S; S.init(NPAN, NXBC / 256, F.G, (int)blockIdx.x);
            EpiXbc E{BIG, (float*)(ws + WS_DT)}; pg8::gemm_phase<EpiXbc, pg8::StaticOrder, true, false>(ring, g, S, E, F.wave0); }
        SEAM(pb + 1);
        if (PHON(3) && IN(pb + 2)) scan_phase(F, A, lp);
        SEAM(pb + 2);
        if (PHON(4) && IN(pb + 3)) { SITE_PTRS pg8::Gemm g{H, (const bf16_t*)(wss + W_WZ), 1024, 1024}; pg8::StaticOrder S; S.init(NPAN, DIN / 256, F.G, (int)blockIdx.x);
            EpiGate E{(const bf16_t*)(ws + WS_Y), BIG, A.ssd_norm_w + (size_t)lp * DIN, (LAS float*)(F.lds + PSCR_OFF)}; pg8::gemm_phase<EpiGate, pg8::StaticOrder, true, false>(ring, g, S, E, F.wave0); }
        SEAM(pb + 3);
        if (PHON(5) && IN(pb + 4)) { SITE_PTRS pg8::Gemm g{BIG, (const bf16_t*)(wss + W_WOUT), DIN, DIN}; pg8::StaticOrder S; S.init(NPAN, 4, F.G, (int)blockIdx.x);
            EpiResid E{ws, F.out, MODV + (size_t)i0 * 17 * 6144, 2, nullptr}; pg8::gemm_phase<EpiResid, pg8::StaticOrder, true, false>(ring, g, S, E, F.wave0); }
        SEAM(pb + 4);
        if (PHON(1) && IN(pb + 5)) norm_phase(F, A, i0, 1, 0);
        SEAM(pb + 5);
        if (PHON(6) && IN(pb + 6)) { SITE_PTRS pg8::Gemm g{H, (const bf16_t*)(wss + W_WUP), 1024, 1024}; pg8::StaticOrder S; S.init(NPAN, 2 * DFF / 256, F.G, (int)blockIdx.x);
            EpiSwiglu E{BIG, DFF}; pg8::gemm_phase<EpiSwiglu, pg8::StaticOrder, true, false>(ring, g, S, E, F.wave0); }
        SEAM(pb + 6);
        if (PHON(5) && IN(pb + 7)) { SITE_PTRS pg8::Gemm g{BIG, (const bf16_t*)(wss + W_WDN), DFF, DFF}; pg8::StaticOrder S; S.init(NPAN, 4, F.G, (int)blockIdx.x);
            EpiResid E{ws, F.out, MODV + (size_t)i0 * 17 * 6144, 5, nullptr}; pg8::gemm_phase<EpiResid, pg8::StaticOrder, true, false>(ring, g, S, E, F.wave0); }
        SEAM(pb + 7);
        if (PHON(1) && IN(pb + 8)) norm_phase(F, A, i1, 0, 0);
        SEAM(pb + 8);
        if (PHON(7) && IN(pb + 9)) { SITE_PTRS pg8::Gemm g{H, (const bf16_t*)(wsa + W_WQKV), 1024, 1024}; pg8::StaticOrder S; S.init(NPAN, NQKV / 256, F.G, (int)blockIdx.x);
            EpiQkv E{BIG, (bf16_t*)(ws + WS_BIG + BIG_K), (bf16_t*)(ws + WS_BIG + BIG_V), A.attn_b_qkv + (size_t)lp * NQKV, (const float*)(ws + WS_ROPE)};
            pg8::gemm_phase<EpiQkv, pg8::StaticOrder, true, false>(ring, g, S, E, F.wave0); }
        SEAM(pb + 9);
        if (PHON(8) && IN(pb + 10)) attn_phase(F, A, lp, lp == 0);
        SEAM(pb + 10);
        if (PHON(5) && IN(pb + 11)) { SITE_PTRS pg8::Gemm g{BIG, (const bf16_t*)(wsa + W_WO), 1024, 1024}; pg8::StaticOrder S; S.init(NPAN, 4, F.G, (int)blockIdx.x);
            EpiResid E{ws, F.out, MODV + (size_t)i1 * 17 * 6144, 2, A.attn_b_o + (size_t)lp * 1024}; pg8::gemm_phase<EpiResid, pg8::StaticOrder, true, false>(ring, g, S, E, F.wave0); }
        SEAM(pb + 11);
        if (PHON(9) && IN(pb + 12)) { norm_phase(F, A, i1, 1, 4 | (lp == 1 ? 16 : 0)); __syncthreads(); moe_convert(F, A, lp); }
        SEAM(pb + 12);
    moe_chunk<lp, 0>(F, A, lo, hi, bar, ring); moe_chunk<lp, 1>(F, A, lo, hi, bar, ring); moe_chunk<lp, 2>(F, A, lo, hi, bar, ring);
}
constexpr int N_PHASES = 40;
__global__ void __launch_bounds__(NWAVES * 64, 2) fwd_kernel(Args A) {
    extern __shared__ __attribute__((aligned(16))) unsigned char lds_raw[];
    Frame F;
    F.lds = (LAS unsigned char*)lds_raw;
    F.tid = threadIdx.x; F.lane = F.tid & 63; F.wave = __builtin_amdgcn_readfirstlane(F.tid >> 6); F.wave0 = F.wave; F.G = gridDim.x;
    F.ws0 = A.ws; F.out0 = A.out; F.ws = A.ws; F.ctl = (gu32*)(A.ws + WS_CTL); F.out = A.out;
    volatile LAS unsigned* MISC = (volatile LAS unsigned*)(F.lds + MISC_OFF);
    for (int u = F.tid; u < (LDS_BYTES - LDSCTL_OFF) / 4; u += NWAVES * 64) ((LAS unsigned*)(F.lds + LDSCTL_OFF))[u] = 0u;
    __syncthreads();
    const int lo = A.ph_lo, hi = A.ph_hi;
    XcdBarrier bar; bar.bar = (unsigned*)(F.ctl + CW_BAR); bar.x = 0; bar.st = MISC + 8; bar.wave0 = F.wave0;
    if (hi - lo > 1) bar = xcd_barrier_post((unsigned*)(F.ctl + CW_BAR), MISC + 8, F.wave0);
    LAS unsigned char* ring = F.lds;

    if (PHON(0) && IN(0)) p0_prologue(F, A);
    SEAM(0);
    layer_pair<0>(F, A, lo, hi, bar, ring);
    layer_pair<1>(F, A, lo, hi, bar, ring);
    if (PHON(1) && IN(39)) {
        norm_phase(F, A, 4, 0, 2 | 8);
        if (xb_ld((unsigned*)(F.ctl + CW_BAR) + XB_TMO) != 0u) {
            const float qn = __builtin_nanf("");
            for (size_t idx = (size_t)blockIdx.x * 512 + F.tid; idx < (size_t)NB * SEQ * DM / 4; idx += (size_t)F.G * 512) ((f32x4*)A.out)[idx] = (f32x4){qn, qn, qn, qn};
        }
    }
#undef IN
#undef SEAM
}

extern "C" void kernel_launch(void* const* d_in, const int* in_sizes, int n_in, void* d_out, int out_size, void* d_ws, size_t ws_size, hipStream_t stream) {
    static int grid = 0;
    if (grid == 0) {
        if (n_in != 29 || in_sizes[0] != NB * SEQ * DM || out_size != NB * SEQ * DM || ws_size < WS_END) {
            fprintf(stderr, "kernel_launch: unexpected problem: n_in %d, in0 %d, out %d, ws %zu (need %zu); nothing launched\n", n_in, n_in > 0 ? in_sizes[0] : -1, out_size, ws_size, (size_t)WS_END); grid = -1; return; }
        int dev = 0, cus = 0, per_cu = 0;
        if (hipGetDevice(&dev) != hipSuccess || hipDeviceGetAttribute(&cus, hipDeviceAttributeMultiprocessorCount, dev) != hipSuccess) { fprintf(stderr, "kernel_launch: device query failed\n"); grid = -1; return; }
        if (hipFuncSetAttribute((const void*)fwd_kernel, hipFuncAttributeMaxDynamicSharedMemorySize, LDS_BYTES) != hipSuccess) { fprintf(stderr, "kernel_launch: hipFuncSetAttribute failed\n"); grid = -1; return; }
        if (hipOccupancyMaxActiveBlocksPerMultiprocessor(&per_cu, (const void*)fwd_kernel, NWAVES * 64, LDS_BYTES) != hipSuccess || per_cu < 1)
            fprintf(stderr, "kernel_launch: note: occupancy query reports %d workgroups per CU\n", per_cu);
        (void)hipGetLastError();
        grid = cus;
    }
    if (grid < 0) return;
    if (hipMemsetAsync((char*)d_ws + WS_CTL, 0, CTL_ZERO_BYTES, stream) != hipSuccess) { fprintf(stderr, "kernel_launch: memset failed\n"); return; }
    Args a{};
    const float** ap = (const float**)&a;
    for (int i = 0; i < 29; ++i) ap[i] = (const float*)d_in[i];
    a.out = (float*)d_out; a.ws = (unsigned char*)d_ws;
#if MK_PER_PHASE
    for (int k = 0; k < N_PHASES; ++k) { a.ph_lo = k; a.ph_hi = k + 1; hipLaunchKernelGGL(fwd_kernel, dim3(grid), dim3(NWAVES * 64), LDS_BYTES, stream, a); }
#else
    a.ph_lo = 0; a.ph_hi = N_PHASES;
    hipLaunchKernelGGL(fwd_kernel, dim3(grid), dim3(NWAVES * 64), LDS_BYTES, stream, a);
#endif
    const hipError_t le = hipPeekAtLastError();
    if (le != hipSuccess) fprintf(stderr, "kernel_launch: launch failed: %s\n", hipGetErrorName(le));
}
```

```cpp
#include <hip/hip_runtime.h>
#include <cstdio>
#include <cstdint>

#define LAS __attribute__((address_space(3)))
#define GAS __attribute__((address_space(1)))
typedef unsigned short bf16_t;
typedef short bf16x8 __attribute__((ext_vector_type(8)));
typedef short s16x4 __attribute__((ext_vector_type(4)));
typedef float f32x4 __attribute__((ext_vector_type(4)));
typedef float f32x2 __attribute__((ext_vector_type(2)));
typedef float f32x16 __attribute__((ext_vector_type(16)));
typedef unsigned u32x4 __attribute__((ext_vector_type(4)));
typedef unsigned u32x2 __attribute__((ext_vector_type(2)));
typedef GAS unsigned gu32;

namespace pg8 {
constexpr int BM = 256, BK = 64, HALF = 128, HTB = HALF * BK * 2  , STAGE_BYTES = 8 * HTB, NXCD = 8, WGM = 8;

__host__ __device__ __forceinline__ int lds_byte(int r, int c) { const int st = (r >> 4) * 2 + (c >> 5), rr = r & 15, cc = c & 31, ob = rr * 64 + cc * 2; return st * 1024 + (ob ^ (((ob >> 9) & 1) << 5)); }
__host__ __device__ __forceinline__ void stage_rc(int b, int& R, int& C) { const int st = b / 1024, sb = b % 1024, swz = sb ^ (((sb >> 9) & 1) << 5); R = (st >> 1) * 16 + swz / 64; C = (st & 1) * 32 + (swz % 64) / 2; }
__host__ __device__ __forceinline__ int perm32(int rho) { const int n = rho >> 4, i = rho & 15; return 8 * (i >> 2) + 4 * n + (i & 3); }

struct Unit { int pm, pn; };
struct Gemm { const bf16_t* A; const bf16_t* Bt; int lda, K; };

struct StaticOrder {
    int nM, nN, nwg, G, c;
    __device__ void init(int nM_, int nN_, int G_, int c_) { nM = nM_; nN = nN_; nwg = nM * nN; G = G_; c = c_; }
    __device__ bool next(int i, Unit& u) const {
        const long L = (long)i * G + c; if (L >= nwg) return false;
        int wgid = (int)L; { const int q = nwg / NXCD, r = nwg % NXCD, xcd = wgid % NXCD, off = wgid / NXCD; wgid = (xcd < r ? xcd * (q + 1) : r * (q + 1) + (xcd - r) * q) + off; }
        const int nig = WGM * nN, gid = wgid / nig, fm = gid * WGM, gsz = (nM - fm) < WGM ? (nM - fm) : WGM;
        u.pm = fm + ((wgid % nig) % gsz); u.pn = (wgid % nig) / gsz; return true;
    }
    __device__ __forceinline__ const char* a_base(const Gemm& g, const Unit& u) const { return (const char*)g.A + (size_t)u.pm * (size_t)(BM * 2) * g.lda; }
    __device__ __forceinline__ const char* b_base(const Gemm& g, const Unit& u) const { return (const char*)g.Bt + (size_t)u.pn * (size_t)(BM * 2) * g.K; }
    __device__ __forceinline__ unsigned row_off(const Gemm& g, const Unit&, int r) const { return (unsigned)r * (unsigned)g.lda * 2u; }
};

__device__ __forceinline__ unsigned cvt_pk_bf16(float lo, float hi) { unsigned r; asm volatile("v_cvt_pk_bf16_f32 %0, %1, %2" : "=v"(r) : "v"(lo), "v"(hi)); return r; }

template <class Epi, class Sched, bool ALIGN_EPI, bool GATHER>
__device__ __forceinline__ void gemm_phase(LAS unsigned char* lds, const Gemm g, const Sched& S, const Epi& E, const int wave0) {
    int tid_ = wave0 * 64 + (int)__builtin_amdgcn_mbcnt_hi(~0u, __builtin_amdgcn_mbcnt_lo(~0u, 0u)); asm volatile("" : "+v"(tid_));
    const int tid = tid_, wid = __builtin_amdgcn_readfirstlane(tid >> 6), lane = tid & 63, wr = wid >> 2, wc = wid & 3, fr = lane & 15, fq = lane >> 4;
    const int K = g.K, nt = K / BK;
    unsigned voffB[2];
#pragma unroll
    for (int i = 0; i < 2; ++i) { int R, C; stage_rc(tid * 16 + i * 8192, R, C); const int Rb = Epi::PERM ? ((R & ~31) + perm32(R & 31)) : R; voffB[i] = (unsigned)(Rb * K + C) * 2u; }
    const size_t kstep = (size_t)(BK * 2);
    const size_t hstepB = (size_t)HALF * K * 2;
    const unsigned ldsw = (unsigned)wid * 1024u;
    const int aoff = lds_byte(wr * 64 + fr, fq * 8), boff = lds_byte(wc * 32 + fr, fq * 8);
#define PG8_SA(b, h) (((b) * 2 + (h)) * HTB)
#define PG8_SB(b, h) ((4 + (b) * 2 + (h)) * HTB)
#define PG8_STAGE(bufoff, gbase, voff) do { _Pragma("unroll") for (int _i = 0; _i < 2; ++_i) \
        __builtin_amdgcn_global_load_lds((const unsigned*)((const char*)(gbase) + (voff)[_i]), (LAS unsigned*)(lds + (bufoff) + ldsw + _i * 8192), 16, 0, 0); } while (0)
#define PG8_LDA(dst, b, h) do { _Pragma("unroll") for (int m = 0; m < 4; ++m) _Pragma("unroll") for (int k = 0; k < 2; ++k) dst[m][k] = *(const LAS bf16x8*)(lds + PG8_SA(b, h) + aoff + m * 2048 + k * 1024); } while (0)
#define PG8_LDB(dst, b, h) do { _Pragma("unroll") for (int n = 0; n < 2; ++n) _Pragma("unroll") for (int k = 0; k < 2; ++k) dst[n][k] = *(const LAS bf16x8*)(lds + PG8_SB(b, h) + boff + n * 2048 + k * 1024); } while (0)
#define PG8_MMA(ai, bj, At, Bt) do { __builtin_amdgcn_s_setprio(1); _Pragma("unroll") for (int m = 0; m < 4; ++m) _Pragma("unroll") for (int n = 0; n < 2; ++n) _Pragma("unroll") for (int k = 0; k < 2; ++k) \
        acc[ai][bj][m][n] = __builtin_amdgcn_mfma_f32_16x16x32_bf16(Bt[n][k], At[m][k], acc[ai][bj][m][n], 0, 0, 0); __builtin_amdgcn_s_setprio(0); } while (0)
#define PG8_WAIT_V(n) asm volatile("s_waitcnt vmcnt(" #n ")" ::: "memory")
#define PG8_WAIT_L(n) asm volatile("s_waitcnt lgkmcnt(" #n ")" ::: "memory")
#define PG8_BAR __builtin_amdgcn_s_barrier()
#define PG8_SCHED __builtin_amdgcn_sched_barrier(0)
    Unit cur, nxt; int ui = 0;
    if (!S.next(0, cur)) return;
    f32x4 acc[2][2][4][2];
#pragma unroll
    for (int a = 0; a < 2; ++a)
#pragma unroll
        for (int b = 0; b < 2; ++b)
#pragma unroll
            for (int m = 0; m < 4; ++m)
#pragma unroll
                for (int n = 0; n < 2; ++n) acc[a][b][m][n] = (f32x4){0.f, 0.f, 0.f, 0.f};
    bf16x8 At[4][2], B0[2][2], B1[2][2];
    const char* cA = S.a_base(g, cur); const char* cB = S.b_base(g, cur);
    unsigned va[2][2], vn[2][2];
#pragma unroll
    for (int h = 0; h < 2; ++h)
#pragma unroll
        for (int i = 0; i < 2; ++i) { int R, C; stage_rc(tid * 16 + i * 8192, R, C); va[h][i] = S.row_off(g, cur, h * HALF + R) + (unsigned)C * 2u; vn[h][i] = va[h][i]; }
    PG8_STAGE(PG8_SB(0, 0), cB, voffB); PG8_STAGE(PG8_SB(0, 1), cB + hstepB, voffB); PG8_STAGE(PG8_SA(0, 0), cA, va[0]); PG8_STAGE(PG8_SA(0, 1), cA, va[1]);
    if (wr == 1) PG8_BAR;
    PG8_WAIT_V(2); PG8_BAR;
    PG8_STAGE(PG8_SB(1, 0), cB + kstep, voffB); PG8_STAGE(PG8_SA(1, 0), cA + kstep, va[0]); PG8_STAGE(PG8_SB(1, 1), cB + hstepB + kstep, voffB);
    PG8_WAIT_V(6); PG8_BAR;
    for (;;) {
        const bool has_next = S.next(ui + 1, nxt);
        const char* nA = has_next ? S.a_base(g, nxt) : cA; const char* nB = has_next ? S.b_base(g, nxt) : cB;
        if (GATHER) {
            if (has_next) {
#pragma unroll
                for (int h = 0; h < 2; ++h)
#pragma unroll
                    for (int i = 0; i < 2; ++i) { int R, C; stage_rc(tid * 16 + i * 8192, R, C); vn[h][i] = S.row_off(g, nxt, h * HALF + R) + (unsigned)C * 2u; }
            } else {
#pragma unroll
                for (int h = 0; h < 2; ++h)
#pragma unroll
                    for (int i = 0; i < 2; ++i) vn[h][i] = va[h][i];
            }
        }
        for (int t = 0; t < nt; t += 2) {
            const bool last = (t == nt - 2);
            const char* a1 = cA + (size_t)(t + 1) * kstep;
            const char* a2 = last ? nA : cA + (size_t)(t + 2) * kstep; const char* b2 = last ? nB : cB + (size_t)(t + 2) * kstep;
            const char* a3 = a2 + kstep; const char* b3 = b2 + kstep;
            unsigned v2[2][2];
#pragma unroll
            for (int h = 0; h < 2; ++h)
#pragma unroll
                for (int i = 0; i < 2; ++i) v2[h][i] = (GATHER && last) ? vn[h][i] : va[h][i];
            PG8_LDB(B0, 0, 0); PG8_LDB(B1, 0, 1); PG8_SCHED; PG8_LDA(At, 0, 0); PG8_STAGE(PG8_SA(1, 1), a1, va[1]);
            PG8_WAIT_V(8); PG8_WAIT_L(0); PG8_BAR; PG8_MMA(0, 0, At, B0); PG8_MMA(0, 1, At, B1); PG8_BAR; PG8_SCHED;
            PG8_LDA(At, 0, 1); PG8_STAGE(PG8_SB(0, 0), b2, voffB); PG8_STAGE(PG8_SB(0, 1), b2 + hstepB, voffB); PG8_STAGE(PG8_SA(0, 0), a2, v2[0]);
            PG8_WAIT_V(8); PG8_WAIT_L(0); PG8_BAR; PG8_MMA(1, 0, At, B0); PG8_MMA(1, 1, At, B1); PG8_BAR; PG8_SCHED;
            PG8_LDB(B0, 1, 0); PG8_LDB(B1, 1, 1); PG8_SCHED; PG8_LDA(At, 1, 0); PG8_STAGE(PG8_SA(0, 1), a2, v2[1]);
            PG8_WAIT_V(8); PG8_WAIT_L(0); PG8_BAR; PG8_MMA(0, 0, At, B0); PG8_MMA(0, 1, At, B1); PG8_BAR; PG8_SCHED;
            PG8_LDA(At, 1, 1); PG8_STAGE(PG8_SB(1, 0), b3, voffB); PG8_STAGE(PG8_SB(1, 1), b3 + hstepB, voffB); PG8_STAGE(PG8_SA(1, 0), a3, v2[0]);
            PG8_WAIT_V(8); PG8_WAIT_L(0); PG8_BAR; PG8_MMA(1, 0, At, B0); PG8_MMA(1, 1, At, B1); PG8_BAR; PG8_SCHED;
        }
        if constexpr (ALIGN_EPI) { if (wr == 0) PG8_BAR; }
        { int l2 = (int)__builtin_amdgcn_mbcnt_hi(~0u, __builtin_amdgcn_mbcnt_lo(~0u, 0u)); asm volatile("" : "+v"(l2)); E(acc, cur, wr, wc, l2 & 15, l2 >> 4); }
        if (!has_next) break;
#pragma unroll
        for (int a = 0; a < 2; ++a)
#pragma unroll
            for (int b = 0; b < 2; ++b)
#pragma unroll
                for (int m = 0; m < 4; ++m)
#pragma unroll
                    for (int n = 0; n < 2; ++n) acc[a][b][m][n] = (f32x4){0.f, 0.f, 0.f, 0.f};
        cur = nxt; cA = nA; cB = nB; ++ui;
        if (GATHER) {
#pragma unroll
            for (int h = 0; h < 2; ++h)
#pragma unroll
                for (int i = 0; i < 2; ++i) va[h][i] = vn[h][i];
        }
        if constexpr (ALIGN_EPI) { if (wr == 1) PG8_BAR; }
    }
    PG8_WAIT_V(0);
    if constexpr (!ALIGN_EPI) { if (wr == 0) PG8_BAR; }
    PG8_BAR;
#undef PG8_SA
#undef PG8_SB
#undef PG8_STAGE
#undef PG8_LDA
#undef PG8_LDB
#undef PG8_MMA
#undef PG8_WAIT_V
#undef PG8_WAIT_L
#undef PG8_BAR
#undef PG8_SCHED
}
}

constexpr int DM = 1024, NB = 16, SEQ = 4096, NCTX = 256, SROW = SEQ + NCTX  , MROWS = NB * SROW  , NPAN = MROWS / 256  ;
constexpr int DIN = 2048, CONVCH = 4096, SSD_IN = 6208, NXBC = 4352  ;
constexpr int QW = 1024, KVW = 256, NQKV = 1536;
constexpr int DFF = 2816, NEXP = 8, DFFE = 3584;
constexpr float EPS = 1e-6f;
constexpr int MOE_CHUNK = 184;
constexpr int NWAVES = 8;

constexpr size_t MiB = 1u << 20;
constexpr size_t WS_CTL = 0, CTL_ZERO_BYTES = 1 * MiB;
constexpr size_t WS_MODV = 2 * MiB;
constexpr size_t WS_ROPE = 4 * MiB;
constexpr size_t WS_GATE = 5 * MiB;
constexpr size_t WS_RLIST = 6 * MiB;
constexpr size_t WS_CX = 10 * MiB;
constexpr size_t WS_W = 26 * MiB;
constexpr size_t W_SSD_STRIDE = 33 * MiB, W_WZ = 0, W_WIN = 4 * MiB, W_WOUT = 12 * MiB + MiB / 2, W_WUP = 16 * MiB + MiB / 2, W_WDN = 27 * MiB + MiB / 2;
constexpr size_t W_ATT0 = 66 * MiB, W_ATT_STRIDE = 5 * MiB, W_WQKV = 0, W_WO = 3 * MiB;
constexpr size_t WS_H = 102 * MiB;
constexpr size_t WS_BIG = 238 * MiB;
constexpr size_t BIG_K = 136 * MiB, BIG_V = 170 * MiB, BIG_O = 204 * MiB, BIG_MW13 = 322 * MiB, BIG_MW2 = 434 * MiB;
constexpr size_t WS_Y = 782 * MiB;
constexpr size_t WS_DT = 1054 * MiB;
constexpr size_t WS_END = 1071 * MiB;
constexpr int CW_BAR = 4096;
constexpr int CW_CNT = 16384;

constexpr int RING_BYTES = 131072;
constexpr int PSCR_OFF = 131072;
constexpr int LDSCTL_OFF = 151552, MISC_OFF = LDSCTL_OFF + 320;
constexpr int LDS_BYTES = 155648;

#define RLX_AGENT __ATOMIC_RELAXED, __HIP_MEMORY_SCOPE_AGENT
#define LDS_WAIT() asm volatile("s_waitcnt lgkmcnt(0)" ::: "memory")
#define VM_WAIT() asm volatile("s_waitcnt vmcnt(0)" ::: "memory")
__device__ __forceinline__ unsigned f2bf(float f) { unsigned u = __builtin_bit_cast(unsigned, f); return (u + 0x7fffu + ((u >> 16) & 1u)) >> 16; }
__device__ __forceinline__ unsigned pk2(float lo, float hi) { return f2bf(lo) | (f2bf(hi) << 16); }
__device__ __forceinline__ float bf_lo(unsigned u) { return __builtin_bit_cast(float, u << 16); }
__device__ __forceinline__ float bf_hi(unsigned u) { return __builtin_bit_cast(float, u & 0xffff0000u); }
__device__ __forceinline__ float bf1(bf16_t h) { return __builtin_bit_cast(float, (unsigned)h << 16); }
__device__ __forceinline__ float siluf(float v) { return v * __builtin_amdgcn_rcpf(1.0f + __expf(-v)); }
__device__ __forceinline__ float shx(float v, int mask, int lane) { return __builtin_bit_cast(float, __builtin_amdgcn_ds_bpermute((lane ^ mask) << 2, __builtin_bit_cast(int, v))); }
__device__ __forceinline__ float wave_sum(float v, int lane) {
#pragma unroll
    for (int o = 1; o < 64; o <<= 1) v += shx(v, o, lane);
    return v;
}

__device__ __forceinline__ int lane_id() { return (int)__builtin_amdgcn_mbcnt_hi(~0u, __builtin_amdgcn_mbcnt_lo(~0u, 0u)); }
#define XB_TMO      128
#define XB_XCNT(j)  (256  + 64 * (j))
#define XB_XSUB(j)  (1280 + 64 * (j))
#define XB_XGEN(j)  (2304 + 64 * (j))
#define XB_TOP      3328
#define XB_TOPGEN   3392
#define XCD_BAR_WORDS 3456
#define XB_SPIN_CAP (1u << 18)

__device__ __forceinline__ unsigned xb_ld(unsigned* p)              { return __hip_atomic_load(p, __ATOMIC_RELAXED, __HIP_MEMORY_SCOPE_AGENT); }
__device__ __forceinline__ unsigned xb_add(unsigned* p, unsigned v) { return __hip_atomic_fetch_add(p, v, __ATOMIC_RELAXED, __HIP_MEMORY_SCOPE_AGENT); }
__device__ __forceinline__ unsigned xb_xcc_id() { return (unsigned)__builtin_amdgcn_s_getreg((3 << 11) | 20) & 0xFu; }
#define XB_SPIN(cond, bar) do { unsigned _sp = 0; while (cond) { __builtin_amdgcn_s_sleep(1); \
    if ((++_sp & 255u) == 0u) { if (xb_ld(&(bar)[XB_TMO])) break; if (_sp > XB_SPIN_CAP) { atomicAdd(&(bar)[XB_TMO], 1u); break; } } } } while (0)

struct XcdBarrier {
    unsigned* bar; unsigned x;
    volatile LAS unsigned* st;
    int wave0;
};
__device__ __forceinline__ XcdBarrier xcd_barrier_post(unsigned* bar, volatile LAS unsigned* st, int wave0) {
    XcdBarrier b; b.bar = bar; b.x = xb_xcc_id(); b.st = st; b.wave0 = wave0;
    if (wave0 == 0 && lane_id() == 0) (void)xb_add(&bar[XB_XCNT(b.x)], 1u);
    return b;
}
__device__ __forceinline__ void xcd_barrier_complete(unsigned* bar, unsigned x, unsigned& nloc, unsigned& nx) {
    const unsigned G = gridDim.x * gridDim.y * gridDim.z;
    unsigned sum, cnt, mine, sp = 0u;
    for (;;) {
        sum = 0u; cnt = 0u; mine = 0u;
#pragma unroll
        for (unsigned j = 0; j < 16; ++j) { const unsigned c = xb_ld(&bar[XB_XCNT(j)]); sum += c; cnt += (c > 0u) ? 1u : 0u; mine = (j == x) ? c : mine; }
        if (sum == G) break;
        __builtin_amdgcn_s_sleep(1);
        if ((++sp & 255u) == 0u) { if (xb_ld(&bar[XB_TMO])) break; if (sp > XB_SPIN_CAP) { atomicAdd(&bar[XB_TMO], 1u); break; } }
    }
    nloc = mine > 0u ? mine : 1u; nx = cnt > 0u ? cnt : 1u;
}
__device__ __forceinline__ void xcd_barrier(const XcdBarrier& b) {
    asm volatile("s_waitcnt vmcnt(0)" ::: "memory");
    __syncthreads();
    if (b.wave0 == 0 && lane_id() == 0) {
        unsigned* bar = b.bar;
        __builtin_amdgcn_s_waitcnt(0);
        unsigned nloc = b.st[0], nx = b.st[1];
        if (nloc == 0u) { xcd_barrier_complete(bar, b.x, nloc, nx); b.st[0] = nloc; b.st[1] = nx; }
        const unsigned old = xb_add(&bar[XB_XSUB(b.x)], 1u);
        const unsigned gen = old / nloc;
        if (old + 1u == (gen + 1u) * nloc) {
            __builtin_amdgcn_fence(__ATOMIC_RELEASE, "agent");
            asm volatile("s_waitcnt vmcnt(0)" ::: "memory");
            const unsigned og = xb_add(&bar[XB_TOP], 1u);
            const unsigned tg = og / nx;
            if (og + 1u == (tg + 1u) * nx) xb_add(&bar[XB_TOPGEN], 1u);
            else XB_SPIN(xb_ld(&bar[XB_TOPGEN]) == tg, bar);
            __builtin_amdgcn_fence(__ATOMIC_ACQUIRE, "agent");
            xb_add(&bar[XB_XGEN(b.x)], 1u);
            asm volatile("s_waitcnt vmcnt(0)" ::: "memory");
        } else {
            XB_SPIN(xb_ld(&bar[XB_XGEN(b.x)]) == gen, bar);
            __builtin_amdgcn_fence(__ATOMIC_ACQUIRE, "agent");
            asm volatile("s_waitcnt vmcnt(0)" ::: "memory");
        }
    }
    __syncthreads();
}

struct Args {
    const float *x, *c, *ctx, *c_ctx, *w_mod, *b_mod, *norm1_w, *norm2_w, *ssd_w_in, *ssd_conv_w, *ssd_conv_b, *ssd_dt_bias, *ssd_a_log, *ssd_d, *ssd_norm_w, *ssd_w_out,
                *attn_w_qkv, *attn_b_qkv, *attn_sink, *attn_w_o, *attn_b_o, *ffn_w1, *ffn_w3, *ffn_w2, *moe_router, *moe_w1, *moe_w3, *moe_w2, *final_norm_w;
    float* out; unsigned char* ws; int ph_lo, ph_hi;
};
struct Frame {
    LAS unsigned char* lds;
    int tid, lane, wave, G;
    unsigned char* ws; gu32* ctl; float* out;
    unsigned char* ws0; float* out0; int wave0;
};
__device__ __forceinline__ void phase_enter(Frame& F) { int l = lane_id(); asm volatile("" : "+v"(l)); F.lane = l; F.wave = F.wave0; F.tid = F.wave0 * 64 + l;
    unsigned char* w = F.ws0; float* o = F.out0; asm volatile("" : "+s"(w), "+s"(o)); F.ws = w; F.ctl = (gu32*)(w + WS_CTL); F.out = o; }
__device__ __forceinline__ float* resid_row(const Frame& F, int R) {
    const int b = R / SROW, s = R - b * SROW;
    return s < NCTX ? (float*)(F.ws + WS_CX) + (size_t)(b * NCTX + s) * DM : F.out + (size_t)(b * SEQ + s - NCTX) * DM;
}
__device__ __forceinline__ float* resid_panel(const Frame& F, int pm, int& cond) {
    const int b = pm / 17, j = pm - b * 17; cond = j == 0 ? 16 : b;
    return j == 0 ? (float*)(F.ws + WS_CX) + (size_t)(b * NCTX) * DM : F.out + (size_t)(b * SEQ + (j - 1) * 256) * DM;
}

__device__ __forceinline__ void transpose_item(const float* W, int ldw, int col0, int ncb, int K, bf16_t* WT, int mode, int half, LAS float* scr, int item, int lane) {
    const int kb = item / ncb, nb = item - kb * ncb, k0 = 64 * kb, n0 = 32 * nb;
#pragma unroll 8
    for (int i = 0; i < 32; ++i) { const int kk = 2 * i + (lane >> 5); scr[kk * 33 + (lane & 31)] = W[(size_t)(k0 + kk) * ldw + col0 + n0 + (lane & 31)]; }
    LDS_WAIT(); asm volatile("" ::: "memory");
    const int c = lane & 7;
#pragma unroll
    for (int j = 0; j < 4; ++j) { const int n = (lane >> 3) + 8 * j; const LAS float* s = scr + (8 * c) * 33 + n;
        u32x4 o; o.x = pk2(s[0 * 33], s[1 * 33]); o.y = pk2(s[2 * 33], s[3 * 33]); o.z = pk2(s[4 * 33], s[5 * 33]); o.w = pk2(s[6 * 33], s[7 * 33]);
        const int cl = n0 + n; const int drow = mode == 0 ? cl : ((cl >> 7) * 256 + half * 128 + (cl & 127));
        *(GAS u32x4*)(WT + (size_t)drow * K + k0 + 8 * c) = o; }
    LDS_WAIT(); asm volatile("" ::: "memory");
}
__device__ __forceinline__ void p0_prologue(Frame& F, const Args& A) {
    phase_enter(F);
    {
        LAS float* sc = (LAS float*)F.lds;
        LAS float* red = (LAS float*)(F.lds + 81920);
        for (int idx = F.tid; idx < 17 * 1024; idx += 512) { const int cb = idx >> 10, k = idx & 1023; const float v = cb < 16 ? A.c[cb * 1024 + k] : A.c_ctx[k]; sc[k * 20 + cb] = v / (1.0f + expf(-v)); }
        __syncthreads();
        float* MODV = (float*)(F.ws + WS_MODV);
        for (int item = blockIdx.x; item < 4 * 96; item += F.G) {
            const int i = item / 96, cblk = item - i * 96;
            const float* Wm = A.w_mod + (size_t)i * 1024 * 6144 + cblk * 64 + F.lane;
            float acc[17];
#pragma unroll
            for (int cb = 0; cb < 17; ++cb) acc[cb] = 0.f;
            const int k0 = F.wave * 128;
#pragma unroll 4
            for (int kk = 0; kk < 128; ++kk) { const int k = k0 + kk; const float w = Wm[(size_t)k * 6144]; const LAS float* s = sc + k * 20;
#pragma unroll
                for (int cb = 0; cb < 17; ++cb) acc[cb] += s[cb] * w; }
#pragma unroll
            for (int cb = 0; cb < 17; ++cb) red[(F.wave * 17 + cb) * 64 + F.lane] = acc[cb];
            __syncthreads();
            for (int idx = F.tid; idx < 17 * 64; idx += 512) { const int cb = idx >> 6, l = idx & 63; float s = 0.f;
#pragma unroll
                for (int w = 0; w < 8; ++w) s += red[(w * 17 + cb) * 64 + l];
                MODV[(size_t)(i * 17 + cb) * 6144 + cblk * 64 + l] = s + A.b_mod[i * 6144 + cblk * 64 + l]; }
            __syncthreads();
        }
    }
    if (blockIdx.x == 0) { float* RT = (float*)(F.ws + WS_ROPE);
        for (int idx = F.tid; idx < 1024; idx += 512) { const int id = idx >> 4, f = idx & 15; const float inv = __builtin_amdgcn_exp2f(-(float)f * (13.287712379549449f / 16.0f)); const float ang = (float)id * inv;
            RT[idx] = __cosf(ang); RT[1024 + idx] = __sinf(ang); } }
    __syncthreads();
    {
        LAS float* scr = (LAS float*)(F.lds + F.wave * 16384);
        const int gw = blockIdx.x * NWAVES + F.wave, NGW = F.G * NWAVES;
        constexpr int I1 = 16 * 64, I2 = 16 * 130, I3 = 32 * 32, I4 = 16 * 88, I5 = 16 * 88, I6 = 44 * 32, I7 = 16 * 48, I8 = 16 * 32, IPER = I1 + I2 + I3 + I4 + I5 + I6 + I7 + I8;
        for (int it = gw; it < 2 * IPER; it += NGW) {
            const int j = it / IPER; int r = it - j * IPER;
            unsigned char* wss = F.ws + WS_W + (size_t)j * W_SSD_STRIDE; unsigned char* wsa = F.ws + WS_W + W_ATT0 + (size_t)j * W_ATT_STRIDE;
            if (r < I1) { transpose_item(A.ssd_w_in + (size_t)j * 1024 * SSD_IN, SSD_IN, 0, 64, 1024, (bf16_t*)(wss + W_WZ), 0, 0, scr, r, F.lane); continue; } r -= I1;
            if (r < I2) { transpose_item(A.ssd_w_in + (size_t)j * 1024 * SSD_IN, SSD_IN, 2048, 130, 1024, (bf16_t*)(wss + W_WIN), 0, 0, scr, r, F.lane); continue; } r -= I2;
            if (r < I3) { transpose_item(A.ssd_w_out + (size_t)j * 2048 * 1024, 1024, 0, 32, 2048, (bf16_t*)(wss + W_WOUT), 0, 0, scr, r, F.lane); continue; } r -= I3;
            if (r < I4) { transpose_item(A.ffn_w1 + (size_t)j * 1024 * DFF, DFF, 0, 88, 1024, (bf16_t*)(wss + W_WUP), 1, 0, scr, r, F.lane); continue; } r -= I4;
            if (r < I5) { transpose_item(A.ffn_w3 + (size_t)j * 1024 * DFF, DFF, 0, 88, 1024, (bf16_t*)(wss + W_WUP), 1, 1, scr, r, F.lane); continue; } r -= I5;
            if (r < I6) { transpose_item(A.ffn_w2 + (size_t)j * DFF * 1024, 1024, 0, 32, DFF, (bf16_t*)(wss + W_WDN), 0, 0, scr, r, F.lane); continue; } r -= I6;
            if (r < I7) { transpose_item(A.attn_w_qkv + (size_t)j * 1024 * NQKV, NQKV, 0, 48, 1024, (bf16_t*)(wsa + W_WQKV), 0, 0, scr, r, F.lane); continue; } r -= I7;
            transpose_item(A.attn_w_o + (size_t)j * 1024 * 1024, 1024, 0, 32, 1024, (bf16_t*)(wsa + W_WO), 0, 0, scr, r, F.lane);
        }
        for (int j = 0; j < 2; ++j) { u32x4* z = (u32x4*)(F.ws + WS_W + (size_t)j * W_SSD_STRIDE + W_WIN + (size_t)4160 * 1024 * 2);
            for (int idx = blockIdx.x * 512 + F.tid; idx < 192 * 1024 * 2 / 16; idx += F.G * 512) z[idx] = (u32x4){0u, 0u, 0u, 0u}; }
    }
}
__device__ __forceinline__ void moe_convert(Frame& F, const Args& A, int j) {
    phase_enter(F);
    LAS float* scr = (LAS float*)(F.lds + F.wave * 16384);
    const int gw = blockIdx.x * NWAVES + F.wave, NGW = F.G * NWAVES;
    constexpr int IE = 16 * 112, I2 = 56 * 32;
    bf16_t* MW13 = (bf16_t*)(F.ws + WS_BIG + BIG_MW13); bf16_t* MW2 = (bf16_t*)(F.ws + WS_BIG + BIG_MW2);
    for (int it = gw; it < 8 * (2 * IE + I2); it += NGW) {
        const int e = it / (2 * IE + I2); int r = it - e * (2 * IE + I2);
        const size_t we = (size_t)(j * 8 + e) * 1024 * DFFE;
        if (r < IE) { transpose_item(A.moe_w1 + we, DFFE, 0, 112, 1024, MW13 + (size_t)e * 7168 * 1024, 1, 0, scr, r, F.lane); continue; } r -= IE;
        if (r < IE) { transpose_item(A.moe_w3 + we, DFFE, 0, 112, 1024, MW13 + (size_t)e * 7168 * 1024, 1, 1, scr, r, F.lane); continue; } r -= IE;
        transpose_item(A.moe_w2 + we, 1024, 0, 32, DFFE, MW2 + (size_t)e * 1024 * DFFE, 0, 0, scr, r, F.lane);
    }
}

__device__ __forceinline__ void norm_phase(Frame& F, const Args& A, int i, int which, int mode) {
    phase_enter(F);
    const bool first = mode & 1, combine = mode & 2, route = mode & 4, fin = mode & 8, lastl = mode & 16;
    const float* MODV = (const float*)(F.ws + WS_MODV);
    bf16_t* H = (bf16_t*)(F.ws + WS_H);
    const bf16_t* EO = (const bf16_t*)(F.ws + WS_Y);
    LAS float* rt = (LAS float*)F.lds;
    LAS int* ents = (LAS int*)(F.lds + 32768);
    const int jm = i >> 1;
    if (route) { const float* rg = A.moe_router + (size_t)jm * 1024 * 8; for (int idx = F.tid; idx < 8192; idx += 512) rt[idx] = rg[idx]; }
    __syncthreads();
    const float* nw = fin ? A.final_norm_w : ((which == 0 ? A.norm1_w : A.norm2_w) + i * 1024);
    unsigned* cnt = (unsigned*)(F.ctl + CW_CNT + (size_t)jm * 8 * 64);
    int* rlist = (int*)(F.ws + WS_RLIST); float* GATE = (float*)(F.ws + WS_GATE);
    for (int ch = blockIdx.x; ch < MROWS / 32; ch += F.G) {
        const int R0 = ch * 32, b = R0 / SROW, s0 = R0 - b * SROW; const bool isctx = s0 < NCTX; const int cond = isctx ? 16 : b;
        if (fin && isctx) continue;
        const bool do_route = route && !(lastl && isctx);
        const float* mv = MODV + (size_t)(i * 17 + cond) * 6144;
        f32x4 wv[4], shv[4], scv[4], g5[4];
#pragma unroll
        for (int j = 0; j < 4; ++j) { const int col = 4 * F.lane + 256 * j; wv[j] = *(const f32x4*)(nw + col);
            if (!fin) { shv[j] = *(const f32x4*)(mv + (which ? 3 : 0) * 1024 + col); scv[j] = *(const f32x4*)(mv + (which ? 4 : 1) * 1024 + col); }
            if (combine) g5[j] = *(const f32x4*)(MODV + (size_t)((i - 1) * 17 + cond) * 6144 + 5 * 1024 + col); }
        for (int rr = 0; rr < 4; ++rr) {
            const int R = R0 + F.wave * 4 + rr, s = s0 + F.wave * 4 + rr;
            float* res = isctx ? (float*)(F.ws + WS_CX) + (size_t)(b * NCTX + s) * DM : F.out + (size_t)(b * SEQ + s - NCTX) * DM;
            const float* src = first ? (isctx ? A.ctx + (size_t)(b * NCTX + s) * DM : A.x + (size_t)(b * SEQ + s - NCTX) * DM) : res;
            f32x4 v[4]; float ss = 0.f;
#pragma unroll
            for (int j = 0; j < 4; ++j) v[j] = *(const f32x4*)(src + 4 * F.lane + 256 * j);
            if (combine) {
#pragma unroll
                for (int j = 0; j < 4; ++j) { const u32x2 e0 = *(const u32x2*)(EO + (size_t)(2 * R) * DM + 4 * F.lane + 256 * j), e1 = *(const u32x2*)(EO + (size_t)(2 * R + 1) * DM + 4 * F.lane + 256 * j);
                    f32x4 ev; ev.x = bf_lo(e0.x) + bf_lo(e1.x); ev.y = bf_hi(e0.x) + bf_hi(e1.x); ev.z = bf_lo(e0.y) + bf_lo(e1.y); ev.w = bf_hi(e0.y) + bf_hi(e1.y);
                    v[j] = v[j] + g5[j] * ev; }
            }
            if (first || combine) {
#pragma unroll
                for (int j = 0; j < 4; ++j) *(f32x4*)(res + 4 * F.lane + 256 * j) = v[j];
            }
#pragma unroll
            for (int j = 0; j < 4; ++j) ss += (v[j].x * v[j].x + v[j].y * v[j].y) + (v[j].z * v[j].z + v[j].w * v[j].w);
            const float rstd = 1.0f / sqrtf(wave_sum(ss, F.lane) * (1.0f / DM) + EPS);
            if (fin) {
#pragma unroll
                for (int j = 0; j < 4; ++j) *(f32x4*)(res + 4 * F.lane + 256 * j) = v[j] * rstd * wv[j];
                continue;
            }
#pragma unroll
            for (int j = 0; j < 4; ++j) { v[j] = v[j] * rstd * wv[j] * (scv[j] + 1.0f) + shv[j];
                u32x2 o; o.x = pk2(v[j].x, v[j].y); o.y = pk2(v[j].z, v[j].w); *(u32x2*)(H + (size_t)R * DM + 4 * F.lane + 256 * j) = o; }
            if (do_route) {
                float lg[8];
#pragma unroll
                for (int e = 0; e < 8; ++e) lg[e] = 0.f;
#pragma unroll
                for (int j = 0; j < 4; ++j)
#pragma unroll
                    for (int q = 0; q < 4; ++q) { const int col = 4 * F.lane + 256 * j + q; const f32x4 r0 = *(const LAS f32x4*)(rt + col * 8), r1 = *(const LAS f32x4*)(rt + col * 8 + 4); const float y = v[j][q];
                        lg[0] += y * r0.x; lg[1] += y * r0.y; lg[2] += y * r0.z; lg[3] += y * r0.w; lg[4] += y * r1.x; lg[5] += y * r1.y; lg[6] += y * r1.z; lg[7] += y * r1.w; }
#pragma unroll
                for (int e = 0; e < 8; ++e) lg[e] = wave_sum(lg[e], F.lane);
                int i1 = 0; float v1 = lg[0];
#pragma unroll
                for (int e = 1; e < 8; ++e) if (lg[e] > v1) { v1 = lg[e]; i1 = e; }
                int i2 = -1; float v2 = -3.0e38f;
#pragma unroll
                for (int e = 0; e < 8; ++e) if (e != i1 && lg[e] > v2) { v2 = lg[e]; i2 = e; }
                const float g1 = 1.0f / (1.0f + expf(v2 - v1)), g2 = 1.0f - g1;
                if (F.lane == 0) { ents[(F.wave * 4 + rr) * 2] = i1; ents[(F.wave * 4 + rr) * 2 + 1] = i2; GATE[(size_t)R * 2] = g1; GATE[(size_t)R * 2 + 1] = g2; }
            }
        }
        if (do_route) {
            __syncthreads();
            if (F.wave == 0) {
                const int e = ents[F.lane];
#pragma unroll
                for (int ee = 0; ee < 8; ++ee) { const unsigned long long m = __ballot(e == ee); const int n = __popcll(m);
                    if (n) { unsigned base = 0; if (F.lane == 0) base = __hip_atomic_fetch_add(cnt + ee * 64, (unsigned)n, RLX_AGENT); base = __builtin_amdgcn_readfirstlane(base);
                        if (e == ee) { const int pos = (int)base + __popcll(m & ((1ull << F.lane) - 1ull)); rlist[(size_t)ee * MROWS + pos] = (R0 + (F.lane >> 1)) * 2 + (F.lane & 1); } } }
            }
            __syncthreads();
        }
    }
}

struct EpiXbc {
    static constexpr bool PERM = true;
    bf16_t* XBC; float* DT;
    __device__ __forceinline__ void operator()(const f32x4 (&acc)[2][2][4][2], const pg8::Unit& u, int wr, int wc, int fr, int fq) const {
        const int row0 = u.pm * 256 + wr * 64 + fr;
        if (u.pn < 16) { const int col0 = u.pn * 256 + wc * 32 + 8 * fq;
#pragma unroll
            for (int ai = 0; ai < 2; ++ai)
#pragma unroll
                for (int m = 0; m < 4; ++m) { bf16_t* rowp = XBC + (size_t)(row0 + ai * 128 + m * 16) * CONVCH + col0;
#pragma unroll
                    for (int bj = 0; bj < 2; ++bj) { const f32x4 v0 = acc[ai][bj][m][0], v1 = acc[ai][bj][m][1]; u32x4 w; w.x = pg8::cvt_pk_bf16(v0[0], v0[1]); w.y = pg8::cvt_pk_bf16(v0[2], v0[3]); w.z = pg8::cvt_pk_bf16(v1[0], v1[1]); w.w = pg8::cvt_pk_bf16(v1[2], v1[3]);
                        *(u32x4*)(rowp + bj * 128) = w; } }
        } else if (wc < 2) { const int c0 = wc * 32 + 8 * fq;
#pragma unroll
            for (int ai = 0; ai < 2; ++ai)
#pragma unroll
                for (int m = 0; m < 4; ++m) { float* p = DT + (size_t)(row0 + ai * 128 + m * 16) * 64 + c0; *(f32x4*)p = acc[ai][0][m][0]; *(f32x4*)(p + 4) = acc[ai][0][m][1]; }
        }
    }
};
struct EpiGate {
    static constexpr bool PERM = true;
    const bf16_t* Y; bf16_t* Gt; const float* nw; LAS float* P;
    __device__ __forceinline__ void operator()(f32x4 (&acc)[2][2][4][2], const pg8::Unit& u, int wr, int wc, int fr, int fq) const {
        const int row0 = u.pm * 256 + wr * 64 + fr, col0 = u.pn * 256 + wc * 32 + 8 * fq;
#pragma unroll
        for (int ai = 0; ai < 2; ++ai)
#pragma unroll
            for (int m = 0; m < 4; ++m) { const bf16_t* yp = Y + (size_t)(row0 + ai * 128 + m * 16) * DIN + col0; float ssq = 0.f;
#pragma unroll
                for (int bj = 0; bj < 2; ++bj) { const u32x4 yv = *(const u32x4*)(yp + bj * 128); f32x4 z0 = acc[ai][bj][m][0], z1 = acc[ai][bj][m][1];
                    z0[0] = bf_lo(yv.x) * siluf(z0[0]); z0[1] = bf_hi(yv.x) * siluf(z0[1]); z0[2] = bf_lo(yv.y) * siluf(z0[2]); z0[3] = bf_hi(yv.y) * siluf(z0[3]);
                    z1[0] = bf_lo(yv.z) * siluf(z1[0]); z1[1] = bf_hi(yv.z) * siluf(z1[1]); z1[2] = bf_lo(yv.w) * siluf(z1[2]); z1[3] = bf_hi(yv.w) * siluf(z1[3]);
                    ssq += (z0[0] * z0[0] + z0[1] * z0[1]) + (z0[2] * z0[2] + z0[3] * z0[3]) + (z1[0] * z1[0] + z1[1] * z1[1]) + (z1[2] * z1[2] + z1[3] * z1[3]);
                    acc[ai][bj][m][0] = z0; acc[ai][bj][m][1] = z1; }
                ssq += shx(ssq, 16, fq * 16 + fr); ssq += shx(ssq, 32, fq * 16 + fr);
                if (fq == 0) P[(ai * 128 + wr * 64 + m * 16 + fr) * 4 + wc] = ssq; }
        asm volatile("s_waitcnt lgkmcnt(0)" ::: "memory"); __builtin_amdgcn_s_barrier(); asm volatile("" ::: "memory");
        f32x4 nv[2][2];
#pragma unroll
        for (int bj = 0; bj < 2; ++bj) { nv[bj][0] = *(const f32x4*)(nw + col0 + bj * 128); nv[bj][1] = *(const f32x4*)(nw + col0 + bj * 128 + 4); }
#pragma unroll
        for (int ai = 0; ai < 2; ++ai)
#pragma unroll
            for (int m = 0; m < 4; ++m) { const f32x4 pp = *(const LAS f32x4*)(P + (ai * 128 + wr * 64 + m * 16 + fr) * 4); const float rstd = 1.0f / sqrtf(((pp.x + pp.y) + (pp.z + pp.w)) * (1.0f / 256.0f) + EPS);
                bf16_t* gp = Gt + (size_t)(row0 + ai * 128 + m * 16) * DIN + col0;
#pragma unroll
                for (int bj = 0; bj < 2; ++bj) { const f32x4 v0 = acc[ai][bj][m][0] * rstd * nv[bj][0], v1 = acc[ai][bj][m][1] * rstd * nv[bj][1];
                    u32x4 w; w.x = pg8::cvt_pk_bf16(v0[0], v0[1]); w.y = pg8::cvt_pk_bf16(v0[2], v0[3]); w.z = pg8::cvt_pk_bf16(v1[0], v1[1]); w.w = pg8::cvt_pk_bf16(v1[2], v1[3]);
                    *(u32x4*)(gp + bj * 128) = w; } }
        asm volatile("s_waitcnt lgkmcnt(0)" ::: "memory");
    }
};
struct EpiResid {
    static constexpr bool PERM = false;
    unsigned char* ws; float* out; const float* modl; int gidx; const float* bias;
    __device__ __forceinline__ void operator()(const f32x4 (&acc)[2][2][4][2], const pg8::Unit& u, int wr, int wc, int fr, int fq) const {
        const int b = u.pm / 17, j = u.pm - b * 17, cond = j == 0 ? 16 : b;
        float* res = (j == 0 ? (float*)(ws + WS_CX) + (size_t)(b * NCTX) * DM : out + (size_t)(b * SEQ + (j - 1) * 256) * DM) + (size_t)(wr * 64 + fr) * DM + u.pn * 256 + wc * 32 + 4 * fq;
        const float* gv = modl + (size_t)cond * 6144 + gidx * 1024 + u.pn * 256 + wc * 32 + 4 * fq;
        const float* bp = bias ? bias + u.pn * 256 + wc * 32 + 4 * fq : nullptr;
#pragma unroll
        for (int bj = 0; bj < 2; ++bj) {
            f32x4 g[2], bv[2];
#pragma unroll
            for (int n = 0; n < 2; ++n) { g[n] = *(const f32x4*)(gv + bj * 128 + n * 16); bv[n] = bp ? *(const f32x4*)(bp + bj * 128 + n * 16) : (f32x4){0.f, 0.f, 0.f, 0.f}; }
#pragma unroll
            for (int ai = 0; ai < 2; ++ai)
#pragma unroll
                for (int m = 0; m < 4; ++m) { float* p = res + (size_t)(ai * 128 + m * 16) * DM + bj * 128;
                    const f32x4 o0 = *(const f32x4*)p, o1 = *(const f32x4*)(p + 16);
                    *(f32x4*)p = o0 + g[0] * (acc[ai][bj][m][0] + bv[0]); *(f32x4*)(p + 16) = o1 + g[1] * (acc[ai][bj][m][1] + bv[1]);
                    if (m & 1) asm volatile("" ::: "memory"); }
        }
    }
};
struct EpiSwiglu {
    static constexpr bool PERM = true;
    bf16_t* ACT; int ldc;
    __device__ __forceinline__ void operator()(const f32x4 (&acc)[2][2][4][2], const pg8::Unit& u, int wr, int wc, int fr, int fq) const {
        const int row0 = u.pm * 256 + wr * 64 + fr, col0 = u.pn * 128 + wc * 32 + 8 * fq;
#pragma unroll
        for (int ai = 0; ai < 2; ++ai)
#pragma unroll
            for (int m = 0; m < 4; ++m) { const f32x4 g0 = acc[ai][0][m][0], g1 = acc[ai][0][m][1], u0 = acc[ai][1][m][0], u1 = acc[ai][1][m][1];
                u32x4 w; w.x = pg8::cvt_pk_bf16(siluf(g0[0]) * u0[0], siluf(g0[1]) * u0[1]); w.y = pg8::cvt_pk_bf16(siluf(g0[2]) * u0[2], siluf(g0[3]) * u0[3]);
                w.z = pg8::cvt_pk_bf16(siluf(g1[0]) * u1[0], siluf(g1[1]) * u1[1]); w.w = pg8::cvt_pk_bf16(siluf(g1[2]) * u1[2], siluf(g1[3]) * u1[3]);
                *(u32x4*)(ACT + (size_t)(row0 + ai * 128 + m * 16) * ldc + col0) = w; }
    }
};
struct EpiQkv {
    static constexpr bool PERM = false;
    bf16_t *Q, *Kb, *Vb; const float* bias; const float* rope;
    __device__ __forceinline__ void operator()(const f32x4 (&acc)[2][2][4][2], const pg8::Unit& u, int wr, int wc, int fr, int fq) const {
        const int b = u.pm / 17, j = u.pm - b * 17; const bool isctx = j == 0; const int pos0 = (j - 1) * 256;
        bf16_t* dst; int ld, cbase; float sc = 1.0f;
        if (u.pn < 4) { dst = Q; ld = QW; cbase = u.pn * 256; sc = 0.125f; } else if (u.pn == 4) { dst = Kb; ld = KVW; cbase = 0; } else { dst = Vb; ld = KVW; cbase = 0; }
        const bool dorope = !isctx && u.pn < 5; const int axis = wc & 1;
        const float* bp = bias + u.pn * 256 + wc * 32 + 4 * fq;
#pragma unroll
        for (int ai = 0; ai < 2; ++ai)
#pragma unroll
            for (int m = 0; m < 4; ++m) { const int r = ai * 128 + wr * 64 + m * 16 + fr; const int pos = pos0 + r; const int id = axis ? (pos & 63) : (pos >> 6);
                f32x4 cs = (f32x4){1.f, 1.f, 1.f, 1.f}, sn = (f32x4){0.f, 0.f, 0.f, 0.f};
                if (dorope) { cs = *(const f32x4*)(rope + id * 16 + 4 * fq); sn = *(const f32x4*)(rope + 1024 + id * 16 + 4 * fq); }
                bf16_t* rowp = dst + (size_t)(u.pm * 256 + r) * ld + cbase + wc * 32 + 4 * fq;
#pragma unroll
                for (int bj = 0; bj < 2; ++bj) { const f32x4 x0 = (acc[ai][bj][m][0] + *(const f32x4*)(bp + bj * 128)) * sc, x1 = (acc[ai][bj][m][1] + *(const f32x4*)(bp + bj * 128 + 16)) * sc;
                    const f32x4 o0 = x0 * cs - x1 * sn, o1 = x1 * cs + x0 * sn;
                    u32x2 w0, w1; w0.x = pg8::cvt_pk_bf16(o0[0], o0[1]); w0.y = pg8::cvt_pk_bf16(o0[2], o0[3]); w1.x = pg8::cvt_pk_bf16(o1[0], o1[1]); w1.y = pg8::cvt_pk_bf16(o1[2], o1[3]);
                    *(u32x2*)(rowp + bj * 128) = w0; *(u32x2*)(rowp + bj * 128 + 16) = w1; }
                if (m & 1) asm volatile("" ::: "memory"); }
    }
};

struct MoeOrder {
    pg8::StaticOrder so; int cs; int pp[9]; int cnt[8]; const int* rlist; size_t bstride; bool GATHER_A;
    __device__ __forceinline__ void locate(int pm, int& e, int& p, int& cn) const { const int gp = cs + pm; e = 0; int pbase = 0; cn = cnt[0];
#pragma unroll
        for (int k = 1; k < 8; ++k) { const bool ge = gp >= pp[k]; e += ge ? 1 : 0; pbase = ge ? pp[k] : pbase; cn = ge ? cnt[k] : cn; }
        p = gp - pbase; }
    __device__ bool next(int i, pg8::Unit& u) const { return so.next(i, u); }
    __device__ __forceinline__ const char* a_base(const pg8::Gemm& g, const pg8::Unit& u) const { return GATHER_A ? (const char*)g.A : (const char*)g.A + (size_t)u.pm * (size_t)(256 * 2) * g.lda; }
    __device__ __forceinline__ const char* b_base(const pg8::Gemm& g, const pg8::Unit& u) const { int e, p, cn; locate(u.pm, e, p, cn); return (const char*)g.Bt + (size_t)e * bstride + (size_t)u.pn * (size_t)(256 * 2) * g.K; }
    __device__ __forceinline__ unsigned row_off(const pg8::Gemm& g, const pg8::Unit& u, int r) const {
        if (!GATHER_A) return (unsigned)r * (unsigned)g.lda * 2u;
        int e, p, cn; locate(u.pm, e, p, cn); const int idx = p * 256 + r; const int tok = idx < cn ? (rlist[(size_t)e * MROWS + idx] >> 1) : 0; return (unsigned)tok * (unsigned)g.lda * 2u; }
};
struct EpiMoeDown {
    static constexpr bool PERM = true;
    MoeOrder mo; bf16_t* EO; const float* GATE;
    __device__ __forceinline__ void operator()(const f32x4 (&acc)[2][2][4][2], const pg8::Unit& u, int wr, int wc, int fr, int fq) const {
        int e, p, cn; mo.locate(u.pm, e, p, cn); const int* rl = mo.rlist + (size_t)e * MROWS + p * 256;
        const int col0 = u.pn * 256 + wc * 32 + 8 * fq;
#pragma unroll
        for (int ai = 0; ai < 2; ++ai)
#pragma unroll
            for (int m = 0; m < 4; ++m) { const int r = ai * 128 + wr * 64 + m * 16 + fr;
                if (p * 256 + r < cn) { const int ent = rl[r]; const float gt = GATE[ent]; bf16_t* dp = EO + (size_t)ent * DM + col0;
#pragma unroll
                    for (int bj = 0; bj < 2; ++bj) { const f32x4 v0 = acc[ai][bj][m][0] * gt, v1 = acc[ai][bj][m][1] * gt; u32x4 w; w.x = pg8::cvt_pk_bf16(v0[0], v0[1]); w.y = pg8::cvt_pk_bf16(v0[2], v0[3]); w.z = pg8::cvt_pk_bf16(v1[0], v1[1]); w.w = pg8::cvt_pk_bf16(v1[2], v1[3]);
                        *(u32x4*)(dp + bj * 128) = w; } } }
    }
};

typedef __bf16 bf16x2_t __attribute__((ext_vector_type(2)));
typedef short v4i16_t __attribute__((ext_vector_type(4)));
__device__ __forceinline__ unsigned cvtpk(float lo, float hi) { f32x2 v = {lo, hi}; bf16x2_t b = __builtin_convertvector(v, bf16x2_t); return __builtin_bit_cast(unsigned, b); }
__device__ __forceinline__ int crow(int r, int hi) { return (r & 3) + 8 * (r >> 2) + 4 * hi; }
__device__ __forceinline__ s16x4 vtr(const LAS unsigned char* p) { return __builtin_bit_cast(s16x4, __builtin_amdgcn_ds_read_tr16_b64_v4i16((LAS v4i16_t*)p)); }
#define MFMA32(a, b, c) __builtin_amdgcn_mfma_f32_32x32x16_bf16((a), (b), (c), 0, 0, 0)
constexpr int SC_RS = 272;
constexpr int SC_TILE = 3 * 32 * SC_RS;
constexpr int SC_YS = 2 * SC_TILE;
constexpr int SC_WS = SC_YS + 16384;
__device__ __forceinline__ void scan_phase(Frame& F, const Args& A, int j) {
    phase_enter(F);
    const bf16_t* XBC = (const bf16_t*)(F.ws + WS_BIG); const float* DT = (const float*)(F.ws + WS_DT); bf16_t* Y = (bf16_t*)(F.ws + WS_Y);
    const int lane = F.lane, wave = F.wave;
    for (int unit = blockIdx.x; unit < 256; unit += F.G) {
        const int b = unit >> 4, g = (unit >> 1) & 7, ph = unit & 1;
        int gcol, lcol, kind;
        if (lane < 16) { const int h4 = lane >> 2, sub = lane & 3; gcol = g * 256 + h4 * 64 + ph * 32 + sub * 8; lcol = h4 * 32 + sub * 8; kind = 2; }
        else if (lane < 32) { gcol = 2048 + g * 128 + (lane - 16) * 8; lcol = (lane - 16) * 8; kind = 0; }
        else if (lane < 48) { gcol = 3072 + g * 128 + (lane - 32) * 8; lcol = (lane - 32) * 8; kind = 1; }
        else { gcol = 0; lcol = 0; kind = 3; }
        f32x2 cw[5][4], cbias[4];
#pragma unroll
        for (int k = 0; k < 5; ++k) { const f32x4 a0 = *(const f32x4*)(A.ssd_conv_w + (size_t)(j * 5 + k) * CONVCH + gcol), a1 = *(const f32x4*)(A.ssd_conv_w + (size_t)(j * 5 + k) * CONVCH + gcol + 4);
            cw[k][0] = (f32x2){a0.x, a0.y}; cw[k][1] = (f32x2){a0.z, a0.w}; cw[k][2] = (f32x2){a1.x, a1.y}; cw[k][3] = (f32x2){a1.z, a1.w}; }
        { const f32x4 a0 = *(const f32x4*)(A.ssd_conv_b + (size_t)j * CONVCH + gcol), a1 = *(const f32x4*)(A.ssd_conv_b + (size_t)j * CONVCH + gcol + 4);
            cbias[0] = (f32x2){a0.x, a0.y}; cbias[1] = (f32x2){a0.z, a0.w}; cbias[2] = (f32x2){a1.x, a1.y}; cbias[3] = (f32x2){a1.z, a1.w}; }
        const int hh = wave >> 1, dir = wave & 1, c31 = lane & 31, hl = lane >> 5;
        const int trq = (lane & 15) >> 2, trp = lane & 3, trb = (lane >> 4) & 1;
        const int head = g * 4 + hh;
        const float Dk = A.ssd_d[(j * 2 + dir) * 32 + head], dtb = A.ssd_dt_bias[(j * 2 + dir) * 32 + head], aneg = -expf(A.ssd_a_log[(j * 2 + dir) * 32 + head]);
        LAS float* wsf = (LAS float*)(F.lds + SC_WS + wave * 512);
        f32x16 ST[4];
#pragma unroll
        for (int t = 0; t < 4; ++t)
#pragma unroll
            for (int e = 0; e < 16; ++e) ST[t][e] = 0.f;
        for (int step = 0; step < 136; ++step) {
            const int cf = step, cbk = step < 8 ? 7 - step : 143 - step;
#pragma unroll
            for (int T = 0; T < 2; ++T) {
                const int chunk = T ? cbk : cf, t0 = chunk * 32, seg_lo = chunk < 8 ? 0 : NCTX, seg_hi = chunk < 8 ? NCTX : SROW;
                if (kind < 3) {
                    const int tb = t0 + wave * 4;
                    u32x4 raw[8];
#pragma unroll
                    for (int q = 0; q < 8; ++q) { const int tt = tb - 2 + q; raw[q] = (tt >= seg_lo && tt < seg_hi) ? *(const u32x4*)(XBC + (size_t)(b * SROW + tt) * CONVCH + gcol) : (u32x4){0u, 0u, 0u, 0u}; }
#pragma unroll
                    for (int o = 0; o < 4; ++o) {
                        f32x2 r[4];
#pragma unroll
                        for (int c = 0; c < 4; ++c) r[c] = cbias[c];
#pragma unroll
                        for (int k = 0; k < 5; ++k) { const u32x4 w = raw[o + k];
                            r[0] += cw[k][0] * (f32x2){bf_lo(w.x), bf_hi(w.x)}; r[1] += cw[k][1] * (f32x2){bf_lo(w.y), bf_hi(w.y)};
                            r[2] += cw[k][2] * (f32x2){bf_lo(w.z), bf_hi(w.z)}; r[3] += cw[k][3] * (f32x2){bf_lo(w.w), bf_hi(w.w)}; }
                        u32x4 w; w.x = cvtpk(siluf(r[0].x), siluf(r[0].y)); w.y = cvtpk(siluf(r[1].x), siluf(r[1].y)); w.z = cvtpk(siluf(r[2].x), siluf(r[2].y)); w.w = cvtpk(siluf(r[3].x), siluf(r[3].y));
                        *(LAS u32x4*)(F.lds + T * SC_TILE + kind * (32 * SC_RS) + (wave * 4 + o) * SC_RS + lcol * 2) = w;
                    }
                }
            }
            {
                const int chunk = dir ? cbk : cf;
                const float xb = DT[(size_t)(b * SROW + chunk * 32 + c31) * 64 + dir * 32 + head] + dtb;
                const float dt = xb > 20.f ? xb : log1pf(__expf(xb)); const float dA = dt * aneg;
                float v = dA;
#pragma unroll
                for (int o = 1; o < 32; o <<= 1) { const float t = __builtin_bit_cast(float, __builtin_amdgcn_ds_bpermute((lane - o) << 2, __builtin_bit_cast(int, v))); if (c31 >= o) v += t; }
                const float tot = __builtin_bit_cast(float, __builtin_amdgcn_ds_bpermute((hl * 32 + 31) << 2, __builtin_bit_cast(int, v)));
                const float cum = dir ? (tot - v + dA) : v;
                if (hl == 0) { wsf[c31] = cum; wsf[32 + c31] = dt; wsf[64 + c31] = __expf(tot - cum) * dt; wsf[96 + c31] = __expf(cum); }
                asm volatile("" :: "v"(tot));
            }
            __syncthreads();
            {
                const LAS unsigned char* Bs = F.lds + dir * SC_TILE; const LAS unsigned char* Cs = Bs + 32 * SC_RS; const LAS unsigned char* xs = Bs + 64 * SC_RS;
                f32x16 gt;
#pragma unroll
                for (int e = 0; e < 16; ++e) gt[e] = 0.f;
#pragma unroll
                for (int s = 0; s < 8; ++s) { const bf16x8 a = *(const LAS bf16x8*)(Bs + c31 * SC_RS + (16 * s + 8 * hl) * 2), bb = *(const LAS bf16x8*)(Cs + c31 * SC_RS + (16 * s + 8 * hl) * 2); gt = MFMA32(a, bb, gt); }
                const float cum_i = wsf[c31];
                bf16x8 mk[2];
                {
                    float mv[16];
#pragma unroll
                    for (int q = 0; q < 4; ++q) { const f32x4 cj = *(const LAS f32x4*)(wsf + 8 * q + 4 * hl), dj = *(const LAS f32x4*)(wsf + 32 + 8 * q + 4 * hl);
#pragma unroll
                        for (int z = 0; z < 4; ++z) { const int jj = 8 * q + 4 * hl + z; const bool ok = dir ? (jj >= c31) : (jj <= c31);
                            float val = gt[4 * q + z] * __expf(ok ? (cum_i - cj[z]) : -INFINITY) * dj[z]; if (jj == c31) val += Dk; mv[4 * q + z] = val; } }
#pragma unroll
                    for (int s2 = 0; s2 < 2; ++s2) { u32x4 w; w.x = cvtpk(mv[8 * s2], mv[8 * s2 + 1]); w.y = cvtpk(mv[8 * s2 + 2], mv[8 * s2 + 3]); w.z = cvtpk(mv[8 * s2 + 4], mv[8 * s2 + 5]); w.w = cvtpk(mv[8 * s2 + 6], mv[8 * s2 + 7]); mk[s2] = __builtin_bit_cast(bf16x8, w); }
                }
                f32x16 ya;
#pragma unroll
                for (int e = 0; e < 16; ++e) ya[e] = 0.f;
#pragma unroll
                for (int t = 0; t < 4; ++t)
#pragma unroll
                    for (int s2 = 0; s2 < 2; ++s2) {
                        const LAS unsigned char* cp = Cs + c31 * SC_RS + (32 * t + 16 * s2 + 4 * hl) * 2;
                        const u32x2 c0 = *(const LAS u32x2*)cp, c1 = *(const LAS u32x2*)(cp + 16);
                        const bf16x8 ca = __builtin_bit_cast(bf16x8, (u32x4){c0.x, c0.y, c1.x, c1.y});
                        u32x4 w; w.x = cvtpk(ST[t][8 * s2], ST[t][8 * s2 + 1]); w.y = cvtpk(ST[t][8 * s2 + 2], ST[t][8 * s2 + 3]); w.z = cvtpk(ST[t][8 * s2 + 4], ST[t][8 * s2 + 5]); w.w = cvtpk(ST[t][8 * s2 + 6], ST[t][8 * s2 + 7]);
                        ya = MFMA32(ca, __builtin_bit_cast(bf16x8, w), ya);
                    }
#pragma unroll
                for (int q = 0; q < 4; ++q) { const f32x4 ec = *(const LAS f32x4*)(wsf + 96 + 8 * q + 4 * hl); ya[4 * q] *= ec.x; ya[4 * q + 1] *= ec.y; ya[4 * q + 2] *= ec.z; ya[4 * q + 3] *= ec.w; }
#pragma unroll
                for (int s2 = 0; s2 < 2; ++s2) {
                    const LAS unsigned char* xp = xs + (16 * s2 + 4 * hl + trq) * SC_RS + (hh * 32 + 16 * trb + 4 * trp) * 2;
                    const s16x4 lo = vtr(xp), hi = vtr(xp + 8 * SC_RS);
                    ya = MFMA32(mk[s2], ((bf16x8){lo[0], lo[1], lo[2], lo[3], hi[0], hi[1], hi[2], hi[3]}), ya);
                }
                {
                    const float etot = dir ? wsf[96] : wsf[96 + 31];
#pragma unroll
                    for (int t = 0; t < 4; ++t)
#pragma unroll
                        for (int e = 0; e < 16; ++e) ST[t][e] *= etot;
#pragma unroll
                    for (int s2 = 0; s2 < 2; ++s2) {
                        const LAS unsigned char* xp = xs + (16 * s2 + 8 * hl + trq) * SC_RS + (hh * 32 + 16 * trb + 4 * trp) * 2;
                        const s16x4 lo = vtr(xp), hi = vtr(xp + 4 * SC_RS);
                        const f32x4 w0 = *(const LAS f32x4*)(wsf + 64 + 16 * s2 + 8 * hl), w1 = *(const LAS f32x4*)(wsf + 64 + 16 * s2 + 8 * hl + 4);
                        u32x4 xw; xw.x = cvtpk(bf1((bf16_t)lo[0]) * w0.x, bf1((bf16_t)lo[1]) * w0.y); xw.y = cvtpk(bf1((bf16_t)lo[2]) * w0.z, bf1((bf16_t)lo[3]) * w0.w);
                        xw.z = cvtpk(bf1((bf16_t)hi[0]) * w1.x, bf1((bf16_t)hi[1]) * w1.y); xw.w = cvtpk(bf1((bf16_t)hi[2]) * w1.z, bf1((bf16_t)hi[3]) * w1.w);
                        const bf16x8 xb8 = __builtin_bit_cast(bf16x8, xw);
#pragma unroll
                        for (int t = 0; t < 4; ++t) {
                            const LAS unsigned char* bp = Bs + (16 * s2 + 8 * hl + trq) * SC_RS + (32 * t + 16 * trb + 4 * trp) * 2;
                            const s16x4 blo = vtr(bp), bhi = vtr(bp + 4 * SC_RS);
                            ST[t] = MFMA32(((bf16x8){blo[0], blo[1], blo[2], blo[3], bhi[0], bhi[1], bhi[2], bhi[3]}), xb8, ST[t]);
                        }
                    }
                }
                LAS bf16_t* ys = (LAS bf16_t*)(F.lds + SC_YS + dir * 8192);
#pragma unroll
                for (int e = 0; e < 16; ++e) ys[crow(e, hl) * 128 + hh * 32 + c31] = (bf16_t)f2bf(ya[e]);
            }
            __syncthreads();
#pragma unroll
            for (int T = 0; T < 2; ++T) {
                const int tok = F.tid >> 4, h4 = (F.tid >> 2) & 3, q4 = F.tid & 3, chunk = T ? cbk : cf;
                const int other = T == 0 ? (chunk < 8 ? 7 - chunk : 143 - chunk) : chunk;
                u32x4 v = *(const LAS u32x4*)(F.lds + SC_YS + T * 8192 + (tok * 128 + h4 * 32 + q4 * 8) * 2);
                bf16_t* yp = Y + (size_t)(b * SROW + chunk * 32 + tok) * DIN + g * 256 + h4 * 64 + ph * 32 + q4 * 8;
                if (step > other) { const u32x4 o = *(const u32x4*)yp;
                    v.x = pk2(bf_lo(o.x) + bf_lo(v.x), bf_hi(o.x) + bf_hi(v.x)); v.y = pk2(bf_lo(o.y) + bf_lo(v.y), bf_hi(o.y) + bf_hi(v.y));
                    v.z = pk2(bf_lo(o.z) + bf_lo(v.z), bf_hi(o.z) + bf_hi(v.z)); v.w = pk2(bf_lo(o.w) + bf_lo(v.w), bf_hi(o.w) + bf_hi(v.w)); }
                *(u32x4*)yp = v;
            }
        }
        __syncthreads();
    }
}

__device__ __forceinline__ void attn_phase(Frame& F, const Args& A, int ja, bool need_ctx) {
    phase_enter(F);
    const bf16_t* Q = (const bf16_t*)(F.ws + WS_BIG); bf16_t* O = (bf16_t*)(F.ws + WS_BIG + BIG_O); const bf16_t* Kb = (const bf16_t*)(F.ws + WS_BIG + BIG_K); const bf16_t* Vb = (const bf16_t*)(F.ws + WS_BIG + BIG_V);
    LAS unsigned char* Kl = F.lds; LAS unsigned char* Vl = F.lds + 9216;
    const int nunits = 2048 + (need_ctx ? 128 : 0);
    const int lane = F.lane, r = F.wave >> 1, rh = F.wave & 1, c31 = lane & 31, hl = lane >> 5;
    const int prow = F.tid >> 3, ppc = F.tid & 7;
    const int trq = (lane & 15) >> 2, trp = lane & 3, trb = (lane >> 4) & 1;
    for (int unit = blockIdx.x; unit < nunits; unit += F.G) {
        int b, g, nblk; bool cq;
        if (unit < 2048) { b = unit >> 7; nblk = (unit >> 2) & 31; g = unit & 3; cq = false; } else { const int u2 = unit - 2048; b = u2 >> 3; nblk = (u2 >> 2) & 1; g = u2 & 3; cq = true; }
        const int qrow0 = b * SROW + (cq ? 128 * nblk : NCTX + 128 * nblk);
        const int start = 128 * nblk;
        bf16x8 qf[2][4];
#pragma unroll
        for (int qb = 0; qb < 2; ++qb)
#pragma unroll
            for (int s = 0; s < 4; ++s) qf[qb][s] = *(const bf16x8*)(Q + (size_t)(qrow0 + 64 * rh + 32 * qb + c31) * QW + g * 256 + r * 64 + 16 * s + 8 * hl);
        const float sink = A.attn_sink[ja * 16 + g * 4 + r];
        float mrun[2] = {sink, sink}, lrun[2] = {1.f, 1.f};
        f32x16 ot[2][2];
#pragma unroll
        for (int db = 0; db < 2; ++db)
#pragma unroll
            for (int qb = 0; qb < 2; ++qb)
#pragma unroll
                for (int e = 0; e < 16; ++e) ot[db][qb][e] = 0.f;
        const int tt_lo = cq ? 0 : (nblk == 0 ? 2 : 0), tt_hi = cq ? 0 : (nblk == 31 ? 4 : 6);
        const int ntile = 4 + (tt_hi - tt_lo);
#define TILE_ROW0(t) ((t) < 4 ? b * SROW + 64 * (t) : b * SROW + NCTX + start - 128 + 64 * (tt_lo + (t) - 4))
        u32x4 kreg, vreg;
        { const int r0 = TILE_ROW0(0); kreg = *(const u32x4*)(Kb + (size_t)(r0 + prow) * KVW + g * 64 + ppc * 8); vreg = *(const u32x4*)(Vb + (size_t)(r0 + prow) * KVW + g * 64 + ppc * 8); }
        for (int t = 0; t < ntile; ++t) {
            __syncthreads();
            *(LAS u32x4*)(Kl + prow * 144 + ppc * 16) = kreg; *(LAS u32x4*)(Vl + prow * 144 + ppc * 16) = vreg;
            __syncthreads();
            if (t + 1 < ntile) { const int r0 = TILE_ROW0(t + 1); kreg = *(const u32x4*)(Kb + (size_t)(r0 + prow) * KVW + g * 64 + ppc * 8); vreg = *(const u32x4*)(Vb + (size_t)(r0 + prow) * KVW + g * 64 + ppc * 8); }
            f32x16 st[2][2];
#pragma unroll
            for (int kb = 0; kb < 2; ++kb) {
#pragma unroll
                for (int qb = 0; qb < 2; ++qb)
#pragma unroll
                    for (int e = 0; e < 16; ++e) st[kb][qb][e] = 0.f;
#pragma unroll
                for (int s = 0; s < 4; ++s) { const bf16x8 a = *(const LAS bf16x8*)(Kl + (32 * kb + c31) * 144 + (16 * s + 8 * hl) * 2);
                    st[kb][0] = MFMA32(a, qf[0][s], st[kb][0]); st[kb][1] = MFMA32(a, qf[1][s], st[kb][1]); }
            }
            if (t >= 4) { const int kpos0 = start - 128 + 64 * (tt_lo + t - 4);
#pragma unroll
                for (int kb = 0; kb < 2; ++kb)
#pragma unroll
                    for (int qb = 0; qb < 2; ++qb) { const int qpos = start + 64 * rh + 32 * qb + c31;
#pragma unroll
                        for (int e = 0; e < 16; ++e) { const int d = qpos - (kpos0 + 32 * kb + crow(e, hl)); if (d > 128 || d < -128) st[kb][qb][e] = -INFINITY; } }
            }
#pragma unroll
            for (int qb = 0; qb < 2; ++qb) {
                float mx = st[0][qb][0];
#pragma unroll
                for (int kb = 0; kb < 2; ++kb)
#pragma unroll
                    for (int e = 0; e < 16; ++e) mx = fmaxf(mx, st[kb][qb][e]);
                mx = fmaxf(mx, shx(mx, 32, lane));
                const float mn = fmaxf(mrun[qb], mx), alpha = __expf(mrun[qb] - mn); mrun[qb] = mn;
                float rs = 0.f;
#pragma unroll
                for (int kb = 0; kb < 2; ++kb)
#pragma unroll
                    for (int e = 0; e < 16; ++e) { const float pv = __expf(st[kb][qb][e] - mn); st[kb][qb][e] = pv; rs += pv; }
                rs += shx(rs, 32, lane);
                lrun[qb] = lrun[qb] * alpha + rs;
#pragma unroll
                for (int db = 0; db < 2; ++db)
#pragma unroll
                    for (int e = 0; e < 16; ++e) ot[db][qb][e] *= alpha;
            }
#pragma unroll
            for (int kb = 0; kb < 2; ++kb)
#pragma unroll
                for (int s2 = 0; s2 < 2; ++s2) {
                    bf16x8 pk[2];
#pragma unroll
                    for (int qb = 0; qb < 2; ++qb) { u32x4 w; w.x = cvtpk(st[kb][qb][8 * s2 + 0], st[kb][qb][8 * s2 + 1]); w.y = cvtpk(st[kb][qb][8 * s2 + 2], st[kb][qb][8 * s2 + 3]);
                        w.z = cvtpk(st[kb][qb][8 * s2 + 4], st[kb][qb][8 * s2 + 5]); w.w = cvtpk(st[kb][qb][8 * s2 + 6], st[kb][qb][8 * s2 + 7]); pk[qb] = __builtin_bit_cast(bf16x8, w); }
#pragma unroll
                    for (int db = 0; db < 2; ++db) {
                        const LAS unsigned char* vp = Vl + (32 * kb + 16 * s2 + 4 * hl + trq) * 144 + (32 * db + 16 * trb + 4 * trp) * 2;
                        const s16x4 lo = vtr(vp), hi = vtr(vp + 8 * 144);
                        const bf16x8 va = (bf16x8){lo[0], lo[1], lo[2], lo[3], hi[0], hi[1], hi[2], hi[3]};
                        ot[db][0] = MFMA32(va, pk[0], ot[db][0]); ot[db][1] = MFMA32(va, pk[1], ot[db][1]);
                    }
                }
        }
#undef TILE_ROW0
#pragma unroll
        for (int qb = 0; qb < 2; ++qb) { const float inv = 1.0f / lrun[qb]; bf16_t* op = O + (size_t)(qrow0 + 64 * rh + 32 * qb + c31) * QW + g * 256 + r * 64;
#pragma unroll
            for (int db = 0; db < 2; ++db)
#pragma unroll
                for (int gq = 0; gq < 4; ++gq) { u32x2 w; w.x = cvtpk(ot[db][qb][4 * gq] * inv, ot[db][qb][4 * gq + 1] * inv); w.y = cvtpk(ot[db][qb][4 * gq + 2] * inv, ot[db][qb][4 * gq + 3] * inv);
                    *(u32x2*)(op + 32 * db + 8 * gq + 4 * hl) = w; } }
    }
    __syncthreads();
}

#ifndef PHMASK
#define PHMASK 0xFFFF
#endif
#define PHON(k) (((PHMASK) >> (k)) & 1)
#ifndef REPMASK
#define REPMASK 0x0
#endif
#define REP(k) (((REPMASK) >> (k)) & 1)
#ifndef MK_PER_PHASE
#define MK_PER_PHASE 0
#endif
#define IN(k) (lo <= (k) && (k) < hi)
#define SEAM(k) do { if (IN(k) && IN((k) + 1)) xcd_barrier(bar); } while (0)
#define SITE_PTRS phase_enter(F); unsigned char* ws = F.ws; bf16_t* H = (bf16_t*)(ws + WS_H); bf16_t* BIG = (bf16_t*)(ws + WS_BIG); const float* MODV = (const float*)(ws + WS_MODV); (void)H; (void)BIG; (void)MODV; \
        unsigned char* wss = ws + WS_W + (size_t)lp * W_SSD_STRIDE; unsigned char* wsa = ws + WS_W + W_ATT0 + (size_t)lp * W_ATT_STRIDE; (void)wss; (void)wsa;
template <int lp, int c> __device__ __forceinline__ void moe_chunk(Frame& F, const Args& A, const int lo, const int hi, const XcdBarrier& bar, LAS unsigned char* ring) {
    constexpr int pb = 1 + lp * 19;
            const int pu = pb + 13 + 2 * c, pd = pu + 1;
            if (IN(pu) || IN(pd)) {
                SITE_PTRS
                MoeOrder mo;
                mo.pp[0] = 0;
#pragma unroll
                for (int e = 0; e < 8; ++e) { const int cn = (int)__hip_atomic_load((unsigned*)(F.ctl + CW_CNT + (size_t)(lp * 8 + e) * 64), RLX_AGENT); mo.cnt[e] = cn; mo.pp[e + 1] = mo.pp[e] + ((cn + 255) >> 8); }
                const int Ptot = mo.pp[8]; int nP = Ptot - c * MOE_CHUNK; nP = nP < 0 ? 0 : (nP > MOE_CHUNK ? MOE_CHUNK : nP);
                mo.cs = c * MOE_CHUNK; mo.rlist = (const int*)(ws + WS_RLIST);
                if (PHON(10) && IN(pu)) { mo.so.init(nP, 2 * DFFE / 256, F.G, (int)blockIdx.x); mo.GATHER_A = true; mo.bstride = (size_t)2 * DFFE * 1024 * 2;
                    pg8::Gemm g{H, (const bf16_t*)(ws + WS_BIG + BIG_MW13), 1024, 1024}; EpiSwiglu E{BIG, DFFE}; pg8::gemm_phase<EpiSwiglu, MoeOrder, true, true>(ring, g, mo, E, F.wave0); if (REP(10)) pg8::gemm_phase<EpiSwiglu, MoeOrder, true, true>(ring, g, mo, E, F.wave0); }
                SEAM(pu);
                if (PHON(11) && IN(pd)) { mo.so.init(nP, 4, F.G, (int)blockIdx.x); mo.GATHER_A = false; mo.bstride = (size_t)1024 * DFFE * 2;
                    pg8::Gemm g{BIG, (const bf16_t*)(ws + WS_BIG + BIG_MW2), DFFE, DFFE}; EpiMoeDown E{mo, (bf16_t*)(ws + WS_Y), (const float*)(ws + WS_GATE)}; pg8::gemm_phase<EpiMoeDown, MoeOrder, true, false>(ring, g, mo, E, F.wave0); if (REP(10)) pg8::gemm_phase<EpiMoeDown, MoeOrder, true, false>(ring, g, mo, E, F.wave0); }
            }
            SEAM(pd);
        }
template <int lp> __device__ __forceinline__ void layer_pair(Frame& F, const Args& A, const int lo, const int hi, const XcdBarrier& bar, LAS unsigned char* ring) {
        const int pb = 1 + lp * 19, i0 = 2 * lp, i1 = 2 * lp + 1;
        if (PHON(1) && IN(pb + 0)) norm_phase(F, A, i0, 0, lp == 0 ? 1 : 2);
        SEAM(pb + 0);
        if (PHON(2) && IN(pb + 1)) { SITE_PTRS pg8::Gemm g{H, (const bf16_t*)(wss + W_WIN), 1024, 1024}; pg8::StaticOrder S; S.init(NPAN, NXBC / 256, F.G, (int)blockIdx.x);
            EpiXbc E{BIG, (float*)(ws + WS_DT)}; pg8::gemm_phase<EpiXbc, pg8::StaticOrder, true, false>(ring, g, S, E, F.wave0); }
                if (REP(2)) { if (PHON(2) && IN(pb + 1)) { SITE_PTRS pg8::Gemm g{H, (const bf16_t*)(wss + W_WIN), 1024, 1024}; pg8::StaticOrder S; S.init(NPAN, NXBC / 256, F.G, (int)blockIdx.x);
            EpiXbc E{BIG, (float*)(ws + WS_DT)}; pg8::gemm_phase<EpiXbc, pg8::StaticOrder, true, false>(ring, g, S, E, F.wave0); } }
        SEAM(pb + 1);
        if (PHON(3) && IN(pb + 2)) scan_phase(F, A, lp);
                if (REP(3)) { if (PHON(3) && IN(pb + 2)) scan_phase(F, A, lp); }
        SEAM(pb + 2);
        if (PHON(4) && IN(pb + 3)) { SITE_PTRS pg8::Gemm g{H, (const bf16_t*)(wss + W_WZ), 1024, 1024}; pg8::StaticOrder S; S.init(NPAN, DIN / 256, F.G, (int)blockIdx.x);
            EpiGate E{(const bf16_t*)(ws + WS_Y), BIG, A.ssd_norm_w + (size_t)lp * DIN, (LAS float*)(F.lds + PSCR_OFF)}; pg8::gemm_phase<EpiGate, pg8::StaticOrder, true, false>(ring, g, S, E, F.wave0); }
                if (REP(2)) { if (PHON(4) && IN(pb + 3)) { SITE_PTRS pg8::Gemm g{H, (const bf16_t*)(wss + W_WZ), 1024, 1024}; pg8::StaticOrder S; S.init(NPAN, DIN / 256, F.G, (int)blockIdx.x);
            EpiGate E{(const bf16_t*)(ws + WS_Y), BIG, A.ssd_norm_w + (size_t)lp * DIN, (LAS float*)(F.lds + PSCR_OFF)}; pg8::gemm_phase<EpiGate, pg8::StaticOrder, true, false>(ring, g, S, E, F.wave0); } }
        SEAM(pb + 3);
        if (PHON(5) && IN(pb + 4)) { SITE_PTRS pg8::Gemm g{BIG, (const bf16_t*)(wss + W_WOUT), DIN, DIN}; pg8::StaticOrder S; S.init(NPAN, 4, F.G, (int)blockIdx.x);
            EpiResid E{ws, F.out, MODV + (size_t)i0 * 17 * 6144, 2, nullptr}; pg8::gemm_phase<EpiResid, pg8::StaticOrder, true, false>(ring, g, S, E, F.wave0); }
        SEAM(pb + 4);
        if (PHON(1) && IN(pb + 5)) norm_phase(F, A, i0, 1, 0);
                if (REP(1)) { if (PHON(1) && IN(pb + 5)) norm_phase(F, A, i0, 1, 0); }
        SEAM(pb + 5);
        if (PHON(6) && IN(pb + 6)) { SITE_PTRS pg8::Gemm g{H, (const bf16_t*)(wss + W_WUP), 1024, 1024}; pg8::StaticOrder S; S.init(NPAN, 2 * DFF / 256, F.G, (int)blockIdx.x);
            EpiSwiglu E{BIG, DFF}; pg8::gemm_phase<EpiSwiglu, pg8::StaticOrder, true, false>(ring, g, S, E, F.wave0); }
                if (REP(2)) { if (PHON(6) && IN(pb + 6)) { SITE_PTRS pg8::Gemm g{H, (const bf16_t*)(wss + W_WUP), 1024, 1024}; pg8::StaticOrder S; S.init(NPAN, 2 * DFF / 256, F.G, (int)blockIdx.x);
            EpiSwiglu E{BIG, DFF}; pg8::gemm_phase<EpiSwiglu, pg8::StaticOrder, true, false>(ring, g, S, E, F.wave0); } }
        SEAM(pb + 6);
        if (PHON(5) && IN(pb + 7)) { SITE_PTRS pg8::Gemm g{BIG, (const bf16_t*)(wss + W_WDN), DFF, DFF}; pg8::StaticOrder S; S.init(NPAN, 4, F.G, (int)blockIdx.x);
            EpiResid E{ws, F.out, MODV + (size_t)i0 * 17 * 6144, 5, nullptr}; pg8::gemm_phase<EpiResid, pg8::StaticOrder, true, false>(ring, g, S, E, F.wave0); }
        SEAM(pb + 7);
        if (PHON(1) && IN(pb + 8)) norm_phase(F, A, i1, 0, 0);
                if (REP(1)) { if (PHON(1) && IN(pb + 8)) norm_phase(F, A, i1, 0, 0); }
        SEAM(pb + 8);
        if (PHON(7) && IN(pb + 9)) { SITE_PTRS pg8::Gemm g{H, (const bf16_t*)(wsa + W_WQKV), 1024, 1024}; pg8::StaticOrder S; S.init(NPAN, NQKV / 256, F.G, (int)blockIdx.x);
            EpiQkv E{BIG, (bf16_t*)(ws + WS_BIG + BIG_K), (bf16_t*)(ws + WS_BIG + BIG_V), A.attn_b_qkv + (size_t)lp * NQKV, (const float*)(ws + WS_ROPE)};
            pg8::gemm_phase<EpiQkv, pg8::StaticOrder, true, false>(ring, g, S, E, F.wave0); }
                if (REP(2)) { if (PHON(7) && IN(pb + 9)) { SITE_PTRS pg8::Gemm g{H, (const bf16_t*)(wsa + W_WQKV), 1024, 1024}; pg8::StaticOrder S; S.init(NPAN, NQKV / 256, F.G, (int)blockIdx.x);
            EpiQkv E{BIG, (bf16_t*)(ws + WS_BIG + BIG_K), (bf16_t*)(ws + WS_BIG + BIG_V), A.attn_b_qkv + (size_t)lp * NQKV, (const float*)(ws + WS_ROPE)};
            pg8::gemm_phase<EpiQkv, pg8::StaticOrder, true, false>(ring, g, S, E, F.wave0); } }
        SEAM(pb + 9);
        if (PHON(8) && IN(pb + 10)) attn_phase(F, A, lp, lp == 0);
                if (REP(8)) { if (PHON(8) && IN(pb + 10)) attn_phase(F, A, lp, lp == 0); }
        SEAM(pb + 10);
        if (PHON(5) && IN(pb + 11)) { SITE_PTRS pg8::Gemm g{(const bf16_t*)(ws + WS_BIG + BIG_O), (const bf16_t*)(wsa + W_WO), 1024, 1024}; pg8::StaticOrder S; S.init(NPAN, 4, F.G, (int)blockIdx.x);
            EpiResid E{ws, F.out, MODV + (size_t)i1 * 17 * 6144, 2, A.attn_b_o + (size_t)lp * 1024}; pg8::gemm_phase<EpiResid, pg8::StaticOrder, true, false>(ring, g, S, E, F.wave0); }
        SEAM(pb + 11);
        if (PHON(9) && IN(pb + 12)) { norm_phase(F, A, i1, 1, 4 | (lp == 1 ? 16 : 0)); __syncthreads(); moe_convert(F, A, lp); }
        SEAM(pb + 12);
    moe_chunk<lp, 0>(F, A, lo, hi, bar, ring); moe_chunk<lp, 1>(F, A, lo, hi, bar, ring); moe_chunk<lp, 2>(F, A, lo, hi, bar, ring);
}
constexpr int N_PHASES = 40;
__global__ void __launch_bounds__(NWAVES * 64, 2) fwd_kernel(Args A) {
    extern __shared__ __attribute__((aligned(16))) unsigned char lds_raw[];
    Frame F;
    F.lds = (LAS unsigned char*)lds_raw;
    F.tid = threadIdx.x; F.lane = F.tid & 63; F.wave = __builtin_amdgcn_readfirstlane(F.tid >> 6); F.wave0 = F.wave; F.G = gridDim.x;
    F.ws0 = A.ws; F.out0 = A.out; F.ws = A.ws; F.ctl = (gu32*)(A.ws + WS_CTL); F.out = A.out;
    volatile LAS unsigned* MISC = (volatile LAS unsigned*)(F.lds + MISC_OFF);
    for (int u = F.tid; u < (LDS_BYTES - LDSCTL_OFF) / 4; u += NWAVES * 64) ((LAS unsigned*)(F.lds + LDSCTL_OFF))[u] = 0u;
    __syncthreads();
    const int lo = A.ph_lo, hi = A.ph_hi;
    XcdBarrier bar; bar.bar = (unsigned*)(F.ctl + CW_BAR); bar.x = 0; bar.st = MISC + 8; bar.wave0 = F.wave0;
    if (hi - lo > 1) bar = xcd_barrier_post((unsigned*)(F.ctl + CW_BAR), MISC + 8, F.wave0);
    LAS unsigned char* ring = F.lds;

    if (PHON(0) && IN(0)) p0_prologue(F, A);
    SEAM(0);
    layer_pair<0>(F, A, lo, hi, bar, ring);
    layer_pair<1>(F, A, lo, hi, bar, ring);
    if (PHON(1) && IN(39)) {
        norm_phase(F, A, 4, 0, 2 | 8);
        if (xb_ld((unsigned*)(F.ctl + CW_BAR) + XB_TMO) != 0u) {
            const float qn = __builtin_nanf("");
            for (size_t idx = (size_t)blockIdx.x * 512 + F.tid; idx < (size_t)NB * SEQ * DM / 4; idx += (size_t)F.G * 512) ((f32x4*)A.out)[idx] = (f32x4){qn, qn, qn, qn};
        }
    }
#undef IN
#undef SEAM
}

extern "C" void kernel_launch(void* const* d_in, const int* in_sizes, int n_in, void* d_out, int out_size, void* d_ws, size_t ws_size, hipStream_t stream) {
    static int grid = 0;
    if (grid == 0) {
        if (n_in != 29 || in_sizes[0] != NB * SEQ * DM || out_size != NB * SEQ * DM || ws_size < WS_END) {
            fprintf(stderr, "kernel_launch: unexpected problem: n_in %d, in0 %d, out %d, ws %zu (need %zu); nothing launched\n", n_in, n_in > 0 ? in_sizes[0] : -1, out_size, ws_size, (size_t)WS_END); grid = -1; return; }
        int dev = 0, cus = 0, per_cu = 0;
        if (hipGetDevice(&dev) != hipSuccess || hipDeviceGetAttribute(&cus, hipDeviceAttributeMultiprocessorCount, dev) != hipSuccess) { fprintf(stderr, "kernel_launch: device query failed\n"); grid = -1; return; }
        if (hipFuncSetAttribute((const void*)fwd_kernel, hipFuncAttributeMaxDynamicSharedMemorySize, LDS_BYTES) != hipSuccess) { fprintf(stderr, "kernel_launch: hipFuncSetAttribute failed\n"); grid = -1; return; }
        if (hipOccupancyMaxActiveBlocksPerMultiprocessor(&per_cu, (const void*)fwd_kernel, NWAVES * 64, LDS_BYTES) != hipSuccess || per_cu < 1)
            fprintf(stderr, "kernel_launch: note: occupancy query reports %d workgroups per CU\n", per_cu);
        (void)hipGetLastError();
        grid = cus;
    }
    if (grid < 0) return;
    if (hipMemsetAsync((char*)d_ws + WS_CTL, 0, CTL_ZERO_BYTES, stream) != hipSuccess) { fprintf(stderr, "kernel_launch: memset failed\n"); return; }
    Args a{};
    const float** ap = (const float**)&a;
    for (int i = 0; i < 29; ++i) ap[i] = (const float*)d_in[i];
    a.out = (float*)d_out; a.ws = (unsigned char*)d_ws;
#if MK_PER_PHASE
    for (int k = 0; k < N_PHASES; ++k) { a.ph_lo = k; a.ph_hi = k + 1; hipLaunchKernelGGL(fwd_kernel, dim3(grid), dim3(NWAVES * 64), LDS_BYTES, stream, a); }
#else
    a.ph_lo = 0; a.ph_hi = N_PHASES;
    hipLaunchKernelGGL(fwd_kernel, dim3(grid), dim3(NWAVES * 64), LDS_BYTES, stream, a);
#endif
    const hipError_t le = hipPeekAtLastError();
    if (le != hipSuccess) fprintf(stderr, "kernel_launch: launch failed: %s\n", hipGetErrorName(le));
}
```

```cpp
#include <hip/hip_runtime.h>
#include <cstdio>
#include <cstdint>

#define LAS __attribute__((address_space(3)))
#define GAS __attribute__((address_space(1)))
typedef unsigned short bf16_t;
typedef short bf16x8 __attribute__((ext_vector_type(8)));
typedef short s16x4 __attribute__((ext_vector_type(4)));
typedef float f32x4 __attribute__((ext_vector_type(4)));
typedef float f32x2 __attribute__((ext_vector_type(2)));
typedef float f32x16 __attribute__((ext_vector_type(16)));
typedef unsigned u32x4 __attribute__((ext_vector_type(4)));
typedef unsigned u32x2 __attribute__((ext_vector_type(2)));
typedef GAS unsigned gu32;

namespace pg8 {
constexpr int BM = 256, BK = 64, HALF = 128, HTB = HALF * BK * 2  , STAGE_BYTES = 8 * HTB, NXCD = 8, WGM = 8;

__host__ __device__ __forceinline__ int lds_byte(int r, int c) { const int st = (r >> 4) * 2 + (c >> 5), rr = r & 15, cc = c & 31, ob = rr * 64 + cc * 2; return st * 1024 + (ob ^ (((ob >> 9) & 1) << 5)); }
__host__ __device__ __forceinline__ void stage_rc(int b, int& R, int& C) { const int st = b / 1024, sb = b % 1024, swz = sb ^ (((sb >> 9) & 1) << 5); R = (st >> 1) * 16 + swz / 64; C = (st & 1) * 32 + (swz % 64) / 2; }
__host__ __device__ __forceinline__ int perm32(int rho) { const int n = rho >> 4, i = rho & 15; return 8 * (i >> 2) + 4 * n + (i & 3); }

struct Unit { int pm, pn; };
struct Gemm { const bf16_t* A; const bf16_t* Bt; int lda, K; };

struct StaticOrder {
    int nM, nN, nwg, G, c;
    __device__ void init(int nM_, int nN_, int G_, int c_) { nM = nM_; nN = nN_; nwg = nM * nN; G = G_; c = c_; }
    __device__ bool next(int i, Unit& u) const {
        const long L = (long)i * G + c; if (L >= nwg) return false;
        int wgid = (int)L; { const int q = nwg / NXCD, r = nwg % NXCD, xcd = wgid % NXCD, off = wgid / NXCD; wgid = (xcd < r ? xcd * (q + 1) : r * (q + 1) + (xcd - r) * q) + off; }
        const int nig = WGM * nN, gid = wgid / nig, fm = gid * WGM, gsz = (nM - fm) < WGM ? (nM - fm) : WGM;
        u.pm = fm + ((wgid % nig) % gsz); u.pn = (wgid % nig) / gsz; return true;
    }
    __device__ __forceinline__ const char* a_base(const Gemm& g, const Unit& u) const { return (const char*)g.A + (size_t)u.pm * (size_t)(BM * 2) * g.lda; }
    __device__ __forceinline__ const char* b_base(const Gemm& g, const Unit& u) const { return (const char*)g.Bt + (size_t)u.pn * (size_t)(BM * 2) * g.K; }
    __device__ __forceinline__ unsigned row_off(const Gemm& g, const Unit&, int r) const { return (unsigned)r * (unsigned)g.lda * 2u; }
};

__device__ __forceinline__ unsigned cvt_pk_bf16(float lo, float hi) { unsigned r; asm volatile("v_cvt_pk_bf16_f32 %0, %1, %2" : "=v"(r) : "v"(lo), "v"(hi)); return r; }

template <class Epi, class Sched, bool ALIGN_EPI, bool GATHER>
__device__ __forceinline__ void gemm_phase(LAS unsigned char* lds, const Gemm g, const Sched& S, const Epi& E, const int wave0) {
    int tid_ = wave0 * 64 + (int)__builtin_amdgcn_mbcnt_hi(~0u, __builtin_amdgcn_mbcnt_lo(~0u, 0u)); asm volatile("" : "+v"(tid_));
    const int tid = tid_, wid = __builtin_amdgcn_readfirstlane(tid >> 6), lane = tid & 63, wr = wid >> 2, wc = wid & 3, fr = lane & 15, fq = lane >> 4;
    const int K = g.K, nt = K / BK;
    unsigned voffB[2];
#pragma unroll
    for (int i = 0; i < 2; ++i) { int R, C; stage_rc(tid * 16 + i * 8192, R, C); const int Rb = Epi::PERM ? ((R & ~31) + perm32(R & 31)) : R; voffB[i] = (unsigned)(Rb * K + C) * 2u; }
    const size_t kstep = (size_t)(BK * 2);
    const size_t hstepB = (size_t)HALF * K * 2;
    const unsigned ldsw = (unsigned)wid * 1024u;
    const int aoff = lds_byte(wr * 64 + fr, fq * 8), boff = lds_byte(wc * 32 + fr, fq * 8);
#define PG8_SA(b, h) (((b) * 2 + (h)) * HTB)
#define PG8_SB(b, h) ((4 + (b) * 2 + (h)) * HTB)
#define PG8_STAGE(bufoff, gbase, voff) do { _Pragma("unroll") for (int _i = 0; _i < 2; ++_i) \
        __builtin_amdgcn_global_load_lds((const unsigned*)((const char*)(gbase) + (voff)[_i]), (LAS unsigned*)(lds + (bufoff) + ldsw + _i * 8192), 16, 0, 0); } while (0)
#define PG8_LDA(dst, b, h) do { _Pragma("unroll") for (int m = 0; m < 4; ++m) _Pragma("unroll") for (int k = 0; k < 2; ++k) dst[m][k] = *(const LAS bf16x8*)(lds + PG8_SA(b, h) + aoff + m * 2048 + k * 1024); } while (0)
#define PG8_LDB(dst, b, h) do { _Pragma("unroll") for (int n = 0; n < 2; ++n) _Pragma("unroll") for (int k = 0; k < 2; ++k) dst[n][k] = *(const LAS bf16x8*)(lds + PG8_SB(b, h) + boff + n * 2048 + k * 1024); } while (0)
#define PG8_MMA(ai, bj, At, Bt) do { __builtin_amdgcn_s_setprio(1); _Pragma("unroll") for (int m = 0; m < 4; ++m) _Pragma("unroll") for (int n = 0; n < 2; ++n) _Pragma("unroll") for (int k = 0; k < 2; ++k) \
        acc[ai][bj][m][n] = __builtin_amdgcn_mfma_f32_16x16x32_bf16(Bt[n][k], At[m][k], acc[ai][bj][m][n], 0, 0, 0); __builtin_amdgcn_s_setprio(0); } while (0)
#define PG8_WAIT_V(n) asm volatile("s_waitcnt vmcnt(" #n ")" ::: "memory")
#define PG8_WAIT_L(n) asm volatile("s_waitcnt lgkmcnt(" #n ")" ::: "memory")
#define PG8_BAR __builtin_amdgcn_s_barrier()
#define PG8_SCHED __builtin_amdgcn_sched_barrier(0)
    Unit cur, nxt; int ui = 0;
    if (!S.next(0, cur)) return;
    f32x4 acc[2][2][4][2];
#pragma unroll
    for (int a = 0; a < 2; ++a)
#pragma unroll
        for (int b = 0; b < 2; ++b)
#pragma unroll
            for (int m = 0; m < 4; ++m)
#pragma unroll
                for (int n = 0; n < 2; ++n) acc[a][b][m][n] = (f32x4){0.f, 0.f, 0.f, 0.f};
    bf16x8 At[4][2], B0[2][2], B1[2][2];
    const char* cA = S.a_base(g, cur); const char* cB = S.b_base(g, cur);
    unsigned va[2][2], vn[2][2];
#pragma unroll
    for (int h = 0; h < 2; ++h)
#pragma unroll
        for (int i = 0; i < 2; ++i) { int R, C; stage_rc(tid * 16 + i * 8192, R, C); va[h][i] = S.row_off(g, cur, h * HALF + R) + (unsigned)C * 2u; vn[h][i] = va[h][i]; }
    PG8_STAGE(PG8_SB(0, 0), cB, voffB); PG8_STAGE(PG8_SB(0, 1), cB + hstepB, voffB); PG8_STAGE(PG8_SA(0, 0), cA, va[0]); PG8_STAGE(PG8_SA(0, 1), cA, va[1]);
    if (wr == 1) PG8_BAR;
    PG8_WAIT_V(2); PG8_BAR;
    PG8_STAGE(PG8_SB(1, 0), cB + kstep, voffB); PG8_STAGE(PG8_SA(1, 0), cA + kstep, va[0]); PG8_STAGE(PG8_SB(1, 1), cB + hstepB + kstep, voffB);
    PG8_WAIT_V(6); PG8_BAR;
    for (;;) {
        const bool has_next = S.next(ui + 1, nxt);
        const char* nA = has_next ? S.a_base(g, nxt) : cA; const char* nB = has_next ? S.b_base(g, nxt) : cB;
        if (GATHER) {
            if (has_next) {
#pragma unroll
                for (int h = 0; h < 2; ++h)
#pragma unroll
                    for (int i = 0; i < 2; ++i) { int R, C; stage_rc(tid * 16 + i * 8192, R, C); vn[h][i] = S.row_off(g, nxt, h * HALF + R) + (unsigned)C * 2u; }
            } else {
#pragma unroll
                for (int h = 0; h < 2; ++h)
#pragma unroll
                    for (int i = 0; i < 2; ++i) vn[h][i] = va[h][i];
            }
        }
        for (int t = 0; t < nt; t += 2) {
            const bool last = (t == nt - 2);
            const char* a1 = cA + (size_t)(t + 1) * kstep;
            const char* a2 = last ? nA : cA + (size_t)(t + 2) * kstep; const char* b2 = last ? nB : cB + (size_t)(t + 2) * kstep;
            const char* a3 = a2 + kstep; const char* b3 = b2 + kstep;
            unsigned v2[2][2];
#pragma unroll
            for (int h = 0; h < 2; ++h)
#pragma unroll
                for (int i = 0; i < 2; ++i) v2[h][i] = (GATHER && last) ? vn[h][i] : va[h][i];
            PG8_LDB(B0, 0, 0); PG8_LDB(B1, 0, 1); PG8_SCHED; PG8_LDA(At, 0, 0); PG8_STAGE(PG8_SA(1, 1), a1, va[1]);
            PG8_WAIT_V(8); PG8_WAIT_L(0); PG8_BAR; PG8_MMA(0, 0, At, B0); PG8_MMA(0, 1, At, B1); PG8_BAR; PG8_SCHED;
            PG8_LDA(At, 0, 1); PG8_STAGE(PG8_SB(0, 0), b2, voffB); PG8_STAGE(PG8_SB(0, 1), b2 + hstepB, voffB); PG8_STAGE(PG8_SA(0, 0), a2, v2[0]);
            PG8_WAIT_V(8); PG8_WAIT_L(0); PG8_BAR; PG8_MMA(1, 0, At, B0); PG8_MMA(1, 1, At, B1); PG8_BAR; PG8_SCHED;
            PG8_LDB(B0, 1, 0); PG8_LDB(B1, 1, 1); PG8_SCHED; PG8_LDA(At, 1, 0); PG8_STAGE(PG8_SA(0, 1), a2, v2[1]);
            PG8_WAIT_V(8); PG8_WAIT_L(0); PG8_BAR; PG8_MMA(0, 0, At, B0); PG8_MMA(0, 1, At, B1); PG8_BAR; PG8_SCHED;
            PG8_LDA(At, 1, 1); PG8_STAGE(PG8_SB(1, 0), b3, voffB); PG8_STAGE(PG8_SB(1, 1), b3 + hstepB, voffB); PG8_STAGE(PG8_SA(1, 0), a3, v2[0]);
            PG8_WAIT_V(8); PG8_WAIT_L(0); PG8_BAR; PG8_MMA(1, 0, At, B0); PG8_MMA(1, 1, At, B1); PG8_BAR; PG8_SCHED;
        }
        if constexpr (ALIGN_EPI) { if (wr == 0) PG8_BAR; }
        { int l2 = (int)__builtin_amdgcn_mbcnt_hi(~0u, __builtin_amdgcn_mbcnt_lo(~0u, 0u)); asm volatile("" : "+v"(l2)); E(acc, cur, wr, wc, l2 & 15, l2 >> 4); }
        if (!has_next) break;
#pragma unroll
        for (int a = 0; a < 2; ++a)
#pragma unroll
            for (int b = 0; b < 2; ++b)
#pragma unroll
                for (int m = 0; m < 4; ++m)
#pragma unroll
                    for (int n = 0; n < 2; ++n) acc[a][b][m][n] = (f32x4){0.f, 0.f, 0.f, 0.f};
        cur = nxt; cA = nA; cB = nB; ++ui;
        if (GATHER) {
#pragma unroll
            for (int h = 0; h < 2; ++h)
#pragma unroll
                for (int i = 0; i < 2; ++i) va[h][i] = vn[h][i];
        }
        if constexpr (ALIGN_EPI) { if (wr == 1) PG8_BAR; }
    }
    PG8_WAIT_V(0);
    if constexpr (!ALIGN_EPI) { if (wr == 0) PG8_BAR; }
    PG8_BAR;
#undef PG8_SA
#undef PG8_SB
#undef PG8_STAGE
#undef PG8_LDA
#undef PG8_LDB
#undef PG8_MMA
#undef PG8_WAIT_V
#undef PG8_WAIT_L
#undef PG8_BAR
#undef PG8_SCHED
}
}

constexpr int DM = 1024, NB = 16, SEQ = 4096, NCTX = 256, SROW = SEQ + NCTX  , MROWS = NB * SROW  , NPAN = MROWS / 256  ;
constexpr int DIN = 2048, CONVCH = 4096, SSD_IN = 6208, NXBC = 4352  ;
constexpr int QW = 1024, KVW = 256, NQKV = 1536;
constexpr int DFF = 2816, NEXP = 8, DFFE = 3584;
constexpr float EPS = 1e-6f;
constexpr int MOE_CHUNK = 184;
constexpr int NWAVES = 8;

constexpr size_t MiB = 1u << 20;
constexpr size_t WS_CTL = 0, CTL_ZERO_BYTES = 1 * MiB;
constexpr size_t WS_MODV = 2 * MiB;
constexpr size_t WS_ROPE = 4 * MiB;
constexpr size_t WS_GATE = 5 * MiB;
constexpr size_t WS_RLIST = 6 * MiB;
constexpr size_t WS_CX = 10 * MiB;
constexpr size_t WS_W = 26 * MiB;
constexpr size_t W_SSD_STRIDE = 33 * MiB, W_WZ = 0, W_WIN = 4 * MiB, W_WOUT = 12 * MiB + MiB / 2, W_WUP = 16 * MiB + MiB / 2, W_WDN = 27 * MiB + MiB / 2;
constexpr size_t W_ATT0 = 66 * MiB, W_ATT_STRIDE = 5 * MiB, W_WQKV = 0, W_WO = 3 * MiB;
constexpr size_t WS_H = 102 * MiB;
constexpr size_t WS_BIG = 238 * MiB;
constexpr size_t BIG_K = 136 * MiB, BIG_V = 170 * MiB, BIG_O = 204 * MiB, BIG_MW13 = 322 * MiB, BIG_MW2 = 434 * MiB;
constexpr size_t WS_Y = 782 * MiB;
constexpr size_t WS_DT = 1054 * MiB;
constexpr size_t WS_HALO = 1071 * MiB;
constexpr size_t WS_END = 1080 * MiB;
constexpr int CW_BAR = 4096;
constexpr int CW_CNT = 16384;

constexpr int RING_BYTES = 131072;
constexpr int PSCR_OFF = 131072;
constexpr int LDSCTL_OFF = 151552, MISC_OFF = LDSCTL_OFF + 320;
constexpr int LDS_BYTES = 155648;

#define RLX_AGENT __ATOMIC_RELAXED, __HIP_MEMORY_SCOPE_AGENT
#define LDS_WAIT() asm volatile("s_waitcnt lgkmcnt(0)" ::: "memory")
#define VM_WAIT() asm volatile("s_waitcnt vmcnt(0)" ::: "memory")
__device__ __forceinline__ unsigned f2bf(float f) { unsigned u = __builtin_bit_cast(unsigned, f); return (u + 0x7fffu + ((u >> 16) & 1u)) >> 16; }
__device__ __forceinline__ unsigned pk2(float lo, float hi) { return f2bf(lo) | (f2bf(hi) << 16); }
__device__ __forceinline__ float bf_lo(unsigned u) { return __builtin_bit_cast(float, u << 16); }
__device__ __forceinline__ float bf_hi(unsigned u) { return __builtin_bit_cast(float, u & 0xffff0000u); }
__device__ __forceinline__ float bf1(bf16_t h) { return __builtin_bit_cast(float, (unsigned)h << 16); }
__device__ __forceinline__ float siluf(float v) { return v * __builtin_amdgcn_rcpf(1.0f + __expf(-v)); }
__device__ __forceinline__ float shx(float v, int mask, int lane) { return __builtin_bit_cast(float, __builtin_amdgcn_ds_bpermute((lane ^ mask) << 2, __builtin_bit_cast(int, v))); }
__device__ __forceinline__ float wave_sum(float v, int lane) {
#pragma unroll
    for (int o = 1; o < 64; o <<= 1) v += shx(v, o, lane);
    return v;
}

__device__ __forceinline__ int lane_id() { return (int)__builtin_amdgcn_mbcnt_hi(~0u, __builtin_amdgcn_mbcnt_lo(~0u, 0u)); }
#define XB_TMO      128
#define XB_XCNT(j)  (256  + 64 * (j))
#define XB_XSUB(j)  (1280 + 64 * (j))
#define XB_XGEN(j)  (2304 + 64 * (j))
#define XB_TOP      3328
#define XB_TOPGEN   3392
#define XCD_BAR_WORDS 3456
#define XB_SPIN_CAP (1u << 18)

__device__ __forceinline__ unsigned xb_ld(unsigned* p)              { return __hip_atomic_load(p, __ATOMIC_RELAXED, __HIP_MEMORY_SCOPE_AGENT); }
__device__ __forceinline__ unsigned xb_add(unsigned* p, unsigned v) { return __hip_atomic_fetch_add(p, v, __ATOMIC_RELAXED, __HIP_MEMORY_SCOPE_AGENT); }
__device__ __forceinline__ unsigned xb_xcc_id() { return (unsigned)__builtin_amdgcn_s_getreg((3 << 11) | 20) & 0xFu; }
#define XB_SPIN(cond, bar) do { unsigned _sp = 0; while (cond) { __builtin_amdgcn_s_sleep(1); \
    if ((++_sp & 255u) == 0u) { if (xb_ld(&(bar)[XB_TMO])) break; if (_sp > XB_SPIN_CAP) { atomicAdd(&(bar)[XB_TMO], 1u); break; } } } } while (0)

struct XcdBarrier {
    unsigned* bar; unsigned x;
    volatile LAS unsigned* st;
    int wave0;
};
__device__ __forceinline__ XcdBarrier xcd_barrier_post(unsigned* bar, volatile LAS unsigned* st, int wave0) {
    XcdBarrier b; b.bar = bar; b.x = xb_xcc_id(); b.st = st; b.wave0 = wave0;
    if (wave0 == 0 && lane_id() == 0) (void)xb_add(&bar[XB_XCNT(b.x)], 1u);
    return b;
}
__device__ __forceinline__ void xcd_barrier_complete(unsigned* bar, unsigned x, unsigned& nloc, unsigned& nx) {
    const unsigned G = gridDim.x * gridDim.y * gridDim.z;
    unsigned sum, cnt, mine, sp = 0u;
    for (;;) {
        sum = 0u; cnt = 0u; mine = 0u;
#pragma unroll
        for (unsigned j = 0; j < 16; ++j) { const unsigned c = xb_ld(&bar[XB_XCNT(j)]); sum += c; cnt += (c > 0u) ? 1u : 0u; mine = (j == x) ? c : mine; }
        if (sum == G) break;
        __builtin_amdgcn_s_sleep(1);
        if ((++sp & 255u) == 0u) { if (xb_ld(&bar[XB_TMO])) break; if (sp > XB_SPIN_CAP) { atomicAdd(&bar[XB_TMO], 1u); break; } }
    }
    nloc = mine > 0u ? mine : 1u; nx = cnt > 0u ? cnt : 1u;
}
__device__ __forceinline__ void xcd_barrier(const XcdBarrier& b) {
    asm volatile("s_waitcnt vmcnt(0)" ::: "memory");
    __syncthreads();
    if (b.wave0 == 0 && lane_id() == 0) {
        unsigned* bar = b.bar;
        __builtin_amdgcn_s_waitcnt(0);
        unsigned nloc = b.st[0], nx = b.st[1];
        if (nloc == 0u) { xcd_barrier_complete(bar, b.x, nloc, nx); b.st[0] = nloc; b.st[1] = nx; }
        const unsigned old = xb_add(&bar[XB_XSUB(b.x)], 1u);
        const unsigned gen = old / nloc;
        if (old + 1u == (gen + 1u) * nloc) {
            __builtin_amdgcn_fence(__ATOMIC_RELEASE, "agent");
            asm volatile("s_waitcnt vmcnt(0)" ::: "memory");
            const unsigned og = xb_add(&bar[XB_TOP], 1u);
            const unsigned tg = og / nx;
            if (og + 1u == (tg + 1u) * nx) xb_add(&bar[XB_TOPGEN], 1u);
            else XB_SPIN(xb_ld(&bar[XB_TOPGEN]) == tg, bar);
            __builtin_amdgcn_fence(__ATOMIC_ACQUIRE, "agent");
            xb_add(&bar[XB_XGEN(b.x)], 1u);
            asm volatile("s_waitcnt vmcnt(0)" ::: "memory");
        } else {
            XB_SPIN(xb_ld(&bar[XB_XGEN(b.x)]) == gen, bar);
            __builtin_amdgcn_fence(__ATOMIC_ACQUIRE, "agent");
            asm volatile("s_waitcnt vmcnt(0)" ::: "memory");
        }
    }
    __syncthreads();
}

struct Args {
    const float *x, *c, *ctx, *c_ctx, *w_mod, *b_mod, *norm1_w, *norm2_w, *ssd_w_in, *ssd_conv_w, *ssd_conv_b, *ssd_dt_bias, *ssd_a_log, *ssd_d, *ssd_norm_w, *ssd_w_out,
                *attn_w_qkv, *attn_b_qkv, *attn_sink, *attn_w_o, *attn_b_o, *ffn_w1, *ffn_w3, *ffn_w2, *moe_router, *moe_w1, *moe_w3, *moe_w2, *final_norm_w;
    float* out; unsigned char* ws; int ph_lo, ph_hi;
};
struct Frame {
    LAS unsigned char* lds;
    int tid, lane, wave, G;
    unsigned char* ws; gu32* ctl; float* out;
    unsigned char* ws0; float* out0; int wave0;
};
__device__ __forceinline__ void phase_enter(Frame& F) { int l = lane_id(); asm volatile("" : "+v"(l)); F.lane = l; F.wave = F.wave0; F.tid = F.wave0 * 64 + l;
    unsigned char* w = F.ws0; float* o = F.out0; asm volatile("" : "+s"(w), "+s"(o)); F.ws = w; F.ctl = (gu32*)(w + WS_CTL); F.out = o; }
__device__ __forceinline__ float* resid_row(const Frame& F, int R) {
    const int b = R / SROW, s = R - b * SROW;
    return s < NCTX ? (float*)(F.ws + WS_CX) + (size_t)(b * NCTX + s) * DM : F.out + (size_t)(b * SEQ + s - NCTX) * DM;
}
__device__ __forceinline__ float* resid_panel(const Frame& F, int pm, int& cond) {
    const int b = pm / 17, j = pm - b * 17; cond = j == 0 ? 16 : b;
    return j == 0 ? (float*)(F.ws + WS_CX) + (size_t)(b * NCTX) * DM : F.out + (size_t)(b * SEQ + (j - 1) * 256) * DM;
}

__device__ __forceinline__ void transpose_item(const float* W, int ldw, int col0, int ncb, int K, bf16_t* WT, int mode, int half, LAS float* scr, int item, int lane) {
    const int kb = item / ncb, nb = item - kb * ncb, k0 = 64 * kb, n0 = 32 * nb;
#pragma unroll 8
    for (int i = 0; i < 32; ++i) { const int kk = 2 * i + (lane >> 5); scr[kk * 33 + (lane & 31)] = W[(size_t)(k0 + kk) * ldw + col0 + n0 + (lane & 31)]; }
    LDS_WAIT(); asm volatile("" ::: "memory");
    const int c = lane & 7;
#pragma unroll
    for (int j = 0; j < 4; ++j) { const int n = (lane >> 3) + 8 * j; const LAS float* s = scr + (8 * c) * 33 + n;
        u32x4 o; o.x = pk2(s[0 * 33], s[1 * 33]); o.y = pk2(s[2 * 33], s[3 * 33]); o.z = pk2(s[4 * 33], s[5 * 33]); o.w = pk2(s[6 * 33], s[7 * 33]);
        const int cl = n0 + n; const int drow = mode == 0 ? cl : ((cl >> 7) * 256 + half * 128 + (cl & 127));
        *(GAS u32x4*)(WT + (size_t)drow * K + k0 + 8 * c) = o; }
    LDS_WAIT(); asm volatile("" ::: "memory");
}
__device__ __forceinline__ void p0_prologue(Frame& F, const Args& A) {
    phase_enter(F);
    {
        LAS float* sc = (LAS float*)F.lds;
        LAS float* red = (LAS float*)(F.lds + 81920);
        for (int idx = F.tid; idx < 17 * 1024; idx += 512) { const int cb = idx >> 10, k = idx & 1023; const float v = cb < 16 ? A.c[cb * 1024 + k] : A.c_ctx[k]; sc[k * 20 + cb] = v / (1.0f + expf(-v)); }
        __syncthreads();
        float* MODV = (float*)(F.ws + WS_MODV);
        for (int item = blockIdx.x; item < 4 * 96; item += F.G) {
            const int i = item / 96, cblk = item - i * 96;
            const float* Wm = A.w_mod + (size_t)i * 1024 * 6144 + cblk * 64 + F.lane;
            float acc[17];
#pragma unroll
            for (int cb = 0; cb < 17; ++cb) acc[cb] = 0.f;
            const int k0 = F.wave * 128;
#pragma unroll 4
            for (int kk = 0; kk < 128; ++kk) { const int k = k0 + kk; const float w = Wm[(size_t)k * 6144]; const LAS float* s = sc + k * 20;
#pragma unroll
                for (int cb = 0; cb < 17; ++cb) acc[cb] += s[cb] * w; }
#pragma unroll
            for (int cb = 0; cb < 17; ++cb) red[(F.wave * 17 + cb) * 64 + F.lane] = acc[cb];
            __syncthreads();
            for (int idx = F.tid; idx < 17 * 64; idx += 512) { const int cb = idx >> 6, l = idx & 63; float s = 0.f;
#pragma unroll
                for (int w = 0; w < 8; ++w) s += red[(w * 17 + cb) * 64 + l];
                MODV[(size_t)(i * 17 + cb) * 6144 + cblk * 64 + l] = s + A.b_mod[i * 6144 + cblk * 64 + l]; }
            __syncthreads();
        }
    }
    if (blockIdx.x == 0) { float* RT = (float*)(F.ws + WS_ROPE);
        for (int idx = F.tid; idx < 1024; idx += 512) { const int id = idx >> 4, f = idx & 15; const float inv = __builtin_amdgcn_exp2f(-(float)f * (13.287712379549449f / 16.0f)); const float ang = (float)id * inv;
            RT[idx] = __cosf(ang); RT[1024 + idx] = __sinf(ang); } }
    __syncthreads();
    {
        LAS float* scr = (LAS float*)(F.lds + F.wave * 16384);
        const int gw = blockIdx.x * NWAVES + F.wave, NGW = F.G * NWAVES;
        constexpr int I1 = 16 * 64, I2 = 16 * 130, I3 = 32 * 32, I4 = 16 * 88, I5 = 16 * 88, I6 = 44 * 32, I7 = 16 * 48, I8 = 16 * 32, IPER = I1 + I2 + I3 + I4 + I5 + I6 + I7 + I8;
        for (int it = gw; it < 2 * IPER; it += NGW) {
            const int j = it / IPER; int r = it - j * IPER;
            unsigned char* wss = F.ws + WS_W + (size_t)j * W_SSD_STRIDE; unsigned char* wsa = F.ws + WS_W + W_ATT0 + (size_t)j * W_ATT_STRIDE;
            if (r < I1) { transpose_item(A.ssd_w_in + (size_t)j * 1024 * SSD_IN, SSD_IN, 0, 64, 1024, (bf16_t*)(wss + W_WZ), 0, 0, scr, r, F.lane); continue; } r -= I1;
            if (r < I2) { transpose_item(A.ssd_w_in + (size_t)j * 1024 * SSD_IN, SSD_IN, 2048, 130, 1024, (bf16_t*)(wss + W_WIN), 0, 0, scr, r, F.lane); continue; } r -= I2;
            if (r < I3) { transpose_item(A.ssd_w_out + (size_t)j * 2048 * 1024, 1024, 0, 32, 2048, (bf16_t*)(wss + W_WOUT), 0, 0, scr, r, F.lane); continue; } r -= I3;
            if (r < I4) { transpose_item(A.ffn_w1 + (size_t)j * 1024 * DFF, DFF, 0, 88, 1024, (bf16_t*)(wss + W_WUP), 1, 0, scr, r, F.lane); continue; } r -= I4;
            if (r < I5) { transpose_item(A.ffn_w3 + (size_t)j * 1024 * DFF, DFF, 0, 88, 1024, (bf16_t*)(wss + W_WUP), 1, 1, scr, r, F.lane); continue; } r -= I5;
            if (r < I6) { transpose_item(A.ffn_w2 + (size_t)j * DFF * 1024, 1024, 0, 32, DFF, (bf16_t*)(wss + W_WDN), 0, 0, scr, r, F.lane); continue; } r -= I6;
            if (r < I7) { transpose_item(A.attn_w_qkv + (size_t)j * 1024 * NQKV, NQKV, 0, 48, 1024, (bf16_t*)(wsa + W_WQKV), 0, 0, scr, r, F.lane); continue; } r -= I7;
            transpose_item(A.attn_w_o + (size_t)j * 1024 * 1024, 1024, 0, 32, 1024, (bf16_t*)(wsa + W_WO), 0, 0, scr, r, F.lane);
        }
        for (int j = 0; j < 2; ++j) { u32x4* z = (u32x4*)(F.ws + WS_W + (size_t)j * W_SSD_STRIDE + W_WIN + (size_t)4160 * 1024 * 2);
            for (int idx = blockIdx.x * 512 + F.tid; idx < 192 * 1024 * 2 / 16; idx += F.G * 512) z[idx] = (u32x4){0u, 0u, 0u, 0u}; }
    }
}
__device__ __forceinline__ void moe_convert(Frame& F, const Args& A, int j) {
    phase_enter(F);
    LAS float* scr = (LAS float*)(F.lds + F.wave * 16384);
    const int gw = blockIdx.x * NWAVES + F.wave, NGW = F.G * NWAVES;
    constexpr int IE = 16 * 112, I2 = 56 * 32;
    bf16_t* MW13 = (bf16_t*)(F.ws + WS_BIG + BIG_MW13); bf16_t* MW2 = (bf16_t*)(F.ws + WS_BIG + BIG_MW2);
    for (int it = gw; it < 8 * (2 * IE + I2); it += NGW) {
        const int e = it / (2 * IE + I2); int r = it - e * (2 * IE + I2);
        const size_t we = (size_t)(j * 8 + e) * 1024 * DFFE;
        if (r < IE) { transpose_item(A.moe_w1 + we, DFFE, 0, 112, 1024, MW13 + (size_t)e * 7168 * 1024, 1, 0, scr, r, F.lane); continue; } r -= IE;
        if (r < IE) { transpose_item(A.moe_w3 + we, DFFE, 0, 112, 1024, MW13 + (size_t)e * 7168 * 1024, 1, 1, scr, r, F.lane); continue; } r -= IE;
        transpose_item(A.moe_w2 + we, 1024, 0, 32, DFFE, MW2 + (size_t)e * 1024 * DFFE, 0, 0, scr, r, F.lane);
    }
}

__device__ __forceinline__ void norm_phase(Frame& F, const Args& A, int i, int which, int mode) {
    phase_enter(F);
    const bool first = mode & 1, combine = mode & 2, route = mode & 4, fin = mode & 8, lastl = mode & 16;
    const float* MODV = (const float*)(F.ws + WS_MODV);
    bf16_t* H = (bf16_t*)(F.ws + WS_H);
    const bf16_t* EO = (const bf16_t*)(F.ws + WS_Y);
    LAS float* rt = (LAS float*)F.lds;
    LAS int* ents = (LAS int*)(F.lds + 32768);
    const int jm = i >> 1;
    if (route) { const float* rg = A.moe_router + (size_t)jm * 1024 * 8; for (int idx = F.tid; idx < 8192; idx += 512) rt[idx] = rg[idx]; }
    __syncthreads();
    const float* nw = fin ? A.final_norm_w : ((which == 0 ? A.norm1_w : A.norm2_w) + i * 1024);
    unsigned* cnt = (unsigned*)(F.ctl + CW_CNT + (size_t)jm * 8 * 64);
    int* rlist = (int*)(F.ws + WS_RLIST); float* GATE = (float*)(F.ws + WS_GATE);
    for (int ch = blockIdx.x; ch < MROWS / 32; ch += F.G) {
        const int R0 = ch * 32, b = R0 / SROW, s0 = R0 - b * SROW; const bool isctx = s0 < NCTX; const int cond = isctx ? 16 : b;
        if (fin && isctx) continue;
        const bool do_route = route && !(lastl && isctx);
        const float* mv = MODV + (size_t)(i * 17 + cond) * 6144;
        f32x4 wv[4], shv[4], scv[4], g5[4];
#pragma unroll
        for (int j = 0; j < 4; ++j) { const int col = 4 * F.lane + 256 * j; wv[j] = *(const f32x4*)(nw + col);
            if (!fin) { shv[j] = *(const f32x4*)(mv + (which ? 3 : 0) * 1024 + col); scv[j] = *(const f32x4*)(mv + (which ? 4 : 1) * 1024 + col); }
            if (combine) g5[j] = *(const f32x4*)(MODV + (size_t)((i - 1) * 17 + cond) * 6144 + 5 * 1024 + col); }
        for (int rr = 0; rr < 4; ++rr) {
            const int R = R0 + F.wave * 4 + rr, s = s0 + F.wave * 4 + rr;
            float* res = isctx ? (float*)(F.ws + WS_CX) + (size_t)(b * NCTX + s) * DM : F.out + (size_t)(b * SEQ + s - NCTX) * DM;
            const float* src = first ? (isctx ? A.ctx + (size_t)(b * NCTX + s) * DM : A.x + (size_t)(b * SEQ + s - NCTX) * DM) : res;
            f32x4 v[4]; float ss = 0.f;
#pragma unroll
            for (int j = 0; j < 4; ++j) v[j] = *(const f32x4*)(src + 4 * F.lane + 256 * j);
            if (combine) {
#pragma unroll
                for (int j = 0; j < 4; ++j) { const u32x2 e0 = *(const u32x2*)(EO + (size_t)(2 * R) * DM + 4 * F.lane + 256 * j), e1 = *(const u32x2*)(EO + (size_t)(2 * R + 1) * DM + 4 * F.lane + 256 * j);
                    f32x4 ev; ev.x = bf_lo(e0.x) + bf_lo(e1.x); ev.y = bf_hi(e0.x) + bf_hi(e1.x); ev.z = bf_lo(e0.y) + bf_lo(e1.y); ev.w = bf_hi(e0.y) + bf_hi(e1.y);
                    v[j] = v[j] + g5[j] * ev; }
            }
            if (first || combine) {
#pragma unroll
                for (int j = 0; j < 4; ++j) *(f32x4*)(res + 4 * F.lane + 256 * j) = v[j];
            }
#pragma unroll
            for (int j = 0; j < 4; ++j) ss += (v[j].x * v[j].x + v[j].y * v[j].y) + (v[j].z * v[j].z + v[j].w * v[j].w);
            const float rstd = 1.0f / sqrtf(wave_sum(ss, F.lane) * (1.0f / DM) + EPS);
            if (fin) {
#pragma unroll
                for (int j = 0; j < 4; ++j) *(f32x4*)(res + 4 * F.lane + 256 * j) = v[j] * rstd * wv[j];
                continue;
            }
#pragma unroll
            for (int j = 0; j < 4; ++j) { v[j] = v[j] * rstd * wv[j] * (scv[j] + 1.0f) + shv[j];
                u32x2 o; o.x = pk2(v[j].x, v[j].y); o.y = pk2(v[j].z, v[j].w); *(u32x2*)(H + (size_t)R * DM + 4 * F.lane + 256 * j) = o; }
            if (do_route) {
                float lg[8];
#pragma unroll
                for (int e = 0; e < 8; ++e) lg[e] = 0.f;
#pragma unroll
                for (int j = 0; j < 4; ++j)
#pragma unroll
                    for (int q = 0; q < 4; ++q) { const int col = 4 * F.lane + 256 * j + q; const f32x4 r0 = *(const LAS f32x4*)(rt + col * 8), r1 = *(const LAS f32x4*)(rt + col * 8 + 4); const float y = v[j][q];
                        lg[0] += y * r0.x; lg[1] += y * r0.y; lg[2] += y * r0.z; lg[3] += y * r0.w; lg[4] += y * r1.x; lg[5] += y * r1.y; lg[6] += y * r1.z; lg[7] += y * r1.w; }
#pragma unroll
                for (int e = 0; e < 8; ++e) lg[e] = wave_sum(lg[e], F.lane);
                int i1 = 0; float v1 = lg[0];
#pragma unroll
                for (int e = 1; e < 8; ++e) if (lg[e] > v1) { v1 = lg[e]; i1 = e; }
                int i2 = -1; float v2 = -3.0e38f;
#pragma unroll
                for (int e = 0; e < 8; ++e) if (e != i1 && lg[e] > v2) { v2 = lg[e]; i2 = e; }
                const float g1 = 1.0f / (1.0f + expf(v2 - v1)), g2 = 1.0f - g1;
                if (F.lane == 0) { ents[(F.wave * 4 + rr) * 2] = i1; ents[(F.wave * 4 + rr) * 2 + 1] = i2; GATE[(size_t)R * 2] = g1; GATE[(size_t)R * 2 + 1] = g2; }
            }
        }
        if (do_route) {
            __syncthreads();
            if (F.wave == 0) {
                const int e = ents[F.lane];
#pragma unroll
                for (int ee = 0; ee < 8; ++ee) { const unsigned long long m = __ballot(e == ee); const int n = __popcll(m);
                    if (n) { unsigned base = 0; if (F.lane == 0) base = __hip_atomic_fetch_add(cnt + ee * 64, (unsigned)n, RLX_AGENT); base = __builtin_amdgcn_readfirstlane(base);
                        if (e == ee) { const int pos = (int)base + __popcll(m & ((1ull << F.lane) - 1ull)); rlist[(size_t)ee * MROWS + pos] = (R0 + (F.lane >> 1)) * 2 + (F.lane & 1); } } }
            }
            __syncthreads();
        }
    }
}

struct EpiXbc {
    static constexpr bool PERM = true;
    bf16_t* XBC; float* DT; bf16_t* HALO;
    __device__ __forceinline__ void operator()(const f32x4 (&acc)[2][2][4][2], const pg8::Unit& u, int wr, int wc, int fr, int fq) const {
        const int row0 = u.pm * 256 + wr * 64 + fr;
        if (u.pn < 16) { const int col0 = u.pn * 256 + wc * 32 + 8 * fq;
#pragma unroll
            for (int ai = 0; ai < 2; ++ai)
#pragma unroll
                for (int m = 0; m < 4; ++m) { bf16_t* rowp = XBC + (size_t)(row0 + ai * 128 + m * 16) * CONVCH + col0;
#pragma unroll
                    for (int bj = 0; bj < 2; ++bj) { const f32x4 v0 = acc[ai][bj][m][0], v1 = acc[ai][bj][m][1]; u32x4 w; w.x = pg8::cvt_pk_bf16(v0[0], v0[1]); w.y = pg8::cvt_pk_bf16(v0[2], v0[3]); w.z = pg8::cvt_pk_bf16(v1[0], v1[1]); w.w = pg8::cvt_pk_bf16(v1[2], v1[3]);
                        *(GAS u32x4*)(rowp + bj * 128) = w;
                        const int rin = ai * 128 + wr * 64 + m * 16 + fr;
                        if (rin < 2 || rin >= 254) *(GAS u32x4*)(HALO + ((size_t)u.pm * 4 + (rin < 2 ? rin : rin - 252)) * CONVCH + col0 + bj * 128) = w; } }
        } else if (wc < 2) { const int c0 = wc * 32 + 8 * fq;
#pragma unroll
            for (int ai = 0; ai < 2; ++ai)
#pragma unroll
                for (int m = 0; m < 4; ++m) { float* p = DT + (size_t)(row0 + ai * 128 + m * 16) * 64 + c0; *(GAS f32x4*)p = acc[ai][0][m][0]; *(GAS f32x4*)(p + 4) = acc[ai][0][m][1]; }
        }
    }
};
struct EpiGate {
    static constexpr bool PERM = true;
    const bf16_t* Y; bf16_t* Gt; const float* nw; LAS float* P;
    __device__ __forceinline__ void operator()(f32x4 (&acc)[2][2][4][2], const pg8::Unit& u, int wr, int wc, int fr, int fq) const {
        const int row0 = u.pm * 256 + wr * 64 + fr, col0 = u.pn * 256 + wc * 32 + 8 * fq;
#pragma unroll
        for (int ai = 0; ai < 2; ++ai)
#pragma unroll
            for (int m = 0; m < 4; ++m) { const bf16_t* yp = Y + (size_t)(row0 + ai * 128 + m * 16) * DIN + col0; float ssq = 0.f;
#pragma unroll
                for (int bj = 0; bj < 2; ++bj) { const u32x4 yv = *(const GAS u32x4*)(yp + bj * 128); f32x4 z0 = acc[ai][bj][m][0], z1 = acc[ai][bj][m][1];
                    z0[0] = bf_lo(yv.x) * siluf(z0[0]); z0[1] = bf_hi(yv.x) * siluf(z0[1]); z0[2] = bf_lo(yv.y) * siluf(z0[2]); z0[3] = bf_hi(yv.y) * siluf(z0[3]);
                    z1[0] = bf_lo(yv.z) * siluf(z1[0]); z1[1] = bf_hi(yv.z) * siluf(z1[1]); z1[2] = bf_lo(yv.w) * siluf(z1[2]); z1[3] = bf_hi(yv.w) * siluf(z1[3]);
                    ssq += (z0[0] * z0[0] + z0[1] * z0[1]) + (z0[2] * z0[2] + z0[3] * z0[3]) + (z1[0] * z1[0] + z1[1] * z1[1]) + (z1[2] * z1[2] + z1[3] * z1[3]);
                    acc[ai][bj][m][0] = z0; acc[ai][bj][m][1] = z1; }
                ssq += shx(ssq, 16, fq * 16 + fr); ssq += shx(ssq, 32, fq * 16 + fr);
                if (fq == 0) P[(ai * 128 + wr * 64 + m * 16 + fr) * 4 + wc] = ssq; }
        asm volatile("s_waitcnt lgkmcnt(0)" ::: "memory"); __builtin_amdgcn_s_barrier(); asm volatile("" ::: "memory");
        f32x4 nv[2][2];
#pragma unroll
        for (int bj = 0; bj < 2; ++bj) { nv[bj][0] = *(const GAS f32x4*)(nw + col0 + bj * 128); nv[bj][1] = *(const GAS f32x4*)(nw + col0 + bj * 128 + 4); }
#pragma unroll
        for (int ai = 0; ai < 2; ++ai)
#pragma unroll
            for (int m = 0; m < 4; ++m) { const f32x4 pp = *(const LAS f32x4*)(P + (ai * 128 + wr * 64 + m * 16 + fr) * 4); const float rstd = 1.0f / sqrtf(((pp.x + pp.y) + (pp.z + pp.w)) * (1.0f / 256.0f) + EPS);
                bf16_t* gp = Gt + (size_t)(row0 + ai * 128 + m * 16) * DIN + col0;
#pragma unroll
                for (int bj = 0; bj < 2; ++bj) { const f32x4 v0 = acc[ai][bj][m][0] * rstd * nv[bj][0], v1 = acc[ai][bj][m][1] * rstd * nv[bj][1];
                    u32x4 w; w.x = pg8::cvt_pk_bf16(v0[0], v0[1]); w.y = pg8::cvt_pk_bf16(v0[2], v0[3]); w.z = pg8::cvt_pk_bf16(v1[0], v1[1]); w.w = pg8::cvt_pk_bf16(v1[2], v1[3]);
                    *(GAS u32x4*)(gp + bj * 128) = w; } }
        asm volatile("s_waitcnt lgkmcnt(0)" ::: "memory");
    }
};
struct EpiResid {
    static constexpr bool PERM = false;
    unsigned char* ws; float* out; const float* modl; int gidx; const float* bias;
    __device__ __forceinline__ void operator()(const f32x4 (&acc)[2][2][4][2], const pg8::Unit& u, int wr, int wc, int fr, int fq) const {
        const int b = u.pm / 17, j = u.pm - b * 17, cond = j == 0 ? 16 : b;
        GAS float* res = (GAS float*)((j == 0 ? (float*)(ws + WS_CX) + (size_t)(b * NCTX) * DM : out + (size_t)(b * SEQ + (j - 1) * 256) * DM) + (size_t)(wr * 64 + fr) * DM + u.pn * 256 + wc * 32 + 4 * fq);
        const GAS float* gv = (const GAS float*)(modl + (size_t)cond * 6144 + gidx * 1024 + u.pn * 256 + wc * 32 + 4 * fq);
        const GAS float* bp = (const GAS float*)(bias ? bias + u.pn * 256 + wc * 32 + 4 * fq : nullptr);
        f32x4 g[2][2], bv[2][2];
#pragma unroll
        for (int bj = 0; bj < 2; ++bj)
#pragma unroll
            for (int n = 0; n < 2; ++n) { g[bj][n] = *(const GAS f32x4*)(gv + bj * 128 + n * 16); bv[bj][n] = bp ? *(const GAS f32x4*)(bp + bj * 128 + n * 16) : (f32x4){0.f, 0.f, 0.f, 0.f}; }
#pragma unroll
        for (int am = 0; am < 4; ++am) { const int ai = am >> 1, m0 = (am & 1) * 2;
            f32x4 o[2][2][2];
#pragma unroll
            for (int mm = 0; mm < 2; ++mm)
#pragma unroll
                for (int bj = 0; bj < 2; ++bj)
#pragma unroll
                    for (int n = 0; n < 2; ++n) o[mm][bj][n] = *(const GAS f32x4*)(res + (size_t)(ai * 128 + (m0 + mm) * 16) * DM + bj * 128 + n * 16);
#pragma unroll
            for (int mm = 0; mm < 2; ++mm)
#pragma unroll
                for (int bj = 0; bj < 2; ++bj)
#pragma unroll
                    for (int n = 0; n < 2; ++n) *(GAS f32x4*)(res + (size_t)(ai * 128 + (m0 + mm) * 16) * DM + bj * 128 + n * 16) = o[mm][bj][n] + g[bj][n] * (acc[ai][bj][m0 + mm][n] + bv[bj][n]);
            asm volatile("" ::: "memory");
        }
    }
};
struct EpiSwiglu {
    static constexpr bool PERM = true;
    bf16_t* ACT; int ldc;
    __device__ __forceinline__ void operator()(const f32x4 (&acc)[2][2][4][2], const pg8::Unit& u, int wr, int wc, int fr, int fq) const {
        const int row0 = u.pm * 256 + wr * 64 + fr, col0 = u.pn * 128 + wc * 32 + 8 * fq;
#pragma unroll
        for (int ai = 0; ai < 2; ++ai)
#pragma unroll
            for (int m = 0; m < 4; ++m) { const f32x4 g0 = acc[ai][0][m][0], g1 = acc[ai][0][m][1], u0 = acc[ai][1][m][0], u1 = acc[ai][1][m][1];
                u32x4 w; w.x = pg8::cvt_pk_bf16(siluf(g0[0]) * u0[0], siluf(g0[1]) * u0[1]); w.y = pg8::cvt_pk_bf16(siluf(g0[2]) * u0[2], siluf(g0[3]) * u0[3]);
                w.z = pg8::cvt_pk_bf16(siluf(g1[0]) * u1[0], siluf(g1[1]) * u1[1]); w.w = pg8::cvt_pk_bf16(siluf(g1[2]) * u1[2], siluf(g1[3]) * u1[3]);
                *(GAS u32x4*)(ACT + (size_t)(row0 + ai * 128 + m * 16) * ldc + col0) = w; }
    }
};
struct EpiQkv {
    static constexpr bool PERM = false;
    bf16_t *Q, *Kb, *Vb; const float* bias; const float* rope;
    __device__ __forceinline__ void operator()(const f32x4 (&acc)[2][2][4][2], const pg8::Unit& u, int wr, int wc, int fr, int fq) const {
        const int b = u.pm / 17, j = u.pm - b * 17; const bool isctx = j == 0; const int pos0 = (j - 1) * 256;
        bf16_t* dst; int ld, cbase; float sc = 1.0f;
        if (u.pn < 4) { dst = Q; ld = QW; cbase = u.pn * 256; sc = 0.125f; } else if (u.pn == 4) { dst = Kb; ld = KVW; cbase = 0; } else { dst = Vb; ld = KVW; cbase = 0; }
        const bool dorope = !isctx && u.pn < 5; const int axis = wc & 1;
        const float* bp = bias + u.pn * 256 + wc * 32 + 4 * fq;
#pragma unroll
        for (int ai = 0; ai < 2; ++ai)
#pragma unroll
            for (int m = 0; m < 4; ++m) { const int r = ai * 128 + wr * 64 + m * 16 + fr; const int pos = pos0 + r; const int id = axis ? (pos & 63) : (pos >> 6);
                f32x4 cs = (f32x4){1.f, 1.f, 1.f, 1.f}, sn = (f32x4){0.f, 0.f, 0.f, 0.f};
                if (dorope) { cs = *(const f32x4*)(rope + id * 16 + 4 * fq); sn = *(const f32x4*)(rope + 1024 + id * 16 + 4 * fq); }
                bf16_t* rowp = dst + (size_t)(u.pm * 256 + r) * ld + cbase + wc * 32 + 4 * fq;
#pragma unroll
                for (int bj = 0; bj < 2; ++bj) { const f32x4 x0 = (acc[ai][bj][m][0] + *(const f32x4*)(bp + bj * 128)) * sc, x1 = (acc[ai][bj][m][1] + *(const f32x4*)(bp + bj * 128 + 16)) * sc;
                    const f32x4 o0 = x0 * cs - x1 * sn, o1 = x1 * cs + x0 * sn;
                    u32x2 w0, w1; w0.x = pg8::cvt_pk_bf16(o0[0], o0[1]); w0.y = pg8::cvt_pk_bf16(o0[2], o0[3]); w1.x = pg8::cvt_pk_bf16(o1[0], o1[1]); w1.y = pg8::cvt_pk_bf16(o1[2], o1[3]);
                    *(GAS u32x2*)(rowp + bj * 128) = w0; *(GAS u32x2*)(rowp + bj * 128 + 16) = w1; }
                if (m & 1) asm volatile("" ::: "memory"); }
    }
};

struct MoeOrder {
    pg8::StaticOrder so; int cs; int pp[9]; int cnt[8]; const int* rlist; size_t bstride; bool GATHER_A;
    __device__ __forceinline__ void locate(int pm, int& e, int& p, int& cn) const { const int gp = cs + pm; e = 0; int pbase = 0; cn = cnt[0];
#pragma unroll
        for (int k = 1; k < 8; ++k) { const bool ge = gp >= pp[k]; e += ge ? 1 : 0; pbase = ge ? pp[k] : pbase; cn = ge ? cnt[k] : cn; }
        p = gp - pbase; }
    __device__ bool next(int i, pg8::Unit& u) const { return so.next(i, u); }
    __device__ __forceinline__ const char* a_base(const pg8::Gemm& g, const pg8::Unit& u) const { return GATHER_A ? (const char*)g.A : (const char*)g.A + (size_t)u.pm * (size_t)(256 * 2) * g.lda; }
    __device__ __forceinline__ const char* b_base(const pg8::Gemm& g, const pg8::Unit& u) const { int e, p, cn; locate(u.pm, e, p, cn); return (const char*)g.Bt + (size_t)e * bstride + (size_t)u.pn * (size_t)(256 * 2) * g.K; }
    __device__ __forceinline__ unsigned row_off(const pg8::Gemm& g, const pg8::Unit& u, int r) const {
        if (!GATHER_A) return (unsigned)r * (unsigned)g.lda * 2u;
        int e, p, cn; locate(u.pm, e, p, cn); const int idx = p * 256 + r; const int tok = idx < cn ? (rlist[(size_t)e * MROWS + idx] >> 1) : 0; return (unsigned)tok * (unsigned)g.lda * 2u; }
};
struct EpiMoeDown {
    static constexpr bool PERM = true;
    MoeOrder mo; bf16_t* EO; const float* GATE;
    __device__ __forceinline__ void operator()(const f32x4 (&acc)[2][2][4][2], const pg8::Unit& u, int wr, int wc, int fr, int fq) const {
        int e, p, cn; mo.locate(u.pm, e, p, cn); const int* rl = mo.rlist + (size_t)e * MROWS + p * 256;
        const int col0 = u.pn * 256 + wc * 32 + 8 * fq;
#pragma unroll
        for (int ai = 0; ai < 2; ++ai)
#pragma unroll
            for (int m = 0; m < 4; ++m) { const int r = ai * 128 + wr * 64 + m * 16 + fr;
                if (p * 256 + r < cn) { const int ent = rl[r]; const float gt = GATE[ent]; bf16_t* dp = EO + (size_t)ent * DM + col0;
#pragma unroll
                    for (int bj = 0; bj < 2; ++bj) { const f32x4 v0 = acc[ai][bj][m][0] * gt, v1 = acc[ai][bj][m][1] * gt; u32x4 w; w.x = pg8::cvt_pk_bf16(v0[0], v0[1]); w.y = pg8::cvt_pk_bf16(v0[2], v0[3]); w.z = pg8::cvt_pk_bf16(v1[0], v1[1]); w.w = pg8::cvt_pk_bf16(v1[2], v1[3]);
                        *(GAS u32x4*)(dp + bj * 128) = w; } } }
    }
};

typedef __bf16 bf16x2_t __attribute__((ext_vector_type(2)));
typedef short v4i16_t __attribute__((ext_vector_type(4)));
__device__ __forceinline__ unsigned cvtpk(float lo, float hi) { f32x2 v = {lo, hi}; bf16x2_t b = __builtin_convertvector(v, bf16x2_t); return __builtin_bit_cast(unsigned, b); }
__device__ __forceinline__ int crow(int r, int hi) { return (r & 3) + 8 * (r >> 2) + 4 * hi; }
__device__ __forceinline__ s16x4 vtr(const LAS unsigned char* p) { return __builtin_bit_cast(s16x4, __builtin_amdgcn_ds_read_tr16_b64_v4i16((LAS v4i16_t*)p)); }
#define MFMA32(a, b, c) __builtin_amdgcn_mfma_f32_32x32x16_bf16((a), (b), (c), 0, 0, 0)
__device__ __forceinline__ void conv_phase(Frame& F, const Args& A, int j) {
    phase_enter(F);
    bf16_t* XBC = (bf16_t*)(F.ws + WS_BIG); const bf16_t* HALO = (const bf16_t*)(F.ws + WS_HALO);
    const int lane = F.lane;
    const int gw = blockIdx.x * NWAVES + F.wave, NGW = F.G * NWAVES;
    for (int task = gw; task < NPAN * 8; task += NGW) {
        const int pm = task >> 3, sl = task & 7, jj = pm % 17, c0 = sl * 512 + lane * 8;
        const bool top_zero = jj <= 1, bot_zero = jj == 0 || jj == 16;
        f32x2 cw[5][4], cbias[4];
#pragma unroll
        for (int k = 0; k < 5; ++k) { const f32x4 a0 = *(const GAS f32x4*)(A.ssd_conv_w + (size_t)(j * 5 + k) * CONVCH + c0), a1 = *(const GAS f32x4*)(A.ssd_conv_w + (size_t)(j * 5 + k) * CONVCH + c0 + 4);
            cw[k][0] = (f32x2){a0.x, a0.y}; cw[k][1] = (f32x2){a0.z, a0.w}; cw[k][2] = (f32x2){a1.x, a1.y}; cw[k][3] = (f32x2){a1.z, a1.w}; }
        { const f32x4 a0 = *(const GAS f32x4*)(A.ssd_conv_b + (size_t)j * CONVCH + c0), a1 = *(const GAS f32x4*)(A.ssd_conv_b + (size_t)j * CONVCH + c0 + 4);
            cbias[0] = (f32x2){a0.x, a0.y}; cbias[1] = (f32x2){a0.z, a0.w}; cbias[2] = (f32x2){a1.x, a1.y}; cbias[3] = (f32x2){a1.z, a1.w}; }
        GAS bf16_t* base = (GAS bf16_t*)(XBC + (size_t)pm * 256 * CONVCH + c0);
        const u32x4 zero4 = (u32x4){0u, 0u, 0u, 0u};
        u32x4 win[12], pre[8];
        win[0] = top_zero ? zero4 : *(const GAS u32x4*)(HALO + ((size_t)(pm - 1) * 4 + 2) * CONVCH + c0);
        win[1] = top_zero ? zero4 : *(const GAS u32x4*)(HALO + ((size_t)(pm - 1) * 4 + 3) * CONVCH + c0);
#pragma unroll
        for (int q = 0; q < 10; ++q) win[2 + q] = *(const GAS u32x4*)(base + (size_t)q * CONVCH);
        for (int k = 0; k < 32; ++k) {
            if (k < 30) {
#pragma unroll
                for (int q = 0; q < 8; ++q) pre[q] = *(const GAS u32x4*)(base + (size_t)(8 * k + 10 + q) * CONVCH);
            } else if (k == 30) {
#pragma unroll
                for (int q = 0; q < 6; ++q) pre[q] = *(const GAS u32x4*)(base + (size_t)(250 + q) * CONVCH);
                pre[6] = bot_zero ? zero4 : *(const GAS u32x4*)(HALO + ((size_t)(pm + 1) * 4 + 0) * CONVCH + c0);
                pre[7] = bot_zero ? zero4 : *(const GAS u32x4*)(HALO + ((size_t)(pm + 1) * 4 + 1) * CONVCH + c0);
            }
#pragma unroll
            for (int o = 0; o < 8; ++o) {
                f32x2 r[4];
#pragma unroll
                for (int c = 0; c < 4; ++c) r[c] = cbias[c];
#pragma unroll
                for (int t = 0; t < 5; ++t) { const u32x4 w = win[o + t];
                    r[0] += cw[t][0] * (f32x2){bf_lo(w.x), bf_hi(w.x)}; r[1] += cw[t][1] * (f32x2){bf_lo(w.y), bf_hi(w.y)};
                    r[2] += cw[t][2] * (f32x2){bf_lo(w.z), bf_hi(w.z)}; r[3] += cw[t][3] * (f32x2){bf_lo(w.w), bf_hi(w.w)}; }
                u32x4 w; w.x = cvtpk(siluf(r[0].x), siluf(r[0].y)); w.y = cvtpk(siluf(r[1].x), siluf(r[1].y)); w.z = cvtpk(siluf(r[2].x), siluf(r[2].y)); w.w = cvtpk(siluf(r[3].x), siluf(r[3].y));
                *(GAS u32x4*)(base + (size_t)(8 * k + o) * CONVCH) = w;
            }
#pragma unroll
            for (int q = 0; q < 4; ++q) win[q] = win[8 + q];
#pragma unroll
            for (int q = 0; q < 8; ++q) win[4 + q] = pre[q];
        }
    }
}


constexpr int SC_RS = 272;
constexpr int SC_TILE = 3 * 32 * SC_RS;
constexpr int SC_YS = 2 * SC_TILE;
constexpr int SC_WS = SC_YS + 16384;
constexpr int SC_RAW = 73728;
static_assert(SC_WS + 4096 <= SC_RAW && SC_RAW + 2 * 36 * 1024 <= LDSCTL_OFF, "scan LDS map");
__device__ __forceinline__ void scan_phase(Frame& F, const Args& A, int j) {
    phase_enter(F);
    const bf16_t* XBC = (const bf16_t*)(F.ws + WS_BIG); const float* DT = (const float*)(F.ws + WS_DT); bf16_t* Y = (bf16_t*)(F.ws + WS_Y);
    const int lane = F.lane, wave = F.wave;
    for (int u0 = blockIdx.x; u0 < 256; u0 += F.G) {
        const int unit = (F.G == 256) ? ((u0 & 7) * 32 + (u0 >> 3)) : u0;
        const int b = unit >> 4, g = (unit >> 1) & 7, ph = unit & 1;
        const int srow = F.tid >> 4, sch = F.tid & 15;
        const int gcolB = 2048 + g * 128 + sch * 8, gcolC = 3072 + g * 128 + sch * 8, gcolX = g * 256 + (sch >> 2) * 64 + ph * 32 + (sch & 3) * 8;
        const int hh = wave >> 1, dir = wave & 1, c31 = lane & 31, hl = lane >> 5;
        const int trq = (lane & 15) >> 2, trp = lane & 3, trb = (lane >> 4) & 1;
        const int head = g * 4 + hh;
        const float Dk = A.ssd_d[(j * 2 + dir) * 32 + head], dtb = A.ssd_dt_bias[(j * 2 + dir) * 32 + head], aneg = -expf(A.ssd_a_log[(j * 2 + dir) * 32 + head]);
        LAS float* wsf = (LAS float*)(F.lds + SC_WS + wave * 512);
        f32x16 ST[4];
#pragma unroll
        for (int t = 0; t < 4; ++t)
#pragma unroll
            for (int e = 0; e < 16; ++e) ST[t][e] = 0.f;
#define SC_PF(st) do { const int cf_ = (st), cb_ = (st) < 8 ? 7 - (st) : 143 - (st); \
            _Pragma("unroll") for (int T = 0; T < 2; ++T) { const GAS bf16_t* rp = (const GAS bf16_t*)(XBC + (size_t)(b * SROW + (T ? cb_ : cf_) * 32 + srow) * CONVCH); \
                pf[T][0] = *(const GAS u32x4*)(rp + gcolB); pf[T][1] = *(const GAS u32x4*)(rp + gcolC); pf[T][2] = *(const GAS u32x4*)(rp + gcolX); } } while (0)
#define SC_DTLOAD(st) DT[(size_t)(b * SROW + (dir ? ((st) < 8 ? 7 - (st) : 143 - (st)) : (st)) * 32 + c31) * 64 + dir * 32 + head]
#define SC_WRITEOUT(st) do { const int cf_ = (st), cb_ = (st) < 8 ? 7 - (st) : 143 - (st); \
            _Pragma("unroll") for (int T = 0; T < 2; ++T) { const int tok = F.tid >> 4, h4 = (F.tid >> 2) & 3, q4 = F.tid & 3, chunk = T ? cb_ : cf_; \
                const int other = T == 0 ? (chunk < 8 ? 7 - chunk : 143 - chunk) : chunk; \
                u32x4 v = *(const LAS u32x4*)(F.lds + SC_YS + T * 8192 + (tok * 128 + h4 * 32 + q4 * 8) * 2); \
                bf16_t* yp = Y + (size_t)(b * SROW + chunk * 32 + tok) * DIN + g * 256 + h4 * 64 + ph * 32 + q4 * 8; \
                if ((st) > other) { const u32x4 o = oldy[T]; \
                    v.x = pk2(bf_lo(o.x) + bf_lo(v.x), bf_hi(o.x) + bf_hi(v.x)); v.y = pk2(bf_lo(o.y) + bf_lo(v.y), bf_hi(o.y) + bf_hi(v.y)); \
                    v.z = pk2(bf_lo(o.z) + bf_lo(v.z), bf_hi(o.z) + bf_hi(v.z)); v.w = pk2(bf_lo(o.w) + bf_lo(v.w), bf_hi(o.w) + bf_hi(v.w)); } \
                *(u32x4*)yp = v; } } while (0)
        u32x4 pf[2][3];
        SC_PF(0);
        float dtraw = SC_DTLOAD(0);
        u32x4 oldy[2] = {(u32x4){0u, 0u, 0u, 0u}, (u32x4){0u, 0u, 0u, 0u}};
        for (int step = 0; step < 136; ++step) {
            const int cf = step, cbk = step < 8 ? 7 - step : 143 - step;
            __syncthreads();
            if (step > 0) SC_WRITEOUT(step - 1);
#pragma unroll
            for (int T = 0; T < 2; ++T)
#pragma unroll
                for (int a = 0; a < 3; ++a) *(LAS u32x4*)(F.lds + T * SC_TILE + a * (32 * SC_RS) + srow * SC_RS + sch * 16) = pf[T][a];
            {
                const float xb = dtraw + dtb;
                const float dt = xb > 20.f ? xb : log1pf(__expf(xb)); const float dA = dt * aneg;
                float v = dA;
#pragma unroll
                for (int o = 1; o < 32; o <<= 1) { const float t = __builtin_bit_cast(float, __builtin_amdgcn_ds_bpermute((lane - o) << 2, __builtin_bit_cast(int, v))); if (c31 >= o) v += t; }
                const float tot = __builtin_bit_cast(float, __builtin_amdgcn_ds_bpermute((hl * 32 + 31) << 2, __builtin_bit_cast(int, v)));
                const float cum = dir ? (tot - v + dA) : v;
                if (hl == 0) { wsf[c31] = cum; wsf[32 + c31] = dt; wsf[64 + c31] = __expf(tot - cum) * dt; wsf[96 + c31] = __expf(cum); }
            }
            asm volatile("s_waitcnt lgkmcnt(0)" ::: "memory"); __builtin_amdgcn_s_barrier(); asm volatile("" ::: "memory");
            if (step + 1 < 136) { SC_PF(step + 1); dtraw = SC_DTLOAD(step + 1); }
#pragma unroll
            for (int T = 0; T < 2; ++T) {
                const int tok = F.tid >> 4, h4 = (F.tid >> 2) & 3, q4 = F.tid & 3, chunk = T ? cbk : cf;
                const int other = T == 0 ? (chunk < 8 ? 7 - chunk : 143 - chunk) : chunk;
                if (step > other) oldy[T] = *(const u32x4*)(Y + (size_t)(b * SROW + chunk * 32 + tok) * DIN + g * 256 + h4 * 64 + ph * 32 + q4 * 8);
            }
            {
                const LAS unsigned char* Bs = F.lds + dir * SC_TILE; const LAS unsigned char* Cs = Bs + 32 * SC_RS; const LAS unsigned char* xs = Bs + 64 * SC_RS;
                f32x16 gt;
#pragma unroll
                for (int e = 0; e < 16; ++e) gt[e] = 0.f;
#pragma unroll
                for (int s = 0; s < 8; ++s) { const bf16x8 a = *(const LAS bf16x8*)(Bs + c31 * SC_RS + (16 * s + 8 * hl) * 2), bb = *(const LAS bf16x8*)(Cs + c31 * SC_RS + (16 * s + 8 * hl) * 2); gt = MFMA32(a, bb, gt); }
                const float cum_i = wsf[c31];
                bf16x8 mk[2];
                {
                    float mv[16];
#pragma unroll
                    for (int q = 0; q < 4; ++q) { const f32x4 cj = *(const LAS f32x4*)(wsf + 8 * q + 4 * hl), dj = *(const LAS f32x4*)(wsf + 32 + 8 * q + 4 * hl);
#pragma unroll
                        for (int z = 0; z < 4; ++z) { const int jj = 8 * q + 4 * hl + z; const bool ok = dir ? (jj >= c31) : (jj <= c31);
                            float val = gt[4 * q + z] * __expf(ok ? (cum_i - cj[z]) : -INFINITY) * dj[z]; if (jj == c31) val += Dk; mv[4 * q + z] = val; } }
#pragma unroll
                    for (int s2 = 0; s2 < 2; ++s2) { u32x4 w; w.x = cvtpk(mv[8 * s2], mv[8 * s2 + 1]); w.y = cvtpk(mv[8 * s2 + 2], mv[8 * s2 + 3]); w.z = cvtpk(mv[8 * s2 + 4], mv[8 * s2 + 5]); w.w = cvtpk(mv[8 * s2 + 6], mv[8 * s2 + 7]); mk[s2] = __builtin_bit_cast(bf16x8, w); }
                }
                f32x16 ya;
#pragma unroll
                for (int e = 0; e < 16; ++e) ya[e] = 0.f;
#pragma unroll
                for (int t = 0; t < 4; ++t)
#pragma unroll
                    for (int s2 = 0; s2 < 2; ++s2) {
                        const LAS unsigned char* cp = Cs + c31 * SC_RS + (32 * t + 16 * s2 + 4 * hl) * 2;
                        const u32x2 c0 = *(const LAS u32x2*)cp, c1 = *(const LAS u32x2*)(cp + 16);
                        const bf16x8 ca = __builtin_bit_cast(bf16x8, (u32x4){c0.x, c0.y, c1.x, c1.y});
                        u32x4 w; w.x = cvtpk(ST[t][8 * s2], ST[t][8 * s2 + 1]); w.y = cvtpk(ST[t][8 * s2 + 2], ST[t][8 * s2 + 3]); w.z = cvtpk(ST[t][8 * s2 + 4], ST[t][8 * s2 + 5]); w.w = cvtpk(ST[t][8 * s2 + 6], ST[t][8 * s2 + 7]);
                        ya = MFMA32(ca, __builtin_bit_cast(bf16x8, w), ya);
                    }
#pragma unroll
                for (int q = 0; q < 4; ++q) { const f32x4 ec = *(const LAS f32x4*)(wsf + 96 + 8 * q + 4 * hl); ya[4 * q] *= ec.x; ya[4 * q + 1] *= ec.y; ya[4 * q + 2] *= ec.z; ya[4 * q + 3] *= ec.w; }
#pragma unroll
                for (int s2 = 0; s2 < 2; ++s2) {
                    const LAS unsigned char* xp = xs + (16 * s2 + 4 * hl + trq) * SC_RS + (hh * 32 + 16 * trb + 4 * trp) * 2;
                    const s16x4 lo = vtr(xp), hi = vtr(xp + 8 * SC_RS);
                    ya = MFMA32(mk[s2], ((bf16x8){lo[0], lo[1], lo[2], lo[3], hi[0], hi[1], hi[2], hi[3]}), ya);
                }
                {
                    const float etot = dir ? wsf[96] : wsf[96 + 31];
#pragma unroll
                    for (int t = 0; t < 4; ++t)
#pragma unroll
                        for (int e = 0; e < 16; ++e) ST[t][e] *= etot;
#pragma unroll
                    for (int s2 = 0; s2 < 2; ++s2) {
                        const LAS unsigned char* xp = xs + (16 * s2 + 8 * hl + trq) * SC_RS + (hh * 32 + 16 * trb + 4 * trp) * 2;
                        const s16x4 lo = vtr(xp), hi = vtr(xp + 4 * SC_RS);
                        const f32x4 w0 = *(const LAS f32x4*)(wsf + 64 + 16 * s2 + 8 * hl), w1 = *(const LAS f32x4*)(wsf + 64 + 16 * s2 + 8 * hl + 4);
                        u32x4 xw; xw.x = cvtpk(bf1((bf16_t)lo[0]) * w0.x, bf1((bf16_t)lo[1]) * w0.y); xw.y = cvtpk(bf1((bf16_t)lo[2]) * w0.z, bf1((bf16_t)lo[3]) * w0.w);
                        xw.z = cvtpk(bf1((bf16_t)hi[0]) * w1.x, bf1((bf16_t)hi[1]) * w1.y); xw.w = cvtpk(bf1((bf16_t)hi[2]) * w1.z, bf1((bf16_t)hi[3]) * w1.w);
                        const bf16x8 xb8 = __builtin_bit_cast(bf16x8, xw);
#pragma unroll
                        for (int t = 0; t < 4; ++t) {
                            const LAS unsigned char* bp = Bs + (16 * s2 + 8 * hl + trq) * SC_RS + (32 * t + 16 * trb + 4 * trp) * 2;
                            const s16x4 blo = vtr(bp), bhi = vtr(bp + 4 * SC_RS);
                            ST[t] = MFMA32(((bf16x8){blo[0], blo[1], blo[2], blo[3], bhi[0], bhi[1], bhi[2], bhi[3]}), xb8, ST[t]);
                        }
                    }
                }
                LAS bf16_t* ys = (LAS bf16_t*)(F.lds + SC_YS + dir * 8192);
#pragma unroll
                for (int e = 0; e < 16; ++e) ys[crow(e, hl) * 128 + hh * 32 + c31] = (bf16_t)f2bf(ya[e]);
            }
        }
        VM_WAIT(); __syncthreads();
        SC_WRITEOUT(135);
#undef SC_PF
#undef SC_DTLOAD
#undef SC_WRITEOUT
        __syncthreads();
    }
}

__device__ __forceinline__ void attn_phase(Frame& F, const Args& A, int ja, bool need_ctx) {
    phase_enter(F);
    const bf16_t* Q = (const bf16_t*)(F.ws + WS_BIG); bf16_t* O = (bf16_t*)(F.ws + WS_BIG + BIG_O); const bf16_t* Kb = (const bf16_t*)(F.ws + WS_BIG + BIG_K); const bf16_t* Vb = (const bf16_t*)(F.ws + WS_BIG + BIG_V);
    LAS unsigned char* Kl = F.lds; LAS unsigned char* Vl = F.lds + 9216;
    const int nunits = 2048 + (need_ctx ? 128 : 0);
    const int lane = F.lane, r = F.wave >> 1, rh = F.wave & 1, c31 = lane & 31, hl = lane >> 5;
    const int prow = F.tid >> 3, ppc = F.tid & 7;
    const int trq = (lane & 15) >> 2, trp = lane & 3, trb = (lane >> 4) & 1;
    for (int unit = blockIdx.x; unit < nunits; unit += F.G) {
        int b, g, nblk; bool cq;
        if (unit < 2048) { b = unit >> 7; nblk = (unit >> 2) & 31; g = unit & 3; cq = false; } else { const int u2 = unit - 2048; b = u2 >> 3; nblk = (u2 >> 2) & 1; g = u2 & 3; cq = true; }
        const int qrow0 = b * SROW + (cq ? 128 * nblk : NCTX + 128 * nblk);
        const int start = 128 * nblk;
        bf16x8 qf[2][4];
#pragma unroll
        for (int qb = 0; qb < 2; ++qb)
#pragma unroll
            for (int s = 0; s < 4; ++s) qf[qb][s] = *(const bf16x8*)(Q + (size_t)(qrow0 + 64 * rh + 32 * qb + c31) * QW + g * 256 + r * 64 + 16 * s + 8 * hl);
        const float sink = A.attn_sink[ja * 16 + g * 4 + r];
        float mrun[2] = {sink, sink}, lrun[2] = {1.f, 1.f};
        f32x16 ot[2][2];
#pragma unroll
        for (int db = 0; db < 2; ++db)
#pragma unroll
            for (int qb = 0; qb < 2; ++qb)
#pragma unroll
                for (int e = 0; e < 16; ++e) ot[db][qb][e] = 0.f;
        const int tt_lo = cq ? 0 : (nblk == 0 ? 2 : 0), tt_hi = cq ? 0 : (nblk == 31 ? 4 : 6);
        const int ntile = 4 + (tt_hi - tt_lo);
#define TILE_ROW0(t) ((t) < 4 ? b * SROW + 64 * (t) : b * SROW + NCTX + start - 128 + 64 * (tt_lo + (t) - 4))
        u32x4 kreg, vreg;
        { const int r0 = TILE_ROW0(0); kreg = *(const u32x4*)(Kb + (size_t)(r0 + prow) * KVW + g * 64 + ppc * 8); vreg = *(const u32x4*)(Vb + (size_t)(r0 + prow) * KVW + g * 64 + ppc * 8); }
        for (int t = 0; t < ntile; ++t) {
            __syncthreads();
            *(LAS u32x4*)(Kl + prow * 144 + ppc * 16) = kreg; *(LAS u32x4*)(Vl + prow * 144 + ppc * 16) = vreg;
            __syncthreads();
            if (t + 1 < ntile) { const int r0 = TILE_ROW0(t + 1); kreg = *(const u32x4*)(Kb + (size_t)(r0 + prow) * KVW + g * 64 + ppc * 8); vreg = *(const u32x4*)(Vb + (size_t)(r0 + prow) * KVW + g * 64 + ppc * 8); }
            f32x16 st[2][2];
#pragma unroll
            for (int kb = 0; kb < 2; ++kb) {
#pragma unroll
                for (int qb = 0; qb < 2; ++qb)
#pragma unroll
                    for (int e = 0; e < 16; ++e) st[kb][qb][e] = 0.f;
#pragma unroll
                for (int s = 0; s < 4; ++s) { const bf16x8 a = *(const LAS bf16x8*)(Kl + (32 * kb + c31) * 144 + (16 * s + 8 * hl) * 2);
                    st[kb][0] = MFMA32(a, qf[0][s], st[kb][0]); st[kb][1] = MFMA32(a, qf[1][s], st[kb][1]); }
            }
            if (t >= 4) { const int kpos0 = start - 128 + 64 * (tt_lo + t - 4);
#pragma unroll
                for (int kb = 0; kb < 2; ++kb)
#pragma unroll
                    for (int qb = 0; qb < 2; ++qb) { const int qpos = start + 64 * rh + 32 * qb + c31;
#pragma unroll
                        for (int e = 0; e < 16; ++e) { const int d = qpos - (kpos0 + 32 * kb + crow(e, hl)); if (d > 128 || d < -128) st[kb][qb][e] = -INFINITY; } }
            }
#pragma unroll
            for (int qb = 0; qb < 2; ++qb) {
                float mx = st[0][qb][0];
#pragma unroll
                for (int kb = 0; kb < 2; ++kb)
#pragma unroll
                    for (int e = 0; e < 16; ++e) mx = fmaxf(mx, st[kb][qb][e]);
                mx = fmaxf(mx, shx(mx, 32, lane));
                const float mn = fmaxf(mrun[qb], mx), alpha = __expf(mrun[qb] - mn); mrun[qb] = mn;
                float rs = 0.f;
#pragma unroll
                for (int kb = 0; kb < 2; ++kb)
#pragma unroll
                    for (int e = 0; e < 16; ++e) { const float pv = __expf(st[kb][qb][e] - mn); st[kb][qb][e] = pv; rs += pv; }
                rs += shx(rs, 32, lane);
                lrun[qb] = lrun[qb] * alpha + rs;
#pragma unroll
                for (int db = 0; db < 2; ++db)
#pragma unroll
                    for (int e = 0; e < 16; ++e) ot[db][qb][e] *= alpha;
            }
#pragma unroll
            for (int kb = 0; kb < 2; ++kb)
#pragma unroll
                for (int s2 = 0; s2 < 2; ++s2) {
                    bf16x8 pk[2];
#pragma unroll
                    for (int qb = 0; qb < 2; ++qb) { u32x4 w; w.x = cvtpk(st[kb][qb][8 * s2 + 0], st[kb][qb][8 * s2 + 1]); w.y = cvtpk(st[kb][qb][8 * s2 + 2], st[kb][qb][8 * s2 + 3]);
                        w.z = cvtpk(st[kb][qb][8 * s2 + 4], st[kb][qb][8 * s2 + 5]); w.w = cvtpk(st[kb][qb][8 * s2 + 6], st[kb][qb][8 * s2 + 7]); pk[qb] = __builtin_bit_cast(bf16x8, w); }
#pragma unroll
                    for (int db = 0; db < 2; ++db) {
                        const LAS unsigned char* vp = Vl + (32 * kb + 16 * s2 + 4 * hl + trq) * 144 + (32 * db + 16 * trb + 4 * trp) * 2;
                        const s16x4 lo = vtr(vp), hi = vtr(vp + 8 * 144);
                        const bf16x8 va = (bf16x8){lo[0], lo[1], lo[2], lo[3], hi[0], hi[1], hi[2], hi[3]};
                        ot[db][0] = MFMA32(va, pk[0], ot[db][0]); ot[db][1] = MFMA32(va, pk[1], ot[db][1]);
                    }
                }
        }
#undef TILE_ROW0
#pragma unroll
        for (int qb = 0; qb < 2; ++qb) { const float inv = 1.0f / lrun[qb]; bf16_t* op = O + (size_t)(qrow0 + 64 * rh + 32 * qb + c31) * QW + g * 256 + r * 64;
#pragma unroll
            for (int db = 0; db < 2; ++db)
#pragma unroll
                for (int gq = 0; gq < 4; ++gq) { u32x2 w; w.x = cvtpk(ot[db][qb][4 * gq] * inv, ot[db][qb][4 * gq + 1] * inv); w.y = cvtpk(ot[db][qb][4 * gq + 2] * inv, ot[db][qb][4 * gq + 3] * inv);
                    *(u32x2*)(op + 32 * db + 8 * gq + 4 * hl) = w; } }
    }
    __syncthreads();
}


#ifndef PHMASK
#define PHMASK 0xFFFF
#endif
#define PHON(k) (((PHMASK) >> (k)) & 1)
#ifndef REPMASK
#define REPMASK 0x0
#endif
#define REP(k) (((REPMASK) >> (k)) & 1)
#ifndef MK_PER_PHASE
#define MK_PER_PHASE 0
#endif
#ifndef TIMER_LO
#define TIMER_LO 999
#define TIMER_HI 999
#endif
#define TIMER_ON (TIMER_LO < 999)
#define IN(k) (lo <= (k) && (k) < hi)
#define SEAM(k) do { if (IN(k) && IN((k) + 1)) { xcd_barrier(bar); } if (TIMER_ON) { const unsigned long long now_ = __builtin_amdgcn_s_memrealtime(); if ((k) >= TIMER_LO && (k) <= TIMER_HI) TM.acc += now_ - TM.prev; TM.prev = now_; } } while (0)
#define SITE_PTRS phase_enter(F); unsigned char* ws = F.ws; bf16_t* H = (bf16_t*)(ws + WS_H); bf16_t* BIG = (bf16_t*)(ws + WS_BIG); const float* MODV = (const float*)(ws + WS_MODV); (void)H; (void)BIG; (void)MODV; \
        unsigned char* wss = ws + WS_W + (size_t)lp * W_SSD_STRIDE; unsigned char* wsa = ws + WS_W + W_ATT0 + (size_t)lp * W_ATT_STRIDE; (void)wss; (void)wsa;
struct Timer { unsigned long long prev, acc; };
template <int lp, int c> __device__ __forceinline__ void moe_chunk(Frame& F, const Args& A, const int lo, const int hi, const XcdBarrier& bar, LAS unsigned char* ring, Timer& TM) {
    constexpr int pb = 1 + lp * 20;
            const int pu = pb + 14 + 2 * c, pd = pu + 1;
            if (IN(pu) || IN(pd)) {
                SITE_PTRS
                MoeOrder mo;
                mo.pp[0] = 0;
#pragma unroll
                for (int e = 0; e < 8; ++e) { const int cn = (int)__hip_atomic_load((unsigned*)(F.ctl + CW_CNT + (size_t)(lp * 8 + e) * 64), RLX_AGENT); mo.cnt[e] = cn; mo.pp[e + 1] = mo.pp[e] + ((cn + 255) >> 8); }
                const int Ptot = mo.pp[8]; int nP = Ptot - c * MOE_CHUNK; nP = nP < 0 ? 0 : (nP > MOE_CHUNK ? MOE_CHUNK : nP);
                mo.cs = c * MOE_CHUNK; mo.rlist = (const int*)(ws + WS_RLIST);
                if (PHON(10) && IN(pu)) { mo.so.init(nP, 2 * DFFE / 256, F.G, (int)blockIdx.x); mo.GATHER_A = true; mo.bstride = (size_t)2 * DFFE * 1024 * 2;
                    pg8::Gemm g{H, (const bf16_t*)(ws + WS_BIG + BIG_MW13), 1024, 1024}; EpiSwiglu E{BIG, DFFE}; pg8::gemm_phase<EpiSwiglu, MoeOrder, true, true>(ring, g, mo, E, F.wave0); if (REP(10)) pg8::gemm_phase<EpiSwiglu, MoeOrder, true, true>(ring, g, mo, E, F.wave0); }
                SEAM(pu);
                if (PHON(11) && IN(pd)) { mo.so.init(nP, 4, F.G, (int)blockIdx.x); mo.GATHER_A = false; mo.bstride = (size_t)1024 * DFFE * 2;
                    pg8::Gemm g{BIG, (const bf16_t*)(ws + WS_BIG + BIG_MW2), DFFE, DFFE}; EpiMoeDown E{mo, (bf16_t*)(ws + WS_Y), (const float*)(ws + WS_GATE)}; pg8::gemm_phase<EpiMoeDown, MoeOrder, true, false>(ring, g, mo, E, F.wave0); if (REP(10)) pg8::gemm_phase<EpiMoeDown, MoeOrder, true, false>(ring, g, mo, E, F.wave0); }
            }
            SEAM(pd);
        }
template <int lp> __device__ __forceinline__ void layer_pair(Frame& F, const Args& A, const int lo, const int hi, const XcdBarrier& bar, LAS unsigned char* ring, Timer& TM) {
        const int pb = 1 + lp * 20, i0 = 2 * lp, i1 = 2 * lp + 1;
        if (PHON(1) && IN(pb + 0)) norm_phase(F, A, i0, 0, lp == 0 ? 1 : 2);
        SEAM(pb + 0);
        if (PHON(2) && IN(pb + 1)) { SITE_PTRS pg8::Gemm g{H, (const bf16_t*)(wss + W_WIN), 1024, 1024}; pg8::StaticOrder S; S.init(NPAN, NXBC / 256, F.G, (int)blockIdx.x);
            EpiXbc E{BIG, (float*)(ws + WS_DT), (bf16_t*)(ws + WS_HALO)}; pg8::gemm_phase<EpiXbc, pg8::StaticOrder, true, false>(ring, g, S, E, F.wave0); }
                if (REP(2)) { if (PHON(2) && IN(pb + 1)) { SITE_PTRS pg8::Gemm g{H, (const bf16_t*)(wss + W_WIN), 1024, 1024}; pg8::StaticOrder S; S.init(NPAN, NXBC / 256, F.G, (int)blockIdx.x);
            EpiXbc E{BIG, (float*)(ws + WS_DT), (bf16_t*)(ws + WS_HALO)}; pg8::gemm_phase<EpiXbc, pg8::StaticOrder, true, false>(ring, g, S, E, F.wave0); } }
        SEAM(pb + 1);
        if (PHON(3) && IN(pb + 2)) conv_phase(F, A, lp);
        SEAM(pb + 2);
        if (PHON(3) && IN(pb + 3)) scan_phase(F, A, lp);
                if (REP(3)) { if (PHON(3) && IN(pb + 3)) scan_phase(F, A, lp); }
        SEAM(pb + 3);
        if (PHON(4) && IN(pb + 4)) { SITE_PTRS pg8::Gemm g{H, (const bf16_t*)(wss + W_WZ), 1024, 1024}; pg8::StaticOrder S; S.init(NPAN, DIN / 256, F.G, (int)blockIdx.x);
            EpiGate E{(const bf16_t*)(ws + WS_Y), BIG, A.ssd_norm_w + (size_t)lp * DIN, (LAS float*)(F.lds + PSCR_OFF)}; pg8::gemm_phase<EpiGate, pg8::StaticOrder, true, false>(ring, g, S, E, F.wave0); }
                if (REP(2)) { if (PHON(4) && IN(pb + 4)) { SITE_PTRS pg8::Gemm g{H, (const bf16_t*)(wss + W_WZ), 1024, 1024}; pg8::StaticOrder S; S.init(NPAN, DIN / 256, F.G, (int)blockIdx.x);
            EpiGate E{(const bf16_t*)(ws + WS_Y), BIG, A.ssd_norm_w + (size_t)lp * DIN, (LAS float*)(F.lds + PSCR_OFF)}; pg8::gemm_phase<EpiGate, pg8::StaticOrder, true, false>(ring, g, S, E, F.wave0); } }
        SEAM(pb + 4);
        if (PHON(5) && IN(pb + 5)) { SITE_PTRS pg8::Gemm g{BIG, (const bf16_t*)(wss + W_WOUT), DIN, DIN}; pg8::StaticOrder S; S.init(NPAN, 4, F.G, (int)blockIdx.x);
            EpiResid E{ws, F.out, MODV + (size_t)i0 * 17 * 6144, 2, nullptr}; pg8::gemm_phase<EpiResid, pg8::StaticOrder, true, false>(ring, g, S, E, F.wave0); }
                if (REP(5)) { if (PHON(5) && IN(pb + 5)) { SITE_PTRS pg8::Gemm g{BIG, (const bf16_t*)(wss + W_WOUT), DIN, DIN}; pg8::StaticOrder S; S.init(NPAN, 4, F.G, (int)blockIdx.x);
            EpiResid E{ws, F.out, (const float*)(ws + WS_CTL), 2, nullptr}; pg8::gemm_phase<EpiResid, pg8::StaticOrder, true, false>(ring, g, S, E, F.wave0); } }
        SEAM(pb + 5);
        if (PHON(1) && IN(pb + 6)) norm_phase(F, A, i0, 1, 0);
                if (REP(1)) { if (PHON(1) && IN(pb + 6)) norm_phase(F, A, i0, 1, 0); }
        SEAM(pb + 6);
        if (PHON(6) && IN(pb + 7)) { SITE_PTRS pg8::Gemm g{H, (const bf16_t*)(wss + W_WUP), 1024, 1024}; pg8::StaticOrder S; S.init(NPAN, 2 * DFF / 256, F.G, (int)blockIdx.x);
            EpiSwiglu E{BIG, DFF}; pg8::gemm_phase<EpiSwiglu, pg8::StaticOrder, true, false>(ring, g, S, E, F.wave0); }
                if (REP(2)) { if (PHON(6) && IN(pb + 7)) { SITE_PTRS pg8::Gemm g{H, (const bf16_t*)(wss + W_WUP), 1024, 1024}; pg8::StaticOrder S; S.init(NPAN, 2 * DFF / 256, F.G, (int)blockIdx.x);
            EpiSwiglu E{BIG, DFF}; pg8::gemm_phase<EpiSwiglu, pg8::StaticOrder, true, false>(ring, g, S, E, F.wave0); } }
        SEAM(pb + 7);
        if (PHON(5) && IN(pb + 8)) { SITE_PTRS pg8::Gemm g{BIG, (const bf16_t*)(wss + W_WDN), DFF, DFF}; pg8::StaticOrder S; S.init(NPAN, 4, F.G, (int)blockIdx.x);
            EpiResid E{ws, F.out, MODV + (size_t)i0 * 17 * 6144, 5, nullptr}; pg8::gemm_phase<EpiResid, pg8::StaticOrder, true, false>(ring, g, S, E, F.wave0); }
                if (REP(5)) { if (PHON(5) && IN(pb + 8)) { SITE_PTRS pg8::Gemm g{BIG, (const bf16_t*)(wss + W_WDN), DFF, DFF}; pg8::StaticOrder S; S.init(NPAN, 4, F.G, (int)blockIdx.x);
            EpiResid E{ws, F.out, (const float*)(ws + WS_CTL), 5, nullptr}; pg8::gemm_phase<EpiResid, pg8::StaticOrder, true, false>(ring, g, S, E, F.wave0); } }
        SEAM(pb + 8);
        if (PHON(1) && IN(pb + 9)) norm_phase(F, A, i1, 0, 0);
                if (REP(1)) { if (PHON(1) && IN(pb + 9)) norm_phase(F, A, i1, 0, 0); }
        SEAM(pb + 9);
        if (PHON(7) && IN(pb + 10)) { SITE_PTRS pg8::Gemm g{H, (const bf16_t*)(wsa + W_WQKV), 1024, 1024}; pg8::StaticOrder S; S.init(NPAN, NQKV / 256, F.G, (int)blockIdx.x);
            EpiQkv E{BIG, (bf16_t*)(ws + WS_BIG + BIG_K), (bf16_t*)(ws + WS_BIG + BIG_V), A.attn_b_qkv + (size_t)lp * NQKV, (const float*)(ws + WS_ROPE)};
            pg8::gemm_phase<EpiQkv, pg8::StaticOrder, true, false>(ring, g, S, E, F.wave0); }
                if (REP(2)) { if (PHON(7) && IN(pb + 10)) { SITE_PTRS pg8::Gemm g{H, (const bf16_t*)(wsa + W_WQKV), 1024, 1024}; pg8::StaticOrder S; S.init(NPAN, NQKV / 256, F.G, (int)blockIdx.x);
            EpiQkv E{BIG, (bf16_t*)(ws + WS_BIG + BIG_K), (bf16_t*)(ws + WS_BIG + BIG_V), A.attn_b_qkv + (size_t)lp * NQKV, (const float*)(ws + WS_ROPE)};
            pg8::gemm_phase<EpiQkv, pg8::StaticOrder, true, false>(ring, g, S, E, F.wave0); } }
        SEAM(pb + 10);
        if (PHON(8) && IN(pb + 11)) attn_phase(F, A, lp, lp == 0);
                if (REP(8)) { if (PHON(8) && IN(pb + 11)) attn_phase(F, A, lp, lp == 0); }
        SEAM(pb + 11);
        if (PHON(5) && IN(pb + 12)) { SITE_PTRS pg8::Gemm g{(const bf16_t*)(ws + WS_BIG + BIG_O), (const bf16_t*)(wsa + W_WO), 1024, 1024}; pg8::StaticOrder S; S.init(NPAN, 4, F.G, (int)blockIdx.x);
            EpiResid E{ws, F.out, MODV + (size_t)i1 * 17 * 6144, 2, A.attn_b_o + (size_t)lp * 1024}; pg8::gemm_phase<EpiResid, pg8::StaticOrder, true, false>(ring, g, S, E, F.wave0); }
                if (REP(5)) { if (PHON(5) && IN(pb + 12)) { SITE_PTRS pg8::Gemm g{(const bf16_t*)(ws + WS_BIG + BIG_O), (const bf16_t*)(wsa + W_WO), 1024, 1024}; pg8::StaticOrder S; S.init(NPAN, 4, F.G, (int)blockIdx.x);
            EpiResid E{ws, F.out, (const float*)(ws + WS_CTL), 2, A.attn_b_o + (size_t)lp * 1024}; pg8::gemm_phase<EpiResid, pg8::StaticOrder, true, false>(ring, g, S, E, F.wave0); } }
        SEAM(pb + 12);
        if (PHON(9) && IN(pb + 13)) { norm_phase(F, A, i1, 1, 4 | (lp == 1 ? 16 : 0)); __syncthreads(); moe_convert(F, A, lp); if (REP(9)) { __syncthreads(); moe_convert(F, A, lp); } }
        SEAM(pb + 13);
    moe_chunk<lp, 0>(F, A, lo, hi, bar, ring, TM); moe_chunk<lp, 1>(F, A, lo, hi, bar, ring, TM); moe_chunk<lp, 2>(F, A, lo, hi, bar, ring, TM);
}
constexpr int N_PHASES = 42;
__global__ void __launch_bounds__(NWAVES * 64, 2) fwd_kernel(Args A) {
    extern __shared__ __attribute__((aligned(16))) unsigned char lds_raw[];
    Frame F;
    F.lds = (LAS unsigned char*)lds_raw;
    F.tid = threadIdx.x; F.lane = F.tid & 63; F.wave = __builtin_amdgcn_readfirstlane(F.tid >> 6); F.wave0 = F.wave; F.G = gridDim.x;
    F.ws0 = A.ws; F.out0 = A.out; F.ws = A.ws; F.ctl = (gu32*)(A.ws + WS_CTL); F.out = A.out;
    volatile LAS unsigned* MISC = (volatile LAS unsigned*)(F.lds + MISC_OFF);
    for (int u = F.tid; u < (LDS_BYTES - LDSCTL_OFF) / 4; u += NWAVES * 64) ((LAS unsigned*)(F.lds + LDSCTL_OFF))[u] = 0u;
    __syncthreads();
    const int lo = A.ph_lo, hi = A.ph_hi;
    XcdBarrier bar; bar.bar = (unsigned*)(F.ctl + CW_BAR); bar.x = 0; bar.st = MISC + 8; bar.wave0 = F.wave0;
    if (hi - lo > 1) bar = xcd_barrier_post((unsigned*)(F.ctl + CW_BAR), MISC + 8, F.wave0);
    LAS unsigned char* ring = F.lds;

    Timer TM; TM.prev = TIMER_ON ? __builtin_amdgcn_s_memrealtime() : 0ull; TM.acc = 0ull;
    if (PHON(0) && IN(0)) { p0_prologue(F, A); if (REP(0)) { __syncthreads(); p0_prologue(F, A); } }
    SEAM(0);
    layer_pair<0>(F, A, lo, hi, bar, ring, TM);
    layer_pair<1>(F, A, lo, hi, bar, ring, TM);
    if (PHON(1) && IN(41)) {
        norm_phase(F, A, 4, 0, 2 | 8);
        if (xb_ld((unsigned*)(F.ctl + CW_BAR) + XB_TMO) != 0u) {
            const float qn = __builtin_nanf("");
            for (size_t idx = (size_t)blockIdx.x * 512 + F.tid; idx < (size_t)NB * SEQ * DM / 4; idx += (size_t)F.G * 512) ((f32x4*)A.out)[idx] = (f32x4){qn, qn, qn, qn};
        }
    }
    if (TIMER_ON) { const unsigned long long now_ = __builtin_amdgcn_s_memrealtime(); if (41 >= TIMER_LO && 41 <= TIMER_HI) TM.acc += now_ - TM.prev;
        if (blockIdx.x == 0) { const unsigned long long tgt = now_ + TM.acc; while (__builtin_amdgcn_s_memrealtime() < tgt) __builtin_amdgcn_s_sleep(8); } }
#undef IN
#undef SEAM
}

extern "C" void kernel_launch(void* const* d_in, const int* in_sizes, int n_in, void* d_out, int out_size, void* d_ws, size_t ws_size, hipStream_t stream) {
    static int grid = 0;
    if (grid == 0) {
        if (n_in != 29 || in_sizes[0] != NB * SEQ * DM || out_size != NB * SEQ * DM || ws_size < WS_END) {
            fprintf(stderr, "kernel_launch: unexpected problem: n_in %d, in0 %d, out %d, ws %zu (need %zu); nothing launched\n", n_in, n_in > 0 ? in_sizes[0] : -1, out_size, ws_size, (size_t)WS_END); grid = -1; return; }
        int dev = 0, cus = 0, per_cu = 0;
        if (hipGetDevice(&dev) != hipSuccess || hipDeviceGetAttribute(&cus, hipDeviceAttributeMultiprocessorCount, dev) != hipSuccess) { fprintf(stderr, "kernel_launch: device query failed\n"); grid = -1; return; }
        if (hipFuncSetAttribute((const void*)fwd_kernel, hipFuncAttributeMaxDynamicSharedMemorySize, LDS_BYTES) != hipSuccess) { fprintf(stderr, "kernel_launch: hipFuncSetAttribute failed\n"); grid = -1; return; }
        if (hipOccupancyMaxActiveBlocksPerMultiprocessor(&per_cu, (const void*)fwd_kernel, NWAVES * 64, LDS_BYTES) != hipSuccess || per_cu < 1)
            fprintf(stderr, "kernel_launch: note: occupancy query reports %d workgroups per CU\n", per_cu);
        (void)hipGetLastError();
        grid = cus;
    }
    if (grid < 0) return;
    if (hipMemsetAsync((char*)d_ws + WS_CTL, 0, CTL_ZERO_BYTES, stream) != hipSuccess) { fprintf(stderr, "kernel_launch: memset failed\n"); return; }
    Args a{};
    const float** ap = (const float**)&a;
    for (int i = 0; i < 29; ++i) ap[i] = (const float*)d_in[i];
    a.out = (float*)d_out; a.ws = (unsigned char*)d_ws;
#if MK_PER_PHASE
    for (int k = 0; k < N_PHASES; ++k) { a.ph_lo = k; a.ph_hi = k + 1; hipLaunchKernelGGL(fwd_kernel, dim3(grid), dim3(NWAVES * 64), LDS_BYTES, stream, a); }
#else
    a.ph_lo = 0; a.ph_hi = N_PHASES;
    hipLaunchKernelGGL(fwd_kernel, dim3(grid), dim3(NWAVES * 64), LDS_BYTES, stream, a);
#endif
    const hipError_t le = hipPeekAtLastError();
    if (le != hipSuccess) fprintf(stderr, "kernel_launch: launch failed: %s\n", hipGetErrorName(le));
}
```

```cpp
#include <hip/hip_runtime.h>
#include <cstdio>
#include <cstdint>

#define LAS __attribute__((address_space(3)))
#define GAS __attribute__((address_space(1)))
typedef unsigned short bf16_t;
typedef short bf16x8 __attribute__((ext_vector_type(8)));
typedef short s16x4 __attribute__((ext_vector_type(4)));
typedef float f32x4 __attribute__((ext_vector_type(4)));
typedef float f32x2 __attribute__((ext_vector_type(2)));
typedef float f32x16 __attribute__((ext_vector_type(16)));
typedef unsigned u32x4 __attribute__((ext_vector_type(4)));
typedef unsigned u32x2 __attribute__((ext_vector_type(2)));
typedef GAS unsigned gu32;

namespace pg8 {
constexpr int BM = 256, BK = 64, HALF = 128, HTB = HALF * BK * 2  , STAGE_BYTES = 8 * HTB, NXCD = 8, WGM = 8;

__host__ __device__ __forceinline__ int lds_byte(int r, int c) { const int st = (r >> 4) * 2 + (c >> 5), rr = r & 15, cc = c & 31, ob = rr * 64 + cc * 2; return st * 1024 + (ob ^ (((ob >> 9) & 1) << 5)); }
__host__ __device__ __forceinline__ void stage_rc(int b, int& R, int& C) { const int st = b / 1024, sb = b % 1024, swz = sb ^ (((sb >> 9) & 1) << 5); R = (st >> 1) * 16 + swz / 64; C = (st & 1) * 32 + (swz % 64) / 2; }
__host__ __device__ __forceinline__ int perm32(int rho) { const int n = rho >> 4, i = rho & 15; return 8 * (i >> 2) + 4 * n + (i & 3); }

struct Unit { int pm, pn; };
struct Gemm { const bf16_t* A; const bf16_t* Bt; int lda, K; };

struct StaticOrder {
    int nM, nN, nwg, G, c;
    __device__ void init(int nM_, int nN_, int G_, int c_) { nM = nM_; nN = nN_; nwg = nM * nN; G = G_; c = c_; }
    __device__ bool next(int i, Unit& u) const {
        const long L = (long)i * G + c; if (L >= nwg) return false;
        int wgid = (int)L; { const int q = nwg / NXCD, r = nwg % NXCD, xcd = wgid % NXCD, off = wgid / NXCD; wgid = (xcd < r ? xcd * (q + 1) : r * (q + 1) + (xcd - r) * q) + off; }
        const int nig = WGM * nN, gid = wgid / nig, fm = gid * WGM, gsz = (nM - fm) < WGM ? (nM - fm) : WGM;
        u.pm = fm + ((wgid % nig) % gsz); u.pn = (wgid % nig) / gsz; return true;
    }
    __device__ __forceinline__ const char* a_base(const Gemm& g, const Unit& u) const { return (const char*)g.A + (size_t)u.pm * (size_t)(BM * 2) * g.lda; }
    __device__ __forceinline__ const char* b_base(const Gemm& g, const Unit& u) const { return (const char*)g.Bt + (size_t)u.pn * (size_t)(BM * 2) * g.K; }
    __device__ __forceinline__ unsigned row_off(const Gemm& g, const Unit&, int r) const { return (unsigned)r * (unsigned)g.lda * 2u; }
};

__device__ __forceinline__ unsigned cvt_pk_bf16(float lo, float hi) { unsigned r; asm volatile("v_cvt_pk_bf16_f32 %0, %1, %2" : "=v"(r) : "v"(lo), "v"(hi)); return r; }

template <class Epi, class Sched, bool ALIGN_EPI, bool GATHER>
__device__ __forceinline__ void gemm_phase(LAS unsigned char* lds, const Gemm g, const Sched& S, const Epi& E, const int wave0, const unsigned delay_ticks = 0u) {
    if (delay_ticks) { const unsigned long long t0_ = __builtin_amdgcn_s_memrealtime(); while (__builtin_amdgcn_s_memrealtime() - t0_ < (unsigned long long)delay_ticks) __builtin_amdgcn_s_sleep(16); }
    int tid_ = wave0 * 64 + (int)__builtin_amdgcn_mbcnt_hi(~0u, __builtin_amdgcn_mbcnt_lo(~0u, 0u)); asm volatile("" : "+v"(tid_));
    const int tid = tid_, wid = __builtin_amdgcn_readfirstlane(tid >> 6), lane = tid & 63, wr = wid >> 2, wc = wid & 3, fr = lane & 15, fq = lane >> 4;
    const int K = g.K, nt = K / BK;
    unsigned voffB[2];
#pragma unroll
    for (int i = 0; i < 2; ++i) { int R, C; stage_rc(tid * 16 + i * 8192, R, C); const int Rb = Epi::PERM ? ((R & ~31) + perm32(R & 31)) : R; voffB[i] = (unsigned)(Rb * K + C) * 2u; }
    const size_t kstep = (size_t)(BK * 2);
    const size_t hstepB = (size_t)HALF * K * 2;
    const unsigned ldsw = (unsigned)wid * 1024u;
    const int aoff = lds_byte(wr * 64 + fr, fq * 8), boff = lds_byte(wc * 32 + fr, fq * 8);
#define PG8_SA(b, h) (((b) * 2 + (h)) * HTB)
#define PG8_SB(b, h) ((4 + (b) * 2 + (h)) * HTB)
#define PG8_STAGE(bufoff, gbase, voff) do { _Pragma("unroll") for (int _i = 0; _i < 2; ++_i) \
        __builtin_amdgcn_global_load_lds((const unsigned*)((const char*)(gbase) + (voff)[_i]), (LAS unsigned*)(lds + (bufoff) + ldsw + _i * 8192), 16, 0, 0); } while (0)
#define PG8_LDA(dst, b, h) do { _Pragma("unroll") for (int m = 0; m < 4; ++m) _Pragma("unroll") for (int k = 0; k < 2; ++k) dst[m][k] = *(const LAS bf16x8*)(lds + PG8_SA(b, h) + aoff + m * 2048 + k * 1024); } while (0)
#define PG8_LDB(dst, b, h) do { _Pragma("unroll") for (int n = 0; n < 2; ++n) _Pragma("unroll") for (int k = 0; k < 2; ++k) dst[n][k] = *(const LAS bf16x8*)(lds + PG8_SB(b, h) + boff + n * 2048 + k * 1024); } while (0)
#define PG8_MMA(ai, bj, At, Bt) do { __builtin_amdgcn_s_setprio(1); _Pragma("unroll") for (int m = 0; m < 4; ++m) _Pragma("unroll") for (int n = 0; n < 2; ++n) _Pragma("unroll") for (int k = 0; k < 2; ++k) \
        acc[ai][bj][m][n] = __builtin_amdgcn_mfma_f32_16x16x32_bf16(Bt[n][k], At[m][k], acc[ai][bj][m][n], 0, 0, 0); __builtin_amdgcn_s_setprio(0); } while (0)
#define PG8_WAIT_V(n) asm volatile("s_waitcnt vmcnt(" #n ")" ::: "memory")
#define PG8_WAIT_L(n) asm volatile("s_waitcnt lgkmcnt(" #n ")" ::: "memory")
#define PG8_BAR __builtin_amdgcn_s_barrier()
#define PG8_SCHED __builtin_amdgcn_sched_barrier(0)
    Unit cur, nxt; int ui = 0;
    if (!S.next(0, cur)) return;
    f32x4 acc[2][2][4][2];
#pragma unroll
    for (int a = 0; a < 2; ++a)
#pragma unroll
        for (int b = 0; b < 2; ++b)
#pragma unroll
            for (int m = 0; m < 4; ++m)
#pragma unroll
                for (int n = 0; n < 2; ++n) acc[a][b][m][n] = (f32x4){0.f, 0.f, 0.f, 0.f};
    bf16x8 At[4][2], B0[2][2], B1[2][2];
    const char* cA = S.a_base(g, cur); const char* cB = S.b_base(g, cur);
    unsigned va[2][2], vn[2][2];
#pragma unroll
    for (int h = 0; h < 2; ++h)
#pragma unroll
        for (int i = 0; i < 2; ++i) { int R, C; stage_rc(tid * 16 + i * 8192, R, C); va[h][i] = S.row_off(g, cur, h * HALF + R) + (unsigned)C * 2u; vn[h][i] = va[h][i]; }
    PG8_STAGE(PG8_SB(0, 0), cB, voffB); PG8_STAGE(PG8_SB(0, 1), cB + hstepB, voffB); PG8_STAGE(PG8_SA(0, 0), cA, va[0]); PG8_STAGE(PG8_SA(0, 1), cA, va[1]);
    if (wr == 1) PG8_BAR;
    PG8_WAIT_V(2); PG8_BAR;
    PG8_STAGE(PG8_SB(1, 0), cB + kstep, voffB); PG8_STAGE(PG8_SA(1, 0), cA + kstep, va[0]); PG8_STAGE(PG8_SB(1, 1), cB + hstepB + kstep, voffB);
    PG8_WAIT_V(6); PG8_BAR;
    for (;;) {
        const bool has_next = S.next(ui + 1, nxt);
        const char* nA = has_next ? S.a_base(g, nxt) : cA; const char* nB = has_next ? S.b_base(g, nxt) : cB;
        if (GATHER) {
            if (has_next) {
#pragma unroll
                for (int h = 0; h < 2; ++h)
#pragma unroll
                    for (int i = 0; i < 2; ++i) { int R, C; stage_rc(tid * 16 + i * 8192, R, C); vn[h][i] = S.row_off(g, nxt, h * HALF + R) + (unsigned)C * 2u; }
            } else {
#pragma unroll
                for (int h = 0; h < 2; ++h)
#pragma unroll
                    for (int i = 0; i < 2; ++i) vn[h][i] = va[h][i];
            }
        }
        for (int t = 0; t < nt; t += 2) {
            const bool last = (t == nt - 2);
            const char* a1 = cA + (size_t)(t + 1) * kstep;
            const char* a2 = last ? nA : cA + (size_t)(t + 2) * kstep; const char* b2 = last ? nB : cB + (size_t)(t + 2) * kstep;
            const char* a3 = a2 + kstep; const char* b3 = b2 + kstep;
            unsigned v2[2][2];
#pragma unroll
            for (int h = 0; h < 2; ++h)
#pragma unroll
                for (int i = 0; i < 2; ++i) v2[h][i] = (GATHER && last) ? vn[h][i] : va[h][i];
            PG8_LDB(B0, 0, 0); PG8_LDB(B1, 0, 1); PG8_SCHED; PG8_LDA(At, 0, 0); PG8_STAGE(PG8_SA(1, 1), a1, va[1]);
            PG8_WAIT_V(8); PG8_WAIT_L(0); PG8_BAR; PG8_MMA(0, 0, At, B0); PG8_MMA(0, 1, At, B1); PG8_BAR; PG8_SCHED;
            PG8_LDA(At, 0, 1); PG8_STAGE(PG8_SB(0, 0), b2, voffB); PG8_STAGE(PG8_SB(0, 1), b2 + hstepB, voffB); PG8_STAGE(PG8_SA(0, 0), a2, v2[0]);
            PG8_WAIT_V(8); PG8_WAIT_L(0); PG8_BAR; PG8_MMA(1, 0, At, B0); PG8_MMA(1, 1, At, B1); PG8_BAR; PG8_SCHED;
            PG8_LDB(B0, 1, 0); PG8_LDB(B1, 1, 1); PG8_SCHED; PG8_LDA(At, 1, 0); PG8_STAGE(PG8_SA(0, 1), a2, v2[1]);
            PG8_WAIT_V(8); PG8_WAIT_L(0); PG8_BAR; PG8_MMA(0, 0, At, B0); PG8_MMA(0, 1, At, B1); PG8_BAR; PG8_SCHED;
            PG8_LDA(At, 1, 1); PG8_STAGE(PG8_SB(1, 0), b3, voffB); PG8_STAGE(PG8_SB(1, 1), b3 + hstepB, voffB); PG8_STAGE(PG8_SA(1, 0), a3, v2[0]);
            PG8_WAIT_V(8); PG8_WAIT_L(0); PG8_BAR; PG8_MMA(1, 0, At, B0); PG8_MMA(1, 1, At, B1); PG8_BAR; PG8_SCHED;
        }
        if constexpr (ALIGN_EPI) { if (wr == 0) PG8_BAR; }
        { int l2 = (int)__builtin_amdgcn_mbcnt_hi(~0u, __builtin_amdgcn_mbcnt_lo(~0u, 0u)); asm volatile("" : "+v"(l2)); E(acc, cur, wr, wc, l2 & 15, l2 >> 4); }
        if (!has_next) break;
#pragma unroll
        for (int a = 0; a < 2; ++a)
#pragma unroll
            for (int b = 0; b < 2; ++b)
#pragma unroll
                for (int m = 0; m < 4; ++m)
#pragma unroll
                    for (int n = 0; n < 2; ++n) acc[a][b][m][n] = (f32x4){0.f, 0.f, 0.f, 0.f};
        cur = nxt; cA = nA; cB = nB; ++ui;
        if (GATHER) {
#pragma unroll
            for (int h = 0; h < 2; ++h)
#pragma unroll
                for (int i = 0; i < 2; ++i) va[h][i] = vn[h][i];
        }
        if constexpr (ALIGN_EPI) { if (wr == 1) PG8_BAR; }
    }
    PG8_WAIT_V(0);
    if constexpr (!ALIGN_EPI) { if (wr == 0) PG8_BAR; }
    PG8_BAR;
#undef PG8_SA
#undef PG8_SB
#undef PG8_STAGE
#undef PG8_LDA
#undef PG8_LDB
#undef PG8_MMA
#undef PG8_WAIT_V
#undef PG8_WAIT_L
#undef PG8_BAR
#undef PG8_SCHED
}
}

constexpr int DM = 1024, NB = 16, SEQ = 4096, NCTX = 256, SROW = SEQ + NCTX  , MROWS = NB * SROW  , NPAN = MROWS / 256  ;
constexpr int DIN = 2048, CONVCH = 4096, SSD_IN = 6208, NXBC = 4352  ;
constexpr int QW = 1024, KVW = 256, NQKV = 1536;
constexpr int DFF = 2816, NEXP = 8, DFFE = 3584;
constexpr float EPS = 1e-6f;
constexpr int MOE_CHUNK = 192;
constexpr int NWAVES = 8;

constexpr size_t MiB = 1u << 20;
constexpr size_t WS_CTL = 0, CTL_ZERO_BYTES = 1 * MiB;
constexpr size_t WS_MODV = 2 * MiB;
constexpr size_t WS_ROPE = 4 * MiB;
constexpr size_t WS_GATE = 5 * MiB;
constexpr size_t WS_RLIST = 6 * MiB;
constexpr size_t WS_CX = 10 * MiB;
constexpr size_t WS_W = 26 * MiB;
constexpr size_t W_SSD_STRIDE = 33 * MiB, W_WZ = 0, W_WIN = 4 * MiB, W_WOUT = 12 * MiB + MiB / 2, W_WUP = 16 * MiB + MiB / 2, W_WDN = 27 * MiB + MiB / 2;
constexpr size_t W_ATT0 = 66 * MiB, W_ATT_STRIDE = 5 * MiB, W_WQKV = 0, W_WO = 3 * MiB;
constexpr size_t WS_H = 102 * MiB;
constexpr size_t WS_BIG = 238 * MiB;
constexpr size_t BIG_K = 136 * MiB, BIG_V = 170 * MiB, BIG_O = 204 * MiB, BIG_MW13 = 336 * MiB, BIG_MW2 = 448 * MiB;
static_assert((size_t)MOE_CHUNK * 256 * DFFE * 2 <= BIG_MW13 && BIG_O + 136 * MiB <= BIG_MW13 + 200 * MiB && BIG_MW2 + 56 * MiB <= 544 * MiB, "BIG region map");
constexpr size_t WS_Y = 782 * MiB;
constexpr size_t WS_DT = 1054 * MiB;
constexpr size_t WS_HALO = 1071 * MiB;
constexpr size_t WS_END = 1080 * MiB;
constexpr int CW_BAR = 4096;
constexpr int CW_CNT = 16384;

constexpr int RING_BYTES = 131072;
constexpr int PSCR_OFF = 131072;
constexpr int LDSCTL_OFF = 151552, MISC_OFF = LDSCTL_OFF + 320;
constexpr int LDS_BYTES = 155648;

#define RLX_AGENT __ATOMIC_RELAXED, __HIP_MEMORY_SCOPE_AGENT
#define LDS_WAIT() asm volatile("s_waitcnt lgkmcnt(0)" ::: "memory")
#define VM_WAIT() asm volatile("s_waitcnt vmcnt(0)" ::: "memory")
__device__ __forceinline__ unsigned f2bf(float f) { unsigned u = __builtin_bit_cast(unsigned, f); return (u + 0x7fffu + ((u >> 16) & 1u)) >> 16; }
__device__ __forceinline__ unsigned pk2(float lo, float hi) { return f2bf(lo) | (f2bf(hi) << 16); }
__device__ __forceinline__ float bf_lo(unsigned u) { return __builtin_bit_cast(float, u << 16); }
__device__ __forceinline__ float bf_hi(unsigned u) { return __builtin_bit_cast(float, u & 0xffff0000u); }
__device__ __forceinline__ float bf1(bf16_t h) { return __builtin_bit_cast(float, (unsigned)h << 16); }
__device__ __forceinline__ float siluf(float v) { return v * __builtin_amdgcn_rcpf(1.0f + __expf(-v)); }
__device__ __forceinline__ float shx(float v, int mask, int lane) { return __builtin_bit_cast(float, __builtin_amdgcn_ds_bpermute((lane ^ mask) << 2, __builtin_bit_cast(int, v))); }
__device__ __forceinline__ float wave_sum(float v, int lane) {
#pragma unroll
    for (int o = 1; o < 64; o <<= 1) v += shx(v, o, lane);
    return v;
}

__device__ __forceinline__ int lane_id() { return (int)__builtin_amdgcn_mbcnt_hi(~0u, __builtin_amdgcn_mbcnt_lo(~0u, 0u)); }
#define XB_TMO      128
#define XB_XCNT(j)  (256  + 64 * (j))
#define XB_XSUB(j)  (1280 + 64 * (j))
#define XB_XGEN(j)  (2304 + 64 * (j))
#define XB_TOP      3328
#define XB_TOPGEN   3392
#define XCD_BAR_WORDS 3456
#define XB_SPIN_CAP (1u << 18)

__device__ __forceinline__ unsigned xb_ld(unsigned* p)              { return __hip_atomic_load(p, __ATOMIC_RELAXED, __HIP_MEMORY_SCOPE_AGENT); }
__device__ __forceinline__ unsigned xb_add(unsigned* p, unsigned v) { return __hip_atomic_fetch_add(p, v, __ATOMIC_RELAXED, __HIP_MEMORY_SCOPE_AGENT); }
__device__ __forceinline__ unsigned xb_xcc_id() { return (unsigned)__builtin_amdgcn_s_getreg((3 << 11) | 20) & 0xFu; }
#define XB_SPIN(cond, bar) do { unsigned _sp = 0; while (cond) { __builtin_amdgcn_s_sleep(1); \
    if ((++_sp & 255u) == 0u) { if (xb_ld(&(bar)[XB_TMO])) break; if (_sp > XB_SPIN_CAP) { atomicAdd(&(bar)[XB_TMO], 1u); break; } } } } while (0)

struct XcdBarrier {
    unsigned* bar; unsigned x;
    volatile LAS unsigned* st;
    int wave0;
};
__device__ __forceinline__ XcdBarrier xcd_barrier_post(unsigned* bar, volatile LAS unsigned* st, int wave0) {
    XcdBarrier b; b.bar = bar; b.x = xb_xcc_id(); b.st = st; b.wave0 = wave0;
    if (wave0 == 0 && lane_id() == 0) (void)xb_add(&bar[XB_XCNT(b.x)], 1u);
    return b;
}
__device__ __forceinline__ void xcd_barrier_complete(unsigned* bar, unsigned x, unsigned& nloc, unsigned& nx) {
    const unsigned G = gridDim.x * gridDim.y * gridDim.z;
    unsigned sum, cnt, mine, sp = 0u;
    for (;;) {
        sum = 0u; cnt = 0u; mine = 0u;
#pragma unroll
        for (unsigned j = 0; j < 16; ++j) { const unsigned c = xb_ld(&bar[XB_XCNT(j)]); sum += c; cnt += (c > 0u) ? 1u : 0u; mine = (j == x) ? c : mine; }
        if (sum == G) break;
        __builtin_amdgcn_s_sleep(1);
        if ((++sp & 255u) == 0u) { if (xb_ld(&bar[XB_TMO])) break; if (sp > XB_SPIN_CAP) { atomicAdd(&bar[XB_TMO], 1u); break; } }
    }
    nloc = mine > 0u ? mine : 1u; nx = cnt > 0u ? cnt : 1u;
}
__device__ __forceinline__ void xcd_barrier(const XcdBarrier& b) {
    asm volatile("s_waitcnt vmcnt(0)" ::: "memory");
    __syncthreads();
    if (b.wave0 == 0 && lane_id() == 0) {
        unsigned* bar = b.bar;
        __builtin_amdgcn_s_waitcnt(0);
        unsigned nloc = b.st[0], nx = b.st[1];
        if (nloc == 0u) { xcd_barrier_complete(bar, b.x, nloc, nx); b.st[0] = nloc; b.st[1] = nx; }
        const unsigned old = xb_add(&bar[XB_XSUB(b.x)], 1u);
        const unsigned gen = old / nloc;
        if (old + 1u == (gen + 1u) * nloc) {
            __builtin_amdgcn_fence(__ATOMIC_RELEASE, "agent");
            asm volatile("s_waitcnt vmcnt(0)" ::: "memory");
            const unsigned og = xb_add(&bar[XB_TOP], 1u);
            const unsigned tg = og / nx;
            if (og + 1u == (tg + 1u) * nx) xb_add(&bar[XB_TOPGEN], 1u);
            else XB_SPIN(xb_ld(&bar[XB_TOPGEN]) == tg, bar);
            __builtin_amdgcn_fence(__ATOMIC_ACQUIRE, "agent");
            xb_add(&bar[XB_XGEN(b.x)], 1u);
            asm volatile("s_waitcnt vmcnt(0)" ::: "memory");
        } else {
            XB_SPIN(xb_ld(&bar[XB_XGEN(b.x)]) == gen, bar);
            __builtin_amdgcn_fence(__ATOMIC_ACQUIRE, "agent");
            asm volatile("s_waitcnt vmcnt(0)" ::: "memory");
        }
    }
    __syncthreads();
}

struct Args {
    const float *x, *c, *ctx, *c_ctx, *w_mod, *b_mod, *norm1_w, *norm2_w, *ssd_w_in, *ssd_conv_w, *ssd_conv_b, *ssd_dt_bias, *ssd_a_log, *ssd_d, *ssd_norm_w, *ssd_w_out,
                *attn_w_qkv, *attn_b_qkv, *attn_sink, *attn_w_o, *attn_b_o, *ffn_w1, *ffn_w3, *ffn_w2, *moe_router, *moe_w1, *moe_w3, *moe_w2, *final_norm_w;
    float* out; unsigned char* ws; int ph_lo, ph_hi;
};
struct Frame {
    LAS unsigned char* lds;
    int tid, lane, wave, G;
    unsigned char* ws; gu32* ctl; float* out;
    unsigned char* ws0; float* out0; int wave0;
};
__device__ __forceinline__ void phase_enter(Frame& F) { int l = lane_id(); asm volatile("" : "+v"(l)); F.lane = l; F.wave = F.wave0; F.tid = F.wave0 * 64 + l;
    unsigned char* w = F.ws0; float* o = F.out0; asm volatile("" : "+s"(w), "+s"(o)); F.ws = w; F.ctl = (gu32*)(w + WS_CTL); F.out = o; }
__device__ __forceinline__ float* resid_row(const Frame& F, int R) {
    const int b = R / SROW, s = R - b * SROW;
    return s < NCTX ? (float*)(F.ws + WS_CX) + (size_t)(b * NCTX + s) * DM : F.out + (size_t)(b * SEQ + s - NCTX) * DM;
}
__device__ __forceinline__ float* resid_panel(const Frame& F, int pm, int& cond) {
    const int b = pm / 17, j = pm - b * 17; cond = j == 0 ? 16 : b;
    return j == 0 ? (float*)(F.ws + WS_CX) + (size_t)(b * NCTX) * DM : F.out + (size_t)(b * SEQ + (j - 1) * 256) * DM;
}

__device__ __forceinline__ void transpose_item(const float* W, int ldw, int col0, int ncb, int K, bf16_t* WT, int mode, int half, LAS float* scr, int item, int lane) {
    const int kb = item / ncb, nb = item - kb * ncb, k0 = 64 * kb, n0 = 32 * nb;
    float tv[32];
#pragma unroll
    for (int i = 0; i < 32; ++i) tv[i] = W[(size_t)(k0 + 2 * i + (lane >> 5)) * ldw + col0 + n0 + (lane & 31)];
#pragma unroll
    for (int i = 0; i < 32; ++i) scr[(2 * i + (lane >> 5)) * 33 + (lane & 31)] = tv[i];
    LDS_WAIT(); asm volatile("" ::: "memory");
    const int c = lane & 7;
#pragma unroll
    for (int j = 0; j < 4; ++j) { const int n = (lane >> 3) + 8 * j; const LAS float* s = scr + (8 * c) * 33 + n;
        u32x4 o; o.x = pk2(s[0 * 33], s[1 * 33]); o.y = pk2(s[2 * 33], s[3 * 33]); o.z = pk2(s[4 * 33], s[5 * 33]); o.w = pk2(s[6 * 33], s[7 * 33]);
        const int cl = n0 + n; const int drow = mode == 0 ? cl : ((cl >> 7) * 256 + half * 128 + (cl & 127));
        *(GAS u32x4*)(WT + (size_t)drow * K + k0 + 8 * c) = o; }
    LDS_WAIT(); asm volatile("" ::: "memory");
}
__device__ __forceinline__ void p0_prologue(Frame& F, const Args& A) {
    phase_enter(F);
    {
        LAS float* sc = (LAS float*)F.lds;
        LAS float* red = (LAS float*)(F.lds + 81920);
        for (int idx = F.tid; idx < 17 * 1024; idx += 512) { const int cb = idx >> 10, k = idx & 1023; const float v = cb < 16 ? A.c[cb * 1024 + k] : A.c_ctx[k]; sc[k * 20 + cb] = v / (1.0f + expf(-v)); }
        __syncthreads();
        float* MODV = (float*)(F.ws + WS_MODV);
        for (int item = blockIdx.x; item < 4 * 96; item += F.G) {
            const int i = item / 96, cblk = item - i * 96;
            const float* Wm = A.w_mod + (size_t)i * 1024 * 6144 + cblk * 64 + F.lane;
            float acc[17];
#pragma unroll
            for (int cb = 0; cb < 17; ++cb) acc[cb] = 0.f;
            const int k0 = F.wave * 128;
#pragma unroll 4
            for (int kk = 0; kk < 128; ++kk) { const int k = k0 + kk; const float w = Wm[(size_t)k * 6144]; const LAS float* s = sc + k * 20;
#pragma unroll
                for (int cb = 0; cb < 17; ++cb) acc[cb] += s[cb] * w; }
#pragma unroll
            for (int cb = 0; cb < 17; ++cb) red[(F.wave * 17 + cb) * 64 + F.lane] = acc[cb];
            __syncthreads();
            for (int idx = F.tid; idx < 17 * 64; idx += 512) { const int cb = idx >> 6, l = idx & 63; float s = 0.f;
#pragma unroll
                for (int w = 0; w < 8; ++w) s += red[(w * 17 + cb) * 64 + l];
                MODV[(size_t)(i * 17 + cb) * 6144 + cblk * 64 + l] = s + A.b_mod[i * 6144 + cblk * 64 + l]; }
            __syncthreads();
        }
    }
    if (blockIdx.x == 0) { float* RT = (float*)(F.ws + WS_ROPE);
        for (int idx = F.tid; idx < 1024; idx += 512) { const int id = idx >> 4, f = idx & 15; const float inv = __builtin_amdgcn_exp2f(-(float)f * (13.287712379549449f / 16.0f)); const float ang = (float)id * inv;
            RT[idx] = __cosf(ang); RT[1024 + idx] = __sinf(ang); } }
    __syncthreads();
    {
        LAS float* scr = (LAS float*)(F.lds + F.wave * 16384);
        const int gw = blockIdx.x * NWAVES + F.wave, NGW = F.G * NWAVES;
        constexpr int I1 = 16 * 64, I2 = 16 * 130, I3 = 32 * 32, I4 = 16 * 88, I5 = 16 * 88, I6 = 44 * 32, I7 = 16 * 48, I8 = 16 * 32, IPER = I1 + I2 + I3 + I4 + I5 + I6 + I7 + I8;
        for (int it = gw; it < 2 * IPER; it += NGW) {
            const int j = it / IPER; int r = it - j * IPER;
            unsigned char* wss = F.ws + WS_W + (size_t)j * W_SSD_STRIDE; unsigned char* wsa = F.ws + WS_W + W_ATT0 + (size_t)j * W_ATT_STRIDE;
            if (r < I1) { transpose_item(A.ssd_w_in + (size_t)j * 1024 * SSD_IN, SSD_IN, 0, 64, 1024, (bf16_t*)(wss + W_WZ), 0, 0, scr, r, F.lane); continue; } r -= I1;
            if (r < I2) { transpose_item(A.ssd_w_in + (size_t)j * 1024 * SSD_IN, SSD_IN, 2048, 130, 1024, (bf16_t*)(wss + W_WIN), 0, 0, scr, r, F.lane); continue; } r -= I2;
            if (r < I3) { transpose_item(A.ssd_w_out + (size_t)j * 2048 * 1024, 1024, 0, 32, 2048, (bf16_t*)(wss + W_WOUT), 0, 0, scr, r, F.lane); continue; } r -= I3;
            if (r < I4) { transpose_item(A.ffn_w1 + (size_t)j * 1024 * DFF, DFF, 0, 88, 1024, (bf16_t*)(wss + W_WUP), 1, 0, scr, r, F.lane); continue; } r -= I4;
            if (r < I5) { transpose_item(A.ffn_w3 + (size_t)j * 1024 * DFF, DFF, 0, 88, 1024, (bf16_t*)(wss + W_WUP), 1, 1, scr, r, F.lane); continue; } r -= I5;
            if (r < I6) { transpose_item(A.ffn_w2 + (size_t)j * DFF * 1024, 1024, 0, 32, DFF, (bf16_t*)(wss + W_WDN), 0, 0, scr, r, F.lane); continue; } r -= I6;
            if (r < I7) { transpose_item(A.attn_w_qkv + (size_t)j * 1024 * NQKV, NQKV, 0, 48, 1024, (bf16_t*)(wsa + W_WQKV), 0, 0, scr, r, F.lane); continue; } r -= I7;
            transpose_item(A.attn_w_o + (size_t)j * 1024 * 1024, 1024, 0, 32, 1024, (bf16_t*)(wsa + W_WO), 0, 0, scr, r, F.lane);
        }
        for (int j = 0; j < 2; ++j) { u32x4* z = (u32x4*)(F.ws + WS_W + (size_t)j * W_SSD_STRIDE + W_WIN + (size_t)4160 * 1024 * 2);
            for (int idx = blockIdx.x * 512 + F.tid; idx < 192 * 1024 * 2 / 16; idx += F.G * 512) z[idx] = (u32x4){0u, 0u, 0u, 0u}; }
    }
}
__device__ __forceinline__ void moe_convert(Frame& F, const Args& A, int j, int wg0, int nwg) {
    phase_enter(F);
    LAS float* scr = (LAS float*)(F.lds + F.wave * 16384);
    const int gw = ((int)blockIdx.x - wg0) * NWAVES + F.wave, NGW = nwg * NWAVES;
    constexpr int IE = 16 * 112, I2 = 56 * 32;
    bf16_t* MW13 = (bf16_t*)(F.ws + WS_BIG + BIG_MW13); bf16_t* MW2 = (bf16_t*)(F.ws + WS_BIG + BIG_MW2);
    for (int it = gw; it < 8 * (2 * IE + I2); it += NGW) {
        const int e = it / (2 * IE + I2); int r = it - e * (2 * IE + I2);
        const size_t we = (size_t)(j * 8 + e) * 1024 * DFFE;
        if (r < IE) { transpose_item(A.moe_w1 + we, DFFE, 0, 112, 1024, MW13 + (size_t)e * 7168 * 1024, 1, 0, scr, r, F.lane); continue; } r -= IE;
        if (r < IE) { transpose_item(A.moe_w3 + we, DFFE, 0, 112, 1024, MW13 + (size_t)e * 7168 * 1024, 1, 1, scr, r, F.lane); continue; } r -= IE;
        transpose_item(A.moe_w2 + we, 1024, 0, 32, DFFE, MW2 + (size_t)e * 1024 * DFFE, 0, 0, scr, r, F.lane);
    }
}

__device__ __forceinline__ void norm_phase(Frame& F, const Args& A, int i, int which, int mode) {
    phase_enter(F);
    const bool first = mode & 1, combine = mode & 2, route = mode & 4, fin = mode & 8, lastl = mode & 16;
    const float* MODV = (const float*)(F.ws + WS_MODV);
    bf16_t* H = (bf16_t*)(F.ws + WS_H);
    const bf16_t* EO = (const bf16_t*)(F.ws + WS_Y);
    LAS float* rt = (LAS float*)F.lds;
    LAS int* ents = (LAS int*)(F.lds + 32768);
    const int jm = i >> 1;
    if (route) { const float* rg = A.moe_router + (size_t)jm * 1024 * 8; for (int idx = F.tid; idx < 8192; idx += 512) rt[(idx & 7) * 1024 + (idx >> 3)] = rg[idx]; }
    __syncthreads();
    const float* nw = fin ? A.final_norm_w : ((which == 0 ? A.norm1_w : A.norm2_w) + i * 1024);
    unsigned* cnt = (unsigned*)(F.ctl + CW_CNT + (size_t)jm * 8 * 64);
    int* rlist = (int*)(F.ws + WS_RLIST); float* GATE = (float*)(F.ws + WS_GATE);
    for (int ch = blockIdx.x; ch < MROWS / 32; ch += F.G) {
        const int R0 = ch * 32, b = R0 / SROW, s0 = R0 - b * SROW; const bool isctx = s0 < NCTX; const int cond = isctx ? 16 : b;
        if (fin && isctx) continue;
        const bool do_route = route && !(lastl && isctx);
        const float* mv = MODV + (size_t)(i * 17 + cond) * 6144;
        f32x4 wv[4], shv[4], scv[4], g5[4];
#pragma unroll
        for (int j = 0; j < 4; ++j) { const int col = 4 * F.lane + 256 * j; wv[j] = *(const f32x4*)(nw + col);
            if (!fin) { shv[j] = *(const f32x4*)(mv + (which ? 3 : 0) * 1024 + col); scv[j] = *(const f32x4*)(mv + (which ? 4 : 1) * 1024 + col); }
            if (combine) g5[j] = *(const f32x4*)(MODV + (size_t)((i - 1) * 17 + cond) * 6144 + 5 * 1024 + col); }
        for (int rr = 0; rr < 4; ++rr) {
            const int R = R0 + F.wave * 4 + rr, s = s0 + F.wave * 4 + rr;
            float* res = isctx ? (float*)(F.ws + WS_CX) + (size_t)(b * NCTX + s) * DM : F.out + (size_t)(b * SEQ + s - NCTX) * DM;
            const float* src = first ? (isctx ? A.ctx + (size_t)(b * NCTX + s) * DM : A.x + (size_t)(b * SEQ + s - NCTX) * DM) : res;
            f32x4 v[4]; float ss = 0.f;
#pragma unroll
            for (int j = 0; j < 4; ++j) v[j] = *(const f32x4*)(src + 4 * F.lane + 256 * j);
            if (combine) {
#pragma unroll
                for (int j = 0; j < 4; ++j) { const u32x2 e0 = *(const u32x2*)(EO + (size_t)(2 * R) * DM + 4 * F.lane + 256 * j), e1 = *(const u32x2*)(EO + (size_t)(2 * R + 1) * DM + 4 * F.lane + 256 * j);
                    f32x4 ev; ev.x = bf_lo(e0.x) + bf_lo(e1.x); ev.y = bf_hi(e0.x) + bf_hi(e1.x); ev.z = bf_lo(e0.y) + bf_lo(e1.y); ev.w = bf_hi(e0.y) + bf_hi(e1.y);
                    v[j] = v[j] + g5[j] * ev; }
            }
            if (first || combine) {
#pragma unroll
                for (int j = 0; j < 4; ++j) *(f32x4*)(res + 4 * F.lane + 256 * j) = v[j];
            }
#pragma unroll
            for (int j = 0; j < 4; ++j) ss += (v[j].x * v[j].x + v[j].y * v[j].y) + (v[j].z * v[j].z + v[j].w * v[j].w);
            const float rstd = 1.0f / sqrtf(wave_sum(ss, F.lane) * (1.0f / DM) + EPS);
            if (fin) {
#pragma unroll
                for (int j = 0; j < 4; ++j) *(f32x4*)(res + 4 * F.lane + 256 * j) = v[j] * rstd * wv[j];
                continue;
            }
#pragma unroll
            for (int j = 0; j < 4; ++j) { v[j] = v[j] * rstd * wv[j] * (scv[j] + 1.0f) + shv[j];
                u32x2 o; o.x = pk2(v[j].x, v[j].y); o.y = pk2(v[j].z, v[j].w); *(u32x2*)(H + (size_t)R * DM + 4 * F.lane + 256 * j) = o; }
            if (do_route) {
                float lg[8];
#pragma unroll
                for (int e = 0; e < 8; ++e) lg[e] = 0.f;
#pragma unroll
                for (int e = 0; e < 8; ++e)
#pragma unroll
                    for (int j = 0; j < 4; ++j) { const f32x4 r = *(const LAS f32x4*)(rt + e * 1024 + 4 * F.lane + 256 * j); lg[e] += (v[j].x * r.x + v[j].y * r.y) + (v[j].z * r.z + v[j].w * r.w); }
#pragma unroll
                for (int e = 0; e < 8; ++e) lg[e] = wave_sum(lg[e], F.lane);
                int i1 = 0; float v1 = lg[0];
#pragma unroll
                for (int e = 1; e < 8; ++e) if (lg[e] > v1) { v1 = lg[e]; i1 = e; }
                int i2 = -1; float v2 = -3.0e38f;
#pragma unroll
                for (int e = 0; e < 8; ++e) if (e != i1 && lg[e] > v2) { v2 = lg[e]; i2 = e; }
                const float g1 = 1.0f / (1.0f + expf(v2 - v1)), g2 = 1.0f - g1;
                if (F.lane == 0) { ents[(F.wave * 4 + rr) * 2] = i1; ents[(F.wave * 4 + rr) * 2 + 1] = i2; GATE[(size_t)R * 2] = g1; GATE[(size_t)R * 2 + 1] = g2; }
            }
        }
        if (do_route) {
            __syncthreads();
            if (F.wave == 0) {
                const int e = ents[F.lane];
#pragma unroll
                for (int ee = 0; ee < 8; ++ee) { const unsigned long long m = __ballot(e == ee); const int n = __popcll(m);
                    if (n) { unsigned base = 0; if (F.lane == 0) base = __hip_atomic_fetch_add(cnt + ee * 64, (unsigned)n, RLX_AGENT); base = __builtin_amdgcn_readfirstlane(base);
                        if (e == ee) { const int pos = (int)base + __popcll(m & ((1ull << F.lane) - 1ull)); rlist[(size_t)ee * MROWS + pos] = (R0 + (F.lane >> 1)) * 2 + (F.lane & 1); } } }
            }
            __syncthreads();
        }
    }
}

struct EpiXbc {
    static constexpr bool PERM = true;
    bf16_t* XBC; float* DT; bf16_t* HALO;
    __device__ __forceinline__ void operator()(const f32x4 (&acc)[2][2][4][2], const pg8::Unit& u, int wr, int wc, int fr, int fq) const {
        const int row0 = u.pm * 256 + wr * 64 + fr;
        if (u.pn < 16) { const int col0 = u.pn * 256 + wc * 32 + 8 * fq;
#pragma unroll
            for (int ai = 0; ai < 2; ++ai)
#pragma unroll
                for (int m = 0; m < 4; ++m) { bf16_t* rowp = XBC + (size_t)(row0 + ai * 128 + m * 16) * CONVCH + col0;
#pragma unroll
                    for (int bj = 0; bj < 2; ++bj) { const f32x4 v0 = acc[ai][bj][m][0], v1 = acc[ai][bj][m][1]; u32x4 w; w.x = pg8::cvt_pk_bf16(v0[0], v0[1]); w.y = pg8::cvt_pk_bf16(v0[2], v0[3]); w.z = pg8::cvt_pk_bf16(v1[0], v1[1]); w.w = pg8::cvt_pk_bf16(v1[2], v1[3]);
                        *(GAS u32x4*)(rowp + bj * 128) = w;
                        const int rin = ai * 128 + wr * 64 + m * 16 + fr;
                        if (rin < 2 || rin >= 254) *(GAS u32x4*)(HALO + ((size_t)u.pm * 4 + (rin < 2 ? rin : rin - 252)) * CONVCH + col0 + bj * 128) = w; } }
        } else if (wc < 2) { const int c0 = wc * 32 + 8 * fq;
#pragma unroll
            for (int ai = 0; ai < 2; ++ai)
#pragma unroll
                for (int m = 0; m < 4; ++m) { float* p = DT + (size_t)(row0 + ai * 128 + m * 16) * 64 + c0; *(GAS f32x4*)p = acc[ai][0][m][0]; *(GAS f32x4*)(p + 4) = acc[ai][0][m][1]; }
        }
    }
};
struct EpiGate {
    static constexpr bool PERM = true;
    const bf16_t* Y; bf16_t* Gt; const float* nw; LAS float* P;
    __device__ __forceinline__ void operator()(f32x4 (&acc)[2][2][4][2], const pg8::Unit& u, int wr, int wc, int fr, int fq) const {
        const int row0 = u.pm * 256 + wr * 64 + fr, col0 = u.pn * 256 + wc * 32 + 8 * fq;
#pragma unroll
        for (int ai = 0; ai < 2; ++ai)
#pragma unroll
            for (int m = 0; m < 4; ++m) { const bf16_t* yp = Y + (size_t)(row0 + ai * 128 + m * 16) * DIN + col0; float ssq = 0.f;
#pragma unroll
                for (int bj = 0; bj < 2; ++bj) { const u32x4 yv = *(const GAS u32x4*)(yp + bj * 128); f32x4 z0 = acc[ai][bj][m][0], z1 = acc[ai][bj][m][1];
                    z0[0] = bf_lo(yv.x) * siluf(z0[0]); z0[1] = bf_hi(yv.x) * siluf(z0[1]); z0[2] = bf_lo(yv.y) * siluf(z0[2]); z0[3] = bf_hi(yv.y) * siluf(z0[3]);
                    z1[0] = bf_lo(yv.z) * siluf(z1[0]); z1[1] = bf_hi(yv.z) * siluf(z1[1]); z1[2] = bf_lo(yv.w) * siluf(z1[2]); z1[3] = bf_hi(yv.w) * siluf(z1[3]);
                    ssq += (z0[0] * z0[0] + z0[1] * z0[1]) + (z0[2] * z0[2] + z0[3] * z0[3]) + (z1[0] * z1[0] + z1[1] * z1[1]) + (z1[2] * z1[2] + z1[3] * z1[3]);
                    acc[ai][bj][m][0] = z0; acc[ai][bj][m][1] = z1; }
                ssq += shx(ssq, 16, fq * 16 + fr); ssq += shx(ssq, 32, fq * 16 + fr);
                if (fq == 0) P[(ai * 128 + wr * 64 + m * 16 + fr) * 4 + wc] = ssq; }
        asm volatile("s_waitcnt lgkmcnt(0)" ::: "memory"); __builtin_amdgcn_s_barrier(); asm volatile("" ::: "memory");
        f32x4 nv[2][2];
#pragma unroll
        for (int bj = 0; bj < 2; ++bj) { nv[bj][0] = *(const GAS f32x4*)(nw + col0 + bj * 128); nv[bj][1] = *(const GAS f32x4*)(nw + col0 + bj * 128 + 4); }
#pragma unroll
        for (int ai = 0; ai < 2; ++ai)
#pragma unroll
            for (int m = 0; m < 4; ++m) { const f32x4 pp = *(const LAS f32x4*)(P + (ai * 128 + wr * 64 + m * 16 + fr) * 4); const float rstd = 1.0f / sqrtf(((pp.x + pp.y) + (pp.z + pp.w)) * (1.0f / 256.0f) + EPS);
                bf16_t* gp = Gt + (size_t)(row0 + ai * 128 + m * 16) * DIN + col0;
#pragma unroll
                for (int bj = 0; bj < 2; ++bj) { const f32x4 v0 = acc[ai][bj][m][0] * rstd * nv[bj][0], v1 = acc[ai][bj][m][1] * rstd * nv[bj][1];
                    u32x4 w; w.x = pg8::cvt_pk_bf16(v0[0], v0[1]); w.y = pg8::cvt_pk_bf16(v0[2], v0[3]); w.z = pg8::cvt_pk_bf16(v1[0], v1[1]); w.w = pg8::cvt_pk_bf16(v1[2], v1[3]);
                    *(GAS u32x4*)(gp + bj * 128) = w; } }
        asm volatile("s_waitcnt lgkmcnt(0)" ::: "memory");
    }
};
struct EpiResid {
    static constexpr bool PERM = false;
    unsigned char* ws; float* out; const float* modl; int gidx; const float* bias;
    __device__ __forceinline__ void operator()(const f32x4 (&acc)[2][2][4][2], const pg8::Unit& u, int wr, int wc, int fr, int fq) const {
        const int b = u.pm / 17, j = u.pm - b * 17, cond = j == 0 ? 16 : b;
        const GAS char* pbase = (const GAS char*)(j == 0 ? (float*)(ws + WS_CX) + (size_t)(b * NCTX) * DM : out + (size_t)(b * SEQ + (j - 1) * 256) * DM);
        unsigned lo = (unsigned)(((wr * 64 + fr) * DM + u.pn * 256 + wc * 32 + 4 * fq) * 4); asm volatile("" : "+v"(lo));
        const GAS float* gv = (const GAS float*)(modl + (size_t)cond * 6144 + gidx * 1024 + u.pn * 256 + wc * 32 + 4 * fq);
        const GAS float* bp = (const GAS float*)(bias ? bias + u.pn * 256 + wc * 32 + 4 * fq : nullptr);
#define RES_PTR(ai, m, bj, n) ((GAS f32x4*)(pbase + (size_t)((ai) * 128 + (m) * 16) * DM * 4 + lo + ((bj) * 128 + (n) * 16) * 4))
#pragma unroll
        for (int bj = 0; bj < 2; ++bj) {
            f32x4 g[2], bv[2];
#pragma unroll
            for (int n = 0; n < 2; ++n) { g[n] = *(const GAS f32x4*)(gv + bj * 128 + n * 16); bv[n] = bp ? *(const GAS f32x4*)(bp + bj * 128 + n * 16) : (f32x4){0.f, 0.f, 0.f, 0.f}; }
            if (bj == 0) {
#pragma unroll
                for (int ai = 0; ai < 2; ++ai) {
                    f32x4 o[4][2];
#pragma unroll
                    for (int m = 0; m < 4; ++m)
#pragma unroll
                        for (int n = 0; n < 2; ++n) o[m][n] = *RES_PTR(ai, m, bj, n);
#pragma unroll
                    for (int m = 0; m < 4; ++m)
#pragma unroll
                        for (int n = 0; n < 2; ++n) *RES_PTR(ai, m, bj, n) = o[m][n] + g[n] * (acc[ai][bj][m][n] + bv[n]);
                    asm volatile("" ::: "memory");
                }
            } else {
                f32x4 o[2][4][2];
#pragma unroll
                for (int ai = 0; ai < 2; ++ai)
#pragma unroll
                    for (int m = 0; m < 4; ++m)
#pragma unroll
                        for (int n = 0; n < 2; ++n) o[ai][m][n] = *RES_PTR(ai, m, bj, n);
#pragma unroll
                for (int ai = 0; ai < 2; ++ai)
#pragma unroll
                    for (int m = 0; m < 4; ++m)
#pragma unroll
                        for (int n = 0; n < 2; ++n) *RES_PTR(ai, m, bj, n) = o[ai][m][n] + g[n] * (acc[ai][bj][m][n] + bv[n]);
            }
        }
#undef RES_PTR
    }
};
struct EpiSwiglu {
    static constexpr bool PERM = true;
    bf16_t* ACT; int ldc;
    __device__ __forceinline__ void operator()(const f32x4 (&acc)[2][2][4][2], const pg8::Unit& u, int wr, int wc, int fr, int fq) const {
        const int row0 = u.pm * 256 + wr * 64 + fr, col0 = u.pn * 128 + wc * 32 + 8 * fq;
#pragma unroll
        for (int ai = 0; ai < 2; ++ai)
#pragma unroll
            for (int m = 0; m < 4; ++m) { const f32x4 g0 = acc[ai][0][m][0], g1 = acc[ai][0][m][1], u0 = acc[ai][1][m][0], u1 = acc[ai][1][m][1];
                u32x4 w; w.x = pg8::cvt_pk_bf16(siluf(g0[0]) * u0[0], siluf(g0[1]) * u0[1]); w.y = pg8::cvt_pk_bf16(siluf(g0[2]) * u0[2], siluf(g0[3]) * u0[3]);
                w.z = pg8::cvt_pk_bf16(siluf(g1[0]) * u1[0], siluf(g1[1]) * u1[1]); w.w = pg8::cvt_pk_bf16(siluf(g1[2]) * u1[2], siluf(g1[3]) * u1[3]);
                *(GAS u32x4*)(ACT + (size_t)(row0 + ai * 128 + m * 16) * ldc + col0) = w; }
    }
};
struct EpiQkv {
    static constexpr bool PERM = false;
    bf16_t *Q, *Kb, *Vb; const LAS float* T;
    __device__ __forceinline__ void operator()(const f32x4 (&acc)[2][2][4][2], const pg8::Unit& u, int wr, int wc, int fr, int fq) const {
        const int b = u.pm / 17, j = u.pm - b * 17; const bool isctx = j == 0; const int pos0 = (j - 1) * 256;
        bf16_t* dst; int ld, cbase; float sc = 1.0f;
        if (u.pn < 4) { dst = Q; ld = QW; cbase = u.pn * 256; sc = 0.125f * 1.4426950408889634f;   } else if (u.pn == 4) { dst = Kb; ld = KVW; cbase = 0; } else { dst = Vb; ld = KVW; cbase = 0; }
        const bool dorope = !isctx && u.pn < 5; const int axis = wc & 1;
        const LAS float* bp = T + 2048 + u.pn * 256 + wc * 32 + 4 * fq;
        f32x4 bv[2][2];
#pragma unroll
        for (int bj = 0; bj < 2; ++bj)
#pragma unroll
            for (int n = 0; n < 2; ++n) bv[bj][n] = *(const LAS f32x4*)(bp + bj * 128 + n * 16);
#pragma unroll
        for (int ai = 0; ai < 2; ++ai)
#pragma unroll
            for (int m = 0; m < 4; ++m) { const int r = ai * 128 + wr * 64 + m * 16 + fr; const int pos = pos0 + r; const int id = axis ? (pos & 63) : (pos >> 6);
                f32x4 cs = (f32x4){1.f, 1.f, 1.f, 1.f}, sn = (f32x4){0.f, 0.f, 0.f, 0.f};
                if (dorope) { cs = *(const LAS f32x4*)(T + id * 16 + 4 * fq); sn = *(const LAS f32x4*)(T + 1024 + id * 16 + 4 * fq); }
                GAS bf16_t* rowp = (GAS bf16_t*)(dst + (size_t)(u.pm * 256 + r) * ld + cbase + wc * 32 + 4 * fq);
#pragma unroll
                for (int bj = 0; bj < 2; ++bj) { const f32x4 x0 = (acc[ai][bj][m][0] + bv[bj][0]) * sc, x1 = (acc[ai][bj][m][1] + bv[bj][1]) * sc;
                    const f32x4 o0 = x0 * cs - x1 * sn, o1 = x1 * cs + x0 * sn;
                    u32x2 w0, w1; w0.x = pg8::cvt_pk_bf16(o0[0], o0[1]); w0.y = pg8::cvt_pk_bf16(o0[2], o0[3]); w1.x = pg8::cvt_pk_bf16(o1[0], o1[1]); w1.y = pg8::cvt_pk_bf16(o1[2], o1[3]);
                    *(GAS u32x2*)(rowp + bj * 128) = w0; *(GAS u32x2*)(rowp + bj * 128 + 16) = w1; } }
    }
};

struct EpiNull {
    static constexpr bool PERM = false;
    __device__ __forceinline__ void operator()(const f32x4 (&acc)[2][2][4][2], const pg8::Unit& u, int wr, int wc, int fr, int fq) const {
#pragma unroll
        for (int ai = 0; ai < 2; ++ai)
#pragma unroll
            for (int bj = 0; bj < 2; ++bj)
#pragma unroll
                for (int m = 0; m < 4; ++m)
#pragma unroll
                    for (int n = 0; n < 2; ++n) asm volatile("" :: "v"(acc[ai][bj][m][n]));
    }
};
template <int MODE> struct EpiProbe {
    static constexpr bool PERM = false;
    unsigned char* ws; float* out; float* scratch;
    __device__ __forceinline__ void operator()(const f32x4 (&acc)[2][2][4][2], const pg8::Unit& u, int wr, int wc, int fr, int fq) const {
        const int b = u.pm / 17, j = u.pm - b * 17;
        const GAS char* pbase = MODE == 1 ? (const GAS char*)(j == 0 ? (float*)(ws + WS_CX) + (size_t)(b * NCTX) * DM : out + (size_t)(b * SEQ + (j - 1) * 256) * DM) : (const GAS char*)(scratch + (size_t)(u.pm & 255) * 256 * DM);
        unsigned lo = (unsigned)(((wr * 64 + fr) * DM + u.pn * 256 + wc * 32 + 4 * fq) * 4); asm volatile("" : "+v"(lo));
#define RES_PTR(ai, m, bj, n) ((GAS f32x4*)(pbase + (size_t)((ai) * 128 + (m) * 16) * DM * 4 + lo + ((bj) * 128 + (n) * 16) * 4))
#pragma unroll
        for (int bj = 0; bj < 2; ++bj)
#pragma unroll
            for (int ai = 0; ai < 2; ++ai) {
                f32x4 o[4][2];
#pragma unroll
                for (int m = 0; m < 4; ++m)
#pragma unroll
                    for (int n = 0; n < 2; ++n) { if (MODE == 1) o[m][n] = *RES_PTR(ai, m, bj, n); else *RES_PTR(ai, m, bj, n) = acc[ai][bj][m][n]; }
                if (MODE == 1) {
#pragma unroll
                    for (int m = 0; m < 4; ++m)
#pragma unroll
                        for (int n = 0; n < 2; ++n) asm volatile("" :: "v"(o[m][n]), "v"(acc[ai][bj][m][n]));
                }
                asm volatile("" ::: "memory");
            }
#undef RES_PTR
    }
};
struct MoeOrder {
    pg8::StaticOrder so; int cs; int pp[9]; int cnt[8]; const int* rlist; size_t bstride; bool GATHER_A;
    __device__ __forceinline__ void locate(int pm, int& e, int& p, int& cn) const { const int gp = cs + pm; e = 0; int pbase = 0; cn = cnt[0];
#pragma unroll
        for (int k = 1; k < 8; ++k) { const bool ge = gp >= pp[k]; e += ge ? 1 : 0; pbase = ge ? pp[k] : pbase; cn = ge ? cnt[k] : cn; }
        p = gp - pbase; }
    __device__ bool next(int i, pg8::Unit& u) const { return so.next(i, u); }
    __device__ __forceinline__ const char* a_base(const pg8::Gemm& g, const pg8::Unit& u) const { return GATHER_A ? (const char*)g.A : (const char*)g.A + (size_t)u.pm * (size_t)(256 * 2) * g.lda; }
    __device__ __forceinline__ const char* b_base(const pg8::Gemm& g, const pg8::Unit& u) const { int e, p, cn; locate(u.pm, e, p, cn); return (const char*)g.Bt + (size_t)e * bstride + (size_t)u.pn * (size_t)(256 * 2) * g.K; }
    __device__ __forceinline__ unsigned row_off(const pg8::Gemm& g, const pg8::Unit& u, int r) const {
        if (!GATHER_A) return (unsigned)r * (unsigned)g.lda * 2u;
        int e, p, cn; locate(u.pm, e, p, cn); const int idx = p * 256 + r; const int tok = idx < cn ? (rlist[(size_t)e * MROWS + idx] >> 1) : 0; return (unsigned)tok * (unsigned)g.lda * 2u; }
};
struct EpiMoeDown {
    static constexpr bool PERM = true;
    MoeOrder mo; bf16_t* EO; const float* GATE;
    __device__ __forceinline__ void operator()(const f32x4 (&acc)[2][2][4][2], const pg8::Unit& u, int wr, int wc, int fr, int fq) const {
        int e, p, cn; mo.locate(u.pm, e, p, cn); const int* rl = mo.rlist + (size_t)e * MROWS + p * 256;
        const int col0 = u.pn * 256 + wc * 32 + 8 * fq;
#pragma unroll
        for (int ai = 0; ai < 2; ++ai)
#pragma unroll
            for (int m = 0; m < 4; ++m) { const int r = ai * 128 + wr * 64 + m * 16 + fr;
                if (p * 256 + r < cn) { const int ent = rl[r]; const float gt = GATE[ent]; bf16_t* dp = EO + (size_t)ent * DM + col0;
#pragma unroll
                    for (int bj = 0; bj < 2; ++bj) { const f32x4 v0 = acc[ai][bj][m][0] * gt, v1 = acc[ai][bj][m][1] * gt; u32x4 w; w.x = pg8::cvt_pk_bf16(v0[0], v0[1]); w.y = pg8::cvt_pk_bf16(v0[2], v0[3]); w.z = pg8::cvt_pk_bf16(v1[0], v1[1]); w.w = pg8::cvt_pk_bf16(v1[2], v1[3]);
                        *(GAS u32x4*)(dp + bj * 128) = w; } } }
    }
};

typedef __bf16 bf16x2_t __attribute__((ext_vector_type(2)));
typedef short v4i16_t __attribute__((ext_vector_type(4)));
__device__ __forceinline__ unsigned cvtpk(float lo, float hi) { f32x2 v = {lo, hi}; bf16x2_t b = __builtin_convertvector(v, bf16x2_t); return __builtin_bit_cast(unsigned, b); }
__device__ __forceinline__ int crow(int r, int hi) { return (r & 3) + 8 * (r >> 2) + 4 * hi; }
__device__ __forceinline__ s16x4 vtr(const LAS unsigned char* p) { return __builtin_bit_cast(s16x4, __builtin_amdgcn_ds_read_tr16_b64_v4i16((LAS v4i16_t*)p)); }
#define MFMA32(a, b, c) __builtin_amdgcn_mfma_f32_32x32x16_bf16((a), (b), (c), 0, 0, 0)
__device__ __forceinline__ void conv_phase(Frame& F, const Args& A, int j) {
    phase_enter(F);
    bf16_t* XBC = (bf16_t*)(F.ws + WS_BIG); const bf16_t* HALO = (const bf16_t*)(F.ws + WS_HALO);
    const int lane = F.lane;
    const int gw = blockIdx.x * NWAVES + F.wave, NGW = F.G * NWAVES;
    for (int task = gw; task < NPAN * 8; task += NGW) {
        const int pm = task >> 3, sl = task & 7, jj = pm % 17, c0 = sl * 512 + lane * 8;
        const bool top_zero = jj <= 1, bot_zero = jj == 0 || jj == 16;
        f32x2 cw[5][4], cbias[4];
#pragma unroll
        for (int k = 0; k < 5; ++k) { const f32x4 a0 = *(const GAS f32x4*)(A.ssd_conv_w + (size_t)(j * 5 + k) * CONVCH + c0), a1 = *(const GAS f32x4*)(A.ssd_conv_w + (size_t)(j * 5 + k) * CONVCH + c0 + 4);
            cw[k][0] = (f32x2){a0.x, a0.y}; cw[k][1] = (f32x2){a0.z, a0.w}; cw[k][2] = (f32x2){a1.x, a1.y}; cw[k][3] = (f32x2){a1.z, a1.w}; }
        { const f32x4 a0 = *(const GAS f32x4*)(A.ssd_conv_b + (size_t)j * CONVCH + c0), a1 = *(const GAS f32x4*)(A.ssd_conv_b + (size_t)j * CONVCH + c0 + 4);
            cbias[0] = (f32x2){a0.x, a0.y}; cbias[1] = (f32x2){a0.z, a0.w}; cbias[2] = (f32x2){a1.x, a1.y}; cbias[3] = (f32x2){a1.z, a1.w}; }
        GAS bf16_t* base = (GAS bf16_t*)(XBC + (size_t)pm * 256 * CONVCH + c0);
        const u32x4 zero4 = (u32x4){0u, 0u, 0u, 0u};
        u32x4 win[12], pre[8];
        win[0] = top_zero ? zero4 : *(const GAS u32x4*)(HALO + ((size_t)(pm - 1) * 4 + 2) * CONVCH + c0);
        win[1] = top_zero ? zero4 : *(const GAS u32x4*)(HALO + ((size_t)(pm - 1) * 4 + 3) * CONVCH + c0);
#pragma unroll
        for (int q = 0; q < 10; ++q) win[2 + q] = *(const GAS u32x4*)(base + (size_t)q * CONVCH);
        for (int k = 0; k < 32; ++k) {
            if (k < 30) {
#pragma unroll
                for (int q = 0; q < 8; ++q) pre[q] = *(const GAS u32x4*)(base + (size_t)(8 * k + 10 + q) * CONVCH);
            } else if (k == 30) {
#pragma unroll
                for (int q = 0; q < 6; ++q) pre[q] = *(const GAS u32x4*)(base + (size_t)(250 + q) * CONVCH);
                pre[6] = bot_zero ? zero4 : *(const GAS u32x4*)(HALO + ((size_t)(pm + 1) * 4 + 0) * CONVCH + c0);
                pre[7] = bot_zero ? zero4 : *(const GAS u32x4*)(HALO + ((size_t)(pm + 1) * 4 + 1) * CONVCH + c0);
            }
#pragma unroll
            for (int o = 0; o < 8; ++o) {
                f32x2 r[4];
#pragma unroll
                for (int c = 0; c < 4; ++c) r[c] = cbias[c];
#pragma unroll
                for (int t = 0; t < 5; ++t) { const u32x4 w = win[o + t];
                    r[0] += cw[t][0] * (f32x2){bf_lo(w.x), bf_hi(w.x)}; r[1] += cw[t][1] * (f32x2){bf_lo(w.y), bf_hi(w.y)};
                    r[2] += cw[t][2] * (f32x2){bf_lo(w.z), bf_hi(w.z)}; r[3] += cw[t][3] * (f32x2){bf_lo(w.w), bf_hi(w.w)}; }
                u32x4 w; w.x = cvtpk(siluf(r[0].x), siluf(r[0].y)); w.y = cvtpk(siluf(r[1].x), siluf(r[1].y)); w.z = cvtpk(siluf(r[2].x), siluf(r[2].y)); w.w = cvtpk(siluf(r[3].x), siluf(r[3].y));
                *(GAS u32x4*)(base + (size_t)(8 * k + o) * CONVCH) = w;
            }
#pragma unroll
            for (int q = 0; q < 4; ++q) win[q] = win[8 + q];
#pragma unroll
            for (int q = 0; q < 8; ++q) win[4 + q] = pre[q];
        }
    }
}


constexpr int SC_RS = 272;
constexpr int SC_TILE = 3 * 32 * SC_RS;
constexpr int SC_YS = 2 * SC_TILE;
constexpr int SC_WS = SC_YS + 16384;
constexpr int SC_RAW = 73728;
static_assert(SC_WS + 4096 <= SC_RAW && SC_RAW + 2 * 36 * 1024 <= LDSCTL_OFF, "scan LDS map");
template <int PH>
__device__ __forceinline__ void scan_phase(Frame& F, const Args& A, int j) {
    phase_enter(F);
    const bf16_t* XBC = (const bf16_t*)(F.ws + WS_BIG); const float* DT = (const float*)(F.ws + WS_DT); bf16_t* Y = (bf16_t*)(F.ws + WS_Y);
    const int lane = F.lane, wave = F.wave;
    for (int u0 = blockIdx.x; u0 < 256; u0 += F.G) {
        const int unit = (F.G == 256) ? ((u0 & 7) * 32 + (u0 >> 3)) : u0;
        const int b = unit >> 4, g = (unit >> 1) & 7, ph = unit & 1;
        const int srow = F.tid >> 4, sch = F.tid & 15;
        const int gcolB = 2048 + g * 128 + sch * 8, gcolC = 3072 + g * 128 + sch * 8, gcolX = g * 256 + (sch >> 2) * 64 + ph * 32 + (sch & 3) * 8;
        const int hh = wave >> 1, dir = wave & 1, c31 = lane & 31, hl = lane >> 5;
        const int trq = (lane & 15) >> 2, trp = lane & 3, trb = (lane >> 4) & 1;
        const int head = g * 4 + hh;
        const float Dk = A.ssd_d[(j * 2 + dir) * 32 + head], dtb = A.ssd_dt_bias[(j * 2 + dir) * 32 + head], aneg = -expf(A.ssd_a_log[(j * 2 + dir) * 32 + head]);
        LAS float* wsf = (LAS float*)(F.lds + SC_WS + wave * 512);
        f32x16 ST[4];
#pragma unroll
        for (int t = 0; t < 4; ++t)
#pragma unroll
            for (int e = 0; e < 16; ++e) ST[t][e] = 0.f;
#define SC_PF(st_) do { const int st = (PH == 2) ? 0 : (st_); const int cf_ = (st), cb_ = (st) < 8 ? 7 - (st) : 143 - (st); \
            _Pragma("unroll") for (int T = 0; T < 2; ++T) { const GAS bf16_t* rp = (const GAS bf16_t*)(XBC + (size_t)(b * SROW + (T ? cb_ : cf_) * 32 + srow) * CONVCH); \
                pf[T][0] = *(const GAS u32x4*)(rp + gcolB); pf[T][1] = *(const GAS u32x4*)(rp + gcolC); pf[T][2] = *(const GAS u32x4*)(rp + gcolX); } } while (0)
#define SC_DTLOAD(st) DT[(size_t)(b * SROW + (dir ? ((st) < 8 ? 7 - (st) : 143 - (st)) : (st)) * 32 + c31) * 64 + dir * 32 + head]
#define SC_WRITEOUT(st) do { const int cf_ = (st), cb_ = (st) < 8 ? 7 - (st) : 143 - (st); \
            _Pragma("unroll") for (int T = 0; T < 2; ++T) { const int tok = F.tid >> 4, h4 = (F.tid >> 2) & 3, q4 = F.tid & 3, chunk = T ? cb_ : cf_; \
                const int other = T == 0 ? (chunk < 8 ? 7 - chunk : 143 - chunk) : chunk; \
                u32x4 v = *(const LAS u32x4*)(F.lds + SC_YS + T * 8192 + (tok * 128 + h4 * 32 + q4 * 8) * 2); \
                bf16_t* yp = Y + (size_t)(b * SROW + chunk * 32 + tok) * DIN + g * 256 + h4 * 64 + ph * 32 + q4 * 8; \
                if ((st) > other) { const u32x4 o = oldy[T]; \
                    v.x = pk2(bf_lo(o.x) + bf_lo(v.x), bf_hi(o.x) + bf_hi(v.x)); v.y = pk2(bf_lo(o.y) + bf_lo(v.y), bf_hi(o.y) + bf_hi(v.y)); \
                    v.z = pk2(bf_lo(o.z) + bf_lo(v.z), bf_hi(o.z) + bf_hi(v.z)); v.w = pk2(bf_lo(o.w) + bf_lo(v.w), bf_hi(o.w) + bf_hi(v.w)); } \
                if (PH == 0) *(u32x4*)yp = v; else asm volatile("" :: "v"(v)); } } while (0)
        u32x4 pf[2][3];
        SC_PF(0);
        float dtraw = SC_DTLOAD(0);
        u32x4 oldy[2] = {(u32x4){0u, 0u, 0u, 0u}, (u32x4){0u, 0u, 0u, 0u}};
        for (int step = 0; step < 136; ++step) {
            const int cf = step, cbk = step < 8 ? 7 - step : 143 - step;
            __syncthreads();
            if (step > 0) SC_WRITEOUT(step - 1);
#pragma unroll
            for (int T = 0; T < 2; ++T)
#pragma unroll
                for (int a = 0; a < 3; ++a) *(LAS u32x4*)(F.lds + T * SC_TILE + a * (32 * SC_RS) + srow * SC_RS + sch * 16) = pf[T][a];
            {
                const float xb = dtraw + dtb;
                const float dt = xb > 20.f ? xb : log1pf(__expf(xb)); const float dA = dt * aneg;
                float v = dA;
                v += __builtin_bit_cast(float, __builtin_amdgcn_update_dpp(0, __builtin_bit_cast(int, v), 0x111, 0xf, 0xf, true));
                v += __builtin_bit_cast(float, __builtin_amdgcn_update_dpp(0, __builtin_bit_cast(int, v), 0x112, 0xf, 0xf, true));
                v += __builtin_bit_cast(float, __builtin_amdgcn_update_dpp(0, __builtin_bit_cast(int, v), 0x114, 0xf, 0xf, true));
                v += __builtin_bit_cast(float, __builtin_amdgcn_update_dpp(0, __builtin_bit_cast(int, v), 0x118, 0xf, 0xf, true));
                v += __builtin_bit_cast(float, __builtin_amdgcn_update_dpp(0, __builtin_bit_cast(int, v), 0x142, 0xa, 0xf, false));
                const float tot = __builtin_bit_cast(float, __builtin_amdgcn_readlane(__builtin_bit_cast(int, v), 31));
                const float cum = dir ? (tot - v + dA) : v;
                if (hl == 0) { wsf[c31] = cum; wsf[32 + c31] = dt; wsf[64 + c31] = __expf(tot - cum) * dt; wsf[96 + c31] = __expf(cum); }
            }
            asm volatile("s_waitcnt lgkmcnt(0)" ::: "memory"); __builtin_amdgcn_s_barrier(); asm volatile("" ::: "memory");
            if (step + 1 < 136) { SC_PF(step + 1); dtraw = SC_DTLOAD(step + 1); }
#pragma unroll
            for (int T = 0; T < 2; ++T) {
                const int tok = F.tid >> 4, h4 = (F.tid >> 2) & 3, q4 = F.tid & 3, chunk = T ? cbk : cf;
                const int other = T == 0 ? (chunk < 8 ? 7 - chunk : 143 - chunk) : chunk;
                if (PH == 0 && step > other) oldy[T] = *(const u32x4*)(Y + (size_t)(b * SROW + chunk * 32 + tok) * DIN + g * 256 + h4 * 64 + ph * 32 + q4 * 8);
            }
            {
                const LAS unsigned char* Bs = F.lds + dir * SC_TILE; const LAS unsigned char* Cs = Bs + 32 * SC_RS; const LAS unsigned char* xs = Bs + 64 * SC_RS;
                f32x16 gt;
#pragma unroll
                for (int e = 0; e < 16; ++e) gt[e] = 0.f;
#pragma unroll
                for (int s = 0; s < 8; ++s) { const bf16x8 a = *(const LAS bf16x8*)(Bs + c31 * SC_RS + (16 * s + 8 * hl) * 2), bb = *(const LAS bf16x8*)(Cs + c31 * SC_RS + (16 * s + 8 * hl) * 2); gt = MFMA32(a, bb, gt); }
                const float cum_i = wsf[c31];
                bf16x8 mk[2];
                {
                    float mv[16];
#pragma unroll
                    for (int q = 0; q < 4; ++q) { const f32x4 cj = *(const LAS f32x4*)(wsf + 8 * q + 4 * hl), dj = *(const LAS f32x4*)(wsf + 32 + 8 * q + 4 * hl);
#pragma unroll
                        for (int z = 0; z < 4; ++z) { const int jj = 8 * q + 4 * hl + z; const bool ok = dir ? (jj >= c31) : (jj <= c31);
                            float val = gt[4 * q + z] * __expf(ok ? (cum_i - cj[z]) : -INFINITY) * dj[z]; if (jj == c31) val += Dk; mv[4 * q + z] = val; } }
#pragma unroll
                    for (int s2 = 0; s2 < 2; ++s2) { u32x4 w; w.x = cvtpk(mv[8 * s2], mv[8 * s2 + 1]); w.y = cvtpk(mv[8 * s2 + 2], mv[8 * s2 + 3]); w.z = cvtpk(mv[8 * s2 + 4], mv[8 * s2 + 5]); w.w = cvtpk(mv[8 * s2 + 6], mv[8 * s2 + 7]); mk[s2] = __builtin_bit_cast(bf16x8, w); }
                }
                f32x16 ya;
#pragma unroll
                for (int e = 0; e < 16; ++e) ya[e] = 0.f;
#pragma unroll
                for (int t = 0; t < 4; ++t)
#pragma unroll
                    for (int s2 = 0; s2 < 2; ++s2) {
                        const LAS unsigned char* cp = Cs + c31 * SC_RS + (32 * t + 16 * s2 + 4 * hl) * 2;
                        const u32x2 c0 = *(const LAS u32x2*)cp, c1 = *(const LAS u32x2*)(cp + 16);
                        const bf16x8 ca = __builtin_bit_cast(bf16x8, (u32x4){c0.x, c0.y, c1.x, c1.y});
                        u32x4 w; w.x = cvtpk(ST[t][8 * s2], ST[t][8 * s2 + 1]); w.y = cvtpk(ST[t][8 * s2 + 2], ST[t][8 * s2 + 3]); w.z = cvtpk(ST[t][8 * s2 + 4], ST[t][8 * s2 + 5]); w.w = cvtpk(ST[t][8 * s2 + 6], ST[t][8 * s2 + 7]);
                        ya = MFMA32(ca, __builtin_bit_cast(bf16x8, w), ya);
                    }
#pragma unroll
                for (int q = 0; q < 4; ++q) { const f32x4 ec = *(const LAS f32x4*)(wsf + 96 + 8 * q + 4 * hl); ya[4 * q] *= ec.x; ya[4 * q + 1] *= ec.y; ya[4 * q + 2] *= ec.z; ya[4 * q + 3] *= ec.w; }
#pragma unroll
                for (int s2 = 0; s2 < 2; ++s2) {
                    const LAS unsigned char* xp = xs + (16 * s2 + 4 * hl + trq) * SC_RS + (hh * 32 + 16 * trb + 4 * trp) * 2;
                    const s16x4 lo = vtr(xp), hi = vtr(xp + 8 * SC_RS);
                    ya = MFMA32(mk[s2], ((bf16x8){lo[0], lo[1], lo[2], lo[3], hi[0], hi[1], hi[2], hi[3]}), ya);
                }
                {
                    const float etot = dir ? wsf[96] : wsf[96 + 31];
#pragma unroll
                    for (int t = 0; t < 4; ++t)
#pragma unroll
                        for (int e = 0; e < 16; ++e) ST[t][e] *= etot;
#pragma unroll
                    for (int s2 = 0; s2 < 2; ++s2) {
                        const LAS unsigned char* xp = xs + (16 * s2 + 8 * hl + trq) * SC_RS + (hh * 32 + 16 * trb + 4 * trp) * 2;
                        const s16x4 lo = vtr(xp), hi = vtr(xp + 4 * SC_RS);
                        const f32x4 w0 = *(const LAS f32x4*)(wsf + 64 + 16 * s2 + 8 * hl), w1 = *(const LAS f32x4*)(wsf + 64 + 16 * s2 + 8 * hl + 4);
                        u32x4 xw; xw.x = cvtpk(bf1((bf16_t)lo[0]) * w0.x, bf1((bf16_t)lo[1]) * w0.y); xw.y = cvtpk(bf1((bf16_t)lo[2]) * w0.z, bf1((bf16_t)lo[3]) * w0.w);
                        xw.z = cvtpk(bf1((bf16_t)hi[0]) * w1.x, bf1((bf16_t)hi[1]) * w1.y); xw.w = cvtpk(bf1((bf16_t)hi[2]) * w1.z, bf1((bf16_t)hi[3]) * w1.w);
                        const bf16x8 xb8 = __builtin_bit_cast(bf16x8, xw);
#pragma unroll
                        for (int t = 0; t < 4; ++t) {
                            const LAS unsigned char* bp = Bs + (16 * s2 + 8 * hl + trq) * SC_RS + (32 * t + 16 * trb + 4 * trp) * 2;
                            const s16x4 blo = vtr(bp), bhi = vtr(bp + 4 * SC_RS);
                            ST[t] = MFMA32(((bf16x8){blo[0], blo[1], blo[2], blo[3], bhi[0], bhi[1], bhi[2], bhi[3]}), xb8, ST[t]);
                        }
                    }
                }
                LAS bf16_t* ys = (LAS bf16_t*)(F.lds + SC_YS + dir * 8192);
#pragma unroll
                for (int e = 0; e < 16; ++e) ys[crow(e, hl) * 128 + hh * 32 + c31] = (bf16_t)f2bf(ya[e]);
            }
        }
        VM_WAIT(); __syncthreads();
        SC_WRITEOUT(135);
#undef SC_PF
#undef SC_DTLOAD
#undef SC_WRITEOUT
        __syncthreads();
    }
}

__device__ __forceinline__ void attn_phase(Frame& F, const Args& A, int ja, bool need_ctx, int nwg) {
    phase_enter(F);
    const bf16_t* Q = (const bf16_t*)(F.ws + WS_BIG); bf16_t* O = (bf16_t*)(F.ws + WS_H);     const bf16_t* Kb = (const bf16_t*)(F.ws + WS_BIG + BIG_K); const bf16_t* Vb = (const bf16_t*)(F.ws + WS_BIG + BIG_V);
    LAS unsigned char* Kl = F.lds; LAS unsigned char* Vl = F.lds + 9216;
    const int nunits = 2048 + (need_ctx ? 128 : 0);
    const int lane = F.lane, r = F.wave >> 1, rh = F.wave & 1, c31 = lane & 31, hl = lane >> 5;
    const int prow = F.tid >> 3, ppc = F.tid & 7;
    const int trq = (lane & 15) >> 2, trp = lane & 3, trb = (lane >> 4) & 1;
    for (int unit = blockIdx.x; unit < nunits; unit += nwg) {
        int b, g, nblk; bool cq;
        if (unit < 2048) { b = unit >> 7; nblk = (unit >> 2) & 31; g = unit & 3; cq = false; } else { const int u2 = unit - 2048; b = u2 >> 3; nblk = (u2 >> 2) & 1; g = u2 & 3; cq = true; }
        const int qrow0 = b * SROW + (cq ? 128 * nblk : NCTX + 128 * nblk);
        const int start = 128 * nblk;
        bf16x8 qf[2][4];
#pragma unroll
        for (int qb = 0; qb < 2; ++qb)
#pragma unroll
            for (int s = 0; s < 4; ++s) qf[qb][s] = *(const bf16x8*)(Q + (size_t)(qrow0 + 64 * rh + 32 * qb + c31) * QW + g * 256 + r * 64 + 16 * s + 8 * hl);
        const float sink = A.attn_sink[ja * 16 + g * 4 + r] * 1.4426950408889634f;
        float mrun[2] = {sink, sink}, lrun[2] = {1.f, 1.f};
        f32x16 ot[2][2];
#pragma unroll
        for (int db = 0; db < 2; ++db)
#pragma unroll
            for (int qb = 0; qb < 2; ++qb)
#pragma unroll
                for (int e = 0; e < 16; ++e) ot[db][qb][e] = 0.f;
        const int tt_lo = cq ? 0 : (nblk == 0 ? 2 : 0), tt_hi = cq ? 0 : (nblk == 31 ? 4 : 6);
        const int ntile = 4 + (tt_hi - tt_lo);
#define TILE_ROW0(t) ((t) < 4 ? b * SROW + 64 * (t) : b * SROW + NCTX + start - 128 + 64 * (tt_lo + (t) - 4))
        u32x4 kreg, vreg;
        { const int r0 = TILE_ROW0(0); kreg = *(const u32x4*)(Kb + (size_t)(r0 + prow) * KVW + g * 64 + ppc * 8); vreg = *(const u32x4*)(Vb + (size_t)(r0 + prow) * KVW + g * 64 + ppc * 8); }
        for (int t = 0; t < ntile; ++t) {
            __syncthreads();
            *(LAS u32x4*)(Kl + prow * 144 + ppc * 16) = kreg; *(LAS u32x4*)(Vl + prow * 144 + ppc * 16) = vreg;
            __syncthreads();
            if (t + 1 < ntile) { const int r0 = TILE_ROW0(t + 1); kreg = *(const u32x4*)(Kb + (size_t)(r0 + prow) * KVW + g * 64 + ppc * 8); vreg = *(const u32x4*)(Vb + (size_t)(r0 + prow) * KVW + g * 64 + ppc * 8); }
            const int dk0 = (t >= 4) ? (-128 + 64 * (tt_lo + t - 4)) - 64 * rh : 0;
            const bool tile_empty = (t >= 4) && (dk0 <= -192 || dk0 >= 192);
            const bool tile_mask = (t >= 4) && !tile_empty && (dk0 < -65 || dk0 > 65);
            if (!tile_empty) {
            f32x16 st[2][2];
#pragma unroll
            for (int kb = 0; kb < 2; ++kb) {
#pragma unroll
                for (int qb = 0; qb < 2; ++qb)
#pragma unroll
                    for (int e = 0; e < 16; ++e) st[kb][qb][e] = 0.f;
#pragma unroll
                for (int s = 0; s < 4; ++s) { const bf16x8 a = *(const LAS bf16x8*)(Kl + (32 * kb + c31) * 144 + (16 * s + 8 * hl) * 2);
                    st[kb][0] = MFMA32(a, qf[0][s], st[kb][0]); st[kb][1] = MFMA32(a, qf[1][s], st[kb][1]); }
            }
            if (tile_mask) { const int kpos0 = start - 128 + 64 * (tt_lo + t - 4);
#pragma unroll
                for (int kb = 0; kb < 2; ++kb)
#pragma unroll
                    for (int qb = 0; qb < 2; ++qb) { const int qpos = start + 64 * rh + 32 * qb + c31;
#pragma unroll
                        for (int e = 0; e < 16; ++e) { const int d = qpos - (kpos0 + 32 * kb + crow(e, hl)); if (d > 128 || d < -128) st[kb][qb][e] = -INFINITY; } }
            }
#pragma unroll
            for (int qb = 0; qb < 2; ++qb) {
                float mx = st[0][qb][0];
#pragma unroll
                for (int kb = 0; kb < 2; ++kb)
#pragma unroll
                    for (int e = 0; e < 16; ++e) mx = fmaxf(mx, st[kb][qb][e]);
                mx = fmaxf(mx, shx(mx, 32, lane));
                const float mn = fmaxf(mrun[qb], mx);
                const bool grew = mn > mrun[qb];
                float rs = 0.f;
#pragma unroll
                for (int kb = 0; kb < 2; ++kb)
#pragma unroll
                    for (int e = 0; e < 16; ++e) { const float pv = __builtin_amdgcn_exp2f(st[kb][qb][e] - mn); st[kb][qb][e] = pv; rs += pv; }
                rs += shx(rs, 32, lane);
                if (__any(grew)) {
                    const float alpha = __builtin_amdgcn_exp2f(mrun[qb] - mn);
                    lrun[qb] = lrun[qb] * alpha + rs;
#pragma unroll
                    for (int db = 0; db < 2; ++db)
#pragma unroll
                        for (int e = 0; e < 16; ++e) ot[db][qb][e] *= alpha;
                } else lrun[qb] += rs;
                mrun[qb] = mn;
            }
#pragma unroll
            for (int kb = 0; kb < 2; ++kb)
#pragma unroll
                for (int s2 = 0; s2 < 2; ++s2) {
                    bf16x8 pk[2];
#pragma unroll
                    for (int qb = 0; qb < 2; ++qb) { u32x4 w; w.x = cvtpk(st[kb][qb][8 * s2 + 0], st[kb][qb][8 * s2 + 1]); w.y = cvtpk(st[kb][qb][8 * s2 + 2], st[kb][qb][8 * s2 + 3]);
                        w.z = cvtpk(st[kb][qb][8 * s2 + 4], st[kb][qb][8 * s2 + 5]); w.w = cvtpk(st[kb][qb][8 * s2 + 6], st[kb][qb][8 * s2 + 7]); pk[qb] = __builtin_bit_cast(bf16x8, w); }
#pragma unroll
                    for (int db = 0; db < 2; ++db) {
                        const LAS unsigned char* vp = Vl + (32 * kb + 16 * s2 + 4 * hl + trq) * 144 + (32 * db + 16 * trb + 4 * trp) * 2;
                        const s16x4 lo = vtr(vp), hi = vtr(vp + 8 * 144);
                        const bf16x8 va = (bf16x8){lo[0], lo[1], lo[2], lo[3], hi[0], hi[1], hi[2], hi[3]};
                        ot[db][0] = MFMA32(va, pk[0], ot[db][0]); ot[db][1] = MFMA32(va, pk[1], ot[db][1]);
                    }
                }
            }
        }
#undef TILE_ROW0
#pragma unroll
        for (int qb = 0; qb < 2; ++qb) { const float inv = 1.0f / lrun[qb]; bf16_t* op = O + (size_t)(qrow0 + 64 * rh + 32 * qb + c31) * QW + g * 256 + r * 64;
#pragma unroll
            for (int db = 0; db < 2; ++db)
#pragma unroll
                for (int gq = 0; gq < 4; ++gq) { u32x2 w; w.x = cvtpk(ot[db][qb][4 * gq] * inv, ot[db][qb][4 * gq + 1] * inv); w.y = cvtpk(ot[db][qb][4 * gq + 2] * inv, ot[db][qb][4 * gq + 3] * inv);
                    *(u32x2*)(op + 32 * db + 8 * gq + 4 * hl) = w; } }
    }
    __syncthreads();
}


#ifndef PHMASK
#define PHMASK 0xFFFF
#endif
#define PHON(k) (((PHMASK) >> (k)) & 1)
#ifndef REPMASK
#define REPMASK 0x0
#endif
#define REP(k) (((REPMASK) >> (k)) & 1)
#ifndef MK_PER_PHASE
#define MK_PER_PHASE 0
#endif
#ifndef TIMER_LO
#define TIMER_LO 999
#define TIMER_HI 999
#endif
#define TIMER_ON (TIMER_LO < 999)
#define IN(k) (lo <= (k) && (k) < hi)
#define SEAM(k) do { if (IN(k) && IN((k) + 1)) { xcd_barrier(bar); } if (TIMER_ON) { const unsigned long long now_ = __builtin_amdgcn_s_memrealtime(); if ((k) >= TIMER_LO && (k) <= TIMER_HI) TM.acc += now_ - TM.prev; TM.prev = now_; } } while (0)
#define SITE_PTRS phase_enter(F); unsigned char* ws = F.ws; bf16_t* H = (bf16_t*)(ws + WS_H); bf16_t* BIG = (bf16_t*)(ws + WS_BIG); const float* MODV = (const float*)(ws + WS_MODV); (void)H; (void)BIG; (void)MODV; \
        unsigned char* wss = ws + WS_W + (size_t)lp * W_SSD_STRIDE; unsigned char* wsa = ws + WS_W + W_ATT0 + (size_t)lp * W_ATT_STRIDE; (void)wss; (void)wsa;
struct Timer { unsigned long long prev, acc; };
template <int lp, int c> __device__ __forceinline__ void moe_chunk(Frame& F, const Args& A, const int lo, const int hi, const XcdBarrier& bar, LAS unsigned char* ring, Timer& TM) {
    constexpr int pb = 1 + lp * 20;
            const int pu = pb + 14 + 2 * c, pd = pu + 1;
            if (IN(pu) || IN(pd)) {
                SITE_PTRS
                MoeOrder mo;
                mo.pp[0] = 0;
#pragma unroll
                for (int e = 0; e < 8; ++e) { const int cn = __builtin_amdgcn_readfirstlane((int)__hip_atomic_load((unsigned*)(F.ctl + CW_CNT + (size_t)(lp * 8 + e) * 64), RLX_AGENT)); mo.cnt[e] = cn; mo.pp[e + 1] = mo.pp[e] + ((cn + 255) >> 8); }
                const int Ptot = mo.pp[8]; int nP = Ptot - c * MOE_CHUNK; nP = nP < 0 ? 0 : (nP > MOE_CHUNK ? MOE_CHUNK : nP);
                mo.cs = c * MOE_CHUNK; mo.rlist = (const int*)(ws + WS_RLIST);
                if (PHON(10) && IN(pu)) { mo.so.init(nP, 2 * DFFE / 256, F.G, (int)blockIdx.x); mo.GATHER_A = true; mo.bstride = (size_t)2 * DFFE * 1024 * 2;
                    pg8::Gemm g{H, (const bf16_t*)(ws + WS_BIG + BIG_MW13), 1024, 1024}; EpiSwiglu E{BIG, DFFE}; pg8::gemm_phase<EpiSwiglu, MoeOrder, true, true>(ring, g, mo, E, F.wave0); }
                SEAM(pu);
                if (PHON(11) && IN(pd)) { mo.so.init(nP, 4, F.G, (int)blockIdx.x); mo.GATHER_A = false; mo.bstride = (size_t)1024 * DFFE * 2;
                    pg8::Gemm g{BIG, (const bf16_t*)(ws + WS_BIG + BIG_MW2), DFFE, DFFE}; EpiMoeDown E{mo, (bf16_t*)(ws + WS_Y), (const float*)(ws + WS_GATE)}; pg8::gemm_phase<EpiMoeDown, MoeOrder, true, false>(ring, g, mo, E, F.wave0); }
            }
            SEAM(pd);
        }
template <int lp> __device__ __forceinline__ void layer_pair(Frame& F, const Args& A, const int lo, const int hi, const XcdBarrier& bar, LAS unsigned char* ring, Timer& TM) {
        const int pb = 1 + lp * 20, i0 = 2 * lp, i1 = 2 * lp + 1;
        if (PHON(1) && IN(pb + 0)) norm_phase(F, A, i0, 0, lp == 0 ? 1 : 2);
        SEAM(pb + 0);
        if (PHON(2) && IN(pb + 1)) { SITE_PTRS pg8::Gemm g{H, (const bf16_t*)(wss + W_WIN), 1024, 1024}; pg8::StaticOrder S; S.init(NPAN, NXBC / 256, F.G, (int)blockIdx.x);
            EpiXbc E{BIG, (float*)(ws + WS_DT), (bf16_t*)(ws + WS_HALO)}; pg8::gemm_phase<EpiXbc, pg8::StaticOrder, true, false>(ring, g, S, E, F.wave0); }
        SEAM(pb + 1);
        if (PHON(3) && IN(pb + 2)) conv_phase(F, A, lp);
        SEAM(pb + 2);
        if (PHON(3) && IN(pb + 3)) scan_phase<0>(F, A, lp);
        SEAM(pb + 3);
        if (PHON(4) && IN(pb + 4)) { SITE_PTRS pg8::Gemm g{H, (const bf16_t*)(wss + W_WZ), 1024, 1024}; pg8::StaticOrder S; S.init(NPAN, DIN / 256, F.G, (int)blockIdx.x);
            EpiGate E{(const bf16_t*)(ws + WS_Y), BIG, A.ssd_norm_w + (size_t)lp * DIN, (LAS float*)(F.lds + PSCR_OFF)}; pg8::gemm_phase<EpiGate, pg8::StaticOrder, true, false>(ring, g, S, E, F.wave0); }
        SEAM(pb + 4);
        if (PHON(5) && IN(pb + 5)) { SITE_PTRS pg8::Gemm g{BIG, (const bf16_t*)(wss + W_WOUT), DIN, DIN}; pg8::StaticOrder S; S.init(NPAN, 4, F.G, (int)blockIdx.x);
            EpiResid E{ws, F.out, MODV + (size_t)i0 * 17 * 6144, 2, nullptr};
            pg8::gemm_phase<EpiResid, pg8::StaticOrder, true, false>(ring, g, S, E, F.wave0); }
        SEAM(pb + 5);
        if (PHON(1) && IN(pb + 6)) norm_phase(F, A, i0, 1, 0);
        SEAM(pb + 6);
        if (PHON(6) && IN(pb + 7)) { SITE_PTRS pg8::Gemm g{H, (const bf16_t*)(wss + W_WUP), 1024, 1024}; pg8::StaticOrder S; S.init(NPAN, 2 * DFF / 256, F.G, (int)blockIdx.x);
            EpiSwiglu E{BIG, DFF}; pg8::gemm_phase<EpiSwiglu, pg8::StaticOrder, true, false>(ring, g, S, E, F.wave0); }
        SEAM(pb + 7);
        if (PHON(5) && IN(pb + 8)) { SITE_PTRS pg8::Gemm g{BIG, (const bf16_t*)(wss + W_WDN), DFF, DFF}; pg8::StaticOrder S; S.init(NPAN, 4, F.G, (int)blockIdx.x);
            EpiResid E{ws, F.out, MODV + (size_t)i0 * 17 * 6144, 5, nullptr};
            pg8::gemm_phase<EpiResid, pg8::StaticOrder, true, false>(ring, g, S, E, F.wave0); }
        SEAM(pb + 8);
        if (PHON(1) && IN(pb + 9)) norm_phase(F, A, i1, 0, 0);
        SEAM(pb + 9);
        if (PHON(7) && IN(pb + 10)) { SITE_PTRS pg8::Gemm g{H, (const bf16_t*)(wsa + W_WQKV), 1024, 1024}; pg8::StaticOrder S; S.init(NPAN, NQKV / 256, F.G, (int)blockIdx.x);
            LAS float* qt = (LAS float*)(F.lds + PSCR_OFF);
            { const float* rp = (const float*)(ws + WS_ROPE); const float* bq = A.attn_b_qkv + (size_t)lp * NQKV; for (int idx = F.tid; idx < 3584; idx += 512) qt[idx] = idx < 2048 ? rp[idx] : bq[idx - 2048]; }
            __syncthreads();
            EpiQkv E{BIG, (bf16_t*)(ws + WS_BIG + BIG_K), (bf16_t*)(ws + WS_BIG + BIG_V), qt};
            pg8::gemm_phase<EpiQkv, pg8::StaticOrder, true, false>(ring, g, S, E, F.wave0); }
        SEAM(pb + 10);
        if (PHON(8) && IN(pb + 11)) { const int nconv = F.G >= 9996 ? 48 : 0;
            if ((int)blockIdx.x < F.G - nconv) attn_phase(F, A, lp, lp == 0, F.G - nconv); else moe_convert(F, A, lp, F.G - nconv, nconv); }
        SEAM(pb + 11);
        if (PHON(5) && IN(pb + 12)) { SITE_PTRS pg8::Gemm g{H, (const bf16_t*)(wsa + W_WO), 1024, 1024}; pg8::StaticOrder S; S.init(NPAN, 4, F.G, (int)blockIdx.x);
            EpiResid E{ws, F.out, MODV + (size_t)i1 * 17 * 6144, 2, A.attn_b_o + (size_t)lp * 1024};
            pg8::gemm_phase<EpiResid, pg8::StaticOrder, true, false>(ring, g, S, E, F.wave0); }
        SEAM(pb + 12);
        if (PHON(9) && IN(pb + 13)) { norm_phase(F, A, i1, 1, 4 | (lp == 1 ? 16 : 0)); if (F.G < 9996) { __syncthreads(); moe_convert(F, A, lp, 0, F.G); } }
        SEAM(pb + 13);
    moe_chunk<lp, 0>(F, A, lo, hi, bar, ring, TM); moe_chunk<lp, 1>(F, A, lo, hi, bar, ring, TM); moe_chunk<lp, 2>(F, A, lo, hi, bar, ring, TM);
}
constexpr int N_PHASES = 42;
__global__ void __launch_bounds__(NWAVES * 64, 2) fwd_kernel(Args A) {
    extern __shared__ __attribute__((aligned(16))) unsigned char lds_raw[];
    Frame F;
    F.lds = (LAS unsigned char*)lds_raw;
    F.tid = threadIdx.x; F.lane = F.tid & 63; F.wave = __builtin_amdgcn_readfirstlane(F.tid >> 6); F.wave0 = F.wave; F.G = gridDim.x;
    F.ws0 = A.ws; F.out0 = A.out; F.ws = A.ws; F.ctl = (gu32*)(A.ws + WS_CTL); F.out = A.out;
    volatile LAS unsigned* MISC = (volatile LAS unsigned*)(F.lds + MISC_OFF);
    for (int u = F.tid; u < (LDS_BYTES - LDSCTL_OFF) / 4; u += NWAVES * 64) ((LAS unsigned*)(F.lds + LDSCTL_OFF))[u] = 0u;
    __syncthreads();
    const int lo = A.ph_lo, hi = A.ph_hi;
    XcdBarrier bar; bar.bar = (unsigned*)(F.ctl + CW_BAR); bar.x = 0; bar.st = MISC + 8; bar.wave0 = F.wave0;
    if (hi - lo > 1) bar = xcd_barrier_post((unsigned*)(F.ctl + CW_BAR), MISC + 8, F.wave0);
    LAS unsigned char* ring = F.lds;

    Timer TM; TM.prev = TIMER_ON ? __builtin_amdgcn_s_memrealtime() : 0ull; TM.acc = 0ull;
    if (PHON(0) && IN(0)) { p0_prologue(F, A); }
    SEAM(0);
    layer_pair<0>(F, A, lo, hi, bar, ring, TM);
    layer_pair<1>(F, A, lo, hi, bar, ring, TM);
    if (PHON(1) && IN(41)) {
        norm_phase(F, A, 4, 0, 2 | 8);
        if (xb_ld((unsigned*)(F.ctl + CW_BAR) + XB_TMO) != 0u) {
            const float qn = __builtin_nanf("");
            for (size_t idx = (size_t)blockIdx.x * 512 + F.tid; idx < (size_t)NB * SEQ * DM / 4; idx += (size_t)F.G * 512) ((f32x4*)A.out)[idx] = (f32x4){qn, qn, qn, qn};
        }
    }
    if (TIMER_ON) { const unsigned long long now_ = __builtin_amdgcn_s_memrealtime(); if (41 >= TIMER_LO && 41 <= TIMER_HI) TM.acc += now_ - TM.prev;
        if (blockIdx.x == 0) { const unsigned long long tgt = now_ + TM.acc; while (__builtin_amdgcn_s_memrealtime() < tgt) __builtin_amdgcn_s_sleep(8); } }
#undef IN
#undef SEAM
}

extern "C" void kernel_launch(void* const* d_in, const int* in_sizes, int n_in, void* d_out, int out_size, void* d_ws, size_t ws_size, hipStream_t stream) {
    static int grid = 0;
    if (grid == 0) {
        if (n_in != 29 || in_sizes[0] != NB * SEQ * DM || out_size != NB * SEQ * DM || ws_size < WS_END) {
            fprintf(stderr, "kernel_launch: unexpected problem: n_in %d, in0 %d, out %d, ws %zu (need %zu); nothing launched\n", n_in, n_in > 0 ? in_sizes[0] : -1, out_size, ws_size, (size_t)WS_END); grid = -1; return; }
        int dev = 0, cus = 0, per_cu = 0;
        if (hipGetDevice(&dev) != hipSuccess || hipDeviceGetAttribute(&cus, hipDeviceAttributeMultiprocessorCount, dev) != hipSuccess) { fprintf(stderr, "kernel_launch: device query failed\n"); grid = -1; return; }
        if (hipFuncSetAttribute((const void*)fwd_kernel, hipFuncAttributeMaxDynamicSharedMemorySize, LDS_BYTES) != hipSuccess) { fprintf(stderr, "kernel_launch: hipFuncSetAttribute failed\n"); grid = -1; return; }
        if (hipOccupancyMaxActiveBlocksPerMultiprocessor(&per_cu, (const void*)fwd_kernel, NWAVES * 64, LDS_BYTES) != hipSuccess || per_cu < 1)
            fprintf(stderr, "kernel_launch: note: occupancy query reports %d workgroups per CU\n", per_cu);
        (void)hipGetLastError();
        grid = cus;
    }
    if (grid < 0) return;
    if (hipMemsetAsync((char*)d_ws + WS_CTL, 0, CTL_ZERO_BYTES, stream) != hipSuccess) { fprintf(stderr, "kernel_launch: memset failed\n"); return; }
    Args a{};
    const float** ap = (const float**)&a;
    for (int i = 0; i < 29; ++i) ap[i] = (const float*)d_in[i];
    a.out = (float*)d_out; a.ws = (unsigned char*)d_ws;
#if MK_PER_PHASE
    for (int k = 0; k < N_PHASES; ++k) { a.ph_lo = k; a.ph_hi = k + 1; hipLaunchKernelGGL(fwd_kernel, dim3(grid), dim3(NWAVES * 64), LDS_BYTES, stream, a); }
#else
    a.ph_lo = 0; a.ph_hi = N_PHASES;
    hipLaunchKernelGGL(fwd_kernel, dim3(grid), dim3(NWAVES * 64), LDS_BYTES, stream, a);
#endif
    const hipError_t le = hipPeekAtLastError();
    if (le != hipSuccess) fprintf(stderr, "kernel_launch: launch failed: %s\n", hipGetErrorName(le));
}
```

```cpp
#include <hip/hip_runtime.h>
#include <cstdio>
#include <cstdint>

#define LAS __attribute__((address_space(3)))
#define GAS __attribute__((address_space(1)))
typedef unsigned short bf16_t;
typedef short bf16x8 __attribute__((ext_vector_type(8)));
typedef short s16x4 __attribute__((ext_vector_type(4)));
typedef float f32x4 __attribute__((ext_vector_type(4)));
typedef float f32x2 __attribute__((ext_vector_type(2)));
typedef float f32x16 __attribute__((ext_vector_type(16)));
typedef unsigned u32x4 __attribute__((ext_vector_type(4)));
typedef unsigned u32x2 __attribute__((ext_vector_type(2)));
typedef GAS unsigned gu32;

namespace pg8 {
constexpr int BM = 256, BK = 64, HALF = 128, HTB = HALF * BK * 2  , STAGE_BYTES = 8 * HTB, NXCD = 8, WGM = 8;

__host__ __device__ __forceinline__ int lds_byte(int r, int c) { const int st = (r >> 4) * 2 + (c >> 5), rr = r & 15, cc = c & 31, ob = rr * 64 + cc * 2; return st * 1024 + (ob ^ (((ob >> 9) & 1) << 5)); }
__host__ __device__ __forceinline__ void stage_rc(int b, int& R, int& C) { const int st = b / 1024, sb = b % 1024, swz = sb ^ (((sb >> 9) & 1) << 5); R = (st >> 1) * 16 + swz / 64; C = (st & 1) * 32 + (swz % 64) / 2; }
__host__ __device__ __forceinline__ int perm32(int rho) { const int n = rho >> 4, i = rho & 15; return 8 * (i >> 2) + 4 * n + (i & 3); }

struct Unit { int pm, pn; };
struct Gemm { const bf16_t* A; const bf16_t* Bt; int lda, K; };

struct StaticOrder {
    int nM, nN, nwg, G, c;
    __device__ void init(int nM_, int nN_, int G_, int c_) { nM = nM_; nN = nN_; nwg = nM * nN; G = G_; c = c_; }
    __device__ bool next(int i, Unit& u) const {
        const long L = (long)i * G + c; if (L >= nwg) return false;
        int wgid = (int)L; { const int q = nwg / NXCD, r = nwg % NXCD, xcd = wgid % NXCD, off = wgid / NXCD; wgid = (xcd < r ? xcd * (q + 1) : r * (q + 1) + (xcd - r) * q) + off; }
        const int nig = WGM * nN, gid = wgid / nig, fm = gid * WGM, gsz = (nM - fm) < WGM ? (nM - fm) : WGM;
        u.pm = fm + ((wgid % nig) % gsz); u.pn = (wgid % nig) / gsz; return true;
    }
    __device__ __forceinline__ const char* a_base(const Gemm& g, const Unit& u) const { return (const char*)g.A + (size_t)u.pm * (size_t)(BM * 2) * g.lda; }
    __device__ __forceinline__ const char* b_base(const Gemm& g, const Unit& u) const { return (const char*)g.Bt + (size_t)u.pn * (size_t)(BM * 2) * g.K; }
    __device__ __forceinline__ unsigned row_off(const Gemm& g, const Unit&, int r) const { return (unsigned)r * (unsigned)g.lda * 2u; }
};

struct LatentOrder : StaticOrder {
    __device__ bool next(int i, Unit& u) const { if (!StaticOrder::next(i, u)) return false; u.pm = u.pm + (u.pm >> 4) + 1; return true; }
};

__device__ __forceinline__ unsigned cvt_pk_bf16(float lo, float hi) { unsigned r; asm volatile("v_cvt_pk_bf16_f32 %0, %1, %2" : "=v"(r) : "v"(lo), "v"(hi)); return r; }

template <class Epi, class Sched, bool ALIGN_EPI, bool GATHER>
__device__ __forceinline__ void gemm_phase(LAS unsigned char* lds, const Gemm g, const Sched& S, const Epi& E, const int wave0, const unsigned delay_ticks = 0u) {
    if (delay_ticks) { const unsigned long long t0_ = __builtin_amdgcn_s_memrealtime(); while (__builtin_amdgcn_s_memrealtime() - t0_ < (unsigned long long)delay_ticks) __builtin_amdgcn_s_sleep(16); }
    int tid_ = wave0 * 64 + (int)__builtin_amdgcn_mbcnt_hi(~0u, __builtin_amdgcn_mbcnt_lo(~0u, 0u)); asm volatile("" : "+v"(tid_));
    const int tid = tid_, wid = __builtin_amdgcn_readfirstlane(tid >> 6), lane = tid & 63, wr = wid >> 2, wc = wid & 3, fr = lane & 15, fq = lane >> 4;
    const int K = g.K, nt = K / BK;
    unsigned voffB[2];
#pragma unroll
    for (int i = 0; i < 2; ++i) { int R, C; stage_rc(tid * 16 + i * 8192, R, C); const int Rb = Epi::PERM ? ((R & ~31) + perm32(R & 31)) : R; voffB[i] = (unsigned)(Rb * K + C) * 2u; }
    const size_t kstep = (size_t)(BK * 2);
    const size_t hstepB = (size_t)HALF * K * 2;
    const unsigned ldsw = (unsigned)wid * 1024u;
    const int aoff = lds_byte(wr * 64 + fr, fq * 8), boff = lds_byte(wc * 32 + fr, fq * 8);
#define PG8_SA(b, h) (((b) * 2 + (h)) * HTB)
#define PG8_SB(b, h) ((4 + (b) * 2 + (h)) * HTB)
#define PG8_STAGE(bufoff, gbase, voff) do { _Pragma("unroll") for (int _i = 0; _i < 2; ++_i) \
        __builtin_amdgcn_global_load_lds((const unsigned*)((const char*)(gbase) + (voff)[_i]), (LAS unsigned*)(lds + (bufoff) + ldsw + _i * 8192), 16, 0, 0); } while (0)
#define PG8_LDA(dst, b, h) do { _Pragma("unroll") for (int m = 0; m < 4; ++m) _Pragma("unroll") for (int k = 0; k < 2; ++k) dst[m][k] = *(const LAS bf16x8*)(lds + PG8_SA(b, h) + aoff + m * 2048 + k * 1024); } while (0)
#define PG8_LDB(dst, b, h) do { _Pragma("unroll") for (int n = 0; n < 2; ++n) _Pragma("unroll") for (int k = 0; k < 2; ++k) dst[n][k] = *(const LAS bf16x8*)(lds + PG8_SB(b, h) + boff + n * 2048 + k * 1024); } while (0)
#define PG8_MMA(ai, bj, At, Bt) do { __builtin_amdgcn_s_setprio(1); _Pragma("unroll") for (int m = 0; m < 4; ++m) _Pragma("unroll") for (int n = 0; n < 2; ++n) _Pragma("unroll") for (int k = 0; k < 2; ++k) \
        acc[ai][bj][m][n] = __builtin_amdgcn_mfma_f32_16x16x32_bf16(Bt[n][k], At[m][k], acc[ai][bj][m][n], 0, 0, 0); __builtin_amdgcn_s_setprio(0); } while (0)
#define PG8_WAIT_V(n) asm volatile("s_waitcnt vmcnt(" #n ")" ::: "memory")
#define PG8_WAIT_L(n) asm volatile("s_waitcnt lgkmcnt(" #n ")" ::: "memory")
#define PG8_BAR __builtin_amdgcn_s_barrier()
#define PG8_SCHED __builtin_amdgcn_sched_barrier(0)
    Unit cur, nxt; int ui = 0;
    if (!S.next(0, cur)) return;
    f32x4 acc[2][2][4][2];
#pragma unroll
    for (int a = 0; a < 2; ++a)
#pragma unroll
        for (int b = 0; b < 2; ++b)
#pragma unroll
            for (int m = 0; m < 4; ++m)
#pragma unroll
                for (int n = 0; n < 2; ++n) acc[a][b][m][n] = (f32x4){0.f, 0.f, 0.f, 0.f};
    bf16x8 At[4][2], B0[2][2], B1[2][2];
    const char* cA = S.a_base(g, cur); const char* cB = S.b_base(g, cur);
    unsigned va[2][2], vn[2][2];
#pragma unroll
    for (int h = 0; h < 2; ++h)
#pragma unroll
        for (int i = 0; i < 2; ++i) { int R, C; stage_rc(tid * 16 + i * 8192, R, C); va[h][i] = S.row_off(g, cur, h * HALF + R) + (unsigned)C * 2u; vn[h][i] = va[h][i]; }
    PG8_STAGE(PG8_SB(0, 0), cB, voffB); PG8_STAGE(PG8_SB(0, 1), cB + hstepB, voffB); PG8_STAGE(PG8_SA(0, 0), cA, va[0]); PG8_STAGE(PG8_SA(0, 1), cA, va[1]);
    if (wr == 1) PG8_BAR;
    PG8_WAIT_V(2); PG8_BAR;
    PG8_STAGE(PG8_SB(1, 0), cB + kstep, voffB); PG8_STAGE(PG8_SA(1, 0), cA + kstep, va[0]); PG8_STAGE(PG8_SB(1, 1), cB + hstepB + kstep, voffB);
    PG8_WAIT_V(6); PG8_BAR;
    for (;;) {
        const bool has_next = S.next(ui + 1, nxt);
        const char* nA = has_next ? S.a_base(g, nxt) : cA; const char* nB = has_next ? S.b_base(g, nxt) : cB;
        if (GATHER) {
            if (has_next) {
#pragma unroll
                for (int h = 0; h < 2; ++h)
#pragma unroll
                    for (int i = 0; i < 2; ++i) { int R, C; stage_rc(tid * 16 + i * 8192, R, C); vn[h][i] = S.row_off(g, nxt, h * HALF + R) + (unsigned)C * 2u; }
            } else {
#pragma unroll
                for (int h = 0; h < 2; ++h)
#pragma unroll
                    for (int i = 0; i < 2; ++i) vn[h][i] = va[h][i];
            }
        }
        for (int t = 0; t < nt; t += 2) {
            const bool last = (t == nt - 2);
            const char* a1 = cA + (size_t)(t + 1) * kstep;
            const char* a2 = last ? nA : cA + (size_t)(t + 2) * kstep; const char* b2 = last ? nB : cB + (size_t)(t + 2) * kstep;
            const char* a3 = a2 + kstep; const char* b3 = b2 + kstep;
            unsigned v2[2][2];
#pragma unroll
            for (int h = 0; h < 2; ++h)
#pragma unroll
                for (int i = 0; i < 2; ++i) v2[h][i] = (GATHER && last) ? vn[h][i] : va[h][i];
            PG8_LDB(B0, 0, 0); PG8_LDB(B1, 0, 1); PG8_SCHED; PG8_LDA(At, 0, 0); PG8_STAGE(PG8_SA(1, 1), a1, va[1]);
            PG8_WAIT_V(8); PG8_WAIT_L(0); PG8_BAR; PG8_MMA(0, 0, At, B0); PG8_MMA(0, 1, At, B1); PG8_BAR; PG8_SCHED;
            PG8_LDA(At, 0, 1); PG8_STAGE(PG8_SB(0, 0), b2, voffB); PG8_STAGE(PG8_SB(0, 1), b2 + hstepB, voffB); PG8_STAGE(PG8_SA(0, 0), a2, v2[0]);
            PG8_WAIT_V(8); PG8_WAIT_L(0); PG8_BAR; PG8_MMA(1, 0, At, B0); PG8_MMA(1, 1, At, B1); PG8_BAR; PG8_SCHED;
            PG8_LDB(B0, 1, 0); PG8_LDB(B1, 1, 1); PG8_SCHED; PG8_LDA(At, 1, 0); PG8_STAGE(PG8_SA(0, 1), a2, v2[1]);
            PG8_WAIT_V(8); PG8_WAIT_L(0); PG8_BAR; PG8_MMA(0, 0, At, B0); PG8_MMA(0, 1, At, B1); PG8_BAR; PG8_SCHED;
            PG8_LDA(At, 1, 1); PG8_STAGE(PG8_SB(1, 0), b3, voffB); PG8_STAGE(PG8_SB(1, 1), b3 + hstepB, voffB); PG8_STAGE(PG8_SA(1, 0), a3, v2[0]);
            PG8_WAIT_V(8); PG8_WAIT_L(0); PG8_BAR; PG8_MMA(1, 0, At, B0); PG8_MMA(1, 1, At, B1); PG8_BAR; PG8_SCHED;
        }
        if constexpr (ALIGN_EPI) { if (wr == 0) PG8_BAR; }
        { int l2 = (int)__builtin_amdgcn_mbcnt_hi(~0u, __builtin_amdgcn_mbcnt_lo(~0u, 0u)); asm volatile("" : "+v"(l2)); E(acc, cur, wr, wc, l2 & 15, l2 >> 4); }
        if (!has_next) break;
#pragma unroll
        for (int a = 0; a < 2; ++a)
#pragma unroll
            for (int b = 0; b < 2; ++b)
#pragma unroll
                for (int m = 0; m < 4; ++m)
#pragma unroll
                    for (int n = 0; n < 2; ++n) acc[a][b][m][n] = (f32x4){0.f, 0.f, 0.f, 0.f};
        cur = nxt; cA = nA; cB = nB; ++ui;
        if (GATHER) {
#pragma unroll
            for (int h = 0; h < 2; ++h)
#pragma unroll
                for (int i = 0; i < 2; ++i) va[h][i] = vn[h][i];
        }
        if constexpr (ALIGN_EPI) { if (wr == 1) PG8_BAR; }
    }
    PG8_WAIT_V(0);
    if constexpr (!ALIGN_EPI) { if (wr == 0) PG8_BAR; }
    PG8_BAR;
#undef PG8_SA
#undef PG8_SB
#undef PG8_STAGE
#undef PG8_LDA
#undef PG8_LDB
#undef PG8_MMA
#undef PG8_WAIT_V
#undef PG8_WAIT_L
#undef PG8_BAR
#undef PG8_SCHED
}
}

constexpr int DM = 1024, NB = 16, SEQ = 4096, NCTX = 256, SROW = SEQ + NCTX  , MROWS = NB * SROW  , NPAN = MROWS / 256  ;
constexpr int DIN = 2048, CONVCH = 4096, SSD_IN = 6208, NXBC = 4352  ;
constexpr int QW = 1024, KVW = 256, NQKV = 1536;
constexpr int DFF = 2816, NEXP = 8, DFFE = 3584;
constexpr float EPS = 1e-6f;
constexpr int MOE_CHUNK = 192;
constexpr int NWAVES = 8;

constexpr size_t MiB = 1u << 20;
constexpr size_t WS_CTL = 0, CTL_ZERO_BYTES = 1 * MiB;
constexpr size_t WS_MODV = 2 * MiB;
constexpr size_t WS_ROPE = 4 * MiB;
constexpr size_t WS_GATE = 5 * MiB;
constexpr size_t WS_RLIST = 6 * MiB;
constexpr size_t WS_CX = 10 * MiB;
constexpr size_t WS_W = 26 * MiB;
constexpr size_t W_SSD_STRIDE = 33 * MiB, W_WZ = 0, W_WIN = 4 * MiB, W_WOUT = 12 * MiB + MiB / 2, W_WUP = 16 * MiB + MiB / 2, W_WDN = 27 * MiB + MiB / 2;
constexpr size_t W_ATT0 = 66 * MiB, W_ATT_STRIDE = 5 * MiB, W_WQKV = 0, W_WO = 3 * MiB;
constexpr size_t WS_H = 102 * MiB;
constexpr size_t WS_BIG = 238 * MiB;
constexpr size_t BIG_K = 136 * MiB, BIG_V = 170 * MiB, BIG_O = 204 * MiB, BIG_MW13 = 336 * MiB, BIG_MW2 = 448 * MiB;
static_assert((size_t)MOE_CHUNK * 256 * DFFE * 2 <= BIG_MW13 && BIG_O + 136 * MiB <= BIG_MW13 + 200 * MiB && BIG_MW2 + 56 * MiB <= 544 * MiB, "BIG region map");
constexpr size_t WS_Y = 782 * MiB;
constexpr size_t WS_DT = 1054 * MiB;
constexpr size_t WS_HALO = 1071 * MiB;
constexpr size_t WS_END = 1106 * MiB;
constexpr int CW_BAR = 4096;
constexpr int CW_CNT = 16384;

constexpr int RING_BYTES = 131072;
constexpr int PSCR_OFF = 131072;
constexpr int LDSCTL_OFF = 151552, MISC_OFF = LDSCTL_OFF + 320;
constexpr int LDS_BYTES = 155648;

#define RLX_AGENT __ATOMIC_RELAXED, __HIP_MEMORY_SCOPE_AGENT
#define LDS_WAIT() asm volatile("s_waitcnt lgkmcnt(0)" ::: "memory")
#define VM_WAIT() asm volatile("s_waitcnt vmcnt(0)" ::: "memory")
__device__ __forceinline__ unsigned f2bf(float f) { unsigned u = __builtin_bit_cast(unsigned, f); return (u + 0x7fffu + ((u >> 16) & 1u)) >> 16; }
__device__ __forceinline__ unsigned pk2(float lo, float hi) { return f2bf(lo) | (f2bf(hi) << 16); }
__device__ __forceinline__ float bf_lo(unsigned u) { return __builtin_bit_cast(float, u << 16); }
__device__ __forceinline__ float bf_hi(unsigned u) { return __builtin_bit_cast(float, u & 0xffff0000u); }
__device__ __forceinline__ float bf1(bf16_t h) { return __builtin_bit_cast(float, (unsigned)h << 16); }
__device__ __forceinline__ float siluf(float v) { return v * __builtin_amdgcn_rcpf(1.0f + __expf(-v)); }
__device__ __forceinline__ float shx(float v, int mask, int lane) { return __builtin_bit_cast(float, __builtin_amdgcn_ds_bpermute((lane ^ mask) << 2, __builtin_bit_cast(int, v))); }
__device__ __forceinline__ float wave_sum(float v, int lane) {
#pragma unroll
    for (int o = 1; o < 64; o <<= 1) v += shx(v, o, lane);
    return v;
}

__device__ __forceinline__ int lane_id() { return (int)__builtin_amdgcn_mbcnt_hi(~0u, __builtin_amdgcn_mbcnt_lo(~0u, 0u)); }
#define XB_TMO      128
#define XB_XCNT(j)  (256  + 64 * (j))
#define XB_XSUB(j)  (1280 + 64 * (j))
#define XB_XGEN(j)  (2304 + 64 * (j))
#define XB_TOP      3328
#define XB_TOPGEN   3392
#define XCD_BAR_WORDS 3456
#define XB_SPIN_CAP (1u << 18)

__device__ __forceinline__ unsigned xb_ld(unsigned* p)              { return __hip_atomic_load(p, __ATOMIC_RELAXED, __HIP_MEMORY_SCOPE_AGENT); }
__device__ __forceinline__ unsigned xb_add(unsigned* p, unsigned v) { return __hip_atomic_fetch_add(p, v, __ATOMIC_RELAXED, __HIP_MEMORY_SCOPE_AGENT); }
__device__ __forceinline__ unsigned xb_xcc_id() { return (unsigned)__builtin_amdgcn_s_getreg((3 << 11) | 20) & 0xFu; }
#define XB_SPIN(cond, bar) do { unsigned _sp = 0; while (cond) { __builtin_amdgcn_s_sleep(1); \
    if ((++_sp & 255u) == 0u) { if (xb_ld(&(bar)[XB_TMO])) break; if (_sp > XB_SPIN_CAP) { atomicAdd(&(bar)[XB_TMO], 1u); break; } } } } while (0)

struct XcdBarrier {
    unsigned* bar; unsigned x;
    volatile LAS unsigned* st;
    int wave0;
};
__device__ __forceinline__ XcdBarrier xcd_barrier_post(unsigned* bar, volatile LAS unsigned* st, int wave0) {
    XcdBarrier b; b.bar = bar; b.x = xb_xcc_id(); b.st = st; b.wave0 = wave0;
    if (wave0 == 0 && lane_id() == 0) (void)xb_add(&bar[XB_XCNT(b.x)], 1u);
    return b;
}
__device__ __forceinline__ void xcd_barrier_complete(unsigned* bar, unsigned x, unsigned& nloc, unsigned& nx) {
    const unsigned G = gridDim.x * gridDim.y * gridDim.z;
    unsigned sum, cnt, mine, sp = 0u;
    for (;;) {
        sum = 0u; cnt = 0u; mine = 0u;
#pragma unroll
        for (unsigned j = 0; j < 16; ++j) { const unsigned c = xb_ld(&bar[XB_XCNT(j)]); sum += c; cnt += (c > 0u) ? 1u : 0u; mine = (j == x) ? c : mine; }
        if (sum == G) break;
        __builtin_amdgcn_s_sleep(1);
        if ((++sp & 255u) == 0u) { if (xb_ld(&bar[XB_TMO])) break; if (sp > XB_SPIN_CAP) { atomicAdd(&bar[XB_TMO], 1u); break; } }
    }
    nloc = mine > 0u ? mine : 1u; nx = cnt > 0u ? cnt : 1u;
}
__device__ __forceinline__ void xcd_barrier(const XcdBarrier& b) {
    asm volatile("s_waitcnt vmcnt(0)" ::: "memory");
    __syncthreads();
    if (b.wave0 == 0 && lane_id() == 0) {
        unsigned* bar = b.bar;
        __builtin_amdgcn_s_waitcnt(0);
        unsigned nloc = b.st[0], nx = b.st[1];
        if (nloc == 0u) { xcd_barrier_complete(bar, b.x, nloc, nx); b.st[0] = nloc; b.st[1] = nx; }
        const unsigned old = xb_add(&bar[XB_XSUB(b.x)], 1u);
        const unsigned gen = old / nloc;
        if (old + 1u == (gen + 1u) * nloc) {
            __builtin_amdgcn_fence(__ATOMIC_RELEASE, "agent");
            asm volatile("s_waitcnt vmcnt(0)" ::: "memory");
            const unsigned og = xb_add(&bar[XB_TOP], 1u);
            const unsigned tg = og / nx;
            if (og + 1u == (tg + 1u) * nx) xb_add(&bar[XB_TOPGEN], 1u);
            else XB_SPIN(xb_ld(&bar[XB_TOPGEN]) == tg, bar);
            __builtin_amdgcn_fence(__ATOMIC_ACQUIRE, "agent");
            xb_add(&bar[XB_XGEN(b.x)], 1u);
            asm volatile("s_waitcnt vmcnt(0)" ::: "memory");
        } else {
            XB_SPIN(xb_ld(&bar[XB_XGEN(b.x)]) == gen, bar);
            __builtin_amdgcn_fence(__ATOMIC_ACQUIRE, "agent");
            asm volatile("s_waitcnt vmcnt(0)" ::: "memory");
        }
    }
    __syncthreads();
}

struct Args {
    const float *x, *c, *ctx, *c_ctx, *w_mod, *b_mod, *norm1_w, *norm2_w, *ssd_w_in, *ssd_conv_w, *ssd_conv_b, *ssd_dt_bias, *ssd_a_log, *ssd_d, *ssd_norm_w, *ssd_w_out,
                *attn_w_qkv, *attn_b_qkv, *attn_sink, *attn_w_o, *attn_b_o, *ffn_w1, *ffn_w3, *ffn_w2, *moe_router, *moe_w1, *moe_w3, *moe_w2, *final_norm_w;
    float* out; unsigned char* ws; int ph_lo, ph_hi;
};
struct Frame {
    LAS unsigned char* lds;
    int tid, lane, wave, G;
    unsigned char* ws; gu32* ctl; float* out;
    unsigned char* ws0; float* out0; int wave0;
};
__device__ __forceinline__ void phase_enter(Frame& F) { int l = lane_id(); asm volatile("" : "+v"(l)); F.lane = l; F.wave = F.wave0; F.tid = F.wave0 * 64 + l;
    unsigned char* w = F.ws0; float* o = F.out0; asm volatile("" : "+s"(w), "+s"(o)); F.ws = w; F.ctl = (gu32*)(w + WS_CTL); F.out = o; }
__device__ __forceinline__ float* resid_row(const Frame& F, int R) {
    const int b = R / SROW, s = R - b * SROW;
    return s < NCTX ? (float*)(F.ws + WS_CX) + (size_t)(b * NCTX + s) * DM : F.out + (size_t)(b * SEQ + s - NCTX) * DM;
}
__device__ __forceinline__ float* resid_panel(const Frame& F, int pm, int& cond) {
    const int b = pm / 17, j = pm - b * 17; cond = j == 0 ? 16 : b;
    return j == 0 ? (float*)(F.ws + WS_CX) + (size_t)(b * NCTX) * DM : F.out + (size_t)(b * SEQ + (j - 1) * 256) * DM;
}

__device__ __forceinline__ void transpose_item(const float* W, int ldw, int col0, int ncb, int K, bf16_t* WT, int mode, int half, LAS float* scr, int item, int lane) {
    const int kb = item / ncb, nb = item - kb * ncb, k0 = 64 * kb, n0 = 64 * nb;
    const int lr = lane >> 4, lc = (lane & 15) * 4;
    f32x4 tv[16];
#pragma unroll
    for (int i = 0; i < 16; ++i) tv[i] = *(const GAS f32x4*)(W + (size_t)(k0 + 4 * i + lr) * ldw + col0 + n0 + lc);
#pragma unroll
    for (int i = 0; i < 16; ++i) { LAS float* d = scr + (4 * i + lr) * 65 + lc; d[0] = tv[i].x; d[1] = tv[i].y; d[2] = tv[i].z; d[3] = tv[i].w; }
    LDS_WAIT(); asm volatile("" ::: "memory");
    const int c = lane & 7;
#pragma unroll
    for (int j = 0; j < 8; ++j) { const int n = (lane >> 3) + 8 * j; const LAS float* s = scr + (8 * c) * 65 + n;
        u32x4 o; o.x = pk2(s[0 * 65], s[1 * 65]); o.y = pk2(s[2 * 65], s[3 * 65]); o.z = pk2(s[4 * 65], s[5 * 65]); o.w = pk2(s[6 * 65], s[7 * 65]);
        const int cl = n0 + n; const int drow = mode == 0 ? cl : ((cl >> 7) * 256 + half * 128 + (cl & 127));
        *(GAS u32x4*)(WT + (size_t)drow * K + k0 + 8 * c) = o; }
    LDS_WAIT(); asm volatile("" ::: "memory");
}
__device__ __forceinline__ void p0_prologue(Frame& F, const Args& A) {
    phase_enter(F);
    {
        LAS float* sc = (LAS float*)F.lds;
        LAS float* red = (LAS float*)(F.lds + 81920);
        for (int idx = F.tid; idx < 17 * 1024; idx += 512) { const int cb = idx >> 10, k = idx & 1023; const float v = cb < 16 ? A.c[cb * 1024 + k] : A.c_ctx[k]; sc[k * 20 + cb] = v / (1.0f + expf(-v)); }
        __syncthreads();
        float* MODV = (float*)(F.ws + WS_MODV);
        for (int item = blockIdx.x; item < 4 * 96; item += F.G) {
            const int i = item / 96, cblk = item - i * 96;
            const float* Wm = A.w_mod + (size_t)i * 1024 * 6144 + cblk * 64 + F.lane;
            float acc[17];
#pragma unroll
            for (int cb = 0; cb < 17; ++cb) acc[cb] = 0.f;
            const int k0 = F.wave * 128;
#pragma unroll 4
            for (int kk = 0; kk < 128; ++kk) { const int k = k0 + kk; const float w = Wm[(size_t)k * 6144]; const LAS float* s = sc + k * 20;
#pragma unroll
                for (int cb = 0; cb < 17; ++cb) acc[cb] += s[cb] * w; }
#pragma unroll
            for (int cb = 0; cb < 17; ++cb) red[(F.wave * 17 + cb) * 64 + F.lane] = acc[cb];
            __syncthreads();
            for (int idx = F.tid; idx < 17 * 64; idx += 512) { const int cb = idx >> 6, l = idx & 63; float s = 0.f;
#pragma unroll
                for (int w = 0; w < 8; ++w) s += red[(w * 17 + cb) * 64 + l];
                MODV[(size_t)(i * 17 + cb) * 6144 + cblk * 64 + l] = s + A.b_mod[i * 6144 + cblk * 64 + l]; }
            __syncthreads();
        }
    }
    if (blockIdx.x == 0) { float* RT = (float*)(F.ws + WS_ROPE);
        for (int idx = F.tid; idx < 1024; idx += 512) { const int id = idx >> 4, f = idx & 15; const float inv = __builtin_amdgcn_exp2f(-(float)f * (13.287712379549449f / 16.0f)); const float ang = (float)id * inv;
            RT[idx] = __cosf(ang); RT[1024 + idx] = __sinf(ang); } }
    __syncthreads();
    {
        LAS float* scr = (LAS float*)(F.lds + F.wave * 16896);
        const int gw = blockIdx.x * NWAVES + F.wave, NGW = F.G * NWAVES;
        constexpr int I1 = 16 * 32, I2 = 16 * 65, I3 = 32 * 16, I4 = 16 * 44, I5 = 16 * 44, I6 = 44 * 16, I7 = 16 * 24, I8 = 16 * 16, IPER = I1 + I2 + I3 + I4 + I5 + I6 + I7 + I8;
        for (int it = gw; it < 2 * IPER; it += NGW) {
            const int j = it / IPER; int r = it - j * IPER;
            unsigned char* wss = F.ws + WS_W + (size_t)j * W_SSD_STRIDE; unsigned char* wsa = F.ws + WS_W + W_ATT0 + (size_t)j * W_ATT_STRIDE;
            if (r < I1) { transpose_item(A.ssd_w_in + (size_t)j * 1024 * SSD_IN, SSD_IN, 0, 32, 1024, (bf16_t*)(wss + W_WZ), 0, 0, scr, r, F.lane); continue; } r -= I1;
            if (r < I2) { transpose_item(A.ssd_w_in + (size_t)j * 1024 * SSD_IN, SSD_IN, 2048, 65, 1024, (bf16_t*)(wss + W_WIN), 0, 0, scr, r, F.lane); continue; } r -= I2;
            if (r < I3) { transpose_item(A.ssd_w_out + (size_t)j * 2048 * 1024, 1024, 0, 16, 2048, (bf16_t*)(wss + W_WOUT), 0, 0, scr, r, F.lane); continue; } r -= I3;
            if (r < I4) { transpose_item(A.ffn_w1 + (size_t)j * 1024 * DFF, DFF, 0, 44, 1024, (bf16_t*)(wss + W_WUP), 1, 0, scr, r, F.lane); continue; } r -= I4;
            if (r < I5) { transpose_item(A.ffn_w3 + (size_t)j * 1024 * DFF, DFF, 0, 44, 1024, (bf16_t*)(wss + W_WUP), 1, 1, scr, r, F.lane); continue; } r -= I5;
            if (r < I6) { transpose_item(A.ffn_w2 + (size_t)j * DFF * 1024, 1024, 0, 16, DFF, (bf16_t*)(wss + W_WDN), 0, 0, scr, r, F.lane); continue; } r -= I6;
            if (r < I7) { transpose_item(A.attn_w_qkv + (size_t)j * 1024 * NQKV, NQKV, 0, 24, 1024, (bf16_t*)(wsa + W_WQKV), 0, 0, scr, r, F.lane); continue; } r -= I7;
            transpose_item(A.attn_w_o + (size_t)j * 1024 * 1024, 1024, 0, 16, 1024, (bf16_t*)(wsa + W_WO), 0, 0, scr, r, F.lane);
        }
        for (int j = 0; j < 2; ++j) { u32x4* z = (u32x4*)(F.ws + WS_W + (size_t)j * W_SSD_STRIDE + W_WIN + (size_t)4160 * 1024 * 2);
            for (int idx = blockIdx.x * 512 + F.tid; idx < 192 * 1024 * 2 / 16; idx += F.G * 512) z[idx] = (u32x4){0u, 0u, 0u, 0u}; }
    }
}
__device__ __forceinline__ void moe_convert(Frame& F, const Args& A, int j, int wg0, int nwg) {
    phase_enter(F);
    LAS float* scr = (LAS float*)(F.lds + F.wave * 16896);
    const int gw = ((int)blockIdx.x - wg0) * NWAVES + F.wave, NGW = nwg * NWAVES;
    constexpr int IE = 16 * 56, I2 = 56 * 16;
    bf16_t* MW13 = (bf16_t*)(F.ws + WS_BIG + BIG_MW13); bf16_t* MW2 = (bf16_t*)(F.ws + WS_BIG + BIG_MW2);
    for (int it = gw; it < 8 * (2 * IE + I2); it += NGW) {
        const int e = it / (2 * IE + I2); int r = it - e * (2 * IE + I2);
        const size_t we = (size_t)(j * 8 + e) * 1024 * DFFE;
        if (r < IE) { transpose_item(A.moe_w1 + we, DFFE, 0, 56, 1024, MW13 + (size_t)e * 7168 * 1024, 1, 0, scr, r, F.lane); continue; } r -= IE;
        if (r < IE) { transpose_item(A.moe_w3 + we, DFFE, 0, 56, 1024, MW13 + (size_t)e * 7168 * 1024, 1, 1, scr, r, F.lane); continue; } r -= IE;
        transpose_item(A.moe_w2 + we, 1024, 0, 16, DFFE, MW2 + (size_t)e * 1024 * DFFE, 0, 0, scr, r, F.lane);
    }
}

__device__ __forceinline__ void norm_phase(Frame& F, const Args& A, int i, int which, int mode) {
    phase_enter(F);
    const bool first = mode & 1, combine = mode & 2, route = mode & 4, fin = mode & 8, lastl = mode & 16;
    const float* MODV = (const float*)(F.ws + WS_MODV);
    bf16_t* H = (bf16_t*)(F.ws + WS_H);
    const bf16_t* EO = (const bf16_t*)(F.ws + WS_Y);
    LAS float* rt = (LAS float*)F.lds;
    LAS int* ents = (LAS int*)(F.lds + 32768);
    const int jm = i >> 1;
    if (route) { const float* rg = A.moe_router + (size_t)jm * 1024 * 8; for (int idx = F.tid; idx < 8192; idx += 512) rt[(idx & 7) * 1024 + (idx >> 3)] = rg[idx]; }
    __syncthreads();
    const float* nw = fin ? A.final_norm_w : ((which == 0 ? A.norm1_w : A.norm2_w) + i * 1024);
    unsigned* cnt = (unsigned*)(F.ctl + CW_CNT + (size_t)jm * 8 * 64);
    int* rlist = (int*)(F.ws + WS_RLIST); float* GATE = (float*)(F.ws + WS_GATE);
    for (int ch = blockIdx.x; ch < MROWS / 32; ch += F.G) {
        const int R0 = ch * 32, b = R0 / SROW, s0 = R0 - b * SROW; const bool isctx = s0 < NCTX; const int cond = isctx ? 16 : b;
        if (fin && isctx) continue;
        const bool do_route = route && !(lastl && isctx);
        const float* mv = MODV + (size_t)(i * 17 + cond) * 6144;
        f32x4 wv[4], shv[4], scv[4], g5[4];
#pragma unroll
        for (int j = 0; j < 4; ++j) { const int col = 4 * F.lane + 256 * j; wv[j] = *(const f32x4*)(nw + col);
            if (!fin) { shv[j] = *(const f32x4*)(mv + (which ? 3 : 0) * 1024 + col); scv[j] = *(const f32x4*)(mv + (which ? 4 : 1) * 1024 + col); }
            if (combine) g5[j] = *(const f32x4*)(MODV + (size_t)((i - 1) * 17 + cond) * 6144 + 5 * 1024 + col); }
        for (int rr = 0; rr < 4; ++rr) {
            const int R = R0 + F.wave * 4 + rr, s = s0 + F.wave * 4 + rr;
            float* res = isctx ? (float*)(F.ws + WS_CX) + (size_t)(b * NCTX + s) * DM : F.out + (size_t)(b * SEQ + s - NCTX) * DM;
            const float* src = first ? (isctx ? A.ctx + (size_t)(b * NCTX + s) * DM : A.x + (size_t)(b * SEQ + s - NCTX) * DM) : res;
            f32x4 v[4]; float ss = 0.f;
#pragma unroll
            for (int j = 0; j < 4; ++j) v[j] = *(const f32x4*)(src + 4 * F.lane + 256 * j);
            if (combine) {
#pragma unroll
                for (int j = 0; j < 4; ++j) { const u32x2 e0 = *(const u32x2*)(EO + (size_t)(2 * R) * DM + 4 * F.lane + 256 * j), e1 = *(const u32x2*)(EO + (size_t)(2 * R + 1) * DM + 4 * F.lane + 256 * j);
                    f32x4 ev; ev.x = bf_lo(e0.x) + bf_lo(e1.x); ev.y = bf_hi(e0.x) + bf_hi(e1.x); ev.z = bf_lo(e0.y) + bf_lo(e1.y); ev.w = bf_hi(e0.y) + bf_hi(e1.y);
                    v[j] = v[j] + g5[j] * ev; }
            }
            if (combine) {
#pragma unroll
                for (int j = 0; j < 4; ++j) *(f32x4*)(res + 4 * F.lane + 256 * j) = v[j];
            }
#pragma unroll
            for (int j = 0; j < 4; ++j) ss += (v[j].x * v[j].x + v[j].y * v[j].y) + (v[j].z * v[j].z + v[j].w * v[j].w);
            const float rstd = 1.0f / sqrtf(wave_sum(ss, F.lane) * (1.0f / DM) + EPS);
            if (fin) {
#pragma unroll
                for (int j = 0; j < 4; ++j) *(f32x4*)(res + 4 * F.lane + 256 * j) = v[j] * rstd * wv[j];
                continue;
            }
#pragma unroll
            for (int j = 0; j < 4; ++j) { v[j] = v[j] * rstd * wv[j] * (scv[j] + 1.0f) + shv[j];
                u32x2 o; o.x = pk2(v[j].x, v[j].y); o.y = pk2(v[j].z, v[j].w); *(u32x2*)(H + (size_t)R * DM + 4 * F.lane + 256 * j) = o; }
            if (do_route) {
                float lg[8];
#pragma unroll
                for (int e = 0; e < 8; ++e) lg[e] = 0.f;
#pragma unroll
                for (int e = 0; e < 8; ++e)
#pragma unroll
                    for (int j = 0; j < 4; ++j) { const f32x4 r = *(const LAS f32x4*)(rt + e * 1024 + 4 * F.lane + 256 * j); lg[e] += (v[j].x * r.x + v[j].y * r.y) + (v[j].z * r.z + v[j].w * r.w); }
#pragma unroll
                for (int e = 0; e < 8; ++e) lg[e] = wave_sum(lg[e], F.lane);
                int i1 = 0; float v1 = lg[0];
#pragma unroll
                for (int e = 1; e < 8; ++e) if (lg[e] > v1) { v1 = lg[e]; i1 = e; }
                int i2 = -1; float v2 = -3.0e38f;
#pragma unroll
                for (int e = 0; e < 8; ++e) if (e != i1 && lg[e] > v2) { v2 = lg[e]; i2 = e; }
                const float g1 = 1.0f / (1.0f + expf(v2 - v1)), g2 = 1.0f - g1;
                if (F.lane == 0) { ents[(F.wave * 4 + rr) * 2] = i1; ents[(F.wave * 4 + rr) * 2 + 1] = i2; GATE[(size_t)R * 2] = g1; GATE[(size_t)R * 2 + 1] = g2; }
            }
        }
        if (do_route) {
            __syncthreads();
            if (F.wave == 0) {
                const int e = ents[F.lane];
#pragma unroll
                for (int ee = 0; ee < 8; ++ee) { const unsigned long long m = __ballot(e == ee); const int n = __popcll(m);
                    if (n) { unsigned base = 0; if (F.lane == 0) base = __hip_atomic_fetch_add(cnt + ee * 64, (unsigned)n, RLX_AGENT); base = __builtin_amdgcn_readfirstlane(base);
                        if (e == ee) { const int pos = (int)base + __popcll(m & ((1ull << F.lane) - 1ull)); rlist[(size_t)ee * MROWS + pos] = (R0 + (F.lane >> 1)) * 2 + (F.lane & 1); } } }
            }
            __syncthreads();
        }
    }
}

struct EpiXbc {
    static constexpr bool PERM = true;
    bf16_t* XBC; float* DT; bf16_t* HALO;
    __device__ __forceinline__ void operator()(const f32x4 (&acc)[2][2][4][2], const pg8::Unit& u, int wr, int wc, int fr, int fq) const {
        const int row0 = u.pm * 256 + wr * 64 + fr;
        if (u.pn < 16) { const int col0 = u.pn * 256 + wc * 32 + 8 * fq;
#pragma unroll
            for (int ai = 0; ai < 2; ++ai)
#pragma unroll
                for (int m = 0; m < 4; ++m) { bf16_t* rowp = XBC + (size_t)(row0 + ai * 128 + m * 16) * CONVCH + col0;
#pragma unroll
                    for (int bj = 0; bj < 2; ++bj) { const f32x4 v0 = acc[ai][bj][m][0], v1 = acc[ai][bj][m][1]; u32x4 w; w.x = pg8::cvt_pk_bf16(v0[0], v0[1]); w.y = pg8::cvt_pk_bf16(v0[2], v0[3]); w.z = pg8::cvt_pk_bf16(v1[0], v1[1]); w.w = pg8::cvt_pk_bf16(v1[2], v1[3]);
                        *(GAS u32x4*)(rowp + bj * 128) = w;
                        const int rin = ai * 128 + wr * 64 + m * 16 + fr, rq = rin >> 6, rw = rin & 63;
                        if (rw < 2 || rw >= 62) *(GAS u32x4*)(HALO + ((size_t)u.pm * 16 + (rw < 2 ? (rq == 0 ? rw : 4 * rq + rw) : 4 * rq + rw - 60)) * CONVCH + col0 + bj * 128) = w; } }
        } else if (wc < 2) { const int c0 = wc * 32 + 8 * fq;
#pragma unroll
            for (int ai = 0; ai < 2; ++ai)
#pragma unroll
                for (int m = 0; m < 4; ++m) { float* p = DT + (size_t)(row0 + ai * 128 + m * 16) * 64 + c0; *(GAS f32x4*)p = acc[ai][0][m][0]; *(GAS f32x4*)(p + 4) = acc[ai][0][m][1]; }
        }
    }
};
struct EpiGate {
    static constexpr bool PERM = true;
    const bf16_t* Y; bf16_t* Gt; const float* nw; LAS float* P;
    __device__ __forceinline__ void operator()(f32x4 (&acc)[2][2][4][2], const pg8::Unit& u, int wr, int wc, int fr, int fq) const {
        const int row0 = u.pm * 256 + wr * 64 + fr, col0 = u.pn * 256 + wc * 32 + 8 * fq;
#pragma unroll
        for (int ai = 0; ai < 2; ++ai)
#pragma unroll
            for (int m = 0; m < 4; ++m) { const bf16_t* yp = Y + (size_t)(row0 + ai * 128 + m * 16) * DIN + u.pn * 256; float ssq = 0.f;
#pragma unroll
                for (int bj = 0; bj < 2; ++bj) { const int cg = bj * 128 + wc * 32 + 8 * fq; const u32x4 yv = *(const GAS u32x4*)(yp + ((cg >> 5) & 1) * 128 + (cg >> 6) * 32 + (cg & 31)); f32x4 z0 = acc[ai][bj][m][0], z1 = acc[ai][bj][m][1];
                    z0[0] = bf_lo(yv.x) * siluf(z0[0]); z0[1] = bf_hi(yv.x) * siluf(z0[1]); z0[2] = bf_lo(yv.y) * siluf(z0[2]); z0[3] = bf_hi(yv.y) * siluf(z0[3]);
                    z1[0] = bf_lo(yv.z) * siluf(z1[0]); z1[1] = bf_hi(yv.z) * siluf(z1[1]); z1[2] = bf_lo(yv.w) * siluf(z1[2]); z1[3] = bf_hi(yv.w) * siluf(z1[3]);
                    ssq += (z0[0] * z0[0] + z0[1] * z0[1]) + (z0[2] * z0[2] + z0[3] * z0[3]) + (z1[0] * z1[0] + z1[1] * z1[1]) + (z1[2] * z1[2] + z1[3] * z1[3]);
                    acc[ai][bj][m][0] = z0; acc[ai][bj][m][1] = z1; }
                ssq += shx(ssq, 16, fq * 16 + fr); ssq += shx(ssq, 32, fq * 16 + fr);
                if (fq == 0) P[(ai * 128 + wr * 64 + m * 16 + fr) * 4 + wc] = ssq; }
        asm volatile("s_waitcnt lgkmcnt(0)" ::: "memory"); __builtin_amdgcn_s_barrier(); asm volatile("" ::: "memory");
        f32x4 nv[2][2];
#pragma unroll
        for (int bj = 0; bj < 2; ++bj) { nv[bj][0] = *(const GAS f32x4*)(nw + col0 + bj * 128); nv[bj][1] = *(const GAS f32x4*)(nw + col0 + bj * 128 + 4); }
#pragma unroll
        for (int ai = 0; ai < 2; ++ai)
#pragma unroll
            for (int m = 0; m < 4; ++m) { const f32x4 pp = *(const LAS f32x4*)(P + (ai * 128 + wr * 64 + m * 16 + fr) * 4); const float rstd = 1.0f / sqrtf(((pp.x + pp.y) + (pp.z + pp.w)) * (1.0f / 256.0f) + EPS);
                bf16_t* gp = Gt + (size_t)(row0 + ai * 128 + m * 16) * DIN + col0;
#pragma unroll
                for (int bj = 0; bj < 2; ++bj) { const f32x4 v0 = acc[ai][bj][m][0] * rstd * nv[bj][0], v1 = acc[ai][bj][m][1] * rstd * nv[bj][1];
                    u32x4 w; w.x = pg8::cvt_pk_bf16(v0[0], v0[1]); w.y = pg8::cvt_pk_bf16(v0[2], v0[3]); w.z = pg8::cvt_pk_bf16(v1[0], v1[1]); w.w = pg8::cvt_pk_bf16(v1[2], v1[3]);
                    *(GAS u32x4*)(gp + bj * 128) = w; } }
        asm volatile("s_waitcnt lgkmcnt(0)" ::: "memory");
    }
};
struct EpiResid {
    static constexpr bool PERM = false;
    unsigned char* ws; float* out; const float* modl; int gidx; const float* bias;
    const float* rd_x; const float* rd_ctx;
    __device__ __forceinline__ void operator()(const f32x4 (&acc)[2][2][4][2], const pg8::Unit& u, int wr, int wc, int fr, int fq) const {
        const int b = u.pm / 17, j = u.pm - b * 17, cond = j == 0 ? 16 : b;
        const GAS char* pbase = (const GAS char*)(j == 0 ? (float*)(ws + WS_CX) + (size_t)(b * NCTX) * DM : out + (size_t)(b * SEQ + (j - 1) * 256) * DM);
        unsigned lo = (unsigned)(((wr * 64 + fr) * DM + u.pn * 256 + wc * 32 + 4 * fq) * 4); asm volatile("" : "+v"(lo));
        const GAS char* rbase = rd_x ? (const GAS char*)(j == 0 ? rd_ctx + (size_t)(b * NCTX) * DM : rd_x + (size_t)(b * SEQ + (j - 1) * 256) * DM) : pbase;
        const GAS float* gv = (const GAS float*)(modl + (size_t)cond * 6144 + gidx * 1024 + u.pn * 256 + wc * 32 + 4 * fq);
        const GAS float* bp = (const GAS float*)(bias ? bias + u.pn * 256 + wc * 32 + 4 * fq : nullptr);
#define RES_PTR(ai, m, bj, n) ((GAS f32x4*)(pbase + (size_t)((ai) * 128 + (m) * 16) * DM * 4 + lo + ((bj) * 128 + (n) * 16) * 4))
#define RD_PTR(ai, m, bj, n) ((const GAS f32x4*)(rbase + (size_t)((ai) * 128 + (m) * 16) * DM * 4 + lo + ((bj) * 128 + (n) * 16) * 4))
#pragma unroll
        for (int bj = 0; bj < 2; ++bj) {
            f32x4 g[2], bv[2];
#pragma unroll
            for (int n = 0; n < 2; ++n) { g[n] = *(const GAS f32x4*)(gv + bj * 128 + n * 16); bv[n] = bp ? *(const GAS f32x4*)(bp + bj * 128 + n * 16) : (f32x4){0.f, 0.f, 0.f, 0.f}; }
            if (bj == 0) {
#pragma unroll
                for (int ai = 0; ai < 2; ++ai) {
                    f32x4 o[4][2];
#pragma unroll
                    for (int m = 0; m < 4; ++m)
#pragma unroll
                        for (int n = 0; n < 2; ++n) o[m][n] = *RD_PTR(ai, m, bj, n);
#pragma unroll
                    for (int m = 0; m < 4; ++m)
#pragma unroll
                        for (int n = 0; n < 2; ++n) *RES_PTR(ai, m, bj, n) = o[m][n] + g[n] * (acc[ai][bj][m][n] + bv[n]);
                    asm volatile("" ::: "memory");
                }
            } else {
                f32x4 o[2][4][2];
#pragma unroll
                for (int ai = 0; ai < 2; ++ai)
#pragma unroll
                    for (int m = 0; m < 4; ++m)
#pragma unroll
                        for (int n = 0; n < 2; ++n) o[ai][m][n] = *RD_PTR(ai, m, bj, n);
#pragma unroll
                for (int ai = 0; ai < 2; ++ai)
#pragma unroll
                    for (int m = 0; m < 4; ++m)
#pragma unroll
                        for (int n = 0; n < 2; ++n) *RES_PTR(ai, m, bj, n) = o[ai][m][n] + g[n] * (acc[ai][bj][m][n] + bv[n]);
            }
        }
#undef RES_PTR
#undef RD_PTR
    }
};
struct EpiSwiglu {
    static constexpr bool PERM = true;
    bf16_t* ACT; int ldc;
    __device__ __forceinline__ void operator()(const f32x4 (&acc)[2][2][4][2], const pg8::Unit& u, int wr, int wc, int fr, int fq) const {
        const int row0 = u.pm * 256 + wr * 64 + fr, col0 = u.pn * 128 + wc * 32 + 8 * fq;
#pragma unroll
        for (int ai = 0; ai < 2; ++ai)
#pragma unroll
            for (int m = 0; m < 4; ++m) { const f32x4 g0 = acc[ai][0][m][0], g1 = acc[ai][0][m][1], u0 = acc[ai][1][m][0], u1 = acc[ai][1][m][1];
                u32x4 w; w.x = pg8::cvt_pk_bf16(siluf(g0[0]) * u0[0], siluf(g0[1]) * u0[1]); w.y = pg8::cvt_pk_bf16(siluf(g0[2]) * u0[2], siluf(g0[3]) * u0[3]);
                w.z = pg8::cvt_pk_bf16(siluf(g1[0]) * u1[0], siluf(g1[1]) * u1[1]); w.w = pg8::cvt_pk_bf16(siluf(g1[2]) * u1[2], siluf(g1[3]) * u1[3]);
                *(GAS u32x4*)(ACT + (size_t)(row0 + ai * 128 + m * 16) * ldc + col0) = w; }
    }
};
struct EpiQkv {
    static constexpr bool PERM = false;
    bf16_t *Q, *Kb, *Vb; const LAS float* T;
    __device__ __forceinline__ void operator()(const f32x4 (&acc)[2][2][4][2], const pg8::Unit& u, int wr, int wc, int fr, int fq) const {
        const int b = u.pm / 17, j = u.pm - b * 17; const bool isctx = j == 0; const int pos0 = (j - 1) * 256;
        bf16_t* dst; int ld, cbase; float sc = 1.0f;
        if (u.pn < 4) { dst = Q; ld = QW; cbase = u.pn * 256; sc = 0.125f * 1.4426950408889634f;   } else if (u.pn == 4) { dst = Kb; ld = KVW; cbase = 0; } else { dst = Vb; ld = KVW; cbase = 0; }
        const bool dorope = !isctx && u.pn < 5; const int axis = wc & 1;
        const LAS float* bp = T + 2048 + u.pn * 256 + wc * 32 + 4 * fq;
        f32x4 bv[2][2];
#pragma unroll
        for (int bj = 0; bj < 2; ++bj)
#pragma unroll
            for (int n = 0; n < 2; ++n) bv[bj][n] = *(const LAS f32x4*)(bp + bj * 128 + n * 16);
#pragma unroll
        for (int ai = 0; ai < 2; ++ai)
#pragma unroll
            for (int m = 0; m < 4; ++m) { const int r = ai * 128 + wr * 64 + m * 16 + fr; const int pos = pos0 + r; const int id = axis ? (pos & 63) : (pos >> 6);
                f32x4 cs = (f32x4){1.f, 1.f, 1.f, 1.f}, sn = (f32x4){0.f, 0.f, 0.f, 0.f};
                if (dorope) { cs = *(const LAS f32x4*)(T + id * 16 + 4 * fq); sn = *(const LAS f32x4*)(T + 1024 + id * 16 + 4 * fq); }
                GAS bf16_t* rowp = (GAS bf16_t*)(dst + (size_t)(u.pm * 256 + r) * ld + cbase + wc * 32 + 4 * fq);
#pragma unroll
                for (int bj = 0; bj < 2; ++bj) { const f32x4 x0 = (acc[ai][bj][m][0] + bv[bj][0]) * sc, x1 = (acc[ai][bj][m][1] + bv[bj][1]) * sc;
                    const f32x4 o0 = x0 * cs - x1 * sn, o1 = x1 * cs + x0 * sn;
                    u32x2 w0, w1; w0.x = pg8::cvt_pk_bf16(o0[0], o0[1]); w0.y = pg8::cvt_pk_bf16(o0[2], o0[3]); w1.x = pg8::cvt_pk_bf16(o1[0], o1[1]); w1.y = pg8::cvt_pk_bf16(o1[2], o1[3]);
                    *(GAS u32x2*)(rowp + bj * 128) = w0; *(GAS u32x2*)(rowp + bj * 128 + 16) = w1; } }
    }
};

struct EpiNull {
    static constexpr bool PERM = false;
    __device__ __forceinline__ void operator()(const f32x4 (&acc)[2][2][4][2], const pg8::Unit& u, int wr, int wc, int fr, int fq) const {
#pragma unroll
        for (int ai = 0; ai < 2; ++ai)
#pragma unroll
            for (int bj = 0; bj < 2; ++bj)
#pragma unroll
                for (int m = 0; m < 4; ++m)
#pragma unroll
                    for (int n = 0; n < 2; ++n) asm volatile("" :: "v"(acc[ai][bj][m][n]));
    }
};
template <int MODE> struct EpiProbe {
    static constexpr bool PERM = false;
    unsigned char* ws; float* out; float* scratch;
    __device__ __forceinline__ void operator()(const f32x4 (&acc)[2][2][4][2], const pg8::Unit& u, int wr, int wc, int fr, int fq) const {
        const int b = u.pm / 17, j = u.pm - b * 17;
        const GAS char* pbase = MODE == 1 ? (const GAS char*)(j == 0 ? (float*)(ws + WS_CX) + (size_t)(b * NCTX) * DM : out + (size_t)(b * SEQ + (j - 1) * 256) * DM) : (const GAS char*)(scratch + (size_t)(u.pm & 255) * 256 * DM);
        unsigned lo = (unsigned)(((wr * 64 + fr) * DM + u.pn * 256 + wc * 32 + 4 * fq) * 4); asm volatile("" : "+v"(lo));
#define RES_PTR(ai, m, bj, n) ((GAS f32x4*)(pbase + (size_t)((ai) * 128 + (m) * 16) * DM * 4 + lo + ((bj) * 128 + (n) * 16) * 4))
#pragma unroll
        for (int bj = 0; bj < 2; ++bj)
#pragma unroll
            for (int ai = 0; ai < 2; ++ai) {
                f32x4 o[4][2];
#pragma unroll
                for (int m = 0; m < 4; ++m)
#pragma unroll
                    for (int n = 0; n < 2; ++n) { if (MODE == 1) o[m][n] = *RES_PTR(ai, m, bj, n); else *RES_PTR(ai, m, bj, n) = acc[ai][bj][m][n]; }
                if (MODE == 1) {
#pragma unroll
                    for (int m = 0; m < 4; ++m)
#pragma unroll
                        for (int n = 0; n < 2; ++n) asm volatile("" :: "v"(o[m][n]), "v"(acc[ai][bj][m][n]));
                }
                asm volatile("" ::: "memory");
            }
#undef RES_PTR
    }
};
struct MoeOrder {
    pg8::StaticOrder so; int cs; int pp[9]; int cnt[8]; const int* rlist; size_t bstride; bool GATHER_A;
    __device__ __forceinline__ void locate(int pm, int& e, int& p, int& cn) const { const int gp = cs + pm; e = 0; int pbase = 0; cn = cnt[0];
#pragma unroll
        for (int k = 1; k < 8; ++k) { const bool ge = gp >= pp[k]; e += ge ? 1 : 0; pbase = ge ? pp[k] : pbase; cn = ge ? cnt[k] : cn; }
        p = gp - pbase; }
    __device__ bool next(int i, pg8::Unit& u) const { return so.next(i, u); }
    __device__ __forceinline__ const char* a_base(const pg8::Gemm& g, const pg8::Unit& u) const { return GATHER_A ? (const char*)g.A : (const char*)g.A + (size_t)u.pm * (size_t)(256 * 2) * g.lda; }
    __device__ __forceinline__ const char* b_base(const pg8::Gemm& g, const pg8::Unit& u) const { int e, p, cn; locate(u.pm, e, p, cn); return (const char*)g.Bt + (size_t)e * bstride + (size_t)u.pn * (size_t)(256 * 2) * g.K; }
    __device__ __forceinline__ unsigned row_off(const pg8::Gemm& g, const pg8::Unit& u, int r) const {
        if (!GATHER_A) return (unsigned)r * (unsigned)g.lda * 2u;
        int e, p, cn; locate(u.pm, e, p, cn); const int idx = p * 256 + r; const int tok = idx < cn ? (rlist[(size_t)e * MROWS + idx] >> 1) : 0; return (unsigned)tok * (unsigned)g.lda * 2u; }
};
struct EpiMoeDown {
    static constexpr bool PERM = true;
    MoeOrder mo; bf16_t* EO; const float* GATE;
    __device__ __forceinline__ void operator()(const f32x4 (&acc)[2][2][4][2], const pg8::Unit& u, int wr, int wc, int fr, int fq) const {
        int e, p, cn; mo.locate(u.pm, e, p, cn); const int* rl = mo.rlist + (size_t)e * MROWS + p * 256;
        const int col0 = u.pn * 256 + wc * 32 + 8 * fq;
#pragma unroll
        for (int ai = 0; ai < 2; ++ai)
#pragma unroll
            for (int m = 0; m < 4; ++m) { const int r = ai * 128 + wr * 64 + m * 16 + fr;
                if (p * 256 + r < cn) { const int ent = rl[r]; const float gt = GATE[ent]; bf16_t* dp = EO + (size_t)ent * DM + col0;
#pragma unroll
                    for (int bj = 0; bj < 2; ++bj) { const f32x4 v0 = acc[ai][bj][m][0] * gt, v1 = acc[ai][bj][m][1] * gt; u32x4 w; w.x = pg8::cvt_pk_bf16(v0[0], v0[1]); w.y = pg8::cvt_pk_bf16(v0[2], v0[3]); w.z = pg8::cvt_pk_bf16(v1[0], v1[1]); w.w = pg8::cvt_pk_bf16(v1[2], v1[3]);
                        *(GAS u32x4*)(dp + bj * 128) = w; } } }
    }
};

typedef __bf16 bf16x2_t __attribute__((ext_vector_type(2)));
typedef short v4i16_t __attribute__((ext_vector_type(4)));
__device__ __forceinline__ unsigned cvtpk(float lo, float hi) { f32x2 v = {lo, hi}; bf16x2_t b = __builtin_convertvector(v, bf16x2_t); return __builtin_bit_cast(unsigned, b); }
__device__ __forceinline__ int crow(int r, int hi) { return (r & 3) + 8 * (r >> 2) + 4 * hi; }
__device__ __forceinline__ s16x4 vtr(const LAS unsigned char* p) { return __builtin_bit_cast(s16x4, __builtin_amdgcn_ds_read_tr16_b64_v4i16((LAS v4i16_t*)p)); }
#define MFMA32(a, b, c) __builtin_amdgcn_mfma_f32_32x32x16_bf16((a), (b), (c), 0, 0, 0)
__device__ __forceinline__ void conv_phase(Frame& F, const Args& A, int j) {
    phase_enter(F);
    bf16_t* XBC = (bf16_t*)(F.ws + WS_BIG); const bf16_t* HALO = (const bf16_t*)(F.ws + WS_HALO);
    const int lane = F.lane;
    const int gw = blockIdx.x * NWAVES + F.wave, NGW = F.G * NWAVES;
    for (int task = gw; task < NPAN * 32; task += NGW) {
        const int pm = task >> 5, q = (task >> 3) & 3, sl = task & 7, jj = pm % 17, c0 = sl * 512 + lane * 8;
        const bool top_zero = q == 0 && jj <= 1, bot_zero = q == 3 && (jj == 0 || jj == 16);
        const GAS bf16_t* htop = (const GAS bf16_t*)(HALO + (q == 0 ? ((size_t)(pm - 1) * 16 + 14) : ((size_t)pm * 16 + 4 * q - 2)) * CONVCH + c0);
        const GAS bf16_t* hbot = (const GAS bf16_t*)(HALO + (q == 3 ? ((size_t)(pm + 1) * 16 + 0) : ((size_t)pm * 16 + 4 * q + 4)) * CONVCH + c0);
        f32x2 cw[5][4], cbias[4];
#pragma unroll
        for (int k = 0; k < 5; ++k) { const f32x4 a0 = *(const GAS f32x4*)(A.ssd_conv_w + (size_t)(j * 5 + k) * CONVCH + c0), a1 = *(const GAS f32x4*)(A.ssd_conv_w + (size_t)(j * 5 + k) * CONVCH + c0 + 4);
            cw[k][0] = (f32x2){a0.x, a0.y}; cw[k][1] = (f32x2){a0.z, a0.w}; cw[k][2] = (f32x2){a1.x, a1.y}; cw[k][3] = (f32x2){a1.z, a1.w}; }
        { const f32x4 a0 = *(const GAS f32x4*)(A.ssd_conv_b + (size_t)j * CONVCH + c0), a1 = *(const GAS f32x4*)(A.ssd_conv_b + (size_t)j * CONVCH + c0 + 4);
            cbias[0] = (f32x2){a0.x, a0.y}; cbias[1] = (f32x2){a0.z, a0.w}; cbias[2] = (f32x2){a1.x, a1.y}; cbias[3] = (f32x2){a1.z, a1.w}; }
        GAS bf16_t* base = (GAS bf16_t*)(XBC + ((size_t)pm * 256 + q * 64) * CONVCH + c0);
        const u32x4 zero4 = (u32x4){0u, 0u, 0u, 0u};
        u32x4 win[12], pre[8];
        win[0] = top_zero ? zero4 : *(const GAS u32x4*)(htop);
        win[1] = top_zero ? zero4 : *(const GAS u32x4*)(htop + CONVCH);
#pragma unroll
        for (int r = 0; r < 10; ++r) win[2 + r] = *(const GAS u32x4*)(base + (size_t)r * CONVCH);
        for (int k = 0; k < 8; ++k) {
            if (k < 6) {
#pragma unroll
                for (int r = 0; r < 8; ++r) pre[r] = *(const GAS u32x4*)(base + (size_t)(8 * k + 10 + r) * CONVCH);
            } else if (k == 6) {
#pragma unroll
                for (int r = 0; r < 6; ++r) pre[r] = *(const GAS u32x4*)(base + (size_t)(58 + r) * CONVCH);
                pre[6] = bot_zero ? zero4 : *(const GAS u32x4*)(hbot);
                pre[7] = bot_zero ? zero4 : *(const GAS u32x4*)(hbot + CONVCH);
            }
#pragma unroll
            for (int o = 0; o < 8; ++o) {
                f32x2 r[4];
#pragma unroll
                for (int c = 0; c < 4; ++c) r[c] = cbias[c];
#pragma unroll
                for (int t = 0; t < 5; ++t) { const u32x4 w = win[o + t];
                    r[0] += cw[t][0] * (f32x2){bf_lo(w.x), bf_hi(w.x)}; r[1] += cw[t][1] * (f32x2){bf_lo(w.y), bf_hi(w.y)};
                    r[2] += cw[t][2] * (f32x2){bf_lo(w.z), bf_hi(w.z)}; r[3] += cw[t][3] * (f32x2){bf_lo(w.w), bf_hi(w.w)}; }
                u32x4 w; w.x = cvtpk(siluf(r[0].x), siluf(r[0].y)); w.y = cvtpk(siluf(r[1].x), siluf(r[1].y)); w.z = cvtpk(siluf(r[2].x), siluf(r[2].y)); w.w = cvtpk(siluf(r[3].x), siluf(r[3].y));
                *(GAS u32x4*)(base + (size_t)(8 * k + o) * CONVCH) = w;
            }
#pragma unroll
            for (int r = 0; r < 4; ++r) win[r] = win[8 + r];
#pragma unroll
            for (int r = 0; r < 8; ++r) win[4 + r] = pre[r];
        }
    }
}

constexpr int SC_RS = 272;
constexpr int SC_TILE = 3 * 32 * SC_RS;
constexpr int SC_YS = 2 * SC_TILE;
constexpr int SC_WS = SC_YS + 16384;
constexpr int SC_RAW = 73728;
static_assert(SC_WS + 4096 <= SC_RAW && SC_RAW + 2 * 36 * 1024 <= LDSCTL_OFF, "scan LDS map");
template <int PH>
__device__ __forceinline__ void scan_phase(Frame& F, const Args& A, int j) {
    phase_enter(F);
    const bf16_t* XBC = (const bf16_t*)(F.ws + WS_BIG); const float* DT = (const float*)(F.ws + WS_DT); bf16_t* Y = (bf16_t*)(F.ws + WS_Y);
    const int lane = F.lane, wave = F.wave;
    for (int u0 = blockIdx.x; u0 < 256; u0 += F.G) {
        const int unit = (F.G == 256) ? ((u0 & 7) * 32 + (u0 >> 3)) : u0;
        const int b = unit >> 4, g = (unit >> 1) & 7, ph = unit & 1;
        const int srow = F.tid >> 4, sch = F.tid & 15;
        const int gcolB = 2048 + g * 128 + sch * 8, gcolC = 3072 + g * 128 + sch * 8, gcolX = g * 256 + (sch >> 2) * 64 + ph * 32 + (sch & 3) * 8;
        const int hh = wave >> 1, dir = wave & 1, c31 = lane & 31, hl = lane >> 5;
        const int trq = (lane & 15) >> 2, trp = lane & 3, trb = (lane >> 4) & 1;
        const int head = g * 4 + hh;
        const float Dk = A.ssd_d[(j * 2 + dir) * 32 + head], dtb = A.ssd_dt_bias[(j * 2 + dir) * 32 + head], aneg = -expf(A.ssd_a_log[(j * 2 + dir) * 32 + head]);
        LAS float* wsf = (LAS float*)(F.lds + SC_WS + wave * 512);
        int offRow = dir * SC_TILE + c31 * SC_RS + 16 * hl;
        int offC4 = dir * SC_TILE + 32 * SC_RS + c31 * SC_RS + 8 * hl;
        int offTrX = dir * SC_TILE + 64 * SC_RS + trq * SC_RS + (hh * 32 + 16 * trb + 4 * trp) * 2;
        int offTrB = dir * SC_TILE + trq * SC_RS + (16 * trb + 4 * trp) * 2;
        int ysoff = (4 * hl) * 128 + hh * 32 + c31;
        asm volatile("" : "+v"(offRow), "+v"(offC4), "+v"(offTrX), "+v"(offTrB), "+v"(ysoff));
        f32x16 ST[4];
#pragma unroll
        for (int t = 0; t < 4; ++t)
#pragma unroll
            for (int e = 0; e < 16; ++e) ST[t][e] = 0.f;
#define SC_PF(pf, st_) do { const int st = (PH >= 2) ? 0 : (st_); const int cf_ = (st), cb_ = (st) < 8 ? 7 - (st) : 143 - (st); \
            _Pragma("unroll") for (int T = 0; T < 2; ++T) { const GAS bf16_t* rp = (const GAS bf16_t*)(XBC + (size_t)(b * SROW + (T ? cb_ : cf_) * 32 + srow) * CONVCH); \
                pf[T][0] = *(const GAS u32x4*)(rp + gcolB); pf[T][1] = *(const GAS u32x4*)(rp + gcolC); pf[T][2] = *(const GAS u32x4*)(rp + gcolX); } } while (0)
#define SC_DTLOAD(st) DT[(size_t)(b * SROW + (dir ? ((st) < 8 ? 7 - (st) : 143 - (st)) : (st)) * 32 + c31) * 64 + dir * 32 + head]
#define SC_WRITEOUT(st) do { const int cf_ = (st), cb_ = (st) < 8 ? 7 - (st) : 143 - (st); \
            _Pragma("unroll") for (int T = 0; T < 2; ++T) { const int tok = F.tid >> 4, h4 = (F.tid >> 2) & 3, q4 = F.tid & 3, chunk = T ? cb_ : cf_; \
                const int other = T == 0 ? (chunk < 8 ? 7 - chunk : 143 - chunk) : chunk; \
                u32x4 v = *(const LAS u32x4*)(F.lds + SC_YS + T * 8192 + (tok * 128 + h4 * 32 + q4 * 8) * 2); \
                bf16_t* yp = Y + (size_t)(b * SROW + chunk * 32 + tok) * DIN + g * 256 + ph * 128 + h4 * 32 + q4 * 8; \
                if ((st) > other) { const u32x4 o = oldy[T]; \
                    v.x = pk2(bf_lo(o.x) + bf_lo(v.x), bf_hi(o.x) + bf_hi(v.x)); v.y = pk2(bf_lo(o.y) + bf_lo(v.y), bf_hi(o.y) + bf_hi(v.y)); \
                    v.z = pk2(bf_lo(o.z) + bf_lo(v.z), bf_hi(o.z) + bf_hi(v.z)); v.w = pk2(bf_lo(o.w) + bf_lo(v.w), bf_hi(o.w) + bf_hi(v.w)); } \
                if (PH == 0) *(u32x4*)yp = v; else asm volatile("" :: "v"(v)); } } while (0)
        u32x4 pfE[2][3], pfO[2][3];
        SC_PF(pfE, 0); SC_PF(pfO, 1);
        float dtraw = SC_DTLOAD(0);
        u32x4 oldy[2] = {(u32x4){0u, 0u, 0u, 0u}, (u32x4){0u, 0u, 0u, 0u}};
        for (int step2 = 0; step2 < 136; step2 += 2) {
          { const int step = step2;
            const int cf = step, cbk = step < 8 ? 7 - step : 143 - step;
            __syncthreads();
            if (step > 0) SC_WRITEOUT(step - 1);
#pragma unroll
            for (int T = 0; T < 2; ++T)
#pragma unroll
                for (int a = 0; a < 3; ++a) *(LAS u32x4*)(F.lds + T * SC_TILE + a * (32 * SC_RS) + srow * SC_RS + sch * 16) = pfE[T][a];
            {
                const float xb = dtraw + dtb;
                const float dt = xb > 20.f ? xb : log1pf(__expf(xb)); const float dA = dt * aneg;
                float v = dA;
                v += __builtin_bit_cast(float, __builtin_amdgcn_update_dpp(0, __builtin_bit_cast(int, v), 0x111, 0xf, 0xf, true));
                v += __builtin_bit_cast(float, __builtin_amdgcn_update_dpp(0, __builtin_bit_cast(int, v), 0x112, 0xf, 0xf, true));
                v += __builtin_bit_cast(float, __builtin_amdgcn_update_dpp(0, __builtin_bit_cast(int, v), 0x114, 0xf, 0xf, true));
                v += __builtin_bit_cast(float, __builtin_amdgcn_update_dpp(0, __builtin_bit_cast(int, v), 0x118, 0xf, 0xf, true));
                v += __builtin_bit_cast(float, __builtin_amdgcn_update_dpp(0, __builtin_bit_cast(int, v), 0x142, 0xa, 0xf, false));
                const float tot = __builtin_bit_cast(float, __builtin_amdgcn_readlane(__builtin_bit_cast(int, v), 31));
                const float cum = dir ? (tot - v + dA) : v;
                if (hl == 0) { wsf[c31] = cum; wsf[32 + c31] = dt; wsf[64 + c31] = __expf(tot - cum) * dt; wsf[96 + c31] = __expf(cum); }
            }
            asm volatile("s_waitcnt lgkmcnt(0)" ::: "memory"); __builtin_amdgcn_s_barrier(); asm volatile("" ::: "memory");
            if (step + 2 < 136) SC_PF(pfE, step + 2); if (step + 1 < 136) dtraw = SC_DTLOAD(step + 1);
#pragma unroll
            for (int T = 0; T < 2; ++T) {
                const int tok = F.tid >> 4, h4 = (F.tid >> 2) & 3, q4 = F.tid & 3, chunk = T ? cbk : cf;
                const int other = T == 0 ? (chunk < 8 ? 7 - chunk : 143 - chunk) : chunk;
                if (PH == 0 && step > other) oldy[T] = *(const u32x4*)(Y + (size_t)(b * SROW + chunk * 32 + tok) * DIN + g * 256 + ph * 128 + h4 * 32 + q4 * 8);
            }
            if (PH < 3) {
                const LAS unsigned char* Bs = F.lds + dir * SC_TILE; const LAS unsigned char* Cs = Bs + 32 * SC_RS; const LAS unsigned char* xs = Bs + 64 * SC_RS;
                f32x16 gt;
#pragma unroll
                for (int e = 0; e < 16; ++e) gt[e] = 0.f;
#pragma unroll
                for (int s = 0; s < 8; ++s) { const bf16x8 a = *(const LAS bf16x8*)(F.lds + offRow + 32 * s), bb = *(const LAS bf16x8*)(F.lds + offRow + 32 * SC_RS + 32 * s); gt = MFMA32(a, bb, gt); }
                const float cum_i = wsf[c31];
                bf16x8 mk[2];
                {
                    float mv[16];
#pragma unroll
                    for (int q = 0; q < 4; ++q) { const f32x4 cj = *(const LAS f32x4*)(wsf + 8 * q + 4 * hl), dj = *(const LAS f32x4*)(wsf + 32 + 8 * q + 4 * hl);
#pragma unroll
                        for (int z = 0; z < 4; ++z) { const int jj = 8 * q + 4 * hl + z; const bool ok = dir ? (jj >= c31) : (jj <= c31);
                            float val = gt[4 * q + z] * __expf(ok ? (cum_i - cj[z]) : -INFINITY) * dj[z]; if (jj == c31) val += Dk; mv[4 * q + z] = val; } }
#pragma unroll
                    for (int s2 = 0; s2 < 2; ++s2) { u32x4 w; w.x = cvtpk(mv[8 * s2], mv[8 * s2 + 1]); w.y = cvtpk(mv[8 * s2 + 2], mv[8 * s2 + 3]); w.z = cvtpk(mv[8 * s2 + 4], mv[8 * s2 + 5]); w.w = cvtpk(mv[8 * s2 + 6], mv[8 * s2 + 7]); mk[s2] = __builtin_bit_cast(bf16x8, w); }
                }
                f32x16 ya;
#pragma unroll
                for (int e = 0; e < 16; ++e) ya[e] = 0.f;
#pragma unroll
                for (int t = 0; t < 4; ++t)
#pragma unroll
                    for (int s2 = 0; s2 < 2; ++s2) {
                        const LAS unsigned char* cp = F.lds + offC4 + 64 * t + 32 * s2;
                        const u32x2 c0 = *(const LAS u32x2*)cp, c1 = *(const LAS u32x2*)(cp + 16);
                        const bf16x8 ca = __builtin_bit_cast(bf16x8, (u32x4){c0.x, c0.y, c1.x, c1.y});
                        u32x4 w; w.x = cvtpk(ST[t][8 * s2], ST[t][8 * s2 + 1]); w.y = cvtpk(ST[t][8 * s2 + 2], ST[t][8 * s2 + 3]); w.z = cvtpk(ST[t][8 * s2 + 4], ST[t][8 * s2 + 5]); w.w = cvtpk(ST[t][8 * s2 + 6], ST[t][8 * s2 + 7]);
                        ya = MFMA32(ca, __builtin_bit_cast(bf16x8, w), ya);
                    }
#pragma unroll
                for (int q = 0; q < 4; ++q) { const f32x4 ec = *(const LAS f32x4*)(wsf + 96 + 8 * q + 4 * hl); ya[4 * q] *= ec.x; ya[4 * q + 1] *= ec.y; ya[4 * q + 2] *= ec.z; ya[4 * q + 3] *= ec.w; }
#pragma unroll
                for (int s2 = 0; s2 < 2; ++s2) {
                    const LAS unsigned char* xp = F.lds + offTrX + (16 * s2) * SC_RS + hl * (4 * SC_RS);
                    const s16x4 lo = vtr(xp), hi = vtr(xp + 8 * SC_RS);
                    ya = MFMA32(mk[s2], ((bf16x8){lo[0], lo[1], lo[2], lo[3], hi[0], hi[1], hi[2], hi[3]}), ya);
                }
                {
                    const float etot = dir ? wsf[96] : wsf[96 + 31];
#pragma unroll
                    for (int t = 0; t < 4; ++t)
#pragma unroll
                        for (int e = 0; e < 16; ++e) ST[t][e] *= etot;
#pragma unroll
                    for (int s2 = 0; s2 < 2; ++s2) {
                        const LAS unsigned char* xp = F.lds + offTrX + (16 * s2) * SC_RS + hl * (8 * SC_RS);
                        const s16x4 lo = vtr(xp), hi = vtr(xp + 4 * SC_RS);
                        const f32x4 w0 = *(const LAS f32x4*)(wsf + 64 + 16 * s2 + 8 * hl), w1 = *(const LAS f32x4*)(wsf + 64 + 16 * s2 + 8 * hl + 4);
                        u32x4 xw; xw.x = cvtpk(bf1((bf16_t)lo[0]) * w0.x, bf1((bf16_t)lo[1]) * w0.y); xw.y = cvtpk(bf1((bf16_t)lo[2]) * w0.z, bf1((bf16_t)lo[3]) * w0.w);
                        xw.z = cvtpk(bf1((bf16_t)hi[0]) * w1.x, bf1((bf16_t)hi[1]) * w1.y); xw.w = cvtpk(bf1((bf16_t)hi[2]) * w1.z, bf1((bf16_t)hi[3]) * w1.w);
                        const bf16x8 xb8 = __builtin_bit_cast(bf16x8, xw);
#pragma unroll
                        for (int t = 0; t < 4; ++t) {
                            const LAS unsigned char* bp = F.lds + offTrB + (16 * s2) * SC_RS + hl * (8 * SC_RS) + 64 * t;
                            const s16x4 blo = vtr(bp), bhi = vtr(bp + 4 * SC_RS);
                            ST[t] = MFMA32(((bf16x8){blo[0], blo[1], blo[2], blo[3], bhi[0], bhi[1], bhi[2], bhi[3]}), xb8, ST[t]);
                        }
                    }
                }
                LAS bf16_t* ys = (LAS bf16_t*)(F.lds + SC_YS + dir * 8192) + ysoff;
#pragma unroll
                for (int e = 0; e < 16; e += 2) { const unsigned w = cvtpk(ya[e], ya[e + 1]); ys[((e & 3) + 8 * (e >> 2)) * 128] = (bf16_t)w; ys[((e & 3) + 1 + 8 * (e >> 2)) * 128] = (bf16_t)(w >> 16); }
            }
                  }
          { const int step = step2 + 1;
            const int cf = step, cbk = step < 8 ? 7 - step : 143 - step;
            __syncthreads();
            if (step > 0) SC_WRITEOUT(step - 1);
#pragma unroll
            for (int T = 0; T < 2; ++T)
#pragma unroll
                for (int a = 0; a < 3; ++a) *(LAS u32x4*)(F.lds + T * SC_TILE + a * (32 * SC_RS) + srow * SC_RS + sch * 16) = pfO[T][a];
            {
                const float xb = dtraw + dtb;
                const float dt = xb > 20.f ? xb : log1pf(__expf(xb)); const float dA = dt * aneg;
                float v = dA;
                v += __builtin_bit_cast(float, __builtin_amdgcn_update_dpp(0, __builtin_bit_cast(int, v), 0x111, 0xf, 0xf, true));
                v += __builtin_bit_cast(float, __builtin_amdgcn_update_dpp(0, __builtin_bit_cast(int, v), 0x112, 0xf, 0xf, true));
                v += __builtin_bit_cast(float, __builtin_amdgcn_update_dpp(0, __builtin_bit_cast(int, v), 0x114, 0xf, 0xf, true));
                v += __builtin_bit_cast(float, __builtin_amdgcn_update_dpp(0, __builtin_bit_cast(int, v), 0x118, 0xf, 0xf, true));
                v += __builtin_bit_cast(float, __builtin_amdgcn_update_dpp(0, __builtin_bit_cast(int, v), 0x142, 0xa, 0xf, false));
                const float tot = __builtin_bit_cast(float, __builtin_amdgcn_readlane(__builtin_bit_cast(int, v), 31));
                const float cum = dir ? (tot - v + dA) : v;
                if (hl == 0) { wsf[c31] = cum; wsf[32 + c31] = dt; wsf[64 + c31] = __expf(tot - cum) * dt; wsf[96 + c31] = __expf(cum); }
            }
            asm volatile("s_waitcnt lgkmcnt(0)" ::: "memory"); __builtin_amdgcn_s_barrier(); asm volatile("" ::: "memory");
            if (step + 2 < 136) SC_PF(pfO, step + 2); if (step + 1 < 136) dtraw = SC_DTLOAD(step + 1);
#pragma unroll
            for (int T = 0; T < 2; ++T) {
                const int tok = F.tid >> 4, h4 = (F.tid >> 2) & 3, q4 = F.tid & 3, chunk = T ? cbk : cf;
                const int other = T == 0 ? (chunk < 8 ? 7 - chunk : 143 - chunk) : chunk;
                if (PH == 0 && step > other) oldy[T] = *(const u32x4*)(Y + (size_t)(b * SROW + chunk * 32 + tok) * DIN + g * 256 + ph * 128 + h4 * 32 + q4 * 8);
            }
            if (PH < 3) {
                const LAS unsigned char* Bs = F.lds + dir * SC_TILE; const LAS unsigned char* Cs = Bs + 32 * SC_RS; const LAS unsigned char* xs = Bs + 64 * SC_RS;
                f32x16 gt;
#pragma unroll
                for (int e = 0; e < 16; ++e) gt[e] = 0.f;
#pragma unroll
                for (int s = 0; s < 8; ++s) { const bf16x8 a = *(const LAS bf16x8*)(F.lds + offRow + 32 * s), bb = *(const LAS bf16x8*)(F.lds + offRow + 32 * SC_RS + 32 * s); gt = MFMA32(a, bb, gt); }
                const float cum_i = wsf[c31];
                bf16x8 mk[2];
                {
                    float mv[16];
#pragma unroll
                    for (int q = 0; q < 4; ++q) { const f32x4 cj = *(const LAS f32x4*)(wsf + 8 * q + 4 * hl), dj = *(const LAS f32x4*)(wsf + 32 + 8 * q + 4 * hl);
#pragma unroll
                        for (int z = 0; z < 4; ++z) { const int jj = 8 * q + 4 * hl + z; const bool ok = dir ? (jj >= c31) : (jj <= c31);
                            float val = gt[4 * q + z] * __expf(ok ? (cum_i - cj[z]) : -INFINITY) * dj[z]; if (jj == c31) val += Dk; mv[4 * q + z] = val; } }
#pragma unroll
                    for (int s2 = 0; s2 < 2; ++s2) { u32x4 w; w.x = cvtpk(mv[8 * s2], mv[8 * s2 + 1]); w.y = cvtpk(mv[8 * s2 + 2], mv[8 * s2 + 3]); w.z = cvtpk(mv[8 * s2 + 4], mv[8 * s2 + 5]); w.w = cvtpk(mv[8 * s2 + 6], mv[8 * s2 + 7]); mk[s2] = __builtin_bit_cast(bf16x8, w); }
                }
                f32x16 ya;
#pragma unroll
                for (int e = 0; e < 16; ++e) ya[e] = 0.f;
#pragma unroll
                for (int t = 0; t < 4; ++t)
#pragma unroll
                    for (int s2 = 0; s2 < 2; ++s2) {
                        const LAS unsigned char* cp = F.lds + offC4 + 64 * t + 32 * s2;
                        const u32x2 c0 = *(const LAS u32x2*)cp, c1 = *(const LAS u32x2*)(cp + 16);
                        const bf16x8 ca = __builtin_bit_cast(bf16x8, (u32x4){c0.x, c0.y, c1.x, c1.y});
                        u32x4 w; w.x = cvtpk(ST[t][8 * s2], ST[t][8 * s2 + 1]); w.y = cvtpk(ST[t][8 * s2 + 2], ST[t][8 * s2 + 3]); w.z = cvtpk(ST[t][8 * s2 + 4], ST[t][8 * s2 + 5]); w.w = cvtpk(ST[t][8 * s2 + 6], ST[t][8 * s2 + 7]);
                        ya = MFMA32(ca, __builtin_bit_cast(bf16x8, w), ya);
                    }
#pragma unroll
                for (int q = 0; q < 4; ++q) { const f32x4 ec = *(const LAS f32x4*)(wsf + 96 + 8 * q + 4 * hl); ya[4 * q] *= ec.x; ya[4 * q + 1] *= ec.y; ya[4 * q + 2] *= ec.z; ya[4 * q + 3] *= ec.w; }
#pragma unroll
                for (int s2 = 0; s2 < 2; ++s2) {
                    const LAS unsigned char* xp = F.lds + offTrX + (16 * s2) * SC_RS + hl * (4 * SC_RS);
                    const s16x4 lo = vtr(xp), hi = vtr(xp + 8 * SC_RS);
                    ya = MFMA32(mk[s2], ((bf16x8){lo[0], lo[1], lo[2], lo[3], hi[0], hi[1], hi[2], hi[3]}), ya);
                }
                {
                    const float etot = dir ? wsf[96] : wsf[96 + 31];
#pragma unroll
                    for (int t = 0; t < 4; ++t)
#pragma unroll
                        for (int e = 0; e < 16; ++e) ST[t][e] *= etot;
#pragma unroll
                    for (int s2 = 0; s2 < 2; ++s2) {
                        const LAS unsigned char* xp = F.lds + offTrX + (16 * s2) * SC_RS + hl * (8 * SC_RS);
                        const s16x4 lo = vtr(xp), hi = vtr(xp + 4 * SC_RS);
                        const f32x4 w0 = *(const LAS f32x4*)(wsf + 64 + 16 * s2 + 8 * hl), w1 = *(const LAS f32x4*)(wsf + 64 + 16 * s2 + 8 * hl + 4);
                        u32x4 xw; xw.x = cvtpk(bf1((bf16_t)lo[0]) * w0.x, bf1((bf16_t)lo[1]) * w0.y); xw.y = cvtpk(bf1((bf16_t)lo[2]) * w0.z, bf1((bf16_t)lo[3]) * w0.w);
                        xw.z = cvtpk(bf1((bf16_t)hi[0]) * w1.x, bf1((bf16_t)hi[1]) * w1.y); xw.w = cvtpk(bf1((bf16_t)hi[2]) * w1.z, bf1((bf16_t)hi[3]) * w1.w);
                        const bf16x8 xb8 = __builtin_bit_cast(bf16x8, xw);
#pragma unroll
                        for (int t = 0; t < 4; ++t) {
                            const LAS unsigned char* bp = F.lds + offTrB + (16 * s2) * SC_RS + hl * (8 * SC_RS) + 64 * t;
                            const s16x4 blo = vtr(bp), bhi = vtr(bp + 4 * SC_RS);
                            ST[t] = MFMA32(((bf16x8){blo[0], blo[1], blo[2], blo[3], bhi[0], bhi[1], bhi[2], bhi[3]}), xb8, ST[t]);
                        }
                    }
                }
                LAS bf16_t* ys = (LAS bf16_t*)(F.lds + SC_YS + dir * 8192) + ysoff;
#pragma unroll
                for (int e = 0; e < 16; e += 2) { const unsigned w = cvtpk(ya[e], ya[e + 1]); ys[((e & 3) + 8 * (e >> 2)) * 128] = (bf16_t)w; ys[((e & 3) + 1 + 8 * (e >> 2)) * 128] = (bf16_t)(w >> 16); }
            }
                  }
        }
        VM_WAIT(); __syncthreads();
        SC_WRITEOUT(135);
#undef SC_PF
#undef SC_DTLOAD
#undef SC_WRITEOUT
        __syncthreads();
    }
}

__device__ __forceinline__ void attn_phase(Frame& F, const Args& A, int ja, bool need_ctx, int nwg) {
    phase_enter(F);
    const bf16_t* Q = (const bf16_t*)(F.ws + WS_BIG); bf16_t* O = (bf16_t*)(F.ws + WS_H);     const bf16_t* Kb = (const bf16_t*)(F.ws + WS_BIG + BIG_K); const bf16_t* Vb = (const bf16_t*)(F.ws + WS_BIG + BIG_V);
    LAS unsigned char* Kl = F.lds; LAS unsigned char* Vl = F.lds + 9216;
    const int nunits = 2048 + (need_ctx ? 128 : 0);
    const int lane = F.lane, r = F.wave >> 1, rh = F.wave & 1, c31 = lane & 31, hl = lane >> 5;
    const int prow = F.tid >> 3, ppc = F.tid & 7;
    const int trq = (lane & 15) >> 2, trp = lane & 3, trb = (lane >> 4) & 1;
    for (int unit = blockIdx.x; unit < nunits; unit += nwg) {
        int b, g, nblk; bool cq;
        if (unit < 2048) { b = unit >> 7; nblk = (unit >> 2) & 31; g = unit & 3; cq = false; } else { const int u2 = unit - 2048; b = u2 >> 3; nblk = (u2 >> 2) & 1; g = u2 & 3; cq = true; }
        const int qrow0 = b * SROW + (cq ? 128 * nblk : NCTX + 128 * nblk);
        const int start = 128 * nblk;
        bf16x8 qf[2][4];
#pragma unroll
        for (int qb = 0; qb < 2; ++qb)
#pragma unroll
            for (int s = 0; s < 4; ++s) qf[qb][s] = *(const bf16x8*)(Q + (size_t)(qrow0 + 64 * rh + 32 * qb + c31) * QW + g * 256 + r * 64 + 16 * s + 8 * hl);
        const float sink = A.attn_sink[ja * 16 + g * 4 + r] * 1.4426950408889634f;
        float mrun[2] = {sink, sink}, lrun[2] = {1.f, 1.f};
        f32x16 ot[2][2];
#pragma unroll
        for (int db = 0; db < 2; ++db)
#pragma unroll
            for (int qb = 0; qb < 2; ++qb)
#pragma unroll
                for (int e = 0; e < 16; ++e) ot[db][qb][e] = 0.f;
        const int tt_lo = cq ? 0 : (nblk == 0 ? 2 : 0), tt_hi = cq ? 0 : (nblk == 31 ? 4 : 6);
        const int ntile = 4 + (tt_hi - tt_lo);
#define TILE_ROW0(t) ((t) < 4 ? b * SROW + 64 * (t) : b * SROW + NCTX + start - 128 + 64 * (tt_lo + (t) - 4))
        u32x4 kreg, vreg;
        { const int r0 = TILE_ROW0(0); kreg = *(const u32x4*)(Kb + (size_t)(r0 + prow) * KVW + g * 64 + ppc * 8); vreg = *(const u32x4*)(Vb + (size_t)(r0 + prow) * KVW + g * 64 + ppc * 8); }
        for (int t = 0; t < ntile; ++t) {
            __syncthreads();
            *(LAS u32x4*)(Kl + prow * 144 + ppc * 16) = kreg; *(LAS u32x4*)(Vl + prow * 144 + ppc * 16) = vreg;
            __syncthreads();
            if (t + 1 < ntile) { const int r0 = TILE_ROW0(t + 1); kreg = *(const u32x4*)(Kb + (size_t)(r0 + prow) * KVW + g * 64 + ppc * 8); vreg = *(const u32x4*)(Vb + (size_t)(r0 + prow) * KVW + g * 64 + ppc * 8); }
            const int dk0 = (t >= 4) ? (-128 + 64 * (tt_lo + t - 4)) - 64 * rh : 0;
            const bool tile_empty = (t >= 4) && (dk0 <= -192 || dk0 >= 192);
            const bool tile_mask = (t >= 4) && !tile_empty && (dk0 < -65 || dk0 > 65);
            if (!tile_empty) {
            f32x16 st[2][2];
#pragma unroll
            for (int kb = 0; kb < 2; ++kb) {
#pragma unroll
                for (int qb = 0; qb < 2; ++qb)
#pragma unroll
                    for (int e = 0; e < 16; ++e) st[kb][qb][e] = 0.f;
#pragma unroll
                for (int s = 0; s < 4; ++s) { const bf16x8 a = *(const LAS bf16x8*)(Kl + (32 * kb + c31) * 144 + (16 * s + 8 * hl) * 2);
                    st[kb][0] = MFMA32(a, qf[0][s], st[kb][0]); st[kb][1] = MFMA32(a, qf[1][s], st[kb][1]); }
            }
            if (tile_mask) { const int kpos0 = start - 128 + 64 * (tt_lo + t - 4);
#pragma unroll
                for (int kb = 0; kb < 2; ++kb)
#pragma unroll
                    for (int qb = 0; qb < 2; ++qb) { const int qpos = start + 64 * rh + 32 * qb + c31;
#pragma unroll
                        for (int e = 0; e < 16; ++e) { const int d = qpos - (kpos0 + 32 * kb + crow(e, hl)); if (d > 128 || d < -128) st[kb][qb][e] = -INFINITY; } }
            }
#pragma unroll
            for (int qb = 0; qb < 2; ++qb) {
                float mx = st[0][qb][0];
#pragma unroll
                for (int kb = 0; kb < 2; ++kb)
#pragma unroll
                    for (int e = 0; e < 16; ++e) mx = fmaxf(mx, st[kb][qb][e]);
                mx = fmaxf(mx, shx(mx, 32, lane));
                const float mn = fmaxf(mrun[qb], mx);
                const bool grew = mn > mrun[qb];
                float rs = 0.f;
#pragma unroll
                for (int kb = 0; kb < 2; ++kb)
#pragma unroll
                    for (int e = 0; e < 16; ++e) { const float pv = __builtin_amdgcn_exp2f(st[kb][qb][e] - mn); st[kb][qb][e] = pv; rs += pv; }
                rs += shx(rs, 32, lane);
                if (__any(grew)) {
                    const float alpha = __builtin_amdgcn_exp2f(mrun[qb] - mn);
                    lrun[qb] = lrun[qb] * alpha + rs;
#pragma unroll
                    for (int db = 0; db < 2; ++db)
#pragma unroll
                        for (int e = 0; e < 16; ++e) ot[db][qb][e] *= alpha;
                } else lrun[qb] += rs;
                mrun[qb] = mn;
            }
#pragma unroll
            for (int kb = 0; kb < 2; ++kb)
#pragma unroll
                for (int s2 = 0; s2 < 2; ++s2) {
                    bf16x8 pk[2];
#pragma unroll
                    for (int qb = 0; qb < 2; ++qb) { u32x4 w; w.x = cvtpk(st[kb][qb][8 * s2 + 0], st[kb][qb][8 * s2 + 1]); w.y = cvtpk(st[kb][qb][8 * s2 + 2], st[kb][qb][8 * s2 + 3]);
                        w.z = cvtpk(st[kb][qb][8 * s2 + 4], st[kb][qb][8 * s2 + 5]); w.w = cvtpk(st[kb][qb][8 * s2 + 6], st[kb][qb][8 * s2 + 7]); pk[qb] = __builtin_bit_cast(bf16x8, w); }
#pragma unroll
                    for (int db = 0; db < 2; ++db) {
                        const LAS unsigned char* vp = Vl + (32 * kb + 16 * s2 + 4 * hl + trq) * 144 + (32 * db + 16 * trb + 4 * trp) * 2;
                        const s16x4 lo = vtr(vp), hi = vtr(vp + 8 * 144);
                        const bf16x8 va = (bf16x8){lo[0], lo[1], lo[2], lo[3], hi[0], hi[1], hi[2], hi[3]};
                        ot[db][0] = MFMA32(va, pk[0], ot[db][0]); ot[db][1] = MFMA32(va, pk[1], ot[db][1]);
                    }
                }
            }
        }
#undef TILE_ROW0
#pragma unroll
        for (int qb = 0; qb < 2; ++qb) { const float inv = 1.0f / lrun[qb]; bf16_t* op = O + (size_t)(qrow0 + 64 * rh + 32 * qb + c31) * QW + g * 256 + r * 64;
#pragma unroll
            for (int db = 0; db < 2; ++db)
#pragma unroll
                for (int gq = 0; gq < 4; ++gq) { u32x2 w; w.x = cvtpk(ot[db][qb][4 * gq] * inv, ot[db][qb][4 * gq + 1] * inv); w.y = cvtpk(ot[db][qb][4 * gq + 2] * inv, ot[db][qb][4 * gq + 3] * inv);
                    *(u32x2*)(op + 32 * db + 8 * gq + 4 * hl) = w; } }
    }
    __syncthreads();
}


#ifndef PHMASK
#define PHMASK 0xFFFF
#endif
#define PHON(k) (((PHMASK) >> (k)) & 1)
#ifndef REPMASK
#define REPMASK 0x0
#endif
#define REP(k) (((REPMASK) >> (k)) & 1)
#ifndef MK_PER_PHASE
#define MK_PER_PHASE 0
#endif
#ifndef TIMER_LO
#define TIMER_LO 999
#define TIMER_HI 999
#endif
#define TIMER_ON (TIMER_LO < 999)
#define IN(k) (lo <= (k) && (k) < hi)
#define SEAM(k) do { if (IN(k) && IN((k) + 1)) { xcd_barrier(bar); } if (TIMER_ON) { const unsigned long long now_ = __builtin_amdgcn_s_memrealtime(); if ((k) >= TIMER_LO && (k) <= TIMER_HI) TM.acc += now_ - TM.prev; TM.prev = now_; } } while (0)
#define SITE_PTRS phase_enter(F); unsigned char* ws = F.ws; bf16_t* H = (bf16_t*)(ws + WS_H); bf16_t* BIG = (bf16_t*)(ws + WS_BIG); const float* MODV = (const float*)(ws + WS_MODV); (void)H; (void)BIG; (void)MODV; \
        unsigned char* wss = ws + WS_W + (size_t)lp * W_SSD_STRIDE; unsigned char* wsa = ws + WS_W + W_ATT0 + (size_t)lp * W_ATT_STRIDE; (void)wss; (void)wsa;
struct Timer { unsigned long long prev, acc; };
template <int lp, int c> __device__ __forceinline__ void moe_chunk(Frame& F, const Args& A, const int lo, const int hi, const XcdBarrier& bar, LAS unsigned char* ring, Timer& TM) {
    constexpr int pb = 1 + lp * 20;
            const int pu = pb + 14 + 2 * c, pd = pu + 1;
            if (IN(pu) || IN(pd)) {
                SITE_PTRS
                MoeOrder mo;
                mo.pp[0] = 0;
#pragma unroll
                for (int e = 0; e < 8; ++e) { const int cn = __builtin_amdgcn_readfirstlane((int)__hip_atomic_load((unsigned*)(F.ctl + CW_CNT + (size_t)(lp * 8 + e) * 64), RLX_AGENT)); mo.cnt[e] = cn; mo.pp[e + 1] = mo.pp[e] + ((cn + 255) >> 8); }
                const int Ptot = mo.pp[8]; int nP = Ptot - c * MOE_CHUNK; nP = nP < 0 ? 0 : (nP > MOE_CHUNK ? MOE_CHUNK : nP);
                mo.cs = c * MOE_CHUNK; mo.rlist = (const int*)(ws + WS_RLIST);
                if (PHON(10) && IN(pu)) { mo.so.init(nP, 2 * DFFE / 256, F.G, (int)blockIdx.x); mo.GATHER_A = true; mo.bstride = (size_t)2 * DFFE * 1024 * 2;
                    pg8::Gemm g{H, (const bf16_t*)(ws + WS_BIG + BIG_MW13), 1024, 1024}; EpiSwiglu E{BIG, DFFE}; pg8::gemm_phase<EpiSwiglu, MoeOrder, true, true>(ring, g, mo, E, F.wave0); }
                SEAM(pu);
                if (PHON(11) && IN(pd)) { mo.so.init(nP, 4, F.G, (int)blockIdx.x); mo.GATHER_A = false; mo.bstride = (size_t)1024 * DFFE * 2;
                    pg8::Gemm g{BIG, (const bf16_t*)(ws + WS_BIG + BIG_MW2), DFFE, DFFE}; EpiMoeDown E{mo, (bf16_t*)(ws + WS_Y), (const float*)(ws + WS_GATE)}; pg8::gemm_phase<EpiMoeDown, MoeOrder, true, false>(ring, g, mo, E, F.wave0); }
            }
            SEAM(pd);
        }
template <int lp> __device__ __forceinline__ void layer_pair(Frame& F, const Args& A, const int lo, const int hi, const XcdBarrier& bar, LAS unsigned char* ring, Timer& TM) {
        const int pb = 1 + lp * 20, i0 = 2 * lp, i1 = 2 * lp + 1;
        if (PHON(1) && IN(pb + 0)) norm_phase(F, A, i0, 0, lp == 0 ? 1 : 2);
        SEAM(pb + 0);
        if (PHON(2) && IN(pb + 1)) { SITE_PTRS pg8::Gemm g{H, (const bf16_t*)(wss + W_WIN), 1024, 1024}; pg8::StaticOrder S; S.init(NPAN, NXBC / 256, F.G, (int)blockIdx.x);
            EpiXbc E{BIG, (float*)(ws + WS_DT), (bf16_t*)(ws + WS_HALO)}; pg8::gemm_phase<EpiXbc, pg8::StaticOrder, true, false>(ring, g, S, E, F.wave0); }
        SEAM(pb + 1);
        if (PHON(3) && IN(pb + 2)) conv_phase(F, A, lp);
        SEAM(pb + 2);
        if (PHON(3) && IN(pb + 3)) scan_phase<0>(F, A, lp);
        SEAM(pb + 3);
        if (PHON(4) && IN(pb + 4)) { SITE_PTRS pg8::Gemm g{H, (const bf16_t*)(wss + W_WZ), 1024, 1024}; pg8::StaticOrder S; S.init(NPAN, DIN / 256, F.G, (int)blockIdx.x);
            EpiGate E{(const bf16_t*)(ws + WS_Y), BIG, A.ssd_norm_w + (size_t)lp * DIN, (LAS float*)(F.lds + PSCR_OFF)}; pg8::gemm_phase<EpiGate, pg8::StaticOrder, true, false>(ring, g, S, E, F.wave0); }
        SEAM(pb + 4);
        if (PHON(5) && IN(pb + 5)) { SITE_PTRS pg8::Gemm g{BIG, (const bf16_t*)(wss + W_WOUT), DIN, DIN}; pg8::StaticOrder S; S.init(NPAN, 4, F.G, (int)blockIdx.x);
            EpiResid E{ws, F.out, MODV + (size_t)i0 * 17 * 6144, 2, nullptr, lp == 0 ? A.x : nullptr, lp == 0 ? A.ctx : nullptr};
            pg8::gemm_phase<EpiResid, pg8::StaticOrder, true, false>(ring, g, S, E, F.wave0); }
        SEAM(pb + 5);
        if (PHON(1) && IN(pb + 6)) norm_phase(F, A, i0, 1, 0);
        SEAM(pb + 6);
        if (PHON(6) && IN(pb + 7)) { SITE_PTRS pg8::Gemm g{H, (const bf16_t*)(wss + W_WUP), 1024, 1024}; pg8::StaticOrder S; S.init(NPAN, 2 * DFF / 256, F.G, (int)blockIdx.x);
            EpiSwiglu E{BIG, DFF}; pg8::gemm_phase<EpiSwiglu, pg8::StaticOrder, true, false>(ring, g, S, E, F.wave0); }
        SEAM(pb + 7);
        if (PHON(5) && IN(pb + 8)) { SITE_PTRS pg8::Gemm g{BIG, (const bf16_t*)(wss + W_WDN), DFF, DFF}; pg8::StaticOrder S; S.init(NPAN, 4, F.G, (int)blockIdx.x);
            EpiResid E{ws, F.out, MODV + (size_t)i0 * 17 * 6144, 5, nullptr, nullptr, nullptr};
            pg8::gemm_phase<EpiResid, pg8::StaticOrder, true, false>(ring, g, S, E, F.wave0); }
        SEAM(pb + 8);
        if (PHON(1) && IN(pb + 9)) norm_phase(F, A, i1, 0, 0);
        SEAM(pb + 9);
        if (PHON(7) && IN(pb + 10)) { SITE_PTRS pg8::Gemm g{H, (const bf16_t*)(wsa + W_WQKV), 1024, 1024}; pg8::StaticOrder S; S.init(NPAN, NQKV / 256, F.G, (int)blockIdx.x);
            LAS float* qt = (LAS float*)(F.lds + PSCR_OFF);
            { const float* rp = (const float*)(ws + WS_ROPE); const float* bq = A.attn_b_qkv + (size_t)lp * NQKV; for (int idx = F.tid; idx < 3584; idx += 512) qt[idx] = idx < 2048 ? rp[idx] : bq[idx - 2048]; }
            __syncthreads();
            EpiQkv E{BIG, (bf16_t*)(ws + WS_BIG + BIG_K), (bf16_t*)(ws + WS_BIG + BIG_V), qt};
            pg8::gemm_phase<EpiQkv, pg8::StaticOrder, true, false>(ring, g, S, E, F.wave0); }
        SEAM(pb + 10);
        if (PHON(8) && IN(pb + 11)) { const int nconv = F.G >= 9996 ? 48 : 0;
            if ((int)blockIdx.x < F.G - nconv) attn_phase(F, A, lp, lp == 0, F.G - nconv); else moe_convert(F, A, lp, F.G - nconv, nconv); }
        SEAM(pb + 11);
        if (PHON(5) && IN(pb + 12)) { SITE_PTRS pg8::Gemm g{H, (const bf16_t*)(wsa + W_WO), 1024, 1024};
            EpiResid E{ws, F.out, MODV + (size_t)i1 * 17 * 6144, 2, A.attn_b_o + (size_t)lp * 1024, nullptr, nullptr};
            if (lp == 1) { pg8::LatentOrder S; S.init(NPAN - NB, 4, F.G, (int)blockIdx.x); pg8::gemm_phase<EpiResid, pg8::LatentOrder, true, false>(ring, g, S, E, F.wave0); }
            else { pg8::StaticOrder S; S.init(NPAN, 4, F.G, (int)blockIdx.x); pg8::gemm_phase<EpiResid, pg8::StaticOrder, true, false>(ring, g, S, E, F.wave0); } }
        SEAM(pb + 12);
        if (PHON(9) && IN(pb + 13)) { norm_phase(F, A, i1, 1, 4 | (lp == 1 ? 16 : 0)); if (F.G < 9996) { __syncthreads(); moe_convert(F, A, lp, 0, F.G); } }
        SEAM(pb + 13);
    moe_chunk<lp, 0>(F, A, lo, hi, bar, ring, TM); moe_chunk<lp, 1>(F, A, lo, hi, bar, ring, TM); moe_chunk<lp, 2>(F, A, lo, hi, bar, ring, TM);
}
constexpr int N_PHASES = 42;
__global__ void __launch_bounds__(NWAVES * 64, 2) fwd_kernel(Args A) {
    extern __shared__ __attribute__((aligned(16))) unsigned char lds_raw[];
    Frame F;
    F.lds = (LAS unsigned char*)lds_raw;
    F.tid = threadIdx.x; F.lane = F.tid & 63; F.wave = __builtin_amdgcn_readfirstlane(F.tid >> 6); F.wave0 = F.wave; F.G = gridDim.x;
    F.ws0 = A.ws; F.out0 = A.out; F.ws = A.ws; F.ctl = (gu32*)(A.ws + WS_CTL); F.out = A.out;
    volatile LAS unsigned* MISC = (volatile LAS unsigned*)(F.lds + MISC_OFF);
    for (int u = F.tid; u < (LDS_BYTES - LDSCTL_OFF) / 4; u += NWAVES * 64) ((LAS unsigned*)(F.lds + LDSCTL_OFF))[u] = 0u;
    __syncthreads();
    const int lo = A.ph_lo, hi = A.ph_hi;
    XcdBarrier bar; bar.bar = (unsigned*)(F.ctl + CW_BAR); bar.x = 0; bar.st = MISC + 8; bar.wave0 = F.wave0;
    if (hi - lo > 1) bar = xcd_barrier_post((unsigned*)(F.ctl + CW_BAR), MISC + 8, F.wave0);
    LAS unsigned char* ring = F.lds;

    Timer TM; TM.prev = TIMER_ON ? __builtin_amdgcn_s_memrealtime() : 0ull; TM.acc = 0ull;
    if (PHON(0) && IN(0)) { p0_prologue(F, A); }
    SEAM(0);
    layer_pair<0>(F, A, lo, hi, bar, ring, TM);
    layer_pair<1>(F, A, lo, hi, bar, ring, TM);
    if (PHON(1) && IN(41)) {
        norm_phase(F, A, 4, 0, 2 | 8);
        if (xb_ld((unsigned*)(F.ctl + CW_BAR) + XB_TMO) != 0u) {
            const float qn = __builtin_nanf("");
            for (size_t idx = (size_t)blockIdx.x * 512 + F.tid; idx < (size_t)NB * SEQ * DM / 4; idx += (size_t)F.G * 512) ((f32x4*)A.out)[idx] = (f32x4){qn, qn, qn, qn};
        }
    }
    if (TIMER_ON) { const unsigned long long now_ = __builtin_amdgcn_s_memrealtime(); if (41 >= TIMER_LO && 41 <= TIMER_HI) TM.acc += now_ - TM.prev;
        if (blockIdx.x == 0) { const unsigned long long tgt = now_ + TM.acc; while (__builtin_amdgcn_s_memrealtime() < tgt) __builtin_amdgcn_s_sleep(8); } }
#undef IN
#undef SEAM
}

extern "C" void kernel_launch(void* const* d_in, const int* in_sizes, int n_in, void* d_out, int out_size, void* d_ws, size_t ws_size, hipStream_t stream) {
    static int grid = 0;
    if (grid == 0) {
        if (n_in != 29 || in_sizes[0] != NB * SEQ * DM || out_size != NB * SEQ * DM || ws_size < WS_END) {
            fprintf(stderr, "kernel_launch: unexpected problem: n_in %d, in0 %d, out %d, ws %zu (need %zu); nothing launched\n", n_in, n_in > 0 ? in_sizes[0] : -1, out_size, ws_size, (size_t)WS_END); grid = -1; return; }
        int dev = 0, cus = 0, per_cu = 0;
        if (hipGetDevice(&dev) != hipSuccess || hipDeviceGetAttribute(&cus, hipDeviceAttributeMultiprocessorCount, dev) != hipSuccess) { fprintf(stderr, "kernel_launch: device query failed\n"); grid = -1; return; }
        if (hipFuncSetAttribute((const void*)fwd_kernel, hipFuncAttributeMaxDynamicSharedMemorySize, LDS_BYTES) != hipSuccess) { fprintf(stderr, "kernel_launch: hipFuncSetAttribute failed\n"); grid = -1; return; }
        if (hipOccupancyMaxActiveBlocksPerMultiprocessor(&per_cu, (const void*)fwd_kernel, NWAVES * 64, LDS_BYTES) != hipSuccess || per_cu < 1)
            fprintf(stderr, "kernel_launch: note: occupancy query reports %d workgroups per CU\n", per_cu);
        (void)hipGetLastError();
        grid = cus;
    }
    if (grid < 0) return;
    if (hipMemsetAsync((char*)d_ws + WS_CTL, 0, CTL_ZERO_BYTES, stream) != hipSuccess) { fprintf(stderr, "kernel_launch: memset failed\n"); return; }
    Args a{};
    const float** ap = (const float**)&a;
    for (int i = 0; i < 29; ++i) ap[i] = (const float*)d_in[i];
    a.out = (float*)d_out; a.ws = (unsigned char*)d_ws;
#if MK_PER_PHASE
    for (int k = 0; k < N_PHASES; ++k) { a.ph_lo = k; a.ph_hi = k + 1; hipLaunchKernelGGL(fwd_kernel, dim3(grid), dim3(NWAVES * 64), LDS_BYTES, stream, a); }
#else
    a.ph_lo = 0; a.ph_hi = N_PHASES;
    hipLaunchKernelGGL(fwd_kernel, dim3(grid), dim3(NWAVES * 64), LDS_BYTES, stream, a);
#endif
    const hipError_t le = hipPeekAtLastError();
    if (le != hipSuccess) fprintf(stderr, "kernel_launch: launch failed: %s\n", hipGetErrorName(le));
}
```

```cpp
#include <hip/hip_runtime.h>
#include <cstdio>
#include <cstdint>

#define LAS __attribute__((address_space(3)))
#define GAS __attribute__((address_space(1)))
typedef unsigned short bf16_t;
typedef short bf16x8 __attribute__((ext_vector_type(8)));
typedef short s16x4 __attribute__((ext_vector_type(4)));
typedef float f32x4 __attribute__((ext_vector_type(4)));
typedef float f32x2 __attribute__((ext_vector_type(2)));
typedef float f32x16 __attribute__((ext_vector_type(16)));
typedef unsigned u32x4 __attribute__((ext_vector_type(4)));
typedef unsigned u32x2 __attribute__((ext_vector_type(2)));
typedef GAS unsigned gu32;

namespace pg8 {
constexpr int BM = 256, BK = 64, HALF = 128, HTB = HALF * BK * 2  , STAGE_BYTES = 8 * HTB, NXCD = 8, WGM = 8;

__host__ __device__ __forceinline__ int lds_byte(int r, int c) { const int st = (r >> 4) * 2 + (c >> 5), rr = r & 15, cc = c & 31, ob = rr * 64 + cc * 2; return st * 1024 + (ob ^ (((ob >> 9) & 1) << 5)); }
__host__ __device__ __forceinline__ void stage_rc(int b, int& R, int& C) { const int st = b / 1024, sb = b % 1024, swz = sb ^ (((sb >> 9) & 1) << 5); R = (st >> 1) * 16 + swz / 64; C = (st & 1) * 32 + (swz % 64) / 2; }
__host__ __device__ __forceinline__ int perm32(int rho) { const int n = rho >> 4, i = rho & 15; return 8 * (i >> 2) + 4 * n + (i & 3); }

struct Unit { int pm, pn; };
struct Gemm { const bf16_t* A; const bf16_t* Bt; int lda, K; };

struct StaticOrder {
    int nM, nN, nwg, G, c;
    __device__ void init(int nM_, int nN_, int G_, int c_) { nM = nM_; nN = nN_; nwg = nM * nN; G = G_; c = c_; }
    __device__ bool next(int i, Unit& u) const {
        const long L = (long)i * G + c; if (L >= nwg) return false;
        int wgid = (int)L; { const int q = nwg / NXCD, r = nwg % NXCD, xcd = wgid % NXCD, off = wgid / NXCD; wgid = (xcd < r ? xcd * (q + 1) : r * (q + 1) + (xcd - r) * q) + off; }
        const int nig = WGM * nN, gid = wgid / nig, fm = gid * WGM, gsz = (nM - fm) < WGM ? (nM - fm) : WGM;
        u.pm = fm + ((wgid % nig) % gsz); u.pn = (wgid % nig) / gsz; return true;
    }
    __device__ __forceinline__ const char* a_base(const Gemm& g, const Unit& u) const { return (const char*)g.A + (size_t)u.pm * (size_t)(BM * 2) * g.lda; }
    __device__ __forceinline__ const char* b_base(const Gemm& g, const Unit& u) const { return (const char*)g.Bt + (size_t)u.pn * (size_t)(BM * 2) * g.K; }
    __device__ __forceinline__ unsigned row_off(const Gemm& g, const Unit&, int r) const { return (unsigned)r * (unsigned)g.lda * 2u; }
};

struct LatentOrder : StaticOrder {
    __device__ bool next(int i, Unit& u) const { if (!StaticOrder::next(i, u)) return false; u.pm = u.pm + (u.pm >> 4) + 1; return true; }
};

__device__ __forceinline__ unsigned cvt_pk_bf16(float lo, float hi) { unsigned r; asm volatile("v_cvt_pk_bf16_f32 %0, %1, %2" : "=v"(r) : "v"(lo), "v"(hi)); return r; }

template <class Epi, class Sched, bool ALIGN_EPI, bool GATHER>
__device__ __forceinline__ void gemm_phase(LAS unsigned char* lds, const Gemm g, const Sched& S, const Epi& E, const int wave0, const unsigned delay_ticks = 0u) {
    if (delay_ticks) { const unsigned long long t0_ = __builtin_amdgcn_s_memrealtime(); while (__builtin_amdgcn_s_memrealtime() - t0_ < (unsigned long long)delay_ticks) __builtin_amdgcn_s_sleep(16); }
    int tid_ = wave0 * 64 + (int)__builtin_amdgcn_mbcnt_hi(~0u, __builtin_amdgcn_mbcnt_lo(~0u, 0u)); asm volatile("" : "+v"(tid_));
    const int tid = tid_, wid = __builtin_amdgcn_readfirstlane(tid >> 6), lane = tid & 63, wr = wid >> 2, wc = wid & 3, fr = lane & 15, fq = lane >> 4;
    const int K = g.K, nt = K / BK;
    unsigned voffB[2];
#pragma unroll
    for (int i = 0; i < 2; ++i) { int R, C; stage_rc(tid * 16 + i * 8192, R, C); const int Rb = Epi::PERM ? ((R & ~31) + perm32(R & 31)) : R; voffB[i] = (unsigned)(Rb * K + C) * 2u; }
    const size_t kstep = (size_t)(BK * 2);
    const size_t hstepB = (size_t)HALF * K * 2;
    const unsigned ldsw = (unsigned)wid * 1024u;
    const int aoff = lds_byte(wr * 64 + fr, fq * 8), boff = lds_byte(wc * 32 + fr, fq * 8);
#define PG8_SA(b, h) (((b) * 2 + (h)) * HTB)
#define PG8_SB(b, h) ((4 + (b) * 2 + (h)) * HTB)
#define PG8_STAGE(bufoff, gbase, voff) do { _Pragma("unroll") for (int _i = 0; _i < 2; ++_i) \
        __builtin_amdgcn_global_load_lds((const unsigned*)((const char*)(gbase) + (voff)[_i]), (LAS unsigned*)(lds + (bufoff) + ldsw + _i * 8192), 16, 0, 0); } while (0)
#define PG8_LDA(dst, b, h) do { _Pragma("unroll") for (int m = 0; m < 4; ++m) _Pragma("unroll") for (int k = 0; k < 2; ++k) dst[m][k] = *(const LAS bf16x8*)(lds + PG8_SA(b, h) + aoff + m * 2048 + k * 1024); } while (0)
#define PG8_LDB(dst, b, h) do { _Pragma("unroll") for (int n = 0; n < 2; ++n) _Pragma("unroll") for (int k = 0; k < 2; ++k) dst[n][k] = *(const LAS bf16x8*)(lds + PG8_SB(b, h) + boff + n * 2048 + k * 1024); } while (0)
#define PG8_MMA(ai, bj, At, Bt) do { __builtin_amdgcn_s_setprio(1); _Pragma("unroll") for (int m = 0; m < 4; ++m) _Pragma("unroll") for (int n = 0; n < 2; ++n) _Pragma("unroll") for (int k = 0; k < 2; ++k) \
        acc[ai][bj][m][n] = __builtin_amdgcn_mfma_f32_16x16x32_bf16(Bt[n][k], At[m][k], acc[ai][bj][m][n], 0, 0, 0); __builtin_amdgcn_s_setprio(0); } while (0)
#define PG8_WAIT_V(n) asm volatile("s_waitcnt vmcnt(" #n ")" ::: "memory")
#define PG8_WAIT_L(n) asm volatile("s_waitcnt lgkmcnt(" #n ")" ::: "memory")
#define PG8_BAR __builtin_amdgcn_s_barrier()
#define PG8_SCHED __builtin_amdgcn_sched_barrier(0)
    Unit cur, nxt; int ui = 0;
    if (!S.next(0, cur)) return;
    f32x4 acc[2][2][4][2];
#pragma unroll
    for (int a = 0; a < 2; ++a)
#pragma unroll
        for (int b = 0; b < 2; ++b)
#pragma unroll
            for (int m = 0; m < 4; ++m)
#pragma unroll
                for (int n = 0; n < 2; ++n) acc[a][b][m][n] = (f32x4){0.f, 0.f, 0.f, 0.f};
    bf16x8 At[4][2], B0[2][2], B1[2][2];
    const char* cA = S.a_base(g, cur); const char* cB = S.b_base(g, cur);
    unsigned va[2][2], vn[2][2];
#pragma unroll
    for (int h = 0; h < 2; ++h)
#pragma unroll
        for (int i = 0; i < 2; ++i) { int R, C; stage_rc(tid * 16 + i * 8192, R, C); va[h][i] = S.row_off(g, cur, h * HALF + R) + (unsigned)C * 2u; vn[h][i] = va[h][i]; }
    PG8_STAGE(PG8_SB(0, 0), cB, voffB); PG8_STAGE(PG8_SB(0, 1), cB + hstepB, voffB); PG8_STAGE(PG8_SA(0, 0), cA, va[0]); PG8_STAGE(PG8_SA(0, 1), cA, va[1]);
    if (wr == 1) PG8_BAR;
    PG8_WAIT_V(2); PG8_BAR;
    PG8_STAGE(PG8_SB(1, 0), cB + kstep, voffB); PG8_STAGE(PG8_SA(1, 0), cA + kstep, va[0]); PG8_STAGE(PG8_SB(1, 1), cB + hstepB + kstep, voffB);
    PG8_WAIT_V(6); PG8_BAR;
    for (;;) {
        const bool has_next = S.next(ui + 1, nxt);
        const char* nA = has_next ? S.a_base(g, nxt) : cA; const char* nB = has_next ? S.b_base(g, nxt) : cB;
        if (GATHER) {
            if (has_next) {
#pragma unroll
                for (int h = 0; h < 2; ++h)
#pragma unroll
                    for (int i = 0; i < 2; ++i) { int R, C; stage_rc(tid * 16 + i * 8192, R, C); vn[h][i] = S.row_off(g, nxt, h * HALF + R) + (unsigned)C * 2u; }
            } else {
#pragma unroll
                for (int h = 0; h < 2; ++h)
#pragma unroll
                    for (int i = 0; i < 2; ++i) vn[h][i] = va[h][i];
            }
        }
        for (int t = 0; t < nt; t += 2) {
            const bool last = (t == nt - 2);
            const char* a1 = cA + (size_t)(t + 1) * kstep;
            const char* a2 = last ? nA : cA + (size_t)(t + 2) * kstep; const char* b2 = last ? nB : cB + (size_t)(t + 2) * kstep;
            const char* a3 = a2 + kstep; const char* b3 = b2 + kstep;
            unsigned v2[2][2];
#pragma unroll
            for (int h = 0; h < 2; ++h)
#pragma unroll
                for (int i = 0; i < 2; ++i) v2[h][i] = (GATHER && last) ? vn[h][i] : va[h][i];
            PG8_LDB(B0, 0, 0); PG8_LDB(B1, 0, 1); PG8_SCHED; PG8_LDA(At, 0, 0); PG8_STAGE(PG8_SA(1, 1), a1, va[1]);
            PG8_WAIT_V(8); PG8_WAIT_L(0); PG8_BAR; PG8_MMA(0, 0, At, B0); PG8_MMA(0, 1, At, B1); PG8_BAR; PG8_SCHED;
            PG8_LDA(At, 0, 1); PG8_STAGE(PG8_SB(0, 0), b2, voffB); PG8_STAGE(PG8_SB(0, 1), b2 + hstepB, voffB); PG8_STAGE(PG8_SA(0, 0), a2, v2[0]);
            PG8_WAIT_V(8); PG8_WAIT_L(0); PG8_BAR; PG8_MMA(1, 0, At, B0); PG8_MMA(1, 1, At, B1); PG8_BAR; PG8_SCHED;
            PG8_LDB(B0, 1, 0); PG8_LDB(B1, 1, 1); PG8_SCHED; PG8_LDA(At, 1, 0); PG8_STAGE(PG8_SA(0, 1), a2, v2[1]);
            PG8_WAIT_V(8); PG8_WAIT_L(0); PG8_BAR; PG8_MMA(0, 0, At, B0); PG8_MMA(0, 1, At, B1); PG8_BAR; PG8_SCHED;
            PG8_LDA(At, 1, 1); PG8_STAGE(PG8_SB(1, 0), b3, voffB); PG8_STAGE(PG8_SB(1, 1), b3 + hstepB, voffB); PG8_STAGE(PG8_SA(1, 0), a3, v2[0]);
            PG8_WAIT_V(8); PG8_WAIT_L(0); PG8_BAR; PG8_MMA(1, 0, At, B0); PG8_MMA(1, 1, At, B1); PG8_BAR; PG8_SCHED;
        }
        if constexpr (ALIGN_EPI) { if (wr == 0) PG8_BAR; }
        { int l2 = (int)__builtin_amdgcn_mbcnt_hi(~0u, __builtin_amdgcn_mbcnt_lo(~0u, 0u)); asm volatile("" : "+v"(l2)); E(acc, cur, wr, wc, l2 & 15, l2 >> 4); }
        if (!has_next) break;
#pragma unroll
        for (int a = 0; a < 2; ++a)
#pragma unroll
            for (int b = 0; b < 2; ++b)
#pragma unroll
                for (int m = 0; m < 4; ++m)
#pragma unroll
                    for (int n = 0; n < 2; ++n) acc[a][b][m][n] = (f32x4){0.f, 0.f, 0.f, 0.f};
        cur = nxt; cA = nA; cB = nB; ++ui;
        if (GATHER) {
#pragma unroll
            for (int h = 0; h < 2; ++h)
#pragma unroll
                for (int i = 0; i < 2; ++i) va[h][i] = vn[h][i];
        }
        if constexpr (ALIGN_EPI) { if (wr == 1) PG8_BAR; }
    }
    PG8_WAIT_V(0);
    if constexpr (!ALIGN_EPI) { if (wr == 0) PG8_BAR; }
    PG8_BAR;
#undef PG8_SA
#undef PG8_SB
#undef PG8_STAGE
#undef PG8_LDA
#undef PG8_LDB
#undef PG8_MMA
#undef PG8_WAIT_V
#undef PG8_WAIT_L
#undef PG8_BAR
#undef PG8_SCHED
}
}

constexpr int DM = 1024, NB = 16, SEQ = 4096, NCTX = 256, SROW = SEQ + NCTX  , MROWS = NB * SROW  , NPAN = MROWS / 256  ;
constexpr int DIN = 2048, CONVCH = 4096, SSD_IN = 6208, NXBC = 4352  ;
constexpr int QW = 1024, KVW = 256, NQKV = 1536;
constexpr int DFF = 2816, NEXP = 8, DFFE = 3584;
constexpr float EPS = 1e-6f;
constexpr int MOE_CHUNK = 192;
constexpr int NWAVES = 8;

constexpr size_t MiB = 1u << 20;
constexpr size_t WS_CTL = 0, CTL_ZERO_BYTES = 1 * MiB;
constexpr size_t WS_MODV = 2 * MiB;
constexpr size_t WS_ROPE = 4 * MiB;
constexpr size_t WS_GATE = 5 * MiB;
constexpr size_t WS_RLIST = 6 * MiB;
constexpr size_t WS_CX = 10 * MiB;
constexpr size_t WS_W = 26 * MiB;
constexpr size_t W_SSD_STRIDE = 33 * MiB, W_WZ = 0, W_WIN = 4 * MiB, W_WOUT = 12 * MiB + MiB / 2, W_WUP = 16 * MiB + MiB / 2, W_WDN = 27 * MiB + MiB / 2;
constexpr size_t W_ATT0 = 66 * MiB, W_ATT_STRIDE = 5 * MiB, W_WQKV = 0, W_WO = 3 * MiB;
constexpr size_t WS_H = 102 * MiB;
constexpr size_t WS_BIG = 238 * MiB;
constexpr size_t BIG_K = 136 * MiB, BIG_V = 170 * MiB, BIG_O = 204 * MiB, BIG_MW13 = 336 * MiB, BIG_MW2 = 448 * MiB;
static_assert((size_t)MOE_CHUNK * 256 * DFFE * 2 <= BIG_MW13 && BIG_O + 136 * MiB <= BIG_MW13 + 200 * MiB && BIG_MW2 + 56 * MiB <= 544 * MiB, "BIG region map");
constexpr size_t WS_Y = 782 * MiB;
constexpr size_t WS_DT = 1054 * MiB;
constexpr size_t WS_HALO = 1071 * MiB;
constexpr size_t WS_END = 1106 * MiB;
constexpr int CW_BAR = 4096;
constexpr int CW_CNT = 16384;

constexpr int RING_BYTES = 131072;
constexpr int PSCR_OFF = 131072;
constexpr int LDSCTL_OFF = 151552, MISC_OFF = LDSCTL_OFF + 320;
constexpr int LDS_BYTES = 155648;

#define RLX_AGENT __ATOMIC_RELAXED, __HIP_MEMORY_SCOPE_AGENT
#define LDS_WAIT() asm volatile("s_waitcnt lgkmcnt(0)" ::: "memory")
#define VM_WAIT() asm volatile("s_waitcnt vmcnt(0)" ::: "memory")
__device__ __forceinline__ unsigned f2bf(float f) { unsigned u = __builtin_bit_cast(unsigned, f); return (u + 0x7fffu + ((u >> 16) & 1u)) >> 16; }
__device__ __forceinline__ unsigned pk2(float lo, float hi) { return f2bf(lo) | (f2bf(hi) << 16); }
__device__ __forceinline__ float bf_lo(unsigned u) { return __builtin_bit_cast(float, u << 16); }
__device__ __forceinline__ float bf_hi(unsigned u) { return __builtin_bit_cast(float, u & 0xffff0000u); }
__device__ __forceinline__ float bf1(bf16_t h) { return __builtin_bit_cast(float, (unsigned)h << 16); }
__device__ __forceinline__ float siluf(float v) { return v * __builtin_amdgcn_rcpf(1.0f + __expf(-v)); }
__device__ __forceinline__ float shx(float v, int mask, int lane) { return __builtin_bit_cast(float, __builtin_amdgcn_ds_bpermute((lane ^ mask) << 2, __builtin_bit_cast(int, v))); }
__device__ __forceinline__ float wave_sum(float v, int lane) {
#pragma unroll
    for (int o = 1; o < 64; o <<= 1) v += shx(v, o, lane);
    return v;
}

__device__ __forceinline__ int lane_id() { return (int)__builtin_amdgcn_mbcnt_hi(~0u, __builtin_amdgcn_mbcnt_lo(~0u, 0u)); }
#define XB_TMO      128
#define XB_XCNT(j)  (256  + 64 * (j))
#define XB_XSUB(j)  (1280 + 64 * (j))
#define XB_XGEN(j)  (2304 + 64 * (j))
#define XB_TOP      3328
#define XB_TOPGEN   3392
#define XCD_BAR_WORDS 3456
#define XB_SPIN_CAP (1u << 18)

__device__ __forceinline__ unsigned xb_ld(unsigned* p)              { return __hip_atomic_load(p, __ATOMIC_RELAXED, __HIP_MEMORY_SCOPE_AGENT); }
__device__ __forceinline__ unsigned xb_add(unsigned* p, unsigned v) { return __hip_atomic_fetch_add(p, v, __ATOMIC_RELAXED, __HIP_MEMORY_SCOPE_AGENT); }
__device__ __forceinline__ unsigned xb_xcc_id() { return (unsigned)__builtin_amdgcn_s_getreg((3 << 11) | 20) & 0xFu; }
#define XB_SPIN(cond, bar) do { unsigned _sp = 0; while (cond) { __builtin_amdgcn_s_sleep(1); \
    if ((++_sp & 255u) == 0u) { if (xb_ld(&(bar)[XB_TMO])) break; if (_sp > XB_SPIN_CAP) { atomicAdd(&(bar)[XB_TMO], 1u); break; } } } } while (0)

struct XcdBarrier {
    unsigned* bar; unsigned x;
    volatile LAS unsigned* st;
    int wave0;
};
__device__ __forceinline__ XcdBarrier xcd_barrier_post(unsigned* bar, volatile LAS unsigned* st, int wave0) {
    XcdBarrier b; b.bar = bar; b.x = xb_xcc_id(); b.st = st; b.wave0 = wave0;
    if (wave0 == 0 && lane_id() == 0) (void)xb_add(&bar[XB_XCNT(b.x)], 1u);
    return b;
}
__device__ __forceinline__ void xcd_barrier_complete(unsigned* bar, unsigned x, unsigned& nloc, unsigned& nx) {
    const unsigned G = gridDim.x * gridDim.y * gridDim.z;
    unsigned sum, cnt, mine, sp = 0u;
    for (;;) {
        sum = 0u; cnt = 0u; mine = 0u;
#pragma unroll
        for (unsigned j = 0; j < 16; ++j) { const unsigned c = xb_ld(&bar[XB_XCNT(j)]); sum += c; cnt += (c > 0u) ? 1u : 0u; mine = (j == x) ? c : mine; }
        if (sum == G) break;
        __builtin_amdgcn_s_sleep(1);
        if ((++sp & 255u) == 0u) { if (xb_ld(&bar[XB_TMO])) break; if (sp > XB_SPIN_CAP) { atomicAdd(&bar[XB_TMO], 1u); break; } }
    }
    nloc = mine > 0u ? mine : 1u; nx = cnt > 0u ? cnt : 1u;
}
__device__ __forceinline__ void xcd_barrier(const XcdBarrier& b) {
    asm volatile("s_waitcnt vmcnt(0)" ::: "memory");
    __syncthreads();
    if (b.wave0 == 0 && lane_id() == 0) {
        unsigned* bar = b.bar;
        __builtin_amdgcn_s_waitcnt(0);
        unsigned nloc = b.st[0], nx = b.st[1];
        if (nloc == 0u) { xcd_barrier_complete(bar, b.x, nloc, nx); b.st[0] = nloc; b.st[1] = nx; }
        const unsigned old = xb_add(&bar[XB_XSUB(b.x)], 1u);
        const unsigned gen = old / nloc;
        if (old + 1u == (gen + 1u) * nloc) {
            __builtin_amdgcn_fence(__ATOMIC_RELEASE, "agent");
            asm volatile("s_waitcnt vmcnt(0)" ::: "memory");
            const unsigned og = xb_add(&bar[XB_TOP], 1u);
            const unsigned tg = og / nx;
            if (og + 1u == (tg + 1u) * nx) xb_add(&bar[XB_TOPGEN], 1u);
            else XB_SPIN(xb_ld(&bar[XB_TOPGEN]) == tg, bar);
            __builtin_amdgcn_fence(__ATOMIC_ACQUIRE, "agent");
            xb_add(&bar[XB_XGEN(b.x)], 1u);
            asm volatile("s_waitcnt vmcnt(0)" ::: "memory");
        } else {
            XB_SPIN(xb_ld(&bar[XB_XGEN(b.x)]) == gen, bar);
            __builtin_amdgcn_fence(__ATOMIC_ACQUIRE, "agent");
            asm volatile("s_waitcnt vmcnt(0)" ::: "memory");
        }
    }
    __syncthreads();
}

struct Args {
    const float *x, *c, *ctx, *c_ctx, *w_mod, *b_mod, *norm1_w, *norm2_w, *ssd_w_in, *ssd_conv_w, *ssd_conv_b, *ssd_dt_bias, *ssd_a_log, *ssd_d, *ssd_norm_w, *ssd_w_out,
                *attn_w_qkv, *attn_b_qkv, *attn_sink, *attn_w_o, *attn_b_o, *ffn_w1, *ffn_w3, *ffn_w2, *moe_router, *moe_w1, *moe_w3, *moe_w2, *final_norm_w;
    float* out; unsigned char* ws; int ph_lo, ph_hi;
};
struct Frame {
    LAS unsigned char* lds;
    int tid, lane, wave, G;
    unsigned char* ws; gu32* ctl; float* out;
    unsigned char* ws0; float* out0; int wave0;
};
__device__ __forceinline__ void phase_enter(Frame& F) { int l = lane_id(); asm volatile("" : "+v"(l)); F.lane = l; F.wave = F.wave0; F.tid = F.wave0 * 64 + l;
    unsigned char* w = F.ws0; float* o = F.out0; asm volatile("" : "+s"(w), "+s"(o)); F.ws = w; F.ctl = (gu32*)(w + WS_CTL); F.out = o; }
__device__ __forceinline__ float* resid_row(const Frame& F, int R) {
    const int b = R / SROW, s = R - b * SROW;
    return s < NCTX ? (float*)(F.ws + WS_CX) + (size_t)(b * NCTX + s) * DM : F.out + (size_t)(b * SEQ + s - NCTX) * DM;
}
__device__ __forceinline__ float* resid_panel(const Frame& F, int pm, int& cond) {
    const int b = pm / 17, j = pm - b * 17; cond = j == 0 ? 16 : b;
    return j == 0 ? (float*)(F.ws + WS_CX) + (size_t)(b * NCTX) * DM : F.out + (size_t)(b * SEQ + (j - 1) * 256) * DM;
}

__device__ __forceinline__ void transpose_item(const float* W, int ldw, int col0, int ncb, int K, bf16_t* WT, int mode, int half, LAS float* scr, int item, int lane) {
    const int kb = item / ncb, nb = item - kb * ncb, k0 = 64 * kb, n0 = 64 * nb;
    const int lr = lane >> 4, lc = (lane & 15) * 4;
    f32x4 tv[16];
#pragma unroll
    for (int i = 0; i < 16; ++i) tv[i] = *(const GAS f32x4*)(W + (size_t)(k0 + 4 * i + lr) * ldw + col0 + n0 + lc);
#pragma unroll
    for (int i = 0; i < 16; ++i) { LAS float* d = scr + (4 * i + lr) * 65 + lc; d[0] = tv[i].x; d[1] = tv[i].y; d[2] = tv[i].z; d[3] = tv[i].w; }
    LDS_WAIT(); asm volatile("" ::: "memory");
    const int c = lane & 7;
#pragma unroll
    for (int j = 0; j < 8; ++j) { const int n = (lane >> 3) + 8 * j; const LAS float* s = scr + (8 * c) * 65 + n;
        u32x4 o; o.x = pk2(s[0 * 65], s[1 * 65]); o.y = pk2(s[2 * 65], s[3 * 65]); o.z = pk2(s[4 * 65], s[5 * 65]); o.w = pk2(s[6 * 65], s[7 * 65]);
        const int cl = n0 + n; const int drow = mode == 0 ? cl : ((cl >> 7) * 256 + half * 128 + (cl & 127));
        *(GAS u32x4*)(WT + (size_t)drow * K + k0 + 8 * c) = o; }
    LDS_WAIT(); asm volatile("" ::: "memory");
}
__device__ __forceinline__ void p0_prologue(Frame& F, const Args& A) {
    phase_enter(F);
    {
        LAS float* sc = (LAS float*)F.lds;
        LAS float* red = (LAS float*)(F.lds + 81920);
        for (int idx = F.tid; idx < 17 * 1024; idx += 512) { const int cb = idx >> 10, k = idx & 1023; const float v = cb < 16 ? A.c[cb * 1024 + k] : A.c_ctx[k]; sc[k * 20 + cb] = v / (1.0f + expf(-v)); }
        __syncthreads();
        float* MODV = (float*)(F.ws + WS_MODV);
        for (int item = blockIdx.x; item < 4 * 96; item += F.G) {
            const int i = item / 96, cblk = item - i * 96;
            const float* Wm = A.w_mod + (size_t)i * 1024 * 6144 + cblk * 64 + F.lane;
            float acc[17];
#pragma unroll
            for (int cb = 0; cb < 17; ++cb) acc[cb] = 0.f;
            const int k0 = F.wave * 128;
#pragma unroll 4
            for (int kk = 0; kk < 128; ++kk) { const int k = k0 + kk; const float w = Wm[(size_t)k * 6144]; const LAS float* s = sc + k * 20;
#pragma unroll
                for (int cb = 0; cb < 17; ++cb) acc[cb] += s[cb] * w; }
#pragma unroll
            for (int cb = 0; cb < 17; ++cb) red[(F.wave * 17 + cb) * 64 + F.lane] = acc[cb];
            __syncthreads();
            for (int idx = F.tid; idx < 17 * 64; idx += 512) { const int cb = idx >> 6, l = idx & 63; float s = 0.f;
#pragma unroll
                for (int w = 0; w < 8; ++w) s += red[(w * 17 + cb) * 64 + l];
                MODV[(size_t)(i * 17 + cb) * 6144 + cblk * 64 + l] = s + A.b_mod[i * 6144 + cblk * 64 + l]; }
            __syncthreads();
        }
    }
    if (blockIdx.x == 0) { float* RT = (float*)(F.ws + WS_ROPE);
        for (int idx = F.tid; idx < 1024; idx += 512) { const int id = idx >> 4, f = idx & 15; const float inv = __builtin_amdgcn_exp2f(-(float)f * (13.287712379549449f / 16.0f)); const float ang = (float)id * inv;
            RT[idx] = __cosf(ang); RT[1024 + idx] = __sinf(ang); } }
    __syncthreads();
    {
        LAS float* scr = (LAS float*)(F.lds + F.wave * 16896);
        const int gw = blockIdx.x * NWAVES + F.wave, NGW = F.G * NWAVES;
        constexpr int I1 = 16 * 32, I2 = 16 * 65, I3 = 32 * 16, I4 = 16 * 44, I5 = 16 * 44, I6 = 44 * 16, I7 = 16 * 24, I8 = 16 * 16, IPER = I1 + I2 + I3 + I4 + I5 + I6 + I7 + I8;
        for (int it = gw; it < 2 * IPER; it += NGW) {
            const int j = it / IPER; int r = it - j * IPER;
            unsigned char* wss = F.ws + WS_W + (size_t)j * W_SSD_STRIDE; unsigned char* wsa = F.ws + WS_W + W_ATT0 + (size_t)j * W_ATT_STRIDE;
            if (r < I1) { transpose_item(A.ssd_w_in + (size_t)j * 1024 * SSD_IN, SSD_IN, 0, 32, 1024, (bf16_t*)(wss + W_WZ), 0, 0, scr, r, F.lane); continue; } r -= I1;
            if (r < I2) { transpose_item(A.ssd_w_in + (size_t)j * 1024 * SSD_IN, SSD_IN, 2048, 65, 1024, (bf16_t*)(wss + W_WIN), 0, 0, scr, r, F.lane); continue; } r -= I2;
            if (r < I3) { transpose_item(A.ssd_w_out + (size_t)j * 2048 * 1024, 1024, 0, 16, 2048, (bf16_t*)(wss + W_WOUT), 0, 0, scr, r, F.lane); continue; } r -= I3;
            if (r < I4) { transpose_item(A.ffn_w1 + (size_t)j * 1024 * DFF, DFF, 0, 44, 1024, (bf16_t*)(wss + W_WUP), 1, 0, scr, r, F.lane); continue; } r -= I4;
            if (r < I5) { transpose_item(A.ffn_w3 + (size_t)j * 1024 * DFF, DFF, 0, 44, 1024, (bf16_t*)(wss + W_WUP), 1, 1, scr, r, F.lane); continue; } r -= I5;
            if (r < I6) { transpose_item(A.ffn_w2 + (size_t)j * DFF * 1024, 1024, 0, 16, DFF, (bf16_t*)(wss + W_WDN), 0, 0, scr, r, F.lane); continue; } r -= I6;
            if (r < I7) { transpose_item(A.attn_w_qkv + (size_t)j * 1024 * NQKV, NQKV, 0, 24, 1024, (bf16_t*)(wsa + W_WQKV), 0, 0, scr, r, F.lane); continue; } r -= I7;
            transpose_item(A.attn_w_o + (size_t)j * 1024 * 1024, 1024, 0, 16, 1024, (bf16_t*)(wsa + W_WO), 0, 0, scr, r, F.lane);
        }
        for (int j = 0; j < 2; ++j) { u32x4* z = (u32x4*)(F.ws + WS_W + (size_t)j * W_SSD_STRIDE + W_WIN + (size_t)4160 * 1024 * 2);
            for (int idx = blockIdx.x * 512 + F.tid; idx < 192 * 1024 * 2 / 16; idx += F.G * 512) z[idx] = (u32x4){0u, 0u, 0u, 0u}; }
    }
}
__device__ __forceinline__ void moe_convert(Frame& F, const Args& A, int j, int wg0, int nwg) {
    phase_enter(F);
    LAS float* scr = (LAS float*)(F.lds + F.wave * 16896);
    const int gw = ((int)blockIdx.x - wg0) * NWAVES + F.wave, NGW = nwg * NWAVES;
    constexpr int IE = 16 * 56, I2 = 56 * 16;
    bf16_t* MW13 = (bf16_t*)(F.ws + WS_BIG + BIG_MW13); bf16_t* MW2 = (bf16_t*)(F.ws + WS_BIG + BIG_MW2);
    for (int it = gw; it < 8 * (2 * IE + I2); it += NGW) {
        const int e = it / (2 * IE + I2); int r = it - e * (2 * IE + I2);
        const size_t we = (size_t)(j * 8 + e) * 1024 * DFFE;
        if (r < IE) { transpose_item(A.moe_w1 + we, DFFE, 0, 56, 1024, MW13 + (size_t)e * 7168 * 1024, 1, 0, scr, r, F.lane); continue; } r -= IE;
        if (r < IE) { transpose_item(A.moe_w3 + we, DFFE, 0, 56, 1024, MW13 + (size_t)e * 7168 * 1024, 1, 1, scr, r, F.lane); continue; } r -= IE;
        transpose_item(A.moe_w2 + we, 1024, 0, 16, DFFE, MW2 + (size_t)e * 1024 * DFFE, 0, 0, scr, r, F.lane);
    }
}

__device__ __forceinline__ void norm_phase(Frame& F, const Args& A, int i, int which, int mode) {
    phase_enter(F);
    const bool first = mode & 1, combine = mode & 2, route = mode & 4, fin = mode & 8, lastl = mode & 16;
    const float* MODV = (const float*)(F.ws + WS_MODV);
    bf16_t* H = (bf16_t*)(F.ws + WS_H);
    const bf16_t* EO = (const bf16_t*)(F.ws + WS_Y);
    LAS float* rt = (LAS float*)F.lds;
    LAS int* ents = (LAS int*)(F.lds + 32768);
    const int jm = i >> 1;
    if (route) { const float* rg = A.moe_router + (size_t)jm * 1024 * 8; for (int idx = F.tid; idx < 8192; idx += 512) rt[(idx & 7) * 1024 + (idx >> 3)] = rg[idx]; }
    __syncthreads();
    const float* nw = fin ? A.final_norm_w : ((which == 0 ? A.norm1_w : A.norm2_w) + i * 1024);
    unsigned* cnt = (unsigned*)(F.ctl + CW_CNT + (size_t)jm * 8 * 64);
    int* rlist = (int*)(F.ws + WS_RLIST); float* GATE = (float*)(F.ws + WS_GATE);
    for (int ch = blockIdx.x; ch < MROWS / 32; ch += F.G) {
        const int R0 = ch * 32, b = R0 / SROW, s0 = R0 - b * SROW; const bool isctx = s0 < NCTX; const int cond = isctx ? 16 : b;
        if (fin && isctx) continue;
        const bool do_route = route && !(lastl && isctx);
        const float* mv = MODV + (size_t)(i * 17 + cond) * 6144;
        f32x4 wv[4], shv[4], scv[4], g5[4];
#pragma unroll
        for (int j = 0; j < 4; ++j) { const int col = 4 * F.lane + 256 * j; wv[j] = *(const f32x4*)(nw + col);
            if (!fin) { shv[j] = *(const f32x4*)(mv + (which ? 3 : 0) * 1024 + col); scv[j] = *(const f32x4*)(mv + (which ? 4 : 1) * 1024 + col); }
            if (combine) g5[j] = *(const f32x4*)(MODV + (size_t)((i - 1) * 17 + cond) * 6144 + 5 * 1024 + col); }
        for (int rr = 0; rr < 4; ++rr) {
            const int R = R0 + F.wave * 4 + rr, s = s0 + F.wave * 4 + rr;
            float* res = isctx ? (float*)(F.ws + WS_CX) + (size_t)(b * NCTX + s) * DM : F.out + (size_t)(b * SEQ + s - NCTX) * DM;
            const float* src = first ? (isctx ? A.ctx + (size_t)(b * NCTX + s) * DM : A.x + (size_t)(b * SEQ + s - NCTX) * DM) : res;
            f32x4 v[4]; float ss = 0.f;
#pragma unroll
            for (int j = 0; j < 4; ++j) v[j] = *(const f32x4*)(src + 4 * F.lane + 256 * j);
            if (combine) {
#pragma unroll
                for (int j = 0; j < 4; ++j) { const u32x2 e0 = *(const u32x2*)(EO + (size_t)(2 * R) * DM + 4 * F.lane + 256 * j), e1 = *(const u32x2*)(EO + (size_t)(2 * R + 1) * DM + 4 * F.lane + 256 * j);
                    f32x4 ev; ev.x = bf_lo(e0.x) + bf_lo(e1.x); ev.y = bf_hi(e0.x) + bf_hi(e1.x); ev.z = bf_lo(e0.y) + bf_lo(e1.y); ev.w = bf_hi(e0.y) + bf_hi(e1.y);
                    v[j] = v[j] + g5[j] * ev; }
            }
            if (combine) {
#pragma unroll
                for (int j = 0; j < 4; ++j) *(f32x4*)(res + 4 * F.lane + 256 * j) = v[j];
            }
#pragma unroll
            for (int j = 0; j < 4; ++j) ss += (v[j].x * v[j].x + v[j].y * v[j].y) + (v[j].z * v[j].z + v[j].w * v[j].w);
            const float rstd = 1.0f / sqrtf(wave_sum(ss, F.lane) * (1.0f / DM) + EPS);
            if (fin) {
#pragma unroll
                for (int j = 0; j < 4; ++j) *(f32x4*)(res + 4 * F.lane + 256 * j) = v[j] * rstd * wv[j];
                continue;
            }
#pragma unroll
            for (int j = 0; j < 4; ++j) { v[j] = v[j] * rstd * wv[j] * (scv[j] + 1.0f) + shv[j];
                u32x2 o; o.x = pk2(v[j].x, v[j].y); o.y = pk2(v[j].z, v[j].w); *(u32x2*)(H + (size_t)R * DM + 4 * F.lane + 256 * j) = o; }
            if (do_route) {
                float lg[8];
#pragma unroll
                for (int e = 0; e < 8; ++e) lg[e] = 0.f;
#pragma unroll
                for (int e = 0; e < 8; ++e)
#pragma unroll
                    for (int j = 0; j < 4; ++j) { const f32x4 r = *(const LAS f32x4*)(rt + e * 1024 + 4 * F.lane + 256 * j); lg[e] += (v[j].x * r.x + v[j].y * r.y) + (v[j].z * r.z + v[j].w * r.w); }
#pragma unroll
                for (int e = 0; e < 8; ++e) lg[e] = wave_sum(lg[e], F.lane);
                int i1 = 0; float v1 = lg[0];
#pragma unroll
                for (int e = 1; e < 8; ++e) if (lg[e] > v1) { v1 = lg[e]; i1 = e; }
                int i2 = -1; float v2 = -3.0e38f;
#pragma unroll
                for (int e = 0; e < 8; ++e) if (e != i1 && lg[e] > v2) { v2 = lg[e]; i2 = e; }
                const float g1 = 1.0f / (1.0f + expf(v2 - v1)), g2 = 1.0f - g1;
                if (F.lane == 0) { ents[(F.wave * 4 + rr) * 2] = i1; ents[(F.wave * 4 + rr) * 2 + 1] = i2; GATE[(size_t)R * 2] = g1; GATE[(size_t)R * 2 + 1] = g2; }
            }
        }
        if (do_route) {
            __syncthreads();
            if (F.wave == 0) {
                const int e = ents[F.lane];
#pragma unroll
                for (int ee = 0; ee < 8; ++ee) { const unsigned long long m = __ballot(e == ee); const int n = __popcll(m);
                    if (n) { unsigned base = 0; if (F.lane == 0) base = __hip_atomic_fetch_add(cnt + ee * 64, (unsigned)n, RLX_AGENT); base = __builtin_amdgcn_readfirstlane(base);
                        if (e == ee) { const int pos = (int)base + __popcll(m & ((1ull << F.lane) - 1ull)); rlist[(size_t)ee * MROWS + pos] = (R0 + (F.lane >> 1)) * 2 + (F.lane & 1); } } }
            }
            __syncthreads();
        }
    }
}

struct EpiXbc {
    static constexpr bool PERM = true;
    bf16_t* XBC; float* DT; bf16_t* HALO;
    __device__ __forceinline__ void operator()(const f32x4 (&acc)[2][2][4][2], const pg8::Unit& u, int wr, int wc, int fr, int fq) const {
        const int row0 = u.pm * 256 + wr * 64 + fr;
        if (u.pn < 16) { const int col0 = u.pn * 256 + wc * 32 + 8 * fq;
#pragma unroll
            for (int ai = 0; ai < 2; ++ai)
#pragma unroll
                for (int m = 0; m < 4; ++m) { bf16_t* rowp = XBC + (size_t)(row0 + ai * 128 + m * 16) * CONVCH + col0;
#pragma unroll
                    for (int bj = 0; bj < 2; ++bj) { const f32x4 v0 = acc[ai][bj][m][0], v1 = acc[ai][bj][m][1]; u32x4 w; w.x = pg8::cvt_pk_bf16(v0[0], v0[1]); w.y = pg8::cvt_pk_bf16(v0[2], v0[3]); w.z = pg8::cvt_pk_bf16(v1[0], v1[1]); w.w = pg8::cvt_pk_bf16(v1[2], v1[3]);
                        *(GAS u32x4*)(rowp + bj * 128) = w;
                        const int rin = ai * 128 + wr * 64 + m * 16 + fr, rq = rin >> 6, rw = rin & 63;
                        if (rw < 2 || rw >= 62) *(GAS u32x4*)(HALO + ((size_t)u.pm * 16 + (rw < 2 ? (rq == 0 ? rw : 4 * rq + rw) : 4 * rq + rw - 60)) * CONVCH + col0 + bj * 128) = w; } }
        } else if (wc < 2) { const int c0 = wc * 32 + 8 * fq;
#pragma unroll
            for (int ai = 0; ai < 2; ++ai)
#pragma unroll
                for (int m = 0; m < 4; ++m) { float* p = DT + (size_t)(row0 + ai * 128 + m * 16) * 64 + c0; *(GAS f32x4*)p = acc[ai][0][m][0]; *(GAS f32x4*)(p + 4) = acc[ai][0][m][1]; }
        }
    }
};
struct EpiGate {
    static constexpr bool PERM = true;
    const bf16_t* Y; bf16_t* Gt; const float* nw; LAS float* P;
    __device__ __forceinline__ void operator()(f32x4 (&acc)[2][2][4][2], const pg8::Unit& u, int wr, int wc, int fr, int fq) const {
        const int row0 = u.pm * 256 + wr * 64 + fr, col0 = u.pn * 256 + wc * 32 + 8 * fq;
        u32x4 yq[2][4][2];
        { const GAS char* yb = (const GAS char*)(Y + (size_t)(u.pm * 256) * DIN + u.pn * 256); unsigned yo = (unsigned)((wr * 64 + fr) * DIN * 2); asm volatile("" : "+v"(yo));
#pragma unroll
          for (int ai = 0; ai < 2; ++ai)
#pragma unroll
            for (int m = 0; m < 4; ++m)
#pragma unroll
                for (int bj = 0; bj < 2; ++bj) { const int cg = bj * 128 + wc * 32 + 8 * fq; const int cy = ((cg >> 5) & 1) * 128 + (cg >> 6) * 32 + (cg & 31);
                    yq[ai][m][bj] = *(const GAS u32x4*)(yb + (size_t)(ai * 128 + m * 16) * DIN * 2 + yo + cy * 2); } }
#pragma unroll
        for (int ai = 0; ai < 2; ++ai)
#pragma unroll
            for (int m = 0; m < 4; ++m) { float ssq = 0.f;
#pragma unroll
                for (int bj = 0; bj < 2; ++bj) { const u32x4 yv = yq[ai][m][bj]; f32x4 z0 = acc[ai][bj][m][0], z1 = acc[ai][bj][m][1];
                    z0[0] = bf_lo(yv.x) * siluf(z0[0]); z0[1] = bf_hi(yv.x) * siluf(z0[1]); z0[2] = bf_lo(yv.y) * siluf(z0[2]); z0[3] = bf_hi(yv.y) * siluf(z0[3]);
                    z1[0] = bf_lo(yv.z) * siluf(z1[0]); z1[1] = bf_hi(yv.z) * siluf(z1[1]); z1[2] = bf_lo(yv.w) * siluf(z1[2]); z1[3] = bf_hi(yv.w) * siluf(z1[3]);
                    ssq += (z0[0] * z0[0] + z0[1] * z0[1]) + (z0[2] * z0[2] + z0[3] * z0[3]) + (z1[0] * z1[0] + z1[1] * z1[1]) + (z1[2] * z1[2] + z1[3] * z1[3]);
                    acc[ai][bj][m][0] = z0; acc[ai][bj][m][1] = z1; }
                ssq += shx(ssq, 16, fq * 16 + fr); ssq += shx(ssq, 32, fq * 16 + fr);
                if (fq == 0) P[(ai * 128 + wr * 64 + m * 16 + fr) * 4 + wc] = ssq; }
        asm volatile("s_waitcnt lgkmcnt(0)" ::: "memory"); __builtin_amdgcn_s_barrier(); asm volatile("" ::: "memory");
        f32x4 nv[2][2];
#pragma unroll
        for (int bj = 0; bj < 2; ++bj) { nv[bj][0] = *(const GAS f32x4*)(nw + col0 + bj * 128); nv[bj][1] = *(const GAS f32x4*)(nw + col0 + bj * 128 + 4); }
#pragma unroll
        for (int ai = 0; ai < 2; ++ai)
#pragma unroll
            for (int m = 0; m < 4; ++m) { const f32x4 pp = *(const LAS f32x4*)(P + (ai * 128 + wr * 64 + m * 16 + fr) * 4); const float rstd = 1.0f / sqrtf(((pp.x + pp.y) + (pp.z + pp.w)) * (1.0f / 256.0f) + EPS);
                bf16_t* gp = Gt + (size_t)(row0 + ai * 128 + m * 16) * DIN + col0;
#pragma unroll
                for (int bj = 0; bj < 2; ++bj) { const f32x4 v0 = acc[ai][bj][m][0] * rstd * nv[bj][0], v1 = acc[ai][bj][m][1] * rstd * nv[bj][1];
                    u32x4 w; w.x = pg8::cvt_pk_bf16(v0[0], v0[1]); w.y = pg8::cvt_pk_bf16(v0[2], v0[3]); w.z = pg8::cvt_pk_bf16(v1[0], v1[1]); w.w = pg8::cvt_pk_bf16(v1[2], v1[3]);
                    *(GAS u32x4*)(gp + bj * 128) = w; } }
        asm volatile("s_waitcnt lgkmcnt(0)" ::: "memory");
    }
};
struct EpiResid {
    static constexpr bool PERM = false;
    unsigned char* ws; float* out; const float* modl; int gidx; const float* bias;
    const float* rd_x; const float* rd_ctx;
    __device__ __forceinline__ void operator()(const f32x4 (&acc)[2][2][4][2], const pg8::Unit& u, int wr, int wc, int fr, int fq) const {
        const int b = u.pm / 17, j = u.pm - b * 17, cond = j == 0 ? 16 : b;
        const GAS char* pbase = (const GAS char*)(j == 0 ? (float*)(ws + WS_CX) + (size_t)(b * NCTX) * DM : out + (size_t)(b * SEQ + (j - 1) * 256) * DM);
        unsigned lo = (unsigned)(((wr * 64 + fr) * DM + u.pn * 256 + wc * 32 + 4 * fq) * 4); asm volatile("" : "+v"(lo));
        const GAS char* rbase = rd_x ? (const GAS char*)(j == 0 ? rd_ctx + (size_t)(b * NCTX) * DM : rd_x + (size_t)(b * SEQ + (j - 1) * 256) * DM) : pbase;
        const GAS float* gv = (const GAS float*)(modl + (size_t)cond * 6144 + gidx * 1024 + u.pn * 256 + wc * 32 + 4 * fq);
        const GAS float* bp = (const GAS float*)(bias ? bias + u.pn * 256 + wc * 32 + 4 * fq : nullptr);
#define RES_PTR(ai, m, bj, n) ((GAS f32x4*)(pbase + (size_t)((ai) * 128 + (m) * 16) * DM * 4 + lo + ((bj) * 128 + (n) * 16) * 4))
#define RD_PTR(ai, m, bj, n) ((const GAS f32x4*)(rbase + (size_t)((ai) * 128 + (m) * 16) * DM * 4 + lo + ((bj) * 128 + (n) * 16) * 4))
#pragma unroll
        for (int bj = 0; bj < 2; ++bj) {
            f32x4 g[2], bv[2];
#pragma unroll
            for (int n = 0; n < 2; ++n) { g[n] = *(const GAS f32x4*)(gv + bj * 128 + n * 16); bv[n] = bp ? *(const GAS f32x4*)(bp + bj * 128 + n * 16) : (f32x4){0.f, 0.f, 0.f, 0.f}; }
            if (bj == 0) {
#pragma unroll
                for (int ai = 0; ai < 2; ++ai) {
                    f32x4 o[4][2];
#pragma unroll
                    for (int m = 0; m < 4; ++m)
#pragma unroll
                        for (int n = 0; n < 2; ++n) o[m][n] = *RD_PTR(ai, m, bj, n);
#pragma unroll
                    for (int m = 0; m < 4; ++m)
#pragma unroll
                        for (int n = 0; n < 2; ++n) *RES_PTR(ai, m, bj, n) = o[m][n] + g[n] * (acc[ai][bj][m][n] + bv[n]);
                    asm volatile("" ::: "memory");
                }
            } else {
                f32x4 o[2][4][2];
#pragma unroll
                for (int ai = 0; ai < 2; ++ai)
#pragma unroll
                    for (int m = 0; m < 4; ++m)
#pragma unroll
                        for (int n = 0; n < 2; ++n) o[ai][m][n] = *RD_PTR(ai, m, bj, n);
#pragma unroll
                for (int ai = 0; ai < 2; ++ai)
#pragma unroll
                    for (int m = 0; m < 4; ++m)
#pragma unroll
                        for (int n = 0; n < 2; ++n) *RES_PTR(ai, m, bj, n) = o[ai][m][n] + g[n] * (acc[ai][bj][m][n] + bv[n]);
            }
        }
#undef RES_PTR
#undef RD_PTR
    }
};
struct EpiSwiglu {
    static constexpr bool PERM = true;
    bf16_t* ACT; int ldc;
    __device__ __forceinline__ void operator()(const f32x4 (&acc)[2][2][4][2], const pg8::Unit& u, int wr, int wc, int fr, int fq) const {
        const int row0 = u.pm * 256 + wr * 64 + fr, col0 = u.pn * 128 + wc * 32 + 8 * fq;
#pragma unroll
        for (int ai = 0; ai < 2; ++ai)
#pragma unroll
            for (int m = 0; m < 4; ++m) { const f32x4 g0 = acc[ai][0][m][0], g1 = acc[ai][0][m][1], u0 = acc[ai][1][m][0], u1 = acc[ai][1][m][1];
                u32x4 w; w.x = pg8::cvt_pk_bf16(siluf(g0[0]) * u0[0], siluf(g0[1]) * u0[1]); w.y = pg8::cvt_pk_bf16(siluf(g0[2]) * u0[2], siluf(g0[3]) * u0[3]);
                w.z = pg8::cvt_pk_bf16(siluf(g1[0]) * u1[0], siluf(g1[1]) * u1[1]); w.w = pg8::cvt_pk_bf16(siluf(g1[2]) * u1[2], siluf(g1[3]) * u1[3]);
                *(GAS u32x4*)(ACT + (size_t)(row0 + ai * 128 + m * 16) * ldc + col0) = w; }
    }
};
struct EpiQkv {
    static constexpr bool PERM = false;
    bf16_t *Q, *Kb, *Vb; const LAS float* T;
    __device__ __forceinline__ void operator()(const f32x4 (&acc)[2][2][4][2], const pg8::Unit& u, int wr, int wc, int fr, int fq) const {
        const int b = u.pm / 17, j = u.pm - b * 17; const bool isctx = j == 0; const int pos0 = (j - 1) * 256;
        bf16_t* dst; int ld, cbase; float sc = 1.0f;
        if (u.pn < 4) { dst = Q; ld = QW; cbase = u.pn * 256; sc = 0.125f * 1.4426950408889634f;   } else if (u.pn == 4) { dst = Kb; ld = KVW; cbase = 0; } else { dst = Vb; ld = KVW; cbase = 0; }
        const bool dorope = !isctx && u.pn < 5; const int axis = wc & 1;
        const LAS float* bp = T + 2048 + u.pn * 256 + wc * 32 + 4 * fq;
        f32x4 bv[2][2];
#pragma unroll
        for (int bj = 0; bj < 2; ++bj)
#pragma unroll
            for (int n = 0; n < 2; ++n) bv[bj][n] = *(const LAS f32x4*)(bp + bj * 128 + n * 16);
#pragma unroll
        for (int ai = 0; ai < 2; ++ai)
#pragma unroll
            for (int m = 0; m < 4; ++m) { const int r = ai * 128 + wr * 64 + m * 16 + fr; const int pos = pos0 + r; const int id = axis ? (pos & 63) : (pos >> 6);
                f32x4 cs = (f32x4){1.f, 1.f, 1.f, 1.f}, sn = (f32x4){0.f, 0.f, 0.f, 0.f};
                if (dorope) { cs = *(const LAS f32x4*)(T + id * 16 + 4 * fq); sn = *(const LAS f32x4*)(T + 1024 + id * 16 + 4 * fq); }
                GAS bf16_t* rowp = (GAS bf16_t*)(dst + (size_t)(u.pm * 256 + r) * ld + cbase + wc * 32 + 4 * fq);
#pragma unroll
                for (int bj = 0; bj < 2; ++bj) { const f32x4 x0 = (acc[ai][bj][m][0] + bv[bj][0]) * sc, x1 = (acc[ai][bj][m][1] + bv[bj][1]) * sc;
                    const f32x4 o0 = x0 * cs - x1 * sn, o1 = x1 * cs + x0 * sn;
                    u32x2 w0, w1; w0.x = pg8::cvt_pk_bf16(o0[0], o0[1]); w0.y = pg8::cvt_pk_bf16(o0[2], o0[3]); w1.x = pg8::cvt_pk_bf16(o1[0], o1[1]); w1.y = pg8::cvt_pk_bf16(o1[2], o1[3]);
                    *(GAS u32x2*)(rowp + bj * 128) = w0; *(GAS u32x2*)(rowp + bj * 128 + 16) = w1; } }
    }
};

struct EpiNull {
    static constexpr bool PERM = false;
    __device__ __forceinline__ void operator()(const f32x4 (&acc)[2][2][4][2], const pg8::Unit& u, int wr, int wc, int fr, int fq) const {
#pragma unroll
        for (int ai = 0; ai < 2; ++ai)
#pragma unroll
            for (int bj = 0; bj < 2; ++bj)
#pragma unroll
                for (int m = 0; m < 4; ++m)
#pragma unroll
                    for (int n = 0; n < 2; ++n) asm volatile("" :: "v"(acc[ai][bj][m][n]));
    }
};
template <int MODE> struct EpiProbe {
    static constexpr bool PERM = false;
    unsigned char* ws; float* out; float* scratch;
    __device__ __forceinline__ void operator()(const f32x4 (&acc)[2][2][4][2], const pg8::Unit& u, int wr, int wc, int fr, int fq) const {
        const int b = u.pm / 17, j = u.pm - b * 17;
        const GAS char* pbase = MODE == 1 ? (const GAS char*)(j == 0 ? (float*)(ws + WS_CX) + (size_t)(b * NCTX) * DM : out + (size_t)(b * SEQ + (j - 1) * 256) * DM) : (const GAS char*)(scratch + (size_t)(u.pm & 255) * 256 * DM);
        unsigned lo = (unsigned)(((wr * 64 + fr) * DM + u.pn * 256 + wc * 32 + 4 * fq) * 4); asm volatile("" : "+v"(lo));
#define RES_PTR(ai, m, bj, n) ((GAS f32x4*)(pbase + (size_t)((ai) * 128 + (m) * 16) * DM * 4 + lo + ((bj) * 128 + (n) * 16) * 4))
#pragma unroll
        for (int bj = 0; bj < 2; ++bj)
#pragma unroll
            for (int ai = 0; ai < 2; ++ai) {
                f32x4 o[4][2];
#pragma unroll
                for (int m = 0; m < 4; ++m)
#pragma unroll
                    for (int n = 0; n < 2; ++n) { if (MODE == 1) o[m][n] = *RES_PTR(ai, m, bj, n); else *RES_PTR(ai, m, bj, n) = acc[ai][bj][m][n]; }
                if (MODE == 1) {
#pragma unroll
                    for (int m = 0; m < 4; ++m)
#pragma unroll
                        for (int n = 0; n < 2; ++n) asm volatile("" :: "v"(o[m][n]), "v"(acc[ai][bj][m][n]));
                }
                asm volatile("" ::: "memory");
            }
#undef RES_PTR
    }
};
struct MoeOrder {
    pg8::StaticOrder so; int cs; int pp[9]; int cnt[8]; const int* rlist; size_t bstride; bool GATHER_A;
    __device__ __forceinline__ void locate(int pm, int& e, int& p, int& cn) const { const int gp = cs + pm; e = 0; int pbase = 0; cn = cnt[0];
#pragma unroll
        for (int k = 1; k < 8; ++k) { const bool ge = gp >= pp[k]; e += ge ? 1 : 0; pbase = ge ? pp[k] : pbase; cn = ge ? cnt[k] : cn; }
        p = gp - pbase; }
    __device__ bool next(int i, pg8::Unit& u) const { return so.next(i, u); }
    __device__ __forceinline__ const char* a_base(const pg8::Gemm& g, const pg8::Unit& u) const { return GATHER_A ? (const char*)g.A : (const char*)g.A + (size_t)u.pm * (size_t)(256 * 2) * g.lda; }
    __device__ __forceinline__ const char* b_base(const pg8::Gemm& g, const pg8::Unit& u) const { int e, p, cn; locate(u.pm, e, p, cn); return (const char*)g.Bt + (size_t)e * bstride + (size_t)u.pn * (size_t)(256 * 2) * g.K; }
    __device__ __forceinline__ unsigned row_off(const pg8::Gemm& g, const pg8::Unit& u, int r) const {
        if (!GATHER_A) return (unsigned)r * (unsigned)g.lda * 2u;
        int e, p, cn; locate(u.pm, e, p, cn); const int idx = p * 256 + r; const int tok = idx < cn ? (rlist[(size_t)e * MROWS + idx] >> 1) : 0; return (unsigned)tok * (unsigned)g.lda * 2u; }
};
struct EpiMoeDown {
    static constexpr bool PERM = true;
    MoeOrder mo; bf16_t* EO; const float* GATE;
    __device__ __forceinline__ void operator()(const f32x4 (&acc)[2][2][4][2], const pg8::Unit& u, int wr, int wc, int fr, int fq) const {
        int e, p, cn; mo.locate(u.pm, e, p, cn); const int* rl = mo.rlist + (size_t)e * MROWS + p * 256;
        const int col0 = u.pn * 256 + wc * 32 + 8 * fq;
#pragma unroll
        for (int ai = 0; ai < 2; ++ai)
#pragma unroll
            for (int m = 0; m < 4; ++m) { const int r = ai * 128 + wr * 64 + m * 16 + fr;
                if (p * 256 + r < cn) { const int ent = rl[r]; const float gt = GATE[ent]; bf16_t* dp = EO + (size_t)ent * DM + col0;
#pragma unroll
                    for (int bj = 0; bj < 2; ++bj) { const f32x4 v0 = acc[ai][bj][m][0] * gt, v1 = acc[ai][bj][m][1] * gt; u32x4 w; w.x = pg8::cvt_pk_bf16(v0[0], v0[1]); w.y = pg8::cvt_pk_bf16(v0[2], v0[3]); w.z = pg8::cvt_pk_bf16(v1[0], v1[1]); w.w = pg8::cvt_pk_bf16(v1[2], v1[3]);
                        *(GAS u32x4*)(dp + bj * 128) = w; } } }
    }
};

typedef __bf16 bf16x2_t __attribute__((ext_vector_type(2)));
typedef short v4i16_t __attribute__((ext_vector_type(4)));
__device__ __forceinline__ unsigned cvtpk(float lo, float hi) { f32x2 v = {lo, hi}; bf16x2_t b = __builtin_convertvector(v, bf16x2_t); return __builtin_bit_cast(unsigned, b); }
__device__ __forceinline__ int crow(int r, int hi) { return (r & 3) + 8 * (r >> 2) + 4 * hi; }
__device__ __forceinline__ s16x4 vtr(const LAS unsigned char* p) { return __builtin_bit_cast(s16x4, __builtin_amdgcn_ds_read_tr16_b64_v4i16((LAS v4i16_t*)p)); }
#define MFMA32(a, b, c) __builtin_amdgcn_mfma_f32_32x32x16_bf16((a), (b), (c), 0, 0, 0)
__device__ __forceinline__ void conv_phase(Frame& F, const Args& A, int j) {
    phase_enter(F);
    bf16_t* XBC = (bf16_t*)(F.ws + WS_BIG); const bf16_t* HALO = (const bf16_t*)(F.ws + WS_HALO);
    const int lane = F.lane;
    const int gw = blockIdx.x * NWAVES + F.wave, NGW = F.G * NWAVES;
    for (int task = gw; task < NPAN * 32; task += NGW) {
        const int pm = task >> 5, q = (task >> 3) & 3, sl = task & 7, jj = pm % 17, c0 = sl * 512 + lane * 8;
        const bool top_zero = q == 0 && jj <= 1, bot_zero = q == 3 && (jj == 0 || jj == 16);
        const GAS bf16_t* htop = (const GAS bf16_t*)(HALO + (q == 0 ? ((size_t)(pm - 1) * 16 + 14) : ((size_t)pm * 16 + 4 * q - 2)) * CONVCH + c0);
        const GAS bf16_t* hbot = (const GAS bf16_t*)(HALO + (q == 3 ? ((size_t)(pm + 1) * 16 + 0) : ((size_t)pm * 16 + 4 * q + 4)) * CONVCH + c0);
        f32x2 cw[5][4], cbias[4];
#pragma unroll
        for (int k = 0; k < 5; ++k) { const f32x4 a0 = *(const GAS f32x4*)(A.ssd_conv_w + (size_t)(j * 5 + k) * CONVCH + c0), a1 = *(const GAS f32x4*)(A.ssd_conv_w + (size_t)(j * 5 + k) * CONVCH + c0 + 4);
            cw[k][0] = (f32x2){a0.x, a0.y}; cw[k][1] = (f32x2){a0.z, a0.w}; cw[k][2] = (f32x2){a1.x, a1.y}; cw[k][3] = (f32x2){a1.z, a1.w}; }
        { const f32x4 a0 = *(const GAS f32x4*)(A.ssd_conv_b + (size_t)j * CONVCH + c0), a1 = *(const GAS f32x4*)(A.ssd_conv_b + (size_t)j * CONVCH + c0 + 4);
            cbias[0] = (f32x2){a0.x, a0.y}; cbias[1] = (f32x2){a0.z, a0.w}; cbias[2] = (f32x2){a1.x, a1.y}; cbias[3] = (f32x2){a1.z, a1.w}; }
        GAS bf16_t* base = (GAS bf16_t*)(XBC + ((size_t)pm * 256 + q * 64) * CONVCH + c0);
        const u32x4 zero4 = (u32x4){0u, 0u, 0u, 0u};
        u32x4 win[12], pre[8];
        win[0] = top_zero ? zero4 : *(const GAS u32x4*)(htop);
        win[1] = top_zero ? zero4 : *(const GAS u32x4*)(htop + CONVCH);
#pragma unroll
        for (int r = 0; r < 10; ++r) win[2 + r] = *(const GAS u32x4*)(base + (size_t)r * CONVCH);
        for (int k = 0; k < 8; ++k) {
            if (k < 6) {
#pragma unroll
                for (int r = 0; r < 8; ++r) pre[r] = *(const GAS u32x4*)(base + (size_t)(8 * k + 10 + r) * CONVCH);
            } else if (k == 6) {
#pragma unroll
                for (int r = 0; r < 6; ++r) pre[r] = *(const GAS u32x4*)(base + (size_t)(58 + r) * CONVCH);
                pre[6] = bot_zero ? zero4 : *(const GAS u32x4*)(hbot);
                pre[7] = bot_zero ? zero4 : *(const GAS u32x4*)(hbot + CONVCH);
            }
#pragma unroll
            for (int o = 0; o < 8; ++o) {
                f32x2 r[4];
#pragma unroll
                for (int c = 0; c < 4; ++c) r[c] = cbias[c];
#pragma unroll
                for (int t = 0; t < 5; ++t) { const u32x4 w = win[o + t];
                    r[0] += cw[t][0] * (f32x2){bf_lo(w.x), bf_hi(w.x)}; r[1] += cw[t][1] * (f32x2){bf_lo(w.y), bf_hi(w.y)};
                    r[2] += cw[t][2] * (f32x2){bf_lo(w.z), bf_hi(w.z)}; r[3] += cw[t][3] * (f32x2){bf_lo(w.w), bf_hi(w.w)}; }
                u32x4 w; w.x = cvtpk(siluf(r[0].x), siluf(r[0].y)); w.y = cvtpk(siluf(r[1].x), siluf(r[1].y)); w.z = cvtpk(siluf(r[2].x), siluf(r[2].y)); w.w = cvtpk(siluf(r[3].x), siluf(r[3].y));
                *(GAS u32x4*)(base + (size_t)(8 * k + o) * CONVCH) = w;
            }
#pragma unroll
            for (int r = 0; r < 4; ++r) win[r] = win[8 + r];
#pragma unroll
            for (int r = 0; r < 8; ++r) win[4 + r] = pre[r];
        }
    }
}

constexpr int SC_RS = 272;
constexpr int SC_TILE = 3 * 32 * SC_RS;
constexpr int SC_YS = 2 * SC_TILE;
constexpr int SC_WS = SC_YS + 16384;
constexpr int SC_RAW = 73728;
static_assert(SC_WS + 4096 <= SC_RAW && SC_RAW + 2 * 36 * 1024 <= LDSCTL_OFF, "scan LDS map");
template <int PH>
__device__ __forceinline__ void scan_phase(Frame& F, const Args& A, int j) {
    phase_enter(F);
    const bf16_t* XBC = (const bf16_t*)(F.ws + WS_BIG); const float* DT = (const float*)(F.ws + WS_DT); bf16_t* Y = (bf16_t*)(F.ws + WS_Y);
    const int lane = F.lane, wave = F.wave;
    for (int u0 = blockIdx.x; u0 < 256; u0 += F.G) {
        const int unit = (F.G == 256) ? ((u0 & 7) * 32 + (u0 >> 3)) : u0;
        const int b = unit >> 4, g = (unit >> 1) & 7, ph = unit & 1;
        const int srow = F.tid >> 4, sch = F.tid & 15;
        const int gcolB = 2048 + g * 128 + sch * 8, gcolC = 3072 + g * 128 + sch * 8, gcolX = g * 256 + (sch >> 2) * 64 + ph * 32 + (sch & 3) * 8;
        const int hh = wave >> 1, dir = wave & 1, c31 = lane & 31, hl = lane >> 5;
        const int trq = (lane & 15) >> 2, trp = lane & 3, trb = (lane >> 4) & 1;
        const int head = g * 4 + hh;
        const float Dk = A.ssd_d[(j * 2 + dir) * 32 + head], dtb = A.ssd_dt_bias[(j * 2 + dir) * 32 + head], aneg = -expf(A.ssd_a_log[(j * 2 + dir) * 32 + head]);
        LAS float* wsf = (LAS float*)(F.lds + SC_WS + wave * 512);
        int offRow = dir * SC_TILE + c31 * SC_RS + 16 * hl;
        int offC4 = dir * SC_TILE + 32 * SC_RS + c31 * SC_RS + 8 * hl;
        int offTrX = dir * SC_TILE + 64 * SC_RS + trq * SC_RS + (hh * 32 + 16 * trb + 4 * trp) * 2;
        int offTrB = dir * SC_TILE + trq * SC_RS + (16 * trb + 4 * trp) * 2;
        int ysoff = (4 * hl) * 128 + hh * 32 + c31;
        asm volatile("" : "+v"(offRow), "+v"(offC4), "+v"(offTrX), "+v"(offTrB), "+v"(ysoff));
        f32x16 ST[4];
#pragma unroll
        for (int t = 0; t < 4; ++t)
#pragma unroll
            for (int e = 0; e < 16; ++e) ST[t][e] = 0.f;
#define SC_PF(pf, st_) do { const int st = (PH >= 2) ? 0 : (st_); const int cf_ = (st), cb_ = (st) < 8 ? 7 - (st) : 143 - (st); \
            _Pragma("unroll") for (int T = 0; T < 2; ++T) { const GAS bf16_t* rp = (const GAS bf16_t*)(XBC + (size_t)(b * SROW + (T ? cb_ : cf_) * 32 + srow) * CONVCH); \
                pf[T][0] = *(const GAS u32x4*)(rp + gcolB); pf[T][1] = *(const GAS u32x4*)(rp + gcolC); pf[T][2] = *(const GAS u32x4*)(rp + gcolX); } } while (0)
#define SC_DTLOAD(st) DT[(size_t)(b * SROW + (dir ? ((st) < 8 ? 7 - (st) : 143 - (st)) : (st)) * 32 + c31) * 64 + dir * 32 + head]
#define SC_WRITEOUT(st) do { const int cf_ = (st), cb_ = (st) < 8 ? 7 - (st) : 143 - (st); \
            _Pragma("unroll") for (int T = 0; T < 2; ++T) { const int tok = F.tid >> 4, h4 = (F.tid >> 2) & 3, q4 = F.tid & 3, chunk = T ? cb_ : cf_; \
                const int other = T == 0 ? (chunk < 8 ? 7 - chunk : 143 - chunk) : chunk; \
                u32x4 v = *(const LAS u32x4*)(F.lds + SC_YS + T * 8192 + (tok * 128 + h4 * 32 + q4 * 8) * 2); \
                bf16_t* yp = Y + (size_t)(b * SROW + chunk * 32 + tok) * DIN + g * 256 + ph * 128 + h4 * 32 + q4 * 8; \
                if ((st) > other) { const u32x4 o = oldy[T]; \
                    v.x = pk2(bf_lo(o.x) + bf_lo(v.x), bf_hi(o.x) + bf_hi(v.x)); v.y = pk2(bf_lo(o.y) + bf_lo(v.y), bf_hi(o.y) + bf_hi(v.y)); \
                    v.z = pk2(bf_lo(o.z) + bf_lo(v.z), bf_hi(o.z) + bf_hi(v.z)); v.w = pk2(bf_lo(o.w) + bf_lo(v.w), bf_hi(o.w) + bf_hi(v.w)); } \
                if (PH == 0) *(u32x4*)yp = v; else asm volatile("" :: "v"(v)); } } while (0)
        u32x4 pfE[2][3], pfO[2][3];
        SC_PF(pfE, 0); SC_PF(pfO, 1);
        float dtraw = SC_DTLOAD(0);
        u32x4 oldy[2] = {(u32x4){0u, 0u, 0u, 0u}, (u32x4){0u, 0u, 0u, 0u}};
        for (int step2 = 0; step2 < 136; step2 += 2) {
          { const int step = step2;
            const int cf = step, cbk = step < 8 ? 7 - step : 143 - step;
            __syncthreads();
            if (step > 0) SC_WRITEOUT(step - 1);
#pragma unroll
            for (int T = 0; T < 2; ++T)
#pragma unroll
                for (int a = 0; a < 3; ++a) *(LAS u32x4*)(F.lds + T * SC_TILE + a * (32 * SC_RS) + srow * SC_RS + sch * 16) = pfE[T][a];
            {
                const float xb = dtraw + dtb;
                const float dt = xb > 20.f ? xb : log1pf(__expf(xb)); const float dA = dt * aneg;
                float v = dA;
                v += __builtin_bit_cast(float, __builtin_amdgcn_update_dpp(0, __builtin_bit_cast(int, v), 0x111, 0xf, 0xf, true));
                v += __builtin_bit_cast(float, __builtin_amdgcn_update_dpp(0, __builtin_bit_cast(int, v), 0x112, 0xf, 0xf, true));
                v += __builtin_bit_cast(float, __builtin_amdgcn_update_dpp(0, __builtin_bit_cast(int, v), 0x114, 0xf, 0xf, true));
                v += __builtin_bit_cast(float, __builtin_amdgcn_update_dpp(0, __builtin_bit_cast(int, v), 0x118, 0xf, 0xf, true));
                v += __builtin_bit_cast(float, __builtin_amdgcn_update_dpp(0, __builtin_bit_cast(int, v), 0x142, 0xa, 0xf, false));
                const float tot = __builtin_bit_cast(float, __builtin_amdgcn_readlane(__builtin_bit_cast(int, v), 31));
                const float cum = dir ? (tot - v + dA) : v;
                if (hl == 0) { wsf[c31] = cum; wsf[32 + c31] = dt; wsf[64 + c31] = __expf(tot - cum) * dt; wsf[96 + c31] = __expf(cum); }
            }
            asm volatile("s_waitcnt lgkmcnt(0)" ::: "memory"); __builtin_amdgcn_s_barrier(); asm volatile("" ::: "memory");
            if (step + 2 < 136) SC_PF(pfE, step + 2); if (step + 1 < 136) dtraw = SC_DTLOAD(step + 1);
#pragma unroll
            for (int T = 0; T < 2; ++T) {
                const int tok = F.tid >> 4, h4 = (F.tid >> 2) & 3, q4 = F.tid & 3, chunk = T ? cbk : cf;
                const int other = T == 0 ? (chunk < 8 ? 7 - chunk : 143 - chunk) : chunk;
                if (PH == 0 && step > other) oldy[T] = *(const u32x4*)(Y + (size_t)(b * SROW + chunk * 32 + tok) * DIN + g * 256 + ph * 128 + h4 * 32 + q4 * 8);
            }
            if (PH < 3) {
                const LAS unsigned char* Bs = F.lds + dir * SC_TILE; const LAS unsigned char* Cs = Bs + 32 * SC_RS; const LAS unsigned char* xs = Bs + 64 * SC_RS;
                f32x16 gt;
#pragma unroll
                for (int e = 0; e < 16; ++e) gt[e] = 0.f;
#pragma unroll
                for (int s = 0; s < 8; ++s) { const bf16x8 a = *(const LAS bf16x8*)(F.lds + offRow + 32 * s), bb = *(const LAS bf16x8*)(F.lds + offRow + 32 * SC_RS + 32 * s); gt = MFMA32(a, bb, gt); }
                const float cum_i = wsf[c31];
                bf16x8 mk[2];
                {
                    float mv[16];
#pragma unroll
                    for (int q = 0; q < 4; ++q) { const f32x4 cj = *(const LAS f32x4*)(wsf + 8 * q + 4 * hl), dj = *(const LAS f32x4*)(wsf + 32 + 8 * q + 4 * hl);
#pragma unroll
                        for (int z = 0; z < 4; ++z) { const int jj = 8 * q + 4 * hl + z; const bool ok = dir ? (jj >= c31) : (jj <= c31);
                            float val = gt[4 * q + z] * __expf(ok ? (cum_i - cj[z]) : -INFINITY) * dj[z]; if (jj == c31) val += Dk; mv[4 * q + z] = val; } }
#pragma unroll
                    for (int s2 = 0; s2 < 2; ++s2) { u32x4 w; w.x = cvtpk(mv[8 * s2], mv[8 * s2 + 1]); w.y = cvtpk(mv[8 * s2 + 2], mv[8 * s2 + 3]); w.z = cvtpk(mv[8 * s2 + 4], mv[8 * s2 + 5]); w.w = cvtpk(mv[8 * s2 + 6], mv[8 * s2 + 7]); mk[s2] = __builtin_bit_cast(bf16x8, w); }
                }
                f32x16 ya;
#pragma unroll
                for (int e = 0; e < 16; ++e) ya[e] = 0.f;
#pragma unroll
                for (int t = 0; t < 4; ++t)
#pragma unroll
                    for (int s2 = 0; s2 < 2; ++s2) {
                        const LAS unsigned char* cp = F.lds + offC4 + 64 * t + 32 * s2;
                        const u32x2 c0 = *(const LAS u32x2*)cp, c1 = *(const LAS u32x2*)(cp + 16);
                        const bf16x8 ca = __builtin_bit_cast(bf16x8, (u32x4){c0.x, c0.y, c1.x, c1.y});
                        u32x4 w; w.x = cvtpk(ST[t][8 * s2], ST[t][8 * s2 + 1]); w.y = cvtpk(ST[t][8 * s2 + 2], ST[t][8 * s2 + 3]); w.z = cvtpk(ST[t][8 * s2 + 4], ST[t][8 * s2 + 5]); w.w = cvtpk(ST[t][8 * s2 + 6], ST[t][8 * s2 + 7]);
                        ya = MFMA32(ca, __builtin_bit_cast(bf16x8, w), ya);
                    }
#pragma unroll
                for (int q = 0; q < 4; ++q) { const f32x4 ec = *(const LAS f32x4*)(wsf + 96 + 8 * q + 4 * hl); ya[4 * q] *= ec.x; ya[4 * q + 1] *= ec.y; ya[4 * q + 2] *= ec.z; ya[4 * q + 3] *= ec.w; }
#pragma unroll
                for (int s2 = 0; s2 < 2; ++s2) {
                    const LAS unsigned char* xp = F.lds + offTrX + (16 * s2) * SC_RS + hl * (4 * SC_RS);
                    const s16x4 lo = vtr(xp), hi = vtr(xp + 8 * SC_RS);
                    ya = MFMA32(mk[s2], ((bf16x8){lo[0], lo[1], lo[2], lo[3], hi[0], hi[1], hi[2], hi[3]}), ya);
                }
                {
                    const float etot = dir ? wsf[96] : wsf[96 + 31];
#pragma unroll
                    for (int t = 0; t < 4; ++t)
#pragma unroll
                        for (int e = 0; e < 16; ++e) ST[t][e] *= etot;
#pragma unroll
                    for (int s2 = 0; s2 < 2; ++s2) {
                        const LAS unsigned char* xp = F.lds + offTrX + (16 * s2) * SC_RS + hl * (8 * SC_RS);
                        const s16x4 lo = vtr(xp), hi = vtr(xp + 4 * SC_RS);
                        const f32x4 w0 = *(const LAS f32x4*)(wsf + 64 + 16 * s2 + 8 * hl), w1 = *(const LAS f32x4*)(wsf + 64 + 16 * s2 + 8 * hl + 4);
                        u32x4 xw; xw.x = cvtpk(bf1((bf16_t)lo[0]) * w0.x, bf1((bf16_t)lo[1]) * w0.y); xw.y = cvtpk(bf1((bf16_t)lo[2]) * w0.z, bf1((bf16_t)lo[3]) * w0.w);
                        xw.z = cvtpk(bf1((bf16_t)hi[0]) * w1.x, bf1((bf16_t)hi[1]) * w1.y); xw.w = cvtpk(bf1((bf16_t)hi[2]) * w1.z, bf1((bf16_t)hi[3]) * w1.w);
                        const bf16x8 xb8 = __builtin_bit_cast(bf16x8, xw);
#pragma unroll
                        for (int t = 0; t < 4; ++t) {
                            const LAS unsigned char* bp = F.lds + offTrB + (16 * s2) * SC_RS + hl * (8 * SC_RS) + 64 * t;
                            const s16x4 blo = vtr(bp), bhi = vtr(bp + 4 * SC_RS);
                            ST[t] = MFMA32(((bf16x8){blo[0], blo[1], blo[2], blo[3], bhi[0], bhi[1], bhi[2], bhi[3]}), xb8, ST[t]);
                        }
                    }
                }
                LAS bf16_t* ys = (LAS bf16_t*)(F.lds + SC_YS + dir * 8192) + ysoff;
#pragma unroll
                for (int e = 0; e < 16; e += 2) { const unsigned w = cvtpk(ya[e], ya[e + 1]); ys[((e & 3) + 8 * (e >> 2)) * 128] = (bf16_t)w; ys[((e & 3) + 1 + 8 * (e >> 2)) * 128] = (bf16_t)(w >> 16); }
            }
                  }
          { const int step = step2 + 1;
            const int cf = step, cbk = step < 8 ? 7 - step : 143 - step;
            __syncthreads();
            if (step > 0) SC_WRITEOUT(step - 1);
#pragma unroll
            for (int T = 0; T < 2; ++T)
#pragma unroll
                for (int a = 0; a < 3; ++a) *(LAS u32x4*)(F.lds + T * SC_TILE + a * (32 * SC_RS) + srow * SC_RS + sch * 16) = pfO[T][a];
            {
                const float xb = dtraw + dtb;
                const float dt = xb > 20.f ? xb : log1pf(__expf(xb)); const float dA = dt * aneg;
                float v = dA;
                v += __builtin_bit_cast(float, __builtin_amdgcn_update_dpp(0, __builtin_bit_cast(int, v), 0x111, 0xf, 0xf, true));
                v += __builtin_bit_cast(float, __builtin_amdgcn_update_dpp(0, __builtin_bit_cast(int, v), 0x112, 0xf, 0xf, true));
                v += __builtin_bit_cast(float, __builtin_amdgcn_update_dpp(0, __builtin_bit_cast(int, v), 0x114, 0xf, 0xf, true));
                v += __builtin_bit_cast(float, __builtin_amdgcn_update_dpp(0, __builtin_bit_cast(int, v), 0x118, 0xf, 0xf, true));
                v += __builtin_bit_cast(float, __builtin_amdgcn_update_dpp(0, __builtin_bit_cast(int, v), 0x142, 0xa, 0xf, false));
                const float tot = __builtin_bit_cast(float, __builtin_amdgcn_readlane(__builtin_bit_cast(int, v), 31));
                const float cum = dir ? (tot - v + dA) : v;
                if (hl == 0) { wsf[c31] = cum; wsf[32 + c31] = dt; wsf[64 + c31] = __expf(tot - cum) * dt; wsf[96 + c31] = __expf(cum); }
            }
            asm volatile("s_waitcnt lgkmcnt(0)" ::: "memory"); __builtin_amdgcn_s_barrier(); asm volatile("" ::: "memory");
            if (step + 2 < 136) SC_PF(pfO, step + 2); if (step + 1 < 136) dtraw = SC_DTLOAD(step + 1);
#pragma unroll
            for (int T = 0; T < 2; ++T) {
                const int tok = F.tid >> 4, h4 = (F.tid >> 2) & 3, q4 = F.tid & 3, chunk = T ? cbk : cf;
                const int other = T == 0 ? (chunk < 8 ? 7 - chunk : 143 - chunk) : chunk;
                if (PH == 0 && step > other) oldy[T] = *(const u32x4*)(Y + (size_t)(b * SROW + chunk * 32 + tok) * DIN + g * 256 + ph * 128 + h4 * 32 + q4 * 8);
            }
            if (PH < 3) {
                const LAS unsigned char* Bs = F.lds + dir * SC_TILE; const LAS unsigned char* Cs = Bs + 32 * SC_RS; const LAS unsigned char* xs = Bs + 64 * SC_RS;
                f32x16 gt;
#pragma unroll
                for (int e = 0; e < 16; ++e) gt[e] = 0.f;
#pragma unroll
                for (int s = 0; s < 8; ++s) { const bf16x8 a = *(const LAS bf16x8*)(F.lds + offRow + 32 * s), bb = *(const LAS bf16x8*)(F.lds + offRow + 32 * SC_RS + 32 * s); gt = MFMA32(a, bb, gt); }
                const float cum_i = wsf[c31];
                bf16x8 mk[2];
                {
                    float mv[16];
#pragma unroll
                    for (int q = 0; q < 4; ++q) { const f32x4 cj = *(const LAS f32x4*)(wsf + 8 * q + 4 * hl), dj = *(const LAS f32x4*)(wsf + 32 + 8 * q + 4 * hl);
#pragma unroll
                        for (int z = 0; z < 4; ++z) { const int jj = 8 * q + 4 * hl + z; const bool ok = dir ? (jj >= c31) : (jj <= c31);
                            float val = gt[4 * q + z] * __expf(ok ? (cum_i - cj[z]) : -INFINITY) * dj[z]; if (jj == c31) val += Dk; mv[4 * q + z] = val; } }
#pragma unroll
                    for (int s2 = 0; s2 < 2; ++s2) { u32x4 w; w.x = cvtpk(mv[8 * s2], mv[8 * s2 + 1]); w.y = cvtpk(mv[8 * s2 + 2], mv[8 * s2 + 3]); w.z = cvtpk(mv[8 * s2 + 4], mv[8 * s2 + 5]); w.w = cvtpk(mv[8 * s2 + 6], mv[8 * s2 + 7]); mk[s2] = __builtin_bit_cast(bf16x8, w); }
                }
                f32x16 ya;
#pragma unroll
                for (int e = 0; e < 16; ++e) ya[e] = 0.f;
#pragma unroll
                for (int t = 0; t < 4; ++t)
#pragma unroll
                    for (int s2 = 0; s2 < 2; ++s2) {
                        const LAS unsigned char* cp = F.lds + offC4 + 64 * t + 32 * s2;
                        const u32x2 c0 = *(const LAS u32x2*)cp, c1 = *(const LAS u32x2*)(cp + 16);
                        const bf16x8 ca = __builtin_bit_cast(bf16x8, (u32x4){c0.x, c0.y, c1.x, c1.y});
                        u32x4 w; w.x = cvtpk(ST[t][8 * s2], ST[t][8 * s2 + 1]); w.y = cvtpk(ST[t][8 * s2 + 2], ST[t][8 * s2 + 3]); w.z = cvtpk(ST[t][8 * s2 + 4], ST[t][8 * s2 + 5]); w.w = cvtpk(ST[t][8 * s2 + 6], ST[t][8 * s2 + 7]);
                        ya = MFMA32(ca, __builtin_bit_cast(bf16x8, w), ya);
                    }
#pragma unroll
                for (int q = 0; q < 4; ++q) { const f32x4 ec = *(const LAS f32x4*)(wsf + 96 + 8 * q + 4 * hl); ya[4 * q] *= ec.x; ya[4 * q + 1] *= ec.y; ya[4 * q + 2] *= ec.z; ya[4 * q + 3] *= ec.w; }
#pragma unroll
                for (int s2 = 0; s2 < 2; ++s2) {
                    const LAS unsigned char* xp = F.lds + offTrX + (16 * s2) * SC_RS + hl * (4 * SC_RS);
                    const s16x4 lo = vtr(xp), hi = vtr(xp + 8 * SC_RS);
                    ya = MFMA32(mk[s2], ((bf16x8){lo[0], lo[1], lo[2], lo[3], hi[0], hi[1], hi[2], hi[3]}), ya);
                }
                {
                    const float etot = dir ? wsf[96] : wsf[96 + 31];
#pragma unroll
                    for (int t = 0; t < 4; ++t)
#pragma unroll
                        for (int e = 0; e < 16; ++e) ST[t][e] *= etot;
#pragma unroll
                    for (int s2 = 0; s2 < 2; ++s2) {
                        const LAS unsigned char* xp = F.lds + offTrX + (16 * s2) * SC_RS + hl * (8 * SC_RS);
                        const s16x4 lo = vtr(xp), hi = vtr(xp + 4 * SC_RS);
                        const f32x4 w0 = *(const LAS f32x4*)(wsf + 64 + 16 * s2 + 8 * hl), w1 = *(const LAS f32x4*)(wsf + 64 + 16 * s2 + 8 * hl + 4);
                        u32x4 xw; xw.x = cvtpk(bf1((bf16_t)lo[0]) * w0.x, bf1((bf16_t)lo[1]) * w0.y); xw.y = cvtpk(bf1((bf16_t)lo[2]) * w0.z, bf1((bf16_t)lo[3]) * w0.w);
                        xw.z = cvtpk(bf1((bf16_t)hi[0]) * w1.x, bf1((bf16_t)hi[1]) * w1.y); xw.w = cvtpk(bf1((bf16_t)hi[2]) * w1.z, bf1((bf16_t)hi[3]) * w1.w);
                        const bf16x8 xb8 = __builtin_bit_cast(bf16x8, xw);
#pragma unroll
                        for (int t = 0; t < 4; ++t) {
                            const LAS unsigned char* bp = F.lds + offTrB + (16 * s2) * SC_RS + hl * (8 * SC_RS) + 64 * t;
                            const s16x4 blo = vtr(bp), bhi = vtr(bp + 4 * SC_RS);
                            ST[t] = MFMA32(((bf16x8){blo[0], blo[1], blo[2], blo[3], bhi[0], bhi[1], bhi[2], bhi[3]}), xb8, ST[t]);
                        }
                    }
                }
                LAS bf16_t* ys = (LAS bf16_t*)(F.lds + SC_YS + dir * 8192) + ysoff;
#pragma unroll
                for (int e = 0; e < 16; e += 2) { const unsigned w = cvtpk(ya[e], ya[e + 1]); ys[((e & 3) + 8 * (e >> 2)) * 128] = (bf16_t)w; ys[((e & 3) + 1 + 8 * (e >> 2)) * 128] = (bf16_t)(w >> 16); }
            }
                  }
        }
        VM_WAIT(); __syncthreads();
        SC_WRITEOUT(135);
#undef SC_PF
#undef SC_DTLOAD
#undef SC_WRITEOUT
        __syncthreads();
    }
}

__device__ __forceinline__ void attn_phase(Frame& F, const Args& A, int ja, bool need_ctx, int nwg) {
    phase_enter(F);
    const bf16_t* Q = (const bf16_t*)(F.ws + WS_BIG); bf16_t* O = (bf16_t*)(F.ws + WS_H);     const bf16_t* Kb = (const bf16_t*)(F.ws + WS_BIG + BIG_K); const bf16_t* Vb = (const bf16_t*)(F.ws + WS_BIG + BIG_V);
    LAS unsigned char* Kl = F.lds; LAS unsigned char* Vl = F.lds + 9216;
    const int nunits = 2048 + (need_ctx ? 128 : 0);
    const int lane = F.lane, r = F.wave >> 1, rh = F.wave & 1, c31 = lane & 31, hl = lane >> 5;
    const int prow = F.tid >> 3, ppc = F.tid & 7;
    const int trq = (lane & 15) >> 2, trp = lane & 3, trb = (lane >> 4) & 1;
    for (int unit = blockIdx.x; unit < nunits; unit += nwg) {
        int b, g, nblk; bool cq;
        if (unit < 2048) { b = unit >> 7; nblk = (unit >> 2) & 31; g = unit & 3; cq = false; } else { const int u2 = unit - 2048; b = u2 >> 3; nblk = (u2 >> 2) & 1; g = u2 & 3; cq = true; }
        const int qrow0 = b * SROW + (cq ? 128 * nblk : NCTX + 128 * nblk);
        const int start = 128 * nblk;
        bf16x8 qf[2][4];
#pragma unroll
        for (int qb = 0; qb < 2; ++qb)
#pragma unroll
            for (int s = 0; s < 4; ++s) qf[qb][s] = *(const bf16x8*)(Q + (size_t)(qrow0 + 64 * rh + 32 * qb + c31) * QW + g * 256 + r * 64 + 16 * s + 8 * hl);
        const float sink = A.attn_sink[ja * 16 + g * 4 + r] * 1.4426950408889634f;
        float mrun[2] = {sink, sink}, lrun[2] = {1.f, 1.f};
        f32x16 ot[2][2];
#pragma unroll
        for (int db = 0; db < 2; ++db)
#pragma unroll
            for (int qb = 0; qb < 2; ++qb)
#pragma unroll
                for (int e = 0; e < 16; ++e) ot[db][qb][e] = 0.f;
        const int tt_lo = cq ? 0 : (nblk == 0 ? 2 : 0), tt_hi = cq ? 0 : (nblk == 31 ? 4 : 6);
        const int ntile = 4 + (tt_hi - tt_lo);
#define TILE_ROW0(t) ((t) < 4 ? b * SROW + 64 * (t) : b * SROW + NCTX + start - 128 + 64 * (tt_lo + (t) - 4))
        u32x4 kreg, vreg;
        { const int r0 = TILE_ROW0(0); kreg = *(const u32x4*)(Kb + (size_t)(r0 + prow) * KVW + g * 64 + ppc * 8); vreg = *(const u32x4*)(Vb + (size_t)(r0 + prow) * KVW + g * 64 + ppc * 8); }
        for (int t = 0; t < ntile; ++t) {
            __syncthreads();
            *(LAS u32x4*)(Kl + prow * 144 + ppc * 16) = kreg; *(LAS u32x4*)(Vl + prow * 144 + ppc * 16) = vreg;
            __syncthreads();
            if (t + 1 < ntile) { const int r0 = TILE_ROW0(t + 1); kreg = *(const u32x4*)(Kb + (size_t)(r0 + prow) * KVW + g * 64 + ppc * 8); vreg = *(const u32x4*)(Vb + (size_t)(r0 + prow) * KVW + g * 64 + ppc * 8); }
            const int dk0 = (t >= 4) ? (-128 + 64 * (tt_lo + t - 4)) - 64 * rh : 0;
            const bool tile_empty = (t >= 4) && (dk0 <= -192 || dk0 >= 192);
            const bool tile_mask = (t >= 4) && !tile_empty && (dk0 < -65 || dk0 > 65);
            if (!tile_empty) {
            f32x16 st[2][2];
#pragma unroll
            for (int kb = 0; kb < 2; ++kb) {
#pragma unroll
                for (int qb = 0; qb < 2; ++qb)
#pragma unroll
                    for (int e = 0; e < 16; ++e) st[kb][qb][e] = 0.f;
#pragma unroll
                for (int s = 0; s < 4; ++s) { const bf16x8 a = *(const LAS bf16x8*)(Kl + (32 * kb + c31) * 144 + (16 * s + 8 * hl) * 2);
                    st[kb][0] = MFMA32(a, qf[0][s], st[kb][0]); st[kb][1] = MFMA32(a, qf[1][s], st[kb][1]); }
            }
            if (tile_mask) { const int kpos0 = start - 128 + 64 * (tt_lo + t - 4);
#pragma unroll
                for (int kb = 0; kb < 2; ++kb)
#pragma unroll
                    for (int qb = 0; qb < 2; ++qb) { const int qpos = start + 64 * rh + 32 * qb + c31;
#pragma unroll
                        for (int e = 0; e < 16; ++e) { const int d = qpos - (kpos0 + 32 * kb + crow(e, hl)); if (d > 128 || d < -128) st[kb][qb][e] = -INFINITY; } }
            }
#pragma unroll
            for (int qb = 0; qb < 2; ++qb) {
                float mx = st[0][qb][0];
#pragma unroll
                for (int kb = 0; kb < 2; ++kb)
#pragma unroll
                    for (int e = 0; e < 16; ++e) mx = fmaxf(mx, st[kb][qb][e]);
                mx = fmaxf(mx, shx(mx, 32, lane));
                const float mn = fmaxf(mrun[qb], mx);
                const bool grew = mn > mrun[qb];
                float rs = 0.f;
#pragma unroll
                for (int kb = 0; kb < 2; ++kb)
#pragma unroll
                    for (int e = 0; e < 16; ++e) { const float pv = __builtin_amdgcn_exp2f(st[kb][qb][e] - mn); st[kb][qb][e] = pv; rs += pv; }
                rs += shx(rs, 32, lane);
                if (__any(grew)) {
                    const float alpha = __builtin_amdgcn_exp2f(mrun[qb] - mn);
                    lrun[qb] = lrun[qb] * alpha + rs;
#pragma unroll
                    for (int db = 0; db < 2; ++db)
#pragma unroll
                        for (int e = 0; e < 16; ++e) ot[db][qb][e] *= alpha;
                } else lrun[qb] += rs;
                mrun[qb] = mn;
            }
#pragma unroll
            for (int kb = 0; kb < 2; ++kb)
#pragma unroll
                for (int s2 = 0; s2 < 2; ++s2) {
                    bf16x8 pk[2];
#pragma unroll
                    for (int qb = 0; qb < 2; ++qb) { u32x4 w; w.x = cvtpk(st[kb][qb][8 * s2 + 0], st[kb][qb][8 * s2 + 1]); w.y = cvtpk(st[kb][qb][8 * s2 + 2], st[kb][qb][8 * s2 + 3]);
                        w.z = cvtpk(st[kb][qb][8 * s2 + 4], st[kb][qb][8 * s2 + 5]); w.w = cvtpk(st[kb][qb][8 * s2 + 6], st[kb][qb][8 * s2 + 7]); pk[qb] = __builtin_bit_cast(bf16x8, w); }
#pragma unroll
                    for (int db = 0; db < 2; ++db) {
                        const LAS unsigned char* vp = Vl + (32 * kb + 16 * s2 + 4 * hl + trq) * 144 + (32 * db + 16 * trb + 4 * trp) * 2;
                        const s16x4 lo = vtr(vp), hi = vtr(vp + 8 * 144);
                        const bf16x8 va = (bf16x8){lo[0], lo[1], lo[2], lo[3], hi[0], hi[1], hi[2], hi[3]};
                        ot[db][0] = MFMA32(va, pk[0], ot[db][0]); ot[db][1] = MFMA32(va, pk[1], ot[db][1]);
                    }
                }
            }
        }
#undef TILE_ROW0
#pragma unroll
        for (int qb = 0; qb < 2; ++qb) { const float inv = 1.0f / lrun[qb]; bf16_t* op = O + (size_t)(qrow0 + 64 * rh + 32 * qb + c31) * QW + g * 256 + r * 64;
#pragma unroll
            for (int db = 0; db < 2; ++db)
#pragma unroll
                for (int gq = 0; gq < 4; ++gq) { u32x2 w; w.x = cvtpk(ot[db][qb][4 * gq] * inv, ot[db][qb][4 * gq + 1] * inv); w.y = cvtpk(ot[db][qb][4 * gq + 2] * inv, ot[db][qb][4 * gq + 3] * inv);
                    *(u32x2*)(op + 32 * db + 8 * gq + 4 * hl) = w; } }
    }
    __syncthreads();
}


#ifndef PHMASK
#define PHMASK 0xFFFF
#endif
#define PHON(k) (((PHMASK) >> (k)) & 1)
#ifndef REPMASK
#define REPMASK 0x0
#endif
#define REP(k) (((REPMASK) >> (k)) & 1)
#ifndef MK_PER_PHASE
#define MK_PER_PHASE 0
#endif
#ifndef TIMER_LO
#define TIMER_LO 999
#define TIMER_HI 999
#endif
#define TIMER_ON (TIMER_LO < 999)
#define IN(k) (lo <= (k) && (k) < hi)
#define SEAM(k) do { if (IN(k) && IN((k) + 1)) { xcd_barrier(bar); } if (TIMER_ON) { const unsigned long long now_ = __builtin_amdgcn_s_memrealtime(); if ((k) >= TIMER_LO && (k) <= TIMER_HI) TM.acc += now_ - TM.prev; TM.prev = now_; } } while (0)
#define SITE_PTRS phase_enter(F); unsigned char* ws = F.ws; bf16_t* H = (bf16_t*)(ws + WS_H); bf16_t* BIG = (bf16_t*)(ws + WS_BIG); const float* MODV = (const float*)(ws + WS_MODV); (void)H; (void)BIG; (void)MODV; \
        unsigned char* wss = ws + WS_W + (size_t)lp * W_SSD_STRIDE; unsigned char* wsa = ws + WS_W + W_ATT0 + (size_t)lp * W_ATT_STRIDE; (void)wss; (void)wsa;
struct Timer { unsigned long long prev, acc; };
template <int lp, int c> __device__ __forceinline__ void moe_chunk(Frame& F, const Args& A, const int lo, const int hi, const XcdBarrier& bar, LAS unsigned char* ring, Timer& TM) {
    constexpr int pb = 1 + lp * 20;
            const int pu = pb + 14 + 2 * c, pd = pu + 1;
            if (IN(pu) || IN(pd)) {
                SITE_PTRS
                MoeOrder mo;
                mo.pp[0] = 0;
#pragma unroll
                for (int e = 0; e < 8; ++e) { const int cn = __builtin_amdgcn_readfirstlane((int)__hip_atomic_load((unsigned*)(F.ctl + CW_CNT + (size_t)(lp * 8 + e) * 64), RLX_AGENT)); mo.cnt[e] = cn; mo.pp[e + 1] = mo.pp[e] + ((cn + 255) >> 8); }
                const int Ptot = mo.pp[8]; int nP = Ptot - c * MOE_CHUNK; nP = nP < 0 ? 0 : (nP > MOE_CHUNK ? MOE_CHUNK : nP);
                mo.cs = c * MOE_CHUNK; mo.rlist = (const int*)(ws + WS_RLIST);
                if (PHON(10) && IN(pu)) { mo.so.init(nP, 2 * DFFE / 256, F.G, (int)blockIdx.x); mo.GATHER_A = true; mo.bstride = (size_t)2 * DFFE * 1024 * 2;
                    pg8::Gemm g{H, (const bf16_t*)(ws + WS_BIG + BIG_MW13), 1024, 1024}; EpiSwiglu E{BIG, DFFE}; pg8::gemm_phase<EpiSwiglu, MoeOrder, true, true>(ring, g, mo, E, F.wave0); }
                SEAM(pu);
                if (PHON(11) && IN(pd)) { mo.so.init(nP, 4, F.G, (int)blockIdx.x); mo.GATHER_A = false; mo.bstride = (size_t)1024 * DFFE * 2;
                    pg8::Gemm g{BIG, (const bf16_t*)(ws + WS_BIG + BIG_MW2), DFFE, DFFE}; EpiMoeDown E{mo, (bf16_t*)(ws + WS_Y), (const float*)(ws + WS_GATE)}; pg8::gemm_phase<EpiMoeDown, MoeOrder, true, false>(ring, g, mo, E, F.wave0); }
            }
            SEAM(pd);
        }
template <int lp> __device__ __forceinline__ void layer_pair(Frame& F, const Args& A, const int lo, const int hi, const XcdBarrier& bar, LAS unsigned char* ring, Timer& TM) {
        const int pb = 1 + lp * 20, i0 = 2 * lp, i1 = 2 * lp + 1;
        if (PHON(1) && IN(pb + 0)) norm_phase(F, A, i0, 0, lp == 0 ? 1 : 2);
        SEAM(pb + 0);
        if (PHON(2) && IN(pb + 1)) { SITE_PTRS pg8::Gemm g{H, (const bf16_t*)(wss + W_WIN), 1024, 1024}; pg8::StaticOrder S; S.init(NPAN, NXBC / 256, F.G, (int)blockIdx.x);
            EpiXbc E{BIG, (float*)(ws + WS_DT), (bf16_t*)(ws + WS_HALO)}; pg8::gemm_phase<EpiXbc, pg8::StaticOrder, true, false>(ring, g, S, E, F.wave0); }
        SEAM(pb + 1);
        if (PHON(3) && IN(pb + 2)) conv_phase(F, A, lp);
        SEAM(pb + 2);
        if (PHON(3) && IN(pb + 3)) scan_phase<0>(F, A, lp);
        SEAM(pb + 3);
        if (PHON(4) && IN(pb + 4)) { SITE_PTRS pg8::Gemm g{H, (const bf16_t*)(wss + W_WZ), 1024, 1024}; pg8::StaticOrder S; S.init(NPAN, DIN / 256, F.G, (int)blockIdx.x);
            EpiGate E{(const bf16_t*)(ws + WS_Y), BIG, A.ssd_norm_w + (size_t)lp * DIN, (LAS float*)(F.lds + PSCR_OFF)}; pg8::gemm_phase<EpiGate, pg8::StaticOrder, true, false>(ring, g, S, E, F.wave0); }
        SEAM(pb + 4);
        if (PHON(5) && IN(pb + 5)) { SITE_PTRS pg8::Gemm g{BIG, (const bf16_t*)(wss + W_WOUT), DIN, DIN}; pg8::StaticOrder S; S.init(NPAN, 4, F.G, (int)blockIdx.x);
            EpiResid E{ws, F.out, MODV + (size_t)i0 * 17 * 6144, 2, nullptr, lp == 0 ? A.x : nullptr, lp == 0 ? A.ctx : nullptr};
            pg8::gemm_phase<EpiResid, pg8::StaticOrder, true, false>(ring, g, S, E, F.wave0); }
        SEAM(pb + 5);
        if (PHON(1) && IN(pb + 6)) norm_phase(F, A, i0, 1, 0);
        SEAM(pb + 6);
        if (PHON(6) && IN(pb + 7)) { SITE_PTRS pg8::Gemm g{H, (const bf16_t*)(wss + W_WUP), 1024, 1024}; pg8::StaticOrder S; S.init(NPAN, 2 * DFF / 256, F.G, (int)blockIdx.x);
            EpiSwiglu E{BIG, DFF}; pg8::gemm_phase<EpiSwiglu, pg8::StaticOrder, true, false>(ring, g, S, E, F.wave0); }
        SEAM(pb + 7);
        if (PHON(5) && IN(pb + 8)) { SITE_PTRS pg8::Gemm g{BIG, (const bf16_t*)(wss + W_WDN), DFF, DFF}; pg8::StaticOrder S; S.init(NPAN, 4, F.G, (int)blockIdx.x);
            EpiResid E{ws, F.out, MODV + (size_t)i0 * 17 * 6144, 5, nullptr, nullptr, nullptr};
            pg8::gemm_phase<EpiResid, pg8::StaticOrder, true, false>(ring, g, S, E, F.wave0); }
        SEAM(pb + 8);
        if (PHON(1) && IN(pb + 9)) norm_phase(F, A, i1, 0, 0);
        SEAM(pb + 9);
        if (PHON(7) && IN(pb + 10)) { SITE_PTRS pg8::Gemm g{H, (const bf16_t*)(wsa + W_WQKV), 1024, 1024}; pg8::StaticOrder S; S.init(NPAN, NQKV / 256, F.G, (int)blockIdx.x);
            LAS float* qt = (LAS float*)(F.lds + PSCR_OFF);
            { const float* rp = (const float*)(ws + WS_ROPE); const float* bq = A.attn_b_qkv + (size_t)lp * NQKV; for (int idx = F.tid; idx < 3584; idx += 512) qt[idx] = idx < 2048 ? rp[idx] : bq[idx - 2048]; }
            __syncthreads();
            EpiQkv E{BIG, (bf16_t*)(ws + WS_BIG + BIG_K), (bf16_t*)(ws + WS_BIG + BIG_V), qt};
            pg8::gemm_phase<EpiQkv, pg8::StaticOrder, true, false>(ring, g, S, E, F.wave0); }
        SEAM(pb + 10);
        if (PHON(8) && IN(pb + 11)) { const int nconv = F.G >= 9996 ? 48 : 0;
            if ((int)blockIdx.x < F.G - nconv) attn_phase(F, A, lp, lp == 0, F.G - nconv); else moe_convert(F, A, lp, F.G - nconv, nconv); }
        SEAM(pb + 11);
        if (PHON(5) && IN(pb + 12)) { SITE_PTRS pg8::Gemm g{H, (const bf16_t*)(wsa + W_WO), 1024, 1024};
            EpiResid E{ws, F.out, MODV + (size_t)i1 * 17 * 6144, 2, A.attn_b_o + (size_t)lp * 1024, nullptr, nullptr};
            if (lp == 1) { pg8::LatentOrder S; S.init(NPAN - NB, 4, F.G, (int)blockIdx.x); pg8::gemm_phase<EpiResid, pg8::LatentOrder, true, false>(ring, g, S, E, F.wave0); }
            else { pg8::StaticOrder S; S.init(NPAN, 4, F.G, (int)blockIdx.x); pg8::gemm_phase<EpiResid, pg8::StaticOrder, true, false>(ring, g, S, E, F.wave0); } }
        SEAM(pb + 12);
        if (PHON(9) && IN(pb + 13)) { norm_phase(F, A, i1, 1, 4 | (lp == 1 ? 16 : 0)); if (F.G < 9996) { __syncthreads(); moe_convert(F, A, lp, 0, F.G); } }
        SEAM(pb + 13);
    moe_chunk<lp, 0>(F, A, lo, hi, bar, ring, TM); moe_chunk<lp, 1>(F, A, lo, hi, bar, ring, TM); moe_chunk<lp, 2>(F, A, lo, hi, bar, ring, TM);
}
constexpr int N_PHASES = 42;
__global__ void __launch_bounds__(NWAVES * 64, 2) fwd_kernel(Args A) {
    extern __shared__ __attribute__((aligned(16))) unsigned char lds_raw[];
    Frame F;
    F.lds = (LAS unsigned char*)lds_raw;
    F.tid = threadIdx.x; F.lane = F.tid & 63; F.wave = __builtin_amdgcn_readfirstlane(F.tid >> 6); F.wave0 = F.wave; F.G = gridDim.x;
    F.ws0 = A.ws; F.out0 = A.out; F.ws = A.ws; F.ctl = (gu32*)(A.ws + WS_CTL); F.out = A.out;
    volatile LAS unsigned* MISC = (volatile LAS unsigned*)(F.lds + MISC_OFF);
    for (int u = F.tid; u < (LDS_BYTES - LDSCTL_OFF) / 4; u += NWAVES * 64) ((LAS unsigned*)(F.lds + LDSCTL_OFF))[u] = 0u;
    __syncthreads();
    const int lo = A.ph_lo, hi = A.ph_hi;
    XcdBarrier bar; bar.bar = (unsigned*)(F.ctl + CW_BAR); bar.x = 0; bar.st = MISC + 8; bar.wave0 = F.wave0;
    if (hi - lo > 1) bar = xcd_barrier_post((unsigned*)(F.ctl + CW_BAR), MISC + 8, F.wave0);
    LAS unsigned char* ring = F.lds;

    Timer TM; TM.prev = TIMER_ON ? __builtin_amdgcn_s_memrealtime() : 0ull; TM.acc = 0ull;
    if (PHON(0) && IN(0)) { p0_prologue(F, A); }
    SEAM(0);
    layer_pair<0>(F, A, lo, hi, bar, ring, TM);
    layer_pair<1>(F, A, lo, hi, bar, ring, TM);
    if (PHON(1) && IN(41)) {
        norm_phase(F, A, 4, 0, 2 | 8);
        if (xb_ld((unsigned*)(F.ctl + CW_BAR) + XB_TMO) != 0u) {
            const float qn = __builtin_nanf("");
            for (size_t idx = (size_t)blockIdx.x * 512 + F.tid; idx < (size_t)NB * SEQ * DM / 4; idx += (size_t)F.G * 512) ((f32x4*)A.out)[idx] = (f32x4){qn, qn, qn, qn};
        }
    }
    if (TIMER_ON) { const unsigned long long now_ = __builtin_amdgcn_s_memrealtime(); if (41 >= TIMER_LO && 41 <= TIMER_HI) TM.acc += now_ - TM.prev;
        if (blockIdx.x == 0) { const unsigned long long tgt = now_ + TM.acc; while (__builtin_amdgcn_s_memrealtime() < tgt) __builtin_amdgcn_s_sleep(8); } }
#undef IN
#undef SEAM
}

extern "C" void kernel_launch(void* const* d_in, const int* in_sizes, int n_in, void* d_out, int out_size, void* d_ws, size_t ws_size, hipStream_t stream) {
    static int grid = 0;
    if (grid == 0) {
        if (n_in != 29 || in_sizes[0] != NB * SEQ * DM || out_size != NB * SEQ * DM || ws_size < WS_END) {
            fprintf(stderr, "kernel_launch: unexpected problem: n_in %d, in0 %d, out %d, ws %zu (need %zu); nothing launched\n", n_in, n_in > 0 ? in_sizes[0] : -1, out_size, ws_size, (size_t)WS_END); grid = -1; return; }
        int dev = 0, cus = 0, per_cu = 0;
        if (hipGetDevice(&dev) != hipSuccess || hipDeviceGetAttribute(&cus, hipDeviceAttributeMultiprocessorCount, dev) != hipSuccess) { fprintf(stderr, "kernel_launch: device query failed\n"); grid = -1; return; }
        if (hipFuncSetAttribute((const void*)fwd_kernel, hipFuncAttributeMaxDynamicSharedMemorySize, LDS_BYTES) != hipSuccess) { fprintf(stderr, "kernel_launch: hipFuncSetAttribute failed\n"); grid = -1; return; }
        if (hipOccupancyMaxActiveBlocksPerMultiprocessor(&per_cu, (const void*)fwd_kernel, NWAVES * 64, LDS_BYTES) != hipSuccess || per_cu < 1)
            fprintf(stderr, "kernel_launch: note: occupancy query reports %d workgroups per CU\n", per_cu);
        (void)hipGetLastError();
        grid = cus;
    }
    if (grid < 0) return;
    if (hipMemsetAsync((char*)d_ws + WS_CTL, 0, CTL_ZERO_BYTES, stream) != hipSuccess) { fprintf(stderr, "kernel_launch: memset failed\n"); return; }
    Args a{};
    const float** ap = (const float**)&a;
    for (int i = 0; i < 29; ++i) ap[i] = (const float*)d_in[i];
    a.out = (float*)d_out; a.ws = (unsigned char*)d_ws;
#if MK_PER_PHASE
    for (int k = 0; k < N_PHASES; ++k) { a.ph_lo = k; a.ph_hi = k + 1; hipLaunchKernelGGL(fwd_kernel, dim3(grid), dim3(NWAVES * 64), LDS_BYTES, stream, a); }
#else
    a.ph_lo = 0; a.ph_hi = N_PHASES;
    hipLaunchKernelGGL(fwd_kernel, dim3(grid), dim3(NWAVES * 64), LDS_BYTES, stream, a);
#endif
    const hipError_t le = hipPeekAtLastError();
    if (le != hipSuccess) fprintf(stderr, "kernel_launch: launch failed: %s\n", hipGetErrorName(le));
}
```

```cpp
#include <hip/hip_runtime.h>
#include <cstdio>
#include <cstdint>

#define LAS __attribute__((address_space(3)))
#define GAS __attribute__((address_space(1)))
typedef unsigned short bf16_t;
typedef short bf16x8 __attribute__((ext_vector_type(8)));
typedef short s16x4 __attribute__((ext_vector_type(4)));
typedef float f32x4 __attribute__((ext_vector_type(4)));
typedef float f32x2 __attribute__((ext_vector_type(2)));
typedef float f32x16 __attribute__((ext_vector_type(16)));
typedef unsigned u32x4 __attribute__((ext_vector_type(4)));
typedef unsigned u32x2 __attribute__((ext_vector_type(2)));
typedef GAS unsigned gu32;

namespace pg8 {
constexpr int BM = 256, BK = 64, HALF = 128, HTB = HALF * BK * 2  , STAGE_BYTES = 8 * HTB, NXCD = 8, WGM = 8;

__host__ __device__ __forceinline__ int lds_byte(int r, int c) { const int st = (r >> 4) * 2 + (c >> 5), rr = r & 15, cc = c & 31, ob = rr * 64 + cc * 2; return st * 1024 + (ob ^ (((ob >> 9) & 1) << 5)); }
__host__ __device__ __forceinline__ void stage_rc(int b, int& R, int& C) { const int st = b / 1024, sb = b % 1024, swz = sb ^ (((sb >> 9) & 1) << 5); R = (st >> 1) * 16 + swz / 64; C = (st & 1) * 32 + (swz % 64) / 2; }
__host__ __device__ __forceinline__ int perm32(int rho) { const int n = rho >> 4, i = rho & 15; return 8 * (i >> 2) + 4 * n + (i & 3); }

struct Unit { int pm, pn; };
struct Gemm { const bf16_t* A; const bf16_t* Bt; int lda, K; };

struct StaticOrder {
    int nM, nN, nwg, G, c;
    __device__ void init(int nM_, int nN_, int G_, int c_) { nM = nM_; nN = nN_; nwg = nM * nN; G = G_; c = c_; }
    __device__ bool next(int i, Unit& u) const {
        const long L = (long)i * G + c; if (L >= nwg) return false;
        int wgid = (int)L; { const int q = nwg / NXCD, r = nwg % NXCD, xcd = wgid % NXCD, off = wgid / NXCD; wgid = (xcd < r ? xcd * (q + 1) : r * (q + 1) + (xcd - r) * q) + off; }
        const int nig = WGM * nN, gid = wgid / nig, fm = gid * WGM, gsz = (nM - fm) < WGM ? (nM - fm) : WGM;
        u.pm = fm + ((wgid % nig) % gsz); u.pn = (wgid % nig) / gsz; return true;
    }
    __device__ __forceinline__ const char* a_base(const Gemm& g, const Unit& u) const { return (const char*)g.A + (size_t)u.pm * (size_t)(BM * 2) * g.lda; }
    __device__ __forceinline__ const char* b_base(const Gemm& g, const Unit& u) const { return (const char*)g.Bt + (size_t)u.pn * (size_t)(BM * 2) * g.K; }
    __device__ __forceinline__ unsigned row_off(const Gemm& g, const Unit&, int r) const { return (unsigned)r * (unsigned)g.lda * 2u; }
};

struct LatentOrder : StaticOrder {
    __device__ bool next(int i, Unit& u) const { if (!StaticOrder::next(i, u)) return false; u.pm = u.pm + (u.pm >> 4) + 1; return true; }
};

__device__ __forceinline__ unsigned cvt_pk_bf16(float lo, float hi) { unsigned r; asm volatile("v_cvt_pk_bf16_f32 %0, %1, %2" : "=v"(r) : "v"(lo), "v"(hi)); return r; }

template <class Epi, class Sched, bool ALIGN_EPI, bool GATHER>
__device__ __forceinline__ void gemm_phase(LAS unsigned char* lds, const Gemm g, const Sched& S, const Epi& E, const int wave0, const unsigned delay_ticks = 0u) {
    if (delay_ticks) { const unsigned long long t0_ = __builtin_amdgcn_s_memrealtime(); while (__builtin_amdgcn_s_memrealtime() - t0_ < (unsigned long long)delay_ticks) __builtin_amdgcn_s_sleep(16); }
    int tid_ = wave0 * 64 + (int)__builtin_amdgcn_mbcnt_hi(~0u, __builtin_amdgcn_mbcnt_lo(~0u, 0u)); asm volatile("" : "+v"(tid_));
    const int tid = tid_, wid = __builtin_amdgcn_readfirstlane(tid >> 6), lane = tid & 63, wr = wid >> 2, wc = wid & 3, fr = lane & 15, fq = lane >> 4;
    const int K = g.K, nt = K / BK;
    unsigned voffB[2];
#pragma unroll
    for (int i = 0; i < 2; ++i) { int R, C; stage_rc(tid * 16 + i * 8192, R, C); const int Rb = Epi::PERM ? ((R & ~31) + perm32(R & 31)) : R; voffB[i] = (unsigned)(Rb * K + C) * 2u; }
    const size_t kstep = (size_t)(BK * 2);
    const size_t hstepB = (size_t)HALF * K * 2;
    const unsigned ldsw = (unsigned)wid * 1024u;
    const int aoff = lds_byte(wr * 64 + fr, fq * 8), boff = lds_byte(wc * 32 + fr, fq * 8);
#define PG8_SA(b, h) (((b) * 2 + (h)) * HTB)
#define PG8_SB(b, h) ((4 + (b) * 2 + (h)) * HTB)
#define PG8_STAGE(bufoff, gbase, voff) do { _Pragma("unroll") for (int _i = 0; _i < 2; ++_i) \
        __builtin_amdgcn_global_load_lds((const unsigned*)((const char*)(gbase) + (voff)[_i]), (LAS unsigned*)(lds + (bufoff) + ldsw + _i * 8192), 16, 0, 0); } while (0)
#define PG8_LDA(dst, b, h) do { _Pragma("unroll") for (int m = 0; m < 4; ++m) _Pragma("unroll") for (int k = 0; k < 2; ++k) dst[m][k] = *(const LAS bf16x8*)(lds + PG8_SA(b, h) + aoff + m * 2048 + k * 1024); } while (0)
#define PG8_LDB(dst, b, h) do { _Pragma("unroll") for (int n = 0; n < 2; ++n) _Pragma("unroll") for (int k = 0; k < 2; ++k) dst[n][k] = *(const LAS bf16x8*)(lds + PG8_SB(b, h) + boff + n * 2048 + k * 1024); } while (0)
#define PG8_MMA(ai, bj, At, Bt) do { __builtin_amdgcn_s_setprio(1); _Pragma("unroll") for (int m = 0; m < 4; ++m) _Pragma("unroll") for (int n = 0; n < 2; ++n) _Pragma("unroll") for (int k = 0; k < 2; ++k) \
        acc[ai][bj][m][n] = __builtin_amdgcn_mfma_f32_16x16x32_bf16(Bt[n][k], At[m][k], acc[ai][bj][m][n], 0, 0, 0); __builtin_amdgcn_s_setprio(0); } while (0)
#define PG8_WAIT_V(n) asm volatile("s_waitcnt vmcnt(" #n ")" ::: "memory")
#define PG8_WAIT_L(n) asm volatile("s_waitcnt lgkmcnt(" #n ")" ::: "memory")
#define PG8_BAR __builtin_amdgcn_s_barrier()
#define PG8_SCHED __builtin_amdgcn_sched_barrier(0)
    Unit cur, nxt; int ui = 0;
    if (!S.next(0, cur)) return;
    f32x4 acc[2][2][4][2];
#pragma unroll
    for (int a = 0; a < 2; ++a)
#pragma unroll
        for (int b = 0; b < 2; ++b)
#pragma unroll
            for (int m = 0; m < 4; ++m)
#pragma unroll
                for (int n = 0; n < 2; ++n) acc[a][b][m][n] = (f32x4){0.f, 0.f, 0.f, 0.f};
    bf16x8 At[4][2], B0[2][2], B1[2][2];
    const char* cA = S.a_base(g, cur); const char* cB = S.b_base(g, cur);
    unsigned va[2][2], vn[2][2];
#pragma unroll
    for (int h = 0; h < 2; ++h)
#pragma unroll
        for (int i = 0; i < 2; ++i) { int R, C; stage_rc(tid * 16 + i * 8192, R, C); va[h][i] = S.row_off(g, cur, h * HALF + R) + (unsigned)C * 2u; vn[h][i] = va[h][i]; }
    PG8_STAGE(PG8_SB(0, 0), cB, voffB); PG8_STAGE(PG8_SB(0, 1), cB + hstepB, voffB); PG8_STAGE(PG8_SA(0, 0), cA, va[0]); PG8_STAGE(PG8_SA(0, 1), cA, va[1]);
    if (wr == 1) PG8_BAR;
    PG8_WAIT_V(2); PG8_BAR;
    PG8_STAGE(PG8_SB(1, 0), cB + kstep, voffB); PG8_STAGE(PG8_SA(1, 0), cA + kstep, va[0]); PG8_STAGE(PG8_SB(1, 1), cB + hstepB + kstep, voffB);
    PG8_WAIT_V(6); PG8_BAR;
    for (;;) {
        const bool has_next = S.next(ui + 1, nxt);
        const char* nA = has_next ? S.a_base(g, nxt) : cA; const char* nB = has_next ? S.b_base(g, nxt) : cB;
        if (GATHER) {
            if (has_next) {
#pragma unroll
                for (int h = 0; h < 2; ++h)
#pragma unroll
                    for (int i = 0; i < 2; ++i) { int R, C; stage_rc(tid * 16 + i * 8192, R, C); vn[h][i] = S.row_off(g, nxt, h * HALF + R) + (unsigned)C * 2u; }
            } else {
#pragma unroll
                for (int h = 0; h < 2; ++h)
#pragma unroll
                    for (int i = 0; i < 2; ++i) vn[h][i] = va[h][i];
            }
        }
        for (int t = 0; t < nt; t += 2) {
            const bool last = (t == nt - 2);
            const char* a1 = cA + (size_t)(t + 1) * kstep;
            const char* a2 = last ? nA : cA + (size_t)(t + 2) * kstep; const char* b2 = last ? nB : cB + (size_t)(t + 2) * kstep;
            const char* a3 = a2 + kstep; const char* b3 = b2 + kstep;
            unsigned v2[2][2];
#pragma unroll
            for (int h = 0; h < 2; ++h)
#pragma unroll
                for (int i = 0; i < 2; ++i) v2[h][i] = (GATHER && last) ? vn[h][i] : va[h][i];
            PG8_LDB(B0, 0, 0); PG8_LDB(B1, 0, 1); PG8_SCHED; PG8_LDA(At, 0, 0); PG8_STAGE(PG8_SA(1, 1), a1, va[1]);
            PG8_WAIT_V(8); PG8_WAIT_L(0); PG8_BAR; PG8_MMA(0, 0, At, B0); PG8_MMA(0, 1, At, B1); PG8_BAR; PG8_SCHED;
            PG8_LDA(At, 0, 1); PG8_STAGE(PG8_SB(0, 0), b2, voffB); PG8_STAGE(PG8_SB(0, 1), b2 + hstepB, voffB); PG8_STAGE(PG8_SA(0, 0), a2, v2[0]);
            PG8_WAIT_V(8); PG8_WAIT_L(0); PG8_BAR; PG8_MMA(1, 0, At, B0); PG8_MMA(1, 1, At, B1); PG8_BAR; PG8_SCHED;
            PG8_LDB(B0, 1, 0); PG8_LDB(B1, 1, 1); PG8_SCHED; PG8_LDA(At, 1, 0); PG8_STAGE(PG8_SA(0, 1), a2, v2[1]);
            PG8_WAIT_V(8); PG8_WAIT_L(0); PG8_BAR; PG8_MMA(0, 0, At, B0); PG8_MMA(0, 1, At, B1); PG8_BAR; PG8_SCHED;
            PG8_LDA(At, 1, 1); PG8_STAGE(PG8_SB(1, 0), b3, voffB); PG8_STAGE(PG8_SB(1, 1), b3 + hstepB, voffB); PG8_STAGE(PG8_SA(1, 0), a3, v2[0]);
            PG8_WAIT_V(8); PG8_WAIT_L(0); PG8_BAR; PG8_MMA(1, 0, At, B0); PG8_MMA(1, 1, At, B1); PG8_BAR; PG8_SCHED;
        }
        if constexpr (ALIGN_EPI) { if (wr == 0) PG8_BAR; }
        { int l2 = (int)__builtin_amdgcn_mbcnt_hi(~0u, __builtin_amdgcn_mbcnt_lo(~0u, 0u)); asm volatile("" : "+v"(l2)); E(acc, cur, wr, wc, l2 & 15, l2 >> 4); }
        if (!has_next) break;
#pragma unroll
        for (int a = 0; a < 2; ++a)
#pragma unroll
            for (int b = 0; b < 2; ++b)
#pragma unroll
                for (int m = 0; m < 4; ++m)
#pragma unroll
                    for (int n = 0; n < 2; ++n) acc[a][b][m][n] = (f32x4){0.f, 0.f, 0.f, 0.f};
        cur = nxt; cA = nA; cB = nB; ++ui;
        if (GATHER) {
#pragma unroll
            for (int h = 0; h < 2; ++h)
#pragma unroll
                for (int i = 0; i < 2; ++i) va[h][i] = vn[h][i];
        }
        if constexpr (ALIGN_EPI) { if (wr == 1) PG8_BAR; }
    }
    PG8_WAIT_V(0);
    if constexpr (!ALIGN_EPI) { if (wr == 0) PG8_BAR; }
    PG8_BAR;
#undef PG8_SA
#undef PG8_SB
#undef PG8_STAGE
#undef PG8_LDA
#undef PG8_LDB
#undef PG8_MMA
#undef PG8_WAIT_V
#undef PG8_WAIT_L
#undef PG8_BAR
#undef PG8_SCHED
}
}

constexpr int DM = 1024, NB = 16, SEQ = 4096, NCTX = 256, SROW = SEQ + NCTX  , MROWS = NB * SROW  , NPAN = MROWS / 256  ;
constexpr int DIN = 2048, CONVCH = 4096, SSD_IN = 6208, NXBC = 4352  ;
constexpr int QW = 1024, KVW = 256, NQKV = 1536;
constexpr int DFF = 2816, NEXP = 8, DFFE = 3584;
constexpr float EPS = 1e-6f;
constexpr int MOE_CHUNK = 192;
constexpr int NWAVES = 8;

constexpr size_t MiB = 1u << 20;
constexpr size_t WS_CTL = 0, CTL_ZERO_BYTES = 1 * MiB;
constexpr size_t WS_MODV = 2 * MiB;
constexpr size_t WS_ROPE = 4 * MiB;
constexpr size_t WS_GATE = 5 * MiB;
constexpr size_t WS_RLIST = 6 * MiB;
constexpr size_t WS_W = 26 * MiB;
constexpr size_t W_SSD_STRIDE = 33 * MiB, W_WZ = 0, W_WIN = 4 * MiB, W_WOUT = 12 * MiB + MiB / 2, W_WUP = 16 * MiB + MiB / 2, W_WDN = 27 * MiB + MiB / 2;
constexpr size_t W_ATT0 = 66 * MiB, W_ATT_STRIDE = 5 * MiB, W_WQKV = 0, W_WO = 3 * MiB;
constexpr size_t WS_XR = 102 * MiB;
constexpr size_t WS_BIG = 238 * MiB;
constexpr size_t BIG_K = 136 * MiB, BIG_V = 170 * MiB, BIG_O = 204 * MiB, BIG_MW13 = 336 * MiB, BIG_MW2 = 448 * MiB;
static_assert((size_t)MOE_CHUNK * 256 * DFFE * 2 <= BIG_MW13 && BIG_O + 136 * MiB <= BIG_MW13 + 200 * MiB && BIG_MW2 + 56 * MiB <= 544 * MiB, "BIG region map");
constexpr size_t WS_Y = 782 * MiB;
constexpr size_t WS_DT = 1054 * MiB;
constexpr size_t WS_HALO = 1071 * MiB;
constexpr size_t WS_END = 1106 * MiB;
constexpr int CW_BAR = 4096;
constexpr int CW_CNT = 16384;

constexpr int RING_BYTES = 131072;
constexpr int PSCR_OFF = 131072;
constexpr int LDSCTL_OFF = 151552, MISC_OFF = LDSCTL_OFF + 320;
constexpr int LDS_BYTES = 155648;

#define RLX_AGENT __ATOMIC_RELAXED, __HIP_MEMORY_SCOPE_AGENT
#define LDS_WAIT() asm volatile("s_waitcnt lgkmcnt(0)" ::: "memory")
#define VM_WAIT() asm volatile("s_waitcnt vmcnt(0)" ::: "memory")
__device__ __forceinline__ unsigned f2bf(float f) { unsigned u = __builtin_bit_cast(unsigned, f); return (u + 0x7fffu + ((u >> 16) & 1u)) >> 16; }
__device__ __forceinline__ unsigned pk2(float lo, float hi) { return f2bf(lo) | (f2bf(hi) << 16); }
__device__ __forceinline__ float bf_lo(unsigned u) { return __builtin_bit_cast(float, u << 16); }
__device__ __forceinline__ float bf_hi(unsigned u) { return __builtin_bit_cast(float, u & 0xffff0000u); }
__device__ __forceinline__ float bf1(bf16_t h) { return __builtin_bit_cast(float, (unsigned)h << 16); }
__device__ __forceinline__ float siluf(float v) { return v * __builtin_amdgcn_rcpf(1.0f + __expf(-v)); }
__device__ __forceinline__ float shx(float v, int mask, int lane) { return __builtin_bit_cast(float, __builtin_amdgcn_ds_bpermute((lane ^ mask) << 2, __builtin_bit_cast(int, v))); }
__device__ __forceinline__ float wave_sum(float v, int lane) {
#pragma unroll
    for (int o = 1; o < 64; o <<= 1) v += shx(v, o, lane);
    return v;
}

__device__ __forceinline__ int lane_id() { return (int)__builtin_amdgcn_mbcnt_hi(~0u, __builtin_amdgcn_mbcnt_lo(~0u, 0u)); }
#define XB_TMO      128
#define XB_XCNT(j)  (256  + 64 * (j))
#define XB_XSUB(j)  (1280 + 64 * (j))
#define XB_XGEN(j)  (2304 + 64 * (j))
#define XB_TOP      3328
#define XB_TOPGEN   3392
#define XCD_BAR_WORDS 3456
#define XB_SPIN_CAP (1u << 18)

__device__ __forceinline__ unsigned xb_ld(unsigned* p)              { return __hip_atomic_load(p, __ATOMIC_RELAXED, __HIP_MEMORY_SCOPE_AGENT); }
__device__ __forceinline__ unsigned xb_add(unsigned* p, unsigned v) { return __hip_atomic_fetch_add(p, v, __ATOMIC_RELAXED, __HIP_MEMORY_SCOPE_AGENT); }
__device__ __forceinline__ unsigned xb_xcc_id() { return (unsigned)__builtin_amdgcn_s_getreg((3 << 11) | 20) & 0xFu; }
#define XB_SPIN(cond, bar) do { unsigned _sp = 0; while (cond) { __builtin_amdgcn_s_sleep(1); \
    if ((++_sp & 255u) == 0u) { if (xb_ld(&(bar)[XB_TMO])) break; if (_sp > XB_SPIN_CAP) { atomicAdd(&(bar)[XB_TMO], 1u); break; } } } } while (0)

struct XcdBarrier {
    unsigned* bar; unsigned x;
    volatile LAS unsigned* st;
    int wave0;
};
__device__ __forceinline__ XcdBarrier xcd_barrier_post(unsigned* bar, volatile LAS unsigned* st, int wave0) {
    XcdBarrier b; b.bar = bar; b.x = xb_xcc_id(); b.st = st; b.wave0 = wave0;
    if (wave0 == 0 && lane_id() == 0) (void)xb_add(&bar[XB_XCNT(b.x)], 1u);
    return b;
}
__device__ __forceinline__ void xcd_barrier_complete(unsigned* bar, unsigned x, unsigned& nloc, unsigned& nx) {
    const unsigned G = gridDim.x * gridDim.y * gridDim.z;
    unsigned sum, cnt, mine, sp = 0u;
    for (;;) {
        sum = 0u; cnt = 0u; mine = 0u;
#pragma unroll
        for (unsigned j = 0; j < 16; ++j) { const unsigned c = xb_ld(&bar[XB_XCNT(j)]); sum += c; cnt += (c > 0u) ? 1u : 0u; mine = (j == x) ? c : mine; }
        if (sum == G) break;
        __builtin_amdgcn_s_sleep(1);
        if ((++sp & 255u) == 0u) { if (xb_ld(&bar[XB_TMO])) break; if (sp > XB_SPIN_CAP) { atomicAdd(&bar[XB_TMO], 1u); break; } }
    }
    nloc = mine > 0u ? mine : 1u; nx = cnt > 0u ? cnt : 1u;
}
__device__ __forceinline__ void xcd_barrier(const XcdBarrier& b) {
    asm volatile("s_waitcnt vmcnt(0)" ::: "memory");
    __syncthreads();
    if (b.wave0 == 0 && lane_id() == 0) {
        unsigned* bar = b.bar;
        __builtin_amdgcn_s_waitcnt(0);
        unsigned nloc = b.st[0], nx = b.st[1];
        if (nloc == 0u) { xcd_barrier_complete(bar, b.x, nloc, nx); b.st[0] = nloc; b.st[1] = nx; }
        const unsigned old = xb_add(&bar[XB_XSUB(b.x)], 1u);
        const unsigned gen = old / nloc;
        if (old + 1u == (gen + 1u) * nloc) {
            __builtin_amdgcn_fence(__ATOMIC_RELEASE, "agent");
            asm volatile("s_waitcnt vmcnt(0)" ::: "memory");
            const unsigned og = xb_add(&bar[XB_TOP], 1u);
            const unsigned tg = og / nx;
            if (og + 1u == (tg + 1u) * nx) xb_add(&bar[XB_TOPGEN], 1u);
            else XB_SPIN(xb_ld(&bar[XB_TOPGEN]) == tg, bar);
            __builtin_amdgcn_fence(__ATOMIC_ACQUIRE, "agent");
            xb_add(&bar[XB_XGEN(b.x)], 1u);
            asm volatile("s_waitcnt vmcnt(0)" ::: "memory");
        } else {
            XB_SPIN(xb_ld(&bar[XB_XGEN(b.x)]) == gen, bar);
            __builtin_amdgcn_fence(__ATOMIC_ACQUIRE, "agent");
            asm volatile("s_waitcnt vmcnt(0)" ::: "memory");
        }
    }
    __syncthreads();
}

struct Args {
    const float *x, *c, *ctx, *c_ctx, *w_mod, *b_mod, *norm1_w, *norm2_w, *ssd_w_in, *ssd_conv_w, *ssd_conv_b, *ssd_dt_bias, *ssd_a_log, *ssd_d, *ssd_norm_w, *ssd_w_out,
                *attn_w_qkv, *attn_b_qkv, *attn_sink, *attn_w_o, *attn_b_o, *ffn_w1, *ffn_w3, *ffn_w2, *moe_router, *moe_w1, *moe_w3, *moe_w2, *final_norm_w;
    float* out; unsigned char* ws; int ph_lo, ph_hi;
};
struct Frame {
    LAS unsigned char* lds;
    int tid, lane, wave, G;
    unsigned char* ws; gu32* ctl; float* out;
    unsigned char* ws0; float* out0; int wave0;
};
__device__ __forceinline__ void phase_enter(Frame& F) { int l = lane_id(); asm volatile("" : "+v"(l)); F.lane = l; F.wave = F.wave0; F.tid = F.wave0 * 64 + l;
    unsigned char* w = F.ws0; float* o = F.out0; asm volatile("" : "+s"(w), "+s"(o)); F.ws = w; F.ctl = (gu32*)(w + WS_CTL); F.out = o; }
__device__ __forceinline__ void transpose_item(const float* W, int ldw, int col0, int ncb, int K, bf16_t* WT, int mode, int half, LAS float* scr, int item, int lane) {
    const int kb = item / ncb, nb = item - kb * ncb, k0 = 64 * kb, n0 = 64 * nb;
    const int lr = lane >> 4, lc = (lane & 15) * 4;
    f32x4 tv[16];
#pragma unroll
    for (int i = 0; i < 16; ++i) tv[i] = *(const GAS f32x4*)(W + (size_t)(k0 + 4 * i + lr) * ldw + col0 + n0 + lc);
#pragma unroll
    for (int i = 0; i < 16; ++i) { LAS float* d = scr + (4 * i + lr) * 65 + lc; d[0] = tv[i].x; d[1] = tv[i].y; d[2] = tv[i].z; d[3] = tv[i].w; }
    LDS_WAIT(); asm volatile("" ::: "memory");
    const int c = lane & 7;
#pragma unroll
    for (int j = 0; j < 8; ++j) { const int n = (lane >> 3) + 8 * j; const LAS float* s = scr + (8 * c) * 65 + n;
        u32x4 o; o.x = pk2(s[0 * 65], s[1 * 65]); o.y = pk2(s[2 * 65], s[3 * 65]); o.z = pk2(s[4 * 65], s[5 * 65]); o.w = pk2(s[6 * 65], s[7 * 65]);
        const int cl = n0 + n; const int drow = mode == 0 ? cl : ((cl >> 7) * 256 + half * 128 + (cl & 127));
        *(GAS u32x4*)(WT + (size_t)drow * K + k0 + 8 * c) = o; }
    LDS_WAIT(); asm volatile("" ::: "memory");
}
__device__ __forceinline__ void p0_prologue(Frame& F, const Args& A) {
    phase_enter(F);
    {
        LAS float* sc = (LAS float*)F.lds;
        LAS float* red = (LAS float*)(F.lds + 81920);
        for (int idx = F.tid; idx < 17 * 1024; idx += 512) { const int cb = idx >> 10, k = idx & 1023; const float v = cb < 16 ? A.c[cb * 1024 + k] : A.c_ctx[k]; sc[k * 20 + cb] = v / (1.0f + expf(-v)); }
        __syncthreads();
        float* MODV = (float*)(F.ws + WS_MODV);
        for (int item = blockIdx.x; item < 4 * 96; item += F.G) {
            const int i = item / 96, cblk = item - i * 96;
            const float* Wm = A.w_mod + (size_t)i * 1024 * 6144 + cblk * 64 + F.lane;
            float acc[17];
#pragma unroll
            for (int cb = 0; cb < 17; ++cb) acc[cb] = 0.f;
            const int k0 = F.wave * 128;
#pragma unroll 4
            for (int kk = 0; kk < 128; ++kk) { const int k = k0 + kk; const float w = Wm[(size_t)k * 6144]; const LAS float* s = sc + k * 20;
#pragma unroll
                for (int cb = 0; cb < 17; ++cb) acc[cb] += s[cb] * w; }
#pragma unroll
            for (int cb = 0; cb < 17; ++cb) red[(F.wave * 17 + cb) * 64 + F.lane] = acc[cb];
            __syncthreads();
            for (int idx = F.tid; idx < 17 * 64; idx += 512) { const int cb = idx >> 6, l = idx & 63; float s = 0.f;
#pragma unroll
                for (int w = 0; w < 8; ++w) s += red[(w * 17 + cb) * 64 + l];
                MODV[(size_t)(i * 17 + cb) * 6144 + cblk * 64 + l] = s + A.b_mod[i * 6144 + cblk * 64 + l]; }
            __syncthreads();
        }
    }
    if (blockIdx.x == 0) { float* RT = (float*)(F.ws + WS_ROPE);
        for (int idx = F.tid; idx < 1024; idx += 512) { const int id = idx >> 4, f = idx & 15; const float inv = __builtin_amdgcn_exp2f(-(float)f * (13.287712379549449f / 16.0f)); const float ang = (float)id * inv;
            RT[idx] = __cosf(ang); RT[1024 + idx] = __sinf(ang); } }
    __syncthreads();
    {
        LAS float* scr = (LAS float*)(F.lds + F.wave * 16896);
        const int gw = blockIdx.x * NWAVES + F.wave, NGW = F.G * NWAVES;
        constexpr int I1 = 16 * 32, I2 = 16 * 65, I3 = 32 * 16, I4 = 16 * 44, I5 = 16 * 44, I6 = 44 * 16, I7 = 16 * 24, I8 = 16 * 16, IPER = I1 + I2 + I3 + I4 + I5 + I6 + I7 + I8;
        for (int it = gw; it < 2 * IPER; it += NGW) {
            const int j = it / IPER; int r = it - j * IPER;
            unsigned char* wss = F.ws + WS_W + (size_t)j * W_SSD_STRIDE; unsigned char* wsa = F.ws + WS_W + W_ATT0 + (size_t)j * W_ATT_STRIDE;
            if (r < I1) { transpose_item(A.ssd_w_in + (size_t)j * 1024 * SSD_IN, SSD_IN, 0, 32, 1024, (bf16_t*)(wss + W_WZ), 0, 0, scr, r, F.lane); continue; } r -= I1;
            if (r < I2) { transpose_item(A.ssd_w_in + (size_t)j * 1024 * SSD_IN, SSD_IN, 2048, 65, 1024, (bf16_t*)(wss + W_WIN), 0, 0, scr, r, F.lane); continue; } r -= I2;
            if (r < I3) { transpose_item(A.ssd_w_out + (size_t)j * 2048 * 1024, 1024, 0, 16, 2048, (bf16_t*)(wss + W_WOUT), 0, 0, scr, r, F.lane); continue; } r -= I3;
            if (r < I4) { transpose_item(A.ffn_w1 + (size_t)j * 1024 * DFF, DFF, 0, 44, 1024, (bf16_t*)(wss + W_WUP), 1, 0, scr, r, F.lane); continue; } r -= I4;
            if (r < I5) { transpose_item(A.ffn_w3 + (size_t)j * 1024 * DFF, DFF, 0, 44, 1024, (bf16_t*)(wss + W_WUP), 1, 1, scr, r, F.lane); continue; } r -= I5;
            if (r < I6) { transpose_item(A.ffn_w2 + (size_t)j * DFF * 1024, 1024, 0, 16, DFF, (bf16_t*)(wss + W_WDN), 0, 0, scr, r, F.lane); continue; } r -= I6;
            if (r < I7) { transpose_item(A.attn_w_qkv + (size_t)j * 1024 * NQKV, NQKV, 0, 24, 1024, (bf16_t*)(wsa + W_WQKV), 0, 0, scr, r, F.lane); continue; } r -= I7;
            transpose_item(A.attn_w_o + (size_t)j * 1024 * 1024, 1024, 0, 16, 1024, (bf16_t*)(wsa + W_WO), 0, 0, scr, r, F.lane);
        }
        for (int j = 0; j < 2; ++j) { u32x4* z = (u32x4*)(F.ws + WS_W + (size_t)j * W_SSD_STRIDE + W_WIN + (size_t)4160 * 1024 * 2);
            for (int idx = blockIdx.x * 512 + F.tid; idx < 192 * 1024 * 2 / 16; idx += F.G * 512) z[idx] = (u32x4){0u, 0u, 0u, 0u}; }
    }
}
__device__ __forceinline__ void moe_convert(Frame& F, const Args& A, int j, int wg0, int nwg) {
    phase_enter(F);
    LAS float* scr = (LAS float*)(F.lds + F.wave * 16896);
    const int gw = ((int)blockIdx.x - wg0) * NWAVES + F.wave, NGW = nwg * NWAVES;
    constexpr int IE = 16 * 56, I2 = 56 * 16;
    bf16_t* MW13 = (bf16_t*)(F.ws + WS_BIG + BIG_MW13); bf16_t* MW2 = (bf16_t*)(F.ws + WS_BIG + BIG_MW2);
    for (int it = gw; it < 8 * (2 * IE + I2); it += NGW) {
        const int e = it / (2 * IE + I2); int r = it - e * (2 * IE + I2);
        const size_t we = (size_t)(j * 8 + e) * 1024 * DFFE;
        if (r < IE) { transpose_item(A.moe_w1 + we, DFFE, 0, 56, 1024, MW13 + (size_t)e * 7168 * 1024, 1, 0, scr, r, F.lane); continue; } r -= IE;
        if (r < IE) { transpose_item(A.moe_w3 + we, DFFE, 0, 56, 1024, MW13 + (size_t)e * 7168 * 1024, 1, 1, scr, r, F.lane); continue; } r -= IE;
        transpose_item(A.moe_w2 + we, 1024, 0, 16, DFFE, MW2 + (size_t)e * 1024 * DFFE, 0, 0, scr, r, F.lane);
    }
}

__device__ __forceinline__ void norm_phase(Frame& F, const Args& A, int i, int which, int mode) {
    phase_enter(F);
    const bool first = mode & 1, combine = mode & 2, route = mode & 4, fin = mode & 8, lastl = mode & 16;
    const float* MODV = (const float*)(F.ws + WS_MODV);
    bf16_t* H = (bf16_t*)F.out; bf16_t* XR = (bf16_t*)(F.ws + WS_XR);
    const bf16_t* EO = (const bf16_t*)(F.ws + WS_Y);
    LAS float* rt = (LAS float*)F.lds;
    LAS int* ents = (LAS int*)(F.lds + 32768);
    const int jm = i >> 1;
    if (route) { const float* rg = A.moe_router + (size_t)jm * 1024 * 8; for (int idx = F.tid; idx < 8192; idx += 512) rt[(idx & 7) * 1024 + (idx >> 3)] = rg[idx]; }
    __syncthreads();
    const float* nw = fin ? A.final_norm_w : ((which == 0 ? A.norm1_w : A.norm2_w) + i * 1024);
    unsigned* cnt = (unsigned*)(F.ctl + CW_CNT + (size_t)jm * 8 * 64);
    int* rlist = (int*)(F.ws + WS_RLIST); float* GATE = (float*)(F.ws + WS_GATE);
    for (int ch = blockIdx.x; ch < MROWS / 32; ch += F.G) {
        const int R0 = ch * 32, b = R0 / SROW, s0 = R0 - b * SROW; const bool isctx = s0 < NCTX; const int cond = isctx ? 16 : b;
        if (fin && isctx) continue;
        const bool do_route = route && !(lastl && isctx);
        const float* mv = MODV + (size_t)(i * 17 + cond) * 6144;
        f32x4 wv[4], shv[4], scv[4], g5[4];
#pragma unroll
        for (int j = 0; j < 4; ++j) { const int col = 4 * F.lane + 256 * j; wv[j] = *(const f32x4*)(nw + col);
            if (!fin) { shv[j] = *(const f32x4*)(mv + (which ? 3 : 0) * 1024 + col); scv[j] = *(const f32x4*)(mv + (which ? 4 : 1) * 1024 + col); }
            if (combine) g5[j] = *(const f32x4*)(MODV + (size_t)((i - 1) * 17 + cond) * 6144 + 5 * 1024 + col); }
        for (int rr = 0; rr < 4; ++rr) {
            const int R = R0 + F.wave * 4 + rr, s = s0 + F.wave * 4 + rr;
            bf16_t* xr = XR + (size_t)R * DM + 4 * F.lane;
            f32x4 v[4]; float ss = 0.f;
            if (first) { const float* src = isctx ? A.ctx + (size_t)(b * NCTX + s) * DM : A.x + (size_t)(b * SEQ + s - NCTX) * DM;
#pragma unroll
                for (int j = 0; j < 4; ++j) v[j] = *(const f32x4*)(src + 4 * F.lane + 256 * j);
            } else {
#pragma unroll
                for (int j = 0; j < 4; ++j) { const u32x2 w = *(const u32x2*)(xr + 256 * j); v[j] = (f32x4){bf_lo(w.x), bf_hi(w.x), bf_lo(w.y), bf_hi(w.y)}; }
            }
            if (combine) {
#pragma unroll
                for (int j = 0; j < 4; ++j) { const u32x2 e0 = *(const u32x2*)(EO + (size_t)(2 * R) * DM + 4 * F.lane + 256 * j), e1 = *(const u32x2*)(EO + (size_t)(2 * R + 1) * DM + 4 * F.lane + 256 * j);
                    f32x4 ev; ev.x = bf_lo(e0.x) + bf_lo(e1.x); ev.y = bf_hi(e0.x) + bf_hi(e1.x); ev.z = bf_lo(e0.y) + bf_lo(e1.y); ev.w = bf_hi(e0.y) + bf_hi(e1.y);
                    v[j] = v[j] + g5[j] * ev; }
                if (!fin) {
#pragma unroll
                    for (int j = 0; j < 4; ++j) { u32x2 o; o.x = pk2(v[j].x, v[j].y); o.y = pk2(v[j].z, v[j].w); *(u32x2*)(xr + 256 * j) = o; }
                }
            }
#pragma unroll
            for (int j = 0; j < 4; ++j) ss += (v[j].x * v[j].x + v[j].y * v[j].y) + (v[j].z * v[j].z + v[j].w * v[j].w);
            const float rstd = 1.0f / sqrtf(wave_sum(ss, F.lane) * (1.0f / DM) + EPS);
            if (fin) { float* orow = F.out + (size_t)(b * SEQ + s - NCTX) * DM;
#pragma unroll
                for (int j = 0; j < 4; ++j) *(f32x4*)(orow + 4 * F.lane + 256 * j) = v[j] * rstd * wv[j];
                continue;
            }
#pragma unroll
            for (int j = 0; j < 4; ++j) { v[j] = v[j] * rstd * wv[j] * (scv[j] + 1.0f) + shv[j];
                u32x2 o; o.x = pk2(v[j].x, v[j].y); o.y = pk2(v[j].z, v[j].w); *(u32x2*)(H + (size_t)R * DM + 4 * F.lane + 256 * j) = o; }
            if (do_route) {
                float lg[8];
#pragma unroll
                for (int e = 0; e < 8; ++e) lg[e] = 0.f;
#pragma unroll
                for (int e = 0; e < 8; ++e)
#pragma unroll
                    for (int j = 0; j < 4; ++j) { const f32x4 r = *(const LAS f32x4*)(rt + e * 1024 + 4 * F.lane + 256 * j); lg[e] += (v[j].x * r.x + v[j].y * r.y) + (v[j].z * r.z + v[j].w * r.w); }
#pragma unroll
                for (int e = 0; e < 8; ++e) lg[e] = wave_sum(lg[e], F.lane);
                int i1 = 0; float v1 = lg[0];
#pragma unroll
                for (int e = 1; e < 8; ++e) if (lg[e] > v1) { v1 = lg[e]; i1 = e; }
                int i2 = -1; float v2 = -3.0e38f;
#pragma unroll
                for (int e = 0; e < 8; ++e) if (e != i1 && lg[e] > v2) { v2 = lg[e]; i2 = e; }
                const float g1 = 1.0f / (1.0f + expf(v2 - v1)), g2 = 1.0f - g1;
                if (F.lane == 0) { ents[(F.wave * 4 + rr) * 2] = i1; ents[(F.wave * 4 + rr) * 2 + 1] = i2; GATE[(size_t)R * 2] = g1; GATE[(size_t)R * 2 + 1] = g2; }
            }
        }
        if (do_route) {
            __syncthreads();
            if (F.wave == 0) {
                const int e = ents[F.lane];
#pragma unroll
                for (int ee = 0; ee < 8; ++ee) { const unsigned long long m = __ballot(e == ee); const int n = __popcll(m);
                    if (n) { unsigned base = 0; if (F.lane == 0) base = __hip_atomic_fetch_add(cnt + ee * 64, (unsigned)n, RLX_AGENT); base = __builtin_amdgcn_readfirstlane(base);
                        if (e == ee) { const int pos = (int)base + __popcll(m & ((1ull << F.lane) - 1ull)); rlist[(size_t)ee * MROWS + pos] = (R0 + (F.lane >> 1)) * 2 + (F.lane & 1); } } }
            }
            __syncthreads();
        }
    }
}

struct EpiXbc {
    static constexpr bool PERM = true;
    bf16_t* XBC; float* DT; bf16_t* HALO;
    __device__ __forceinline__ void operator()(const f32x4 (&acc)[2][2][4][2], const pg8::Unit& u, int wr, int wc, int fr, int fq) const {
        const int row0 = u.pm * 256 + wr * 64 + fr;
        if (u.pn < 16) { const int col0 = u.pn * 256 + wc * 32 + 8 * fq;
#pragma unroll
            for (int ai = 0; ai < 2; ++ai)
#pragma unroll
                for (int m = 0; m < 4; ++m) { bf16_t* rowp = XBC + (size_t)(row0 + ai * 128 + m * 16) * CONVCH + col0;
#pragma unroll
                    for (int bj = 0; bj < 2; ++bj) { const f32x4 v0 = acc[ai][bj][m][0], v1 = acc[ai][bj][m][1]; u32x4 w; w.x = pg8::cvt_pk_bf16(v0[0], v0[1]); w.y = pg8::cvt_pk_bf16(v0[2], v0[3]); w.z = pg8::cvt_pk_bf16(v1[0], v1[1]); w.w = pg8::cvt_pk_bf16(v1[2], v1[3]);
                        *(GAS u32x4*)(rowp + bj * 128) = w;
                        const int rin = ai * 128 + wr * 64 + m * 16 + fr, rq = rin >> 6, rw = rin & 63;
                        if (rw < 2 || rw >= 62) *(GAS u32x4*)(HALO + ((size_t)u.pm * 16 + (rw < 2 ? (rq == 0 ? rw : 4 * rq + rw) : 4 * rq + rw - 60)) * CONVCH + col0 + bj * 128) = w; } }
        } else if (wc < 2) { const int c0 = wc * 32 + 8 * fq;
#pragma unroll
            for (int ai = 0; ai < 2; ++ai)
#pragma unroll
                for (int m = 0; m < 4; ++m) { float* p = DT + (size_t)(row0 + ai * 128 + m * 16) * 64 + c0; *(GAS f32x4*)p = acc[ai][0][m][0]; *(GAS f32x4*)(p + 4) = acc[ai][0][m][1]; }
        }
    }
};
struct EpiGate {
    static constexpr bool PERM = true;
    const bf16_t* Y; bf16_t* Gt; const float* nw; LAS float* P;
    __device__ __forceinline__ void operator()(f32x4 (&acc)[2][2][4][2], const pg8::Unit& u, int wr, int wc, int fr, int fq) const {
        const int row0 = u.pm * 256 + wr * 64 + fr, col0 = u.pn * 256 + wc * 32 + 8 * fq;
        u32x4 yq[2][4][2];
        { const GAS char* yb = (const GAS char*)(Y + (size_t)(u.pm * 256) * DIN + u.pn * 256); unsigned yo = (unsigned)((wr * 64 + fr) * DIN * 2); asm volatile("" : "+v"(yo));
#pragma unroll
          for (int ai = 0; ai < 2; ++ai)
#pragma unroll
            for (int m = 0; m < 4; ++m)
#pragma unroll
                for (int bj = 0; bj < 2; ++bj) { const int cg = bj * 128 + wc * 32 + 8 * fq; const int cy = ((cg >> 5) & 1) * 128 + (cg >> 6) * 32 + (cg & 31);
                    yq[ai][m][bj] = *(const GAS u32x4*)(yb + (size_t)(ai * 128 + m * 16) * DIN * 2 + yo + cy * 2); } }
#pragma unroll
        for (int ai = 0; ai < 2; ++ai)
#pragma unroll
            for (int m = 0; m < 4; ++m) { float ssq = 0.f;
#pragma unroll
                for (int bj = 0; bj < 2; ++bj) { const u32x4 yv = yq[ai][m][bj]; f32x4 z0 = acc[ai][bj][m][0], z1 = acc[ai][bj][m][1];
                    z0[0] = bf_lo(yv.x) * siluf(z0[0]); z0[1] = bf_hi(yv.x) * siluf(z0[1]); z0[2] = bf_lo(yv.y) * siluf(z0[2]); z0[3] = bf_hi(yv.y) * siluf(z0[3]);
                    z1[0] = bf_lo(yv.z) * siluf(z1[0]); z1[1] = bf_hi(yv.z) * siluf(z1[1]); z1[2] = bf_lo(yv.w) * siluf(z1[2]); z1[3] = bf_hi(yv.w) * siluf(z1[3]);
                    ssq += (z0[0] * z0[0] + z0[1] * z0[1]) + (z0[2] * z0[2] + z0[3] * z0[3]) + (z1[0] * z1[0] + z1[1] * z1[1]) + (z1[2] * z1[2] + z1[3] * z1[3]);
                    acc[ai][bj][m][0] = z0; acc[ai][bj][m][1] = z1; }
                ssq += shx(ssq, 16, fq * 16 + fr); ssq += shx(ssq, 32, fq * 16 + fr);
                if (fq == 0) P[(ai * 128 + wr * 64 + m * 16 + fr) * 4 + wc] = ssq; }
        asm volatile("s_waitcnt lgkmcnt(0)" ::: "memory"); __builtin_amdgcn_s_barrier(); asm volatile("" ::: "memory");
        f32x4 nv[2][2];
#pragma unroll
        for (int bj = 0; bj < 2; ++bj) { nv[bj][0] = *(const GAS f32x4*)(nw + col0 + bj * 128); nv[bj][1] = *(const GAS f32x4*)(nw + col0 + bj * 128 + 4); }
#pragma unroll
        for (int ai = 0; ai < 2; ++ai)
#pragma unroll
            for (int m = 0; m < 4; ++m) { const f32x4 pp = *(const LAS f32x4*)(P + (ai * 128 + wr * 64 + m * 16 + fr) * 4); const float rstd = 1.0f / sqrtf(((pp.x + pp.y) + (pp.z + pp.w)) * (1.0f / 256.0f) + EPS);
                bf16_t* gp = Gt + (size_t)(row0 + ai * 128 + m * 16) * DIN + col0;
#pragma unroll
                for (int bj = 0; bj < 2; ++bj) { const f32x4 v0 = acc[ai][bj][m][0] * rstd * nv[bj][0], v1 = acc[ai][bj][m][1] * rstd * nv[bj][1];
                    u32x4 w; w.x = pg8::cvt_pk_bf16(v0[0], v0[1]); w.y = pg8::cvt_pk_bf16(v0[2], v0[3]); w.z = pg8::cvt_pk_bf16(v1[0], v1[1]); w.w = pg8::cvt_pk_bf16(v1[2], v1[3]);
                    *(GAS u32x4*)(gp + bj * 128) = w; } }
        asm volatile("s_waitcnt lgkmcnt(0)" ::: "memory");
    }
};
struct EpiResid {
    static constexpr bool PERM = true;
    bf16_t* XR; const float* modl; int gidx; const float* bias; const float* rd_x; const float* rd_ctx;
    __device__ __forceinline__ void operator()(const f32x4 (&acc)[2][2][4][2], const pg8::Unit& u, int wr, int wc, int fr, int fq) const {
        const int b = u.pm / 17, j = u.pm - b * 17, cond = j == 0 ? 16 : b;
        const GAS char* pbase = (const GAS char*)(XR + (size_t)u.pm * 256 * DM);
        unsigned lo = (unsigned)(((wr * 64 + fr) * DM + u.pn * 256 + wc * 32 + 8 * fq) * 2); asm volatile("" : "+v"(lo));
        const GAS char* ibase = (const GAS char*)(rd_x ? (j == 0 ? rd_ctx + (size_t)(b * NCTX) * DM : rd_x + (size_t)(b * SEQ + (j - 1) * 256) * DM) : nullptr);
        const GAS float* gv = (const GAS float*)(modl + (size_t)cond * 6144 + gidx * 1024 + u.pn * 256 + wc * 32 + 8 * fq);
        const GAS float* bp = (const GAS float*)(bias ? bias + u.pn * 256 + wc * 32 + 8 * fq : nullptr);
#pragma unroll
        for (int bj = 0; bj < 2; ++bj) {
            f32x4 g[2], bv[2];
#pragma unroll
            for (int n = 0; n < 2; ++n) { g[n] = *(const GAS f32x4*)(gv + bj * 128 + n * 4); bv[n] = bp ? *(const GAS f32x4*)(bp + bj * 128 + n * 4) : (f32x4){0.f, 0.f, 0.f, 0.f}; }
#pragma unroll
            for (int ai = 0; ai < 2; ++ai) {
                f32x4 o[4][2];
                if (rd_x) {
#pragma unroll
                    for (int m = 0; m < 4; ++m)
#pragma unroll
                        for (int n = 0; n < 2; ++n) o[m][n] = *(const GAS f32x4*)(ibase + (size_t)(ai * 128 + m * 16) * DM * 4 + 2 * lo + (bj * 128 + n * 4) * 4);
                } else {
                    u32x4 w[4];
#pragma unroll
                    for (int m = 0; m < 4; ++m) w[m] = *(const GAS u32x4*)(pbase + (size_t)(ai * 128 + m * 16) * DM * 2 + lo + bj * 256);
#pragma unroll
                    for (int m = 0; m < 4; ++m) { o[m][0] = (f32x4){bf_lo(w[m].x), bf_hi(w[m].x), bf_lo(w[m].y), bf_hi(w[m].y)}; o[m][1] = (f32x4){bf_lo(w[m].z), bf_hi(w[m].z), bf_lo(w[m].w), bf_hi(w[m].w)}; }
                }
#pragma unroll
                for (int m = 0; m < 4; ++m) { const f32x4 r0 = o[m][0] + g[0] * (acc[ai][bj][m][0] + bv[0]), r1 = o[m][1] + g[1] * (acc[ai][bj][m][1] + bv[1]);
                    u32x4 w; w.x = pg8::cvt_pk_bf16(r0[0], r0[1]); w.y = pg8::cvt_pk_bf16(r0[2], r0[3]); w.z = pg8::cvt_pk_bf16(r1[0], r1[1]); w.w = pg8::cvt_pk_bf16(r1[2], r1[3]);
                    *(GAS u32x4*)(pbase + (size_t)(ai * 128 + m * 16) * DM * 2 + lo + bj * 256) = w; }
                asm volatile("" ::: "memory");
            }
        }
    }
};
struct EpiSwiglu {
    static constexpr bool PERM = true;
    bf16_t* ACT; int ldc;
    __device__ __forceinline__ void operator()(const f32x4 (&acc)[2][2][4][2], const pg8::Unit& u, int wr, int wc, int fr, int fq) const {
        const int row0 = u.pm * 256 + wr * 64 + fr, col0 = u.pn * 128 + wc * 32 + 8 * fq;
#pragma unroll
        for (int ai = 0; ai < 2; ++ai)
#pragma unroll
            for (int m = 0; m < 4; ++m) { const f32x4 g0 = acc[ai][0][m][0], g1 = acc[ai][0][m][1], u0 = acc[ai][1][m][0], u1 = acc[ai][1][m][1];
                u32x4 w; w.x = pg8::cvt_pk_bf16(siluf(g0[0]) * u0[0], siluf(g0[1]) * u0[1]); w.y = pg8::cvt_pk_bf16(siluf(g0[2]) * u0[2], siluf(g0[3]) * u0[3]);
                w.z = pg8::cvt_pk_bf16(siluf(g1[0]) * u1[0], siluf(g1[1]) * u1[1]); w.w = pg8::cvt_pk_bf16(siluf(g1[2]) * u1[2], siluf(g1[3]) * u1[3]);
                *(GAS u32x4*)(ACT + (size_t)(row0 + ai * 128 + m * 16) * ldc + col0) = w; }
    }
};
struct EpiQkv {
    static constexpr bool PERM = false;
    bf16_t *Q, *Kb, *Vb; const LAS float* T;
    __device__ __forceinline__ void operator()(const f32x4 (&acc)[2][2][4][2], const pg8::Unit& u, int wr, int wc, int fr, int fq) const {
        const int b = u.pm / 17, j = u.pm - b * 17; const bool isctx = j == 0; const int pos0 = (j - 1) * 256;
        bf16_t* dst; int ld, cbase; float sc = 1.0f;
        if (u.pn < 4) { dst = Q; ld = QW; cbase = u.pn * 256; sc = 0.125f * 1.4426950408889634f;   } else if (u.pn == 4) { dst = Kb; ld = KVW; cbase = 0; } else { dst = Vb; ld = KVW; cbase = 0; }
        const bool dorope = !isctx && u.pn < 5; const int axis = wc & 1;
        const LAS float* bp = T + 2048 + u.pn * 256 + wc * 32 + 4 * fq;
        f32x4 bv[2][2];
#pragma unroll
        for (int bj = 0; bj < 2; ++bj)
#pragma unroll
            for (int n = 0; n < 2; ++n) bv[bj][n] = *(const LAS f32x4*)(bp + bj * 128 + n * 16);
#pragma unroll
        for (int ai = 0; ai < 2; ++ai)
#pragma unroll
            for (int m = 0; m < 4; ++m) { const int r = ai * 128 + wr * 64 + m * 16 + fr; const int pos = pos0 + r; const int id = axis ? (pos & 63) : (pos >> 6);
                f32x4 cs = (f32x4){1.f, 1.f, 1.f, 1.f}, sn = (f32x4){0.f, 0.f, 0.f, 0.f};
                if (dorope) { cs = *(const LAS f32x4*)(T + id * 16 + 4 * fq); sn = *(const LAS f32x4*)(T + 1024 + id * 16 + 4 * fq); }
                GAS bf16_t* rowp = (GAS bf16_t*)(dst + (size_t)(u.pm * 256 + r) * ld + cbase + wc * 32 + 4 * fq);
#pragma unroll
                for (int bj = 0; bj < 2; ++bj) { const f32x4 x0 = (acc[ai][bj][m][0] + bv[bj][0]) * sc, x1 = (acc[ai][bj][m][1] + bv[bj][1]) * sc;
                    const f32x4 o0 = x0 * cs - x1 * sn, o1 = x1 * cs + x0 * sn;
                    u32x2 w0, w1; w0.x = pg8::cvt_pk_bf16(o0[0], o0[1]); w0.y = pg8::cvt_pk_bf16(o0[2], o0[3]); w1.x = pg8::cvt_pk_bf16(o1[0], o1[1]); w1.y = pg8::cvt_pk_bf16(o1[2], o1[3]);
                    *(GAS u32x2*)(rowp + bj * 128) = w0; *(GAS u32x2*)(rowp + bj * 128 + 16) = w1; } }
    }
};

struct MoeOrder {
    pg8::StaticOrder so; int cs; int pp[9]; int cnt[8]; const int* rlist; size_t bstride; bool GATHER_A;
    __device__ __forceinline__ void locate(int pm, int& e, int& p, int& cn) const { const int gp = cs + pm; e = 0; int pbase = 0; cn = cnt[0];
#pragma unroll
        for (int k = 1; k < 8; ++k) { const bool ge = gp >= pp[k]; e += ge ? 1 : 0; pbase = ge ? pp[k] : pbase; cn = ge ? cnt[k] : cn; }
        p = gp - pbase; }
    __device__ bool next(int i, pg8::Unit& u) const { return so.next(i, u); }
    __device__ __forceinline__ const char* a_base(const pg8::Gemm& g, const pg8::Unit& u) const { return GATHER_A ? (const char*)g.A : (const char*)g.A + (size_t)u.pm * (size_t)(256 * 2) * g.lda; }
    __device__ __forceinline__ const char* b_base(const pg8::Gemm& g, const pg8::Unit& u) const { int e, p, cn; locate(u.pm, e, p, cn); return (const char*)g.Bt + (size_t)e * bstride + (size_t)u.pn * (size_t)(256 * 2) * g.K; }
    __device__ __forceinline__ unsigned row_off(const pg8::Gemm& g, const pg8::Unit& u, int r) const {
        if (!GATHER_A) return (unsigned)r * (unsigned)g.lda * 2u;
        int e, p, cn; locate(u.pm, e, p, cn); const int idx = p * 256 + r; const int tok = idx < cn ? (rlist[(size_t)e * MROWS + idx] >> 1) : 0; return (unsigned)tok * (unsigned)g.lda * 2u; }
};
struct EpiMoeDown {
    static constexpr bool PERM = true;
    MoeOrder mo; bf16_t* EO; const float* GATE;
    __device__ __forceinline__ void operator()(const f32x4 (&acc)[2][2][4][2], const pg8::Unit& u, int wr, int wc, int fr, int fq) const {
        int e, p, cn; mo.locate(u.pm, e, p, cn); const int* rl = mo.rlist + (size_t)e * MROWS + p * 256;
        const int col0 = u.pn * 256 + wc * 32 + 8 * fq;
#pragma unroll
        for (int ai = 0; ai < 2; ++ai)
#pragma unroll
            for (int m = 0; m < 4; ++m) { const int r = ai * 128 + wr * 64 + m * 16 + fr;
                if (p * 256 + r < cn) { const int ent = rl[r]; const float gt = GATE[ent]; bf16_t* dp = EO + (size_t)ent * DM + col0;
#pragma unroll
                    for (int bj = 0; bj < 2; ++bj) { const f32x4 v0 = acc[ai][bj][m][0] * gt, v1 = acc[ai][bj][m][1] * gt; u32x4 w; w.x = pg8::cvt_pk_bf16(v0[0], v0[1]); w.y = pg8::cvt_pk_bf16(v0[2], v0[3]); w.z = pg8::cvt_pk_bf16(v1[0], v1[1]); w.w = pg8::cvt_pk_bf16(v1[2], v1[3]);
                        *(GAS u32x4*)(dp + bj * 128) = w; } } }
    }
};

typedef __bf16 bf16x2_t __attribute__((ext_vector_type(2)));
typedef short v4i16_t __attribute__((ext_vector_type(4)));
__device__ __forceinline__ unsigned cvtpk(float lo, float hi) { f32x2 v = {lo, hi}; bf16x2_t b = __builtin_convertvector(v, bf16x2_t); return __builtin_bit_cast(unsigned, b); }
__device__ __forceinline__ int crow(int r, int hi) { return (r & 3) + 8 * (r >> 2) + 4 * hi; }
__device__ __forceinline__ s16x4 vtr(const LAS unsigned char* p) { return __builtin_bit_cast(s16x4, __builtin_amdgcn_ds_read_tr16_b64_v4i16((LAS v4i16_t*)p)); }
#define MFMA32(a, b, c) __builtin_amdgcn_mfma_f32_32x32x16_bf16((a), (b), (c), 0, 0, 0)
__device__ __forceinline__ void conv_phase(Frame& F, const Args& A, int j) {
    phase_enter(F);
    bf16_t* XBC = (bf16_t*)(F.ws + WS_BIG); const bf16_t* HALO = (const bf16_t*)(F.ws + WS_HALO);
    const int lane = F.lane;
    const int gw = blockIdx.x * NWAVES + F.wave, NGW = F.G * NWAVES;
    for (int task = gw; task < NPAN * 32; task += NGW) {
        const int pm = task >> 5, q = (task >> 3) & 3, sl = task & 7, jj = pm % 17, c0 = sl * 512 + lane * 8;
        const bool top_zero = q == 0 && jj <= 1, bot_zero = q == 3 && (jj == 0 || jj == 16);
        const GAS bf16_t* htop = (const GAS bf16_t*)(HALO + (q == 0 ? ((size_t)(pm - 1) * 16 + 14) : ((size_t)pm * 16 + 4 * q - 2)) * CONVCH + c0);
        const GAS bf16_t* hbot = (const GAS bf16_t*)(HALO + (q == 3 ? ((size_t)(pm + 1) * 16 + 0) : ((size_t)pm * 16 + 4 * q + 4)) * CONVCH + c0);
        f32x2 cw[5][4], cbias[4];
#pragma unroll
        for (int k = 0; k < 5; ++k) { const f32x4 a0 = *(const GAS f32x4*)(A.ssd_conv_w + (size_t)(j * 5 + k) * CONVCH + c0), a1 = *(const GAS f32x4*)(A.ssd_conv_w + (size_t)(j * 5 + k) * CONVCH + c0 + 4);
            cw[k][0] = (f32x2){a0.x, a0.y}; cw[k][1] = (f32x2){a0.z, a0.w}; cw[k][2] = (f32x2){a1.x, a1.y}; cw[k][3] = (f32x2){a1.z, a1.w}; }
        { const f32x4 a0 = *(const GAS f32x4*)(A.ssd_conv_b + (size_t)j * CONVCH + c0), a1 = *(const GAS f32x4*)(A.ssd_conv_b + (size_t)j * CONVCH + c0 + 4);
            cbias[0] = (f32x2){a0.x, a0.y}; cbias[1] = (f32x2){a0.z, a0.w}; cbias[2] = (f32x2){a1.x, a1.y}; cbias[3] = (f32x2){a1.z, a1.w}; }
        GAS bf16_t* base = (GAS bf16_t*)(XBC + ((size_t)pm * 256 + q * 64) * CONVCH + c0);
        const u32x4 zero4 = (u32x4){0u, 0u, 0u, 0u};
        u32x4 win[12], pre[8];
        win[0] = top_zero ? zero4 : *(const GAS u32x4*)(htop);
        win[1] = top_zero ? zero4 : *(const GAS u32x4*)(htop + CONVCH);
#pragma unroll
        for (int r = 0; r < 10; ++r) win[2 + r] = *(const GAS u32x4*)(base + (size_t)r * CONVCH);
        for (int k = 0; k < 8; ++k) {
            if (k < 6) {
#pragma unroll
                for (int r = 0; r < 8; ++r) pre[r] = *(const GAS u32x4*)(base + (size_t)(8 * k + 10 + r) * CONVCH);
            } else if (k == 6) {
#pragma unroll
                for (int r = 0; r < 6; ++r) pre[r] = *(const GAS u32x4*)(base + (size_t)(58 + r) * CONVCH);
                pre[6] = bot_zero ? zero4 : *(const GAS u32x4*)(hbot);
                pre[7] = bot_zero ? zero4 : *(const GAS u32x4*)(hbot + CONVCH);
            }
#pragma unroll
            for (int o = 0; o < 8; ++o) {
                f32x2 r[4];
#pragma unroll
                for (int c = 0; c < 4; ++c) r[c] = cbias[c];
#pragma unroll
                for (int t = 0; t < 5; ++t) { const u32x4 w = win[o + t];
                    r[0] += cw[t][0] * (f32x2){bf_lo(w.x), bf_hi(w.x)}; r[1] += cw[t][1] * (f32x2){bf_lo(w.y), bf_hi(w.y)};
                    r[2] += cw[t][2] * (f32x2){bf_lo(w.z), bf_hi(w.z)}; r[3] += cw[t][3] * (f32x2){bf_lo(w.w), bf_hi(w.w)}; }
                u32x4 w; w.x = cvtpk(siluf(r[0].x), siluf(r[0].y)); w.y = cvtpk(siluf(r[1].x), siluf(r[1].y)); w.z = cvtpk(siluf(r[2].x), siluf(r[2].y)); w.w = cvtpk(siluf(r[3].x), siluf(r[3].y));
                *(GAS u32x4*)(base + (size_t)(8 * k + o) * CONVCH) = w;
            }
#pragma unroll
            for (int r = 0; r < 4; ++r) win[r] = win[8 + r];
#pragma unroll
            for (int r = 0; r < 8; ++r) win[4 + r] = pre[r];
        }
    }
}

constexpr int SC_RS = 272;
constexpr int SC_TILE = 3 * 32 * SC_RS;
constexpr int SC_YS = 2 * SC_TILE;
constexpr int SC_WS = SC_YS + 16384;
constexpr int SC_RAW = 73728;
static_assert(SC_WS + 4096 <= SC_RAW && SC_RAW + 2 * 36 * 1024 <= LDSCTL_OFF, "scan LDS map");
template <int PH>
__device__ __forceinline__ void scan_phase(Frame& F, const Args& A, int j) {
    phase_enter(F);
    const bf16_t* XBC = (const bf16_t*)(F.ws + WS_BIG); const float* DT = (const float*)(F.ws + WS_DT); bf16_t* Y = (bf16_t*)(F.ws + WS_Y);
    const int lane = F.lane, wave = F.wave;
    for (int u0 = blockIdx.x; u0 < 256; u0 += F.G) {
        const int unit = (F.G == 256) ? ((u0 & 7) * 32 + (u0 >> 3)) : u0;
        const int b = unit >> 4, g = (unit >> 1) & 7, ph = unit & 1;
        const int srow = F.tid >> 4, sch = F.tid & 15;
        const int gcolB = 2048 + g * 128 + sch * 8, gcolC = 3072 + g * 128 + sch * 8, gcolX = g * 256 + (sch >> 2) * 64 + ph * 32 + (sch & 3) * 8;
        const int hh = wave >> 1, dir = wave & 1, c31 = lane & 31, hl = lane >> 5;
        const int trq = (lane & 15) >> 2, trp = lane & 3, trb = (lane >> 4) & 1;
        const int head = g * 4 + hh;
        const float Dk = A.ssd_d[(j * 2 + dir) * 32 + head], dtb = A.ssd_dt_bias[(j * 2 + dir) * 32 + head], aneg = -expf(A.ssd_a_log[(j * 2 + dir) * 32 + head]);
        LAS float* wsf = (LAS float*)(F.lds + SC_WS + wave * 512);
        int offRow = dir * SC_TILE + c31 * SC_RS + 16 * hl;
        int offC4 = dir * SC_TILE + 32 * SC_RS + c31 * SC_RS + 8 * hl;
        int offTrX = dir * SC_TILE + 64 * SC_RS + trq * SC_RS + (hh * 32 + 16 * trb + 4 * trp) * 2;
        int offTrB = dir * SC_TILE + trq * SC_RS + (16 * trb + 4 * trp) * 2;
        int ysoff = (4 * hl) * 128 + hh * 32 + c31;
        asm volatile("" : "+v"(offRow), "+v"(offC4), "+v"(offTrX), "+v"(offTrB), "+v"(ysoff));
        f32x16 ST[4];
#pragma unroll
        for (int t = 0; t < 4; ++t)
#pragma unroll
            for (int e = 0; e < 16; ++e) ST[t][e] = 0.f;
#define SC_PF(pf, st_) do { const int st = (PH >= 2) ? 0 : (st_); const int cf_ = (st), cb_ = (st) < 8 ? 7 - (st) : 143 - (st); \
            _Pragma("unroll") for (int T = 0; T < 2; ++T) { const GAS bf16_t* rp = (const GAS bf16_t*)(XBC + (size_t)(b * SROW + (T ? cb_ : cf_) * 32 + srow) * CONVCH); \
                pf[T][0] = *(const GAS u32x4*)(rp + gcolB); pf[T][1] = *(const GAS u32x4*)(rp + gcolC); pf[T][2] = *(const GAS u32x4*)(rp + gcolX); } } while (0)
#define SC_DTLOAD(st) DT[(size_t)(b * SROW + (dir ? ((st) < 8 ? 7 - (st) : 143 - (st)) : (st)) * 32 + c31) * 64 + dir * 32 + head]
#define SC_WRITEOUT(st) do { const int cf_ = (st), cb_ = (st) < 8 ? 7 - (st) : 143 - (st); \
            _Pragma("unroll") for (int T = 0; T < 2; ++T) { const int tok = F.tid >> 4, h4 = (F.tid >> 2) & 3, q4 = F.tid & 3, chunk = T ? cb_ : cf_; \
                const int other = T == 0 ? (chunk < 8 ? 7 - chunk : 143 - chunk) : chunk; \
                u32x4 v = *(const LAS u32x4*)(F.lds + SC_YS + T * 8192 + (tok * 128 + h4 * 32 + q4 * 8) * 2); \
                bf16_t* yp = Y + (size_t)(b * SROW + chunk * 32 + tok) * DIN + g * 256 + ph * 128 + h4 * 32 + q4 * 8; \
                if ((st) > other) { const u32x4 o = oldy[T]; \
                    v.x = pk2(bf_lo(o.x) + bf_lo(v.x), bf_hi(o.x) + bf_hi(v.x)); v.y = pk2(bf_lo(o.y) + bf_lo(v.y), bf_hi(o.y) + bf_hi(v.y)); \
                    v.z = pk2(bf_lo(o.z) + bf_lo(v.z), bf_hi(o.z) + bf_hi(v.z)); v.w = pk2(bf_lo(o.w) + bf_lo(v.w), bf_hi(o.w) + bf_hi(v.w)); } \
                if (PH == 0) *(u32x4*)yp = v; else asm volatile("" :: "v"(v)); } } while (0)
        u32x4 pfE[2][3], pfO[2][3];
        SC_PF(pfE, 0); SC_PF(pfO, 1);
        float dtraw = SC_DTLOAD(0);
        u32x4 oldy[2] = {(u32x4){0u, 0u, 0u, 0u}, (u32x4){0u, 0u, 0u, 0u}};
        for (int step2 = 0; step2 < 136; step2 += 2) {
          { const int step = step2;
            const int cf = step, cbk = step < 8 ? 7 - step : 143 - step;
            __syncthreads();
            if (step > 0) SC_WRITEOUT(step - 1);
#pragma unroll
            for (int T = 0; T < 2; ++T)
#pragma unroll
                for (int a = 0; a < 3; ++a) *(LAS u32x4*)(F.lds + T * SC_TILE + a * (32 * SC_RS) + srow * SC_RS + sch * 16) = pfE[T][a];
            {
                const float xb = dtraw + dtb;
                const float dt = xb > 20.f ? xb : log1pf(__expf(xb)); const float dA = dt * aneg;
                float v = dA;
                v += __builtin_bit_cast(float, __builtin_amdgcn_update_dpp(0, __builtin_bit_cast(int, v), 0x111, 0xf, 0xf, true));
                v += __builtin_bit_cast(float, __builtin_amdgcn_update_dpp(0, __builtin_bit_cast(int, v), 0x112, 0xf, 0xf, true));
                v += __builtin_bit_cast(float, __builtin_amdgcn_update_dpp(0, __builtin_bit_cast(int, v), 0x114, 0xf, 0xf, true));
                v += __builtin_bit_cast(float, __builtin_amdgcn_update_dpp(0, __builtin_bit_cast(int, v), 0x118, 0xf, 0xf, true));
                v += __builtin_bit_cast(float, __builtin_amdgcn_update_dpp(0, __builtin_bit_cast(int, v), 0x142, 0xa, 0xf, false));
                const float tot = __builtin_bit_cast(float, __builtin_amdgcn_readlane(__builtin_bit_cast(int, v), 31));
                const float cum = dir ? (tot - v + dA) : v;
                if (hl == 0) { wsf[c31] = cum; wsf[32 + c31] = dt; wsf[64 + c31] = __expf(tot - cum) * dt; wsf[96 + c31] = __expf(cum); }
            }
            asm volatile("s_waitcnt lgkmcnt(0)" ::: "memory"); __builtin_amdgcn_s_barrier(); asm volatile("" ::: "memory");
            if (step + 2 < 136) SC_PF(pfE, step + 2); if (step + 1 < 136) dtraw = SC_DTLOAD(step + 1);
#pragma unroll
            for (int T = 0; T < 2; ++T) {
                const int tok = F.tid >> 4, h4 = (F.tid >> 2) & 3, q4 = F.tid & 3, chunk = T ? cbk : cf;
                const int other = T == 0 ? (chunk < 8 ? 7 - chunk : 143 - chunk) : chunk;
                if (PH == 0 && step > other) oldy[T] = *(const u32x4*)(Y + (size_t)(b * SROW + chunk * 32 + tok) * DIN + g * 256 + ph * 128 + h4 * 32 + q4 * 8);
            }
            if (PH < 3) {
                const LAS unsigned char* Bs = F.lds + dir * SC_TILE; const LAS unsigned char* Cs = Bs + 32 * SC_RS; const LAS unsigned char* xs = Bs + 64 * SC_RS;
                f32x16 gt;
#pragma unroll
                for (int e = 0; e < 16; ++e) gt[e] = 0.f;
#pragma unroll
                for (int s = 0; s < 8; ++s) { const bf16x8 a = *(const LAS bf16x8*)(F.lds + offRow + 32 * s), bb = *(const LAS bf16x8*)(F.lds + offRow + 32 * SC_RS + 32 * s); gt = MFMA32(a, bb, gt); }
                const float cum_i = wsf[c31];
                bf16x8 mk[2];
                {
                    float mv[16];
#pragma unroll
                    for (int q = 0; q < 4; ++q) { const f32x4 cj = *(const LAS f32x4*)(wsf + 8 * q + 4 * hl), dj = *(const LAS f32x4*)(wsf + 32 + 8 * q + 4 * hl);
#pragma unroll
                        for (int z = 0; z < 4; ++z) { const int jj = 8 * q + 4 * hl + z; const bool ok = dir ? (jj >= c31) : (jj <= c31);
                            float val = gt[4 * q + z] * __expf(ok ? (cum_i - cj[z]) : -INFINITY) * dj[z]; if (jj == c31) val += Dk; mv[4 * q + z] = val; } }
#pragma unroll
                    for (int s2 = 0; s2 < 2; ++s2) { u32x4 w; w.x = cvtpk(mv[8 * s2], mv[8 * s2 + 1]); w.y = cvtpk(mv[8 * s2 + 2], mv[8 * s2 + 3]); w.z = cvtpk(mv[8 * s2 + 4], mv[8 * s2 + 5]); w.w = cvtpk(mv[8 * s2 + 6], mv[8 * s2 + 7]); mk[s2] = __builtin_bit_cast(bf16x8, w); }
                }
                f32x16 ya;
#pragma unroll
                for (int e = 0; e < 16; ++e) ya[e] = 0.f;
#pragma unroll
                for (int t = 0; t < 4; ++t)
#pragma unroll
                    for (int s2 = 0; s2 < 2; ++s2) {
                        const LAS unsigned char* cp = F.lds + offC4 + 64 * t + 32 * s2;
                        const u32x2 c0 = *(const LAS u32x2*)cp, c1 = *(const LAS u32x2*)(cp + 16);
                        const bf16x8 ca = __builtin_bit_cast(bf16x8, (u32x4){c0.x, c0.y, c1.x, c1.y});
                        u32x4 w; w.x = cvtpk(ST[t][8 * s2], ST[t][8 * s2 + 1]); w.y = cvtpk(ST[t][8 * s2 + 2], ST[t][8 * s2 + 3]); w.z = cvtpk(ST[t][8 * s2 + 4], ST[t][8 * s2 + 5]); w.w = cvtpk(ST[t][8 * s2 + 6], ST[t][8 * s2 + 7]);
                        ya = MFMA32(ca, __builtin_bit_cast(bf16x8, w), ya);
                    }
#pragma unroll
                for (int q = 0; q < 4; ++q) { const f32x4 ec = *(const LAS f32x4*)(wsf + 96 + 8 * q + 4 * hl); ya[4 * q] *= ec.x; ya[4 * q + 1] *= ec.y; ya[4 * q + 2] *= ec.z; ya[4 * q + 3] *= ec.w; }
#pragma unroll
                for (int s2 = 0; s2 < 2; ++s2) {
                    const LAS unsigned char* xp = F.lds + offTrX + (16 * s2) * SC_RS + hl * (4 * SC_RS);
                    const s16x4 lo = vtr(xp), hi = vtr(xp + 8 * SC_RS);
                    ya = MFMA32(mk[s2], ((bf16x8){lo[0], lo[1], lo[2], lo[3], hi[0], hi[1], hi[2], hi[3]}), ya);
                }
                {
                    const float etot = dir ? wsf[96] : wsf[96 + 31];
#pragma unroll
                    for (int t = 0; t < 4; ++t)
#pragma unroll
                        for (int e = 0; e < 16; ++e) ST[t][e] *= etot;
#pragma unroll
                    for (int s2 = 0; s2 < 2; ++s2) {
                        const LAS unsigned char* xp = F.lds + offTrX + (16 * s2) * SC_RS + hl * (8 * SC_RS);
                        const s16x4 lo = vtr(xp), hi = vtr(xp + 4 * SC_RS);
                        const f32x4 w0 = *(const LAS f32x4*)(wsf + 64 + 16 * s2 + 8 * hl), w1 = *(const LAS f32x4*)(wsf + 64 + 16 * s2 + 8 * hl + 4);
                        u32x4 xw; xw.x = cvtpk(bf1((bf16_t)lo[0]) * w0.x, bf1((bf16_t)lo[1]) * w0.y); xw.y = cvtpk(bf1((bf16_t)lo[2]) * w0.z, bf1((bf16_t)lo[3]) * w0.w);
                        xw.z = cvtpk(bf1((bf16_t)hi[0]) * w1.x, bf1((bf16_t)hi[1]) * w1.y); xw.w = cvtpk(bf1((bf16_t)hi[2]) * w1.z, bf1((bf16_t)hi[3]) * w1.w);
                        const bf16x8 xb8 = __builtin_bit_cast(bf16x8, xw);
#pragma unroll
                        for (int t = 0; t < 4; ++t) {
                            const LAS unsigned char* bp = F.lds + offTrB + (16 * s2) * SC_RS + hl * (8 * SC_RS) + 64 * t;
                            const s16x4 blo = vtr(bp), bhi = vtr(bp + 4 * SC_RS);
                            ST[t] = MFMA32(((bf16x8){blo[0], blo[1], blo[2], blo[3], bhi[0], bhi[1], bhi[2], bhi[3]}), xb8, ST[t]);
                        }
                    }
                }
                LAS bf16_t* ys = (LAS bf16_t*)(F.lds + SC_YS + dir * 8192) + ysoff;
#pragma unroll
                for (int e = 0; e < 16; e += 2) { const unsigned w = cvtpk(ya[e], ya[e + 1]); ys[((e & 3) + 8 * (e >> 2)) * 128] = (bf16_t)w; ys[((e & 3) + 1 + 8 * (e >> 2)) * 128] = (bf16_t)(w >> 16); }
            }
                  }
          { const int step = step2 + 1;
            const int cf = step, cbk = step < 8 ? 7 - step : 143 - step;
            __syncthreads();
            if (step > 0) SC_WRITEOUT(step - 1);
#pragma unroll
            for (int T = 0; T < 2; ++T)
#pragma unroll
                for (int a = 0; a < 3; ++a) *(LAS u32x4*)(F.lds + T * SC_TILE + a * (32 * SC_RS) + srow * SC_RS + sch * 16) = pfO[T][a];
            {
                const float xb = dtraw + dtb;
                const float dt = xb > 20.f ? xb : log1pf(__expf(xb)); const float dA = dt * aneg;
                float v = dA;
                v += __builtin_bit_cast(float, __builtin_amdgcn_update_dpp(0, __builtin_bit_cast(int, v), 0x111, 0xf, 0xf, true));
                v += __builtin_bit_cast(float, __builtin_amdgcn_update_dpp(0, __builtin_bit_cast(int, v), 0x112, 0xf, 0xf, true));
                v += __builtin_bit_cast(float, __builtin_amdgcn_update_dpp(0, __builtin_bit_cast(int, v), 0x114, 0xf, 0xf, true));
                v += __builtin_bit_cast(float, __builtin_amdgcn_update_dpp(0, __builtin_bit_cast(int, v), 0x118, 0xf, 0xf, true));
                v += __builtin_bit_cast(float, __builtin_amdgcn_update_dpp(0, __builtin_bit_cast(int, v), 0x142, 0xa, 0xf, false));
                const float tot = __builtin_bit_cast(float, __builtin_amdgcn_readlane(__builtin_bit_cast(int, v), 31));
                const float cum = dir ? (tot - v + dA) : v;
                if (hl == 0) { wsf[c31] = cum; wsf[32 + c31] = dt; wsf[64 + c31] = __expf(tot - cum) * dt; wsf[96 + c31] = __expf(cum); }
            }
            asm volatile("s_waitcnt lgkmcnt(0)" ::: "memory"); __builtin_amdgcn_s_barrier(); asm volatile("" ::: "memory");
            if (step + 2 < 136) SC_PF(pfO, step + 2); if (step + 1 < 136) dtraw = SC_DTLOAD(step + 1);
#pragma unroll
            for (int T = 0; T < 2; ++T) {
                const int tok = F.tid >> 4, h4 = (F.tid >> 2) & 3, q4 = F.tid & 3, chunk = T ? cbk : cf;
                const int other = T == 0 ? (chunk < 8 ? 7 - chunk : 143 - chunk) : chunk;
                if (PH == 0 && step > other) oldy[T] = *(const u32x4*)(Y + (size_t)(b * SROW + chunk * 32 + tok) * DIN + g * 256 + ph * 128 + h4 * 32 + q4 * 8);
            }
            if (PH < 3) {
                const LAS unsigned char* Bs = F.lds + dir * SC_TILE; const LAS unsigned char* Cs = Bs + 32 * SC_RS; const LAS unsigned char* xs = Bs + 64 * SC_RS;
                f32x16 gt;
#pragma unroll
                for (int e = 0; e < 16; ++e) gt[e] = 0.f;
#pragma unroll
                for (int s = 0; s < 8; ++s) { const bf16x8 a = *(const LAS bf16x8*)(F.lds + offRow + 32 * s), bb = *(const LAS bf16x8*)(F.lds + offRow + 32 * SC_RS + 32 * s); gt = MFMA32(a, bb, gt); }
                const float cum_i = wsf[c31];
                bf16x8 mk[2];
                {
                    float mv[16];
#pragma unroll
                    for (int q = 0; q < 4; ++q) { const f32x4 cj = *(const LAS f32x4*)(wsf + 8 * q + 4 * hl), dj = *(const LAS f32x4*)(wsf + 32 + 8 * q + 4 * hl);
#pragma unroll
                        for (int z = 0; z < 4; ++z) { const int jj = 8 * q + 4 * hl + z; const bool ok = dir ? (jj >= c31) : (jj <= c31);
                            float val = gt[4 * q + z] * __expf(ok ? (cum_i - cj[z]) : -INFINITY) * dj[z]; if (jj == c31) val += Dk; mv[4 * q + z] = val; } }
#pragma unroll
                    for (int s2 = 0; s2 < 2; ++s2) { u32x4 w; w.x = cvtpk(mv[8 * s2], mv[8 * s2 + 1]); w.y = cvtpk(mv[8 * s2 + 2], mv[8 * s2 + 3]); w.z = cvtpk(mv[8 * s2 + 4], mv[8 * s2 + 5]); w.w = cvtpk(mv[8 * s2 + 6], mv[8 * s2 + 7]); mk[s2] = __builtin_bit_cast(bf16x8, w); }
                }
                f32x16 ya;
#pragma unroll
                for (int e = 0; e < 16; ++e) ya[e] = 0.f;
#pragma unroll
                for (int t = 0; t < 4; ++t)
#pragma unroll
                    for (int s2 = 0; s2 < 2; ++s2) {
                        const LAS unsigned char* cp = F.lds + offC4 + 64 * t + 32 * s2;
                        const u32x2 c0 = *(const LAS u32x2*)cp, c1 = *(const LAS u32x2*)(cp + 16);
                        const bf16x8 ca = __builtin_bit_cast(bf16x8, (u32x4){c0.x, c0.y, c1.x, c1.y});
                        u32x4 w; w.x = cvtpk(ST[t][8 * s2], ST[t][8 * s2 + 1]); w.y = cvtpk(ST[t][8 * s2 + 2], ST[t][8 * s2 + 3]); w.z = cvtpk(ST[t][8 * s2 + 4], ST[t][8 * s2 + 5]); w.w = cvtpk(ST[t][8 * s2 + 6], ST[t][8 * s2 + 7]);
                        ya = MFMA32(ca, __builtin_bit_cast(bf16x8, w), ya);
                    }
#pragma unroll
                for (int q = 0; q < 4; ++q) { const f32x4 ec = *(const LAS f32x4*)(wsf + 96 + 8 * q + 4 * hl); ya[4 * q] *= ec.x; ya[4 * q + 1] *= ec.y; ya[4 * q + 2] *= ec.z; ya[4 * q + 3] *= ec.w; }
#pragma unroll
                for (int s2 = 0; s2 < 2; ++s2) {
                    const LAS unsigned char* xp = F.lds + offTrX + (16 * s2) * SC_RS + hl * (4 * SC_RS);
                    const s16x4 lo = vtr(xp), hi = vtr(xp + 8 * SC_RS);
                    ya = MFMA32(mk[s2], ((bf16x8){lo[0], lo[1], lo[2], lo[3], hi[0], hi[1], hi[2], hi[3]}), ya);
                }
                {
                    const float etot = dir ? wsf[96] : wsf[96 + 31];
#pragma unroll
                    for (int t = 0; t < 4; ++t)
#pragma unroll
                        for (int e = 0; e < 16; ++e) ST[t][e] *= etot;
#pragma unroll
                    for (int s2 = 0; s2 < 2; ++s2) {
                        const LAS unsigned char* xp = F.lds + offTrX + (16 * s2) * SC_RS + hl * (8 * SC_RS);
                        const s16x4 lo = vtr(xp), hi = vtr(xp + 4 * SC_RS);
                        const f32x4 w0 = *(const LAS f32x4*)(wsf + 64 + 16 * s2 + 8 * hl), w1 = *(const LAS f32x4*)(wsf + 64 + 16 * s2 + 8 * hl + 4);
                        u32x4 xw; xw.x = cvtpk(bf1((bf16_t)lo[0]) * w0.x, bf1((bf16_t)lo[1]) * w0.y); xw.y = cvtpk(bf1((bf16_t)lo[2]) * w0.z, bf1((bf16_t)lo[3]) * w0.w);
                        xw.z = cvtpk(bf1((bf16_t)hi[0]) * w1.x, bf1((bf16_t)hi[1]) * w1.y); xw.w = cvtpk(bf1((bf16_t)hi[2]) * w1.z, bf1((bf16_t)hi[3]) * w1.w);
                        const bf16x8 xb8 = __builtin_bit_cast(bf16x8, xw);
#pragma unroll
                        for (int t = 0; t < 4; ++t) {
                            const LAS unsigned char* bp = F.lds + offTrB + (16 * s2) * SC_RS + hl * (8 * SC_RS) + 64 * t;
                            const s16x4 blo = vtr(bp), bhi = vtr(bp + 4 * SC_RS);
                            ST[t] = MFMA32(((bf16x8){blo[0], blo[1], blo[2], blo[3], bhi[0], bhi[1], bhi[2], bhi[3]}), xb8, ST[t]);
                        }
                    }
                }
                LAS bf16_t* ys = (LAS bf16_t*)(F.lds + SC_YS + dir * 8192) + ysoff;
#pragma unroll
                for (int e = 0; e < 16; e += 2) { const unsigned w = cvtpk(ya[e], ya[e + 1]); ys[((e & 3) + 8 * (e >> 2)) * 128] = (bf16_t)w; ys[((e & 3) + 1 + 8 * (e >> 2)) * 128] = (bf16_t)(w >> 16); }
            }
                  }
        }
        VM_WAIT(); __syncthreads();
        SC_WRITEOUT(135);
#undef SC_PF
#undef SC_DTLOAD
#undef SC_WRITEOUT
        __syncthreads();
    }
}

__device__ __forceinline__ void attn_phase(Frame& F, const Args& A, int ja, bool need_ctx, int nwg) {
    phase_enter(F);
    const bf16_t* Q = (const bf16_t*)(F.ws + WS_BIG); bf16_t* O = (bf16_t*)F.out;     const bf16_t* Kb = (const bf16_t*)(F.ws + WS_BIG + BIG_K); const bf16_t* Vb = (const bf16_t*)(F.ws + WS_BIG + BIG_V);
    LAS unsigned char* Kl = F.lds; LAS unsigned char* Vl = F.lds + 9216;
    const int nunits = 2048 + (need_ctx ? 128 : 0);
    const int lane = F.lane, r = F.wave >> 1, rh = F.wave & 1, c31 = lane & 31, hl = lane >> 5;
    const int prow = F.tid >> 3, ppc = F.tid & 7;
    const int trq = (lane & 15) >> 2, trp = lane & 3, trb = (lane >> 4) & 1;
    for (int unit = blockIdx.x; unit < nunits; unit += nwg) {
        int b, g, nblk; bool cq;
        if (unit < 2048) { b = unit >> 7; nblk = (unit >> 2) & 31; g = unit & 3; cq = false; } else { const int u2 = unit - 2048; b = u2 >> 3; nblk = (u2 >> 2) & 1; g = u2 & 3; cq = true; }
        const int qrow0 = b * SROW + (cq ? 128 * nblk : NCTX + 128 * nblk);
        const int start = 128 * nblk;
        bf16x8 qf[2][4];
#pragma unroll
        for (int qb = 0; qb < 2; ++qb)
#pragma unroll
            for (int s = 0; s < 4; ++s) qf[qb][s] = *(const bf16x8*)(Q + (size_t)(qrow0 + 64 * rh + 32 * qb + c31) * QW + g * 256 + r * 64 + 16 * s + 8 * hl);
        const float sink = A.attn_sink[ja * 16 + g * 4 + r] * 1.4426950408889634f;
        float mrun[2] = {sink, sink}, lrun[2] = {1.f, 1.f};
        f32x16 ot[2][2];
#pragma unroll
        for (int db = 0; db < 2; ++db)
#pragma unroll
            for (int qb = 0; qb < 2; ++qb)
#pragma unroll
                for (int e = 0; e < 16; ++e) ot[db][qb][e] = 0.f;
        const int tt_lo = cq ? 0 : (nblk == 0 ? 2 : 0), tt_hi = cq ? 0 : (nblk == 31 ? 4 : 6);
        const int ntile = 4 + (tt_hi - tt_lo);
#define TILE_ROW0(t) ((t) < 4 ? b * SROW + 64 * (t) : b * SROW + NCTX + start - 128 + 64 * (tt_lo + (t) - 4))
        u32x4 kreg, vreg;
        { const int r0 = TILE_ROW0(0); kreg = *(const u32x4*)(Kb + (size_t)(r0 + prow) * KVW + g * 64 + ppc * 8); vreg = *(const u32x4*)(Vb + (size_t)(r0 + prow) * KVW + g * 64 + ppc * 8); }
        for (int t = 0; t < ntile; ++t) {
            __syncthreads();
            *(LAS u32x4*)(Kl + prow * 144 + ppc * 16) = kreg; *(LAS u32x4*)(Vl + prow * 144 + ppc * 16) = vreg;
            __syncthreads();
            if (t + 1 < ntile) { const int r0 = TILE_ROW0(t + 1); kreg = *(const u32x4*)(Kb + (size_t)(r0 + prow) * KVW + g * 64 + ppc * 8); vreg = *(const u32x4*)(Vb + (size_t)(r0 + prow) * KVW + g * 64 + ppc * 8); }
            const int dk0 = (t >= 4) ? (-128 + 64 * (tt_lo + t - 4)) - 64 * rh : 0;
            const bool tile_empty = (t >= 4) && (dk0 <= -192 || dk0 >= 192);
            const bool tile_mask = (t >= 4) && !tile_empty && (dk0 < -65 || dk0 > 65);
            if (!tile_empty) {
            f32x16 st[2][2];
#pragma unroll
            for (int kb = 0; kb < 2; ++kb) {
#pragma unroll
                for (int qb = 0; qb < 2; ++qb)
#pragma unroll
                    for (int e = 0; e < 16; ++e) st[kb][qb][e] = 0.f;
#pragma unroll
                for (int s = 0; s < 4; ++s) { const bf16x8 a = *(const LAS bf16x8*)(Kl + (32 * kb + c31) * 144 + (16 * s + 8 * hl) * 2);
                    st[kb][0] = MFMA32(a, qf[0][s], st[kb][0]); st[kb][1] = MFMA32(a, qf[1][s], st[kb][1]); }
            }
            if (tile_mask) { const int kpos0 = start - 128 + 64 * (tt_lo + t - 4);
#pragma unroll
                for (int kb = 0; kb < 2; ++kb)
#pragma unroll
                    for (int qb = 0; qb < 2; ++qb) { const int qpos = start + 64 * rh + 32 * qb + c31;
#pragma unroll
                        for (int e = 0; e < 16; ++e) { const int d = qpos - (kpos0 + 32 * kb + crow(e, hl)); if (d > 128 || d < -128) st[kb][qb][e] = -INFINITY; } }
            }
#pragma unroll
            for (int qb = 0; qb < 2; ++qb) {
                float mx = st[0][qb][0];
#pragma unroll
                for (int kb = 0; kb < 2; ++kb)
#pragma unroll
                    for (int e = 0; e < 16; ++e) mx = fmaxf(mx, st[kb][qb][e]);
                mx = fmaxf(mx, shx(mx, 32, lane));
                const float mn = fmaxf(mrun[qb], mx);
                const bool grew = mn > mrun[qb];
                float rs = 0.f;
#pragma unroll
                for (int kb = 0; kb < 2; ++kb)
#pragma unroll
                    for (int e = 0; e < 16; ++e) { const float pv = __builtin_amdgcn_exp2f(st[kb][qb][e] - mn); st[kb][qb][e] = pv; rs += pv; }
                rs += shx(rs, 32, lane);
                if (__any(grew)) {
                    const float alpha = __builtin_amdgcn_exp2f(mrun[qb] - mn);
                    lrun[qb] = lrun[qb] * alpha + rs;
#pragma unroll
                    for (int db = 0; db < 2; ++db)
#pragma unroll
                        for (int e = 0; e < 16; ++e) ot[db][qb][e] *= alpha;
                } else lrun[qb] += rs;
                mrun[qb] = mn;
            }
#pragma unroll
            for (int kb = 0; kb < 2; ++kb)
#pragma unroll
                for (int s2 = 0; s2 < 2; ++s2) {
                    bf16x8 pk[2];
#pragma unroll
                    for (int qb = 0; qb < 2; ++qb) { u32x4 w; w.x = cvtpk(st[kb][qb][8 * s2 + 0], st[kb][qb][8 * s2 + 1]); w.y = cvtpk(st[kb][qb][8 * s2 + 2], st[kb][qb][8 * s2 + 3]);
                        w.z = cvtpk(st[kb][qb][8 * s2 + 4], st[kb][qb][8 * s2 + 5]); w.w = cvtpk(st[kb][qb][8 * s2 + 6], st[kb][qb][8 * s2 + 7]); pk[qb] = __builtin_bit_cast(bf16x8, w); }
#pragma unroll
                    for (int db = 0; db < 2; ++db) {
                        const LAS unsigned char* vp = Vl + (32 * kb + 16 * s2 + 4 * hl + trq) * 144 + (32 * db + 16 * trb + 4 * trp) * 2;
                        const s16x4 lo = vtr(vp), hi = vtr(vp + 8 * 144);
                        const bf16x8 va = (bf16x8){lo[0], lo[1], lo[2], lo[3], hi[0], hi[1], hi[2], hi[3]};
                        ot[db][0] = MFMA32(va, pk[0], ot[db][0]); ot[db][1] = MFMA32(va, pk[1], ot[db][1]);
                    }
                }
            }
        }
#undef TILE_ROW0
#pragma unroll
        for (int qb = 0; qb < 2; ++qb) { const float inv = 1.0f / lrun[qb]; bf16_t* op = O + (size_t)(qrow0 + 64 * rh + 32 * qb + c31) * QW + g * 256 + r * 64;
#pragma unroll
            for (int db = 0; db < 2; ++db)
#pragma unroll
                for (int gq = 0; gq < 4; ++gq) { u32x2 w; w.x = cvtpk(ot[db][qb][4 * gq] * inv, ot[db][qb][4 * gq + 1] * inv); w.y = cvtpk(ot[db][qb][4 * gq + 2] * inv, ot[db][qb][4 * gq + 3] * inv);
                    *(u32x2*)(op + 32 * db + 8 * gq + 4 * hl) = w; } }
    }
    __syncthreads();
}


#ifndef PHMASK
#define PHMASK 0xFFFF
#endif
#define PHON(k) (((PHMASK) >> (k)) & 1)
#ifndef REPMASK
#define REPMASK 0x0
#endif
#define REP(k) (((REPMASK) >> (k)) & 1)
#ifndef MK_PER_PHASE
#define MK_PER_PHASE 0
#endif
#ifndef TIMER_LO
#define TIMER_LO 999
#define TIMER_HI 999
#endif
#define TIMER_ON (TIMER_LO < 999)
#define IN(k) (lo <= (k) && (k) < hi)
#define SEAM(k) do { if (IN(k) && IN((k) + 1)) { xcd_barrier(bar); } if (TIMER_ON) { const unsigned long long now_ = __builtin_amdgcn_s_memrealtime(); if ((k) >= TIMER_LO && (k) <= TIMER_HI) TM.acc += now_ - TM.prev; TM.prev = now_; } } while (0)
#define SITE_PTRS phase_enter(F); unsigned char* ws = F.ws; bf16_t* H = (bf16_t*)F.out; bf16_t* BIG = (bf16_t*)(ws + WS_BIG); const float* MODV = (const float*)(ws + WS_MODV); (void)H; (void)BIG; (void)MODV; \
        unsigned char* wss = ws + WS_W + (size_t)lp * W_SSD_STRIDE; unsigned char* wsa = ws + WS_W + W_ATT0 + (size_t)lp * W_ATT_STRIDE; (void)wss; (void)wsa;
struct Timer { unsigned long long prev, acc; };
template <int lp, int c> __device__ __forceinline__ void moe_chunk(Frame& F, const Args& A, const int lo, const int hi, const XcdBarrier& bar, LAS unsigned char* ring, Timer& TM) {
    constexpr int pb = 1 + lp * 20;
            const int pu = pb + 14 + 2 * c, pd = pu + 1;
            if (IN(pu) || IN(pd)) {
                SITE_PTRS
                MoeOrder mo;
                mo.pp[0] = 0;
#pragma unroll
                for (int e = 0; e < 8; ++e) { const int cn = __builtin_amdgcn_readfirstlane((int)__hip_atomic_load((unsigned*)(F.ctl + CW_CNT + (size_t)(lp * 8 + e) * 64), RLX_AGENT)); mo.cnt[e] = cn; mo.pp[e + 1] = mo.pp[e] + ((cn + 255) >> 8); }
                const int Ptot = mo.pp[8]; int nP = Ptot - c * MOE_CHUNK; nP = nP < 0 ? 0 : (nP > MOE_CHUNK ? MOE_CHUNK : nP);
                mo.cs = c * MOE_CHUNK; mo.rlist = (const int*)(ws + WS_RLIST);
                if (PHON(10) && IN(pu)) { mo.so.init(nP, 2 * DFFE / 256, F.G, (int)blockIdx.x); mo.GATHER_A = true; mo.bstride = (size_t)2 * DFFE * 1024 * 2;
                    pg8::Gemm g{H, (const bf16_t*)(ws + WS_BIG + BIG_MW13), 1024, 1024}; EpiSwiglu E{BIG, DFFE}; pg8::gemm_phase<EpiSwiglu, MoeOrder, true, true>(ring, g, mo, E, F.wave0); }
                SEAM(pu);
                if (PHON(11) && IN(pd)) { mo.so.init(nP, 4, F.G, (int)blockIdx.x); mo.GATHER_A = false; mo.bstride = (size_t)1024 * DFFE * 2;
                    pg8::Gemm g{BIG, (const bf16_t*)(ws + WS_BIG + BIG_MW2), DFFE, DFFE}; EpiMoeDown E{mo, (bf16_t*)(ws + WS_Y), (const float*)(ws + WS_GATE)}; pg8::gemm_phase<EpiMoeDown, MoeOrder, true, false>(ring, g, mo, E, F.wave0); }
            }
            SEAM(pd);
        }
template <int lp> __device__ __forceinline__ void layer_pair(Frame& F, const Args& A, const int lo, const int hi, const XcdBarrier& bar, LAS unsigned char* ring, Timer& TM) {
        const int pb = 1 + lp * 20, i0 = 2 * lp, i1 = 2 * lp + 1;
        if (PHON(1) && IN(pb + 0)) norm_phase(F, A, i0, 0, lp == 0 ? 1 : 2);
        SEAM(pb + 0);
        if (PHON(2) && IN(pb + 1)) { SITE_PTRS pg8::Gemm g{H, (const bf16_t*)(wss + W_WIN), 1024, 1024}; pg8::StaticOrder S; S.init(NPAN, NXBC / 256, F.G, (int)blockIdx.x);
            EpiXbc E{BIG, (float*)(ws + WS_DT), (bf16_t*)(ws + WS_HALO)}; pg8::gemm_phase<EpiXbc, pg8::StaticOrder, true, false>(ring, g, S, E, F.wave0); }
        SEAM(pb + 1);
        if (PHON(3) && IN(pb + 2)) conv_phase(F, A, lp);
        SEAM(pb + 2);
        if (PHON(3) && IN(pb + 3)) scan_phase<0>(F, A, lp);
        SEAM(pb + 3);
        if (PHON(4) && IN(pb + 4)) { SITE_PTRS pg8::Gemm g{H, (const bf16_t*)(wss + W_WZ), 1024, 1024}; pg8::StaticOrder S; S.init(NPAN, DIN / 256, F.G, (int)blockIdx.x);
            EpiGate E{(const bf16_t*)(ws + WS_Y), BIG, A.ssd_norm_w + (size_t)lp * DIN, (LAS float*)(F.lds + PSCR_OFF)}; pg8::gemm_phase<EpiGate, pg8::StaticOrder, true, false>(ring, g, S, E, F.wave0); }
        SEAM(pb + 4);
        if (PHON(5) && IN(pb + 5)) { SITE_PTRS pg8::Gemm g{BIG, (const bf16_t*)(wss + W_WOUT), DIN, DIN}; pg8::StaticOrder S; S.init(NPAN, 4, F.G, (int)blockIdx.x);
            EpiResid E{(bf16_t*)(ws + WS_XR), MODV + (size_t)i0 * 17 * 6144, 2, nullptr, lp == 0 ? A.x : nullptr, lp == 0 ? A.ctx : nullptr};
            pg8::gemm_phase<EpiResid, pg8::StaticOrder, true, false>(ring, g, S, E, F.wave0); }
        SEAM(pb + 5);
        if (PHON(1) && IN(pb + 6)) norm_phase(F, A, i0, 1, 0);
        SEAM(pb + 6);
        if (PHON(6) && IN(pb + 7)) { SITE_PTRS pg8::Gemm g{H, (const bf16_t*)(wss + W_WUP), 1024, 1024}; pg8::StaticOrder S; S.init(NPAN, 2 * DFF / 256, F.G, (int)blockIdx.x);
            EpiSwiglu E{BIG, DFF}; pg8::gemm_phase<EpiSwiglu, pg8::StaticOrder, true, false>(ring, g, S, E, F.wave0); }
        SEAM(pb + 7);
        if (PHON(5) && IN(pb + 8)) { SITE_PTRS pg8::Gemm g{BIG, (const bf16_t*)(wss + W_WDN), DFF, DFF}; pg8::StaticOrder S; S.init(NPAN, 4, F.G, (int)blockIdx.x);
            EpiResid E{(bf16_t*)(ws + WS_XR), MODV + (size_t)i0 * 17 * 6144, 5, nullptr, nullptr, nullptr};
            pg8::gemm_phase<EpiResid, pg8::StaticOrder, true, false>(ring, g, S, E, F.wave0); }
        SEAM(pb + 8);
        if (PHON(1) && IN(pb + 9)) norm_phase(F, A, i1, 0, 0);
        SEAM(pb + 9);
        if (PHON(7) && IN(pb + 10)) { SITE_PTRS pg8::Gemm g{H, (const bf16_t*)(wsa + W_WQKV), 1024, 1024}; pg8::StaticOrder S; S.init(NPAN, NQKV / 256, F.G, (int)blockIdx.x);
            LAS float* qt = (LAS float*)(F.lds + PSCR_OFF);
            { const float* rp = (const float*)(ws + WS_ROPE); const float* bq = A.attn_b_qkv + (size_t)lp * NQKV; for (int idx = F.tid; idx < 3584; idx += 512) qt[idx] = idx < 2048 ? rp[idx] : bq[idx - 2048]; }
            __syncthreads();
            EpiQkv E{BIG, (bf16_t*)(ws + WS_BIG + BIG_K), (bf16_t*)(ws + WS_BIG + BIG_V), qt};
            pg8::gemm_phase<EpiQkv, pg8::StaticOrder, true, false>(ring, g, S, E, F.wave0); }
        SEAM(pb + 10);
        if (PHON(8) && IN(pb + 11)) { const int nconv = F.G >= 9996 ? 48 : 0;
            if ((int)blockIdx.x < F.G - nconv) attn_phase(F, A, lp, lp == 0, F.G - nconv); else moe_convert(F, A, lp, F.G - nconv, nconv); }
        SEAM(pb + 11);
        if (PHON(5) && IN(pb + 12)) { SITE_PTRS pg8::Gemm g{H, (const bf16_t*)(wsa + W_WO), 1024, 1024};
            EpiResid E{(bf16_t*)(ws + WS_XR), MODV + (size_t)i1 * 17 * 6144, 2, A.attn_b_o + (size_t)lp * 1024, nullptr, nullptr};
            if (lp == 1) { pg8::LatentOrder S; S.init(NPAN - NB, 4, F.G, (int)blockIdx.x); pg8::gemm_phase<EpiResid, pg8::LatentOrder, true, false>(ring, g, S, E, F.wave0); }
            else { pg8::StaticOrder S; S.init(NPAN, 4, F.G, (int)blockIdx.x); pg8::gemm_phase<EpiResid, pg8::StaticOrder, true, false>(ring, g, S, E, F.wave0); } }
        SEAM(pb + 12);
        if (PHON(9) && IN(pb + 13)) { norm_phase(F, A, i1, 1, 4 | (lp == 1 ? 16 : 0)); if (F.G < 9996) { __syncthreads(); moe_convert(F, A, lp, 0, F.G); } }
        SEAM(pb + 13);
    moe_chunk<lp, 0>(F, A, lo, hi, bar, ring, TM); moe_chunk<lp, 1>(F, A, lo, hi, bar, ring, TM); moe_chunk<lp, 2>(F, A, lo, hi, bar, ring, TM);
}
constexpr int N_PHASES = 42;
__global__ void __launch_bounds__(NWAVES * 64, 2) fwd_kernel(Args A) {
    extern __shared__ __attribute__((aligned(16))) unsigned char lds_raw[];
    Frame F;
    F.lds = (LAS unsigned char*)lds_raw;
    F.tid = threadIdx.x; F.lane = F.tid & 63; F.wave = __builtin_amdgcn_readfirstlane(F.tid >> 6); F.wave0 = F.wave; F.G = gridDim.x;
    F.ws0 = A.ws; F.out0 = A.out; F.ws = A.ws; F.ctl = (gu32*)(A.ws + WS_CTL); F.out = A.out;
    volatile LAS unsigned* MISC = (volatile LAS unsigned*)(F.lds + MISC_OFF);
    for (int u = F.tid; u < (LDS_BYTES - LDSCTL_OFF) / 4; u += NWAVES * 64) ((LAS unsigned*)(F.lds + LDSCTL_OFF))[u] = 0u;
    __syncthreads();
    const int lo = A.ph_lo, hi = A.ph_hi;
    XcdBarrier bar; bar.bar = (unsigned*)(F.ctl + CW_BAR); bar.x = 0; bar.st = MISC + 8; bar.wave0 = F.wave0;
    if (hi - lo > 1) bar = xcd_barrier_post((unsigned*)(F.ctl + CW_BAR), MISC + 8, F.wave0);
    LAS unsigned char* ring = F.lds;

    Timer TM; TM.prev = TIMER_ON ? __builtin_amdgcn_s_memrealtime() : 0ull; TM.acc = 0ull;
    if (PHON(0) && IN(0)) { p0_prologue(F, A); }
    SEAM(0);
    layer_pair<0>(F, A, lo, hi, bar, ring, TM);
    layer_pair<1>(F, A, lo, hi, bar, ring, TM);
    if (PHON(1) && IN(41)) {
        norm_phase(F, A, 4, 0, 2 | 8);
        if (xb_ld((unsigned*)(F.ctl + CW_BAR) + XB_TMO) != 0u) {
            const float qn = __builtin_nanf("");
            for (size_t idx = (size_t)blockIdx.x * 512 + F.tid; idx < (size_t)NB * SEQ * DM / 4; idx += (size_t)F.G * 512) ((f32x4*)A.out)[idx] = (f32x4){qn, qn, qn, qn};
        }
    }
    if (TIMER_ON) { const unsigned long long now_ = __builtin_amdgcn_s_memrealtime(); if (41 >= TIMER_LO && 41 <= TIMER_HI) TM.acc += now_ - TM.prev;
        if (blockIdx.x == 0) { const unsigned long long tgt = now_ + TM.acc; while (__builtin_amdgcn_s_memrealtime() < tgt) __builtin_amdgcn_s_sleep(8); } }
#undef IN
#undef SEAM
}

extern "C" void kernel_launch(void* const* d_in, const int* in_sizes, int n_in, void* d_out, int out_size, void* d_ws, size_t ws_size, hipStream_t stream) {
    static int grid = 0;
    if (grid == 0) {
        if (n_in != 29 || in_sizes[0] != NB * SEQ * DM || out_size != NB * SEQ * DM || ws_size < WS_END) {
            fprintf(stderr, "kernel_launch: unexpected problem: n_in %d, in0 %d, out %d, ws %zu (need %zu); nothing launched\n", n_in, n_in > 0 ? in_sizes[0] : -1, out_size, ws_size, (size_t)WS_END); grid = -1; return; }
        int dev = 0, cus = 0, per_cu = 0;
        if (hipGetDevice(&dev) != hipSuccess || hipDeviceGetAttribute(&cus, hipDeviceAttributeMultiprocessorCount, dev) != hipSuccess) { fprintf(stderr, "kernel_launch: device query failed\n"); grid = -1; return; }
        if (hipFuncSetAttribute((const void*)fwd_kernel, hipFuncAttributeMaxDynamicSharedMemorySize, LDS_BYTES) != hipSuccess) { fprintf(stderr, "kernel_launch: hipFuncSetAttribute failed\n"); grid = -1; return; }
        if (hipOccupancyMaxActiveBlocksPerMultiprocessor(&per_cu, (const void*)fwd_kernel, NWAVES * 64, LDS_BYTES) != hipSuccess || per_cu < 1)
            fprintf(stderr, "kernel_launch: note: occupancy query reports %d workgroups per CU\n", per_cu);
        (void)hipGetLastError();
        grid = cus;
    }
    if (grid < 0) return;
    if (hipMemsetAsync((char*)d_ws + WS_CTL, 0, CTL_ZERO_BYTES, stream) != hipSuccess) { fprintf(stderr, "kernel_launch: memset failed\n"); return; }
    Args a{};
    const float** ap = (const float**)&a;
    for (int i = 0; i < 29; ++i) ap[i] = (const float*)d_in[i];
    a.out = (float*)d_out; a.ws = (unsigned char*)d_ws;
#if MK_PER_PHASE
    for (int k = 0; k < N_PHASES; ++k) { a.ph_lo = k; a.ph_hi = k + 1; hipLaunchKernelGGL(fwd_kernel, dim3(grid), dim3(NWAVES * 64), LDS_BYTES, stream, a); }
#else
    a.ph_lo = 0; a.ph_hi = N_PHASES;
    hipLaunchKernelGGL(fwd_kernel, dim3(grid), dim3(NWAVES * 64), LDS_BYTES, stream, a);
#endif
    const hipError_t le = hipPeekAtLastError();
    if (le != hipSuccess) fprintf(stderr, "kernel_launch: launch failed: %s\n", hipGetErrorName(le));
}
```

```cpp
#include <hip/hip_runtime.h>
#include <cstdio>
#include <cstdint>

#define LAS __attribute__((address_space(3)))
#define GAS __attribute__((address_space(1)))
typedef unsigned short bf16_t;
typedef short bf16x8 __attribute__((ext_vector_type(8)));
typedef short s16x4 __attribute__((ext_vector_type(4)));
typedef float f32x4 __attribute__((ext_vector_type(4)));
typedef float f32x2 __attribute__((ext_vector_type(2)));
typedef float f32x16 __attribute__((ext_vector_type(16)));
typedef unsigned u32x4 __attribute__((ext_vector_type(4)));
typedef unsigned u32x2 __attribute__((ext_vector_type(2)));
typedef GAS unsigned gu32;

namespace pg8 {
constexpr int BM = 256, BK = 64, HALF = 128, HTB = HALF * BK * 2  , STAGE_BYTES = 8 * HTB, NXCD = 8, WGM = 8;

__host__ __device__ __forceinline__ int lds_byte(int r, int c) { const int st = (r >> 4) * 2 + (c >> 5), rr = r & 15, cc = c & 31, ob = rr * 64 + cc * 2; return st * 1024 + (ob ^ (((ob >> 9) & 1) << 5)); }
__host__ __device__ __forceinline__ void stage_rc(int b, int& R, int& C) { const int st = b / 1024, sb = b % 1024, swz = sb ^ (((sb >> 9) & 1) << 5); R = (st >> 1) * 16 + swz / 64; C = (st & 1) * 32 + (swz % 64) / 2; }
__host__ __device__ __forceinline__ int perm32(int rho) { const int n = rho >> 4, i = rho & 15; return 8 * (i >> 2) + 4 * n + (i & 3); }

struct Unit { int pm, pn; };
struct Gemm { const bf16_t* A; const bf16_t* Bt; int lda, K; };

struct StaticOrder {
    int nM, nN, nwg, G, c;
    __device__ void init(int nM_, int nN_, int G_, int c_) { nM = nM_; nN = nN_; nwg = nM * nN; G = G_; c = c_; }
    __device__ bool next(int i, Unit& u) const {
        const long L = (long)i * G + c; if (L >= nwg) return false;
        int wgid = (int)L; { const int q = nwg / NXCD, r = nwg % NXCD, xcd = wgid % NXCD, off = wgid / NXCD; wgid = (xcd < r ? xcd * (q + 1) : r * (q + 1) + (xcd - r) * q) + off; }
        const int nig = WGM * nN, gid = wgid / nig, fm = gid * WGM, gsz = (nM - fm) < WGM ? (nM - fm) : WGM;
        u.pm = fm + ((wgid % nig) % gsz); u.pn = (wgid % nig) / gsz; return true;
    }
    __device__ __forceinline__ const char* a_base(const Gemm& g, const Unit& u) const { return (const char*)g.A + (size_t)u.pm * (size_t)(BM * 2) * g.lda; }
    __device__ __forceinline__ const char* b_base(const Gemm& g, const Unit& u) const { return (const char*)g.Bt + (size_t)u.pn * (size_t)(BM * 2) * g.K; }
    __device__ __forceinline__ unsigned row_off(const Gemm& g, const Unit&, int r) const { return (unsigned)r * (unsigned)g.lda * 2u; }
};

struct LatentOrder : StaticOrder {
    __device__ bool next(int i, Unit& u) const { if (!StaticOrder::next(i, u)) return false; u.pm = u.pm + (u.pm >> 4) + 1; return true; }
};

__device__ __forceinline__ unsigned cvt_pk_bf16(float lo, float hi) { unsigned r; asm volatile("v_cvt_pk_bf16_f32 %0, %1, %2" : "=v"(r) : "v"(lo), "v"(hi)); return r; }

template <class Epi, class Sched, bool ALIGN_EPI, bool GATHER>
__device__ __forceinline__ void gemm_phase(LAS unsigned char* lds, const Gemm g, const Sched& S, const Epi& E, const int wave0, const unsigned delay_ticks = 0u) {
    if (delay_ticks) { const unsigned long long t0_ = __builtin_amdgcn_s_memrealtime(); while (__builtin_amdgcn_s_memrealtime() - t0_ < (unsigned long long)delay_ticks) __builtin_amdgcn_s_sleep(16); }
    int tid_ = wave0 * 64 + (int)__builtin_amdgcn_mbcnt_hi(~0u, __builtin_amdgcn_mbcnt_lo(~0u, 0u)); asm volatile("" : "+v"(tid_));
    const int tid = tid_, wid = __builtin_amdgcn_readfirstlane(tid >> 6), lane = tid & 63, wr = wid >> 2, wc = wid & 3, fr = lane & 15, fq = lane >> 4;
    const int K = g.K, nt = K / BK;
    unsigned voffB[2];
#pragma unroll
    for (int i = 0; i < 2; ++i) { int R, C; stage_rc(tid * 16 + i * 8192, R, C); const int Rb = Epi::PERM ? ((R & ~31) + perm32(R & 31)) : R; voffB[i] = (unsigned)(Rb * K + C) * 2u; }
    const size_t kstep = (size_t)(BK * 2);
    const size_t hstepB = (size_t)HALF * K * 2;
    const unsigned ldsw = (unsigned)wid * 1024u;
    const int aoff = lds_byte(wr * 64 + fr, fq * 8), boff = lds_byte(wc * 32 + fr, fq * 8);
#define PG8_SA(b, h) (((b) * 2 + (h)) * HTB)
#define PG8_SB(b, h) ((4 + (b) * 2 + (h)) * HTB)
#define PG8_STAGE(bufoff, gbase, voff) do { _Pragma("unroll") for (int _i = 0; _i < 2; ++_i) \
        __builtin_amdgcn_global_load_lds((const unsigned*)((const char*)(gbase) + (voff)[_i]), (LAS unsigned*)(lds + (bufoff) + ldsw + _i * 8192), 16, 0, 0); } while (0)
#define PG8_LDA(dst, b, h) do { _Pragma("unroll") for (int m = 0; m < 4; ++m) _Pragma("unroll") for (int k = 0; k < 2; ++k) dst[m][k] = *(const LAS bf16x8*)(lds + PG8_SA(b, h) + aoff + m * 2048 + k * 1024); } while (0)
#define PG8_LDB(dst, b, h) do { _Pragma("unroll") for (int n = 0; n < 2; ++n) _Pragma("unroll") for (int k = 0; k < 2; ++k) dst[n][k] = *(const LAS bf16x8*)(lds + PG8_SB(b, h) + boff + n * 2048 + k * 1024); } while (0)
#define PG8_MMA(ai, bj, At, Bt) do { __builtin_amdgcn_s_setprio(1); _Pragma("unroll") for (int m = 0; m < 4; ++m) _Pragma("unroll") for (int n = 0; n < 2; ++n) _Pragma("unroll") for (int k = 0; k < 2; ++k) \
        acc[ai][bj][m][n] = __builtin_amdgcn_mfma_f32_16x16x32_bf16(Bt[n][k], At[m][k], acc[ai][bj][m][n], 0, 0, 0); __builtin_amdgcn_s_setprio(0); } while (0)
#define PG8_WAIT_V(n) asm volatile("s_waitcnt vmcnt(" #n ")" ::: "memory")
#define PG8_WAIT_L(n) asm volatile("s_waitcnt lgkmcnt(" #n ")" ::: "memory")
#define PG8_BAR __builtin_amdgcn_s_barrier()
#define PG8_SCHED __builtin_amdgcn_sched_barrier(0)
    Unit cur, nxt; int ui = 0;
    if (!S.next(0, cur)) return;
    f32x4 acc[2][2][4][2];
#pragma unroll
    for (int a = 0; a < 2; ++a)
#pragma unroll
        for (int b = 0; b < 2; ++b)
#pragma unroll
            for (int m = 0; m < 4; ++m)
#pragma unroll
                for (int n = 0; n < 2; ++n) acc[a][b][m][n] = (f32x4){0.f, 0.f, 0.f, 0.f};
    bf16x8 At[4][2], B0[2][2], B1[2][2];
    const char* cA = S.a_base(g, cur); const char* cB = S.b_base(g, cur);
    unsigned va[2][2], vn[2][2];
#pragma unroll
    for (int h = 0; h < 2; ++h)
#pragma unroll
        for (int i = 0; i < 2; ++i) { int R, C; stage_rc(tid * 16 + i * 8192, R, C); va[h][i] = S.row_off(g, cur, h * HALF + R) + (unsigned)C * 2u; vn[h][i] = va[h][i]; }
    PG8_STAGE(PG8_SB(0, 0), cB, voffB); PG8_STAGE(PG8_SB(0, 1), cB + hstepB, voffB); PG8_STAGE(PG8_SA(0, 0), cA, va[0]); PG8_STAGE(PG8_SA(0, 1), cA, va[1]);
    if (wr == 1) PG8_BAR;
    PG8_WAIT_V(2); PG8_BAR;
    PG8_STAGE(PG8_SB(1, 0), cB + kstep, voffB); PG8_STAGE(PG8_SA(1, 0), cA + kstep, va[0]); PG8_STAGE(PG8_SB(1, 1), cB + hstepB + kstep, voffB);
    PG8_WAIT_V(6); PG8_BAR;
    for (;;) {
        const bool has_next = S.next(ui + 1, nxt);
        const char* nA = has_next ? S.a_base(g, nxt) : cA; const char* nB = has_next ? S.b_base(g, nxt) : cB;
        if (GATHER) {
            if (has_next) {
#pragma unroll
                for (int h = 0; h < 2; ++h)
#pragma unroll
                    for (int i = 0; i < 2; ++i) { int R, C; stage_rc(tid * 16 + i * 8192, R, C); vn[h][i] = S.row_off(g, nxt, h * HALF + R) + (unsigned)C * 2u; }
            } else {
#pragma unroll
                for (int h = 0; h < 2; ++h)
#pragma unroll
                    for (int i = 0; i < 2; ++i) vn[h][i] = va[h][i];
            }
        }
        for (int t = 0; t < nt; t += 2) {
            const bool last = (t == nt - 2);
            const char* a1 = cA + (size_t)(t + 1) * kstep;
            const char* a2 = last ? nA : cA + (size_t)(t + 2) * kstep; const char* b2 = last ? nB : cB + (size_t)(t + 2) * kstep;
            const char* a3 = a2 + kstep; const char* b3 = b2 + kstep;
            unsigned v2[2][2];
#pragma unroll
            for (int h = 0; h < 2; ++h)
#pragma unroll
                for (int i = 0; i < 2; ++i) v2[h][i] = (GATHER && last) ? vn[h][i] : va[h][i];
            PG8_LDB(B0, 0, 0); PG8_LDB(B1, 0, 1); PG8_SCHED; PG8_LDA(At, 0, 0); PG8_STAGE(PG8_SA(1, 1), a1, va[1]);
            PG8_WAIT_V(8); PG8_WAIT_L(0); PG8_BAR; PG8_MMA(0, 0, At, B0); PG8_MMA(0, 1, At, B1); PG8_BAR; PG8_SCHED;
            PG8_LDA(At, 0, 1); PG8_STAGE(PG8_SB(0, 0), b2, voffB); PG8_STAGE(PG8_SB(0, 1), b2 + hstepB, voffB); PG8_STAGE(PG8_SA(0, 0), a2, v2[0]);
            PG8_WAIT_V(8); PG8_WAIT_L(0); PG8_BAR; PG8_MMA(1, 0, At, B0); PG8_MMA(1, 1, At, B1); PG8_BAR; PG8_SCHED;
            PG8_LDB(B0, 1, 0); PG8_LDB(B1, 1, 1); PG8_SCHED; PG8_LDA(At, 1, 0); PG8_STAGE(PG8_SA(0, 1), a2, v2[1]);
            PG8_WAIT_V(8); PG8_WAIT_L(0); PG8_BAR; PG8_MMA(0, 0, At, B0); PG8_MMA(0, 1, At, B1); PG8_BAR; PG8_SCHED;
            PG8_LDA(At, 1, 1); PG8_STAGE(PG8_SB(1, 0), b3, voffB); PG8_STAGE(PG8_SB(1, 1), b3 + hstepB, voffB); PG8_STAGE(PG8_SA(1, 0), a3, v2[0]);
            PG8_WAIT_V(8); PG8_WAIT_L(0); PG8_BAR; PG8_MMA(1, 0, At, B0); PG8_MMA(1, 1, At, B1); PG8_BAR; PG8_SCHED;
        }
        if constexpr (ALIGN_EPI) { if (wr == 0) PG8_BAR; }
        { int l2 = (int)__builtin_amdgcn_mbcnt_hi(~0u, __builtin_amdgcn_mbcnt_lo(~0u, 0u)); asm volatile("" : "+v"(l2)); E(acc, cur, wr, wc, l2 & 15, l2 >> 4); }
        if (!has_next) break;
#pragma unroll
        for (int a = 0; a < 2; ++a)
#pragma unroll
            for (int b = 0; b < 2; ++b)
#pragma unroll
                for (int m = 0; m < 4; ++m)
#pragma unroll
                    for (int n = 0; n < 2; ++n) acc[a][b][m][n] = (f32x4){0.f, 0.f, 0.f, 0.f};
        cur = nxt; cA = nA; cB = nB; ++ui;
        if (GATHER) {
#pragma unroll
            for (int h = 0; h < 2; ++h)
#pragma unroll
                for (int i = 0; i < 2; ++i) va[h][i] = vn[h][i];
        }
        if constexpr (ALIGN_EPI) { if (wr == 1) PG8_BAR; }
    }
    PG8_WAIT_V(0);
    if constexpr (!ALIGN_EPI) { if (wr == 0) PG8_BAR; }
    PG8_BAR;
#undef PG8_SA
#undef PG8_SB
#undef PG8_STAGE
#undef PG8_LDA
#undef PG8_LDB
#undef PG8_MMA
#undef PG8_WAIT_V
#undef PG8_WAIT_L
#undef PG8_BAR
#undef PG8_SCHED
}
}

constexpr int DM = 1024, NB = 16, SEQ = 4096, NCTX = 256, SROW = SEQ + NCTX  , MROWS = NB * SROW  , NPAN = MROWS / 256  ;
constexpr int DIN = 2048, CONVCH = 4096, SSD_IN = 6208, NXBC = 4352  ;
constexpr int QW = 1024, KVW = 256, NQKV = 1536;
constexpr int DFF = 2816, NEXP = 8, DFFE = 3584;
constexpr float EPS = 1e-6f;
constexpr int MOE_CHUNK = 192;
constexpr int NWAVES = 8;

constexpr size_t MiB = 1u << 20;
constexpr size_t WS_CTL = 0, CTL_ZERO_BYTES = 1 * MiB;
constexpr size_t WS_MODV = 2 * MiB;
constexpr size_t WS_ROPE = 4 * MiB;
constexpr size_t WS_GATE = 5 * MiB;
constexpr size_t WS_RLIST = 6 * MiB;
constexpr size_t WS_W = 26 * MiB;
constexpr size_t W_SSD_STRIDE = 33 * MiB, W_WZ = 0, W_WIN = 4 * MiB, W_WOUT = 12 * MiB + MiB / 2, W_WUP = 16 * MiB + MiB / 2, W_WDN = 27 * MiB + MiB / 2;
constexpr size_t W_ATT0 = 66 * MiB, W_ATT_STRIDE = 5 * MiB, W_WQKV = 0, W_WO = 3 * MiB;
constexpr size_t WS_XR = 102 * MiB;
constexpr size_t WS_BIG = 238 * MiB;
constexpr size_t BIG_K = 136 * MiB, BIG_V = 170 * MiB, BIG_O = 204 * MiB, BIG_MW13 = 336 * MiB, BIG_MW2 = 448 * MiB;
static_assert((size_t)MOE_CHUNK * 256 * DFFE * 2 <= BIG_MW13 && BIG_O + 136 * MiB <= BIG_MW13 + 200 * MiB && BIG_MW2 + 56 * MiB <= 544 * MiB, "BIG region map");
constexpr size_t WS_Y = 782 * MiB;
constexpr size_t WS_DT = 1054 * MiB;
constexpr size_t WS_HALO = 1071 * MiB;
constexpr size_t WS_END = 1106 * MiB;
constexpr int CW_BAR = 4096;
constexpr int CW_CNT = 16384;

constexpr int RING_BYTES = 131072;
constexpr int PSCR_OFF = 131072;
constexpr int LDSCTL_OFF = 151552, MISC_OFF = LDSCTL_OFF + 320;
constexpr int LDS_BYTES = 155648;

#define RLX_AGENT __ATOMIC_RELAXED, __HIP_MEMORY_SCOPE_AGENT
#define LDS_WAIT() asm volatile("s_waitcnt lgkmcnt(0)" ::: "memory")
#define VM_WAIT() asm volatile("s_waitcnt vmcnt(0)" ::: "memory")
__device__ __forceinline__ unsigned f2bf(float f) { unsigned u = __builtin_bit_cast(unsigned, f); return (u + 0x7fffu + ((u >> 16) & 1u)) >> 16; }
__device__ __forceinline__ unsigned pk2(float lo, float hi) { return f2bf(lo) | (f2bf(hi) << 16); }
__device__ __forceinline__ float bf_lo(unsigned u) { return __builtin_bit_cast(float, u << 16); }
__device__ __forceinline__ float bf_hi(unsigned u) { return __builtin_bit_cast(float, u & 0xffff0000u); }
__device__ __forceinline__ float bf1(bf16_t h) { return __builtin_bit_cast(float, (unsigned)h << 16); }
__device__ __forceinline__ float siluf(float v) { return v * __builtin_amdgcn_rcpf(1.0f + __expf(-v)); }
__device__ __forceinline__ float shx(float v, int mask, int lane) { return __builtin_bit_cast(float, __builtin_amdgcn_ds_bpermute((lane ^ mask) << 2, __builtin_bit_cast(int, v))); }
__device__ __forceinline__ float wave_sum(float v, int lane) {
#pragma unroll
    for (int o = 1; o < 64; o <<= 1) v += shx(v, o, lane);
    return v;
}

__device__ __forceinline__ int lane_id() { return (int)__builtin_amdgcn_mbcnt_hi(~0u, __builtin_amdgcn_mbcnt_lo(~0u, 0u)); }
#define XB_TMO      128
#define XB_XCNT(j)  (256  + 64 * (j))
#define XB_XSUB(j)  (1280 + 64 * (j))
#define XB_XGEN(j)  (2304 + 64 * (j))
#define XB_TOP      3328
#define XB_TOPGEN   3392
#define XCD_BAR_WORDS 3456
#define XB_SPIN_CAP (1u << 18)

__device__ __forceinline__ unsigned xb_ld(unsigned* p)              { return __hip_atomic_load(p, __ATOMIC_RELAXED, __HIP_MEMORY_SCOPE_AGENT); }
__device__ __forceinline__ unsigned xb_add(unsigned* p, unsigned v) { return __hip_atomic_fetch_add(p, v, __ATOMIC_RELAXED, __HIP_MEMORY_SCOPE_AGENT); }
__device__ __forceinline__ unsigned xb_xcc_id() { return (unsigned)__builtin_amdgcn_s_getreg((3 << 11) | 20) & 0xFu; }
#define XB_SPIN(cond, bar) do { unsigned _sp = 0; while (cond) { __builtin_amdgcn_s_sleep(1); \
    if ((++_sp & 255u) == 0u) { if (xb_ld(&(bar)[XB_TMO])) break; if (_sp > XB_SPIN_CAP) { atomicAdd(&(bar)[XB_TMO], 1u); break; } } } } while (0)

struct XcdBarrier {
    unsigned* bar; unsigned x;
    volatile LAS unsigned* st;
    int wave0;
};
__device__ __forceinline__ XcdBarrier xcd_barrier_post(unsigned* bar, volatile LAS unsigned* st, int wave0) {
    XcdBarrier b; b.bar = bar; b.x = xb_xcc_id(); b.st = st; b.wave0 = wave0;
    if (wave0 == 0 && lane_id() == 0) (void)xb_add(&bar[XB_XCNT(b.x)], 1u);
    return b;
}
__device__ __forceinline__ void xcd_barrier_complete(unsigned* bar, unsigned x, unsigned& nloc, unsigned& nx) {
    const unsigned G = gridDim.x * gridDim.y * gridDim.z;
    unsigned sum, cnt, mine, sp = 0u;
    for (;;) {
        sum = 0u; cnt = 0u; mine = 0u;
#pragma unroll
        for (unsigned j = 0; j < 16; ++j) { const unsigned c = xb_ld(&bar[XB_XCNT(j)]); sum += c; cnt += (c > 0u) ? 1u : 0u; mine = (j == x) ? c : mine; }
        if (sum == G) break;
        __builtin_amdgcn_s_sleep(1);
        if ((++sp & 255u) == 0u) { if (xb_ld(&bar[XB_TMO])) break; if (sp > XB_SPIN_CAP) { atomicAdd(&bar[XB_TMO], 1u); break; } }
    }
    nloc = mine > 0u ? mine : 1u; nx = cnt > 0u ? cnt : 1u;
}
__device__ __forceinline__ void xcd_barrier(const XcdBarrier& b) {
    asm volatile("s_waitcnt vmcnt(0)" ::: "memory");
    __syncthreads();
    if (b.wave0 == 0 && lane_id() == 0) {
        unsigned* bar = b.bar;
        __builtin_amdgcn_s_waitcnt(0);
        unsigned nloc = b.st[0], nx = b.st[1];
        if (nloc == 0u) { xcd_barrier_complete(bar, b.x, nloc, nx); b.st[0] = nloc; b.st[1] = nx; }
        const unsigned old = xb_add(&bar[XB_XSUB(b.x)], 1u);
        const unsigned gen = old / nloc;
        if (old + 1u == (gen + 1u) * nloc) {
            __builtin_amdgcn_fence(__ATOMIC_RELEASE, "agent");
            asm volatile("s_waitcnt vmcnt(0)" ::: "memory");
            const unsigned og = xb_add(&bar[XB_TOP], 1u);
            const unsigned tg = og / nx;
            if (og + 1u == (tg + 1u) * nx) xb_add(&bar[XB_TOPGEN], 1u);
            else XB_SPIN(xb_ld(&bar[XB_TOPGEN]) == tg, bar);
            __builtin_amdgcn_fence(__ATOMIC_ACQUIRE, "agent");
            xb_add(&bar[XB_XGEN(b.x)], 1u);
            asm volatile("s_waitcnt vmcnt(0)" ::: "memory");
        } else {
            XB_SPIN(xb_ld(&bar[XB_XGEN(b.x)]) == gen, bar);
            __builtin_amdgcn_fence(__ATOMIC_ACQUIRE, "agent");
            asm volatile("s_waitcnt vmcnt(0)" ::: "memory");
        }
    }
    __syncthreads();
}

struct Args {
    const float *x, *c, *ctx, *c_ctx, *w_mod, *b_mod, *norm1_w, *norm2_w, *ssd_w_in, *ssd_conv_w, *ssd_conv_b, *ssd_dt_bias, *ssd_a_log, *ssd_d, *ssd_norm_w, *ssd_w_out,
                *attn_w_qkv, *attn_b_qkv, *attn_sink, *attn_w_o, *attn_b_o, *ffn_w1, *ffn_w3, *ffn_w2, *moe_router, *moe_w1, *moe_w3, *moe_w2, *final_norm_w;
    float* out; unsigned char* ws; int ph_lo, ph_hi;
};
struct Frame {
    LAS unsigned char* lds;
    int tid, lane, wave, G;
    unsigned char* ws; gu32* ctl; float* out;
    unsigned char* ws0; float* out0; int wave0;
};
__device__ __forceinline__ void phase_enter(Frame& F) { int l = lane_id(); asm volatile("" : "+v"(l)); F.lane = l; F.wave = F.wave0; F.tid = F.wave0 * 64 + l;
    unsigned char* w = F.ws0; float* o = F.out0; asm volatile("" : "+s"(w), "+s"(o)); F.ws = w; F.ctl = (gu32*)(w + WS_CTL); F.out = o; }
__device__ __forceinline__ void transpose_item(const float* W, int ldw, int col0, int ncb, int K, bf16_t* WT, int mode, int half, LAS float* scr, int item, int lane) {
    const int kb = item / ncb, nb = item - kb * ncb, k0 = 64 * kb, n0 = 64 * nb;
    const int lr = lane >> 4, lc = (lane & 15) * 4;
    f32x4 tv[16];
#pragma unroll
    for (int i = 0; i < 16; ++i) tv[i] = *(const GAS f32x4*)(W + (size_t)(k0 + 4 * i + lr) * ldw + col0 + n0 + lc);
#pragma unroll
    for (int i = 0; i < 16; ++i) { LAS float* d = scr + (4 * i + lr) * 65 + lc; d[0] = tv[i].x; d[1] = tv[i].y; d[2] = tv[i].z; d[3] = tv[i].w; }
    LDS_WAIT(); asm volatile("" ::: "memory");
    const int c = lane & 7;
#pragma unroll
    for (int j = 0; j < 8; ++j) { const int n = (lane >> 3) + 8 * j; const LAS float* s = scr + (8 * c) * 65 + n;
        u32x4 o; o.x = pk2(s[0 * 65], s[1 * 65]); o.y = pk2(s[2 * 65], s[3 * 65]); o.z = pk2(s[4 * 65], s[5 * 65]); o.w = pk2(s[6 * 65], s[7 * 65]);
        const int cl = n0 + n; const int drow = mode == 0 ? cl : ((cl >> 7) * 256 + half * 128 + (cl & 127));
        *(GAS u32x4*)(WT + (size_t)drow * K + k0 + 8 * c) = o; }
    LDS_WAIT(); asm volatile("" ::: "memory");
}
__device__ __forceinline__ void p0_prologue(Frame& F, const Args& A) {
    phase_enter(F);
    {
        LAS float* sc = (LAS float*)F.lds;
        LAS float* red = (LAS float*)(F.lds + 81920);
        for (int idx = F.tid; idx < 17 * 1024; idx += 512) { const int cb = idx >> 10, k = idx & 1023; const float v = cb < 16 ? A.c[cb * 1024 + k] : A.c_ctx[k]; sc[k * 20 + cb] = v / (1.0f + expf(-v)); }
        __syncthreads();
        float* MODV = (float*)(F.ws + WS_MODV);
        for (int item = blockIdx.x; item < 4 * 96; item += F.G) {
            const int i = item / 96, cblk = item - i * 96;
            const float* Wm = A.w_mod + (size_t)i * 1024 * 6144 + cblk * 64 + F.lane;
            float acc[17];
#pragma unroll
            for (int cb = 0; cb < 17; ++cb) acc[cb] = 0.f;
            const int k0 = F.wave * 128;
#pragma unroll 4
            for (int kk = 0; kk < 128; ++kk) { const int k = k0 + kk; const float w = Wm[(size_t)k * 6144]; const LAS float* s = sc + k * 20;
#pragma unroll
                for (int cb = 0; cb < 17; ++cb) acc[cb] += s[cb] * w; }
#pragma unroll
            for (int cb = 0; cb < 17; ++cb) red[(F.wave * 17 + cb) * 64 + F.lane] = acc[cb];
            __syncthreads();
            for (int idx = F.tid; idx < 17 * 64; idx += 512) { const int cb = idx >> 6, l = idx & 63; float s = 0.f;
#pragma unroll
                for (int w = 0; w < 8; ++w) s += red[(w * 17 + cb) * 64 + l];
                MODV[(size_t)(i * 17 + cb) * 6144 + cblk * 64 + l] = s + A.b_mod[i * 6144 + cblk * 64 + l]; }
            __syncthreads();
        }
    }
    if (blockIdx.x == 0) { float* RT = (float*)(F.ws + WS_ROPE);
        for (int idx = F.tid; idx < 1024; idx += 512) { const int id = idx >> 4, f = idx & 15; const float inv = __builtin_amdgcn_exp2f(-(float)f * (13.287712379549449f / 16.0f)); const float ang = (float)id * inv;
            RT[idx] = __cosf(ang); RT[1024 + idx] = __sinf(ang); } }
    __syncthreads();
    {
        LAS float* scr = (LAS float*)(F.lds + F.wave * 16896);
        const int gw = blockIdx.x * NWAVES + F.wave, NGW = F.G * NWAVES;
        constexpr int I1 = 16 * 32, I2 = 16 * 65, I3 = 32 * 16, I4 = 16 * 44, I5 = 16 * 44, I6 = 44 * 16, I7 = 16 * 24, I8 = 16 * 16, IPER = I1 + I2 + I3 + I4 + I5 + I6 + I7 + I8;
        for (int it = gw; it < 2 * IPER; it += NGW) {
            const int j = it / IPER; int r = it - j * IPER;
            unsigned char* wss = F.ws + WS_W + (size_t)j * W_SSD_STRIDE; unsigned char* wsa = F.ws + WS_W + W_ATT0 + (size_t)j * W_ATT_STRIDE;
            if (r < I1) { transpose_item(A.ssd_w_in + (size_t)j * 1024 * SSD_IN, SSD_IN, 0, 32, 1024, (bf16_t*)(wss + W_WZ), 0, 0, scr, r, F.lane); continue; } r -= I1;
            if (r < I2) { transpose_item(A.ssd_w_in + (size_t)j * 1024 * SSD_IN, SSD_IN, 2048, 65, 1024, (bf16_t*)(wss + W_WIN), 0, 0, scr, r, F.lane); continue; } r -= I2;
            if (r < I3) { transpose_item(A.ssd_w_out + (size_t)j * 2048 * 1024, 1024, 0, 16, 2048, (bf16_t*)(wss + W_WOUT), 0, 0, scr, r, F.lane); continue; } r -= I3;
            if (r < I4) { transpose_item(A.ffn_w1 + (size_t)j * 1024 * DFF, DFF, 0, 44, 1024, (bf16_t*)(wss + W_WUP), 1, 0, scr, r, F.lane); continue; } r -= I4;
            if (r < I5) { transpose_item(A.ffn_w3 + (size_t)j * 1024 * DFF, DFF, 0, 44, 1024, (bf16_t*)(wss + W_WUP), 1, 1, scr, r, F.lane); continue; } r -= I5;
            if (r < I6) { transpose_item(A.ffn_w2 + (size_t)j * DFF * 1024, 1024, 0, 16, DFF, (bf16_t*)(wss + W_WDN), 0, 0, scr, r, F.lane); continue; } r -= I6;
            if (r < I7) { transpose_item(A.attn_w_qkv + (size_t)j * 1024 * NQKV, NQKV, 0, 24, 1024, (bf16_t*)(wsa + W_WQKV), 0, 0, scr, r, F.lane); continue; } r -= I7;
            transpose_item(A.attn_w_o + (size_t)j * 1024 * 1024, 1024, 0, 16, 1024, (bf16_t*)(wsa + W_WO), 0, 0, scr, r, F.lane);
        }
        for (int j = 0; j < 2; ++j) { u32x4* z = (u32x4*)(F.ws + WS_W + (size_t)j * W_SSD_STRIDE + W_WIN + (size_t)4160 * 1024 * 2);
            for (int idx = blockIdx.x * 512 + F.tid; idx < 192 * 1024 * 2 / 16; idx += F.G * 512) z[idx] = (u32x4){0u, 0u, 0u, 0u}; }
    }
}
__device__ __forceinline__ void moe_convert(Frame& F, const Args& A, int j, int wg0, int nwg) {
    phase_enter(F);
    LAS float* scr = (LAS float*)(F.lds + F.wave * 16896);
    const int gw = ((int)blockIdx.x - wg0) * NWAVES + F.wave, NGW = nwg * NWAVES;
    constexpr int IE = 16 * 56, I2 = 56 * 16;
    bf16_t* MW13 = (bf16_t*)(F.ws + WS_BIG + BIG_MW13); bf16_t* MW2 = (bf16_t*)(F.ws + WS_BIG + BIG_MW2);
    for (int it = gw; it < 8 * (2 * IE + I2); it += NGW) {
        const int e = it / (2 * IE + I2); int r = it - e * (2 * IE + I2);
        const size_t we = (size_t)(j * 8 + e) * 1024 * DFFE;
        if (r < IE) { transpose_item(A.moe_w1 + we, DFFE, 0, 56, 1024, MW13 + (size_t)e * 7168 * 1024, 1, 0, scr, r, F.lane); continue; } r -= IE;
        if (r < IE) { transpose_item(A.moe_w3 + we, DFFE, 0, 56, 1024, MW13 + (size_t)e * 7168 * 1024, 1, 1, scr, r, F.lane); continue; } r -= IE;
        transpose_item(A.moe_w2 + we, 1024, 0, 16, DFFE, MW2 + (size_t)e * 1024 * DFFE, 0, 0, scr, r, F.lane);
    }
}

__device__ __forceinline__ void norm_phase(Frame& F, const Args& A, int i, int which, int mode) {
    phase_enter(F);
    const bool first = mode & 1, combine = mode & 2, route = mode & 4, fin = mode & 8, lastl = mode & 16;
    const float* MODV = (const float*)(F.ws + WS_MODV);
    bf16_t* H = (bf16_t*)F.out; bf16_t* XR = (bf16_t*)(F.ws + WS_XR);
    const bf16_t* EO = (const bf16_t*)(F.ws + WS_Y);
    LAS float* rt = (LAS float*)F.lds;
    LAS int* ents = (LAS int*)(F.lds + 32768);
    const int jm = i >> 1;
    if (route) { const float* rg = A.moe_router + (size_t)jm * 1024 * 8; for (int idx = F.tid; idx < 8192; idx += 512) rt[(idx & 7) * 1024 + (idx >> 3)] = rg[idx]; }
    __syncthreads();
    const float* nw = fin ? A.final_norm_w : ((which == 0 ? A.norm1_w : A.norm2_w) + i * 1024);
    unsigned* cnt = (unsigned*)(F.ctl + CW_CNT + (size_t)jm * 8 * 64);
    int* rlist = (int*)(F.ws + WS_RLIST); float* GATE = (float*)(F.ws + WS_GATE);
    int kk = -1;
    for (int ch = blockIdx.x; ch < MROWS / 32; ch += F.G) {
        ++kk;
        const int R0 = ch * 32, b = R0 / SROW, s0 = R0 - b * SROW; const bool isctx = s0 < NCTX; const int cond = isctx ? 16 : b;
        if (fin && isctx) continue;
        const bool do_route = route && !(lastl && isctx);
        const float* mv = MODV + (size_t)(i * 17 + cond) * 6144;
        f32x4 wv[4], shv[4], scv[4], g5[4];
#pragma unroll
        for (int j = 0; j < 4; ++j) { const int col = 4 * F.lane + 256 * j; wv[j] = *(const f32x4*)(nw + col);
            if (!fin) { shv[j] = *(const f32x4*)(mv + (which ? 3 : 0) * 1024 + col); scv[j] = *(const f32x4*)(mv + (which ? 4 : 1) * 1024 + col); }
            if (combine) g5[j] = *(const f32x4*)(MODV + (size_t)((i - 1) * 17 + cond) * 6144 + 5 * 1024 + col); }
        for (int rr = 0; rr < 4; ++rr) {
            const int R = R0 + F.wave * 4 + rr, s = s0 + F.wave * 4 + rr;
            bf16_t* xr = XR + (size_t)R * DM + 4 * F.lane;
            f32x4 v[4]; float ss = 0.f;
            if (first) { const float* src = isctx ? A.ctx + (size_t)(b * NCTX + s) * DM : A.x + (size_t)(b * SEQ + s - NCTX) * DM;
#pragma unroll
                for (int j = 0; j < 4; ++j) v[j] = *(const f32x4*)(src + 4 * F.lane + 256 * j);
            } else {
#pragma unroll
                for (int j = 0; j < 4; ++j) { const u32x2 w = *(const u32x2*)(xr + 256 * j); v[j] = (f32x4){bf_lo(w.x), bf_hi(w.x), bf_lo(w.y), bf_hi(w.y)}; }
            }
            if (combine) {
#pragma unroll
                for (int j = 0; j < 4; ++j) { const u32x2 e0 = *(const u32x2*)(EO + (size_t)(2 * R) * DM + 4 * F.lane + 256 * j), e1 = *(const u32x2*)(EO + (size_t)(2 * R + 1) * DM + 4 * F.lane + 256 * j);
                    f32x4 ev; ev.x = bf_lo(e0.x) + bf_lo(e1.x); ev.y = bf_hi(e0.x) + bf_hi(e1.x); ev.z = bf_lo(e0.y) + bf_lo(e1.y); ev.w = bf_hi(e0.y) + bf_hi(e1.y);
                    v[j] = v[j] + g5[j] * ev; }
                if (!fin) {
#pragma unroll
                    for (int j = 0; j < 4; ++j) { u32x2 o; o.x = pk2(v[j].x, v[j].y); o.y = pk2(v[j].z, v[j].w); *(u32x2*)(xr + 256 * j) = o; }
                }
            }
#pragma unroll
            for (int j = 0; j < 4; ++j) ss += (v[j].x * v[j].x + v[j].y * v[j].y) + (v[j].z * v[j].z + v[j].w * v[j].w);
            const float rstd = 1.0f / sqrtf(wave_sum(ss, F.lane) * (1.0f / DM) + EPS);
            if (fin) { float* orow = F.out + (size_t)(b * SEQ + s - NCTX) * DM;
#pragma unroll
                for (int j = 0; j < 4; ++j) *(f32x4*)(orow + 4 * F.lane + 256 * j) = v[j] * rstd * wv[j];
                continue;
            }
#pragma unroll
            for (int j = 0; j < 4; ++j) { v[j] = v[j] * rstd * wv[j] * (scv[j] + 1.0f) + shv[j];
                u32x2 o; o.x = pk2(v[j].x, v[j].y); o.y = pk2(v[j].z, v[j].w); *(u32x2*)(H + (size_t)R * DM + 4 * F.lane + 256 * j) = o; }
            if (do_route) {
                float lg[8];
#pragma unroll
                for (int e = 0; e < 8; ++e) lg[e] = 0.f;
#pragma unroll
                for (int e = 0; e < 8; ++e)
#pragma unroll
                    for (int j = 0; j < 4; ++j) { const f32x4 r = *(const LAS f32x4*)(rt + e * 1024 + 4 * F.lane + 256 * j); lg[e] += (v[j].x * r.x + v[j].y * r.y) + (v[j].z * r.z + v[j].w * r.w); }
#pragma unroll
                for (int e = 0; e < 8; ++e) lg[e] = wave_sum(lg[e], F.lane);
                int i1 = 0; float v1 = lg[0];
#pragma unroll
                for (int e = 1; e < 8; ++e) if (lg[e] > v1) { v1 = lg[e]; i1 = e; }
                int i2 = -1; float v2 = -3.0e38f;
#pragma unroll
                for (int e = 0; e < 8; ++e) if (e != i1 && lg[e] > v2) { v2 = lg[e]; i2 = e; }
                const float g1 = 1.0f / (1.0f + expf(v2 - v1)), g2 = 1.0f - g1;
                if (F.lane == 0) { ents[(kk & 15) * 64 + (F.wave * 4 + rr) * 2] = i1; ents[(kk & 15) * 64 + (F.wave * 4 + rr) * 2 + 1] = i2; GATE[(size_t)R * 2] = g1; GATE[(size_t)R * 2 + 1] = g2; }
            } else if (route && F.lane == 0) { ents[(kk & 15) * 64 + (F.wave * 4 + rr) * 2] = -1; ents[(kk & 15) * 64 + (F.wave * 4 + rr) * 2 + 1] = -1; }
        }
    }
    if (route) {
        __syncthreads();
        if (F.wave == 0) {
            const int npass = kk + 1;
            int n[8];
#pragma unroll
            for (int ee = 0; ee < 8; ++ee) n[ee] = 0;
            for (int p = 0; p < npass; ++p) { const int e = ents[(p & 15) * 64 + F.lane];
#pragma unroll
                for (int ee = 0; ee < 8; ++ee) n[ee] += __popcll(__ballot(e == ee)); }
            int myn = n[0];
#pragma unroll
            for (int ee = 1; ee < 8; ++ee) myn = (F.lane == ee) ? n[ee] : myn;
            unsigned basel = 0u;
            if (F.lane < 8) basel = __hip_atomic_fetch_add(cnt + F.lane * 64, (unsigned)myn, RLX_AGENT);
            int off[8];
#pragma unroll
            for (int ee = 0; ee < 8; ++ee) off[ee] = __builtin_amdgcn_readlane((int)basel, ee);
            for (int p = 0; p < npass; ++p) { const int e = ents[(p & 15) * 64 + F.lane]; const int Rp = ((int)blockIdx.x + p * F.G) * 32;
#pragma unroll
                for (int ee = 0; ee < 8; ++ee) { const unsigned long long m = __ballot(e == ee);
                    if (e == ee) rlist[(size_t)ee * MROWS + off[ee] + __popcll(m & ((1ull << F.lane) - 1ull))] = (Rp + (F.lane >> 1)) * 2 + (F.lane & 1);
                    off[ee] += __popcll(m); } }
        }
        __syncthreads();
    }
}

struct EpiXbc {
    static constexpr bool PERM = true;
    bf16_t* XBC; float* DT; bf16_t* HALO;
    __device__ __forceinline__ void operator()(const f32x4 (&acc)[2][2][4][2], const pg8::Unit& u, int wr, int wc, int fr, int fq) const {
        const int row0 = u.pm * 256 + wr * 64 + fr;
        if (u.pn < 16) { const int col0 = u.pn * 256 + wc * 32 + 8 * fq;
#pragma unroll
            for (int ai = 0; ai < 2; ++ai)
#pragma unroll
                for (int m = 0; m < 4; ++m) { bf16_t* rowp = XBC + (size_t)(row0 + ai * 128 + m * 16) * CONVCH + col0;
#pragma unroll
                    for (int bj = 0; bj < 2; ++bj) { const f32x4 v0 = acc[ai][bj][m][0], v1 = acc[ai][bj][m][1]; u32x4 w; w.x = pg8::cvt_pk_bf16(v0[0], v0[1]); w.y = pg8::cvt_pk_bf16(v0[2], v0[3]); w.z = pg8::cvt_pk_bf16(v1[0], v1[1]); w.w = pg8::cvt_pk_bf16(v1[2], v1[3]);
                        *(GAS u32x4*)(rowp + bj * 128) = w;
                        const int rin = ai * 128 + wr * 64 + m * 16 + fr, rq = rin >> 6, rw = rin & 63;
                        if (rw < 2 || rw >= 62) *(GAS u32x4*)(HALO + ((size_t)u.pm * 16 + (rw < 2 ? (rq == 0 ? rw : 4 * rq + rw) : 4 * rq + rw - 60)) * CONVCH + col0 + bj * 128) = w; } }
        } else if (wc < 2) { const int c0 = wc * 32 + 8 * fq;
#pragma unroll
            for (int ai = 0; ai < 2; ++ai)
#pragma unroll
                for (int m = 0; m < 4; ++m) { float* p = DT + (size_t)(row0 + ai * 128 + m * 16) * 64 + c0; *(GAS f32x4*)p = acc[ai][0][m][0]; *(GAS f32x4*)(p + 4) = acc[ai][0][m][1]; }
        }
    }
};
struct EpiGate {
    static constexpr bool PERM = true;
    const bf16_t* Y; bf16_t* Gt; const float* nw; LAS float* P;
    __device__ __forceinline__ void operator()(f32x4 (&acc)[2][2][4][2], const pg8::Unit& u, int wr, int wc, int fr, int fq) const {
        const int row0 = u.pm * 256 + wr * 64 + fr, col0 = u.pn * 256 + wc * 32 + 8 * fq;
        u32x4 yq[2][4][2];
        { const GAS char* yb = (const GAS char*)(Y + (size_t)(u.pm * 256) * DIN + u.pn * 256); unsigned yo = (unsigned)((wr * 64 + fr) * DIN * 2); asm volatile("" : "+v"(yo));
#pragma unroll
          for (int ai = 0; ai < 2; ++ai)
#pragma unroll
            for (int m = 0; m < 4; ++m)
#pragma unroll
                for (int bj = 0; bj < 2; ++bj) { const int cg = bj * 128 + wc * 32 + 8 * fq; const int cy = ((cg >> 5) & 1) * 128 + (cg >> 6) * 32 + (cg & 31);
                    yq[ai][m][bj] = *(const GAS u32x4*)(yb + (size_t)(ai * 128 + m * 16) * DIN * 2 + yo + cy * 2); } }
#pragma unroll
        for (int ai = 0; ai < 2; ++ai)
#pragma unroll
            for (int m = 0; m < 4; ++m) { float ssq = 0.f;
#pragma unroll
                for (int bj = 0; bj < 2; ++bj) { const u32x4 yv = yq[ai][m][bj]; f32x4 z0 = acc[ai][bj][m][0], z1 = acc[ai][bj][m][1];
                    z0[0] = bf_lo(yv.x) * siluf(z0[0]); z0[1] = bf_hi(yv.x) * siluf(z0[1]); z0[2] = bf_lo(yv.y) * siluf(z0[2]); z0[3] = bf_hi(yv.y) * siluf(z0[3]);
                    z1[0] = bf_lo(yv.z) * siluf(z1[0]); z1[1] = bf_hi(yv.z) * siluf(z1[1]); z1[2] = bf_lo(yv.w) * siluf(z1[2]); z1[3] = bf_hi(yv.w) * siluf(z1[3]);
                    ssq += (z0[0] * z0[0] + z0[1] * z0[1]) + (z0[2] * z0[2] + z0[3] * z0[3]) + (z1[0] * z1[0] + z1[1] * z1[1]) + (z1[2] * z1[2] + z1[3] * z1[3]);
                    acc[ai][bj][m][0] = z0; acc[ai][bj][m][1] = z1; }
                ssq += shx(ssq, 16, fq * 16 + fr); ssq += shx(ssq, 32, fq * 16 + fr);
                if (fq == 0) P[(ai * 128 + wr * 64 + m * 16 + fr) * 4 + wc] = ssq; }
        asm volatile("s_waitcnt lgkmcnt(0)" ::: "memory"); __builtin_amdgcn_s_barrier(); asm volatile("" ::: "memory");
        f32x4 nv[2][2];
#pragma unroll
        for (int bj = 0; bj < 2; ++bj) { nv[bj][0] = *(const GAS f32x4*)(nw + col0 + bj * 128); nv[bj][1] = *(const GAS f32x4*)(nw + col0 + bj * 128 + 4); }
#pragma unroll
        for (int ai = 0; ai < 2; ++ai)
#pragma unroll
            for (int m = 0; m < 4; ++m) { const f32x4 pp = *(const LAS f32x4*)(P + (ai * 128 + wr * 64 + m * 16 + fr) * 4); const float rstd = 1.0f / sqrtf(((pp.x + pp.y) + (pp.z + pp.w)) * (1.0f / 256.0f) + EPS);
                bf16_t* gp = Gt + (size_t)(row0 + ai * 128 + m * 16) * DIN + col0;
#pragma unroll
                for (int bj = 0; bj < 2; ++bj) { const f32x4 v0 = acc[ai][bj][m][0] * rstd * nv[bj][0], v1 = acc[ai][bj][m][1] * rstd * nv[bj][1];
                    u32x4 w; w.x = pg8::cvt_pk_bf16(v0[0], v0[1]); w.y = pg8::cvt_pk_bf16(v0[2], v0[3]); w.z = pg8::cvt_pk_bf16(v1[0], v1[1]); w.w = pg8::cvt_pk_bf16(v1[2], v1[3]);
                    *(GAS u32x4*)(gp + bj * 128) = w; } }
        asm volatile("s_waitcnt lgkmcnt(0)" ::: "memory");
    }
};
struct EpiResid {
    static constexpr bool PERM = true;
    bf16_t* XR; const float* modl; int gidx; const float* bias; const float* rd_x; const float* rd_ctx;
    __device__ __forceinline__ void operator()(const f32x4 (&acc)[2][2][4][2], const pg8::Unit& u, int wr, int wc, int fr, int fq) const {
        const int b = u.pm / 17, j = u.pm - b * 17, cond = j == 0 ? 16 : b;
        const GAS char* pbase = (const GAS char*)(XR + (size_t)u.pm * 256 * DM);
        unsigned lo = (unsigned)(((wr * 64 + fr) * DM + u.pn * 256 + wc * 32 + 8 * fq) * 2); asm volatile("" : "+v"(lo));
        const GAS char* ibase = (const GAS char*)(rd_x ? (j == 0 ? rd_ctx + (size_t)(b * NCTX) * DM : rd_x + (size_t)(b * SEQ + (j - 1) * 256) * DM) : nullptr);
        const GAS float* gv = (const GAS float*)(modl + (size_t)cond * 6144 + gidx * 1024 + u.pn * 256 + wc * 32 + 8 * fq);
        const GAS float* bp = (const GAS float*)(bias ? bias + u.pn * 256 + wc * 32 + 8 * fq : nullptr);
#pragma unroll
        for (int bj = 0; bj < 2; ++bj) {
            f32x4 g[2], bv[2];
#pragma unroll
            for (int n = 0; n < 2; ++n) { g[n] = *(const GAS f32x4*)(gv + bj * 128 + n * 4); bv[n] = bp ? *(const GAS f32x4*)(bp + bj * 128 + n * 4) : (f32x4){0.f, 0.f, 0.f, 0.f}; }
#pragma unroll
            for (int ai = 0; ai < 2; ++ai) {
                f32x4 o[4][2];
                if (rd_x) {
#pragma unroll
                    for (int m = 0; m < 4; ++m)
#pragma unroll
                        for (int n = 0; n < 2; ++n) o[m][n] = *(const GAS f32x4*)(ibase + (size_t)(ai * 128 + m * 16) * DM * 4 + 2 * lo + (bj * 128 + n * 4) * 4);
                } else {
                    u32x4 w[4];
#pragma unroll
                    for (int m = 0; m < 4; ++m) w[m] = *(const GAS u32x4*)(pbase + (size_t)(ai * 128 + m * 16) * DM * 2 + lo + bj * 256);
#pragma unroll
                    for (int m = 0; m < 4; ++m) { o[m][0] = (f32x4){bf_lo(w[m].x), bf_hi(w[m].x), bf_lo(w[m].y), bf_hi(w[m].y)}; o[m][1] = (f32x4){bf_lo(w[m].z), bf_hi(w[m].z), bf_lo(w[m].w), bf_hi(w[m].w)}; }
                }
#pragma unroll
                for (int m = 0; m < 4; ++m) { const f32x4 r0 = o[m][0] + g[0] * (acc[ai][bj][m][0] + bv[0]), r1 = o[m][1] + g[1] * (acc[ai][bj][m][1] + bv[1]);
                    u32x4 w; w.x = pg8::cvt_pk_bf16(r0[0], r0[1]); w.y = pg8::cvt_pk_bf16(r0[2], r0[3]); w.z = pg8::cvt_pk_bf16(r1[0], r1[1]); w.w = pg8::cvt_pk_bf16(r1[2], r1[3]);
                    *(GAS u32x4*)(pbase + (size_t)(ai * 128 + m * 16) * DM * 2 + lo + bj * 256) = w; }
                asm volatile("" ::: "memory");
            }
        }
    }
};
struct EpiSwiglu {
    static constexpr bool PERM = true;
    bf16_t* ACT; int ldc;
    __device__ __forceinline__ void operator()(const f32x4 (&acc)[2][2][4][2], const pg8::Unit& u, int wr, int wc, int fr, int fq) const {
        const int row0 = u.pm * 256 + wr * 64 + fr, col0 = u.pn * 128 + wc * 32 + 8 * fq;
#pragma unroll
        for (int ai = 0; ai < 2; ++ai)
#pragma unroll
            for (int m = 0; m < 4; ++m) { const f32x4 g0 = acc[ai][0][m][0], g1 = acc[ai][0][m][1], u0 = acc[ai][1][m][0], u1 = acc[ai][1][m][1];
                u32x4 w; w.x = pg8::cvt_pk_bf16(siluf(g0[0]) * u0[0], siluf(g0[1]) * u0[1]); w.y = pg8::cvt_pk_bf16(siluf(g0[2]) * u0[2], siluf(g0[3]) * u0[3]);
                w.z = pg8::cvt_pk_bf16(siluf(g1[0]) * u1[0], siluf(g1[1]) * u1[1]); w.w = pg8::cvt_pk_bf16(siluf(g1[2]) * u1[2], siluf(g1[3]) * u1[3]);
                *(GAS u32x4*)(ACT + (size_t)(row0 + ai * 128 + m * 16) * ldc + col0) = w; }
    }
};
struct EpiQkv {
    static constexpr bool PERM = false;
    bf16_t *Q, *Kb, *Vb; const LAS float* T;
    __device__ __forceinline__ void operator()(const f32x4 (&acc)[2][2][4][2], const pg8::Unit& u, int wr, int wc, int fr, int fq) const {
        const int b = u.pm / 17, j = u.pm - b * 17; const bool isctx = j == 0; const int pos0 = (j - 1) * 256;
        bf16_t* dst; int ld, cbase; float sc = 1.0f;
        if (u.pn < 4) { dst = Q; ld = QW; cbase = u.pn * 256; sc = 0.125f * 1.4426950408889634f;   } else if (u.pn == 4) { dst = Kb; ld = KVW; cbase = 0; } else { dst = Vb; ld = KVW; cbase = 0; }
        const bool dorope = !isctx && u.pn < 5; const int axis = wc & 1;
        const LAS float* bp = T + 2048 + u.pn * 256 + wc * 32 + 4 * fq;
        f32x4 bv[2][2];
#pragma unroll
        for (int bj = 0; bj < 2; ++bj)
#pragma unroll
            for (int n = 0; n < 2; ++n) bv[bj][n] = *(const LAS f32x4*)(bp + bj * 128 + n * 16);
#pragma unroll
        for (int ai = 0; ai < 2; ++ai)
#pragma unroll
            for (int m = 0; m < 4; ++m) { const int r = ai * 128 + wr * 64 + m * 16 + fr; const int pos = pos0 + r; const int id = axis ? (pos & 63) : (pos >> 6);
                f32x4 cs = (f32x4){1.f, 1.f, 1.f, 1.f}, sn = (f32x4){0.f, 0.f, 0.f, 0.f};
                if (dorope) { cs = *(const LAS f32x4*)(T + id * 16 + 4 * fq); sn = *(const LAS f32x4*)(T + 1024 + id * 16 + 4 * fq); }
                GAS bf16_t* rowp = (GAS bf16_t*)(dst + (size_t)(u.pm * 256 + r) * ld + cbase + wc * 32 + 4 * fq);
#pragma unroll
                for (int bj = 0; bj < 2; ++bj) { const f32x4 x0 = (acc[ai][bj][m][0] + bv[bj][0]) * sc, x1 = (acc[ai][bj][m][1] + bv[bj][1]) * sc;
                    const f32x4 o0 = x0 * cs - x1 * sn, o1 = x1 * cs + x0 * sn;
                    u32x2 w0, w1; w0.x = pg8::cvt_pk_bf16(o0[0], o0[1]); w0.y = pg8::cvt_pk_bf16(o0[2], o0[3]); w1.x = pg8::cvt_pk_bf16(o1[0], o1[1]); w1.y = pg8::cvt_pk_bf16(o1[2], o1[3]);
                    *(GAS u32x2*)(rowp + bj * 128) = w0; *(GAS u32x2*)(rowp + bj * 128 + 16) = w1; } }
    }
};

struct MoeOrder {
    pg8::StaticOrder so; int cs; int pp[9]; int cnt[8]; const int* rlist; size_t bstride; bool GATHER_A;
    __device__ __forceinline__ void locate(int pm, int& e, int& p, int& cn) const { const int gp = cs + pm; e = 0; int pbase = 0; cn = cnt[0];
#pragma unroll
        for (int k = 1; k < 8; ++k) { const bool ge = gp >= pp[k]; e += ge ? 1 : 0; pbase = ge ? pp[k] : pbase; cn = ge ? cnt[k] : cn; }
        p = gp - pbase; }
    __device__ bool next(int i, pg8::Unit& u) const { return so.next(i, u); }
    __device__ __forceinline__ const char* a_base(const pg8::Gemm& g, const pg8::Unit& u) const { return GATHER_A ? (const char*)g.A : (const char*)g.A + (size_t)u.pm * (size_t)(256 * 2) * g.lda; }
    __device__ __forceinline__ const char* b_base(const pg8::Gemm& g, const pg8::Unit& u) const { int e, p, cn; locate(u.pm, e, p, cn); return (const char*)g.Bt + (size_t)e * bstride + (size_t)u.pn * (size_t)(256 * 2) * g.K; }
    __device__ __forceinline__ unsigned row_off(const pg8::Gemm& g, const pg8::Unit& u, int r) const {
        if (!GATHER_A) return (unsigned)r * (unsigned)g.lda * 2u;
        int e, p, cn; locate(u.pm, e, p, cn); const int idx = p * 256 + r; const int tok = idx < cn ? (rlist[(size_t)e * MROWS + idx] >> 1) : 0; return (unsigned)tok * (unsigned)g.lda * 2u; }
};
struct EpiMoeDown {
    static constexpr bool PERM = true;
    MoeOrder mo; bf16_t* EO; const float* GATE;
    __device__ __forceinline__ void operator()(const f32x4 (&acc)[2][2][4][2], const pg8::Unit& u, int wr, int wc, int fr, int fq) const {
        int e, p, cn; mo.locate(u.pm, e, p, cn); const int* rl = mo.rlist + (size_t)e * MROWS + p * 256;
        const int col0 = u.pn * 256 + wc * 32 + 8 * fq;
#pragma unroll
        for (int ai = 0; ai < 2; ++ai)
#pragma unroll
            for (int m = 0; m < 4; ++m) { const int r = ai * 128 + wr * 64 + m * 16 + fr;
                if (p * 256 + r < cn) { const int ent = rl[r]; const float gt = GATE[ent]; bf16_t* dp = EO + (size_t)ent * DM + col0;
#pragma unroll
                    for (int bj = 0; bj < 2; ++bj) { const f32x4 v0 = acc[ai][bj][m][0] * gt, v1 = acc[ai][bj][m][1] * gt; u32x4 w; w.x = pg8::cvt_pk_bf16(v0[0], v0[1]); w.y = pg8::cvt_pk_bf16(v0[2], v0[3]); w.z = pg8::cvt_pk_bf16(v1[0], v1[1]); w.w = pg8::cvt_pk_bf16(v1[2], v1[3]);
                        *(GAS u32x4*)(dp + bj * 128) = w; } } }
    }
};

typedef __bf16 bf16x2_t __attribute__((ext_vector_type(2)));
typedef short v4i16_t __attribute__((ext_vector_type(4)));
__device__ __forceinline__ unsigned cvtpk(float lo, float hi) { f32x2 v = {lo, hi}; bf16x2_t b = __builtin_convertvector(v, bf16x2_t); return __builtin_bit_cast(unsigned, b); }
__device__ __forceinline__ int crow(int r, int hi) { return (r & 3) + 8 * (r >> 2) + 4 * hi; }
__device__ __forceinline__ s16x4 vtr(const LAS unsigned char* p) { return __builtin_bit_cast(s16x4, __builtin_amdgcn_ds_read_tr16_b64_v4i16((LAS v4i16_t*)p)); }
#define MFMA32(a, b, c) __builtin_amdgcn_mfma_f32_32x32x16_bf16((a), (b), (c), 0, 0, 0)
__device__ __forceinline__ void conv_phase(Frame& F, const Args& A, int j) {
    phase_enter(F);
    bf16_t* XBC = (bf16_t*)(F.ws + WS_BIG); const bf16_t* HALO = (const bf16_t*)(F.ws + WS_HALO);
    const int lane = F.lane;
    const int gw = blockIdx.x * NWAVES + F.wave, NGW = F.G * NWAVES;
    for (int task = gw; task < NPAN * 32; task += NGW) {
        const int pm = task >> 5, q = (task >> 3) & 3, sl = task & 7, jj = pm % 17, c0 = sl * 512 + lane * 8;
        const bool top_zero = q == 0 && jj <= 1, bot_zero = q == 3 && (jj == 0 || jj == 16);
        const GAS bf16_t* htop = (const GAS bf16_t*)(HALO + (q == 0 ? ((size_t)(pm - 1) * 16 + 14) : ((size_t)pm * 16 + 4 * q - 2)) * CONVCH + c0);
        const GAS bf16_t* hbot = (const GAS bf16_t*)(HALO + (q == 3 ? ((size_t)(pm + 1) * 16 + 0) : ((size_t)pm * 16 + 4 * q + 4)) * CONVCH + c0);
        f32x2 cw[5][4], cbias[4];
#pragma unroll
        for (int k = 0; k < 5; ++k) { const f32x4 a0 = *(const GAS f32x4*)(A.ssd_conv_w + (size_t)(j * 5 + k) * CONVCH + c0), a1 = *(const GAS f32x4*)(A.ssd_conv_w + (size_t)(j * 5 + k) * CONVCH + c0 + 4);
            cw[k][0] = (f32x2){a0.x, a0.y}; cw[k][1] = (f32x2){a0.z, a0.w}; cw[k][2] = (f32x2){a1.x, a1.y}; cw[k][3] = (f32x2){a1.z, a1.w}; }
        { const f32x4 a0 = *(const GAS f32x4*)(A.ssd_conv_b + (size_t)j * CONVCH + c0), a1 = *(const GAS f32x4*)(A.ssd_conv_b + (size_t)j * CONVCH + c0 + 4);
            cbias[0] = (f32x2){a0.x, a0.y}; cbias[1] = (f32x2){a0.z, a0.w}; cbias[2] = (f32x2){a1.x, a1.y}; cbias[3] = (f32x2){a1.z, a1.w}; }
        GAS bf16_t* base = (GAS bf16_t*)(XBC + ((size_t)pm * 256 + q * 64) * CONVCH + c0);
        const u32x4 zero4 = (u32x4){0u, 0u, 0u, 0u};
        u32x4 win[12], pre[8];
        win[0] = top_zero ? zero4 : *(const GAS u32x4*)(htop);
        win[1] = top_zero ? zero4 : *(const GAS u32x4*)(htop + CONVCH);
#pragma unroll
        for (int r = 0; r < 10; ++r) win[2 + r] = *(const GAS u32x4*)(base + (size_t)r * CONVCH);
        for (int k = 0; k < 8; ++k) {
            if (k < 6) {
#pragma unroll
                for (int r = 0; r < 8; ++r) pre[r] = *(const GAS u32x4*)(base + (size_t)(8 * k + 10 + r) * CONVCH);
            } else if (k == 6) {
#pragma unroll
                for (int r = 0; r < 6; ++r) pre[r] = *(const GAS u32x4*)(base + (size_t)(58 + r) * CONVCH);
                pre[6] = bot_zero ? zero4 : *(const GAS u32x4*)(hbot);
                pre[7] = bot_zero ? zero4 : *(const GAS u32x4*)(hbot + CONVCH);
            }
#pragma unroll
            for (int o = 0; o < 8; ++o) {
                f32x2 r[4];
#pragma unroll
                for (int c = 0; c < 4; ++c) r[c] = cbias[c];
#pragma unroll
                for (int t = 0; t < 5; ++t) { const u32x4 w = win[o + t];
                    r[0] += cw[t][0] * (f32x2){bf_lo(w.x), bf_hi(w.x)}; r[1] += cw[t][1] * (f32x2){bf_lo(w.y), bf_hi(w.y)};
                    r[2] += cw[t][2] * (f32x2){bf_lo(w.z), bf_hi(w.z)}; r[3] += cw[t][3] * (f32x2){bf_lo(w.w), bf_hi(w.w)}; }
                u32x4 w; w.x = cvtpk(siluf(r[0].x), siluf(r[0].y)); w.y = cvtpk(siluf(r[1].x), siluf(r[1].y)); w.z = cvtpk(siluf(r[2].x), siluf(r[2].y)); w.w = cvtpk(siluf(r[3].x), siluf(r[3].y));
                *(GAS u32x4*)(base + (size_t)(8 * k + o) * CONVCH) = w;
            }
#pragma unroll
            for (int r = 0; r < 4; ++r) win[r] = win[8 + r];
#pragma unroll
            for (int r = 0; r < 8; ++r) win[4 + r] = pre[r];
        }
    }
}

constexpr int SC_RS = 272;
constexpr int SC_TILE = 3 * 32 * SC_RS;
constexpr int SC_YS = 2 * SC_TILE;
constexpr int SC_WS = SC_YS + 16384;
constexpr int SC_RAW = 73728;
static_assert(SC_WS + 4096 <= SC_RAW && SC_RAW + 2 * 36 * 1024 <= LDSCTL_OFF, "scan LDS map");
template <int PH>
__device__ __forceinline__ void scan_phase(Frame& F, const Args& A, int j) {
    phase_enter(F);
    const bf16_t* XBC = (const bf16_t*)(F.ws + WS_BIG); const float* DT = (const float*)(F.ws + WS_DT); bf16_t* Y = (bf16_t*)(F.ws + WS_Y);
    const int lane = F.lane, wave = F.wave;
    for (int u0 = blockIdx.x; u0 < 256; u0 += F.G) {
        const int unit = (F.G == 256) ? ((u0 & 7) * 32 + (u0 >> 3)) : u0;
        const int b = unit >> 4, g = (unit >> 1) & 7, ph = unit & 1;
        const int srow = F.tid >> 4, sch = F.tid & 15;
        const int gcolB = 2048 + g * 128 + sch * 8, gcolC = 3072 + g * 128 + sch * 8, gcolX = g * 256 + (sch >> 2) * 64 + ph * 32 + (sch & 3) * 8;
        const int hh = wave >> 1, dir = wave & 1, c31 = lane & 31, hl = lane >> 5;
        const int trq = (lane & 15) >> 2, trp = lane & 3, trb = (lane >> 4) & 1;
        const int head = g * 4 + hh;
        const float Dk = A.ssd_d[(j * 2 + dir) * 32 + head], dtb = A.ssd_dt_bias[(j * 2 + dir) * 32 + head], aneg = -expf(A.ssd_a_log[(j * 2 + dir) * 32 + head]);
        LAS float* wsf = (LAS float*)(F.lds + SC_WS + wave * 512);
        int offRow = dir * SC_TILE + c31 * SC_RS + 16 * hl;
        int offC4 = dir * SC_TILE + 32 * SC_RS + c31 * SC_RS + 8 * hl;
        int offTrX = dir * SC_TILE + 64 * SC_RS + trq * SC_RS + (hh * 32 + 16 * trb + 4 * trp) * 2;
        int offTrB = dir * SC_TILE + trq * SC_RS + (16 * trb + 4 * trp) * 2;
        int ysoff = (4 * hl) * 128 + hh * 32 + c31;
        asm volatile("" : "+v"(offRow), "+v"(offC4), "+v"(offTrX), "+v"(offTrB), "+v"(ysoff));
        f32x16 ST[4];
#pragma unroll
        for (int t = 0; t < 4; ++t)
#pragma unroll
            for (int e = 0; e < 16; ++e) ST[t][e] = 0.f;
#define SC_PF(pf, st_) do { const int st = (PH >= 2) ? 0 : (st_); const int cf_ = (st), cb_ = (st) < 8 ? 7 - (st) : 143 - (st); \
            _Pragma("unroll") for (int T = 0; T < 2; ++T) { const GAS bf16_t* rp = (const GAS bf16_t*)(XBC + (size_t)(b * SROW + (T ? cb_ : cf_) * 32 + srow) * CONVCH); \
                pf[T][0] = *(const GAS u32x4*)(rp + gcolB); pf[T][1] = *(const GAS u32x4*)(rp + gcolC); pf[T][2] = *(const GAS u32x4*)(rp + gcolX); } } while (0)
#define SC_DTLOAD(st) DT[(size_t)(b * SROW + (dir ? ((st) < 8 ? 7 - (st) : 143 - (st)) : (st)) * 32 + c31) * 64 + dir * 32 + head]
#define SC_WRITEOUT(st) do { const int cf_ = (st), cb_ = (st) < 8 ? 7 - (st) : 143 - (st); \
            _Pragma("unroll") for (int T = 0; T < 2; ++T) { const int tok = F.tid >> 4, h4 = (F.tid >> 2) & 3, q4 = F.tid & 3, chunk = T ? cb_ : cf_; \
                const int other = T == 0 ? (chunk < 8 ? 7 - chunk : 143 - chunk) : chunk; \
                u32x4 v = *(const LAS u32x4*)(F.lds + SC_YS + T * 8192 + (tok * 128 + h4 * 32 + q4 * 8) * 2); \
                bf16_t* yp = Y + (size_t)(b * SROW + chunk * 32 + tok) * DIN + g * 256 + ph * 128 + h4 * 32 + q4 * 8; \
                if ((st) > other) { const u32x4 o = oldy[T]; \
                    v.x = pk2(bf_lo(o.x) + bf_lo(v.x), bf_hi(o.x) + bf_hi(v.x)); v.y = pk2(bf_lo(o.y) + bf_lo(v.y), bf_hi(o.y) + bf_hi(v.y)); \
                    v.z = pk2(bf_lo(o.z) + bf_lo(v.z), bf_hi(o.z) + bf_hi(v.z)); v.w = pk2(bf_lo(o.w) + bf_lo(v.w), bf_hi(o.w) + bf_hi(v.w)); } \
                if (PH == 0) *(u32x4*)yp = v; else asm volatile("" :: "v"(v)); } } while (0)
        u32x4 pfE[2][3], pfO[2][3];
        SC_PF(pfE, 0); SC_PF(pfO, 1);
        float dtraw = SC_DTLOAD(0);
        u32x4 oldy[2] = {(u32x4){0u, 0u, 0u, 0u}, (u32x4){0u, 0u, 0u, 0u}};
        for (int step2 = 0; step2 < 136; step2 += 2) {
          { const int step = step2;
            const int cf = step, cbk = step < 8 ? 7 - step : 143 - step;
            __syncthreads();
            if (step > 0) SC_WRITEOUT(step - 1);
#pragma unroll
            for (int T = 0; T < 2; ++T)
#pragma unroll
                for (int a = 0; a < 3; ++a) *(LAS u32x4*)(F.lds + T * SC_TILE + a * (32 * SC_RS) + srow * SC_RS + sch * 16) = pfE[T][a];
            {
                const float xb = dtraw + dtb;
                const float dt = xb > 20.f ? xb : log1pf(__expf(xb)); const float dA = dt * aneg;
                float v = dA;
                v += __builtin_bit_cast(float, __builtin_amdgcn_update_dpp(0, __builtin_bit_cast(int, v), 0x111, 0xf, 0xf, true));
                v += __builtin_bit_cast(float, __builtin_amdgcn_update_dpp(0, __builtin_bit_cast(int, v), 0x112, 0xf, 0xf, true));
                v += __builtin_bit_cast(float, __builtin_amdgcn_update_dpp(0, __builtin_bit_cast(int, v), 0x114, 0xf, 0xf, true));
                v += __builtin_bit_cast(float, __builtin_amdgcn_update_dpp(0, __builtin_bit_cast(int, v), 0x118, 0xf, 0xf, true));
                v += __builtin_bit_cast(float, __builtin_amdgcn_update_dpp(0, __builtin_bit_cast(int, v), 0x142, 0xa, 0xf, false));
                const float tot = __builtin_bit_cast(float, __builtin_amdgcn_readlane(__builtin_bit_cast(int, v), 31));
                const float cum = dir ? (tot - v + dA) : v;
                if (hl == 0) { wsf[c31] = cum; wsf[32 + c31] = dt; wsf[64 + c31] = __expf(tot - cum) * dt; wsf[96 + c31] = __expf(cum); }
            }
            asm volatile("s_waitcnt lgkmcnt(0)" ::: "memory"); __builtin_amdgcn_s_barrier(); asm volatile("" ::: "memory");
            if (step + 2 < 136) SC_PF(pfE, step + 2); if (step + 1 < 136) dtraw = SC_DTLOAD(step + 1);
#pragma unroll
            for (int T = 0; T < 2; ++T) {
                const int tok = F.tid >> 4, h4 = (F.tid >> 2) & 3, q4 = F.tid & 3, chunk = T ? cbk : cf;
                const int other = T == 0 ? (chunk < 8 ? 7 - chunk : 143 - chunk) : chunk;
                if (PH == 0 && step > other) oldy[T] = *(const u32x4*)(Y + (size_t)(b * SROW + chunk * 32 + tok) * DIN + g * 256 + ph * 128 + h4 * 32 + q4 * 8);
            }
            if (PH < 3) {
                const LAS unsigned char* Bs = F.lds + dir * SC_TILE; const LAS unsigned char* Cs = Bs + 32 * SC_RS; const LAS unsigned char* xs = Bs + 64 * SC_RS;
                f32x16 gt;
#pragma unroll
                for (int e = 0; e < 16; ++e) gt[e] = 0.f;
#pragma unroll
                for (int s = 0; s < 8; ++s) { const bf16x8 a = *(const LAS bf16x8*)(F.lds + offRow + 32 * s), bb = *(const LAS bf16x8*)(F.lds + offRow + 32 * SC_RS + 32 * s); gt = MFMA32(a, bb, gt); }
                const float cum_i = wsf[c31];
                bf16x8 mk[2];
                {
                    float mv[16];
#pragma unroll
                    for (int q = 0; q < 4; ++q) { const f32x4 cj = *(const LAS f32x4*)(wsf + 8 * q + 4 * hl), dj = *(const LAS f32x4*)(wsf + 32 + 8 * q + 4 * hl);
#pragma unroll
                        for (int z = 0; z < 4; ++z) { const int jj = 8 * q + 4 * hl + z; const bool ok = dir ? (jj >= c31) : (jj <= c31);
                            float val = gt[4 * q + z] * __expf(ok ? (cum_i - cj[z]) : -INFINITY) * dj[z]; if (jj == c31) val += Dk; mv[4 * q + z] = val; } }
#pragma unroll
                    for (int s2 = 0; s2 < 2; ++s2) { u32x4 w; w.x = cvtpk(mv[8 * s2], mv[8 * s2 + 1]); w.y = cvtpk(mv[8 * s2 + 2], mv[8 * s2 + 3]); w.z = cvtpk(mv[8 * s2 + 4], mv[8 * s2 + 5]); w.w = cvtpk(mv[8 * s2 + 6], mv[8 * s2 + 7]); mk[s2] = __builtin_bit_cast(bf16x8, w); }
                }
                f32x16 ya;
#pragma unroll
                for (int e = 0; e < 16; ++e) ya[e] = 0.f;
#pragma unroll
                for (int t = 0; t < 4; ++t)
#pragma unroll
                    for (int s2 = 0; s2 < 2; ++s2) {
                        const LAS unsigned char* cp = F.lds + offC4 + 64 * t + 32 * s2;
                        const u32x2 c0 = *(const LAS u32x2*)cp, c1 = *(const LAS u32x2*)(cp + 16);
                        const bf16x8 ca = __builtin_bit_cast(bf16x8, (u32x4){c0.x, c0.y, c1.x, c1.y});
                        u32x4 w; w.x = cvtpk(ST[t][8 * s2], ST[t][8 * s2 + 1]); w.y = cvtpk(ST[t][8 * s2 + 2], ST[t][8 * s2 + 3]); w.z = cvtpk(ST[t][8 * s2 + 4], ST[t][8 * s2 + 5]); w.w = cvtpk(ST[t][8 * s2 + 6], ST[t][8 * s2 + 7]);
                        ya = MFMA32(ca, __builtin_bit_cast(bf16x8, w), ya);
                    }
#pragma unroll
                for (int q = 0; q < 4; ++q) { const f32x4 ec = *(const LAS f32x4*)(wsf + 96 + 8 * q + 4 * hl); ya[4 * q] *= ec.x; ya[4 * q + 1] *= ec.y; ya[4 * q + 2] *= ec.z; ya[4 * q + 3] *= ec.w; }
#pragma unroll
                for (int s2 = 0; s2 < 2; ++s2) {
                    const LAS unsigned char* xp = F.lds + offTrX + (16 * s2) * SC_RS + hl * (4 * SC_RS);
                    const s16x4 lo = vtr(xp), hi = vtr(xp + 8 * SC_RS);
                    ya = MFMA32(mk[s2], ((bf16x8){lo[0], lo[1], lo[2], lo[3], hi[0], hi[1], hi[2], hi[3]}), ya);
                }
                {
                    const float etot = dir ? wsf[96] : wsf[96 + 31];
#pragma unroll
                    for (int t = 0; t < 4; ++t)
#pragma unroll
                        for (int e = 0; e < 16; ++e) ST[t][e] *= etot;
#pragma unroll
                    for (int s2 = 0; s2 < 2; ++s2) {
                        const LAS unsigned char* xp = F.lds + offTrX + (16 * s2) * SC_RS + hl * (8 * SC_RS);
                        const s16x4 lo = vtr(xp), hi = vtr(xp + 4 * SC_RS);
                        const f32x4 w0 = *(const LAS f32x4*)(wsf + 64 + 16 * s2 + 8 * hl), w1 = *(const LAS f32x4*)(wsf + 64 + 16 * s2 + 8 * hl + 4);
                        u32x4 xw; xw.x = cvtpk(bf1((bf16_t)lo[0]) * w0.x, bf1((bf16_t)lo[1]) * w0.y); xw.y = cvtpk(bf1((bf16_t)lo[2]) * w0.z, bf1((bf16_t)lo[3]) * w0.w);
                        xw.z = cvtpk(bf1((bf16_t)hi[0]) * w1.x, bf1((bf16_t)hi[1]) * w1.y); xw.w = cvtpk(bf1((bf16_t)hi[2]) * w1.z, bf1((bf16_t)hi[3]) * w1.w);
                        const bf16x8 xb8 = __builtin_bit_cast(bf16x8, xw);
#pragma unroll
                        for (int t = 0; t < 4; ++t) {
                            const LAS unsigned char* bp = F.lds + offTrB + (16 * s2) * SC_RS + hl * (8 * SC_RS) + 64 * t;
                            const s16x4 blo = vtr(bp), bhi = vtr(bp + 4 * SC_RS);
                            ST[t] = MFMA32(((bf16x8){blo[0], blo[1], blo[2], blo[3], bhi[0], bhi[1], bhi[2], bhi[3]}), xb8, ST[t]);
                        }
                    }
                }
                LAS bf16_t* ys = (LAS bf16_t*)(F.lds + SC_YS + dir * 8192) + ysoff;
#pragma unroll
                for (int e = 0; e < 16; e += 2) { const unsigned w = cvtpk(ya[e], ya[e + 1]); ys[((e & 3) + 8 * (e >> 2)) * 128] = (bf16_t)w; ys[((e & 3) + 1 + 8 * (e >> 2)) * 128] = (bf16_t)(w >> 16); }
            }
                  }
          { const int step = step2 + 1;
            const int cf = step, cbk = step < 8 ? 7 - step : 143 - step;
            __syncthreads();
            if (step > 0) SC_WRITEOUT(step - 1);
#pragma unroll
            for (int T = 0; T < 2; ++T)
#pragma unroll
                for (int a = 0; a < 3; ++a) *(LAS u32x4*)(F.lds + T * SC_TILE + a * (32 * SC_RS) + srow * SC_RS + sch * 16) = pfO[T][a];
            {
                const float xb = dtraw + dtb;
                const float dt = xb > 20.f ? xb : log1pf(__expf(xb)); const float dA = dt * aneg;
                float v = dA;
                v += __builtin_bit_cast(float, __builtin_amdgcn_update_dpp(0, __builtin_bit_cast(int, v), 0x111, 0xf, 0xf, true));
                v += __builtin_bit_cast(float, __builtin_amdgcn_update_dpp(0, __builtin_bit_cast(int, v), 0x112, 0xf, 0xf, true));
                v += __builtin_bit_cast(float, __builtin_amdgcn_update_dpp(0, __builtin_bit_cast(int, v), 0x114, 0xf, 0xf, true));
                v += __builtin_bit_cast(float, __builtin_amdgcn_update_dpp(0, __builtin_bit_cast(int, v), 0x118, 0xf, 0xf, true));
                v += __builtin_bit_cast(float, __builtin_amdgcn_update_dpp(0, __builtin_bit_cast(int, v), 0x142, 0xa, 0xf, false));
                const float tot = __builtin_bit_cast(float, __builtin_amdgcn_readlane(__builtin_bit_cast(int, v), 31));
                const float cum = dir ? (tot - v + dA) : v;
                if (hl == 0) { wsf[c31] = cum; wsf[32 + c31] = dt; wsf[64 + c31] = __expf(tot - cum) * dt; wsf[96 + c31] = __expf(cum); }
            }
            asm volatile("s_waitcnt lgkmcnt(0)" ::: "memory"); __builtin_amdgcn_s_barrier(); asm volatile("" ::: "memory");
            if (step + 2 < 136) SC_PF(pfO, step + 2); if (step + 1 < 136) dtraw = SC_DTLOAD(step + 1);
#pragma unroll
            for (int T = 0; T < 2; ++T) {
                const int tok = F.tid >> 4, h4 = (F.tid >> 2) & 3, q4 = F.tid & 3, chunk = T ? cbk : cf;
                const int other = T == 0 ? (chunk < 8 ? 7 - chunk : 143 - chunk) : chunk;
                if (PH == 0 && step > other) oldy[T] = *(const u32x4*)(Y + (size_t)(b * SROW + chunk * 32 + tok) * DIN + g * 256 + ph * 128 + h4 * 32 + q4 * 8);
            }
            if (PH < 3) {
                const LAS unsigned char* Bs = F.lds + dir * SC_TILE; const LAS unsigned char* Cs = Bs + 32 * SC_RS; const LAS unsigned char* xs = Bs + 64 * SC_RS;
                f32x16 gt;
#pragma unroll
                for (int e = 0; e < 16; ++e) gt[e] = 0.f;
#pragma unroll
                for (int s = 0; s < 8; ++s) { const bf16x8 a = *(const LAS bf16x8*)(F.lds + offRow + 32 * s), bb = *(const LAS bf16x8*)(F.lds + offRow + 32 * SC_RS + 32 * s); gt = MFMA32(a, bb, gt); }
                const float cum_i = wsf[c31];
                bf16x8 mk[2];
                {
                    float mv[16];
#pragma unroll
                    for (int q = 0; q < 4; ++q) { const f32x4 cj = *(const LAS f32x4*)(wsf + 8 * q + 4 * hl), dj = *(const LAS f32x4*)(wsf + 32 + 8 * q + 4 * hl);
#pragma unroll
                        for (int z = 0; z < 4; ++z) { const int jj = 8 * q + 4 * hl + z; const bool ok = dir ? (jj >= c31) : (jj <= c31);
                            float val = gt[4 * q + z] * __expf(ok ? (cum_i - cj[z]) : -INFINITY) * dj[z]; if (jj == c31) val += Dk; mv[4 * q + z] = val; } }
#pragma unroll
                    for (int s2 = 0; s2 < 2; ++s2) { u32x4 w; w.x = cvtpk(mv[8 * s2], mv[8 * s2 + 1]); w.y = cvtpk(mv[8 * s2 + 2], mv[8 * s2 + 3]); w.z = cvtpk(mv[8 * s2 + 4], mv[8 * s2 + 5]); w.w = cvtpk(mv[8 * s2 + 6], mv[8 * s2 + 7]); mk[s2] = __builtin_bit_cast(bf16x8, w); }
                }
                f32x16 ya;
#pragma unroll
                for (int e = 0; e < 16; ++e) ya[e] = 0.f;
#pragma unroll
                for (int t = 0; t < 4; ++t)
#pragma unroll
                    for (int s2 = 0; s2 < 2; ++s2) {
                        const LAS unsigned char* cp = F.lds + offC4 + 64 * t + 32 * s2;
                        const u32x2 c0 = *(const LAS u32x2*)cp, c1 = *(const LAS u32x2*)(cp + 16);
                        const bf16x8 ca = __builtin_bit_cast(bf16x8, (u32x4){c0.x, c0.y, c1.x, c1.y});
                        u32x4 w; w.x = cvtpk(ST[t][8 * s2], ST[t][8 * s2 + 1]); w.y = cvtpk(ST[t][8 * s2 + 2], ST[t][8 * s2 + 3]); w.z = cvtpk(ST[t][8 * s2 + 4], ST[t][8 * s2 + 5]); w.w = cvtpk(ST[t][8 * s2 + 6], ST[t][8 * s2 + 7]);
                        ya = MFMA32(ca, __builtin_bit_cast(bf16x8, w), ya);
                    }
#pragma unroll
                for (int q = 0; q < 4; ++q) { const f32x4 ec = *(const LAS f32x4*)(wsf + 96 + 8 * q + 4 * hl); ya[4 * q] *= ec.x; ya[4 * q + 1] *= ec.y; ya[4 * q + 2] *= ec.z; ya[4 * q + 3] *= ec.w; }
#pragma unroll
                for (int s2 = 0; s2 < 2; ++s2) {
                    const LAS unsigned char* xp = F.lds + offTrX + (16 * s2) * SC_RS + hl * (4 * SC_RS);
                    const s16x4 lo = vtr(xp), hi = vtr(xp + 8 * SC_RS);
                    ya = MFMA32(mk[s2], ((bf16x8){lo[0], lo[1], lo[2], lo[3], hi[0], hi[1], hi[2], hi[3]}), ya);
                }
                {
                    const float etot = dir ? wsf[96] : wsf[96 + 31];
#pragma unroll
                    for (int t = 0; t < 4; ++t)
#pragma unroll
                        for (int e = 0; e < 16; ++e) ST[t][e] *= etot;
#pragma unroll
                    for (int s2 = 0; s2 < 2; ++s2) {
                        const LAS unsigned char* xp = F.lds + offTrX + (16 * s2) * SC_RS + hl * (8 * SC_RS);
                        const s16x4 lo = vtr(xp), hi = vtr(xp + 4 * SC_RS);
                        const f32x4 w0 = *(const LAS f32x4*)(wsf + 64 + 16 * s2 + 8 * hl), w1 = *(const LAS f32x4*)(wsf + 64 + 16 * s2 + 8 * hl + 4);
                        u32x4 xw; xw.x = cvtpk(bf1((bf16_t)lo[0]) * w0.x, bf1((bf16_t)lo[1]) * w0.y); xw.y = cvtpk(bf1((bf16_t)lo[2]) * w0.z, bf1((bf16_t)lo[3]) * w0.w);
                        xw.z = cvtpk(bf1((bf16_t)hi[0]) * w1.x, bf1((bf16_t)hi[1]) * w1.y); xw.w = cvtpk(bf1((bf16_t)hi[2]) * w1.z, bf1((bf16_t)hi[3]) * w1.w);
                        const bf16x8 xb8 = __builtin_bit_cast(bf16x8, xw);
#pragma unroll
                        for (int t = 0; t < 4; ++t) {
                            const LAS unsigned char* bp = F.lds + offTrB + (16 * s2) * SC_RS + hl * (8 * SC_RS) + 64 * t;
                            const s16x4 blo = vtr(bp), bhi = vtr(bp + 4 * SC_RS);
                            ST[t] = MFMA32(((bf16x8){blo[0], blo[1], blo[2], blo[3], bhi[0], bhi[1], bhi[2], bhi[3]}), xb8, ST[t]);
                        }
                    }
                }
                LAS bf16_t* ys = (LAS bf16_t*)(F.lds + SC_YS + dir * 8192) + ysoff;
#pragma unroll
                for (int e = 0; e < 16; e += 2) { const unsigned w = cvtpk(ya[e], ya[e + 1]); ys[((e & 3) + 8 * (e >> 2)) * 128] = (bf16_t)w; ys[((e & 3) + 1 + 8 * (e >> 2)) * 128] = (bf16_t)(w >> 16); }
            }
                  }
        }
        VM_WAIT(); __syncthreads();
        SC_WRITEOUT(135);
#undef SC_PF
#undef SC_DTLOAD
#undef SC_WRITEOUT
        __syncthreads();
    }
}

__device__ __forceinline__ void attn_phase(Frame& F, const Args& A, int ja, bool need_ctx, int nwg) {
    phase_enter(F);
    const bf16_t* Q = (const bf16_t*)(F.ws + WS_BIG); bf16_t* O = (bf16_t*)F.out;     const bf16_t* Kb = (const bf16_t*)(F.ws + WS_BIG + BIG_K); const bf16_t* Vb = (const bf16_t*)(F.ws + WS_BIG + BIG_V);
    LAS unsigned char* Kl = F.lds; LAS unsigned char* Vl = F.lds + 9216;
    const int nunits = 2048 + (need_ctx ? 128 : 0);
    const int lane = F.lane, r = F.wave >> 1, rh = F.wave & 1, c31 = lane & 31, hl = lane >> 5;
    const int prow = F.tid >> 3, ppc = F.tid & 7;
    const int trq = (lane & 15) >> 2, trp = lane & 3, trb = (lane >> 4) & 1;
    for (int unit = blockIdx.x; unit < nunits; unit += nwg) {
        int b, g, nblk; bool cq;
        if (unit < 2048) { b = unit >> 7; nblk = (unit >> 2) & 31; g = unit & 3; cq = false; } else { const int u2 = unit - 2048; b = u2 >> 3; nblk = (u2 >> 2) & 1; g = u2 & 3; cq = true; }
        const int qrow0 = b * SROW + (cq ? 128 * nblk : NCTX + 128 * nblk);
        const int start = 128 * nblk;
        bf16x8 qf[2][4];
#pragma unroll
        for (int qb = 0; qb < 2; ++qb)
#pragma unroll
            for (int s = 0; s < 4; ++s) qf[qb][s] = *(const bf16x8*)(Q + (size_t)(qrow0 + 64 * rh + 32 * qb + c31) * QW + g * 256 + r * 64 + 16 * s + 8 * hl);
        const float sink = A.attn_sink[ja * 16 + g * 4 + r] * 1.4426950408889634f;
        float mrun[2] = {sink, sink}, lrun[2] = {1.f, 1.f};
        f32x16 ot[2][2];
#pragma unroll
        for (int db = 0; db < 2; ++db)
#pragma unroll
            for (int qb = 0; qb < 2; ++qb)
#pragma unroll
                for (int e = 0; e < 16; ++e) ot[db][qb][e] = 0.f;
        const int tt_lo = cq ? 0 : (nblk == 0 ? 2 : 0), tt_hi = cq ? 0 : (nblk == 31 ? 4 : 6);
        const int ntile = 4 + (tt_hi - tt_lo);
#define TILE_ROW0(t) ((t) < 4 ? b * SROW + 64 * (t) : b * SROW + NCTX + start - 128 + 64 * (tt_lo + (t) - 4))
        u32x4 kreg, vreg;
        { const int r0 = TILE_ROW0(0); kreg = *(const u32x4*)(Kb + (size_t)(r0 + prow) * KVW + g * 64 + ppc * 8); vreg = *(const u32x4*)(Vb + (size_t)(r0 + prow) * KVW + g * 64 + ppc * 8); }
        for (int t = 0; t < ntile; ++t) {
            __syncthreads();
            *(LAS u32x4*)(Kl + prow * 144 + ppc * 16) = kreg; *(LAS u32x4*)(Vl + prow * 144 + ppc * 16) = vreg;
            __syncthreads();
            if (t + 1 < ntile) { const int r0 = TILE_ROW0(t + 1); kreg = *(const u32x4*)(Kb + (size_t)(r0 + prow) * KVW + g * 64 + ppc * 8); vreg = *(const u32x4*)(Vb + (size_t)(r0 + prow) * KVW + g * 64 + ppc * 8); }
            const int dk0 = (t >= 4) ? (-128 + 64 * (tt_lo + t - 4)) - 64 * rh : 0;
            const bool tile_empty = (t >= 4) && (dk0 <= -192 || dk0 >= 192);
            const bool tile_mask = (t >= 4) && !tile_empty && (dk0 < -65 || dk0 > 65);
            if (!tile_empty) {
            f32x16 st[2][2];
#pragma unroll
            for (int kb = 0; kb < 2; ++kb) {
#pragma unroll
                for (int qb = 0; qb < 2; ++qb)
#pragma unroll
                    for (int e = 0; e < 16; ++e) st[kb][qb][e] = 0.f;
#pragma unroll
                for (int s = 0; s < 4; ++s) { const bf16x8 a = *(const LAS bf16x8*)(Kl + (32 * kb + c31) * 144 + (16 * s + 8 * hl) * 2);
                    st[kb][0] = MFMA32(a, qf[0][s], st[kb][0]); st[kb][1] = MFMA32(a, qf[1][s], st[kb][1]); }
            }
            if (tile_mask) { const int kpos0 = start - 128 + 64 * (tt_lo + t - 4);
#pragma unroll
                for (int kb = 0; kb < 2; ++kb)
#pragma unroll
                    for (int qb = 0; qb < 2; ++qb) { const int qpos = start + 64 * rh + 32 * qb + c31;
#pragma unroll
                        for (int e = 0; e < 16; ++e) { const int d = qpos - (kpos0 + 32 * kb + crow(e, hl)); if (d > 128 || d < -128) st[kb][qb][e] = -INFINITY; } }
            }
#pragma unroll
            for (int qb = 0; qb < 2; ++qb) {
                float mx = st[0][qb][0];
#pragma unroll
                for (int kb = 0; kb < 2; ++kb)
#pragma unroll
                    for (int e = 0; e < 16; ++e) mx = fmaxf(mx, st[kb][qb][e]);
                mx = fmaxf(mx, shx(mx, 32, lane));
                const float mn = fmaxf(mrun[qb], mx);
                const bool grew = mn > mrun[qb];
                float rs = 0.f;
#pragma unroll
                for (int kb = 0; kb < 2; ++kb)
#pragma unroll
                    for (int e = 0; e < 16; ++e) { const float pv = __builtin_amdgcn_exp2f(st[kb][qb][e] - mn); st[kb][qb][e] = pv; rs += pv; }
                rs += shx(rs, 32, lane);
                if (__any(grew)) {
                    const float alpha = __builtin_amdgcn_exp2f(mrun[qb] - mn);
                    lrun[qb] = lrun[qb] * alpha + rs;
#pragma unroll
                    for (int db = 0; db < 2; ++db)
#pragma unroll
                        for (int e = 0; e < 16; ++e) ot[db][qb][e] *= alpha;
                } else lrun[qb] += rs;
                mrun[qb] = mn;
            }
#pragma unroll
            for (int kb = 0; kb < 2; ++kb)
#pragma unroll
                for (int s2 = 0; s2 < 2; ++s2) {
                    bf16x8 pk[2];
#pragma unroll
                    for (int qb = 0; qb < 2; ++qb) { u32x4 w; w.x = cvtpk(st[kb][qb][8 * s2 + 0], st[kb][qb][8 * s2 + 1]); w.y = cvtpk(st[kb][qb][8 * s2 + 2], st[kb][qb][8 * s2 + 3]);
                        w.z = cvtpk(st[kb][qb][8 * s2 + 4], st[kb][qb][8 * s2 + 5]); w.w = cvtpk(st[kb][qb][8 * s2 + 6], st[kb][qb][8 * s2 + 7]); pk[qb] = __builtin_bit_cast(bf16x8, w); }
#pragma unroll
                    for (int db = 0; db < 2; ++db) {
                        const LAS unsigned char* vp = Vl + (32 * kb + 16 * s2 + 4 * hl + trq) * 144 + (32 * db + 16 * trb + 4 * trp) * 2;
                        const s16x4 lo = vtr(vp), hi = vtr(vp + 8 * 144);
                        const bf16x8 va = (bf16x8){lo[0], lo[1], lo[2], lo[3], hi[0], hi[1], hi[2], hi[3]};
                        ot[db][0] = MFMA32(va, pk[0], ot[db][0]); ot[db][1] = MFMA32(va, pk[1], ot[db][1]);
                    }
                }
            }
        }
#undef TILE_ROW0
#pragma unroll
        for (int qb = 0; qb < 2; ++qb) { const float inv = 1.0f / lrun[qb]; bf16_t* op = O + (size_t)(qrow0 + 64 * rh + 32 * qb + c31) * QW + g * 256 + r * 64;
#pragma unroll
            for (int db = 0; db < 2; ++db)
#pragma unroll
                for (int gq = 0; gq < 4; ++gq) { u32x2 w; w.x = cvtpk(ot[db][qb][4 * gq] * inv, ot[db][qb][4 * gq + 1] * inv); w.y = cvtpk(ot[db][qb][4 * gq + 2] * inv, ot[db][qb][4 * gq + 3] * inv);
                    *(u32x2*)(op + 32 * db + 8 * gq + 4 * hl) = w; } }
    }
    __syncthreads();
}


#ifndef PHMASK
#define PHMASK 0xFFFF
#endif
#define PHON(k) (((PHMASK) >> (k)) & 1)
#ifndef REPMASK
#define REPMASK 0x0
#endif
#define REP(k) (((REPMASK) >> (k)) & 1)
#ifndef MK_PER_PHASE
#define MK_PER_PHASE 0
#endif
#ifndef TIMER_LO
#define TIMER_LO 999
#define TIMER_HI 999
#endif
#define TIMER_ON (TIMER_LO < 999)
#define IN(k) (lo <= (k) && (k) < hi)
#define SEAM(k) do { if (IN(k) && IN((k) + 1)) { xcd_barrier(bar); } if (TIMER_ON) { const unsigned long long now_ = __builtin_amdgcn_s_memrealtime(); if ((k) >= TIMER_LO && (k) <= TIMER_HI) TM.acc += now_ - TM.prev; TM.prev = now_; } } while (0)
#define SITE_PTRS phase_enter(F); unsigned char* ws = F.ws; bf16_t* H = (bf16_t*)F.out; bf16_t* BIG = (bf16_t*)(ws + WS_BIG); const float* MODV = (const float*)(ws + WS_MODV); (void)H; (void)BIG; (void)MODV; \
        unsigned char* wss = ws + WS_W + (size_t)lp * W_SSD_STRIDE; unsigned char* wsa = ws + WS_W + W_ATT0 + (size_t)lp * W_ATT_STRIDE; (void)wss; (void)wsa;
struct Timer { unsigned long long prev, acc; };
template <int lp, int c> __device__ __forceinline__ void moe_chunk(Frame& F, const Args& A, const int lo, const int hi, const XcdBarrier& bar, LAS unsigned char* ring, Timer& TM) {
    constexpr int pb = 1 + lp * 20;
            const int pu = pb + 14 + 2 * c, pd = pu + 1;
            if (IN(pu) || IN(pd)) {
                SITE_PTRS
                MoeOrder mo;
                mo.pp[0] = 0;
#pragma unroll
                for (int e = 0; e < 8; ++e) { const int cn = __builtin_amdgcn_readfirstlane((int)__hip_atomic_load((unsigned*)(F.ctl + CW_CNT + (size_t)(lp * 8 + e) * 64), RLX_AGENT)); mo.cnt[e] = cn; mo.pp[e + 1] = mo.pp[e] + ((cn + 255) >> 8); }
                const int Ptot = mo.pp[8]; int nP = Ptot - c * MOE_CHUNK; nP = nP < 0 ? 0 : (nP > MOE_CHUNK ? MOE_CHUNK : nP);
                mo.cs = c * MOE_CHUNK; mo.rlist = (const int*)(ws + WS_RLIST);
                if (PHON(10) && IN(pu)) { mo.so.init(nP, 2 * DFFE / 256, F.G, (int)blockIdx.x); mo.GATHER_A = true; mo.bstride = (size_t)2 * DFFE * 1024 * 2;
                    pg8::Gemm g{H, (const bf16_t*)(ws + WS_BIG + BIG_MW13), 1024, 1024}; EpiSwiglu E{BIG, DFFE}; pg8::gemm_phase<EpiSwiglu, MoeOrder, true, true>(ring, g, mo, E, F.wave0); }
                SEAM(pu);
                if (PHON(11) && IN(pd)) { mo.so.init(nP, 4, F.G, (int)blockIdx.x); mo.GATHER_A = false; mo.bstride = (size_t)1024 * DFFE * 2;
                    pg8::Gemm g{BIG, (const bf16_t*)(ws + WS_BIG + BIG_MW2), DFFE, DFFE}; EpiMoeDown E{mo, (bf16_t*)(ws + WS_Y), (const float*)(ws + WS_GATE)}; pg8::gemm_phase<EpiMoeDown, MoeOrder, true, false>(ring, g, mo, E, F.wave0); }
            }
            SEAM(pd);
        }
template <int lp> __device__ __forceinline__ void layer_pair(Frame& F, const Args& A, const int lo, const int hi, const XcdBarrier& bar, LAS unsigned char* ring, Timer& TM) {
        const int pb = 1 + lp * 20, i0 = 2 * lp, i1 = 2 * lp + 1;
        if (PHON(1) && IN(pb + 0)) norm_phase(F, A, i0, 0, lp == 0 ? 1 : 2);
        SEAM(pb + 0);
        if (PHON(2) && IN(pb + 1)) { SITE_PTRS pg8::Gemm g{H, (const bf16_t*)(wss + W_WIN), 1024, 1024}; pg8::StaticOrder S; S.init(NPAN, NXBC / 256, F.G, (int)blockIdx.x);
            EpiXbc E{BIG, (float*)(ws + WS_DT), (bf16_t*)(ws + WS_HALO)}; pg8::gemm_phase<EpiXbc, pg8::StaticOrder, true, false>(ring, g, S, E, F.wave0); }
        SEAM(pb + 1);
        if (PHON(3) && IN(pb + 2)) conv_phase(F, A, lp);
        SEAM(pb + 2);
        if (PHON(3) && IN(pb + 3)) scan_phase<0>(F, A, lp);
        SEAM(pb + 3);
        if (PHON(4) && IN(pb + 4)) { SITE_PTRS pg8::Gemm g{H, (const bf16_t*)(wss + W_WZ), 1024, 1024}; pg8::StaticOrder S; S.init(NPAN, DIN / 256, F.G, (int)blockIdx.x);
            EpiGate E{(const bf16_t*)(ws + WS_Y), BIG, A.ssd_norm_w + (size_t)lp * DIN, (LAS float*)(F.lds + PSCR_OFF)}; pg8::gemm_phase<EpiGate, pg8::StaticOrder, true, false>(ring, g, S, E, F.wave0); }
        SEAM(pb + 4);
        if (PHON(5) && IN(pb + 5)) { SITE_PTRS pg8::Gemm g{BIG, (const bf16_t*)(wss + W_WOUT), DIN, DIN}; pg8::StaticOrder S; S.init(NPAN, 4, F.G, (int)blockIdx.x);
            EpiResid E{(bf16_t*)(ws + WS_XR), MODV + (size_t)i0 * 17 * 6144, 2, nullptr, lp == 0 ? A.x : nullptr, lp == 0 ? A.ctx : nullptr};
            pg8::gemm_phase<EpiResid, pg8::StaticOrder, true, false>(ring, g, S, E, F.wave0); }
        SEAM(pb + 5);
        if (PHON(1) && IN(pb + 6)) norm_phase(F, A, i0, 1, 0);
        SEAM(pb + 6);
        if (PHON(6) && IN(pb + 7)) { SITE_PTRS pg8::Gemm g{H, (const bf16_t*)(wss + W_WUP), 1024, 1024}; pg8::StaticOrder S; S.init(NPAN, 2 * DFF / 256, F.G, (int)blockIdx.x);
            EpiSwiglu E{BIG, DFF}; pg8::gemm_phase<EpiSwiglu, pg8::StaticOrder, true, false>(ring, g, S, E, F.wave0); }
        SEAM(pb + 7);
        if (PHON(5) && IN(pb + 8)) { SITE_PTRS pg8::Gemm g{BIG, (const bf16_t*)(wss + W_WDN), DFF, DFF}; pg8::StaticOrder S; S.init(NPAN, 4, F.G, (int)blockIdx.x);
            EpiResid E{(bf16_t*)(ws + WS_XR), MODV + (size_t)i0 * 17 * 6144, 5, nullptr, nullptr, nullptr};
            pg8::gemm_phase<EpiResid, pg8::StaticOrder, true, false>(ring, g, S, E, F.wave0); }
        SEAM(pb + 8);
        if (PHON(1) && IN(pb + 9)) norm_phase(F, A, i1, 0, 0);
        SEAM(pb + 9);
        if (PHON(7) && IN(pb + 10)) { SITE_PTRS pg8::Gemm g{H, (const bf16_t*)(wsa + W_WQKV), 1024, 1024}; pg8::StaticOrder S; S.init(NPAN, NQKV / 256, F.G, (int)blockIdx.x);
            LAS float* qt = (LAS float*)(F.lds + PSCR_OFF);
            { const float* rp = (const float*)(ws + WS_ROPE); const float* bq = A.attn_b_qkv + (size_t)lp * NQKV; for (int idx = F.tid; idx < 3584; idx += 512) qt[idx] = idx < 2048 ? rp[idx] : bq[idx - 2048]; }
            __syncthreads();
            EpiQkv E{BIG, (bf16_t*)(ws + WS_BIG + BIG_K), (bf16_t*)(ws + WS_BIG + BIG_V), qt};
            pg8::gemm_phase<EpiQkv, pg8::StaticOrder, true, false>(ring, g, S, E, F.wave0); }
        SEAM(pb + 10);
        if (PHON(8) && IN(pb + 11)) { const int nconv = F.G >= 9996 ? 48 : 0;
            if ((int)blockIdx.x < F.G - nconv) attn_phase(F, A, lp, lp == 0, F.G - nconv); else moe_convert(F, A, lp, F.G - nconv, nconv); }
        SEAM(pb + 11);
        if (PHON(5) && IN(pb + 12)) { SITE_PTRS pg8::Gemm g{H, (const bf16_t*)(wsa + W_WO), 1024, 1024};
            EpiResid E{(bf16_t*)(ws + WS_XR), MODV + (size_t)i1 * 17 * 6144, 2, A.attn_b_o + (size_t)lp * 1024, nullptr, nullptr};
            if (lp == 1) { pg8::LatentOrder S; S.init(NPAN - NB, 4, F.G, (int)blockIdx.x); pg8::gemm_phase<EpiResid, pg8::LatentOrder, true, false>(ring, g, S, E, F.wave0); }
            else { pg8::StaticOrder S; S.init(NPAN, 4, F.G, (int)blockIdx.x); pg8::gemm_phase<EpiResid, pg8::StaticOrder, true, false>(ring, g, S, E, F.wave0); } }
        SEAM(pb + 12);
        if (PHON(9) && IN(pb + 13)) { norm_phase(F, A, i1, 1, 4 | (lp == 1 ? 16 : 0)); if (F.G < 9996) { __syncthreads(); moe_convert(F, A, lp, 0, F.G); } }
        SEAM(pb + 13);
    moe_chunk<lp, 0>(F, A, lo, hi, bar, ring, TM); moe_chunk<lp, 1>(F, A, lo, hi, bar, ring, TM); moe_chunk<lp, 2>(F, A, lo, hi, bar, ring, TM);
}
constexpr int N_PHASES = 42;
__global__ void __launch_bounds__(NWAVES * 64, 2) fwd_kernel(Args A) {
    extern __shared__ __attribute__((aligned(16))) unsigned char lds_raw[];
    Frame F;
    F.lds = (LAS unsigned char*)lds_raw;
    F.tid = threadIdx.x; F.lane = F.tid & 63; F.wave = __builtin_amdgcn_readfirstlane(F.tid >> 6); F.wave0 = F.wave; F.G = gridDim.x;
    F.ws0 = A.ws; F.out0 = A.out; F.ws = A.ws; F.ctl = (gu32*)(A.ws + WS_CTL); F.out = A.out;
    volatile LAS unsigned* MISC = (volatile LAS unsigned*)(F.lds + MISC_OFF);
    for (int u = F.tid; u < (LDS_BYTES - LDSCTL_OFF) / 4; u += NWAVES * 64) ((LAS unsigned*)(F.lds + LDSCTL_OFF))[u] = 0u;
    __syncthreads();
    const int lo = A.ph_lo, hi = A.ph_hi;
    XcdBarrier bar; bar.bar = (unsigned*)(F.ctl + CW_BAR); bar.x = 0; bar.st = MISC + 8; bar.wave0 = F.wave0;
    if (hi - lo > 1) bar = xcd_barrier_post((unsigned*)(F.ctl + CW_BAR), MISC + 8, F.wave0);
    LAS unsigned char* ring = F.lds;

    Timer TM; TM.prev = TIMER_ON ? __builtin_amdgcn_s_memrealtime() : 0ull; TM.acc = 0ull;
    if (PHON(0) && IN(0)) { p0_prologue(F, A); }
    SEAM(0);
    layer_pair<0>(F, A, lo, hi, bar, ring, TM);
    layer_pair<1>(F, A, lo, hi, bar, ring, TM);
    if (PHON(1) && IN(41)) {
        norm_phase(F, A, 4, 0, 2 | 8);
        if (xb_ld((unsigned*)(F.ctl + CW_BAR) + XB_TMO) != 0u) {
            const float qn = __builtin_nanf("");
            for (size_t idx = (size_t)blockIdx.x * 512 + F.tid; idx < (size_t)NB * SEQ * DM / 4; idx += (size_t)F.G * 512) ((f32x4*)A.out)[idx] = (f32x4){qn, qn, qn, qn};
        }
    }
    if (TIMER_ON) { const unsigned long long now_ = __builtin_amdgcn_s_memrealtime(); if (41 >= TIMER_LO && 41 <= TIMER_HI) TM.acc += now_ - TM.prev;
        if (blockIdx.x == 0) { const unsigned long long tgt = now_ + TM.acc; while (__builtin_amdgcn_s_memrealtime() < tgt) __builtin_amdgcn_s_sleep(8); } }
#undef IN
#undef SEAM
}

extern "C" void kernel_launch(void* const* d_in, const int* in_sizes, int n_in, void* d_out, int out_size, void* d_ws, size_t ws_size, hipStream_t stream) {
    static int grid = 0;
    if (grid == 0) {
        if (n_in != 29 || in_sizes[0] != NB * SEQ * DM || out_size != NB * SEQ * DM || ws_size < WS_END) {
            fprintf(stderr, "kernel_launch: unexpected problem: n_in %d, in0 %d, out %d, ws %zu (need %zu); nothing launched\n", n_in, n_in > 0 ? in_sizes[0] : -1, out_size, ws_size, (size_t)WS_END); grid = -1; return; }
        int dev = 0, cus = 0, per_cu = 0;
        if (hipGetDevice(&dev) != hipSuccess || hipDeviceGetAttribute(&cus, hipDeviceAttributeMultiprocessorCount, dev) != hipSuccess) { fprintf(stderr, "kernel_launch: device query failed\n"); grid = -1; return; }
        if (hipFuncSetAttribute((const void*)fwd_kernel, hipFuncAttributeMaxDynamicSharedMemorySize, LDS_BYTES) != hipSuccess) { fprintf(stderr, "kernel_launch: hipFuncSetAttribute failed\n"); grid = -1; return; }
        if (hipOccupancyMaxActiveBlocksPerMultiprocessor(&per_cu, (const void*)fwd_kernel, NWAVES * 64, LDS_BYTES) != hipSuccess || per_cu < 1)
            fprintf(stderr, "kernel_launch: note: occupancy query reports %d workgroups per CU\n", per_cu);
        (void)hipGetLastError();
        grid = cus;
    }
    if (grid < 0) return;
    if (hipMemsetAsync((char*)d_ws + WS_CTL, 0, CTL_ZERO_BYTES, stream) != hipSuccess) { fprintf(stderr, "kernel_launch: memset failed\n"); return; }
    Args a{};
    const float** ap = (const float**)&a;
    for (int i = 0; i < 29; ++i) ap[i] = (const float*)d_in[i];
    a.out = (float*)d_out; a.ws = (unsigned char*)d_ws;
#if MK_PER_PHASE
    for (int k = 0; k < N_PHASES; ++k) { a.ph_lo = k; a.ph_hi = k + 1; hipLaunchKernelGGL(fwd_kernel, dim3(grid), dim3(NWAVES * 64), LDS_BYTES, stream, a); }
#else
    a.ph_lo = 0; a.ph_hi = N_PHASES;
    hipLaunchKernelGGL(fwd_kernel, dim3(grid), dim3(NWAVES * 64), LDS_BYTES, stream, a);
#endif
    const hipError_t le = hipPeekAtLastError();
    if (le != hipSuccess) fprintf(stderr, "kernel_launch: launch failed: %s\n", hipGetErrorName(le));
}
```

```cpp
#include <hip/hip_runtime.h>
#include <cstdio>
#include <cstdint>

#define LAS __attribute__((address_space(3)))
#define GAS __attribute__((address_space(1)))
typedef unsigned short bf16_t;
typedef short bf16x8 __attribute__((ext_vector_type(8)));
typedef short s16x4 __attribute__((ext_vector_type(4)));
typedef float f32x4 __attribute__((ext_vector_type(4)));
typedef float f32x2 __attribute__((ext_vector_type(2)));
typedef float f32x16 __attribute__((ext_vector_type(16)));
typedef unsigned u32x4 __attribute__((ext_vector_type(4)));
typedef unsigned u32x2 __attribute__((ext_vector_type(2)));
typedef GAS unsigned gu32;

namespace pg8 {
constexpr int BM = 256, BK = 64, HALF = 128, HTB = HALF * BK * 2  , STAGE_BYTES = 8 * HTB, NXCD = 8, WGM = 8;

__host__ __device__ __forceinline__ int lds_byte(int r, int c) { const int st = (r >> 4) * 2 + (c >> 5), rr = r & 15, cc = c & 31, ob = rr * 64 + cc * 2; return st * 1024 + (ob ^ (((ob >> 9) & 1) << 5)); }
__host__ __device__ __forceinline__ void stage_rc(int b, int& R, int& C) { const int st = b / 1024, sb = b % 1024, swz = sb ^ (((sb >> 9) & 1) << 5); R = (st >> 1) * 16 + swz / 64; C = (st & 1) * 32 + (swz % 64) / 2; }
__host__ __device__ __forceinline__ int perm32(int rho) { const int n = rho >> 4, i = rho & 15; return 8 * (i >> 2) + 4 * n + (i & 3); }

struct Unit { int pm, pn; };
struct Gemm { const bf16_t* A; const bf16_t* Bt; int lda, K; };

struct StaticOrder {
    int nM, nN, nwg, G, c;
    __device__ void init(int nM_, int nN_, int G_, int c_) { nM = nM_; nN = nN_; nwg = nM * nN; G = G_; c = c_; }
    __device__ bool next(int i, Unit& u) const {
        const long L = (long)i * G + c; if (L >= nwg) return false;
        int wgid = (int)L; { const int q = nwg / NXCD, r = nwg % NXCD, xcd = wgid % NXCD, off = wgid / NXCD; wgid = (xcd < r ? xcd * (q + 1) : r * (q + 1) + (xcd - r) * q) + off; }
        const int nig = WGM * nN, gid = wgid / nig, fm = gid * WGM, gsz = (nM - fm) < WGM ? (nM - fm) : WGM;
        u.pm = fm + ((wgid % nig) % gsz); u.pn = (wgid % nig) / gsz; return true;
    }
    __device__ __forceinline__ const char* a_base(const Gemm& g, const Unit& u) const { return (const char*)g.A + (size_t)u.pm * (size_t)(BM * 2) * g.lda; }
    __device__ __forceinline__ const char* b_base(const Gemm& g, const Unit& u) const { return (const char*)g.Bt + (size_t)u.pn * (size_t)(BM * 2) * g.K; }
    __device__ __forceinline__ unsigned row_off(const Gemm& g, const Unit&, int r) const { return (unsigned)r * (unsigned)g.lda * 2u; }
};

struct LatentOrder : StaticOrder {
    __device__ bool next(int i, Unit& u) const { if (!StaticOrder::next(i, u)) return false; u.pm = u.pm + (u.pm >> 4) + 1; return true; }
};

struct PanelOrder : StaticOrder {
    __device__ bool next(int i, Unit& u) const { const int x = c & 7, s = c >> 3, per = G >> 5; const int panel = (i * 8 + x) * per + (s >> 2);
        if (panel >= nM) return false; u.pm = panel; u.pn = s & 3; return true; }
};

__device__ __forceinline__ unsigned cvt_pk_bf16(float lo, float hi) { unsigned r; asm volatile("v_cvt_pk_bf16_f32 %0, %1, %2" : "=v"(r) : "v"(lo), "v"(hi)); return r; }

template <class Epi, class Sched, bool ALIGN_EPI, bool GATHER>
__device__ __forceinline__ void gemm_phase(LAS unsigned char* lds, const Gemm g, const Sched& S, const Epi& E, const int wave0, const unsigned delay_ticks = 0u) {
    if (delay_ticks) { const unsigned long long t0_ = __builtin_amdgcn_s_memrealtime(); while (__builtin_amdgcn_s_memrealtime() - t0_ < (unsigned long long)delay_ticks) __builtin_amdgcn_s_sleep(16); }
    int tid_ = wave0 * 64 + (int)__builtin_amdgcn_mbcnt_hi(~0u, __builtin_amdgcn_mbcnt_lo(~0u, 0u)); asm volatile("" : "+v"(tid_));
    const int tid = tid_, wid = __builtin_amdgcn_readfirstlane(tid >> 6), lane = tid & 63, wr = wid >> 2, wc = wid & 3, fr = lane & 15, fq = lane >> 4;
    const int K = g.K, nt = K / BK;
    unsigned voffB[2];
#pragma unroll
    for (int i = 0; i < 2; ++i) { int R, C; stage_rc(tid * 16 + i * 8192, R, C); const int Rb = Epi::PERM ? ((R & ~31) + perm32(R & 31)) : R; voffB[i] = (unsigned)(Rb * K + C) * 2u; }
    const size_t kstep = (size_t)(BK * 2);
    const size_t hstepB = (size_t)HALF * K * 2;
    const unsigned ldsw = (unsigned)wid * 1024u;
    const int aoff = lds_byte(wr * 64 + fr, fq * 8), boff = lds_byte(wc * 32 + fr, fq * 8);
#define PG8_SA(b, h) (((b) * 2 + (h)) * HTB)
#define PG8_SB(b, h) ((4 + (b) * 2 + (h)) * HTB)
#define PG8_STAGE(bufoff, gbase, voff) do { _Pragma("unroll") for (int _i = 0; _i < 2; ++_i) \
        __builtin_amdgcn_global_load_lds((const unsigned*)((const char*)(gbase) + (voff)[_i]), (LAS unsigned*)(lds + (bufoff) + ldsw + _i * 8192), 16, 0, 0); } while (0)
#define PG8_LDA(dst, b, h) do { _Pragma("unroll") for (int m = 0; m < 4; ++m) _Pragma("unroll") for (int k = 0; k < 2; ++k) dst[m][k] = *(const LAS bf16x8*)(lds + PG8_SA(b, h) + aoff + m * 2048 + k * 1024); } while (0)
#define PG8_LDB(dst, b, h) do { _Pragma("unroll") for (int n = 0; n < 2; ++n) _Pragma("unroll") for (int k = 0; k < 2; ++k) dst[n][k] = *(const LAS bf16x8*)(lds + PG8_SB(b, h) + boff + n * 2048 + k * 1024); } while (0)
#define PG8_MMA(ai, bj, At, Bt) do { __builtin_amdgcn_s_setprio(1); _Pragma("unroll") for (int m = 0; m < 4; ++m) _Pragma("unroll") for (int n = 0; n < 2; ++n) _Pragma("unroll") for (int k = 0; k < 2; ++k) \
        acc[ai][bj][m][n] = __builtin_amdgcn_mfma_f32_16x16x32_bf16(Bt[n][k], At[m][k], acc[ai][bj][m][n], 0, 0, 0); __builtin_amdgcn_s_setprio(0); } while (0)
#define PG8_WAIT_V(n) asm volatile("s_waitcnt vmcnt(" #n ")" ::: "memory")
#define PG8_WAIT_L(n) asm volatile("s_waitcnt lgkmcnt(" #n ")" ::: "memory")
#define PG8_BAR __builtin_amdgcn_s_barrier()
#define PG8_SCHED __builtin_amdgcn_sched_barrier(0)
    Unit cur, nxt; int ui = 0;
    if (!S.next(0, cur)) return;
    f32x4 acc[2][2][4][2];
#pragma unroll
    for (int a = 0; a < 2; ++a)
#pragma unroll
        for (int b = 0; b < 2; ++b)
#pragma unroll
            for (int m = 0; m < 4; ++m)
#pragma unroll
                for (int n = 0; n < 2; ++n) acc[a][b][m][n] = (f32x4){0.f, 0.f, 0.f, 0.f};
    bf16x8 At[4][2], B0[2][2], B1[2][2];
    const char* cA = S.a_base(g, cur); const char* cB = S.b_base(g, cur);
    unsigned va[2][2], vn[2][2];
#pragma unroll
    for (int h = 0; h < 2; ++h)
#pragma unroll
        for (int i = 0; i < 2; ++i) { int R, C; stage_rc(tid * 16 + i * 8192, R, C); va[h][i] = S.row_off(g, cur, h * HALF + R) + (unsigned)C * 2u; vn[h][i] = va[h][i]; }
    PG8_STAGE(PG8_SB(0, 0), cB, voffB); PG8_STAGE(PG8_SB(0, 1), cB + hstepB, voffB); PG8_STAGE(PG8_SA(0, 0), cA, va[0]); PG8_STAGE(PG8_SA(0, 1), cA, va[1]);
    if (wr == 1) PG8_BAR;
    PG8_WAIT_V(2); PG8_BAR;
    PG8_STAGE(PG8_SB(1, 0), cB + kstep, voffB); PG8_STAGE(PG8_SA(1, 0), cA + kstep, va[0]); PG8_STAGE(PG8_SB(1, 1), cB + hstepB + kstep, voffB);
    PG8_WAIT_V(6); PG8_BAR;
    for (;;) {
        const bool has_next = S.next(ui + 1, nxt);
        const char* nA = has_next ? S.a_base(g, nxt) : cA; const char* nB = has_next ? S.b_base(g, nxt) : cB;
        if (GATHER) {
            if (has_next) {
#pragma unroll
                for (int h = 0; h < 2; ++h)
#pragma unroll
                    for (int i = 0; i < 2; ++i) { int R, C; stage_rc(tid * 16 + i * 8192, R, C); vn[h][i] = S.row_off(g, nxt, h * HALF + R) + (unsigned)C * 2u; }
            } else {
#pragma unroll
                for (int h = 0; h < 2; ++h)
#pragma unroll
                    for (int i = 0; i < 2; ++i) vn[h][i] = va[h][i];
            }
        }
        for (int t = 0; t < nt; t += 2) {
            const bool last = (t == nt - 2);
            const char* a1 = cA + (size_t)(t + 1) * kstep;
            const char* a2 = last ? nA : cA + (size_t)(t + 2) * kstep; const char* b2 = last ? nB : cB + (size_t)(t + 2) * kstep;
            const char* a3 = a2 + kstep; const char* b3 = b2 + kstep;
            unsigned v2[2][2];
#pragma unroll
            for (int h = 0; h < 2; ++h)
#pragma unroll
                for (int i = 0; i < 2; ++i) v2[h][i] = (GATHER && last) ? vn[h][i] : va[h][i];
            PG8_LDB(B0, 0, 0); PG8_LDB(B1, 0, 1); PG8_SCHED; PG8_LDA(At, 0, 0); PG8_STAGE(PG8_SA(1, 1), a1, va[1]);
            PG8_WAIT_V(8); PG8_WAIT_L(0); PG8_BAR; PG8_MMA(0, 0, At, B0); PG8_MMA(0, 1, At, B1); PG8_BAR; PG8_SCHED;
            PG8_LDA(At, 0, 1); PG8_STAGE(PG8_SB(0, 0), b2, voffB); PG8_STAGE(PG8_SB(0, 1), b2 + hstepB, voffB); PG8_STAGE(PG8_SA(0, 0), a2, v2[0]);
            PG8_WAIT_V(8); PG8_WAIT_L(0); PG8_BAR; PG8_MMA(1, 0, At, B0); PG8_MMA(1, 1, At, B1); PG8_BAR; PG8_SCHED;
            PG8_LDB(B0, 1, 0); PG8_LDB(B1, 1, 1); PG8_SCHED; PG8_LDA(At, 1, 0); PG8_STAGE(PG8_SA(0, 1), a2, v2[1]);
            PG8_WAIT_V(8); PG8_WAIT_L(0); PG8_BAR; PG8_MMA(0, 0, At, B0); PG8_MMA(0, 1, At, B1); PG8_BAR; PG8_SCHED;
            PG8_LDA(At, 1, 1); PG8_STAGE(PG8_SB(1, 0), b3, voffB); PG8_STAGE(PG8_SB(1, 1), b3 + hstepB, voffB); PG8_STAGE(PG8_SA(1, 0), a3, v2[0]);
            PG8_WAIT_V(8); PG8_WAIT_L(0); PG8_BAR; PG8_MMA(1, 0, At, B0); PG8_MMA(1, 1, At, B1); PG8_BAR; PG8_SCHED;
        }
        if constexpr (ALIGN_EPI) { if (wr == 0) PG8_BAR; }
        { int l2 = (int)__builtin_amdgcn_mbcnt_hi(~0u, __builtin_amdgcn_mbcnt_lo(~0u, 0u)); asm volatile("" : "+v"(l2)); E(acc, cur, wr, wc, l2 & 15, l2 >> 4); }
        if (!has_next) break;
#pragma unroll
        for (int a = 0; a < 2; ++a)
#pragma unroll
            for (int b = 0; b < 2; ++b)
#pragma unroll
                for (int m = 0; m < 4; ++m)
#pragma unroll
                    for (int n = 0; n < 2; ++n) acc[a][b][m][n] = (f32x4){0.f, 0.f, 0.f, 0.f};
        cur = nxt; cA = nA; cB = nB; ++ui;
        if (GATHER) {
#pragma unroll
            for (int h = 0; h < 2; ++h)
#pragma unroll
                for (int i = 0; i < 2; ++i) va[h][i] = vn[h][i];
        }
        if constexpr (ALIGN_EPI) { if (wr == 1) PG8_BAR; }
    }
    PG8_WAIT_V(0);
    if constexpr (!ALIGN_EPI) { if (wr == 0) PG8_BAR; }
    PG8_BAR;
#undef PG8_SA
#undef PG8_SB
#undef PG8_STAGE
#undef PG8_LDA
#undef PG8_LDB
#undef PG8_MMA
#undef PG8_WAIT_V
#undef PG8_WAIT_L
#undef PG8_BAR
#undef PG8_SCHED
}
}

constexpr int DM = 1024, NB = 16, SEQ = 4096, NCTX = 256, SROW = SEQ + NCTX  , MROWS = NB * SROW  , NPAN = MROWS / 256  ;
constexpr int DIN = 2048, CONVCH = 4096, SSD_IN = 6208, NXBC = 4352  ;
constexpr int QW = 1024, KVW = 256, NQKV = 1536;
constexpr int DFF = 2816, NEXP = 8, DFFE = 3584;
constexpr float EPS = 1e-6f;
constexpr int MOE_CHUNK = 192;
constexpr int NWAVES = 8;

constexpr size_t MiB = 1u << 20;
constexpr size_t WS_CTL = 0, CTL_ZERO_BYTES = 1 * MiB;
constexpr size_t WS_MODV = 2 * MiB;
constexpr size_t WS_ROPE = 4 * MiB;
constexpr size_t WS_GATE = 5 * MiB;
constexpr size_t WS_RLIST = 6 * MiB;
constexpr size_t WS_W = 26 * MiB;
constexpr size_t W_SSD_STRIDE = 33 * MiB, W_WZ = 0, W_WIN = 4 * MiB, W_WOUT = 12 * MiB + MiB / 2, W_WUP = 16 * MiB + MiB / 2, W_WDN = 27 * MiB + MiB / 2;
constexpr size_t W_ATT0 = 66 * MiB, W_ATT_STRIDE = 5 * MiB, W_WQKV = 0, W_WO = 3 * MiB;
constexpr size_t WS_XR = 102 * MiB;
constexpr size_t WS_BIG = 238 * MiB;
constexpr size_t BIG_K = 136 * MiB, BIG_V = 170 * MiB, BIG_O = 204 * MiB, BIG_MW13 = 336 * MiB, BIG_MW2 = 448 * MiB;
static_assert((size_t)MOE_CHUNK * 256 * DFFE * 2 <= BIG_MW13 && BIG_O + 136 * MiB <= BIG_MW13 + 200 * MiB && BIG_MW2 + 56 * MiB <= 544 * MiB, "BIG region map");
constexpr size_t WS_Y = 782 * MiB;
constexpr size_t WS_DT = 1054 * MiB;
constexpr size_t WS_HALO = 1071 * MiB;
constexpr size_t WS_XCH = 1106 * MiB;
constexpr size_t WS_END = 1108 * MiB;
constexpr int CW_BAR = 4096;
constexpr int CW_CNT = 16384;
constexpr int CW_PAN = 32768;
static_assert((CW_PAN + 4 * 272 * 64) * 4 <= (int)CTL_ZERO_BYTES, "CTL words inside the memset region");

constexpr int RING_BYTES = 131072;
constexpr int PSCR_OFF = 131072;
constexpr int LDSCTL_OFF = 151552, MISC_OFF = LDSCTL_OFF + 320;
constexpr int LDS_BYTES = 155648;

#define RLX_AGENT __ATOMIC_RELAXED, __HIP_MEMORY_SCOPE_AGENT
#define LDS_WAIT() asm volatile("s_waitcnt lgkmcnt(0)" ::: "memory")
#define VM_WAIT() asm volatile("s_waitcnt vmcnt(0)" ::: "memory")
__device__ __forceinline__ unsigned f2bf(float f) { unsigned u = __builtin_bit_cast(unsigned, f); return (u + 0x7fffu + ((u >> 16) & 1u)) >> 16; }
__device__ __forceinline__ unsigned pk2(float lo, float hi) { return f2bf(lo) | (f2bf(hi) << 16); }
__device__ __forceinline__ float bf_lo(unsigned u) { return __builtin_bit_cast(float, u << 16); }
__device__ __forceinline__ float bf_hi(unsigned u) { return __builtin_bit_cast(float, u & 0xffff0000u); }
__device__ __forceinline__ float bf1(bf16_t h) { return __builtin_bit_cast(float, (unsigned)h << 16); }
__device__ __forceinline__ float siluf(float v) { return v * __builtin_amdgcn_rcpf(1.0f + __expf(-v)); }
__device__ __forceinline__ float shx(float v, int mask, int lane) { return __builtin_bit_cast(float, __builtin_amdgcn_ds_bpermute((lane ^ mask) << 2, __builtin_bit_cast(int, v))); }
__device__ __forceinline__ float wave_sum(float v, int lane) {
    (void)lane;
    v += __builtin_bit_cast(float, __builtin_amdgcn_update_dpp(0, __builtin_bit_cast(int, v), 0x111, 0xf, 0xf, true));
    v += __builtin_bit_cast(float, __builtin_amdgcn_update_dpp(0, __builtin_bit_cast(int, v), 0x112, 0xf, 0xf, true));
    v += __builtin_bit_cast(float, __builtin_amdgcn_update_dpp(0, __builtin_bit_cast(int, v), 0x114, 0xf, 0xf, true));
    v += __builtin_bit_cast(float, __builtin_amdgcn_update_dpp(0, __builtin_bit_cast(int, v), 0x118, 0xf, 0xf, true));
    v += __builtin_bit_cast(float, __builtin_amdgcn_update_dpp(0, __builtin_bit_cast(int, v), 0x142, 0xa, 0xf, false));
    v += __builtin_bit_cast(float, __builtin_amdgcn_update_dpp(0, __builtin_bit_cast(int, v), 0x143, 0xc, 0xf, false));
    return __builtin_bit_cast(float, __builtin_amdgcn_readlane(__builtin_bit_cast(int, v), 63));
}

__device__ __forceinline__ int lane_id() { return (int)__builtin_amdgcn_mbcnt_hi(~0u, __builtin_amdgcn_mbcnt_lo(~0u, 0u)); }
#define XB_TMO      128
#define XB_XCNT(j)  (256  + 64 * (j))
#define XB_XSUB(j)  (1280 + 64 * (j))
#define XB_XGEN(j)  (2304 + 64 * (j))
#define XB_TOP      3328
#define XB_TOPGEN   3392
#define XCD_BAR_WORDS 3456
#define XB_SPIN_CAP (1u << 18)

__device__ __forceinline__ unsigned xb_ld(unsigned* p)              { return __hip_atomic_load(p, __ATOMIC_RELAXED, __HIP_MEMORY_SCOPE_AGENT); }
__device__ __forceinline__ unsigned xb_add(unsigned* p, unsigned v) { return __hip_atomic_fetch_add(p, v, __ATOMIC_RELAXED, __HIP_MEMORY_SCOPE_AGENT); }
__device__ __forceinline__ unsigned xb_xcc_id() { return (unsigned)__builtin_amdgcn_s_getreg((3 << 11) | 20) & 0xFu; }
#define XB_SPIN(cond, bar) do { unsigned _sp = 0; while (cond) { __builtin_amdgcn_s_sleep(1); \
    if ((++_sp & 255u) == 0u) { if (xb_ld(&(bar)[XB_TMO])) break; if (_sp > XB_SPIN_CAP) { atomicAdd(&(bar)[XB_TMO], 1u); break; } } } } while (0)

struct XcdBarrier {
    unsigned* bar; unsigned x;
    volatile LAS unsigned* st;
    int wave0;
};
__device__ __forceinline__ XcdBarrier xcd_barrier_post(unsigned* bar, volatile LAS unsigned* st, int wave0) {
    XcdBarrier b; b.bar = bar; b.x = xb_xcc_id(); b.st = st; b.wave0 = wave0;
    if (wave0 == 0 && lane_id() == 0) (void)xb_add(&bar[XB_XCNT(b.x)], 1u);
    return b;
}
__device__ __forceinline__ void xcd_barrier_complete(unsigned* bar, unsigned x, unsigned& nloc, unsigned& nx) {
    const unsigned G = gridDim.x * gridDim.y * gridDim.z;
    unsigned sum, cnt, mine, sp = 0u;
    for (;;) {
        sum = 0u; cnt = 0u; mine = 0u;
#pragma unroll
        for (unsigned j = 0; j < 16; ++j) { const unsigned c = xb_ld(&bar[XB_XCNT(j)]); sum += c; cnt += (c > 0u) ? 1u : 0u; mine = (j == x) ? c : mine; }
        if (sum == G) break;
        __builtin_amdgcn_s_sleep(1);
        if ((++sp & 255u) == 0u) { if (xb_ld(&bar[XB_TMO])) break; if (sp > XB_SPIN_CAP) { atomicAdd(&bar[XB_TMO], 1u); break; } }
    }
    nloc = mine > 0u ? mine : 1u; nx = cnt > 0u ? cnt : 1u;
}
__device__ __forceinline__ void xcd_barrier(const XcdBarrier& b) {
    asm volatile("s_waitcnt vmcnt(0)" ::: "memory");
    __syncthreads();
    if (b.wave0 == 0 && lane_id() == 0) {
        unsigned* bar = b.bar;
        __builtin_amdgcn_s_waitcnt(0);
        unsigned nloc = b.st[0], nx = b.st[1];
        if (nloc == 0u) { xcd_barrier_complete(bar, b.x, nloc, nx); b.st[0] = nloc; b.st[1] = nx; }
        const unsigned old = xb_add(&bar[XB_XSUB(b.x)], 1u);
        const unsigned gen = old / nloc;
        if (old + 1u == (gen + 1u) * nloc) {
            __builtin_amdgcn_fence(__ATOMIC_RELEASE, "agent");
            asm volatile("s_waitcnt vmcnt(0)" ::: "memory");
            const unsigned og = xb_add(&bar[XB_TOP], 1u);
            const unsigned tg = og / nx;
            if (og + 1u == (tg + 1u) * nx) xb_add(&bar[XB_TOPGEN], 1u);
            else XB_SPIN(xb_ld(&bar[XB_TOPGEN]) == tg, bar);
            __builtin_amdgcn_fence(__ATOMIC_ACQUIRE, "agent");
            xb_add(&bar[XB_XGEN(b.x)], 1u);
            asm volatile("s_waitcnt vmcnt(0)" ::: "memory");
        } else {
            XB_SPIN(xb_ld(&bar[XB_XGEN(b.x)]) == gen, bar);
            __builtin_amdgcn_fence(__ATOMIC_ACQUIRE, "agent");
            asm volatile("s_waitcnt vmcnt(0)" ::: "memory");
        }
    }
    __syncthreads();
}

struct Args {
    const float *x, *c, *ctx, *c_ctx, *w_mod, *b_mod, *norm1_w, *norm2_w, *ssd_w_in, *ssd_conv_w, *ssd_conv_b, *ssd_dt_bias, *ssd_a_log, *ssd_d, *ssd_norm_w, *ssd_w_out,
                *attn_w_qkv, *attn_b_qkv, *attn_sink, *attn_w_o, *attn_b_o, *ffn_w1, *ffn_w3, *ffn_w2, *moe_router, *moe_w1, *moe_w3, *moe_w2, *final_norm_w;
    float* out; unsigned char* ws; int ph_lo, ph_hi;
};
struct Frame {
    LAS unsigned char* lds;
    int tid, lane, wave, G;
    unsigned char* ws; gu32* ctl; float* out;
    unsigned char* ws0; float* out0; int wave0;
};
__device__ __forceinline__ void phase_enter(Frame& F) { int l = lane_id(); asm volatile("" : "+v"(l)); F.lane = l; F.wave = F.wave0; F.tid = F.wave0 * 64 + l;
    unsigned char* w = F.ws0; float* o = F.out0; asm volatile("" : "+s"(w), "+s"(o)); F.ws = w; F.ctl = (gu32*)(w + WS_CTL); F.out = o; }
__device__ __forceinline__ void transpose_item(const float* W, int ldw, int col0, int ncb, int K, bf16_t* WT, int mode, int half, LAS float* scr, int item, int lane) {
    const int kb = item / ncb, nb = item - kb * ncb, k0 = 64 * kb, n0 = 64 * nb;
    const int lr = lane >> 4, lc = (lane & 15) * 4;
    f32x4 tv[16];
#pragma unroll
    for (int i = 0; i < 16; ++i) tv[i] = *(const GAS f32x4*)(W + (size_t)(k0 + 4 * i + lr) * ldw + col0 + n0 + lc);
#pragma unroll
    for (int i = 0; i < 16; ++i) { LAS float* d = scr + (4 * i + lr) * 65 + lc; d[0] = tv[i].x; d[1] = tv[i].y; d[2] = tv[i].z; d[3] = tv[i].w; }
    LDS_WAIT(); asm volatile("" ::: "memory");
    const int c = lane & 7;
#pragma unroll
    for (int j = 0; j < 8; ++j) { const int n = (lane >> 3) + 8 * j; const LAS float* s = scr + (8 * c) * 65 + n;
        u32x4 o; o.x = pk2(s[0 * 65], s[1 * 65]); o.y = pk2(s[2 * 65], s[3 * 65]); o.z = pk2(s[4 * 65], s[5 * 65]); o.w = pk2(s[6 * 65], s[7 * 65]);
        const int cl = n0 + n; const int drow = mode == 0 ? cl : ((cl >> 7) * 256 + half * 128 + (cl & 127));
        *(GAS u32x4*)(WT + (size_t)drow * K + k0 + 8 * c) = o; }
    LDS_WAIT(); asm volatile("" ::: "memory");
}
__device__ __forceinline__ void p0_prologue(Frame& F, const Args& A) {
    phase_enter(F);
    {
        LAS float* sc = (LAS float*)F.lds;
        LAS float* red = (LAS float*)(F.lds + 81920);
        for (int idx = F.tid; idx < 17 * 1024; idx += 512) { const int cb = idx >> 10, k = idx & 1023; const float v = cb < 16 ? A.c[cb * 1024 + k] : A.c_ctx[k]; sc[k * 20 + cb] = v / (1.0f + expf(-v)); }
        __syncthreads();
        float* MODV = (float*)(F.ws + WS_MODV);
        for (int item = blockIdx.x; item < 4 * 96; item += F.G) {
            const int i = item / 96, cblk = item - i * 96;
            const float* Wm = A.w_mod + (size_t)i * 1024 * 6144 + cblk * 64 + F.lane;
            float acc[17];
#pragma unroll
            for (int cb = 0; cb < 17; ++cb) acc[cb] = 0.f;
            const int k0 = F.wave * 128;
#pragma unroll 4
            for (int kk = 0; kk < 128; ++kk) { const int k = k0 + kk; const float w = Wm[(size_t)k * 6144]; const LAS float* s = sc + k * 20;
#pragma unroll
                for (int cb = 0; cb < 17; ++cb) acc[cb] += s[cb] * w; }
#pragma unroll
            for (int cb = 0; cb < 17; ++cb) red[(F.wave * 17 + cb) * 64 + F.lane] = acc[cb];
            __syncthreads();
            for (int idx = F.tid; idx < 17 * 64; idx += 512) { const int cb = idx >> 6, l = idx & 63; float s = 0.f;
#pragma unroll
                for (int w = 0; w < 8; ++w) s += red[(w * 17 + cb) * 64 + l];
                MODV[(size_t)(i * 17 + cb) * 6144 + cblk * 64 + l] = s + A.b_mod[i * 6144 + cblk * 64 + l]; }
            __syncthreads();
        }
    }
    if (blockIdx.x == 0) { float* RT = (float*)(F.ws + WS_ROPE);
        for (int idx = F.tid; idx < 1024; idx += 512) { const int id = idx >> 4, f = idx & 15; const float inv = __builtin_amdgcn_exp2f(-(float)f * (13.287712379549449f / 16.0f)); const float ang = (float)id * inv;
            RT[idx] = __cosf(ang); RT[1024 + idx] = __sinf(ang); } }
    __syncthreads();
    {
        LAS float* scr = (LAS float*)(F.lds + F.wave * 16896);
        const int gw = blockIdx.x * NWAVES + F.wave, NGW = F.G * NWAVES;
        constexpr int I1 = 16 * 32, I2 = 16 * 65, I3 = 32 * 16, I4 = 16 * 44, I5 = 16 * 44, I6 = 44 * 16, I7 = 16 * 24, I8 = 16 * 16, IPER = I1 + I2 + I3 + I4 + I5 + I6 + I7 + I8;
        for (int it = gw; it < 2 * IPER; it += NGW) {
            const int j = it / IPER; int r = it - j * IPER;
            unsigned char* wss = F.ws + WS_W + (size_t)j * W_SSD_STRIDE; unsigned char* wsa = F.ws + WS_W + W_ATT0 + (size_t)j * W_ATT_STRIDE;
            if (r < I1) { transpose_item(A.ssd_w_in + (size_t)j * 1024 * SSD_IN, SSD_IN, 0, 32, 1024, (bf16_t*)(wss + W_WZ), 0, 0, scr, r, F.lane); continue; } r -= I1;
            if (r < I2) { transpose_item(A.ssd_w_in + (size_t)j * 1024 * SSD_IN, SSD_IN, 2048, 65, 1024, (bf16_t*)(wss + W_WIN), 0, 0, scr, r, F.lane); continue; } r -= I2;
            if (r < I3) { transpose_item(A.ssd_w_out + (size_t)j * 2048 * 1024, 1024, 0, 16, 2048, (bf16_t*)(wss + W_WOUT), 0, 0, scr, r, F.lane); continue; } r -= I3;
            if (r < I4) { transpose_item(A.ffn_w1 + (size_t)j * 1024 * DFF, DFF, 0, 44, 1024, (bf16_t*)(wss + W_WUP), 1, 0, scr, r, F.lane); continue; } r -= I4;
            if (r < I5) { transpose_item(A.ffn_w3 + (size_t)j * 1024 * DFF, DFF, 0, 44, 1024, (bf16_t*)(wss + W_WUP), 1, 1, scr, r, F.lane); continue; } r -= I5;
            if (r < I6) { transpose_item(A.ffn_w2 + (size_t)j * DFF * 1024, 1024, 0, 16, DFF, (bf16_t*)(wss + W_WDN), 0, 0, scr, r, F.lane); continue; } r -= I6;
            if (r < I7) { transpose_item(A.attn_w_qkv + (size_t)j * 1024 * NQKV, NQKV, 0, 24, 1024, (bf16_t*)(wsa + W_WQKV), 0, 0, scr, r, F.lane); continue; } r -= I7;
            transpose_item(A.attn_w_o + (size_t)j * 1024 * 1024, 1024, 0, 16, 1024, (bf16_t*)(wsa + W_WO), 0, 0, scr, r, F.lane);
        }
        for (int j = 0; j < 2; ++j) { u32x4* z = (u32x4*)(F.ws + WS_W + (size_t)j * W_SSD_STRIDE + W_WIN + (size_t)4160 * 1024 * 2);
            for (int idx = blockIdx.x * 512 + F.tid; idx < 192 * 1024 * 2 / 16; idx += F.G * 512) z[idx] = (u32x4){0u, 0u, 0u, 0u}; }
    }
}
__device__ __forceinline__ void moe_convert(Frame& F, const Args& A, int j, int wg0, int nwg) {
    phase_enter(F);
    LAS float* scr = (LAS float*)(F.lds + F.wave * 16896);
    const int gw = ((int)blockIdx.x - wg0) * NWAVES + F.wave, NGW = nwg * NWAVES;
    constexpr int IE = 16 * 56, I2 = 56 * 16;
    bf16_t* MW13 = (bf16_t*)(F.ws + WS_BIG + BIG_MW13); bf16_t* MW2 = (bf16_t*)(F.ws + WS_BIG + BIG_MW2);
    for (int it = gw; it < 8 * (2 * IE + I2); it += NGW) {
        const int e = it / (2 * IE + I2); int r = it - e * (2 * IE + I2);
        const size_t we = (size_t)(j * 8 + e) * 1024 * DFFE;
        if (r < IE) { transpose_item(A.moe_w1 + we, DFFE, 0, 56, 1024, MW13 + (size_t)e * 7168 * 1024, 1, 0, scr, r, F.lane); continue; } r -= IE;
        if (r < IE) { transpose_item(A.moe_w3 + we, DFFE, 0, 56, 1024, MW13 + (size_t)e * 7168 * 1024, 1, 1, scr, r, F.lane); continue; } r -= IE;
        transpose_item(A.moe_w2 + we, 1024, 0, 16, DFFE, MW2 + (size_t)e * 1024 * DFFE, 0, 0, scr, r, F.lane);
    }
}

__device__ __forceinline__ void norm_phase(Frame& F, const Args& A, int i, int which, int mode) {
    phase_enter(F);
    const bool first = mode & 1, combine = mode & 2, route = mode & 4, fin = mode & 8, lastl = mode & 16;
    const float* MODV = (const float*)(F.ws + WS_MODV);
    bf16_t* H = (bf16_t*)F.out; bf16_t* XR = (bf16_t*)(F.ws + WS_XR);
    const bf16_t* EO = (const bf16_t*)(F.ws + WS_Y);
    LAS float* rt = (LAS float*)F.lds;
    LAS int* ents = (LAS int*)(F.lds + 32768);
    const int jm = i >> 1;
    if (route) { const float* rg = A.moe_router + (size_t)jm * 1024 * 8; for (int idx = F.tid; idx < 8192; idx += 512) rt[(idx & 7) * 1024 + (idx >> 3)] = rg[idx]; }
    __syncthreads();
    const float* nw = fin ? A.final_norm_w : ((which == 0 ? A.norm1_w : A.norm2_w) + i * 1024);
    unsigned* cnt = (unsigned*)(F.ctl + CW_CNT + (size_t)jm * 8 * 64);
    int* rlist = (int*)(F.ws + WS_RLIST); float* GATE = (float*)(F.ws + WS_GATE);
    int kk = -1;
    for (int ch = blockIdx.x; ch < MROWS / 32; ch += F.G) {
        ++kk;
        const int R0 = ch * 32, b = R0 / SROW, s0 = R0 - b * SROW; const bool isctx = s0 < NCTX; const int cond = isctx ? 16 : b;
        if (fin && isctx) continue;
        const bool do_route = route && !(lastl && isctx);
        const float* mv = MODV + (size_t)(i * 17 + cond) * 6144;
        f32x4 wv[4], shv[4], scv[4], g5[4];
#pragma unroll
        for (int j = 0; j < 4; ++j) { const int col = 4 * F.lane + 256 * j; wv[j] = *(const f32x4*)(nw + col);
            if (!fin) { shv[j] = *(const f32x4*)(mv + (which ? 3 : 0) * 1024 + col); scv[j] = *(const f32x4*)(mv + (which ? 4 : 1) * 1024 + col); }
            if (combine) g5[j] = *(const f32x4*)(MODV + (size_t)((i - 1) * 17 + cond) * 6144 + 5 * 1024 + col); }
        for (int rr = 0; rr < 4; ++rr) {
            const int R = R0 + F.wave * 4 + rr, s = s0 + F.wave * 4 + rr;
            bf16_t* xr = XR + (size_t)R * DM + 4 * F.lane;
            f32x4 v[4]; float ss = 0.f;
            if (first) { const float* src = isctx ? A.ctx + (size_t)(b * NCTX + s) * DM : A.x + (size_t)(b * SEQ + s - NCTX) * DM;
#pragma unroll
                for (int j = 0; j < 4; ++j) v[j] = *(const f32x4*)(src + 4 * F.lane + 256 * j);
            } else {
#pragma unroll
                for (int j = 0; j < 4; ++j) { const u32x2 w = *(const u32x2*)(xr + 256 * j); v[j] = (f32x4){bf_lo(w.x), bf_hi(w.x), bf_lo(w.y), bf_hi(w.y)}; }
            }
            if (combine) {
#pragma unroll
                for (int j = 0; j < 4; ++j) { const u32x2 e0 = *(const u32x2*)(EO + (size_t)(2 * R) * DM + 4 * F.lane + 256 * j), e1 = *(const u32x2*)(EO + (size_t)(2 * R + 1) * DM + 4 * F.lane + 256 * j);
                    f32x4 ev; ev.x = bf_lo(e0.x) + bf_lo(e1.x); ev.y = bf_hi(e0.x) + bf_hi(e1.x); ev.z = bf_lo(e0.y) + bf_lo(e1.y); ev.w = bf_hi(e0.y) + bf_hi(e1.y);
                    v[j] = v[j] + g5[j] * ev; }
                if (!fin) {
#pragma unroll
                    for (int j = 0; j < 4; ++j) { u32x2 o; o.x = pk2(v[j].x, v[j].y); o.y = pk2(v[j].z, v[j].w); *(u32x2*)(xr + 256 * j) = o; }
                }
            }
#pragma unroll
            for (int j = 0; j < 4; ++j) ss += (v[j].x * v[j].x + v[j].y * v[j].y) + (v[j].z * v[j].z + v[j].w * v[j].w);
            const float rstd = 1.0f / sqrtf(wave_sum(ss, F.lane) * (1.0f / DM) + EPS);
            if (fin) { float* orow = F.out + (size_t)(b * SEQ + s - NCTX) * DM;
#pragma unroll
                for (int j = 0; j < 4; ++j) *(f32x4*)(orow + 4 * F.lane + 256 * j) = v[j] * rstd * wv[j];
                continue;
            }
#pragma unroll
            for (int j = 0; j < 4; ++j) { v[j] = v[j] * rstd * wv[j] * (scv[j] + 1.0f) + shv[j];
                u32x2 o; o.x = pk2(v[j].x, v[j].y); o.y = pk2(v[j].z, v[j].w); *(u32x2*)(H + (size_t)R * DM + 4 * F.lane + 256 * j) = o; }
            if (do_route) {
                float lg[8];
#pragma unroll
                for (int e = 0; e < 8; ++e) lg[e] = 0.f;
#pragma unroll
                for (int e = 0; e < 8; ++e)
#pragma unroll
                    for (int j = 0; j < 4; ++j) { const f32x4 r = *(const LAS f32x4*)(rt + e * 1024 + 4 * F.lane + 256 * j); lg[e] += (v[j].x * r.x + v[j].y * r.y) + (v[j].z * r.z + v[j].w * r.w); }
#pragma unroll
                for (int e = 0; e < 8; ++e) lg[e] = wave_sum(lg[e], F.lane);
                int i1 = 0; float v1 = lg[0];
#pragma unroll
                for (int e = 1; e < 8; ++e) if (lg[e] > v1) { v1 = lg[e]; i1 = e; }
                int i2 = -1; float v2 = -3.0e38f;
#pragma unroll
                for (int e = 0; e < 8; ++e) if (e != i1 && lg[e] > v2) { v2 = lg[e]; i2 = e; }
                const float g1 = 1.0f / (1.0f + expf(v2 - v1)), g2 = 1.0f - g1;
                if (F.lane == 0) { ents[(kk & 15) * 64 + (F.wave * 4 + rr) * 2] = i1; ents[(kk & 15) * 64 + (F.wave * 4 + rr) * 2 + 1] = i2; GATE[(size_t)R * 2] = g1; GATE[(size_t)R * 2 + 1] = g2; }
            } else if (route && F.lane == 0) { ents[(kk & 15) * 64 + (F.wave * 4 + rr) * 2] = -1; ents[(kk & 15) * 64 + (F.wave * 4 + rr) * 2 + 1] = -1; }
        }
    }
    if (route) {
        __syncthreads();
        if (F.wave == 0) {
            const int npass = kk + 1;
            int n[8];
#pragma unroll
            for (int ee = 0; ee < 8; ++ee) n[ee] = 0;
            for (int p = 0; p < npass; ++p) { const int e = ents[(p & 15) * 64 + F.lane];
#pragma unroll
                for (int ee = 0; ee < 8; ++ee) n[ee] += __popcll(__ballot(e == ee)); }
            int myn = n[0];
#pragma unroll
            for (int ee = 1; ee < 8; ++ee) myn = (F.lane == ee) ? n[ee] : myn;
            unsigned basel = 0u;
            if (F.lane < 8) basel = __hip_atomic_fetch_add(cnt + F.lane * 64, (unsigned)myn, RLX_AGENT);
            int off[8];
#pragma unroll
            for (int ee = 0; ee < 8; ++ee) off[ee] = __builtin_amdgcn_readlane((int)basel, ee);
            for (int p = 0; p < npass; ++p) { const int e = ents[(p & 15) * 64 + F.lane]; const int Rp = ((int)blockIdx.x + p * F.G) * 32;
#pragma unroll
                for (int ee = 0; ee < 8; ++ee) { const unsigned long long m = __ballot(e == ee);
                    if (e == ee) rlist[(size_t)ee * MROWS + off[ee] + __popcll(m & ((1ull << F.lane) - 1ull))] = (Rp + (F.lane >> 1)) * 2 + (F.lane & 1);
                    off[ee] += __popcll(m); } }
        }
        __syncthreads();
    }
}

struct EpiXbc {
    static constexpr bool PERM = true;
    bf16_t* XBC; float* DT; bf16_t* HALO;
    __device__ __forceinline__ void operator()(const f32x4 (&acc)[2][2][4][2], const pg8::Unit& u, int wr, int wc, int fr, int fq) const {
        const int row0 = u.pm * 256 + wr * 64 + fr;
        if (u.pn < 16) { const int col0 = u.pn * 256 + wc * 32 + 8 * fq;
#pragma unroll
            for (int ai = 0; ai < 2; ++ai)
#pragma unroll
                for (int m = 0; m < 4; ++m) { bf16_t* rowp = XBC + (size_t)(row0 + ai * 128 + m * 16) * CONVCH + col0;
#pragma unroll
                    for (int bj = 0; bj < 2; ++bj) { const f32x4 v0 = acc[ai][bj][m][0], v1 = acc[ai][bj][m][1]; u32x4 w; w.x = pg8::cvt_pk_bf16(v0[0], v0[1]); w.y = pg8::cvt_pk_bf16(v0[2], v0[3]); w.z = pg8::cvt_pk_bf16(v1[0], v1[1]); w.w = pg8::cvt_pk_bf16(v1[2], v1[3]);
                        *(GAS u32x4*)(rowp + bj * 128) = w;
                        const int rin = ai * 128 + wr * 64 + m * 16 + fr, rq = rin >> 6, rw = rin & 63;
                        if (rw < 2 || rw >= 62) *(GAS u32x4*)(HALO + ((size_t)u.pm * 16 + (rw < 2 ? (rq == 0 ? rw : 4 * rq + rw) : 4 * rq + rw - 60)) * CONVCH + col0 + bj * 128) = w; } }
        } else if (wc < 2) { const int c0 = wc * 32 + 8 * fq;
#pragma unroll
            for (int ai = 0; ai < 2; ++ai)
#pragma unroll
                for (int m = 0; m < 4; ++m) { float* p = DT + (size_t)(row0 + ai * 128 + m * 16) * 64 + c0; *(GAS f32x4*)p = acc[ai][0][m][0]; *(GAS f32x4*)(p + 4) = acc[ai][0][m][1]; }
        }
    }
};
struct EpiGate {
    static constexpr bool PERM = true;
    const bf16_t* Y; bf16_t* Gt; const float* nw; LAS float* P;
    __device__ __forceinline__ void operator()(f32x4 (&acc)[2][2][4][2], const pg8::Unit& u, int wr, int wc, int fr, int fq) const {
        const int row0 = u.pm * 256 + wr * 64 + fr, col0 = u.pn * 256 + wc * 32 + 8 * fq;
        u32x4 yq[2][4][2];
        { const GAS char* yb = (const GAS char*)(Y + (size_t)(u.pm * 256) * DIN + u.pn * 256); unsigned yo = (unsigned)((wr * 64 + fr) * DIN * 2); asm volatile("" : "+v"(yo));
#pragma unroll
          for (int ai = 0; ai < 2; ++ai)
#pragma unroll
            for (int m = 0; m < 4; ++m)
#pragma unroll
                for (int bj = 0; bj < 2; ++bj) { const int cg = bj * 128 + wc * 32 + 8 * fq; const int cy = ((cg >> 5) & 1) * 128 + (cg >> 6) * 32 + (cg & 31);
                    yq[ai][m][bj] = *(const GAS u32x4*)(yb + (size_t)(ai * 128 + m * 16) * DIN * 2 + yo + cy * 2); } }
#pragma unroll
        for (int ai = 0; ai < 2; ++ai)
#pragma unroll
            for (int m = 0; m < 4; ++m) { float ssq = 0.f;
#pragma unroll
                for (int bj = 0; bj < 2; ++bj) { const u32x4 yv = yq[ai][m][bj]; f32x4 z0 = acc[ai][bj][m][0], z1 = acc[ai][bj][m][1];
                    z0[0] = bf_lo(yv.x) * siluf(z0[0]); z0[1] = bf_hi(yv.x) * siluf(z0[1]); z0[2] = bf_lo(yv.y) * siluf(z0[2]); z0[3] = bf_hi(yv.y) * siluf(z0[3]);
                    z1[0] = bf_lo(yv.z) * siluf(z1[0]); z1[1] = bf_hi(yv.z) * siluf(z1[1]); z1[2] = bf_lo(yv.w) * siluf(z1[2]); z1[3] = bf_hi(yv.w) * siluf(z1[3]);
                    ssq += (z0[0] * z0[0] + z0[1] * z0[1]) + (z0[2] * z0[2] + z0[3] * z0[3]) + (z1[0] * z1[0] + z1[1] * z1[1]) + (z1[2] * z1[2] + z1[3] * z1[3]);
                    acc[ai][bj][m][0] = z0; acc[ai][bj][m][1] = z1; }
                ssq += shx(ssq, 16, fq * 16 + fr); ssq += shx(ssq, 32, fq * 16 + fr);
                if (fq == 0) P[(ai * 128 + wr * 64 + m * 16 + fr) * 4 + wc] = ssq; }
        asm volatile("s_waitcnt lgkmcnt(0)" ::: "memory"); __builtin_amdgcn_s_barrier(); asm volatile("" ::: "memory");
        f32x4 nv[2][2];
#pragma unroll
        for (int bj = 0; bj < 2; ++bj) { nv[bj][0] = *(const GAS f32x4*)(nw + col0 + bj * 128); nv[bj][1] = *(const GAS f32x4*)(nw + col0 + bj * 128 + 4); }
#pragma unroll
        for (int ai = 0; ai < 2; ++ai)
#pragma unroll
            for (int m = 0; m < 4; ++m) { const f32x4 pp = *(const LAS f32x4*)(P + (ai * 128 + wr * 64 + m * 16 + fr) * 4); const float rstd = 1.0f / sqrtf(((pp.x + pp.y) + (pp.z + pp.w)) * (1.0f / 256.0f) + EPS);
                bf16_t* gp = Gt + (size_t)(row0 + ai * 128 + m * 16) * DIN + col0;
#pragma unroll
                for (int bj = 0; bj < 2; ++bj) { const f32x4 v0 = acc[ai][bj][m][0] * rstd * nv[bj][0], v1 = acc[ai][bj][m][1] * rstd * nv[bj][1];
                    u32x4 w; w.x = pg8::cvt_pk_bf16(v0[0], v0[1]); w.y = pg8::cvt_pk_bf16(v0[2], v0[3]); w.z = pg8::cvt_pk_bf16(v1[0], v1[1]); w.w = pg8::cvt_pk_bf16(v1[2], v1[3]);
                    *(GAS u32x4*)(gp + bj * 128) = w; } }
        asm volatile("s_waitcnt lgkmcnt(0)" ::: "memory");
    }
};
struct EpiResid {
    static constexpr bool PERM = true;
    bf16_t* XR; const float* modl; int gidx; const float* bias; const float* rd_x; const float* rd_ctx;
    __device__ __forceinline__ void operator()(const f32x4 (&acc)[2][2][4][2], const pg8::Unit& u, int wr, int wc, int fr, int fq) const {
        const int b = u.pm / 17, j = u.pm - b * 17, cond = j == 0 ? 16 : b;
        const GAS char* pbase = (const GAS char*)(XR + (size_t)u.pm * 256 * DM);
        unsigned lo = (unsigned)(((wr * 64 + fr) * DM + u.pn * 256 + wc * 32 + 8 * fq) * 2); asm volatile("" : "+v"(lo));
        const GAS char* ibase = (const GAS char*)(rd_x ? (j == 0 ? rd_ctx + (size_t)(b * NCTX) * DM : rd_x + (size_t)(b * SEQ + (j - 1) * 256) * DM) : nullptr);
        const GAS float* gv = (const GAS float*)(modl + (size_t)cond * 6144 + gidx * 1024 + u.pn * 256 + wc * 32 + 8 * fq);
        const GAS float* bp = (const GAS float*)(bias ? bias + u.pn * 256 + wc * 32 + 8 * fq : nullptr);
#pragma unroll
        for (int bj = 0; bj < 2; ++bj) {
            f32x4 g[2], bv[2];
#pragma unroll
            for (int n = 0; n < 2; ++n) { g[n] = *(const GAS f32x4*)(gv + bj * 128 + n * 4); bv[n] = bp ? *(const GAS f32x4*)(bp + bj * 128 + n * 4) : (f32x4){0.f, 0.f, 0.f, 0.f}; }
#pragma unroll
            for (int ai = 0; ai < 2; ++ai) {
                f32x4 o[4][2];
                if (rd_x) {
#pragma unroll
                    for (int m = 0; m < 4; ++m)
#pragma unroll
                        for (int n = 0; n < 2; ++n) o[m][n] = *(const GAS f32x4*)(ibase + (size_t)(ai * 128 + m * 16) * DM * 4 + 2 * lo + (bj * 128 + n * 4) * 4);
                } else {
                    u32x4 w[4];
#pragma unroll
                    for (int m = 0; m < 4; ++m) w[m] = *(const GAS u32x4*)(pbase + (size_t)(ai * 128 + m * 16) * DM * 2 + lo + bj * 256);
#pragma unroll
                    for (int m = 0; m < 4; ++m) { o[m][0] = (f32x4){bf_lo(w[m].x), bf_hi(w[m].x), bf_lo(w[m].y), bf_hi(w[m].y)}; o[m][1] = (f32x4){bf_lo(w[m].z), bf_hi(w[m].z), bf_lo(w[m].w), bf_hi(w[m].w)}; }
                }
#pragma unroll
                for (int m = 0; m < 4; ++m) { const f32x4 r0 = o[m][0] + g[0] * (acc[ai][bj][m][0] + bv[0]), r1 = o[m][1] + g[1] * (acc[ai][bj][m][1] + bv[1]);
                    u32x4 w; w.x = pg8::cvt_pk_bf16(r0[0], r0[1]); w.y = pg8::cvt_pk_bf16(r0[2], r0[3]); w.z = pg8::cvt_pk_bf16(r1[0], r1[1]); w.w = pg8::cvt_pk_bf16(r1[2], r1[3]);
                    *(GAS u32x4*)(pbase + (size_t)(ai * 128 + m * 16) * DM * 2 + lo + bj * 256) = w; }
                asm volatile("" ::: "memory");
            }
        }
    }
};
struct EpiResidNorm {
    static constexpr bool PERM = true;
    bf16_t* XR; const float* modl; int gidx; const float* bias; const float* rd_x; const float* rd_ctx;
    bf16_t* H; const float* nw; const float* modn; int sidx;
    unsigned* xbuf; unsigned* cnt; unsigned* tmo; LAS unsigned char* P;
    __device__ __forceinline__ void operator()(f32x4 (&acc)[2][2][4][2], const pg8::Unit& u, int wr, int wc, int fr, int fq) const {
        const int b = u.pm / 17, j = u.pm - b * 17, cond = j == 0 ? 16 : b, lane = fq * 16 + fr, wid = wr * 4 + wc;
        const GAS char* pbase = (const GAS char*)(XR + (size_t)u.pm * 256 * DM);
        unsigned lo = (unsigned)(((wr * 64 + fr) * DM + u.pn * 256 + wc * 32 + 8 * fq) * 2); asm volatile("" : "+v"(lo));
        const GAS char* ibase = (const GAS char*)(rd_x ? (j == 0 ? rd_ctx + (size_t)(b * NCTX) * DM : rd_x + (size_t)(b * SEQ + (j - 1) * 256) * DM) : nullptr);
        const int colv = u.pn * 256 + wc * 32 + 8 * fq;
        const GAS float* gv = (const GAS float*)(modl + (size_t)cond * 6144 + gidx * 1024 + colv);
        const GAS float* bp = (const GAS float*)(bias ? bias + colv : nullptr);
        LAS float* Pf = (LAS float*)P; LAS float* Sf = (LAS float*)(P + 4096); LAS unsigned* flag = (LAS unsigned*)(P + 5120);
#pragma unroll
        for (int bj = 0; bj < 2; ++bj) {
            f32x4 g[2], bv[2];
#pragma unroll
            for (int n = 0; n < 2; ++n) { g[n] = *(const GAS f32x4*)(gv + bj * 128 + n * 4); bv[n] = bp ? *(const GAS f32x4*)(bp + bj * 128 + n * 4) : (f32x4){0.f, 0.f, 0.f, 0.f}; }
#pragma unroll
            for (int ai = 0; ai < 2; ++ai) {
                f32x4 o[4][2];
                if (rd_x) {
#pragma unroll
                    for (int m = 0; m < 4; ++m)
#pragma unroll
                        for (int n = 0; n < 2; ++n) o[m][n] = *(const GAS f32x4*)(ibase + (size_t)(ai * 128 + m * 16) * DM * 4 + 2 * lo + (bj * 128 + n * 4) * 4);
                } else {
                    u32x4 w[4];
#pragma unroll
                    for (int m = 0; m < 4; ++m) w[m] = *(const GAS u32x4*)(pbase + (size_t)(ai * 128 + m * 16) * DM * 2 + lo + bj * 256);
#pragma unroll
                    for (int m = 0; m < 4; ++m) { o[m][0] = (f32x4){bf_lo(w[m].x), bf_hi(w[m].x), bf_lo(w[m].y), bf_hi(w[m].y)}; o[m][1] = (f32x4){bf_lo(w[m].z), bf_hi(w[m].z), bf_lo(w[m].w), bf_hi(w[m].w)}; }
                }
#pragma unroll
                for (int m = 0; m < 4; ++m) { const f32x4 r0 = o[m][0] + g[0] * (acc[ai][bj][m][0] + bv[0]), r1 = o[m][1] + g[1] * (acc[ai][bj][m][1] + bv[1]);
                    u32x4 w; w.x = pg8::cvt_pk_bf16(r0[0], r0[1]); w.y = pg8::cvt_pk_bf16(r0[2], r0[3]); w.z = pg8::cvt_pk_bf16(r1[0], r1[1]); w.w = pg8::cvt_pk_bf16(r1[2], r1[3]);
                    *(GAS u32x4*)(pbase + (size_t)(ai * 128 + m * 16) * DM * 2 + lo + bj * 256) = w; acc[ai][bj][m][0] = r0; acc[ai][bj][m][1] = r1; }
                asm volatile("" ::: "memory");
            }
        }
#pragma unroll
        for (int ai = 0; ai < 2; ++ai)
#pragma unroll
            for (int m = 0; m < 4; ++m) { float s = 0.f;
#pragma unroll
                for (int bj = 0; bj < 2; ++bj)
#pragma unroll
                    for (int n = 0; n < 2; ++n) { const f32x4 x = acc[ai][bj][m][n]; s += (x[0] * x[0] + x[1] * x[1]) + (x[2] * x[2] + x[3] * x[3]); }
                s += shx(s, 16, lane); s += shx(s, 32, lane);
                if (fq == 0) Pf[(ai * 128 + wr * 64 + m * 16 + fr) * 4 + wc] = s; }
        asm volatile("s_waitcnt lgkmcnt(0)" ::: "memory"); __builtin_amdgcn_s_barrier(); asm volatile("" ::: "memory");
        const int row = wid * 32 + (lane & 31);
        if (lane < 32) { const f32x4 pp = *(const LAS f32x4*)(Pf + row * 4); const float t = (pp.x + pp.y) + (pp.z + pp.w);
            __hip_atomic_store(xbuf + ((size_t)(u.pm * 256 + row) * 4 + u.pn), __builtin_bit_cast(unsigned, t), RLX_AGENT); }
        asm volatile("s_waitcnt vmcnt(0)" ::: "memory");
        if (lane == 0) __hip_atomic_fetch_add(cnt + 64 * u.pm, 1u, RLX_AGENT);
        if (wid == 0) { bool dead = false; unsigned sp = 0u;
            while ((unsigned)__builtin_amdgcn_readfirstlane((int)__hip_atomic_load(cnt + 64 * u.pm, RLX_AGENT)) < 32u) { __builtin_amdgcn_s_sleep(2);
                if ((++sp & 255u) == 0u) { if (__hip_atomic_load(tmo, RLX_AGENT) != 0u) { dead = true; break; } if (sp > (1u << 20)) { if (lane == 0) atomicAdd(tmo, 1u); dead = true; break; } } }
            __builtin_amdgcn_fence(__ATOMIC_ACQUIRE, "agent");
            if (lane == 0) flag[0] = dead ? 1u : 0u; }
        asm volatile("s_waitcnt vmcnt(0) lgkmcnt(0)" ::: "memory"); __builtin_amdgcn_s_barrier(); asm volatile("" ::: "memory");
        if (lane < 32) { const unsigned* sl = xbuf + (size_t)(u.pm * 256 + row) * 4; float t = 0.f;
#pragma unroll
            for (int q = 0; q < 4; ++q) t += __builtin_bit_cast(float, __hip_atomic_load(sl + q, RLX_AGENT));
            Sf[row] = 1.0f / sqrtf(t * (1.0f / DM) + EPS); }
        asm volatile("s_waitcnt vmcnt(0) lgkmcnt(0)" ::: "memory"); __builtin_amdgcn_s_barrier(); asm volatile("" ::: "memory");
        const GAS float* sh = (const GAS float*)(modn + (size_t)cond * 6144 + sidx * 1024 + colv); const GAS float* sc = sh + 1024; const GAS float* nwp = (const GAS float*)(nw + colv);
#pragma unroll
        for (int bj = 0; bj < 2; ++bj) {
            f32x4 a[2], d[2];
#pragma unroll
            for (int n = 0; n < 2; ++n) { a[n] = *(const GAS f32x4*)(nwp + bj * 128 + n * 4) * (*(const GAS f32x4*)(sc + bj * 128 + n * 4) + 1.0f); d[n] = *(const GAS f32x4*)(sh + bj * 128 + n * 4); }
#pragma unroll
            for (int ai = 0; ai < 2; ++ai)
#pragma unroll
                for (int m = 0; m < 4; ++m) { const int r = ai * 128 + wr * 64 + m * 16 + fr; const float rstd = Sf[r];
                    const f32x4 h0 = acc[ai][bj][m][0] * rstd * a[0] + d[0], h1 = acc[ai][bj][m][1] * rstd * a[1] + d[1];
                    u32x4 w; w.x = pg8::cvt_pk_bf16(h0[0], h0[1]); w.y = pg8::cvt_pk_bf16(h0[2], h0[3]); w.z = pg8::cvt_pk_bf16(h1[0], h1[1]); w.w = pg8::cvt_pk_bf16(h1[2], h1[3]);
                    *(GAS u32x4*)(H + (size_t)(u.pm * 256 + r) * DM + colv + bj * 128) = w; }
        }
        asm volatile("s_waitcnt lgkmcnt(0)" ::: "memory");
    }
};
struct EpiSwiglu {
    static constexpr bool PERM = true;
    bf16_t* ACT; int ldc;
    __device__ __forceinline__ void operator()(const f32x4 (&acc)[2][2][4][2], const pg8::Unit& u, int wr, int wc, int fr, int fq) const {
        const int row0 = u.pm * 256 + wr * 64 + fr, col0 = u.pn * 128 + wc * 32 + 8 * fq;
#pragma unroll
        for (int ai = 0; ai < 2; ++ai)
#pragma unroll
            for (int m = 0; m < 4; ++m) { const f32x4 g0 = acc[ai][0][m][0], g1 = acc[ai][0][m][1], u0 = acc[ai][1][m][0], u1 = acc[ai][1][m][1];
                u32x4 w; w.x = pg8::cvt_pk_bf16(siluf(g0[0]) * u0[0], siluf(g0[1]) * u0[1]); w.y = pg8::cvt_pk_bf16(siluf(g0[2]) * u0[2], siluf(g0[3]) * u0[3]);
                w.z = pg8::cvt_pk_bf16(siluf(g1[0]) * u1[0], siluf(g1[1]) * u1[1]); w.w = pg8::cvt_pk_bf16(siluf(g1[2]) * u1[2], siluf(g1[3]) * u1[3]);
                *(GAS u32x4*)(ACT + (size_t)(row0 + ai * 128 + m * 16) * ldc + col0) = w; }
    }
};
struct EpiQkv {
    static constexpr bool PERM = false;
    bf16_t *Q, *Kb, *Vb; const LAS float* T;
    __device__ __forceinline__ void operator()(const f32x4 (&acc)[2][2][4][2], const pg8::Unit& u, int wr, int wc, int fr, int fq) const {
        const int b = u.pm / 17, j = u.pm - b * 17; const bool isctx = j == 0; const int pos0 = (j - 1) * 256;
        bf16_t* dst; int ld, cbase; float sc = 1.0f;
        if (u.pn < 4) { dst = Q; ld = QW; cbase = u.pn * 256; sc = 0.125f * 1.4426950408889634f;   } else if (u.pn == 4) { dst = Kb; ld = KVW; cbase = 0; } else { dst = Vb; ld = KVW; cbase = 0; }
        const bool dorope = !isctx && u.pn < 5; const int axis = wc & 1;
        const LAS float* bp = T + 2048 + u.pn * 256 + wc * 32 + 4 * fq;
        f32x4 bv[2][2];
#pragma unroll
        for (int bj = 0; bj < 2; ++bj)
#pragma unroll
            for (int n = 0; n < 2; ++n) bv[bj][n] = *(const LAS f32x4*)(bp + bj * 128 + n * 16);
#pragma unroll
        for (int ai = 0; ai < 2; ++ai)
#pragma unroll
            for (int m = 0; m < 4; ++m) { const int r = ai * 128 + wr * 64 + m * 16 + fr; const int pos = pos0 + r; const int id = axis ? (pos & 63) : (pos >> 6);
                f32x4 cs = (f32x4){1.f, 1.f, 1.f, 1.f}, sn = (f32x4){0.f, 0.f, 0.f, 0.f};
                if (dorope) { cs = *(const LAS f32x4*)(T + id * 16 + 4 * fq); sn = *(const LAS f32x4*)(T + 1024 + id * 16 + 4 * fq); }
                GAS bf16_t* rowp = (GAS bf16_t*)(dst + (size_t)(u.pm * 256 + r) * ld + cbase + wc * 32 + 4 * fq);
#pragma unroll
                for (int bj = 0; bj < 2; ++bj) { const f32x4 x0 = (acc[ai][bj][m][0] + bv[bj][0]) * sc, x1 = (acc[ai][bj][m][1] + bv[bj][1]) * sc;
                    const f32x4 o0 = x0 * cs - x1 * sn, o1 = x1 * cs + x0 * sn;
                    u32x2 w0, w1; w0.x = pg8::cvt_pk_bf16(o0[0], o0[1]); w0.y = pg8::cvt_pk_bf16(o0[2], o0[3]); w1.x = pg8::cvt_pk_bf16(o1[0], o1[1]); w1.y = pg8::cvt_pk_bf16(o1[2], o1[3]);
                    *(GAS u32x2*)(rowp + bj * 128) = w0; *(GAS u32x2*)(rowp + bj * 128 + 16) = w1; } }
    }
};

struct MoeOrder {
    pg8::StaticOrder so; int cs; int pp[9]; int cnt[8]; const int* rlist; size_t bstride; bool GATHER_A;
    __device__ __forceinline__ void locate(int pm, int& e, int& p, int& cn) const { const int gp = cs + pm; e = 0; int pbase = 0; cn = cnt[0];
#pragma unroll
        for (int k = 1; k < 8; ++k) { const bool ge = gp >= pp[k]; e += ge ? 1 : 0; pbase = ge ? pp[k] : pbase; cn = ge ? cnt[k] : cn; }
        p = gp - pbase; }
    __device__ bool next(int i, pg8::Unit& u) const { return so.next(i, u); }
    __device__ __forceinline__ const char* a_base(const pg8::Gemm& g, const pg8::Unit& u) const { return GATHER_A ? (const char*)g.A : (const char*)g.A + (size_t)u.pm * (size_t)(256 * 2) * g.lda; }
    __device__ __forceinline__ const char* b_base(const pg8::Gemm& g, const pg8::Unit& u) const { int e, p, cn; locate(u.pm, e, p, cn); return (const char*)g.Bt + (size_t)e * bstride + (size_t)u.pn * (size_t)(256 * 2) * g.K; }
    __device__ __forceinline__ unsigned row_off(const pg8::Gemm& g, const pg8::Unit& u, int r) const {
        if (!GATHER_A) return (unsigned)r * (unsigned)g.lda * 2u;
        int e, p, cn; locate(u.pm, e, p, cn); const int idx = p * 256 + r; const int tok = idx < cn ? (rlist[(size_t)e * MROWS + idx] >> 1) : 0; return (unsigned)tok * (unsigned)g.lda * 2u; }
};
struct EpiMoeDown {
    static constexpr bool PERM = true;
    MoeOrder mo; bf16_t* EO; const float* GATE;
    __device__ __forceinline__ void operator()(const f32x4 (&acc)[2][2][4][2], const pg8::Unit& u, int wr, int wc, int fr, int fq) const {
        int e, p, cn; mo.locate(u.pm, e, p, cn); const int* rl = mo.rlist + (size_t)e * MROWS + p * 256;
        const int col0 = u.pn * 256 + wc * 32 + 8 * fq;
#pragma unroll
        for (int ai = 0; ai < 2; ++ai)
#pragma unroll
            for (int m = 0; m < 4; ++m) { const int r = ai * 128 + wr * 64 + m * 16 + fr;
                if (p * 256 + r < cn) { const int ent = rl[r]; const float gt = GATE[ent]; bf16_t* dp = EO + (size_t)ent * DM + col0;
#pragma unroll
                    for (int bj = 0; bj < 2; ++bj) { const f32x4 v0 = acc[ai][bj][m][0] * gt, v1 = acc[ai][bj][m][1] * gt; u32x4 w; w.x = pg8::cvt_pk_bf16(v0[0], v0[1]); w.y = pg8::cvt_pk_bf16(v0[2], v0[3]); w.z = pg8::cvt_pk_bf16(v1[0], v1[1]); w.w = pg8::cvt_pk_bf16(v1[2], v1[3]);
                        *(GAS u32x4*)(dp + bj * 128) = w; } } }
    }
};

typedef __bf16 bf16x2_t __attribute__((ext_vector_type(2)));
typedef short v4i16_t __attribute__((ext_vector_type(4)));
__device__ __forceinline__ unsigned cvtpk(float lo, float hi) { f32x2 v = {lo, hi}; bf16x2_t b = __builtin_convertvector(v, bf16x2_t); return __builtin_bit_cast(unsigned, b); }
__device__ __forceinline__ int crow(int r, int hi) { return (r & 3) + 8 * (r >> 2) + 4 * hi; }
__device__ __forceinline__ s16x4 vtr(const LAS unsigned char* p) { return __builtin_bit_cast(s16x4, __builtin_amdgcn_ds_read_tr16_b64_v4i16((LAS v4i16_t*)p)); }
#define MFMA32(a, b, c) __builtin_amdgcn_mfma_f32_32x32x16_bf16((a), (b), (c), 0, 0, 0)
__device__ __forceinline__ void conv_phase(Frame& F, const Args& A, int j) {
    phase_enter(F);
    bf16_t* XBC = (bf16_t*)(F.ws + WS_BIG); const bf16_t* HALO = (const bf16_t*)(F.ws + WS_HALO);
    const int lane = F.lane;
    const int gw = blockIdx.x * NWAVES + F.wave, NGW = F.G * NWAVES;
    for (int task = gw; task < NPAN * 32; task += NGW) {
        const int pm = task >> 5, q = (task >> 3) & 3, sl = task & 7, jj = pm % 17, c0 = sl * 512 + lane * 8;
        const bool top_zero = q == 0 && jj <= 1, bot_zero = q == 3 && (jj == 0 || jj == 16);
        const GAS bf16_t* htop = (const GAS bf16_t*)(HALO + (q == 0 ? ((size_t)(pm - 1) * 16 + 14) : ((size_t)pm * 16 + 4 * q - 2)) * CONVCH + c0);
        const GAS bf16_t* hbot = (const GAS bf16_t*)(HALO + (q == 3 ? ((size_t)(pm + 1) * 16 + 0) : ((size_t)pm * 16 + 4 * q + 4)) * CONVCH + c0);
        f32x2 cw[5][4], cbias[4];
#pragma unroll
        for (int k = 0; k < 5; ++k) { const f32x4 a0 = *(const GAS f32x4*)(A.ssd_conv_w + (size_t)(j * 5 + k) * CONVCH + c0), a1 = *(const GAS f32x4*)(A.ssd_conv_w + (size_t)(j * 5 + k) * CONVCH + c0 + 4);
            cw[k][0] = (f32x2){a0.x, a0.y}; cw[k][1] = (f32x2){a0.z, a0.w}; cw[k][2] = (f32x2){a1.x, a1.y}; cw[k][3] = (f32x2){a1.z, a1.w}; }
        { const f32x4 a0 = *(const GAS f32x4*)(A.ssd_conv_b + (size_t)j * CONVCH + c0), a1 = *(const GAS f32x4*)(A.ssd_conv_b + (size_t)j * CONVCH + c0 + 4);
            cbias[0] = (f32x2){a0.x, a0.y}; cbias[1] = (f32x2){a0.z, a0.w}; cbias[2] = (f32x2){a1.x, a1.y}; cbias[3] = (f32x2){a1.z, a1.w}; }
        GAS bf16_t* base = (GAS bf16_t*)(XBC + ((size_t)pm * 256 + q * 64) * CONVCH + c0);
        const u32x4 zero4 = (u32x4){0u, 0u, 0u, 0u};
        u32x4 win[12], pre[8];
        win[0] = top_zero ? zero4 : *(const GAS u32x4*)(htop);
        win[1] = top_zero ? zero4 : *(const GAS u32x4*)(htop + CONVCH);
#pragma unroll
        for (int r = 0; r < 10; ++r) win[2 + r] = *(const GAS u32x4*)(base + (size_t)r * CONVCH);
        for (int k = 0; k < 8; ++k) {
            if (k < 6) {
#pragma unroll
                for (int r = 0; r < 8; ++r) pre[r] = *(const GAS u32x4*)(base + (size_t)(8 * k + 10 + r) * CONVCH);
            } else if (k == 6) {
#pragma unroll
                for (int r = 0; r < 6; ++r) pre[r] = *(const GAS u32x4*)(base + (size_t)(58 + r) * CONVCH);
                pre[6] = bot_zero ? zero4 : *(const GAS u32x4*)(hbot);
                pre[7] = bot_zero ? zero4 : *(const GAS u32x4*)(hbot + CONVCH);
            }
#pragma unroll
            for (int o = 0; o < 8; ++o) {
                f32x2 r[4];
#pragma unroll
                for (int c = 0; c < 4; ++c) r[c] = cbias[c];
#pragma unroll
                for (int t = 0; t < 5; ++t) { const u32x4 w = win[o + t];
                    r[0] += cw[t][0] * (f32x2){bf_lo(w.x), bf_hi(w.x)}; r[1] += cw[t][1] * (f32x2){bf_lo(w.y), bf_hi(w.y)};
                    r[2] += cw[t][2] * (f32x2){bf_lo(w.z), bf_hi(w.z)}; r[3] += cw[t][3] * (f32x2){bf_lo(w.w), bf_hi(w.w)}; }
                u32x4 w; w.x = cvtpk(siluf(r[0].x), siluf(r[0].y)); w.y = cvtpk(siluf(r[1].x), siluf(r[1].y)); w.z = cvtpk(siluf(r[2].x), siluf(r[2].y)); w.w = cvtpk(siluf(r[3].x), siluf(r[3].y));
                *(GAS u32x4*)(base + (size_t)(8 * k + o) * CONVCH) = w;
            }
#pragma unroll
            for (int r = 0; r < 4; ++r) win[r] = win[8 + r];
#pragma unroll
            for (int r = 0; r < 8; ++r) win[4 + r] = pre[r];
        }
    }
}

constexpr int SC_RS = 272;
constexpr int SC_TILE = 3 * 32 * SC_RS;
constexpr int SC_YS = 2 * SC_TILE;
constexpr int SC_WS = SC_YS + 16384;
constexpr int SC_RAW = 73728;
static_assert(SC_WS + 4096 <= SC_RAW && SC_RAW + 2 * 36 * 1024 <= LDSCTL_OFF, "scan LDS map");
template <int PH>
__device__ __forceinline__ void scan_phase(Frame& F, const Args& A, int j) {
    phase_enter(F);
    const bf16_t* XBC = (const bf16_t*)(F.ws + WS_BIG); const float* DT = (const float*)(F.ws + WS_DT); bf16_t* Y = (bf16_t*)(F.ws + WS_Y);
    const int lane = F.lane, wave = F.wave;
    for (int u0 = blockIdx.x; u0 < 256; u0 += F.G) {
        const int unit = (F.G == 256) ? ((u0 & 7) * 32 + (u0 >> 3)) : u0;
        const int b = unit >> 4, g = (unit >> 1) & 7, ph = unit & 1;
        const int srow = F.tid >> 4, sch = F.tid & 15;
        const int gcolB = 2048 + g * 128 + sch * 8, gcolC = 3072 + g * 128 + sch * 8, gcolX = g * 256 + (sch >> 2) * 64 + ph * 32 + (sch & 3) * 8;
        const int hh = wave >> 1, dir = wave & 1, c31 = lane & 31, hl = lane >> 5;
        const int trq = (lane & 15) >> 2, trp = lane & 3, trb = (lane >> 4) & 1;
        const int head = g * 4 + hh;
        const float Dk = A.ssd_d[(j * 2 + dir) * 32 + head], dtb = A.ssd_dt_bias[(j * 2 + dir) * 32 + head], aneg = -expf(A.ssd_a_log[(j * 2 + dir) * 32 + head]);
        LAS float* wsf = (LAS float*)(F.lds + SC_WS + wave * 512);
        int offRow = dir * SC_TILE + c31 * SC_RS + 16 * hl;
        int offC4 = dir * SC_TILE + 32 * SC_RS + c31 * SC_RS + 8 * hl;
        int offTrX = dir * SC_TILE + 64 * SC_RS + trq * SC_RS + (hh * 32 + 16 * trb + 4 * trp) * 2;
        int offTrB = dir * SC_TILE + trq * SC_RS + (16 * trb + 4 * trp) * 2;
        int ysoff = (4 * hl) * 128 + hh * 32 + c31;
        asm volatile("" : "+v"(offRow), "+v"(offC4), "+v"(offTrX), "+v"(offTrB), "+v"(ysoff));
        f32x16 ST[4];
#pragma unroll
        for (int t = 0; t < 4; ++t)
#pragma unroll
            for (int e = 0; e < 16; ++e) ST[t][e] = 0.f;
#define SC_PF(pf, st_) do { const int st = (PH >= 2) ? 0 : (st_); const int cf_ = (st), cb_ = (st) < 8 ? 7 - (st) : 143 - (st); \
            _Pragma("unroll") for (int T = 0; T < 2; ++T) { const GAS bf16_t* rp = (const GAS bf16_t*)(XBC + (size_t)(b * SROW + (T ? cb_ : cf_) * 32 + srow) * CONVCH); \
                pf[T][0] = *(const GAS u32x4*)(rp + gcolB); pf[T][1] = *(const GAS u32x4*)(rp + gcolC); pf[T][2] = *(const GAS u32x4*)(rp + gcolX); } } while (0)
#define SC_DTLOAD(st) DT[(size_t)(b * SROW + (dir ? ((st) < 8 ? 7 - (st) : 143 - (st)) : (st)) * 32 + c31) * 64 + dir * 32 + head]
#define SC_WRITEOUT(st) do { const int cf_ = (st), cb_ = (st) < 8 ? 7 - (st) : 143 - (st); \
            _Pragma("unroll") for (int T = 0; T < 2; ++T) { const int tok = F.tid >> 4, h4 = (F.tid >> 2) & 3, q4 = F.tid & 3, chunk = T ? cb_ : cf_; \
                const int other = T == 0 ? (chunk < 8 ? 7 - chunk : 143 - chunk) : chunk; \
                u32x4 v = *(const LAS u32x4*)(F.lds + SC_YS + T * 8192 + (tok * 128 + h4 * 32 + q4 * 8) * 2); \
                bf16_t* yp = Y + (size_t)(b * SROW + chunk * 32 + tok) * DIN + g * 256 + ph * 128 + h4 * 32 + q4 * 8; \
                if ((st) > other) { const u32x4 o = oldy[T]; \
                    v.x = pk2(bf_lo(o.x) + bf_lo(v.x), bf_hi(o.x) + bf_hi(v.x)); v.y = pk2(bf_lo(o.y) + bf_lo(v.y), bf_hi(o.y) + bf_hi(v.y)); \
                    v.z = pk2(bf_lo(o.z) + bf_lo(v.z), bf_hi(o.z) + bf_hi(v.z)); v.w = pk2(bf_lo(o.w) + bf_lo(v.w), bf_hi(o.w) + bf_hi(v.w)); } \
                if (PH == 0) *(u32x4*)yp = v; else asm volatile("" :: "v"(v)); } } while (0)
        u32x4 pfE[2][3], pfO[2][3];
        SC_PF(pfE, 0); SC_PF(pfO, 1);
        float dtraw = SC_DTLOAD(0);
        u32x4 oldy[2] = {(u32x4){0u, 0u, 0u, 0u}, (u32x4){0u, 0u, 0u, 0u}};
        for (int step2 = 0; step2 < 136; step2 += 2) {
          { const int step = step2;
            const int cf = step, cbk = step < 8 ? 7 - step : 143 - step;
            __syncthreads();
            if (step > 0) SC_WRITEOUT(step - 1);
#pragma unroll
            for (int T = 0; T < 2; ++T)
#pragma unroll
                for (int a = 0; a < 3; ++a) *(LAS u32x4*)(F.lds + T * SC_TILE + a * (32 * SC_RS) + srow * SC_RS + sch * 16) = pfE[T][a];
            {
                const float xb = dtraw + dtb;
                const float dt = xb > 20.f ? xb : log1pf(__expf(xb)); const float dA = dt * aneg;
                float v = dA;
                v += __builtin_bit_cast(float, __builtin_amdgcn_update_dpp(0, __builtin_bit_cast(int, v), 0x111, 0xf, 0xf, true));
                v += __builtin_bit_cast(float, __builtin_amdgcn_update_dpp(0, __builtin_bit_cast(int, v), 0x112, 0xf, 0xf, true));
                v += __builtin_bit_cast(float, __builtin_amdgcn_update_dpp(0, __builtin_bit_cast(int, v), 0x114, 0xf, 0xf, true));
                v += __builtin_bit_cast(float, __builtin_amdgcn_update_dpp(0, __builtin_bit_cast(int, v), 0x118, 0xf, 0xf, true));
                v += __builtin_bit_cast(float, __builtin_amdgcn_update_dpp(0, __builtin_bit_cast(int, v), 0x142, 0xa, 0xf, false));
                const float tot = __builtin_bit_cast(float, __builtin_amdgcn_readlane(__builtin_bit_cast(int, v), 31));
                const float cum = dir ? (tot - v + dA) : v;
                if (hl == 0) { wsf[c31] = cum; wsf[32 + c31] = dt; wsf[64 + c31] = __expf(tot - cum) * dt; wsf[96 + c31] = __expf(cum); }
            }
            asm volatile("s_waitcnt lgkmcnt(0)" ::: "memory"); __builtin_amdgcn_s_barrier(); asm volatile("" ::: "memory");
            if (step + 2 < 136) SC_PF(pfE, step + 2); if (step + 1 < 136) dtraw = SC_DTLOAD(step + 1);
#pragma unroll
            for (int T = 0; T < 2; ++T) {
                const int tok = F.tid >> 4, h4 = (F.tid >> 2) & 3, q4 = F.tid & 3, chunk = T ? cbk : cf;
                const int other = T == 0 ? (chunk < 8 ? 7 - chunk : 143 - chunk) : chunk;
                if (PH == 0 && step > other) oldy[T] = *(const u32x4*)(Y + (size_t)(b * SROW + chunk * 32 + tok) * DIN + g * 256 + ph * 128 + h4 * 32 + q4 * 8);
            }
            if (PH < 3) {
                const LAS unsigned char* Bs = F.lds + dir * SC_TILE; const LAS unsigned char* Cs = Bs + 32 * SC_RS; const LAS unsigned char* xs = Bs + 64 * SC_RS;
                f32x16 gt;
#pragma unroll
                for (int e = 0; e < 16; ++e) gt[e] = 0.f;
#pragma unroll
                for (int s = 0; s < 8; ++s) { const bf16x8 a = *(const LAS bf16x8*)(F.lds + offRow + 32 * s), bb = *(const LAS bf16x8*)(F.lds + offRow + 32 * SC_RS + 32 * s); gt = MFMA32(a, bb, gt); }
                const float cum_i = wsf[c31];
                bf16x8 mk[2];
                {
                    float mv[16];
#pragma unroll
                    for (int q = 0; q < 4; ++q) { const f32x4 cj = *(const LAS f32x4*)(wsf + 8 * q + 4 * hl), dj = *(const LAS f32x4*)(wsf + 32 + 8 * q + 4 * hl);
#pragma unroll
                        for (int z = 0; z < 4; ++z) { const int jj = 8 * q + 4 * hl + z; const bool ok = dir ? (jj >= c31) : (jj <= c31);
                            float val = gt[4 * q + z] * __expf(ok ? (cum_i - cj[z]) : -INFINITY) * dj[z]; if (jj == c31) val += Dk; mv[4 * q + z] = val; } }
#pragma unroll
                    for (int s2 = 0; s2 < 2; ++s2) { u32x4 w; w.x = cvtpk(mv[8 * s2], mv[8 * s2 + 1]); w.y = cvtpk(mv[8 * s2 + 2], mv[8 * s2 + 3]); w.z = cvtpk(mv[8 * s2 + 4], mv[8 * s2 + 5]); w.w = cvtpk(mv[8 * s2 + 6], mv[8 * s2 + 7]); mk[s2] = __builtin_bit_cast(bf16x8, w); }
                }
                f32x16 ya;
#pragma unroll
                for (int e = 0; e < 16; ++e) ya[e] = 0.f;
#pragma unroll
                for (int t = 0; t < 4; ++t)
#pragma unroll
                    for (int s2 = 0; s2 < 2; ++s2) {
                        const LAS unsigned char* cp = F.lds + offC4 + 64 * t + 32 * s2;
                        const u32x2 c0 = *(const LAS u32x2*)cp, c1 = *(const LAS u32x2*)(cp + 16);
                        const bf16x8 ca = __builtin_bit_cast(bf16x8, (u32x4){c0.x, c0.y, c1.x, c1.y});
                        u32x4 w; w.x = cvtpk(ST[t][8 * s2], ST[t][8 * s2 + 1]); w.y = cvtpk(ST[t][8 * s2 + 2], ST[t][8 * s2 + 3]); w.z = cvtpk(ST[t][8 * s2 + 4], ST[t][8 * s2 + 5]); w.w = cvtpk(ST[t][8 * s2 + 6], ST[t][8 * s2 + 7]);
                        ya = MFMA32(ca, __builtin_bit_cast(bf16x8, w), ya);
                    }
#pragma unroll
                for (int q = 0; q < 4; ++q) { const f32x4 ec = *(const LAS f32x4*)(wsf + 96 + 8 * q + 4 * hl); ya[4 * q] *= ec.x; ya[4 * q + 1] *= ec.y; ya[4 * q + 2] *= ec.z; ya[4 * q + 3] *= ec.w; }
#pragma unroll
                for (int s2 = 0; s2 < 2; ++s2) {
                    const LAS unsigned char* xp = F.lds + offTrX + (16 * s2) * SC_RS + hl * (4 * SC_RS);
                    const s16x4 lo = vtr(xp), hi = vtr(xp + 8 * SC_RS);
                    ya = MFMA32(mk[s2], ((bf16x8){lo[0], lo[1], lo[2], lo[3], hi[0], hi[1], hi[2], hi[3]}), ya);
                }
                {
                    const float etot = dir ? wsf[96] : wsf[96 + 31];
#pragma unroll
                    for (int t = 0; t < 4; ++t)
#pragma unroll
                        for (int e = 0; e < 16; ++e) ST[t][e] *= etot;
#pragma unroll
                    for (int s2 = 0; s2 < 2; ++s2) {
                        const LAS unsigned char* xp = F.lds + offTrX + (16 * s2) * SC_RS + hl * (8 * SC_RS);
                        const s16x4 lo = vtr(xp), hi = vtr(xp + 4 * SC_RS);
                        const f32x4 w0 = *(const LAS f32x4*)(wsf + 64 + 16 * s2 + 8 * hl), w1 = *(const LAS f32x4*)(wsf + 64 + 16 * s2 + 8 * hl + 4);
                        u32x4 xw; xw.x = cvtpk(bf1((bf16_t)lo[0]) * w0.x, bf1((bf16_t)lo[1]) * w0.y); xw.y = cvtpk(bf1((bf16_t)lo[2]) * w0.z, bf1((bf16_t)lo[3]) * w0.w);
                        xw.z = cvtpk(bf1((bf16_t)hi[0]) * w1.x, bf1((bf16_t)hi[1]) * w1.y); xw.w = cvtpk(bf1((bf16_t)hi[2]) * w1.z, bf1((bf16_t)hi[3]) * w1.w);
                        const bf16x8 xb8 = __builtin_bit_cast(bf16x8, xw);
#pragma unroll
                        for (int t = 0; t < 4; ++t) {
                            const LAS unsigned char* bp = F.lds + offTrB + (16 * s2) * SC_RS + hl * (8 * SC_RS) + 64 * t;
                            const s16x4 blo = vtr(bp), bhi = vtr(bp + 4 * SC_RS);
                            ST[t] = MFMA32(((bf16x8){blo[0], blo[1], blo[2], blo[3], bhi[0], bhi[1], bhi[2], bhi[3]}), xb8, ST[t]);
                        }
                    }
                }
                LAS bf16_t* ys = (LAS bf16_t*)(F.lds + SC_YS + dir * 8192) + ysoff;
#pragma unroll
                for (int e = 0; e < 16; e += 2) { const unsigned w = cvtpk(ya[e], ya[e + 1]); ys[((e & 3) + 8 * (e >> 2)) * 128] = (bf16_t)w; ys[((e & 3) + 1 + 8 * (e >> 2)) * 128] = (bf16_t)(w >> 16); }
            }
                  }
          { const int step = step2 + 1;
            const int cf = step, cbk = step < 8 ? 7 - step : 143 - step;
            __syncthreads();
            if (step > 0) SC_WRITEOUT(step - 1);
#pragma unroll
            for (int T = 0; T < 2; ++T)
#pragma unroll
                for (int a = 0; a < 3; ++a) *(LAS u32x4*)(F.lds + T * SC_TILE + a * (32 * SC_RS) + srow * SC_RS + sch * 16) = pfO[T][a];
            {
                const float xb = dtraw + dtb;
                const float dt = xb > 20.f ? xb : log1pf(__expf(xb)); const float dA = dt * aneg;
                float v = dA;
                v += __builtin_bit_cast(float, __builtin_amdgcn_update_dpp(0, __builtin_bit_cast(int, v), 0x111, 0xf, 0xf, true));
                v += __builtin_bit_cast(float, __builtin_amdgcn_update_dpp(0, __builtin_bit_cast(int, v), 0x112, 0xf, 0xf, true));
                v += __builtin_bit_cast(float, __builtin_amdgcn_update_dpp(0, __builtin_bit_cast(int, v), 0x114, 0xf, 0xf, true));
                v += __builtin_bit_cast(float, __builtin_amdgcn_update_dpp(0, __builtin_bit_cast(int, v), 0x118, 0xf, 0xf, true));
                v += __builtin_bit_cast(float, __builtin_amdgcn_update_dpp(0, __builtin_bit_cast(int, v), 0x142, 0xa, 0xf, false));
                const float tot = __builtin_bit_cast(float, __builtin_amdgcn_readlane(__builtin_bit_cast(int, v), 31));
                const float cum = dir ? (tot - v + dA) : v;
                if (hl == 0) { wsf[c31] = cum; wsf[32 + c31] = dt; wsf[64 + c31] = __expf(tot - cum) * dt; wsf[96 + c31] = __expf(cum); }
            }
            asm volatile("s_waitcnt lgkmcnt(0)" ::: "memory"); __builtin_amdgcn_s_barrier(); asm volatile("" ::: "memory");
            if (step + 2 < 136) SC_PF(pfO, step + 2); if (step + 1 < 136) dtraw = SC_DTLOAD(step + 1);
#pragma unroll
            for (int T = 0; T < 2; ++T) {
                const int tok = F.tid >> 4, h4 = (F.tid >> 2) & 3, q4 = F.tid & 3, chunk = T ? cbk : cf;
                const int other = T == 0 ? (chunk < 8 ? 7 - chunk : 143 - chunk) : chunk;
                if (PH == 0 && step > other) oldy[T] = *(const u32x4*)(Y + (size_t)(b * SROW + chunk * 32 + tok) * DIN + g * 256 + ph * 128 + h4 * 32 + q4 * 8);
            }
            if (PH < 3) {
                const LAS unsigned char* Bs = F.lds + dir * SC_TILE; const LAS unsigned char* Cs = Bs + 32 * SC_RS; const LAS unsigned char* xs = Bs + 64 * SC_RS;
                f32x16 gt;
#pragma unroll
                for (int e = 0; e < 16; ++e) gt[e] = 0.f;
#pragma unroll
                for (int s = 0; s < 8; ++s) { const bf16x8 a = *(const LAS bf16x8*)(F.lds + offRow + 32 * s), bb = *(const LAS bf16x8*)(F.lds + offRow + 32 * SC_RS + 32 * s); gt = MFMA32(a, bb, gt); }
                const float cum_i = wsf[c31];
                bf16x8 mk[2];
                {
                    float mv[16];
#pragma unroll
                    for (int q = 0; q < 4; ++q) { const f32x4 cj = *(const LAS f32x4*)(wsf + 8 * q + 4 * hl), dj = *(const LAS f32x4*)(wsf + 32 + 8 * q + 4 * hl);
#pragma unroll
                        for (int z = 0; z < 4; ++z) { const int jj = 8 * q + 4 * hl + z; const bool ok = dir ? (jj >= c31) : (jj <= c31);
                            float val = gt[4 * q + z] * __expf(ok ? (cum_i - cj[z]) : -INFINITY) * dj[z]; if (jj == c31) val += Dk; mv[4 * q + z] = val; } }
#pragma unroll
                    for (int s2 = 0; s2 < 2; ++s2) { u32x4 w; w.x = cvtpk(mv[8 * s2], mv[8 * s2 + 1]); w.y = cvtpk(mv[8 * s2 + 2], mv[8 * s2 + 3]); w.z = cvtpk(mv[8 * s2 + 4], mv[8 * s2 + 5]); w.w = cvtpk(mv[8 * s2 + 6], mv[8 * s2 + 7]); mk[s2] = __builtin_bit_cast(bf16x8, w); }
                }
                f32x16 ya;
#pragma unroll
                for (int e = 0; e < 16; ++e) ya[e] = 0.f;
#pragma unroll
                for (int t = 0; t < 4; ++t)
#pragma unroll
                    for (int s2 = 0; s2 < 2; ++s2) {
                        const LAS unsigned char* cp = F.lds + offC4 + 64 * t + 32 * s2;
                        const u32x2 c0 = *(const LAS u32x2*)cp, c1 = *(const LAS u32x2*)(cp + 16);
                        const bf16x8 ca = __builtin_bit_cast(bf16x8, (u32x4){c0.x, c0.y, c1.x, c1.y});
                        u32x4 w; w.x = cvtpk(ST[t][8 * s2], ST[t][8 * s2 + 1]); w.y = cvtpk(ST[t][8 * s2 + 2], ST[t][8 * s2 + 3]); w.z = cvtpk(ST[t][8 * s2 + 4], ST[t][8 * s2 + 5]); w.w = cvtpk(ST[t][8 * s2 + 6], ST[t][8 * s2 + 7]);
                        ya = MFMA32(ca, __builtin_bit_cast(bf16x8, w), ya);
                    }
#pragma unroll
                for (int q = 0; q < 4; ++q) { const f32x4 ec = *(const LAS f32x4*)(wsf + 96 + 8 * q + 4 * hl); ya[4 * q] *= ec.x; ya[4 * q + 1] *= ec.y; ya[4 * q + 2] *= ec.z; ya[4 * q + 3] *= ec.w; }
#pragma unroll
                for (int s2 = 0; s2 < 2; ++s2) {
                    const LAS unsigned char* xp = F.lds + offTrX + (16 * s2) * SC_RS + hl * (4 * SC_RS);
                    const s16x4 lo = vtr(xp), hi = vtr(xp + 8 * SC_RS);
                    ya = MFMA32(mk[s2], ((bf16x8){lo[0], lo[1], lo[2], lo[3], hi[0], hi[1], hi[2], hi[3]}), ya);
                }
                {
                    const float etot = dir ? wsf[96] : wsf[96 + 31];
#pragma unroll
                    for (int t = 0; t < 4; ++t)
#pragma unroll
                        for (int e = 0; e < 16; ++e) ST[t][e] *= etot;
#pragma unroll
                    for (int s2 = 0; s2 < 2; ++s2) {
                        const LAS unsigned char* xp = F.lds + offTrX + (16 * s2) * SC_RS + hl * (8 * SC_RS);
                        const s16x4 lo = vtr(xp), hi = vtr(xp + 4 * SC_RS);
                        const f32x4 w0 = *(const LAS f32x4*)(wsf + 64 + 16 * s2 + 8 * hl), w1 = *(const LAS f32x4*)(wsf + 64 + 16 * s2 + 8 * hl + 4);
                        u32x4 xw; xw.x = cvtpk(bf1((bf16_t)lo[0]) * w0.x, bf1((bf16_t)lo[1]) * w0.y); xw.y = cvtpk(bf1((bf16_t)lo[2]) * w0.z, bf1((bf16_t)lo[3]) * w0.w);
                        xw.z = cvtpk(bf1((bf16_t)hi[0]) * w1.x, bf1((bf16_t)hi[1]) * w1.y); xw.w = cvtpk(bf1((bf16_t)hi[2]) * w1.z, bf1((bf16_t)hi[3]) * w1.w);
                        const bf16x8 xb8 = __builtin_bit_cast(bf16x8, xw);
#pragma unroll
                        for (int t = 0; t < 4; ++t) {
                            const LAS unsigned char* bp = F.lds + offTrB + (16 * s2) * SC_RS + hl * (8 * SC_RS) + 64 * t;
                            const s16x4 blo = vtr(bp), bhi = vtr(bp + 4 * SC_RS);
                            ST[t] = MFMA32(((bf16x8){blo[0], blo[1], blo[2], blo[3], bhi[0], bhi[1], bhi[2], bhi[3]}), xb8, ST[t]);
                        }
                    }
                }
                LAS bf16_t* ys = (LAS bf16_t*)(F.lds + SC_YS + dir * 8192) + ysoff;
#pragma unroll
                for (int e = 0; e < 16; e += 2) { const unsigned w = cvtpk(ya[e], ya[e + 1]); ys[((e & 3) + 8 * (e >> 2)) * 128] = (bf16_t)w; ys[((e & 3) + 1 + 8 * (e >> 2)) * 128] = (bf16_t)(w >> 16); }
            }
                  }
        }
        VM_WAIT(); __syncthreads();
        SC_WRITEOUT(135);
#undef SC_PF
#undef SC_DTLOAD
#undef SC_WRITEOUT
        __syncthreads();
    }
}

__device__ __forceinline__ void attn_phase(Frame& F, const Args& A, int ja, bool need_ctx, int nwg) {
    phase_enter(F);
    const bf16_t* Q = (const bf16_t*)(F.ws + WS_BIG); bf16_t* O = (bf16_t*)F.out;     const bf16_t* Kb = (const bf16_t*)(F.ws + WS_BIG + BIG_K); const bf16_t* Vb = (const bf16_t*)(F.ws + WS_BIG + BIG_V);
    LAS unsigned char* Kl = F.lds; LAS unsigned char* Vl = F.lds + 9216;
    const int nunits = 2048 + (need_ctx ? 128 : 0);
    const int lane = F.lane, r = F.wave >> 1, rh = F.wave & 1, c31 = lane & 31, hl = lane >> 5;
    const int prow = F.tid >> 3, ppc = F.tid & 7;
    const int trq = (lane & 15) >> 2, trp = lane & 3, trb = (lane >> 4) & 1;
    for (int unit = blockIdx.x; unit < nunits; unit += nwg) {
        int b, g, nblk; bool cq;
        if (unit < 2048) { b = unit >> 7; nblk = (unit >> 2) & 31; g = unit & 3; cq = false; } else { const int u2 = unit - 2048; b = u2 >> 3; nblk = (u2 >> 2) & 1; g = u2 & 3; cq = true; }
        const int qrow0 = b * SROW + (cq ? 128 * nblk : NCTX + 128 * nblk);
        const int start = 128 * nblk;
        bf16x8 qf[2][4];
#pragma unroll
        for (int qb = 0; qb < 2; ++qb)
#pragma unroll
            for (int s = 0; s < 4; ++s) qf[qb][s] = *(const bf16x8*)(Q + (size_t)(qrow0 + 64 * rh + 32 * qb + c31) * QW + g * 256 + r * 64 + 16 * s + 8 * hl);
        const float sink = A.attn_sink[ja * 16 + g * 4 + r] * 1.4426950408889634f;
        float mrun[2] = {sink, sink}, lrun[2] = {1.f, 1.f};
        f32x16 ot[2][2];
#pragma unroll
        for (int db = 0; db < 2; ++db)
#pragma unroll
            for (int qb = 0; qb < 2; ++qb)
#pragma unroll
                for (int e = 0; e < 16; ++e) ot[db][qb][e] = 0.f;
        const int tt_lo = cq ? 0 : (nblk == 0 ? 2 : 0), tt_hi = cq ? 0 : (nblk == 31 ? 4 : 6);
        const int ntile = 4 + (tt_hi - tt_lo);
#define TILE_ROW0(t) ((t) < 4 ? b * SROW + 64 * (t) : b * SROW + NCTX + start - 128 + 64 * (tt_lo + (t) - 4))
        u32x4 kreg, vreg;
        { const int r0 = TILE_ROW0(0); kreg = *(const u32x4*)(Kb + (size_t)(r0 + prow) * KVW + g * 64 + ppc * 8); vreg = *(const u32x4*)(Vb + (size_t)(r0 + prow) * KVW + g * 64 + ppc * 8); }
        for (int t = 0; t < ntile; ++t) {
            __syncthreads();
            *(LAS u32x4*)(Kl + prow * 144 + ppc * 16) = kreg; *(LAS u32x4*)(Vl + prow * 144 + ppc * 16) = vreg;
            __syncthreads();
            if (t + 1 < ntile) { const int r0 = TILE_ROW0(t + 1); kreg = *(const u32x4*)(Kb + (size_t)(r0 + prow) * KVW + g * 64 + ppc * 8); vreg = *(const u32x4*)(Vb + (size_t)(r0 + prow) * KVW + g * 64 + ppc * 8); }
            const int dk0 = (t >= 4) ? (-128 + 64 * (tt_lo + t - 4)) - 64 * rh : 0;
            const bool tile_empty = (t >= 4) && (dk0 <= -192 || dk0 >= 192);
            const bool tile_mask = (t >= 4) && !tile_empty && (dk0 < -65 || dk0 > 65);
            if (!tile_empty) {
            f32x16 st[2][2];
#pragma unroll
            for (int kb = 0; kb < 2; ++kb) {
#pragma unroll
                for (int qb = 0; qb < 2; ++qb)
#pragma unroll
                    for (int e = 0; e < 16; ++e) st[kb][qb][e] = 0.f;
#pragma unroll
                for (int s = 0; s < 4; ++s) { const bf16x8 a = *(const LAS bf16x8*)(Kl + (32 * kb + c31) * 144 + (16 * s + 8 * hl) * 2);
                    st[kb][0] = MFMA32(a, qf[0][s], st[kb][0]); st[kb][1] = MFMA32(a, qf[1][s], st[kb][1]); }
            }
            if (tile_mask) { const int kpos0 = start - 128 + 64 * (tt_lo + t - 4);
#pragma unroll
                for (int kb = 0; kb < 2; ++kb)
#pragma unroll
                    for (int qb = 0; qb < 2; ++qb) { const int qpos = start + 64 * rh + 32 * qb + c31;
#pragma unroll
                        for (int e = 0; e < 16; ++e) { const int d = qpos - (kpos0 + 32 * kb + crow(e, hl)); if (d > 128 || d < -128) st[kb][qb][e] = -INFINITY; } }
            }
#pragma unroll
            for (int qb = 0; qb < 2; ++qb) {
                float mx = st[0][qb][0];
#pragma unroll
                for (int kb = 0; kb < 2; ++kb)
#pragma unroll
                    for (int e = 0; e < 16; ++e) mx = fmaxf(mx, st[kb][qb][e]);
                mx = fmaxf(mx, shx(mx, 32, lane));
                const float mn = fmaxf(mrun[qb], mx);
                const bool grew = mn > mrun[qb];
                float rs = 0.f;
#pragma unroll
                for (int kb = 0; kb < 2; ++kb)
#pragma unroll
                    for (int e = 0; e < 16; ++e) { const float pv = __builtin_amdgcn_exp2f(st[kb][qb][e] - mn); st[kb][qb][e] = pv; rs += pv; }
                rs += shx(rs, 32, lane);
                if (__any(grew)) {
                    const float alpha = __builtin_amdgcn_exp2f(mrun[qb] - mn);
                    lrun[qb] = lrun[qb] * alpha + rs;
#pragma unroll
                    for (int db = 0; db < 2; ++db)
#pragma unroll
                        for (int e = 0; e < 16; ++e) ot[db][qb][e] *= alpha;
                } else lrun[qb] += rs;
                mrun[qb] = mn;
            }
#pragma unroll
            for (int kb = 0; kb < 2; ++kb)
#pragma unroll
                for (int s2 = 0; s2 < 2; ++s2) {
                    bf16x8 pk[2];
#pragma unroll
                    for (int qb = 0; qb < 2; ++qb) { u32x4 w; w.x = cvtpk(st[kb][qb][8 * s2 + 0], st[kb][qb][8 * s2 + 1]); w.y = cvtpk(st[kb][qb][8 * s2 + 2], st[kb][qb][8 * s2 + 3]);
                        w.z = cvtpk(st[kb][qb][8 * s2 + 4], st[kb][qb][8 * s2 + 5]); w.w = cvtpk(st[kb][qb][8 * s2 + 6], st[kb][qb][8 * s2 + 7]); pk[qb] = __builtin_bit_cast(bf16x8, w); }
#pragma unroll
                    for (int db = 0; db < 2; ++db) {
                        const LAS unsigned char* vp = Vl + (32 * kb + 16 * s2 + 4 * hl + trq) * 144 + (32 * db + 16 * trb + 4 * trp) * 2;
                        const s16x4 lo = vtr(vp), hi = vtr(vp + 8 * 144);
                        const bf16x8 va = (bf16x8){lo[0], lo[1], lo[2], lo[3], hi[0], hi[1], hi[2], hi[3]};
                        ot[db][0] = MFMA32(va, pk[0], ot[db][0]); ot[db][1] = MFMA32(va, pk[1], ot[db][1]);
                    }
                }
            }
        }
#undef TILE_ROW0
#pragma unroll
        for (int qb = 0; qb < 2; ++qb) { const float inv = 1.0f / lrun[qb]; bf16_t* op = O + (size_t)(qrow0 + 64 * rh + 32 * qb + c31) * QW + g * 256 + r * 64;
#pragma unroll
            for (int db = 0; db < 2; ++db)
#pragma unroll
                for (int gq = 0; gq < 4; ++gq) { u32x2 w; w.x = cvtpk(ot[db][qb][4 * gq] * inv, ot[db][qb][4 * gq + 1] * inv); w.y = cvtpk(ot[db][qb][4 * gq + 2] * inv, ot[db][qb][4 * gq + 3] * inv);
                    *(u32x2*)(op + 32 * db + 8 * gq + 4 * hl) = w; } }
    }
    __syncthreads();
}


#ifndef PHMASK
#define PHMASK 0xFFFF
#endif
#define PHON(k) (((PHMASK) >> (k)) & 1)
#ifndef REPMASK
#define REPMASK 0x0
#endif
#define REP(k) (((REPMASK) >> (k)) & 1)
#ifndef MK_PER_PHASE
#define MK_PER_PHASE 0
#endif
#ifndef TIMER_LO
#define TIMER_LO 999
#define TIMER_HI 999
#endif
#define TIMER_ON (TIMER_LO < 999)
#define IN(k) (lo <= (k) && (k) < hi)
#define SEAM(k) do { if (IN(k) && IN((k) + 1)) { xcd_barrier(bar); } if (TIMER_ON) { const unsigned long long now_ = __builtin_amdgcn_s_memrealtime(); if ((k) >= TIMER_LO && (k) <= TIMER_HI) TM.acc += now_ - TM.prev; TM.prev = now_; } } while (0)
#define SITE_PTRS phase_enter(F); unsigned char* ws = F.ws; bf16_t* H = (bf16_t*)F.out; bf16_t* BIG = (bf16_t*)(ws + WS_BIG); const float* MODV = (const float*)(ws + WS_MODV); (void)H; (void)BIG; (void)MODV; \
        unsigned char* wss = ws + WS_W + (size_t)lp * W_SSD_STRIDE; unsigned char* wsa = ws + WS_W + W_ATT0 + (size_t)lp * W_ATT_STRIDE; (void)wss; (void)wsa;
struct Timer { unsigned long long prev, acc; };
template <int lp, int c> __device__ __forceinline__ void moe_chunk(Frame& F, const Args& A, const int lo, const int hi, const XcdBarrier& bar, LAS unsigned char* ring, Timer& TM) {
    constexpr int pb = 1 + lp * 20;
            const int pu = pb + 14 + 2 * c, pd = pu + 1;
            if (IN(pu) || IN(pd)) {
                SITE_PTRS
                MoeOrder mo;
                mo.pp[0] = 0;
#pragma unroll
                for (int e = 0; e < 8; ++e) { const int cn = __builtin_amdgcn_readfirstlane((int)__hip_atomic_load((unsigned*)(F.ctl + CW_CNT + (size_t)(lp * 8 + e) * 64), RLX_AGENT)); mo.cnt[e] = cn; mo.pp[e + 1] = mo.pp[e] + ((cn + 255) >> 8); }
                const int Ptot = mo.pp[8]; int nP = Ptot - c * MOE_CHUNK; nP = nP < 0 ? 0 : (nP > MOE_CHUNK ? MOE_CHUNK : nP);
                mo.cs = c * MOE_CHUNK; mo.rlist = (const int*)(ws + WS_RLIST);
                if (PHON(10) && IN(pu)) { mo.so.init(nP, 2 * DFFE / 256, F.G, (int)blockIdx.x); mo.GATHER_A = true; mo.bstride = (size_t)2 * DFFE * 1024 * 2;
                    pg8::Gemm g{H, (const bf16_t*)(ws + WS_BIG + BIG_MW13), 1024, 1024}; EpiSwiglu E{BIG, DFFE}; pg8::gemm_phase<EpiSwiglu, MoeOrder, true, true>(ring, g, mo, E, F.wave0); }
                SEAM(pu);
                if (PHON(11) && IN(pd)) { mo.so.init(nP, 4, F.G, (int)blockIdx.x); mo.GATHER_A = false; mo.bstride = (size_t)1024 * DFFE * 2;
                    pg8::Gemm g{BIG, (const bf16_t*)(ws + WS_BIG + BIG_MW2), DFFE, DFFE}; EpiMoeDown E{mo, (bf16_t*)(ws + WS_Y), (const float*)(ws + WS_GATE)}; pg8::gemm_phase<EpiMoeDown, MoeOrder, true, false>(ring, g, mo, E, F.wave0); }
            }
            SEAM(pd);
        }
template <int lp> __device__ __forceinline__ void layer_pair(Frame& F, const Args& A, const int lo, const int hi, const XcdBarrier& bar, LAS unsigned char* ring, Timer& TM) {
        const int pb = 1 + lp * 20, i0 = 2 * lp, i1 = 2 * lp + 1;
        if (PHON(1) && IN(pb + 0)) norm_phase(F, A, i0, 0, lp == 0 ? 1 : 2);
        SEAM(pb + 0);
        if (PHON(2) && IN(pb + 1)) { SITE_PTRS pg8::Gemm g{H, (const bf16_t*)(wss + W_WIN), 1024, 1024}; pg8::StaticOrder S; S.init(NPAN, NXBC / 256, F.G, (int)blockIdx.x);
            EpiXbc E{BIG, (float*)(ws + WS_DT), (bf16_t*)(ws + WS_HALO)}; pg8::gemm_phase<EpiXbc, pg8::StaticOrder, true, false>(ring, g, S, E, F.wave0); }
        SEAM(pb + 1);
        if (PHON(3) && IN(pb + 2)) conv_phase(F, A, lp);
        SEAM(pb + 2);
        if (PHON(3) && IN(pb + 3)) scan_phase<0>(F, A, lp);
        SEAM(pb + 3);
        if (PHON(4) && IN(pb + 4)) { SITE_PTRS pg8::Gemm g{H, (const bf16_t*)(wss + W_WZ), 1024, 1024}; pg8::StaticOrder S; S.init(NPAN, DIN / 256, F.G, (int)blockIdx.x);
            EpiGate E{(const bf16_t*)(ws + WS_Y), BIG, A.ssd_norm_w + (size_t)lp * DIN, (LAS float*)(F.lds + PSCR_OFF)}; pg8::gemm_phase<EpiGate, pg8::StaticOrder, true, false>(ring, g, S, E, F.wave0); }
        SEAM(pb + 4);
        if (PHON(5) && IN(pb + 5)) { SITE_PTRS pg8::Gemm g{BIG, (const bf16_t*)(wss + W_WOUT), DIN, DIN}; pg8::PanelOrder S; S.init(NPAN, 4, F.G, (int)blockIdx.x);
            EpiResidNorm E{(bf16_t*)(ws + WS_XR), MODV + (size_t)i0 * 17 * 6144, 2, nullptr, lp == 0 ? A.x : nullptr, lp == 0 ? A.ctx : nullptr,
                           H, A.norm2_w + i0 * 1024, MODV + (size_t)i0 * 17 * 6144, 3, (unsigned*)(ws + WS_XCH), (unsigned*)(F.ctl + CW_PAN + (size_t)(lp * 2 + 0) * NPAN * 64), (unsigned*)(F.ctl + CW_BAR) + XB_TMO, F.lds + PSCR_OFF};
            pg8::gemm_phase<EpiResidNorm, pg8::PanelOrder, true, false>(ring, g, S, E, F.wave0); }
        SEAM(pb + 6);
        if (PHON(6) && IN(pb + 7)) { SITE_PTRS pg8::Gemm g{H, (const bf16_t*)(wss + W_WUP), 1024, 1024}; pg8::StaticOrder S; S.init(NPAN, 2 * DFF / 256, F.G, (int)blockIdx.x);
            EpiSwiglu E{BIG, DFF}; pg8::gemm_phase<EpiSwiglu, pg8::StaticOrder, true, false>(ring, g, S, E, F.wave0); }
        SEAM(pb + 7);
        if (PHON(5) && IN(pb + 8)) { SITE_PTRS pg8::Gemm g{BIG, (const bf16_t*)(wss + W_WDN), DFF, DFF}; pg8::PanelOrder S; S.init(NPAN, 4, F.G, (int)blockIdx.x);
            EpiResidNorm E{(bf16_t*)(ws + WS_XR), MODV + (size_t)i0 * 17 * 6144, 5, nullptr, nullptr, nullptr,
                           H, A.norm1_w + i1 * 1024, MODV + (size_t)i1 * 17 * 6144, 0, (unsigned*)(ws + WS_XCH), (unsigned*)(F.ctl + CW_PAN + (size_t)(lp * 2 + 1) * NPAN * 64), (unsigned*)(F.ctl + CW_BAR) + XB_TMO, F.lds + PSCR_OFF};
            pg8::gemm_phase<EpiResidNorm, pg8::PanelOrder, true, false>(ring, g, S, E, F.wave0); }
        SEAM(pb + 9);
        if (PHON(7) && IN(pb + 10)) { SITE_PTRS pg8::Gemm g{H, (const bf16_t*)(wsa + W_WQKV), 1024, 1024}; pg8::StaticOrder S; S.init(NPAN, NQKV / 256, F.G, (int)blockIdx.x);
            LAS float* qt = (LAS float*)(F.lds + PSCR_OFF);
            { const float* rp = (const float*)(ws + WS_ROPE); const float* bq = A.attn_b_qkv + (size_t)lp * NQKV; for (int idx = F.tid; idx < 3584; idx += 512) qt[idx] = idx < 2048 ? rp[idx] : bq[idx - 2048]; }
            __syncthreads();
            EpiQkv E{BIG, (bf16_t*)(ws + WS_BIG + BIG_K), (bf16_t*)(ws + WS_BIG + BIG_V), qt};
            pg8::gemm_phase<EpiQkv, pg8::StaticOrder, true, false>(ring, g, S, E, F.wave0); }
        SEAM(pb + 10);
        if (PHON(8) && IN(pb + 11)) { const int nconv = F.G >= 9996 ? 48 : 0;
            if ((int)blockIdx.x < F.G - nconv) attn_phase(F, A, lp, lp == 0, F.G - nconv); else moe_convert(F, A, lp, F.G - nconv, nconv); }
        SEAM(pb + 11);
        if (PHON(5) && IN(pb + 12)) { SITE_PTRS pg8::Gemm g{H, (const bf16_t*)(wsa + W_WO), 1024, 1024};
            EpiResid E{(bf16_t*)(ws + WS_XR), MODV + (size_t)i1 * 17 * 6144, 2, A.attn_b_o + (size_t)lp * 1024, nullptr, nullptr};
            if (lp == 1) { pg8::LatentOrder S; S.init(NPAN - NB, 4, F.G, (int)blockIdx.x); pg8::gemm_phase<EpiResid, pg8::LatentOrder, true, false>(ring, g, S, E, F.wave0); }
            else { pg8::StaticOrder S; S.init(NPAN, 4, F.G, (int)blockIdx.x); pg8::gemm_phase<EpiResid, pg8::StaticOrder, true, false>(ring, g, S, E, F.wave0); } }
        SEAM(pb + 12);
        if (PHON(9) && IN(pb + 13)) { norm_phase(F, A, i1, 1, 4 | (lp == 1 ? 16 : 0)); if (F.G < 9996) { __syncthreads(); moe_convert(F, A, lp, 0, F.G); } }
        SEAM(pb + 13);
    moe_chunk<lp, 0>(F, A, lo, hi, bar, ring, TM); moe_chunk<lp, 1>(F, A, lo, hi, bar, ring, TM); moe_chunk<lp, 2>(F, A, lo, hi, bar, ring, TM);
}
constexpr int N_PHASES = 42;
__global__ void __launch_bounds__(NWAVES * 64, 2) fwd_kernel(Args A) {
    extern __shared__ __attribute__((aligned(16))) unsigned char lds_raw[];
    Frame F;
    F.lds = (LAS unsigned char*)lds_raw;
    F.tid = threadIdx.x; F.lane = F.tid & 63; F.wave = __builtin_amdgcn_readfirstlane(F.tid >> 6); F.wave0 = F.wave; F.G = gridDim.x;
    F.ws0 = A.ws; F.out0 = A.out; F.ws = A.ws; F.ctl = (gu32*)(A.ws + WS_CTL); F.out = A.out;
    volatile LAS unsigned* MISC = (volatile LAS unsigned*)(F.lds + MISC_OFF);
    for (int u = F.tid; u < (LDS_BYTES - LDSCTL_OFF) / 4; u += NWAVES * 64) ((LAS unsigned*)(F.lds + LDSCTL_OFF))[u] = 0u;
    __syncthreads();
    const int lo = A.ph_lo, hi = A.ph_hi;
    XcdBarrier bar; bar.bar = (unsigned*)(F.ctl + CW_BAR); bar.x = 0; bar.st = MISC + 8; bar.wave0 = F.wave0;
    if (hi - lo > 1) bar = xcd_barrier_post((unsigned*)(F.ctl + CW_BAR), MISC + 8, F.wave0);
    LAS unsigned char* ring = F.lds;

    Timer TM; TM.prev = TIMER_ON ? __builtin_amdgcn_s_memrealtime() : 0ull; TM.acc = 0ull;
    if (PHON(0) && IN(0)) { p0_prologue(F, A); }
    SEAM(0);
    layer_pair<0>(F, A, lo, hi, bar, ring, TM);
    layer_pair<1>(F, A, lo, hi, bar, ring, TM);
    if (PHON(1) && IN(41)) {
        norm_phase(F, A, 4, 0, 2 | 8);
        if (xb_ld((unsigned*)(F.ctl + CW_BAR) + XB_TMO) != 0u) {
            const float qn = __builtin_nanf("");
            for (size_t idx = (size_t)blockIdx.x * 512 + F.tid; idx < (size_t)NB * SEQ * DM / 4; idx += (size_t)F.G * 512) ((f32x4*)A.out)[idx] = (f32x4){qn, qn, qn, qn};
        }
    }
    if (TIMER_ON) { const unsigned long long now_ = __builtin_amdgcn_s_memrealtime(); if (41 >= TIMER_LO && 41 <= TIMER_HI) TM.acc += now_ - TM.prev;
        if (blockIdx.x == 0) { const unsigned long long tgt = now_ + TM.acc; while (__builtin_amdgcn_s_memrealtime() < tgt) __builtin_amdgcn_s_sleep(8); } }
#undef IN
#undef SEAM
}

extern "C" void kernel_launch(void* const* d_in, const int* in_sizes, int n_in, void* d_out, int out_size, void* d_ws, size_t ws_size, hipStream_t stream) {
    static int grid = 0;
    if (grid == 0) {
        if (n_in != 29 || in_sizes[0] != NB * SEQ * DM || out_size != NB * SEQ * DM || ws_size < WS_END) {
            fprintf(stderr, "kernel_launch: unexpected problem: n_in %d, in0 %d, out %d, ws %zu (need %zu); nothing launched\n", n_in, n_in > 0 ? in_sizes[0] : -1, out_size, ws_size, (size_t)WS_END); grid = -1; return; }
        int dev = 0, cus = 0, per_cu = 0;
        if (hipGetDevice(&dev) != hipSuccess || hipDeviceGetAttribute(&cus, hipDeviceAttributeMultiprocessorCount, dev) != hipSuccess) { fprintf(stderr, "kernel_launch: device query failed\n"); grid = -1; return; }
        if (hipFuncSetAttribute((const void*)fwd_kernel, hipFuncAttributeMaxDynamicSharedMemorySize, LDS_BYTES) != hipSuccess) { fprintf(stderr, "kernel_launch: hipFuncSetAttribute failed\n"); grid = -1; return; }
        if (hipOccupancyMaxActiveBlocksPerMultiprocessor(&per_cu, (const void*)fwd_kernel, NWAVES * 64, LDS_BYTES) != hipSuccess || per_cu < 1)
            fprintf(stderr, "kernel_launch: note: occupancy query reports %d workgroups per CU\n", per_cu);
        (void)hipGetLastError();
        grid = cus;
    }
    if (grid < 0) return;
    if (hipMemsetAsync((char*)d_ws + WS_CTL, 0, CTL_ZERO_BYTES, stream) != hipSuccess) { fprintf(stderr, "kernel_launch: memset failed\n"); return; }
    Args a{};
    const float** ap = (const float**)&a;
    for (int i = 0; i < 29; ++i) ap[i] = (const float*)d_in[i];
    a.out = (float*)d_out; a.ws = (unsigned char*)d_ws;
#if MK_PER_PHASE
    for (int k = 0; k < N_PHASES; ++k) { a.ph_lo = k; a.ph_hi = k + 1; hipLaunchKernelGGL(fwd_kernel, dim3(grid), dim3(NWAVES * 64), LDS_BYTES, stream, a); }
#else
    a.ph_lo = 0; a.ph_hi = N_PHASES;
    hipLaunchKernelGGL(fwd_kernel, dim3(grid), dim3(NWAVES * 64), LDS_BYTES, stream, a);
#endif
    const hipError_t le = hipPeekAtLastError();
    if (le != hipSuccess) fprintf(stderr, "kernel_launch: launch failed: %s\n", hipGetErrorName(le));
}
```

```cpp
#include <hip/hip_runtime.h>
#include <cstdio>
#include <cstdint>

#define LAS __attribute__((address_space(3)))
#define GAS __attribute__((address_space(1)))
typedef unsigned short bf16_t;
typedef short bf16x8 __attribute__((ext_vector_type(8)));
typedef short s16x4 __attribute__((ext_vector_type(4)));
typedef float f32x4 __attribute__((ext_vector_type(4)));
typedef float f32x2 __attribute__((ext_vector_type(2)));
typedef float f32x16 __attribute__((ext_vector_type(16)));
typedef unsigned u32x4 __attribute__((ext_vector_type(4)));
typedef unsigned u32x2 __attribute__((ext_vector_type(2)));
typedef GAS unsigned gu32;

namespace pg8 {
constexpr int BM = 256, BK = 64, HALF = 128, HTB = HALF * BK * 2  , STAGE_BYTES = 8 * HTB, NXCD = 8, WGM = 8;

__host__ __device__ __forceinline__ int lds_byte(int r, int c) { const int st = (r >> 4) * 2 + (c >> 5), rr = r & 15, cc = c & 31, ob = rr * 64 + cc * 2; return st * 1024 + (ob ^ (((ob >> 9) & 1) << 5)); }
__host__ __device__ __forceinline__ void stage_rc(int b, int& R, int& C) { const int st = b / 1024, sb = b % 1024, swz = sb ^ (((sb >> 9) & 1) << 5); R = (st >> 1) * 16 + swz / 64; C = (st & 1) * 32 + (swz % 64) / 2; }
__host__ __device__ __forceinline__ int perm32(int rho) { const int n = rho >> 4, i = rho & 15; return 8 * (i >> 2) + 4 * n + (i & 3); }

struct Unit { int pm, pn; };
struct Gemm { const bf16_t* A; const bf16_t* Bt; int lda, K, ldb; };

struct StaticOrder {
    int nM, nN, nwg, G, c;
    __device__ void init(int nM_, int nN_, int G_, int c_) { nM = nM_; nN = nN_; nwg = nM * nN; G = G_; c = c_; }
    __device__ bool next(int i, Unit& u) const {
        const long L = (long)i * G + c; if (L >= nwg) return false;
        int wgid = (int)L; { const int q = nwg / NXCD, r = nwg % NXCD, xcd = wgid % NXCD, off = wgid / NXCD; wgid = (xcd < r ? xcd * (q + 1) : r * (q + 1) + (xcd - r) * q) + off; }
        const int nig = WGM * nN, gid = wgid / nig, fm = gid * WGM, gsz = (nM - fm) < WGM ? (nM - fm) : WGM;
        u.pm = fm + ((wgid % nig) % gsz); u.pn = (wgid % nig) / gsz; return true;
    }
    __device__ __forceinline__ const char* a_base(const Gemm& g, const Unit& u) const { return (const char*)g.A + (size_t)u.pm * (size_t)(BM * 2) * g.lda; }
    __device__ __forceinline__ const char* b_base(const Gemm& g, const Unit& u) const { return (const char*)g.Bt + (size_t)u.pn * (size_t)(BM * 2) * g.K; }
    __device__ __forceinline__ unsigned row_off(const Gemm& g, const Unit&, int r) const { return (unsigned)r * (unsigned)g.lda * 2u; }
};

struct LatentOrder : StaticOrder {
    __device__ bool next(int i, Unit& u) const { if (!StaticOrder::next(i, u)) return false; u.pm = u.pm + (u.pm >> 4) + 1; return true; }
};

struct PanelOrder : StaticOrder {
    __device__ bool next(int i, Unit& u) const { const int x = c & 7, s = c >> 3, per = G >> 5; const int panel = (i * 8 + x) * per + (s >> 2);
        if (panel >= nM) return false; u.pm = panel; u.pn = s & 3; return true; }
};

struct TailOrder {
    int c, pm0; unsigned koff;
    __device__ bool next(int i, Unit& u) const { if (i) return false; const int x = c & 7, s = c >> 3; u.pm = pm0 + x * 2 + (s >> 4); u.pn = (s >> 2) & 3; return true; }
    __device__ __forceinline__ const char* a_base(const Gemm& g, const Unit& u) const { return (const char*)g.A + (size_t)u.pm * (size_t)(BM * 2) * g.lda + koff; }
    __device__ __forceinline__ const char* b_base(const Gemm& g, const Unit& u) const { return (const char*)g.Bt + (size_t)u.pn * (size_t)(BM * 2) * g.ldb + koff; }
    __device__ __forceinline__ unsigned row_off(const Gemm& g, const Unit&, int r) const { return (unsigned)r * (unsigned)g.lda * 2u; }
};

__device__ __forceinline__ unsigned cvt_pk_bf16(float lo, float hi) { unsigned r; asm volatile("v_cvt_pk_bf16_f32 %0, %1, %2" : "=v"(r) : "v"(lo), "v"(hi)); return r; }

template <class Epi, class Sched, bool ALIGN_EPI, bool GATHER>
__device__ __forceinline__ void gemm_phase(LAS unsigned char* lds, const Gemm g, const Sched& S, const Epi& E, const int wave0, const unsigned delay_ticks = 0u) {
    if (delay_ticks) { const unsigned long long t0_ = __builtin_amdgcn_s_memrealtime(); while (__builtin_amdgcn_s_memrealtime() - t0_ < (unsigned long long)delay_ticks) __builtin_amdgcn_s_sleep(16); }
    int tid_ = wave0 * 64 + (int)__builtin_amdgcn_mbcnt_hi(~0u, __builtin_amdgcn_mbcnt_lo(~0u, 0u)); asm volatile("" : "+v"(tid_));
    const int tid = tid_, wid = __builtin_amdgcn_readfirstlane(tid >> 6), lane = tid & 63, wr = wid >> 2, wc = wid & 3, fr = lane & 15, fq = lane >> 4;
    const int K = g.K, nt = K / BK, LDB = g.ldb ? g.ldb : g.K;
    unsigned voffB[2];
#pragma unroll
    for (int i = 0; i < 2; ++i) { int R, C; stage_rc(tid * 16 + i * 8192, R, C); const int Rb = Epi::PERM ? ((R & ~31) + perm32(R & 31)) : R; voffB[i] = (unsigned)(Rb * LDB + C) * 2u; }
    const size_t kstep = (size_t)(BK * 2);
    const size_t hstepB = (size_t)HALF * LDB * 2;
    const unsigned ldsw = (unsigned)wid * 1024u;
    const int aoff = lds_byte(wr * 64 + fr, fq * 8), boff = lds_byte(wc * 32 + fr, fq * 8);
#define PG8_SA(b, h) (((b) * 2 + (h)) * HTB)
#define PG8_SB(b, h) ((4 + (b) * 2 + (h)) * HTB)
#define PG8_STAGE(bufoff, gbase, voff) do { _Pragma("unroll") for (int _i = 0; _i < 2; ++_i) \
        __builtin_amdgcn_global_load_lds((const unsigned*)((const char*)(gbase) + (voff)[_i]), (LAS unsigned*)(lds + (bufoff) + ldsw + _i * 8192), 16, 0, 0); } while (0)
#define PG8_LDA(dst, b, h) do { _Pragma("unroll") for (int m = 0; m < 4; ++m) _Pragma("unroll") for (int k = 0; k < 2; ++k) dst[m][k] = *(const LAS bf16x8*)(lds + PG8_SA(b, h) + aoff + m * 2048 + k * 1024); } while (0)
#define PG8_LDB(dst, b, h) do { _Pragma("unroll") for (int n = 0; n < 2; ++n) _Pragma("unroll") for (int k = 0; k < 2; ++k) dst[n][k] = *(const LAS bf16x8*)(lds + PG8_SB(b, h) + boff + n * 2048 + k * 1024); } while (0)
#define PG8_MMA(ai, bj, At, Bt) do { __builtin_amdgcn_s_setprio(1); _Pragma("unroll") for (int m = 0; m < 4; ++m) _Pragma("unroll") for (int n = 0; n < 2; ++n) _Pragma("unroll") for (int k = 0; k < 2; ++k) \
        acc[ai][bj][m][n] = __builtin_amdgcn_mfma_f32_16x16x32_bf16(Bt[n][k], At[m][k], acc[ai][bj][m][n], 0, 0, 0); __builtin_amdgcn_s_setprio(0); } while (0)
#define PG8_WAIT_V(n) asm volatile("s_waitcnt vmcnt(" #n ")" ::: "memory")
#define PG8_WAIT_L(n) asm volatile("s_waitcnt lgkmcnt(" #n ")" ::: "memory")
#define PG8_BAR __builtin_amdgcn_s_barrier()
#define PG8_SCHED __builtin_amdgcn_sched_barrier(0)
    Unit cur, nxt; int ui = 0;
    if (!S.next(0, cur)) return;
    f32x4 acc[2][2][4][2];
#pragma unroll
    for (int a = 0; a < 2; ++a)
#pragma unroll
        for (int b = 0; b < 2; ++b)
#pragma unroll
            for (int m = 0; m < 4; ++m)
#pragma unroll
                for (int n = 0; n < 2; ++n) acc[a][b][m][n] = (f32x4){0.f, 0.f, 0.f, 0.f};
    bf16x8 At[4][2], B0[2][2], B1[2][2];
    const char* cA = S.a_base(g, cur); const char* cB = S.b_base(g, cur);
    unsigned va[2][2], vn[2][2];
#pragma unroll
    for (int h = 0; h < 2; ++h)
#pragma unroll
        for (int i = 0; i < 2; ++i) { int R, C; stage_rc(tid * 16 + i * 8192, R, C); va[h][i] = S.row_off(g, cur, h * HALF + R) + (unsigned)C * 2u; vn[h][i] = va[h][i]; }
    PG8_STAGE(PG8_SB(0, 0), cB, voffB); PG8_STAGE(PG8_SB(0, 1), cB + hstepB, voffB); PG8_STAGE(PG8_SA(0, 0), cA, va[0]); PG8_STAGE(PG8_SA(0, 1), cA, va[1]);
    if (wr == 1) PG8_BAR;
    PG8_WAIT_V(2); PG8_BAR;
    PG8_STAGE(PG8_SB(1, 0), cB + kstep, voffB); PG8_STAGE(PG8_SA(1, 0), cA + kstep, va[0]); PG8_STAGE(PG8_SB(1, 1), cB + hstepB + kstep, voffB);
    PG8_WAIT_V(6); PG8_BAR;
    for (;;) {
        const bool has_next = S.next(ui + 1, nxt);
        const char* nA = has_next ? S.a_base(g, nxt) : cA; const char* nB = has_next ? S.b_base(g, nxt) : cB;
        if (GATHER) {
            if (has_next) {
#pragma unroll
                for (int h = 0; h < 2; ++h)
#pragma unroll
                    for (int i = 0; i < 2; ++i) { int R, C; stage_rc(tid * 16 + i * 8192, R, C); vn[h][i] = S.row_off(g, nxt, h * HALF + R) + (unsigned)C * 2u; }
            } else {
#pragma unroll
                for (int h = 0; h < 2; ++h)
#pragma unroll
                    for (int i = 0; i < 2; ++i) vn[h][i] = va[h][i];
            }
        }
        for (int t = 0; t < nt; t += 2) {
            const bool last = (t == nt - 2);
            const char* a1 = cA + (size_t)(t + 1) * kstep;
            const char* a2 = last ? nA : cA + (size_t)(t + 2) * kstep; const char* b2 = last ? nB : cB + (size_t)(t + 2) * kstep;
            const char* a3 = a2 + kstep; const char* b3 = b2 + kstep;
            unsigned v2[2][2];
#pragma unroll
            for (int h = 0; h < 2; ++h)
#pragma unroll
                for (int i = 0; i < 2; ++i) v2[h][i] = (GATHER && last) ? vn[h][i] : va[h][i];
            PG8_LDB(B0, 0, 0); PG8_LDB(B1, 0, 1); PG8_SCHED; PG8_LDA(At, 0, 0); PG8_STAGE(PG8_SA(1, 1), a1, va[1]);
            PG8_WAIT_V(8); PG8_WAIT_L(0); PG8_BAR; PG8_MMA(0, 0, At, B0); PG8_MMA(0, 1, At, B1); PG8_BAR; PG8_SCHED;
            PG8_LDA(At, 0, 1); PG8_STAGE(PG8_SB(0, 0), b2, voffB); PG8_STAGE(PG8_SB(0, 1), b2 + hstepB, voffB); PG8_STAGE(PG8_SA(0, 0), a2, v2[0]);
            PG8_WAIT_V(8); PG8_WAIT_L(0); PG8_BAR; PG8_MMA(1, 0, At, B0); PG8_MMA(1, 1, At, B1); PG8_BAR; PG8_SCHED;
            PG8_LDB(B0, 1, 0); PG8_LDB(B1, 1, 1); PG8_SCHED; PG8_LDA(At, 1, 0); PG8_STAGE(PG8_SA(0, 1), a2, v2[1]);
            PG8_WAIT_V(8); PG8_WAIT_L(0); PG8_BAR; PG8_MMA(0, 0, At, B0); PG8_MMA(0, 1, At, B1); PG8_BAR; PG8_SCHED;
            PG8_LDA(At, 1, 1); PG8_STAGE(PG8_SB(1, 0), b3, voffB); PG8_STAGE(PG8_SB(1, 1), b3 + hstepB, voffB); PG8_STAGE(PG8_SA(1, 0), a3, v2[0]);
            PG8_WAIT_V(8); PG8_WAIT_L(0); PG8_BAR; PG8_MMA(1, 0, At, B0); PG8_MMA(1, 1, At, B1); PG8_BAR; PG8_SCHED;
        }
        if constexpr (ALIGN_EPI) { if (wr == 0) PG8_BAR; }
        { int l2 = (int)__builtin_amdgcn_mbcnt_hi(~0u, __builtin_amdgcn_mbcnt_lo(~0u, 0u)); asm volatile("" : "+v"(l2)); E(acc, cur, wr, wc, l2 & 15, l2 >> 4); }
        if (!has_next) break;
#pragma unroll
        for (int a = 0; a < 2; ++a)
#pragma unroll
            for (int b = 0; b < 2; ++b)
#pragma unroll
                for (int m = 0; m < 4; ++m)
#pragma unroll
                    for (int n = 0; n < 2; ++n) acc[a][b][m][n] = (f32x4){0.f, 0.f, 0.f, 0.f};
        cur = nxt; cA = nA; cB = nB; ++ui;
        if (GATHER) {
#pragma unroll
            for (int h = 0; h < 2; ++h)
#pragma unroll
                for (int i = 0; i < 2; ++i) va[h][i] = vn[h][i];
        }
        if constexpr (ALIGN_EPI) { if (wr == 1) PG8_BAR; }
    }
    PG8_WAIT_V(0);
    if constexpr (!ALIGN_EPI) { if (wr == 0) PG8_BAR; }
    PG8_BAR;
#undef PG8_SA
#undef PG8_SB
#undef PG8_STAGE
#undef PG8_LDA
#undef PG8_LDB
#undef PG8_MMA
#undef PG8_WAIT_V
#undef PG8_WAIT_L
#undef PG8_BAR
#undef PG8_SCHED
}
}

constexpr int DM = 1024, NB = 16, SEQ = 4096, NCTX = 256, SROW = SEQ + NCTX  , MROWS = NB * SROW  , NPAN = MROWS / 256  ;
constexpr int DIN = 2048, CONVCH = 4096, SSD_IN = 6208, NXBC = 4352  ;
constexpr int QW = 1024, KVW = 256, NQKV = 1536;
constexpr int DFF = 2816, NEXP = 8, DFFE = 3584;
constexpr float EPS = 1e-6f;
constexpr int MOE_CHUNK = 192;
constexpr int NWAVES = 8;

constexpr size_t MiB = 1u << 20;
constexpr size_t WS_CTL = 0, CTL_ZERO_BYTES = 1 * MiB;
constexpr size_t WS_MODV = 2 * MiB;
constexpr size_t WS_ROPE = 4 * MiB;
constexpr size_t WS_GATE = 5 * MiB;
constexpr size_t WS_RLIST = 6 * MiB;
constexpr size_t WS_W = 26 * MiB;
constexpr size_t W_SSD_STRIDE = 33 * MiB, W_WZ = 0, W_WIN = 4 * MiB, W_WOUT = 12 * MiB + MiB / 2, W_WUP = 16 * MiB + MiB / 2, W_WDN = 27 * MiB + MiB / 2;
constexpr size_t W_ATT0 = 66 * MiB, W_ATT_STRIDE = 5 * MiB, W_WQKV = 0, W_WO = 3 * MiB;
constexpr size_t WS_XR = 102 * MiB;
constexpr size_t WS_BIG = 238 * MiB;
constexpr size_t BIG_K = 136 * MiB, BIG_V = 170 * MiB, BIG_O = 204 * MiB, BIG_MW13 = 336 * MiB, BIG_MW2 = 448 * MiB;
static_assert((size_t)MOE_CHUNK * 256 * DFFE * 2 <= BIG_MW13 && BIG_O + 136 * MiB <= BIG_MW13 + 200 * MiB && BIG_MW2 + 56 * MiB <= 544 * MiB, "BIG region map");
constexpr size_t WS_Y = 782 * MiB;
constexpr size_t WS_DT = 1054 * MiB;
constexpr size_t WS_HALO = 1071 * MiB;
constexpr size_t WS_XCH = 1106 * MiB;
constexpr size_t WS_END = 1108 * MiB;
constexpr int CW_BAR = 4096;
constexpr int CW_CNT = 16384;
constexpr int CW_PAN = 32768;
constexpr int CW_TAIL = 106496;
static_assert(CW_PAN + 4 * 272 * 64 <= CW_TAIL && (CW_TAIL + 6 * 64 * 8 * 16) * 4 <= (int)CTL_ZERO_BYTES, "CTL words inside the memset region");

constexpr int RING_BYTES = 131072;
constexpr int PSCR_OFF = 131072;
constexpr int LDSCTL_OFF = 151552, MISC_OFF = LDSCTL_OFF + 320;
constexpr int LDS_BYTES = 155648;

#define RLX_AGENT __ATOMIC_RELAXED, __HIP_MEMORY_SCOPE_AGENT
#define LDS_WAIT() asm volatile("s_waitcnt lgkmcnt(0)" ::: "memory")
#define VM_WAIT() asm volatile("s_waitcnt vmcnt(0)" ::: "memory")
__device__ __forceinline__ unsigned f2bf(float f) { unsigned u = __builtin_bit_cast(unsigned, f); return (u + 0x7fffu + ((u >> 16) & 1u)) >> 16; }
__device__ __forceinline__ unsigned pk2(float lo, float hi) { return f2bf(lo) | (f2bf(hi) << 16); }
__device__ __forceinline__ float bf_lo(unsigned u) { return __builtin_bit_cast(float, u << 16); }
__device__ __forceinline__ float bf_hi(unsigned u) { return __builtin_bit_cast(float, u & 0xffff0000u); }
__device__ __forceinline__ float bf1(bf16_t h) { return __builtin_bit_cast(float, (unsigned)h << 16); }
__device__ __forceinline__ float siluf(float v) { return v * __builtin_amdgcn_rcpf(1.0f + __expf(-v)); }
__device__ __forceinline__ float shx(float v, int mask, int lane) { return __builtin_bit_cast(float, __builtin_amdgcn_ds_bpermute((lane ^ mask) << 2, __builtin_bit_cast(int, v))); }
__device__ __forceinline__ float wave_sum(float v, int lane) {
    (void)lane;
    v += __builtin_bit_cast(float, __builtin_amdgcn_update_dpp(0, __builtin_bit_cast(int, v), 0x111, 0xf, 0xf, true));
    v += __builtin_bit_cast(float, __builtin_amdgcn_update_dpp(0, __builtin_bit_cast(int, v), 0x112, 0xf, 0xf, true));
    v += __builtin_bit_cast(float, __builtin_amdgcn_update_dpp(0, __builtin_bit_cast(int, v), 0x114, 0xf, 0xf, true));
    v += __builtin_bit_cast(float, __builtin_amdgcn_update_dpp(0, __builtin_bit_cast(int, v), 0x118, 0xf, 0xf, true));
    v += __builtin_bit_cast(float, __builtin_amdgcn_update_dpp(0, __builtin_bit_cast(int, v), 0x142, 0xa, 0xf, false));
    v += __builtin_bit_cast(float, __builtin_amdgcn_update_dpp(0, __builtin_bit_cast(int, v), 0x143, 0xc, 0xf, false));
    return __builtin_bit_cast(float, __builtin_amdgcn_readlane(__builtin_bit_cast(int, v), 63));
}

__device__ __forceinline__ int lane_id() { return (int)__builtin_amdgcn_mbcnt_hi(~0u, __builtin_amdgcn_mbcnt_lo(~0u, 0u)); }
#define XB_TMO      128
#define XB_XCNT(j)  (256  + 64 * (j))
#define XB_XSUB(j)  (1280 + 64 * (j))
#define XB_XGEN(j)  (2304 + 64 * (j))
#define XB_TOP      3328
#define XB_TOPGEN   3392
#define XCD_BAR_WORDS 3456
#define XB_SPIN_CAP (1u << 18)

__device__ __forceinline__ unsigned xb_ld(unsigned* p)              { return __hip_atomic_load(p, __ATOMIC_RELAXED, __HIP_MEMORY_SCOPE_AGENT); }
__device__ __forceinline__ unsigned xb_add(unsigned* p, unsigned v) { return __hip_atomic_fetch_add(p, v, __ATOMIC_RELAXED, __HIP_MEMORY_SCOPE_AGENT); }
__device__ __forceinline__ unsigned xb_xcc_id() { return (unsigned)__builtin_amdgcn_s_getreg((3 << 11) | 20) & 0xFu; }
#define XB_SPIN(cond, bar) do { unsigned _sp = 0; while (cond) { __builtin_amdgcn_s_sleep(1); \
    if ((++_sp & 255u) == 0u) { if (xb_ld(&(bar)[XB_TMO])) break; if (_sp > XB_SPIN_CAP) { atomicAdd(&(bar)[XB_TMO], 1u); break; } } } } while (0)

struct XcdBarrier {
    unsigned* bar; unsigned x;
    volatile LAS unsigned* st;
    int wave0;
};
__device__ __forceinline__ XcdBarrier xcd_barrier_post(unsigned* bar, volatile LAS unsigned* st, int wave0) {
    XcdBarrier b; b.bar = bar; b.x = xb_xcc_id(); b.st = st; b.wave0 = wave0;
    if (wave0 == 0 && lane_id() == 0) (void)xb_add(&bar[XB_XCNT(b.x)], 1u);
    return b;
}
__device__ __forceinline__ void xcd_barrier_complete(unsigned* bar, unsigned x, unsigned& nloc, unsigned& nx) {
    const unsigned G = gridDim.x * gridDim.y * gridDim.z;
    unsigned sum, cnt, mine, sp = 0u;
    for (;;) {
        sum = 0u; cnt = 0u; mine = 0u;
#pragma unroll
        for (unsigned j = 0; j < 16; ++j) { const unsigned c = xb_ld(&bar[XB_XCNT(j)]); sum += c; cnt += (c > 0u) ? 1u : 0u; mine = (j == x) ? c : mine; }
        if (sum == G) break;
        __builtin_amdgcn_s_sleep(1);
        if ((++sp & 255u) == 0u) { if (xb_ld(&bar[XB_TMO])) break; if (sp > XB_SPIN_CAP) { atomicAdd(&bar[XB_TMO], 1u); break; } }
    }
    nloc = mine > 0u ? mine : 1u; nx = cnt > 0u ? cnt : 1u;
}
__device__ __forceinline__ void xcd_barrier(const XcdBarrier& b) {
    asm volatile("s_waitcnt vmcnt(0)" ::: "memory");
    __syncthreads();
    if (b.wave0 == 0 && lane_id() == 0) {
        unsigned* bar = b.bar;
        __builtin_amdgcn_s_waitcnt(0);
        unsigned nloc = b.st[0], nx = b.st[1];
        if (nloc == 0u) { xcd_barrier_complete(bar, b.x, nloc, nx); b.st[0] = nloc; b.st[1] = nx; }
        const unsigned old = xb_add(&bar[XB_XSUB(b.x)], 1u);
        const unsigned gen = old / nloc;
        if (old + 1u == (gen + 1u) * nloc) {
            __builtin_amdgcn_fence(__ATOMIC_RELEASE, "agent");
            asm volatile("s_waitcnt vmcnt(0)" ::: "memory");
            const unsigned og = xb_add(&bar[XB_TOP], 1u);
            const unsigned tg = og / nx;
            if (og + 1u == (tg + 1u) * nx) xb_add(&bar[XB_TOPGEN], 1u);
            else XB_SPIN(xb_ld(&bar[XB_TOPGEN]) == tg, bar);
            __builtin_amdgcn_fence(__ATOMIC_ACQUIRE, "agent");
            xb_add(&bar[XB_XGEN(b.x)], 1u);
            asm volatile("s_waitcnt vmcnt(0)" ::: "memory");
        } else {
            XB_SPIN(xb_ld(&bar[XB_XGEN(b.x)]) == gen, bar);
            __builtin_amdgcn_fence(__ATOMIC_ACQUIRE, "agent");
            asm volatile("s_waitcnt vmcnt(0)" ::: "memory");
        }
    }
    __syncthreads();
}

struct Args {
    const float *x, *c, *ctx, *c_ctx, *w_mod, *b_mod, *norm1_w, *norm2_w, *ssd_w_in, *ssd_conv_w, *ssd_conv_b, *ssd_dt_bias, *ssd_a_log, *ssd_d, *ssd_norm_w, *ssd_w_out,
                *attn_w_qkv, *attn_b_qkv, *attn_sink, *attn_w_o, *attn_b_o, *ffn_w1, *ffn_w3, *ffn_w2, *moe_router, *moe_w1, *moe_w3, *moe_w2, *final_norm_w;
    float* out; unsigned char* ws; int ph_lo, ph_hi;
};
struct Frame {
    LAS unsigned char* lds;
    int tid, lane, wave, G;
    unsigned char* ws; gu32* ctl; float* out;
    unsigned char* ws0; float* out0; int wave0;
};
__device__ __forceinline__ void phase_enter(Frame& F) { int l = lane_id(); asm volatile("" : "+v"(l)); F.lane = l; F.wave = F.wave0; F.tid = F.wave0 * 64 + l;
    unsigned char* w = F.ws0; float* o = F.out0; asm volatile("" : "+s"(w), "+s"(o)); F.ws = w; F.ctl = (gu32*)(w + WS_CTL); F.out = o; }
__device__ __forceinline__ void transpose_item(const float* W, int ldw, int col0, int ncb, int K, bf16_t* WT, int mode, int half, LAS float* scr, int item, int lane) {
    const int kb = item / ncb, nb = item - kb * ncb, k0 = 64 * kb, n0 = 64 * nb;
    const int lr = lane >> 4, lc = (lane & 15) * 4;
    f32x4 tv[16];
#pragma unroll
    for (int i = 0; i < 16; ++i) tv[i] = *(const GAS f32x4*)(W + (size_t)(k0 + 4 * i + lr) * ldw + col0 + n0 + lc);
#pragma unroll
    for (int i = 0; i < 16; ++i) { LAS float* d = scr + (4 * i + lr) * 65 + lc; d[0] = tv[i].x; d[1] = tv[i].y; d[2] = tv[i].z; d[3] = tv[i].w; }
    LDS_WAIT(); asm volatile("" ::: "memory");
    const int c = lane & 7;
#pragma unroll
    for (int j = 0; j < 8; ++j) { const int n = (lane >> 3) + 8 * j; const LAS float* s = scr + (8 * c) * 65 + n;
        u32x4 o; o.x = pk2(s[0 * 65], s[1 * 65]); o.y = pk2(s[2 * 65], s[3 * 65]); o.z = pk2(s[4 * 65], s[5 * 65]); o.w = pk2(s[6 * 65], s[7 * 65]);
        const int cl = n0 + n; const int drow = mode == 0 ? cl : ((cl >> 7) * 256 + half * 128 + (cl & 127));
        *(GAS u32x4*)(WT + (size_t)drow * K + k0 + 8 * c) = o; }
    LDS_WAIT(); asm volatile("" ::: "memory");
}
__device__ __forceinline__ void p0_prologue(Frame& F, const Args& A) {
    phase_enter(F);
    {
        LAS float* sc = (LAS float*)F.lds;
        LAS float* red = (LAS float*)(F.lds + 81920);
        for (int idx = F.tid; idx < 17 * 1024; idx += 512) { const int cb = idx >> 10, k = idx & 1023; const float v = cb < 16 ? A.c[cb * 1024 + k] : A.c_ctx[k]; sc[k * 20 + cb] = v / (1.0f + expf(-v)); }
        __syncthreads();
        float* MODV = (float*)(F.ws + WS_MODV);
        for (int item = blockIdx.x; item < 4 * 96; item += F.G) {
            const int i = item / 96, cblk = item - i * 96;
            const float* Wm = A.w_mod + (size_t)i * 1024 * 6144 + cblk * 64 + F.lane;
            float acc[17];
#pragma unroll
            for (int cb = 0; cb < 17; ++cb) acc[cb] = 0.f;
            const int k0 = F.wave * 128;
#pragma unroll 4
            for (int kk = 0; kk < 128; ++kk) { const int k = k0 + kk; const float w = Wm[(size_t)k * 6144]; const LAS float* s = sc + k * 20;
#pragma unroll
                for (int cb = 0; cb < 17; ++cb) acc[cb] += s[cb] * w; }
#pragma unroll
            for (int cb = 0; cb < 17; ++cb) red[(F.wave * 17 + cb) * 64 + F.lane] = acc[cb];
            __syncthreads();
            for (int idx = F.tid; idx < 17 * 64; idx += 512) { const int cb = idx >> 6, l = idx & 63; float s = 0.f;
#pragma unroll
                for (int w = 0; w < 8; ++w) s += red[(w * 17 + cb) * 64 + l];
                MODV[(size_t)(i * 17 + cb) * 6144 + cblk * 64 + l] = s + A.b_mod[i * 6144 + cblk * 64 + l]; }
            __syncthreads();
        }
    }
    if (blockIdx.x == 0) { float* RT = (float*)(F.ws + WS_ROPE);
        for (int idx = F.tid; idx < 1024; idx += 512) { const int id = idx >> 4, f = idx & 15; const float inv = __builtin_amdgcn_exp2f(-(float)f * (13.287712379549449f / 16.0f)); const float ang = (float)id * inv;
            RT[idx] = __cosf(ang); RT[1024 + idx] = __sinf(ang); } }
    __syncthreads();
    {
        LAS float* scr = (LAS float*)(F.lds + F.wave * 16896);
        const int gw = blockIdx.x * NWAVES + F.wave, NGW = F.G * NWAVES;
        constexpr int I1 = 16 * 32, I2 = 16 * 65, I3 = 32 * 16, I4 = 16 * 44, I5 = 16 * 44, I6 = 44 * 16, I7 = 16 * 24, I8 = 16 * 16, IPER = I1 + I2 + I3 + I4 + I5 + I6 + I7 + I8;
        for (int it = gw; it < 2 * IPER; it += NGW) {
            const int j = it / IPER; int r = it - j * IPER;
            unsigned char* wss = F.ws + WS_W + (size_t)j * W_SSD_STRIDE; unsigned char* wsa = F.ws + WS_W + W_ATT0 + (size_t)j * W_ATT_STRIDE;
            if (r < I1) { transpose_item(A.ssd_w_in + (size_t)j * 1024 * SSD_IN, SSD_IN, 0, 32, 1024, (bf16_t*)(wss + W_WZ), 0, 0, scr, r, F.lane); continue; } r -= I1;
            if (r < I2) { transpose_item(A.ssd_w_in + (size_t)j * 1024 * SSD_IN, SSD_IN, 2048, 65, 1024, (bf16_t*)(wss + W_WIN), 0, 0, scr, r, F.lane); continue; } r -= I2;
            if (r < I3) { transpose_item(A.ssd_w_out + (size_t)j * 2048 * 1024, 1024, 0, 16, 2048, (bf16_t*)(wss + W_WOUT), 0, 0, scr, r, F.lane); continue; } r -= I3;
            if (r < I4) { transpose_item(A.ffn_w1 + (size_t)j * 1024 * DFF, DFF, 0, 44, 1024, (bf16_t*)(wss + W_WUP), 1, 0, scr, r, F.lane); continue; } r -= I4;
            if (r < I5) { transpose_item(A.ffn_w3 + (size_t)j * 1024 * DFF, DFF, 0, 44, 1024, (bf16_t*)(wss + W_WUP), 1, 1, scr, r, F.lane); continue; } r -= I5;
            if (r < I6) { transpose_item(A.ffn_w2 + (size_t)j * DFF * 1024, 1024, 0, 16, DFF, (bf16_t*)(wss + W_WDN), 0, 0, scr, r, F.lane); continue; } r -= I6;
            if (r < I7) { transpose_item(A.attn_w_qkv + (size_t)j * 1024 * NQKV, NQKV, 0, 24, 1024, (bf16_t*)(wsa + W_WQKV), 0, 0, scr, r, F.lane); continue; } r -= I7;
            transpose_item(A.attn_w_o + (size_t)j * 1024 * 1024, 1024, 0, 16, 1024, (bf16_t*)(wsa + W_WO), 0, 0, scr, r, F.lane);
        }
        for (int j = 0; j < 2; ++j) { u32x4* z = (u32x4*)(F.ws + WS_W + (size_t)j * W_SSD_STRIDE + W_WIN + (size_t)4160 * 1024 * 2);
            for (int idx = blockIdx.x * 512 + F.tid; idx < 192 * 1024 * 2 / 16; idx += F.G * 512) z[idx] = (u32x4){0u, 0u, 0u, 0u}; }
    }
}
__device__ __forceinline__ void moe_convert(Frame& F, const Args& A, int j, int wg0, int nwg) {
    phase_enter(F);
    LAS float* scr = (LAS float*)(F.lds + F.wave * 16896);
    const int gw = ((int)blockIdx.x - wg0) * NWAVES + F.wave, NGW = nwg * NWAVES;
    constexpr int IE = 16 * 56, I2 = 56 * 16;
    bf16_t* MW13 = (bf16_t*)(F.ws + WS_BIG + BIG_MW13); bf16_t* MW2 = (bf16_t*)(F.ws + WS_BIG + BIG_MW2);
    for (int it = gw; it < 8 * (2 * IE + I2); it += NGW) {
        const int e = it / (2 * IE + I2); int r = it - e * (2 * IE + I2);
        const size_t we = (size_t)(j * 8 + e) * 1024 * DFFE;
        if (r < IE) { transpose_item(A.moe_w1 + we, DFFE, 0, 56, 1024, MW13 + (size_t)e * 7168 * 1024, 1, 0, scr, r, F.lane); continue; } r -= IE;
        if (r < IE) { transpose_item(A.moe_w3 + we, DFFE, 0, 56, 1024, MW13 + (size_t)e * 7168 * 1024, 1, 1, scr, r, F.lane); continue; } r -= IE;
        transpose_item(A.moe_w2 + we, 1024, 0, 16, DFFE, MW2 + (size_t)e * 1024 * DFFE, 0, 0, scr, r, F.lane);
    }
}

__device__ __forceinline__ void norm_phase(Frame& F, const Args& A, int i, int which, int mode) {
    phase_enter(F);
    const bool first = mode & 1, combine = mode & 2, route = mode & 4, fin = mode & 8, lastl = mode & 16;
    const float* MODV = (const float*)(F.ws + WS_MODV);
    bf16_t* H = (bf16_t*)F.out; bf16_t* XR = (bf16_t*)(F.ws + WS_XR);
    const bf16_t* EO = (const bf16_t*)(F.ws + WS_Y);
    LAS float* rt = (LAS float*)F.lds;
    LAS int* ents = (LAS int*)(F.lds + 32768);
    const int jm = i >> 1;
    if (route) { const float* rg = A.moe_router + (size_t)jm * 1024 * 8; for (int idx = F.tid; idx < 8192; idx += 512) rt[(idx & 7) * 1024 + (idx >> 3)] = rg[idx]; }
    __syncthreads();
    const float* nw = fin ? A.final_norm_w : ((which == 0 ? A.norm1_w : A.norm2_w) + i * 1024);
    unsigned* cnt = (unsigned*)(F.ctl + CW_CNT + (size_t)jm * 8 * 64);
    int* rlist = (int*)(F.ws + WS_RLIST); float* GATE = (float*)(F.ws + WS_GATE);
    int kk = -1;
    for (int ch = blockIdx.x; ch < MROWS / 32; ch += F.G) {
        ++kk;
        const int R0 = ch * 32, b = R0 / SROW, s0 = R0 - b * SROW; const bool isctx = s0 < NCTX; const int cond = isctx ? 16 : b;
        if (fin && isctx) continue;
        const bool do_route = route && !(lastl && isctx);
        const float* mv = MODV + (size_t)(i * 17 + cond) * 6144;
        f32x4 wv[4], shv[4], scv[4], g5[4];
#pragma unroll
        for (int j = 0; j < 4; ++j) { const int col = 4 * F.lane + 256 * j; wv[j] = *(const f32x4*)(nw + col);
            if (!fin) { shv[j] = *(const f32x4*)(mv + (which ? 3 : 0) * 1024 + col); scv[j] = *(const f32x4*)(mv + (which ? 4 : 1) * 1024 + col); }
            if (combine) g5[j] = *(const f32x4*)(MODV + (size_t)((i - 1) * 17 + cond) * 6144 + 5 * 1024 + col); }
        for (int rr = 0; rr < 4; ++rr) {
            const int R = R0 + F.wave * 4 + rr, s = s0 + F.wave * 4 + rr;
            bf16_t* xr = XR + (size_t)R * DM + 4 * F.lane;
            f32x4 v[4]; float ss = 0.f;
            if (first) { const float* src = isctx ? A.ctx + (size_t)(b * NCTX + s) * DM : A.x + (size_t)(b * SEQ + s - NCTX) * DM;
#pragma unroll
                for (int j = 0; j < 4; ++j) v[j] = *(const f32x4*)(src + 4 * F.lane + 256 * j);
            } else {
#pragma unroll
                for (int j = 0; j < 4; ++j) { const u32x2 w = *(const u32x2*)(xr + 256 * j); v[j] = (f32x4){bf_lo(w.x), bf_hi(w.x), bf_lo(w.y), bf_hi(w.y)}; }
            }
            if (combine) {
#pragma unroll
                for (int j = 0; j < 4; ++j) { const u32x2 e0 = *(const u32x2*)(EO + (size_t)(2 * R) * DM + 4 * F.lane + 256 * j), e1 = *(const u32x2*)(EO + (size_t)(2 * R + 1) * DM + 4 * F.lane + 256 * j);
                    f32x4 ev; ev.x = bf_lo(e0.x) + bf_lo(e1.x); ev.y = bf_hi(e0.x) + bf_hi(e1.x); ev.z = bf_lo(e0.y) + bf_lo(e1.y); ev.w = bf_hi(e0.y) + bf_hi(e1.y);
                    v[j] = v[j] + g5[j] * ev; }
                if (!fin) {
#pragma unroll
                    for (int j = 0; j < 4; ++j) { u32x2 o; o.x = pk2(v[j].x, v[j].y); o.y = pk2(v[j].z, v[j].w); *(u32x2*)(xr + 256 * j) = o; }
                }
            }
#pragma unroll
            for (int j = 0; j < 4; ++j) ss += (v[j].x * v[j].x + v[j].y * v[j].y) + (v[j].z * v[j].z + v[j].w * v[j].w);
            const float rstd = 1.0f / sqrtf(wave_sum(ss, F.lane) * (1.0f / DM) + EPS);
            if (fin) { float* orow = F.out + (size_t)(b * SEQ + s - NCTX) * DM;
#pragma unroll
                for (int j = 0; j < 4; ++j) *(f32x4*)(orow + 4 * F.lane + 256 * j) = v[j] * rstd * wv[j];
                continue;
            }
#pragma unroll
            for (int j = 0; j < 4; ++j) { v[j] = v[j] * rstd * wv[j] * (scv[j] + 1.0f) + shv[j];
                u32x2 o; o.x = pk2(v[j].x, v[j].y); o.y = pk2(v[j].z, v[j].w); *(u32x2*)(H + (size_t)R * DM + 4 * F.lane + 256 * j) = o; }
            if (do_route) {
                float lg[8];
#pragma unroll
                for (int e = 0; e < 8; ++e) lg[e] = 0.f;
#pragma unroll
                for (int e = 0; e < 8; ++e)
#pragma unroll
                    for (int j = 0; j < 4; ++j) { const f32x4 r = *(const LAS f32x4*)(rt + e * 1024 + 4 * F.lane + 256 * j); lg[e] += (v[j].x * r.x + v[j].y * r.y) + (v[j].z * r.z + v[j].w * r.w); }
#pragma unroll
                for (int e = 0; e < 8; ++e) lg[e] = wave_sum(lg[e], F.lane);
                int i1 = 0; float v1 = lg[0];
#pragma unroll
                for (int e = 1; e < 8; ++e) if (lg[e] > v1) { v1 = lg[e]; i1 = e; }
                int i2 = -1; float v2 = -3.0e38f;
#pragma unroll
                for (int e = 0; e < 8; ++e) if (e != i1 && lg[e] > v2) { v2 = lg[e]; i2 = e; }
                const float g1 = 1.0f / (1.0f + expf(v2 - v1)), g2 = 1.0f - g1;
                if (F.lane == 0) { ents[(kk & 15) * 64 + (F.wave * 4 + rr) * 2] = i1; ents[(kk & 15) * 64 + (F.wave * 4 + rr) * 2 + 1] = i2; GATE[(size_t)R * 2] = g1; GATE[(size_t)R * 2 + 1] = g2; }
            } else if (route && F.lane == 0) { ents[(kk & 15) * 64 + (F.wave * 4 + rr) * 2] = -1; ents[(kk & 15) * 64 + (F.wave * 4 + rr) * 2 + 1] = -1; }
        }
    }
    if (route) {
        __syncthreads();
        if (F.wave == 0) {
            const int npass = kk + 1;
            int n[8];
#pragma unroll
            for (int ee = 0; ee < 8; ++ee) n[ee] = 0;
            for (int p = 0; p < npass; ++p) { const int e = ents[(p & 15) * 64 + F.lane];
#pragma unroll
                for (int ee = 0; ee < 8; ++ee) n[ee] += __popcll(__ballot(e == ee)); }
            int myn = n[0];
#pragma unroll
            for (int ee = 1; ee < 8; ++ee) myn = (F.lane == ee) ? n[ee] : myn;
            unsigned basel = 0u;
            if (F.lane < 8) basel = __hip_atomic_fetch_add(cnt + F.lane * 64, (unsigned)myn, RLX_AGENT);
            int off[8];
#pragma unroll
            for (int ee = 0; ee < 8; ++ee) off[ee] = __builtin_amdgcn_readlane((int)basel, ee);
            for (int p = 0; p < npass; ++p) { const int e = ents[(p & 15) * 64 + F.lane]; const int Rp = ((int)blockIdx.x + p * F.G) * 32;
#pragma unroll
                for (int ee = 0; ee < 8; ++ee) { const unsigned long long m = __ballot(e == ee);
                    if (e == ee) rlist[(size_t)ee * MROWS + off[ee] + __popcll(m & ((1ull << F.lane) - 1ull))] = (Rp + (F.lane >> 1)) * 2 + (F.lane & 1);
                    off[ee] += __popcll(m); } }
        }
        __syncthreads();
    }
}

struct EpiXbc {
    static constexpr bool PERM = true;
    bf16_t* XBC; float* DT; bf16_t* HALO;
    __device__ __forceinline__ void operator()(const f32x4 (&acc)[2][2][4][2], const pg8::Unit& u, int wr, int wc, int fr, int fq) const {
        const int row0 = u.pm * 256 + wr * 64 + fr;
        if (u.pn < 16) { const int col0 = u.pn * 256 + wc * 32 + 8 * fq;
#pragma unroll
            for (int ai = 0; ai < 2; ++ai)
#pragma unroll
                for (int m = 0; m < 4; ++m) { bf16_t* rowp = XBC + (size_t)(row0 + ai * 128 + m * 16) * CONVCH + col0;
#pragma unroll
                    for (int bj = 0; bj < 2; ++bj) { const f32x4 v0 = acc[ai][bj][m][0], v1 = acc[ai][bj][m][1]; u32x4 w; w.x = pg8::cvt_pk_bf16(v0[0], v0[1]); w.y = pg8::cvt_pk_bf16(v0[2], v0[3]); w.z = pg8::cvt_pk_bf16(v1[0], v1[1]); w.w = pg8::cvt_pk_bf16(v1[2], v1[3]);
                        *(GAS u32x4*)(rowp + bj * 128) = w;
                        const int rin = ai * 128 + wr * 64 + m * 16 + fr, rq = rin >> 6, rw = rin & 63;
                        if (rw < 2 || rw >= 62) *(GAS u32x4*)(HALO + ((size_t)u.pm * 16 + (rw < 2 ? (rq == 0 ? rw : 4 * rq + rw) : 4 * rq + rw - 60)) * CONVCH + col0 + bj * 128) = w; } }
        } else if (wc < 2) { const int c0 = wc * 32 + 8 * fq;
#pragma unroll
            for (int ai = 0; ai < 2; ++ai)
#pragma unroll
                for (int m = 0; m < 4; ++m) { float* p = DT + (size_t)(row0 + ai * 128 + m * 16) * 64 + c0; *(GAS f32x4*)p = acc[ai][0][m][0]; *(GAS f32x4*)(p + 4) = acc[ai][0][m][1]; }
        }
    }
};
struct EpiGate {
    static constexpr bool PERM = true;
    const bf16_t* Y; bf16_t* Gt; const float* nw; LAS float* P;
    __device__ __forceinline__ void operator()(f32x4 (&acc)[2][2][4][2], const pg8::Unit& u, int wr, int wc, int fr, int fq) const {
        const int row0 = u.pm * 256 + wr * 64 + fr, col0 = u.pn * 256 + wc * 32 + 8 * fq;
        u32x4 yq[2][4][2];
        { const GAS char* yb = (const GAS char*)(Y + (size_t)(u.pm * 256) * DIN + u.pn * 256); unsigned yo = (unsigned)((wr * 64 + fr) * DIN * 2); asm volatile("" : "+v"(yo));
#pragma unroll
          for (int ai = 0; ai < 2; ++ai)
#pragma unroll
            for (int m = 0; m < 4; ++m)
#pragma unroll
                for (int bj = 0; bj < 2; ++bj) { const int cg = bj * 128 + wc * 32 + 8 * fq; const int cy = ((cg >> 5) & 1) * 128 + (cg >> 6) * 32 + (cg & 31);
                    yq[ai][m][bj] = *(const GAS u32x4*)(yb + (size_t)(ai * 128 + m * 16) * DIN * 2 + yo + cy * 2); } }
#pragma unroll
        for (int ai = 0; ai < 2; ++ai)
#pragma unroll
            for (int m = 0; m < 4; ++m) { float ssq = 0.f;
#pragma unroll
                for (int bj = 0; bj < 2; ++bj) { const u32x4 yv = yq[ai][m][bj]; f32x4 z0 = acc[ai][bj][m][0], z1 = acc[ai][bj][m][1];
                    z0[0] = bf_lo(yv.x) * siluf(z0[0]); z0[1] = bf_hi(yv.x) * siluf(z0[1]); z0[2] = bf_lo(yv.y) * siluf(z0[2]); z0[3] = bf_hi(yv.y) * siluf(z0[3]);
                    z1[0] = bf_lo(yv.z) * siluf(z1[0]); z1[1] = bf_hi(yv.z) * siluf(z1[1]); z1[2] = bf_lo(yv.w) * siluf(z1[2]); z1[3] = bf_hi(yv.w) * siluf(z1[3]);
                    ssq += (z0[0] * z0[0] + z0[1] * z0[1]) + (z0[2] * z0[2] + z0[3] * z0[3]) + (z1[0] * z1[0] + z1[1] * z1[1]) + (z1[2] * z1[2] + z1[3] * z1[3]);
                    acc[ai][bj][m][0] = z0; acc[ai][bj][m][1] = z1; }
                ssq += shx(ssq, 16, fq * 16 + fr); ssq += shx(ssq, 32, fq * 16 + fr);
                if (fq == 0) P[(ai * 128 + wr * 64 + m * 16 + fr) * 4 + wc] = ssq; }
        asm volatile("s_waitcnt lgkmcnt(0)" ::: "memory"); __builtin_amdgcn_s_barrier(); asm volatile("" ::: "memory");
        f32x4 nv[2][2];
#pragma unroll
        for (int bj = 0; bj < 2; ++bj) { nv[bj][0] = *(const GAS f32x4*)(nw + col0 + bj * 128); nv[bj][1] = *(const GAS f32x4*)(nw + col0 + bj * 128 + 4); }
#pragma unroll
        for (int ai = 0; ai < 2; ++ai)
#pragma unroll
            for (int m = 0; m < 4; ++m) { const f32x4 pp = *(const LAS f32x4*)(P + (ai * 128 + wr * 64 + m * 16 + fr) * 4); const float rstd = 1.0f / sqrtf(((pp.x + pp.y) + (pp.z + pp.w)) * (1.0f / 256.0f) + EPS);
                bf16_t* gp = Gt + (size_t)(row0 + ai * 128 + m * 16) * DIN + col0;
#pragma unroll
                for (int bj = 0; bj < 2; ++bj) { const f32x4 v0 = acc[ai][bj][m][0] * rstd * nv[bj][0], v1 = acc[ai][bj][m][1] * rstd * nv[bj][1];
                    u32x4 w; w.x = pg8::cvt_pk_bf16(v0[0], v0[1]); w.y = pg8::cvt_pk_bf16(v0[2], v0[3]); w.z = pg8::cvt_pk_bf16(v1[0], v1[1]); w.w = pg8::cvt_pk_bf16(v1[2], v1[3]);
                    *(GAS u32x4*)(gp + bj * 128) = w; } }
        asm volatile("s_waitcnt lgkmcnt(0)" ::: "memory");
    }
};
struct EpiResid {
    static constexpr bool PERM = true;
    bf16_t* XR; const float* modl; int gidx; const float* bias; const float* rd_x; const float* rd_ctx;
    __device__ __forceinline__ void operator()(const f32x4 (&acc)[2][2][4][2], const pg8::Unit& u, int wr, int wc, int fr, int fq) const {
        const int b = u.pm / 17, j = u.pm - b * 17, cond = j == 0 ? 16 : b;
        const GAS char* pbase = (const GAS char*)(XR + (size_t)u.pm * 256 * DM);
        unsigned lo = (unsigned)(((wr * 64 + fr) * DM + u.pn * 256 + wc * 32 + 8 * fq) * 2); asm volatile("" : "+v"(lo));
        const GAS char* ibase = (const GAS char*)(rd_x ? (j == 0 ? rd_ctx + (size_t)(b * NCTX) * DM : rd_x + (size_t)(b * SEQ + (j - 1) * 256) * DM) : nullptr);
        const GAS float* gv = (const GAS float*)(modl + (size_t)cond * 6144 + gidx * 1024 + u.pn * 256 + wc * 32 + 8 * fq);
        const GAS float* bp = (const GAS float*)(bias ? bias + u.pn * 256 + wc * 32 + 8 * fq : nullptr);
#pragma unroll
        for (int bj = 0; bj < 2; ++bj) {
            f32x4 g[2], bv[2];
#pragma unroll
            for (int n = 0; n < 2; ++n) { g[n] = *(const GAS f32x4*)(gv + bj * 128 + n * 4); bv[n] = bp ? *(const GAS f32x4*)(bp + bj * 128 + n * 4) : (f32x4){0.f, 0.f, 0.f, 0.f}; }
#pragma unroll
            for (int ai = 0; ai < 2; ++ai) {
                f32x4 o[4][2];
                if (rd_x) {
#pragma unroll
                    for (int m = 0; m < 4; ++m)
#pragma unroll
                        for (int n = 0; n < 2; ++n) o[m][n] = *(const GAS f32x4*)(ibase + (size_t)(ai * 128 + m * 16) * DM * 4 + 2 * lo + (bj * 128 + n * 4) * 4);
                } else {
                    u32x4 w[4];
#pragma unroll
                    for (int m = 0; m < 4; ++m) w[m] = *(const GAS u32x4*)(pbase + (size_t)(ai * 128 + m * 16) * DM * 2 + lo + bj * 256);
#pragma unroll
                    for (int m = 0; m < 4; ++m) { o[m][0] = (f32x4){bf_lo(w[m].x), bf_hi(w[m].x), bf_lo(w[m].y), bf_hi(w[m].y)}; o[m][1] = (f32x4){bf_lo(w[m].z), bf_hi(w[m].z), bf_lo(w[m].w), bf_hi(w[m].w)}; }
                }
#pragma unroll
                for (int m = 0; m < 4; ++m) { const f32x4 r0 = o[m][0] + g[0] * (acc[ai][bj][m][0] + bv[0]), r1 = o[m][1] + g[1] * (acc[ai][bj][m][1] + bv[1]);
                    u32x4 w; w.x = pg8::cvt_pk_bf16(r0[0], r0[1]); w.y = pg8::cvt_pk_bf16(r0[2], r0[3]); w.z = pg8::cvt_pk_bf16(r1[0], r1[1]); w.w = pg8::cvt_pk_bf16(r1[2], r1[3]);
                    *(GAS u32x4*)(pbase + (size_t)(ai * 128 + m * 16) * DM * 2 + lo + bj * 256) = w; }
                asm volatile("" ::: "memory");
            }
        }
    }
};
struct EpiResidNorm {
    static constexpr bool PERM = true;
    bf16_t* XR; const float* modl; int gidx; const float* bias; const float* rd_x; const float* rd_ctx;
    bf16_t* H; const float* nw; const float* modn; int sidx;
    unsigned* xbuf; unsigned* cnt; unsigned* tmo; LAS unsigned char* P;
    __device__ __forceinline__ void operator()(f32x4 (&acc)[2][2][4][2], const pg8::Unit& u, int wr, int wc, int fr, int fq) const {
        const int b = u.pm / 17, j = u.pm - b * 17, cond = j == 0 ? 16 : b, lane = fq * 16 + fr, wid = wr * 4 + wc;
        const GAS char* pbase = (const GAS char*)(XR + (size_t)u.pm * 256 * DM);
        unsigned lo = (unsigned)(((wr * 64 + fr) * DM + u.pn * 256 + wc * 32 + 8 * fq) * 2); asm volatile("" : "+v"(lo));
        const GAS char* ibase = (const GAS char*)(rd_x ? (j == 0 ? rd_ctx + (size_t)(b * NCTX) * DM : rd_x + (size_t)(b * SEQ + (j - 1) * 256) * DM) : nullptr);
        const int colv = u.pn * 256 + wc * 32 + 8 * fq;
        const GAS float* gv = (const GAS float*)(modl + (size_t)cond * 6144 + gidx * 1024 + colv);
        const GAS float* bp = (const GAS float*)(bias ? bias + colv : nullptr);
        LAS float* Pf = (LAS float*)P; LAS float* Sf = (LAS float*)(P + 4096); LAS unsigned* flag = (LAS unsigned*)(P + 5120);
#pragma unroll
        for (int bj = 0; bj < 2; ++bj) {
            f32x4 g[2], bv[2];
#pragma unroll
            for (int n = 0; n < 2; ++n) { g[n] = *(const GAS f32x4*)(gv + bj * 128 + n * 4); bv[n] = bp ? *(const GAS f32x4*)(bp + bj * 128 + n * 4) : (f32x4){0.f, 0.f, 0.f, 0.f}; }
#pragma unroll
            for (int ai = 0; ai < 2; ++ai) {
                f32x4 o[4][2];
                if (rd_x) {
#pragma unroll
                    for (int m = 0; m < 4; ++m)
#pragma unroll
                        for (int n = 0; n < 2; ++n) o[m][n] = *(const GAS f32x4*)(ibase + (size_t)(ai * 128 + m * 16) * DM * 4 + 2 * lo + (bj * 128 + n * 4) * 4);
                } else {
                    u32x4 w[4];
#pragma unroll
                    for (int m = 0; m < 4; ++m) w[m] = *(const GAS u32x4*)(pbase + (size_t)(ai * 128 + m * 16) * DM * 2 + lo + bj * 256);
#pragma unroll
                    for (int m = 0; m < 4; ++m) { o[m][0] = (f32x4){bf_lo(w[m].x), bf_hi(w[m].x), bf_lo(w[m].y), bf_hi(w[m].y)}; o[m][1] = (f32x4){bf_lo(w[m].z), bf_hi(w[m].z), bf_lo(w[m].w), bf_hi(w[m].w)}; }
                }
#pragma unroll
                for (int m = 0; m < 4; ++m) { const f32x4 r0 = o[m][0] + g[0] * (acc[ai][bj][m][0] + bv[0]), r1 = o[m][1] + g[1] * (acc[ai][bj][m][1] + bv[1]);
                    u32x4 w; w.x = pg8::cvt_pk_bf16(r0[0], r0[1]); w.y = pg8::cvt_pk_bf16(r0[2], r0[3]); w.z = pg8::cvt_pk_bf16(r1[0], r1[1]); w.w = pg8::cvt_pk_bf16(r1[2], r1[3]);
                    *(GAS u32x4*)(pbase + (size_t)(ai * 128 + m * 16) * DM * 2 + lo + bj * 256) = w; acc[ai][bj][m][0] = r0; acc[ai][bj][m][1] = r1; }
                asm volatile("" ::: "memory");
            }
        }
#pragma unroll
        for (int ai = 0; ai < 2; ++ai)
#pragma unroll
            for (int m = 0; m < 4; ++m) { float s = 0.f;
#pragma unroll
                for (int bj = 0; bj < 2; ++bj)
#pragma unroll
                    for (int n = 0; n < 2; ++n) { const f32x4 x = acc[ai][bj][m][n]; s += (x[0] * x[0] + x[1] * x[1]) + (x[2] * x[2] + x[3] * x[3]); }
                s += shx(s, 16, lane); s += shx(s, 32, lane);
                if (fq == 0) Pf[(ai * 128 + wr * 64 + m * 16 + fr) * 4 + wc] = s; }
        asm volatile("s_waitcnt lgkmcnt(0)" ::: "memory"); __builtin_amdgcn_s_barrier(); asm volatile("" ::: "memory");
        const int row = wid * 32 + (lane & 31);
        if (lane < 32) { const f32x4 pp = *(const LAS f32x4*)(Pf + row * 4); const float t = (pp.x + pp.y) + (pp.z + pp.w);
            __hip_atomic_store(xbuf + ((size_t)(u.pm * 256 + row) * 4 + u.pn), __builtin_bit_cast(unsigned, t), RLX_AGENT); }
        asm volatile("s_waitcnt vmcnt(0)" ::: "memory");
        if (lane == 0) __hip_atomic_fetch_add(cnt + 64 * u.pm, 1u, RLX_AGENT);
        if (wid == 0) { bool dead = false; unsigned sp = 0u;
            while ((unsigned)__builtin_amdgcn_readfirstlane((int)__hip_atomic_load(cnt + 64 * u.pm, RLX_AGENT)) < 32u) { __builtin_amdgcn_s_sleep(2);
                if ((++sp & 255u) == 0u) { if (__hip_atomic_load(tmo, RLX_AGENT) != 0u) { dead = true; break; } if (sp > (1u << 20)) { if (lane == 0) atomicAdd(tmo, 1u); dead = true; break; } } }
            __builtin_amdgcn_fence(__ATOMIC_ACQUIRE, "agent");
            if (lane == 0) flag[0] = dead ? 1u : 0u; }
        asm volatile("s_waitcnt vmcnt(0) lgkmcnt(0)" ::: "memory"); __builtin_amdgcn_s_barrier(); asm volatile("" ::: "memory");
        if (lane < 32) { const unsigned* sl = xbuf + (size_t)(u.pm * 256 + row) * 4; float t = 0.f;
#pragma unroll
            for (int q = 0; q < 4; ++q) t += __builtin_bit_cast(float, __hip_atomic_load(sl + q, RLX_AGENT));
            Sf[row] = 1.0f / sqrtf(t * (1.0f / DM) + EPS); }
        asm volatile("s_waitcnt vmcnt(0) lgkmcnt(0)" ::: "memory"); __builtin_amdgcn_s_barrier(); asm volatile("" ::: "memory");
        const GAS float* sh = (const GAS float*)(modn + (size_t)cond * 6144 + sidx * 1024 + colv); const GAS float* sc = sh + 1024; const GAS float* nwp = (const GAS float*)(nw + colv);
#pragma unroll
        for (int bj = 0; bj < 2; ++bj) {
            f32x4 a[2], d[2];
#pragma unroll
            for (int n = 0; n < 2; ++n) { a[n] = *(const GAS f32x4*)(nwp + bj * 128 + n * 4) * (*(const GAS f32x4*)(sc + bj * 128 + n * 4) + 1.0f); d[n] = *(const GAS f32x4*)(sh + bj * 128 + n * 4); }
#pragma unroll
            for (int ai = 0; ai < 2; ++ai)
#pragma unroll
                for (int m = 0; m < 4; ++m) { const int r = ai * 128 + wr * 64 + m * 16 + fr; const float rstd = Sf[r];
                    const f32x4 h0 = acc[ai][bj][m][0] * rstd * a[0] + d[0], h1 = acc[ai][bj][m][1] * rstd * a[1] + d[1];
                    u32x4 w; w.x = pg8::cvt_pk_bf16(h0[0], h0[1]); w.y = pg8::cvt_pk_bf16(h0[2], h0[3]); w.z = pg8::cvt_pk_bf16(h1[0], h1[1]); w.w = pg8::cvt_pk_bf16(h1[2], h1[3]);
                    *(GAS u32x4*)(H + (size_t)(u.pm * 256 + r) * DM + colv + bj * 128) = w; }
        }
        asm volatile("s_waitcnt lgkmcnt(0)" ::: "memory");
    }
};
template <class Inner> struct TailEpi {
    static constexpr bool PERM = Inner::PERM;
    Inner in; int ks; unsigned char* part; unsigned* cnt; unsigned* tmo;
    __device__ __forceinline__ void operator()(f32x4 (&acc)[2][2][4][2], const pg8::Unit& u, int wr, int wc, int fr, int fq) const {
        const int lane = fq * 16 + fr, wid = wr * 4 + wc, tu = ((u.pm - 256) & 15) * 4 + u.pn;
        unsigned* cw = cnt + (size_t)(tu * 8 + wid) * 16;
        if (ks != 0) {
            GAS char* p = (GAS char*)part + ((size_t)(((tu * 3 + ks - 1) * 8 + wid) * 32)) * 1024 + lane * 16;
#pragma unroll
            for (int a = 0; a < 2; ++a)
#pragma unroll
                for (int b = 0; b < 2; ++b)
#pragma unroll
                    for (int m = 0; m < 4; ++m)
#pragma unroll
                        for (int n = 0; n < 2; ++n) { const f32x4 v = acc[a][b][m][n]; GAS char* pq = p + (((a * 2 + b) * 4 + m) * 2 + n) * 1024;
                            asm volatile("global_store_dwordx4 %0, %1, off sc0 sc1" :: "v"(pq), "v"(v) : "memory"); }
            asm volatile("s_waitcnt vmcnt(0)" ::: "memory");
            if (lane == 0) __hip_atomic_fetch_add(cw, 1u, RLX_AGENT);
            return;
        }
        { unsigned sp = 0u;
          while ((unsigned)__builtin_amdgcn_readfirstlane((int)__hip_atomic_load(cw, RLX_AGENT)) < 3u) { __builtin_amdgcn_s_sleep(1);
              if ((++sp & 255u) == 0u) { if (__hip_atomic_load(tmo, RLX_AGENT) != 0u) break; if (sp > (1u << 20)) { if (lane == 0) atomicAdd(tmo, 1u); break; } } }
          __builtin_amdgcn_fence(__ATOMIC_ACQUIRE, "agent"); }
#pragma unroll
        for (int s = 0; s < 3; ++s) {
            const GAS char* p = (const GAS char*)part + ((size_t)(((tu * 3 + s) * 8 + wid) * 32)) * 1024 + lane * 16;
#pragma unroll
            for (int a = 0; a < 2; ++a)
#pragma unroll
                for (int b = 0; b < 2; ++b) { f32x4 v[4][2];
#pragma unroll
                    for (int m = 0; m < 4; ++m)
#pragma unroll
                        for (int n = 0; n < 2; ++n) v[m][n] = *(const GAS f32x4*)(p + (((a * 2 + b) * 4 + m) * 2 + n) * 1024);
#pragma unroll
                    for (int m = 0; m < 4; ++m)
#pragma unroll
                        for (int n = 0; n < 2; ++n) { acc[a][b][m][n] += v[m][n]; asm volatile("" : "+v"(acc[a][b][m][n]) :: "memory"); }
                }
        }
        in(acc, u, wr, wc, fr, fq);
    }
};
__device__ __forceinline__ void split4(int NT, int ks, int& t0, int& n) { const int ne = (NT / 8) * 2, ex = (NT - 4 * ne) / 2; n = ne + (ks < ex ? 2 : 0); t0 = ks * ne + 2 * (ks < ex ? ks : ex); }

struct EpiSwiglu {
    static constexpr bool PERM = true;
    bf16_t* ACT; int ldc;
    __device__ __forceinline__ void operator()(const f32x4 (&acc)[2][2][4][2], const pg8::Unit& u, int wr, int wc, int fr, int fq) const {
        const int row0 = u.pm * 256 + wr * 64 + fr, col0 = u.pn * 128 + wc * 32 + 8 * fq;
#pragma unroll
        for (int ai = 0; ai < 2; ++ai)
#pragma unroll
            for (int m = 0; m < 4; ++m) { const f32x4 g0 = acc[ai][0][m][0], g1 = acc[ai][0][m][1], u0 = acc[ai][1][m][0], u1 = acc[ai][1][m][1];
                u32x4 w; w.x = pg8::cvt_pk_bf16(siluf(g0[0]) * u0[0], siluf(g0[1]) * u0[1]); w.y = pg8::cvt_pk_bf16(siluf(g0[2]) * u0[2], siluf(g0[3]) * u0[3]);
                w.z = pg8::cvt_pk_bf16(siluf(g1[0]) * u1[0], siluf(g1[1]) * u1[1]); w.w = pg8::cvt_pk_bf16(siluf(g1[2]) * u1[2], siluf(g1[3]) * u1[3]);
                *(GAS u32x4*)(ACT + (size_t)(row0 + ai * 128 + m * 16) * ldc + col0) = w; }
    }
};
struct EpiQkv {
    static constexpr bool PERM = false;
    bf16_t *Q, *Kb, *Vb; const LAS float* T;
    __device__ __forceinline__ void operator()(const f32x4 (&acc)[2][2][4][2], const pg8::Unit& u, int wr, int wc, int fr, int fq) const {
        const int b = u.pm / 17, j = u.pm - b * 17; const bool isctx = j == 0; const int pos0 = (j - 1) * 256;
        bf16_t* dst; int ld, cbase; float sc = 1.0f;
        if (u.pn < 4) { dst = Q; ld = QW; cbase = u.pn * 256; sc = 0.125f * 1.4426950408889634f;   } else if (u.pn == 4) { dst = Kb; ld = KVW; cbase = 0; } else { dst = Vb; ld = KVW; cbase = 0; }
        const bool dorope = !isctx && u.pn < 5; const int axis = wc & 1;
        const LAS float* bp = T + 2048 + u.pn * 256 + wc * 32 + 4 * fq;
        f32x4 bv[2][2];
#pragma unroll
        for (int bj = 0; bj < 2; ++bj)
#pragma unroll
            for (int n = 0; n < 2; ++n) bv[bj][n] = *(const LAS f32x4*)(bp + bj * 128 + n * 16);
#pragma unroll
        for (int ai = 0; ai < 2; ++ai)
#pragma unroll
            for (int m = 0; m < 4; ++m) { const int r = ai * 128 + wr * 64 + m * 16 + fr; const int pos = pos0 + r; const int id = axis ? (pos & 63) : (pos >> 6);
                f32x4 cs = (f32x4){1.f, 1.f, 1.f, 1.f}, sn = (f32x4){0.f, 0.f, 0.f, 0.f};
                if (dorope) { cs = *(const LAS f32x4*)(T + id * 16 + 4 * fq); sn = *(const LAS f32x4*)(T + 1024 + id * 16 + 4 * fq); }
                GAS bf16_t* rowp = (GAS bf16_t*)(dst + (size_t)(u.pm * 256 + r) * ld + cbase + wc * 32 + 4 * fq);
#pragma unroll
                for (int bj = 0; bj < 2; ++bj) { const f32x4 x0 = (acc[ai][bj][m][0] + bv[bj][0]) * sc, x1 = (acc[ai][bj][m][1] + bv[bj][1]) * sc;
                    const f32x4 o0 = x0 * cs - x1 * sn, o1 = x1 * cs + x0 * sn;
                    u32x2 w0, w1; w0.x = pg8::cvt_pk_bf16(o0[0], o0[1]); w0.y = pg8::cvt_pk_bf16(o0[2], o0[3]); w1.x = pg8::cvt_pk_bf16(o1[0], o1[1]); w1.y = pg8::cvt_pk_bf16(o1[2], o1[3]);
                    *(GAS u32x2*)(rowp + bj * 128) = w0; *(GAS u32x2*)(rowp + bj * 128 + 16) = w1; } }
    }
};

struct MoeOrder {
    pg8::StaticOrder so; int cs; int pp[9]; int cnt[8]; const int* rlist; size_t bstride; bool GATHER_A;
    __device__ __forceinline__ void locate(int pm, int& e, int& p, int& cn) const { const int gp = cs + pm; e = 0; int pbase = 0; cn = cnt[0];
#pragma unroll
        for (int k = 1; k < 8; ++k) { const bool ge = gp >= pp[k]; e += ge ? 1 : 0; pbase = ge ? pp[k] : pbase; cn = ge ? cnt[k] : cn; }
        p = gp - pbase; }
    __device__ bool next(int i, pg8::Unit& u) const { return so.next(i, u); }
    __device__ __forceinline__ const char* a_base(const pg8::Gemm& g, const pg8::Unit& u) const { return GATHER_A ? (const char*)g.A : (const char*)g.A + (size_t)u.pm * (size_t)(256 * 2) * g.lda; }
    __device__ __forceinline__ const char* b_base(const pg8::Gemm& g, const pg8::Unit& u) const { int e, p, cn; locate(u.pm, e, p, cn); return (const char*)g.Bt + (size_t)e * bstride + (size_t)u.pn * (size_t)(256 * 2) * g.K; }
    __device__ __forceinline__ unsigned row_off(const pg8::Gemm& g, const pg8::Unit& u, int r) const {
        if (!GATHER_A) return (unsigned)r * (unsigned)g.lda * 2u;
        int e, p, cn; locate(u.pm, e, p, cn); const int idx = p * 256 + r; const int tok = idx < cn ? (rlist[(size_t)e * MROWS + idx] >> 1) : 0; return (unsigned)tok * (unsigned)g.lda * 2u; }
};
struct EpiMoeDown {
    static constexpr bool PERM = true;
    MoeOrder mo; bf16_t* EO; const float* GATE;
    __device__ __forceinline__ void operator()(const f32x4 (&acc)[2][2][4][2], const pg8::Unit& u, int wr, int wc, int fr, int fq) const {
        int e, p, cn; mo.locate(u.pm, e, p, cn); const int* rl = mo.rlist + (size_t)e * MROWS + p * 256;
        const int col0 = u.pn * 256 + wc * 32 + 8 * fq;
#pragma unroll
        for (int ai = 0; ai < 2; ++ai)
#pragma unroll
            for (int m = 0; m < 4; ++m) { const int r = ai * 128 + wr * 64 + m * 16 + fr;
                if (p * 256 + r < cn) { const int ent = rl[r]; const float gt = GATE[ent]; bf16_t* dp = EO + (size_t)ent * DM + col0;
#pragma unroll
                    for (int bj = 0; bj < 2; ++bj) { const f32x4 v0 = acc[ai][bj][m][0] * gt, v1 = acc[ai][bj][m][1] * gt; u32x4 w; w.x = pg8::cvt_pk_bf16(v0[0], v0[1]); w.y = pg8::cvt_pk_bf16(v0[2], v0[3]); w.z = pg8::cvt_pk_bf16(v1[0], v1[1]); w.w = pg8::cvt_pk_bf16(v1[2], v1[3]);
                        *(GAS u32x4*)(dp + bj * 128) = w; } } }
    }
};

typedef __bf16 bf16x2_t __attribute__((ext_vector_type(2)));
typedef short v4i16_t __attribute__((ext_vector_type(4)));
__device__ __forceinline__ unsigned cvtpk(float lo, float hi) { f32x2 v = {lo, hi}; bf16x2_t b = __builtin_convertvector(v, bf16x2_t); return __builtin_bit_cast(unsigned, b); }
__device__ __forceinline__ int crow(int r, int hi) { return (r & 3) + 8 * (r >> 2) + 4 * hi; }
__device__ __forceinline__ s16x4 vtr(const LAS unsigned char* p) { return __builtin_bit_cast(s16x4, __builtin_amdgcn_ds_read_tr16_b64_v4i16((LAS v4i16_t*)p)); }
#define MFMA32(a, b, c) __builtin_amdgcn_mfma_f32_32x32x16_bf16((a), (b), (c), 0, 0, 0)
__device__ __forceinline__ void conv_phase(Frame& F, const Args& A, int j) {
    phase_enter(F);
    bf16_t* XBC = (bf16_t*)(F.ws + WS_BIG); const bf16_t* HALO = (const bf16_t*)(F.ws + WS_HALO);
    const int lane = F.lane;
    const int gw = blockIdx.x * NWAVES + F.wave, NGW = F.G * NWAVES;
    for (int task = gw; task < NPAN * 32; task += NGW) {
        const int pm = task >> 5, q = (task >> 3) & 3, sl = task & 7, jj = pm % 17, c0 = sl * 512 + lane * 8;
        const bool top_zero = q == 0 && jj <= 1, bot_zero = q == 3 && (jj == 0 || jj == 16);
        const GAS bf16_t* htop = (const GAS bf16_t*)(HALO + (q == 0 ? ((size_t)(pm - 1) * 16 + 14) : ((size_t)pm * 16 + 4 * q - 2)) * CONVCH + c0);
        const GAS bf16_t* hbot = (const GAS bf16_t*)(HALO + (q == 3 ? ((size_t)(pm + 1) * 16 + 0) : ((size_t)pm * 16 + 4 * q + 4)) * CONVCH + c0);
        f32x2 cw[5][4], cbias[4];
#pragma unroll
        for (int k = 0; k < 5; ++k) { const f32x4 a0 = *(const GAS f32x4*)(A.ssd_conv_w + (size_t)(j * 5 + k) * CONVCH + c0), a1 = *(const GAS f32x4*)(A.ssd_conv_w + (size_t)(j * 5 + k) * CONVCH + c0 + 4);
            cw[k][0] = (f32x2){a0.x, a0.y}; cw[k][1] = (f32x2){a0.z, a0.w}; cw[k][2] = (f32x2){a1.x, a1.y}; cw[k][3] = (f32x2){a1.z, a1.w}; }
        { const f32x4 a0 = *(const GAS f32x4*)(A.ssd_conv_b + (size_t)j * CONVCH + c0), a1 = *(const GAS f32x4*)(A.ssd_conv_b + (size_t)j * CONVCH + c0 + 4);
            cbias[0] = (f32x2){a0.x, a0.y}; cbias[1] = (f32x2){a0.z, a0.w}; cbias[2] = (f32x2){a1.x, a1.y}; cbias[3] = (f32x2){a1.z, a1.w}; }
        GAS bf16_t* base = (GAS bf16_t*)(XBC + ((size_t)pm * 256 + q * 64) * CONVCH + c0);
        const u32x4 zero4 = (u32x4){0u, 0u, 0u, 0u};
        u32x4 win[12], pre[8];
        win[0] = top_zero ? zero4 : *(const GAS u32x4*)(htop);
        win[1] = top_zero ? zero4 : *(const GAS u32x4*)(htop + CONVCH);
#pragma unroll
        for (int r = 0; r < 10; ++r) win[2 + r] = *(const GAS u32x4*)(base + (size_t)r * CONVCH);
        for (int k = 0; k < 8; ++k) {
            if (k < 6) {
#pragma unroll
                for (int r = 0; r < 8; ++r) pre[r] = *(const GAS u32x4*)(base + (size_t)(8 * k + 10 + r) * CONVCH);
            } else if (k == 6) {
#pragma unroll
                for (int r = 0; r < 6; ++r) pre[r] = *(const GAS u32x4*)(base + (size_t)(58 + r) * CONVCH);
                pre[6] = bot_zero ? zero4 : *(const GAS u32x4*)(hbot);
                pre[7] = bot_zero ? zero4 : *(const GAS u32x4*)(hbot + CONVCH);
            }
#pragma unroll
            for (int o = 0; o < 8; ++o) {
                f32x2 r[4];
#pragma unroll
                for (int c = 0; c < 4; ++c) r[c] = cbias[c];
#pragma unroll
                for (int t = 0; t < 5; ++t) { const u32x4 w = win[o + t];
                    r[0] += cw[t][0] * (f32x2){bf_lo(w.x), bf_hi(w.x)}; r[1] += cw[t][1] * (f32x2){bf_lo(w.y), bf_hi(w.y)};
                    r[2] += cw[t][2] * (f32x2){bf_lo(w.z), bf_hi(w.z)}; r[3] += cw[t][3] * (f32x2){bf_lo(w.w), bf_hi(w.w)}; }
                u32x4 w; w.x = cvtpk(siluf(r[0].x), siluf(r[0].y)); w.y = cvtpk(siluf(r[1].x), siluf(r[1].y)); w.z = cvtpk(siluf(r[2].x), siluf(r[2].y)); w.w = cvtpk(siluf(r[3].x), siluf(r[3].y));
                *(GAS u32x4*)(base + (size_t)(8 * k + o) * CONVCH) = w;
            }
#pragma unroll
            for (int r = 0; r < 4; ++r) win[r] = win[8 + r];
#pragma unroll
            for (int r = 0; r < 8; ++r) win[4 + r] = pre[r];
        }
    }
}

constexpr int SC_RS = 272;
constexpr int SC_TILE = 3 * 32 * SC_RS;
constexpr int SC_YS = 2 * SC_TILE;
constexpr int SC_WS = SC_YS + 16384;
constexpr int SC_RAW = 73728;
static_assert(SC_WS + 4096 <= SC_RAW && SC_RAW + 2 * 36 * 1024 <= LDSCTL_OFF, "scan LDS map");
template <int PH>
__device__ __forceinline__ void scan_phase(Frame& F, const Args& A, int j) {
    phase_enter(F);
    const bf16_t* XBC = (const bf16_t*)(F.ws + WS_BIG); const float* DT = (const float*)(F.ws + WS_DT); bf16_t* Y = (bf16_t*)(F.ws + WS_Y);
    const int lane = F.lane, wave = F.wave;
    for (int u0 = blockIdx.x; u0 < 256; u0 += F.G) {
        const int unit = (F.G == 256) ? ((u0 & 7) * 32 + (u0 >> 3)) : u0;
        const int b = unit >> 4, g = (unit >> 1) & 7, ph = unit & 1;
        const int srow = F.tid >> 4, sch = F.tid & 15;
        const int gcolB = 2048 + g * 128 + sch * 8, gcolC = 3072 + g * 128 + sch * 8, gcolX = g * 256 + (sch >> 2) * 64 + ph * 32 + (sch & 3) * 8;
        const int hh = wave >> 1, dir = wave & 1, c31 = lane & 31, hl = lane >> 5;
        const int trq = (lane & 15) >> 2, trp = lane & 3, trb = (lane >> 4) & 1;
        const int head = g * 4 + hh;
        const float Dk = A.ssd_d[(j * 2 + dir) * 32 + head], dtb = A.ssd_dt_bias[(j * 2 + dir) * 32 + head], aneg = -expf(A.ssd_a_log[(j * 2 + dir) * 32 + head]);
        LAS float* wsf = (LAS float*)(F.lds + SC_WS + wave * 512);
        int offRow = dir * SC_TILE + c31 * SC_RS + 16 * hl;
        int offC4 = dir * SC_TILE + 32 * SC_RS + c31 * SC_RS + 8 * hl;
        int offTrX = dir * SC_TILE + 64 * SC_RS + trq * SC_RS + (hh * 32 + 16 * trb + 4 * trp) * 2;
        int offTrB = dir * SC_TILE + trq * SC_RS + (16 * trb + 4 * trp) * 2;
        int ysoff = (4 * hl) * 128 + hh * 32 + c31;
        asm volatile("" : "+v"(offRow), "+v"(offC4), "+v"(offTrX), "+v"(offTrB), "+v"(ysoff));
        f32x16 ST[4];
#pragma unroll
        for (int t = 0; t < 4; ++t)
#pragma unroll
            for (int e = 0; e < 16; ++e) ST[t][e] = 0.f;
#define SC_PF(pf, st_) do { const int st = (PH >= 2) ? 0 : (st_); const int cf_ = (st), cb_ = (st) < 8 ? 7 - (st) : 143 - (st); \
            _Pragma("unroll") for (int T = 0; T < 2; ++T) { const GAS bf16_t* rp = (const GAS bf16_t*)(XBC + (size_t)(b * SROW + (T ? cb_ : cf_) * 32 + srow) * CONVCH); \
                pf[T][0] = *(const GAS u32x4*)(rp + gcolB); pf[T][1] = *(const GAS u32x4*)(rp + gcolC); pf[T][2] = *(const GAS u32x4*)(rp + gcolX); } } while (0)
#define SC_DTLOAD(st) DT[(size_t)(b * SROW + (dir ? ((st) < 8 ? 7 - (st) : 143 - (st)) : (st)) * 32 + c31) * 64 + dir * 32 + head]
#define SC_WRITEOUT(st) do { const int cf_ = (st), cb_ = (st) < 8 ? 7 - (st) : 143 - (st); \
            _Pragma("unroll") for (int T = 0; T < 2; ++T) { const int tok = F.tid >> 4, h4 = (F.tid >> 2) & 3, q4 = F.tid & 3, chunk = T ? cb_ : cf_; \
                const int other = T == 0 ? (chunk < 8 ? 7 - chunk : 143 - chunk) : chunk; \
                u32x4 v = *(const LAS u32x4*)(F.lds + SC_YS + T * 8192 + (tok * 128 + h4 * 32 + q4 * 8) * 2); \
                bf16_t* yp = Y + (size_t)(b * SROW + chunk * 32 + tok) * DIN + g * 256 + ph * 128 + h4 * 32 + q4 * 8; \
                if ((st) > other) { const u32x4 o = oldy[T]; \
                    v.x = pk2(bf_lo(o.x) + bf_lo(v.x), bf_hi(o.x) + bf_hi(v.x)); v.y = pk2(bf_lo(o.y) + bf_lo(v.y), bf_hi(o.y) + bf_hi(v.y)); \
                    v.z = pk2(bf_lo(o.z) + bf_lo(v.z), bf_hi(o.z) + bf_hi(v.z)); v.w = pk2(bf_lo(o.w) + bf_lo(v.w), bf_hi(o.w) + bf_hi(v.w)); } \
                if (PH == 0) *(u32x4*)yp = v; else asm volatile("" :: "v"(v)); } } while (0)
        u32x4 pfE[2][3], pfO[2][3];
        SC_PF(pfE, 0); SC_PF(pfO, 1);
        float dtraw = SC_DTLOAD(0);
        u32x4 oldy[2] = {(u32x4){0u, 0u, 0u, 0u}, (u32x4){0u, 0u, 0u, 0u}};
        for (int step2 = 0; step2 < 136; step2 += 2) {
          { const int step = step2;
            const int cf = step, cbk = step < 8 ? 7 - step : 143 - step;
            __syncthreads();
            if (step > 0) SC_WRITEOUT(step - 1);
#pragma unroll
            for (int T = 0; T < 2; ++T)
#pragma unroll
                for (int a = 0; a < 3; ++a) *(LAS u32x4*)(F.lds + T * SC_TILE + a * (32 * SC_RS) + srow * SC_RS + sch * 16) = pfE[T][a];
            {
                const float xb = dtraw + dtb;
                const float dt = xb > 20.f ? xb : log1pf(__expf(xb)); const float dA = dt * aneg;
                float v = dA;
                v += __builtin_bit_cast(float, __builtin_amdgcn_update_dpp(0, __builtin_bit_cast(int, v), 0x111, 0xf, 0xf, true));
                v += __builtin_bit_cast(float, __builtin_amdgcn_update_dpp(0, __builtin_bit_cast(int, v), 0x112, 0xf, 0xf, true));
                v += __builtin_bit_cast(float, __builtin_amdgcn_update_dpp(0, __builtin_bit_cast(int, v), 0x114, 0xf, 0xf, true));
                v += __builtin_bit_cast(float, __builtin_amdgcn_update_dpp(0, __builtin_bit_cast(int, v), 0x118, 0xf, 0xf, true));
                v += __builtin_bit_cast(float, __builtin_amdgcn_update_dpp(0, __builtin_bit_cast(int, v), 0x142, 0xa, 0xf, false));
                const float tot = __builtin_bit_cast(float, __builtin_amdgcn_readlane(__builtin_bit_cast(int, v), 31));
                const float cum = dir ? (tot - v + dA) : v;
                if (hl == 0) { wsf[c31] = cum; wsf[32 + c31] = dt; wsf[64 + c31] = __expf(tot - cum) * dt; wsf[96 + c31] = __expf(cum); }
            }
            asm volatile("s_waitcnt lgkmcnt(0)" ::: "memory"); __builtin_amdgcn_s_barrier(); asm volatile("" ::: "memory");
            if (step + 2 < 136) SC_PF(pfE, step + 2); if (step + 1 < 136) dtraw = SC_DTLOAD(step + 1);
#pragma unroll
            for (int T = 0; T < 2; ++T) {
                const int tok = F.tid >> 4, h4 = (F.tid >> 2) & 3, q4 = F.tid & 3, chunk = T ? cbk : cf;
                const int other = T == 0 ? (chunk < 8 ? 7 - chunk : 143 - chunk) : chunk;
                if (PH == 0 && step > other) oldy[T] = *(const u32x4*)(Y + (size_t)(b * SROW + chunk * 32 + tok) * DIN + g * 256 + ph * 128 + h4 * 32 + q4 * 8);
            }
            if (PH < 3) {
                const LAS unsigned char* Bs = F.lds + dir * SC_TILE; const LAS unsigned char* Cs = Bs + 32 * SC_RS; const LAS unsigned char* xs = Bs + 64 * SC_RS;
                f32x16 gt;
#pragma unroll
                for (int e = 0; e < 16; ++e) gt[e] = 0.f;
#pragma unroll
                for (int s = 0; s < 8; ++s) { const bf16x8 a = *(const LAS bf16x8*)(F.lds + offRow + 32 * s), bb = *(const LAS bf16x8*)(F.lds + offRow + 32 * SC_RS + 32 * s); gt = MFMA32(a, bb, gt); }
                const float cum_i = wsf[c31];
                bf16x8 mk[2];
                {
                    float mv[16];
#pragma unroll
                    for (int q = 0; q < 4; ++q) { const f32x4 cj = *(const LAS f32x4*)(wsf + 8 * q + 4 * hl), dj = *(const LAS f32x4*)(wsf + 32 + 8 * q + 4 * hl);
#pragma unroll
                        for (int z = 0; z < 4; ++z) { const int jj = 8 * q + 4 * hl + z; const bool ok = dir ? (jj >= c31) : (jj <= c31);
                            float val = gt[4 * q + z] * __expf(ok ? (cum_i - cj[z]) : -INFINITY) * dj[z]; if (jj == c31) val += Dk; mv[4 * q + z] = val; } }
#pragma unroll
                    for (int s2 = 0; s2 < 2; ++s2) { u32x4 w; w.x = cvtpk(mv[8 * s2], mv[8 * s2 + 1]); w.y = cvtpk(mv[8 * s2 + 2], mv[8 * s2 + 3]); w.z = cvtpk(mv[8 * s2 + 4], mv[8 * s2 + 5]); w.w = cvtpk(mv[8 * s2 + 6], mv[8 * s2 + 7]); mk[s2] = __builtin_bit_cast(bf16x8, w); }
                }
                f32x16 ya;
#pragma unroll
                for (int e = 0; e < 16; ++e) ya[e] = 0.f;
#pragma unroll
                for (int t = 0; t < 4; ++t)
#pragma unroll
                    for (int s2 = 0; s2 < 2; ++s2) {
                        const LAS unsigned char* cp = F.lds + offC4 + 64 * t + 32 * s2;
                        const u32x2 c0 = *(const LAS u32x2*)cp, c1 = *(const LAS u32x2*)(cp + 16);
                        const bf16x8 ca = __builtin_bit_cast(bf16x8, (u32x4){c0.x, c0.y, c1.x, c1.y});
                        u32x4 w; w.x = cvtpk(ST[t][8 * s2], ST[t][8 * s2 + 1]); w.y = cvtpk(ST[t][8 * s2 + 2], ST[t][8 * s2 + 3]); w.z = cvtpk(ST[t][8 * s2 + 4], ST[t][8 * s2 + 5]); w.w = cvtpk(ST[t][8 * s2 + 6], ST[t][8 * s2 + 7]);
                        ya = MFMA32(ca, __builtin_bit_cast(bf16x8, w), ya);
                    }
#pragma unroll
                for (int q = 0; q < 4; ++q) { const f32x4 ec = *(const LAS f32x4*)(wsf + 96 + 8 * q + 4 * hl); ya[4 * q] *= ec.x; ya[4 * q + 1] *= ec.y; ya[4 * q + 2] *= ec.z; ya[4 * q + 3] *= ec.w; }
#pragma unroll
                for (int s2 = 0; s2 < 2; ++s2) {
                    const LAS unsigned char* xp = F.lds + offTrX + (16 * s2) * SC_RS + hl * (4 * SC_RS);
                    const s16x4 lo = vtr(xp), hi = vtr(xp + 8 * SC_RS);
                    ya = MFMA32(mk[s2], ((bf16x8){lo[0], lo[1], lo[2], lo[3], hi[0], hi[1], hi[2], hi[3]}), ya);
                }
                {
                    const float etot = dir ? wsf[96] : wsf[96 + 31];
#pragma unroll
                    for (int t = 0; t < 4; ++t)
#pragma unroll
                        for (int e = 0; e < 16; ++e) ST[t][e] *= etot;
#pragma unroll
                    for (int s2 = 0; s2 < 2; ++s2) {
                        const LAS unsigned char* xp = F.lds + offTrX + (16 * s2) * SC_RS + hl * (8 * SC_RS);
                        const s16x4 lo = vtr(xp), hi = vtr(xp + 4 * SC_RS);
                        const f32x4 w0 = *(const LAS f32x4*)(wsf + 64 + 16 * s2 + 8 * hl), w1 = *(const LAS f32x4*)(wsf + 64 + 16 * s2 + 8 * hl + 4);
                        u32x4 xw; xw.x = cvtpk(bf1((bf16_t)lo[0]) * w0.x, bf1((bf16_t)lo[1]) * w0.y); xw.y = cvtpk(bf1((bf16_t)lo[2]) * w0.z, bf1((bf16_t)lo[3]) * w0.w);
                        xw.z = cvtpk(bf1((bf16_t)hi[0]) * w1.x, bf1((bf16_t)hi[1]) * w1.y); xw.w = cvtpk(bf1((bf16_t)hi[2]) * w1.z, bf1((bf16_t)hi[3]) * w1.w);
                        const bf16x8 xb8 = __builtin_bit_cast(bf16x8, xw);
#pragma unroll
                        for (int t = 0; t < 4; ++t) {
                            const LAS unsigned char* bp = F.lds + offTrB + (16 * s2) * SC_RS + hl * (8 * SC_RS) + 64 * t;
                            const s16x4 blo = vtr(bp), bhi = vtr(bp + 4 * SC_RS);
                            ST[t] = MFMA32(((bf16x8){blo[0], blo[1], blo[2], blo[3], bhi[0], bhi[1], bhi[2], bhi[3]}), xb8, ST[t]);
                        }
                    }
                }
                LAS bf16_t* ys = (LAS bf16_t*)(F.lds + SC_YS + dir * 8192) + ysoff;
#pragma unroll
                for (int e = 0; e < 16; e += 2) { const unsigned w = cvtpk(ya[e], ya[e + 1]); ys[((e & 3) + 8 * (e >> 2)) * 128] = (bf16_t)w; ys[((e & 3) + 1 + 8 * (e >> 2)) * 128] = (bf16_t)(w >> 16); }
            }
                  }
          { const int step = step2 + 1;
            const int cf = step, cbk = step < 8 ? 7 - step : 143 - step;
            __syncthreads();
            if (step > 0) SC_WRITEOUT(step - 1);
#pragma unroll
            for (int T = 0; T < 2; ++T)
#pragma unroll
                for (int a = 0; a < 3; ++a) *(LAS u32x4*)(F.lds + T * SC_TILE + a * (32 * SC_RS) + srow * SC_RS + sch * 16) = pfO[T][a];
            {
                const float xb = dtraw + dtb;
                const float dt = xb > 20.f ? xb : log1pf(__expf(xb)); const float dA = dt * aneg;
                float v = dA;
                v += __builtin_bit_cast(float, __builtin_amdgcn_update_dpp(0, __builtin_bit_cast(int, v), 0x111, 0xf, 0xf, true));
                v += __builtin_bit_cast(float, __builtin_amdgcn_update_dpp(0, __builtin_bit_cast(int, v), 0x112, 0xf, 0xf, true));
                v += __builtin_bit_cast(float, __builtin_amdgcn_update_dpp(0, __builtin_bit_cast(int, v), 0x114, 0xf, 0xf, true));
                v += __builtin_bit_cast(float, __builtin_amdgcn_update_dpp(0, __builtin_bit_cast(int, v), 0x118, 0xf, 0xf, true));
                v += __builtin_bit_cast(float, __builtin_amdgcn_update_dpp(0, __builtin_bit_cast(int, v), 0x142, 0xa, 0xf, false));
                const float tot = __builtin_bit_cast(float, __builtin_amdgcn_readlane(__builtin_bit_cast(int, v), 31));
                const float cum = dir ? (tot - v + dA) : v;
                if (hl == 0) { wsf[c31] = cum; wsf[32 + c31] = dt; wsf[64 + c31] = __expf(tot - cum) * dt; wsf[96 + c31] = __expf(cum); }
            }
            asm volatile("s_waitcnt lgkmcnt(0)" ::: "memory"); __builtin_amdgcn_s_barrier(); asm volatile("" ::: "memory");
            if (step + 2 < 136) SC_PF(pfO, step + 2); if (step + 1 < 136) dtraw = SC_DTLOAD(step + 1);
#pragma unroll
            for (int T = 0; T < 2; ++T) {
                const int tok = F.tid >> 4, h4 = (F.tid >> 2) & 3, q4 = F.tid & 3, chunk = T ? cbk : cf;
                const int other = T == 0 ? (chunk < 8 ? 7 - chunk : 143 - chunk) : chunk;
                if (PH == 0 && step > other) oldy[T] = *(const u32x4*)(Y + (size_t)(b * SROW + chunk * 32 + tok) * DIN + g * 256 + ph * 128 + h4 * 32 + q4 * 8);
            }
            if (PH < 3) {
                const LAS unsigned char* Bs = F.lds + dir * SC_TILE; const LAS unsigned char* Cs = Bs + 32 * SC_RS; const LAS unsigned char* xs = Bs + 64 * SC_RS;
                f32x16 gt;
#pragma unroll
                for (int e = 0; e < 16; ++e) gt[e] = 0.f;
#pragma unroll
                for (int s = 0; s < 8; ++s) { const bf16x8 a = *(const LAS bf16x8*)(F.lds + offRow + 32 * s), bb = *(const LAS bf16x8*)(F.lds + offRow + 32 * SC_RS + 32 * s); gt = MFMA32(a, bb, gt); }
                const float cum_i = wsf[c31];
                bf16x8 mk[2];
                {
                    float mv[16];
#pragma unroll
                    for (int q = 0; q < 4; ++q) { const f32x4 cj = *(const LAS f32x4*)(wsf + 8 * q + 4 * hl), dj = *(const LAS f32x4*)(wsf + 32 + 8 * q + 4 * hl);
#pragma unroll
                        for (int z = 0; z < 4; ++z) { const int jj = 8 * q + 4 * hl + z; const bool ok = dir ? (jj >= c31) : (jj <= c31);
                            float val = gt[4 * q + z] * __expf(ok ? (cum_i - cj[z]) : -INFINITY) * dj[z]; if (jj == c31) val += Dk; mv[4 * q + z] = val; } }
#pragma unroll
                    for (int s2 = 0; s2 < 2; ++s2) { u32x4 w; w.x = cvtpk(mv[8 * s2], mv[8 * s2 + 1]); w.y = cvtpk(mv[8 * s2 + 2], mv[8 * s2 + 3]); w.z = cvtpk(mv[8 * s2 + 4], mv[8 * s2 + 5]); w.w = cvtpk(mv[8 * s2 + 6], mv[8 * s2 + 7]); mk[s2] = __builtin_bit_cast(bf16x8, w); }
                }
                f32x16 ya;
#pragma unroll
                for (int e = 0; e < 16; ++e) ya[e] = 0.f;
#pragma unroll
                for (int t = 0; t < 4; ++t)
#pragma unroll
                    for (int s2 = 0; s2 < 2; ++s2) {
                        const LAS unsigned char* cp = F.lds + offC4 + 64 * t + 32 * s2;
                        const u32x2 c0 = *(const LAS u32x2*)cp, c1 = *(const LAS u32x2*)(cp + 16);
                        const bf16x8 ca = __builtin_bit_cast(bf16x8, (u32x4){c0.x, c0.y, c1.x, c1.y});
                        u32x4 w; w.x = cvtpk(ST[t][8 * s2], ST[t][8 * s2 + 1]); w.y = cvtpk(ST[t][8 * s2 + 2], ST[t][8 * s2 + 3]); w.z = cvtpk(ST[t][8 * s2 + 4], ST[t][8 * s2 + 5]); w.w = cvtpk(ST[t][8 * s2 + 6], ST[t][8 * s2 + 7]);
                        ya = MFMA32(ca, __builtin_bit_cast(bf16x8, w), ya);
                    }
#pragma unroll
                for (int q = 0; q < 4; ++q) { const f32x4 ec = *(const LAS f32x4*)(wsf + 96 + 8 * q + 4 * hl); ya[4 * q] *= ec.x; ya[4 * q + 1] *= ec.y; ya[4 * q + 2] *= ec.z; ya[4 * q + 3] *= ec.w; }
#pragma unroll
                for (int s2 = 0; s2 < 2; ++s2) {
                    const LAS unsigned char* xp = F.lds + offTrX + (16 * s2) * SC_RS + hl * (4 * SC_RS);
                    const s16x4 lo = vtr(xp), hi = vtr(xp + 8 * SC_RS);
                    ya = MFMA32(mk[s2], ((bf16x8){lo[0], lo[1], lo[2], lo[3], hi[0], hi[1], hi[2], hi[3]}), ya);
                }
                {
                    const float etot = dir ? wsf[96] : wsf[96 + 31];
#pragma unroll
                    for (int t = 0; t < 4; ++t)
#pragma unroll
                        for (int e = 0; e < 16; ++e) ST[t][e] *= etot;
#pragma unroll
                    for (int s2 = 0; s2 < 2; ++s2) {
                        const LAS unsigned char* xp = F.lds + offTrX + (16 * s2) * SC_RS + hl * (8 * SC_RS);
                        const s16x4 lo = vtr(xp), hi = vtr(xp + 4 * SC_RS);
                        const f32x4 w0 = *(const LAS f32x4*)(wsf + 64 + 16 * s2 + 8 * hl), w1 = *(const LAS f32x4*)(wsf + 64 + 16 * s2 + 8 * hl + 4);
                        u32x4 xw; xw.x = cvtpk(bf1((bf16_t)lo[0]) * w0.x, bf1((bf16_t)lo[1]) * w0.y); xw.y = cvtpk(bf1((bf16_t)lo[2]) * w0.z, bf1((bf16_t)lo[3]) * w0.w);
                        xw.z = cvtpk(bf1((bf16_t)hi[0]) * w1.x, bf1((bf16_t)hi[1]) * w1.y); xw.w = cvtpk(bf1((bf16_t)hi[2]) * w1.z, bf1((bf16_t)hi[3]) * w1.w);
                        const bf16x8 xb8 = __builtin_bit_cast(bf16x8, xw);
#pragma unroll
                        for (int t = 0; t < 4; ++t) {
                            const LAS unsigned char* bp = F.lds + offTrB + (16 * s2) * SC_RS + hl * (8 * SC_RS) + 64 * t;
                            const s16x4 blo = vtr(bp), bhi = vtr(bp + 4 * SC_RS);
                            ST[t] = MFMA32(((bf16x8){blo[0], blo[1], blo[2], blo[3], bhi[0], bhi[1], bhi[2], bhi[3]}), xb8, ST[t]);
                        }
                    }
                }
                LAS bf16_t* ys = (LAS bf16_t*)(F.lds + SC_YS + dir * 8192) + ysoff;
#pragma unroll
                for (int e = 0; e < 16; e += 2) { const unsigned w = cvtpk(ya[e], ya[e + 1]); ys[((e & 3) + 8 * (e >> 2)) * 128] = (bf16_t)w; ys[((e & 3) + 1 + 8 * (e >> 2)) * 128] = (bf16_t)(w >> 16); }
            }
                  }
        }
        VM_WAIT(); __syncthreads();
        SC_WRITEOUT(135);
#undef SC_PF
#undef SC_DTLOAD
#undef SC_WRITEOUT
        __syncthreads();
    }
}

__device__ __forceinline__ void attn_phase(Frame& F, const Args& A, int ja, bool need_ctx, int nwg) {
    phase_enter(F);
    const bf16_t* Q = (const bf16_t*)(F.ws + WS_BIG); bf16_t* O = (bf16_t*)F.out;     const bf16_t* Kb = (const bf16_t*)(F.ws + WS_BIG + BIG_K); const bf16_t* Vb = (const bf16_t*)(F.ws + WS_BIG + BIG_V);
    LAS unsigned char* Kl = F.lds; LAS unsigned char* Vl = F.lds + 9216;
    const int nunits = 2048 + (need_ctx ? 128 : 0);
    const int lane = F.lane, r = F.wave >> 1, rh = F.wave & 1, c31 = lane & 31, hl = lane >> 5;
    const int prow = F.tid >> 3, ppc = F.tid & 7;
    const int trq = (lane & 15) >> 2, trp = lane & 3, trb = (lane >> 4) & 1;
    for (int unit = blockIdx.x; unit < nunits; unit += nwg) {
        int b, g, nblk; bool cq;
        if (unit < 2048) { b = unit >> 7; nblk = (unit >> 2) & 31; g = unit & 3; cq = false; } else { const int u2 = unit - 2048; b = u2 >> 3; nblk = (u2 >> 2) & 1; g = u2 & 3; cq = true; }
        const int qrow0 = b * SROW + (cq ? 128 * nblk : NCTX + 128 * nblk);
        const int start = 128 * nblk;
        bf16x8 qf[2][4];
#pragma unroll
        for (int qb = 0; qb < 2; ++qb)
#pragma unroll
            for (int s = 0; s < 4; ++s) qf[qb][s] = *(const bf16x8*)(Q + (size_t)(qrow0 + 64 * rh + 32 * qb + c31) * QW + g * 256 + r * 64 + 16 * s + 8 * hl);
        const float sink = A.attn_sink[ja * 16 + g * 4 + r] * 1.4426950408889634f;
        float mrun[2] = {sink, sink}, lrun[2] = {1.f, 1.f};
        f32x16 ot[2][2];
#pragma unroll
        for (int db = 0; db < 2; ++db)
#pragma unroll
            for (int qb = 0; qb < 2; ++qb)
#pragma unroll
                for (int e = 0; e < 16; ++e) ot[db][qb][e] = 0.f;
        const int tt_lo = cq ? 0 : (nblk == 0 ? 2 : 0), tt_hi = cq ? 0 : (nblk == 31 ? 4 : 6);
        const int ntile = 4 + (tt_hi - tt_lo);
#define TILE_ROW0(t) ((t) < 4 ? b * SROW + 64 * (t) : b * SROW + NCTX + start - 128 + 64 * (tt_lo + (t) - 4))
        u32x4 kreg, vreg;
        { const int r0 = TILE_ROW0(0); kreg = *(const u32x4*)(Kb + (size_t)(r0 + prow) * KVW + g * 64 + ppc * 8); vreg = *(const u32x4*)(Vb + (size_t)(r0 + prow) * KVW + g * 64 + ppc * 8); }
        for (int t = 0; t < ntile; ++t) {
            __syncthreads();
            *(LAS u32x4*)(Kl + prow * 144 + ppc * 16) = kreg; *(LAS u32x4*)(Vl + prow * 144 + ppc * 16) = vreg;
            __syncthreads();
            if (t + 1 < ntile) { const int r0 = TILE_ROW0(t + 1); kreg = *(const u32x4*)(Kb + (size_t)(r0 + prow) * KVW + g * 64 + ppc * 8); vreg = *(const u32x4*)(Vb + (size_t)(r0 + prow) * KVW + g * 64 + ppc * 8); }
            const int dk0 = (t >= 4) ? (-128 + 64 * (tt_lo + t - 4)) - 64 * rh : 0;
            const bool tile_empty = (t >= 4) && (dk0 <= -192 || dk0 >= 192);
            const bool tile_mask = (t >= 4) && !tile_empty && (dk0 < -65 || dk0 > 65);
            if (!tile_empty) {
            f32x16 st[2][2];
#pragma unroll
            for (int kb = 0; kb < 2; ++kb) {
#pragma unroll
                for (int qb = 0; qb < 2; ++qb)
#pragma unroll
                    for (int e = 0; e < 16; ++e) st[kb][qb][e] = 0.f;
#pragma unroll
                for (int s = 0; s < 4; ++s) { const bf16x8 a = *(const LAS bf16x8*)(Kl + (32 * kb + c31) * 144 + (16 * s + 8 * hl) * 2);
                    st[kb][0] = MFMA32(a, qf[0][s], st[kb][0]); st[kb][1] = MFMA32(a, qf[1][s], st[kb][1]); }
            }
            if (tile_mask) { const int kpos0 = start - 128 + 64 * (tt_lo + t - 4);
#pragma unroll
                for (int kb = 0; kb < 2; ++kb)
#pragma unroll
                    for (int qb = 0; qb < 2; ++qb) { const int qpos = start + 64 * rh + 32 * qb + c31;
#pragma unroll
                        for (int e = 0; e < 16; ++e) { const int d = qpos - (kpos0 + 32 * kb + crow(e, hl)); if (d > 128 || d < -128) st[kb][qb][e] = -INFINITY; } }
            }
#pragma unroll
            for (int qb = 0; qb < 2; ++qb) {
                float mx = st[0][qb][0];
#pragma unroll
                for (int kb = 0; kb < 2; ++kb)
#pragma unroll
                    for (int e = 0; e < 16; ++e) mx = fmaxf(mx, st[kb][qb][e]);
                mx = fmaxf(mx, shx(mx, 32, lane));
                const float mn = fmaxf(mrun[qb], mx);
                const bool grew = mn > mrun[qb];
                float rs = 0.f;
#pragma unroll
                for (int kb = 0; kb < 2; ++kb)
#pragma unroll
                    for (int e = 0; e < 16; ++e) { const float pv = __builtin_amdgcn_exp2f(st[kb][qb][e] - mn); st[kb][qb][e] = pv; rs += pv; }
                rs += shx(rs, 32, lane);
                if (__any(grew)) {
                    const float alpha = __builtin_amdgcn_exp2f(mrun[qb] - mn);
                    lrun[qb] = lrun[qb] * alpha + rs;
#pragma unroll
                    for (int db = 0; db < 2; ++db)
#pragma unroll
                        for (int e = 0; e < 16; ++e) ot[db][qb][e] *= alpha;
                } else lrun[qb] += rs;
                mrun[qb] = mn;
            }
#pragma unroll
            for (int kb = 0; kb < 2; ++kb)
#pragma unroll
                for (int s2 = 0; s2 < 2; ++s2) {
                    bf16x8 pk[2];
#pragma unroll
                    for (int qb = 0; qb < 2; ++qb) { u32x4 w; w.x = cvtpk(st[kb][qb][8 * s2 + 0], st[kb][qb][8 * s2 + 1]); w.y = cvtpk(st[kb][qb][8 * s2 + 2], st[kb][qb][8 * s2 + 3]);
                        w.z = cvtpk(st[kb][qb][8 * s2 + 4], st[kb][qb][8 * s2 + 5]); w.w = cvtpk(st[kb][qb][8 * s2 + 6], st[kb][qb][8 * s2 + 7]); pk[qb] = __builtin_bit_cast(bf16x8, w); }
#pragma unroll
                    for (int db = 0; db < 2; ++db) {
                        const LAS unsigned char* vp = Vl + (32 * kb + 16 * s2 + 4 * hl + trq) * 144 + (32 * db + 16 * trb + 4 * trp) * 2;
                        const s16x4 lo = vtr(vp), hi = vtr(vp + 8 * 144);
                        const bf16x8 va = (bf16x8){lo[0], lo[1], lo[2], lo[3], hi[0], hi[1], hi[2], hi[3]};
                        ot[db][0] = MFMA32(va, pk[0], ot[db][0]); ot[db][1] = MFMA32(va, pk[1], ot[db][1]);
                    }
                }
            }
        }
#undef TILE_ROW0
#pragma unroll
        for (int qb = 0; qb < 2; ++qb) { const float inv = 1.0f / lrun[qb]; bf16_t* op = O + (size_t)(qrow0 + 64 * rh + 32 * qb + c31) * QW + g * 256 + r * 64;
#pragma unroll
            for (int db = 0; db < 2; ++db)
#pragma unroll
                for (int gq = 0; gq < 4; ++gq) { u32x2 w; w.x = cvtpk(ot[db][qb][4 * gq] * inv, ot[db][qb][4 * gq + 1] * inv); w.y = cvtpk(ot[db][qb][4 * gq + 2] * inv, ot[db][qb][4 * gq + 3] * inv);
                    *(u32x2*)(op + 32 * db + 8 * gq + 4 * hl) = w; } }
    }
    __syncthreads();
}


#ifndef PHMASK
#define PHMASK 0xFFFF
#endif
#define PHON(k) (((PHMASK) >> (k)) & 1)
#ifndef REPMASK
#define REPMASK 0x0
#endif
#define REP(k) (((REPMASK) >> (k)) & 1)
#ifndef MK_PER_PHASE
#define MK_PER_PHASE 0
#endif
#ifndef TIMER_LO
#define TIMER_LO 999
#define TIMER_HI 999
#endif
#define TIMER_ON (TIMER_LO < 999)
#define IN(k) (lo <= (k) && (k) < hi)
#define SEAM(k) do { if (IN(k) && IN((k) + 1)) { xcd_barrier(bar); } if (TIMER_ON) { const unsigned long long now_ = __builtin_amdgcn_s_memrealtime(); if ((k) >= TIMER_LO && (k) <= TIMER_HI) TM.acc += now_ - TM.prev; TM.prev = now_; } } while (0)
#define SITE_PTRS phase_enter(F); unsigned char* ws = F.ws; bf16_t* H = (bf16_t*)F.out; bf16_t* BIG = (bf16_t*)(ws + WS_BIG); const float* MODV = (const float*)(ws + WS_MODV); (void)H; (void)BIG; (void)MODV; \
        unsigned char* wss = ws + WS_W + (size_t)lp * W_SSD_STRIDE; unsigned char* wsa = ws + WS_W + W_ATT0 + (size_t)lp * W_ATT_STRIDE; (void)wss; (void)wsa;
struct Timer { unsigned long long prev, acc; };
template <int lp, int c> __device__ __forceinline__ void moe_chunk(Frame& F, const Args& A, const int lo, const int hi, const XcdBarrier& bar, LAS unsigned char* ring, Timer& TM) {
    constexpr int pb = 1 + lp * 20;
            const int pu = pb + 14 + 2 * c, pd = pu + 1;
            if (IN(pu) || IN(pd)) {
                SITE_PTRS
                MoeOrder mo;
                mo.pp[0] = 0;
#pragma unroll
                for (int e = 0; e < 8; ++e) { const int cn = __builtin_amdgcn_readfirstlane((int)__hip_atomic_load((unsigned*)(F.ctl + CW_CNT + (size_t)(lp * 8 + e) * 64), RLX_AGENT)); mo.cnt[e] = cn; mo.pp[e + 1] = mo.pp[e] + ((cn + 255) >> 8); }
                const int Ptot = mo.pp[8]; int nP = Ptot - c * MOE_CHUNK; nP = nP < 0 ? 0 : (nP > MOE_CHUNK ? MOE_CHUNK : nP);
                mo.cs = c * MOE_CHUNK; mo.rlist = (const int*)(ws + WS_RLIST);
                if (PHON(10) && IN(pu)) { mo.so.init(nP, 2 * DFFE / 256, F.G, (int)blockIdx.x); mo.GATHER_A = true; mo.bstride = (size_t)2 * DFFE * 1024 * 2;
                    pg8::Gemm g{H, (const bf16_t*)(ws + WS_BIG + BIG_MW13), 1024, 1024}; EpiSwiglu E{BIG, DFFE}; pg8::gemm_phase<EpiSwiglu, MoeOrder, true, true>(ring, g, mo, E, F.wave0); }
                SEAM(pu);
                if (PHON(11) && IN(pd)) { mo.so.init(nP, 4, F.G, (int)blockIdx.x); mo.GATHER_A = false; mo.bstride = (size_t)1024 * DFFE * 2;
                    pg8::Gemm g{BIG, (const bf16_t*)(ws + WS_BIG + BIG_MW2), DFFE, DFFE}; EpiMoeDown E{mo, (bf16_t*)(ws + WS_Y), (const float*)(ws + WS_GATE)}; pg8::gemm_phase<EpiMoeDown, MoeOrder, true, false>(ring, g, mo, E, F.wave0); }
            }
            SEAM(pd);
        }
template <int lp> __device__ __forceinline__ void layer_pair(Frame& F, const Args& A, const int lo, const int hi, const XcdBarrier& bar, LAS unsigned char* ring, Timer& TM) {
        const int pb = 1 + lp * 20, i0 = 2 * lp, i1 = 2 * lp + 1;
        if (PHON(1) && IN(pb + 0)) norm_phase(F, A, i0, 0, lp == 0 ? 1 : 2);
        SEAM(pb + 0);
        if (PHON(2) && IN(pb + 1)) { SITE_PTRS pg8::Gemm g{H, (const bf16_t*)(wss + W_WIN), 1024, 1024}; pg8::StaticOrder S; S.init(NPAN, NXBC / 256, F.G, (int)blockIdx.x);
            EpiXbc E{BIG, (float*)(ws + WS_DT), (bf16_t*)(ws + WS_HALO)}; pg8::gemm_phase<EpiXbc, pg8::StaticOrder, true, false>(ring, g, S, E, F.wave0); }
        SEAM(pb + 1);
        if (PHON(3) && IN(pb + 2)) conv_phase(F, A, lp);
        SEAM(pb + 2);
        if (PHON(3) && IN(pb + 3)) scan_phase<0>(F, A, lp);
        SEAM(pb + 3);
        if (PHON(4) && IN(pb + 4)) { SITE_PTRS pg8::Gemm g{H, (const bf16_t*)(wss + W_WZ), 1024, 1024}; pg8::StaticOrder S; S.init(NPAN, DIN / 256, F.G, (int)blockIdx.x);
            EpiGate E{(const bf16_t*)(ws + WS_Y), BIG, A.ssd_norm_w + (size_t)lp * DIN, (LAS float*)(F.lds + PSCR_OFF)}; pg8::gemm_phase<EpiGate, pg8::StaticOrder, true, false>(ring, g, S, E, F.wave0); }
        SEAM(pb + 4);
        if (PHON(5) && IN(pb + 5)) { SITE_PTRS pg8::Gemm g{BIG, (const bf16_t*)(wss + W_WOUT), DIN, DIN}; pg8::PanelOrder S; S.init(256, 4, F.G, (int)blockIdx.x);
            EpiResidNorm E{(bf16_t*)(ws + WS_XR), MODV + (size_t)i0 * 17 * 6144, 2, nullptr, lp == 0 ? A.x : nullptr, lp == 0 ? A.ctx : nullptr,
                           H, A.norm2_w + i0 * 1024, MODV + (size_t)i0 * 17 * 6144, 3, (unsigned*)(ws + WS_XCH), (unsigned*)(F.ctl + CW_PAN + (size_t)(lp * 2 + 0) * NPAN * 64), (unsigned*)(F.ctl + CW_BAR) + XB_TMO, F.lds + PSCR_OFF};
            pg8::gemm_phase<EpiResidNorm, pg8::PanelOrder, true, false>(ring, g, S, E, F.wave0);
            { const int ks = ((int)blockIdx.x >> 3) & 3; int t0, n; split4(DIN / 64, ks, t0, n); pg8::Gemm gt{g.A, g.Bt, DIN, n * 64, DIN}; pg8::TailOrder T{(int)blockIdx.x, 256, (unsigned)t0 * 128u};
              TailEpi<EpiResidNorm> TE{E, ks, ws + WS_Y, (unsigned*)(F.ctl + CW_TAIL + (size_t)(lp * 3 + 0) * 8192), (unsigned*)(F.ctl + CW_BAR) + XB_TMO};
              pg8::gemm_phase<TailEpi<EpiResidNorm>, pg8::TailOrder, true, false>(ring, gt, T, TE, F.wave0); } }
        SEAM(pb + 6);
        if (PHON(6) && IN(pb + 7)) { SITE_PTRS pg8::Gemm g{H, (const bf16_t*)(wss + W_WUP), 1024, 1024}; pg8::StaticOrder S; S.init(NPAN, 2 * DFF / 256, F.G, (int)blockIdx.x);
            EpiSwiglu E{BIG, DFF}; pg8::gemm_phase<EpiSwiglu, pg8::StaticOrder, true, false>(ring, g, S, E, F.wave0); }
        SEAM(pb + 7);
        if (PHON(5) && IN(pb + 8)) { SITE_PTRS pg8::Gemm g{BIG, (const bf16_t*)(wss + W_WDN), DFF, DFF}; pg8::PanelOrder S; S.init(256, 4, F.G, (int)blockIdx.x);
            EpiResidNorm E{(bf16_t*)(ws + WS_XR), MODV + (size_t)i0 * 17 * 6144, 5, nullptr, nullptr, nullptr,
                           H, A.norm1_w + i1 * 1024, MODV + (size_t)i1 * 17 * 6144, 0, (unsigned*)(ws + WS_XCH), (unsigned*)(F.ctl + CW_PAN + (size_t)(lp * 2 + 1) * NPAN * 64), (unsigned*)(F.ctl + CW_BAR) + XB_TMO, F.lds + PSCR_OFF};
            pg8::gemm_phase<EpiResidNorm, pg8::PanelOrder, true, false>(ring, g, S, E, F.wave0);
            { const int ks = ((int)blockIdx.x >> 3) & 3; int t0, n; split4(DFF / 64, ks, t0, n); pg8::Gemm gt{g.A, g.Bt, DFF, n * 64, DFF}; pg8::TailOrder T{(int)blockIdx.x, 256, (unsigned)t0 * 128u};
              TailEpi<EpiResidNorm> TE{E, ks, ws + WS_Y, (unsigned*)(F.ctl + CW_TAIL + (size_t)(lp * 3 + 1) * 8192), (unsigned*)(F.ctl + CW_BAR) + XB_TMO};
              pg8::gemm_phase<TailEpi<EpiResidNorm>, pg8::TailOrder, true, false>(ring, gt, T, TE, F.wave0); } }
        SEAM(pb + 9);
        if (PHON(7) && IN(pb + 10)) { SITE_PTRS pg8::Gemm g{H, (const bf16_t*)(wsa + W_WQKV), 1024, 1024}; pg8::StaticOrder S; S.init(NPAN, NQKV / 256, F.G, (int)blockIdx.x);
            LAS float* qt = (LAS float*)(F.lds + PSCR_OFF);
            { const float* rp = (const float*)(ws + WS_ROPE); const float* bq = A.attn_b_qkv + (size_t)lp * NQKV; for (int idx = F.tid; idx < 3584; idx += 512) qt[idx] = idx < 2048 ? rp[idx] : bq[idx - 2048]; }
            __syncthreads();
            EpiQkv E{BIG, (bf16_t*)(ws + WS_BIG + BIG_K), (bf16_t*)(ws + WS_BIG + BIG_V), qt};
            pg8::gemm_phase<EpiQkv, pg8::StaticOrder, true, false>(ring, g, S, E, F.wave0); }
        SEAM(pb + 10);
        if (PHON(8) && IN(pb + 11)) { const int nconv = F.G >= 9996 ? 48 : 0;
            if ((int)blockIdx.x < F.G - nconv) attn_phase(F, A, lp, lp == 0, F.G - nconv); else moe_convert(F, A, lp, F.G - nconv, nconv); }
        SEAM(pb + 11);
        if (PHON(5) && IN(pb + 12)) { SITE_PTRS pg8::Gemm g{H, (const bf16_t*)(wsa + W_WO), 1024, 1024};
            EpiResid E{(bf16_t*)(ws + WS_XR), MODV + (size_t)i1 * 17 * 6144, 2, A.attn_b_o + (size_t)lp * 1024, nullptr, nullptr};
            if (lp == 1) { pg8::LatentOrder S; S.init(NPAN - NB, 4, F.G, (int)blockIdx.x); pg8::gemm_phase<EpiResid, pg8::LatentOrder, true, false>(ring, g, S, E, F.wave0); }
            else { pg8::StaticOrder S; S.init(256, 4, F.G, (int)blockIdx.x); pg8::gemm_phase<EpiResid, pg8::StaticOrder, true, false>(ring, g, S, E, F.wave0);
                const int ks = ((int)blockIdx.x >> 3) & 3; int t0, n; split4(1024 / 64, ks, t0, n); pg8::Gemm gt{g.A, g.Bt, 1024, n * 64, 1024}; pg8::TailOrder T{(int)blockIdx.x, 256, (unsigned)t0 * 128u};
                TailEpi<EpiResid> TE{E, ks, ws + WS_Y, (unsigned*)(F.ctl + CW_TAIL + (size_t)(lp * 3 + 2) * 8192), (unsigned*)(F.ctl + CW_BAR) + XB_TMO};
                pg8::gemm_phase<TailEpi<EpiResid>, pg8::TailOrder, true, false>(ring, gt, T, TE, F.wave0); } }
        SEAM(pb + 12);
        if (PHON(9) && IN(pb + 13)) { norm_phase(F, A, i1, 1, 4 | (lp == 1 ? 16 : 0)); if (F.G < 9996) { __syncthreads(); moe_convert(F, A, lp, 0, F.G); } }
        SEAM(pb + 13);
    moe_chunk<lp, 0>(F, A, lo, hi, bar, ring, TM); moe_chunk<lp, 1>(F, A, lo, hi, bar, ring, TM); moe_chunk<lp, 2>(F, A, lo, hi, bar, ring, TM);
}
constexpr int N_PHASES = 42;
__global__ void __launch_bounds__(NWAVES * 64, 2) fwd_kernel(Args A) {
    extern __shared__ __attribute__((aligned(16))) unsigned char lds_raw[];
    Frame F;
    F.lds = (LAS unsigned char*)lds_raw;
    F.tid = threadIdx.x; F.lane = F.tid & 63; F.wave = __builtin_amdgcn_readfirstlane(F.tid >> 6); F.wave0 = F.wave; F.G = gridDim.x;
    F.ws0 = A.ws; F.out0 = A.out; F.ws = A.ws; F.ctl = (gu32*)(A.ws + WS_CTL); F.out = A.out;
    volatile LAS unsigned* MISC = (volatile LAS unsigned*)(F.lds + MISC_OFF);
    for (int u = F.tid; u < (LDS_BYTES - LDSCTL_OFF) / 4; u += NWAVES * 64) ((LAS unsigned*)(F.lds + LDSCTL_OFF))[u] = 0u;
    __syncthreads();
    const int lo = A.ph_lo, hi = A.ph_hi;
    XcdBarrier bar; bar.bar = (unsigned*)(F.ctl + CW_BAR); bar.x = 0; bar.st = MISC + 8; bar.wave0 = F.wave0;
    if (hi - lo > 1) bar = xcd_barrier_post((unsigned*)(F.ctl + CW_BAR), MISC + 8, F.wave0);
    LAS unsigned char* ring = F.lds;

    Timer TM; TM.prev = TIMER_ON ? __builtin_amdgcn_s_memrealtime() : 0ull; TM.acc = 0ull;
    if (PHON(0) && IN(0)) { p0_prologue(F, A); }
    SEAM(0);
    layer_pair<0>(F, A, lo, hi, bar, ring, TM);
    layer_pair<1>(F, A, lo, hi, bar, ring, TM);
    if (PHON(1) && IN(41)) {
        norm_phase(F, A, 4, 0, 2 | 8);
        if (xb_ld((unsigned*)(F.ctl + CW_BAR) + XB_TMO) != 0u) {
            const float qn = __builtin_nanf("");
            for (size_t idx = (size_t)blockIdx.x * 512 + F.tid; idx < (size_t)NB * SEQ * DM / 4; idx += (size_t)F.G * 512) ((f32x4*)A.out)[idx] = (f32x4){qn, qn, qn, qn};
        }
    }
    if (TIMER_ON) { const unsigned long long now_ = __builtin_amdgcn_s_memrealtime(); if (41 >= TIMER_LO && 41 <= TIMER_HI) TM.acc += now_ - TM.prev;
        if (blockIdx.x == 0) { const unsigned long long tgt = now_ + TM.acc; while (__builtin_amdgcn_s_memrealtime() < tgt) __builtin_amdgcn_s_sleep(8); } }
#undef IN
#undef SEAM
}

extern "C" void kernel_launch(void* const* d_in, const int* in_sizes, int n_in, void* d_out, int out_size, void* d_ws, size_t ws_size, hipStream_t stream) {
    static int grid = 0;
    if (grid == 0) {
        if (n_in != 29 || in_sizes[0] != NB * SEQ * DM || out_size != NB * SEQ * DM || ws_size < WS_END) {
            fprintf(stderr, "kernel_launch: unexpected problem: n_in %d, in0 %d, out %d, ws %zu (need %zu); nothing launched\n", n_in, n_in > 0 ? in_sizes[0] : -1, out_size, ws_size, (size_t)WS_END); grid = -1; return; }
        int dev = 0, cus = 0, per_cu = 0;
        if (hipGetDevice(&dev) != hipSuccess || hipDeviceGetAttribute(&cus, hipDeviceAttributeMultiprocessorCount, dev) != hipSuccess) { fprintf(stderr, "kernel_launch: device query failed\n"); grid = -1; return; }
        if (hipFuncSetAttribute((const void*)fwd_kernel, hipFuncAttributeMaxDynamicSharedMemorySize, LDS_BYTES) != hipSuccess) { fprintf(stderr, "kernel_launch: hipFuncSetAttribute failed\n"); grid = -1; return; }
        if (hipOccupancyMaxActiveBlocksPerMultiprocessor(&per_cu, (const void*)fwd_kernel, NWAVES * 64, LDS_BYTES) != hipSuccess || per_cu < 1)
            fprintf(stderr, "kernel_launch: note: occupancy query reports %d workgroups per CU\n", per_cu);
        (void)hipGetLastError();
        if (cus != 256) { fprintf(stderr, "kernel_launch: the unit orders of this kernel are written for 256 CUs (found %d); nothing launched\n", cus); grid = -1; return; }
        grid = cus;
    }
    if (grid < 0) return;
    if (hipMemsetAsync((char*)d_ws + WS_CTL, 0, CTL_ZERO_BYTES, stream) != hipSuccess) { fprintf(stderr, "kernel_launch: memset failed\n"); return; }
    Args a{};
    const float** ap = (const float**)&a;
    for (int i = 0; i < 29; ++i) ap[i] = (const float*)d_in[i];
    a.out = (float*)d_out; a.ws = (unsigned char*)d_ws;
#if MK_PER_PHASE
    for (int k = 0; k < N_PHASES; ++k) { a.ph_lo = k; a.ph_hi = k + 1; hipLaunchKernelGGL(fwd_kernel, dim3(grid), dim3(NWAVES * 64), LDS_BYTES, stream, a); }
#else
    a.ph_lo = 0; a.ph_hi = N_PHASES;
    hipLaunchKernelGGL(fwd_kernel, dim3(grid), dim3(NWAVES * 64), LDS_BYTES, stream, a);
#endif
    const hipError_t le = hipPeekAtLastError();
    if (le != hipSuccess) fprintf(stderr, "kernel_launch: launch failed: %s\n", hipGetErrorName(le));
}
```

```cpp
#include <hip/hip_runtime.h>
#include <cstdio>
#include <cstdint>

#define LAS __attribute__((address_space(3)))
#define GAS __attribute__((address_space(1)))
typedef unsigned short bf16_t;
typedef short bf16x8 __attribute__((ext_vector_type(8)));
typedef short s16x4 __attribute__((ext_vector_type(4)));
typedef float f32x4 __attribute__((ext_vector_type(4)));
typedef float f32x2 __attribute__((ext_vector_type(2)));
typedef float f32x16 __attribute__((ext_vector_type(16)));
typedef unsigned u32x4 __attribute__((ext_vector_type(4)));
typedef unsigned u32x2 __attribute__((ext_vector_type(2)));
typedef GAS unsigned gu32;

namespace pg8 {
constexpr int BM = 256, BK = 64, HALF = 128, HTB = HALF * BK * 2  , STAGE_BYTES = 8 * HTB, NXCD = 8, WGM = 8;

__host__ __device__ __forceinline__ int lds_byte(int r, int c) { const int st = (r >> 4) * 2 + (c >> 5), rr = r & 15, cc = c & 31, ob = rr * 64 + cc * 2; return st * 1024 + (ob ^ (((ob >> 9) & 1) << 5)); }
__host__ __device__ __forceinline__ void stage_rc(int b, int& R, int& C) { const int st = b / 1024, sb = b % 1024, swz = sb ^ (((sb >> 9) & 1) << 5); R = (st >> 1) * 16 + swz / 64; C = (st & 1) * 32 + (swz % 64) / 2; }
__host__ __device__ __forceinline__ int perm32(int rho) { const int n = rho >> 4, i = rho & 15; return 8 * (i >> 2) + 4 * n + (i & 3); }

struct Unit { int pm, pn; };
struct Gemm { const bf16_t* A; const bf16_t* Bt; int lda, K, ldb; };

struct StaticOrder {
    int nM, nN, nwg, G, c;
    __device__ void init(int nM_, int nN_, int G_, int c_) { nM = nM_; nN = nN_; nwg = nM * nN; G = G_; c = c_; }
    __device__ bool next(int i, Unit& u) const {
        const long L = (long)i * G + c; if (L >= nwg) return false;
        int wgid = (int)L; { const int q = nwg / NXCD, r = nwg % NXCD, xcd = wgid % NXCD, off = wgid / NXCD; wgid = (xcd < r ? xcd * (q + 1) : r * (q + 1) + (xcd - r) * q) + off; }
        const int nig = WGM * nN, gid = wgid / nig, fm = gid * WGM, gsz = (nM - fm) < WGM ? (nM - fm) : WGM;
        u.pm = fm + ((wgid % nig) % gsz); u.pn = (wgid % nig) / gsz; return true;
    }
    __device__ __forceinline__ const char* a_base(const Gemm& g, const Unit& u) const { return (const char*)g.A + (size_t)u.pm * (size_t)(BM * 2) * g.lda; }
    __device__ __forceinline__ const char* b_base(const Gemm& g, const Unit& u) const { return (const char*)g.Bt + (size_t)u.pn * (size_t)(BM * 2) * g.K; }
    __device__ __forceinline__ unsigned row_off(const Gemm& g, const Unit&, int r) const { return (unsigned)r * (unsigned)g.lda * 2u; }
};

struct LatentOrder : StaticOrder {
    __device__ bool next(int i, Unit& u) const { if (!StaticOrder::next(i, u)) return false; u.pm = u.pm + (u.pm >> 4) + 1; return true; }
};

struct PanelOrder : StaticOrder {
    __device__ bool next(int i, Unit& u) const { const int x = c & 7, s = c >> 3, per = G >> 5; const int panel = (i * 8 + x) * per + (s >> 2);
        if (panel >= nM) return false; u.pm = panel; u.pn = s & 3; return true; }
};

struct TailOrder {
    int c, pm0; unsigned koff;
    __device__ bool next(int i, Unit& u) const { if (i) return false; const int x = c & 7, s = c >> 3; u.pm = pm0 + x * 2 + (s >> 4); u.pn = (s >> 2) & 3; return true; }
    __device__ __forceinline__ const char* a_base(const Gemm& g, const Unit& u) const { return (const char*)g.A + (size_t)u.pm * (size_t)(BM * 2) * g.lda + koff; }
    __device__ __forceinline__ const char* b_base(const Gemm& g, const Unit& u) const { return (const char*)g.Bt + (size_t)u.pn * (size_t)(BM * 2) * g.ldb + koff; }
    __device__ __forceinline__ unsigned row_off(const Gemm& g, const Unit&, int r) const { return (unsigned)r * (unsigned)g.lda * 2u; }
};

__device__ __forceinline__ unsigned cvt_pk_bf16(float lo, float hi) { unsigned r; asm volatile("v_cvt_pk_bf16_f32 %0, %1, %2" : "=v"(r) : "v"(lo), "v"(hi)); return r; }

template <class Epi, class Sched, bool ALIGN_EPI, bool GATHER>
__device__ __forceinline__ void gemm_phase(LAS unsigned char* lds, const Gemm g, const Sched& S, const Epi& E, const int wave0, const unsigned delay_ticks = 0u) {
    if (delay_ticks) { const unsigned long long t0_ = __builtin_amdgcn_s_memrealtime(); while (__builtin_amdgcn_s_memrealtime() - t0_ < (unsigned long long)delay_ticks) __builtin_amdgcn_s_sleep(16); }
    int tid_ = wave0 * 64 + (int)__builtin_amdgcn_mbcnt_hi(~0u, __builtin_amdgcn_mbcnt_lo(~0u, 0u)); asm volatile("" : "+v"(tid_));
    const int tid = tid_, wid = __builtin_amdgcn_readfirstlane(tid >> 6), lane = tid & 63, wr = wid >> 2, wc = wid & 3, fr = lane & 15, fq = lane >> 4;
    const int K = g.K, nt = K / BK, LDB = g.ldb ? g.ldb : g.K;
    unsigned voffB[2];
#pragma unroll
    for (int i = 0; i < 2; ++i) { int R, C; stage_rc(tid * 16 + i * 8192, R, C); const int Rb = Epi::PERM ? ((R & ~31) + perm32(R & 31)) : R; voffB[i] = (unsigned)(Rb * LDB + C) * 2u; }
    const size_t kstep = (size_t)(BK * 2);
    const size_t hstepB = (size_t)HALF * LDB * 2;
    const unsigned ldsw = (unsigned)wid * 1024u;
    const int aoff = lds_byte(wr * 64 + fr, fq * 8), boff = lds_byte(wc * 32 + fr, fq * 8);
#define PG8_SA(b, h) (((b) * 2 + (h)) * HTB)
#define PG8_SB(b, h) ((4 + (b) * 2 + (h)) * HTB)
#define PG8_STAGE(bufoff, gbase, voff) do { _Pragma("unroll") for (int _i = 0; _i < 2; ++_i) \
        __builtin_amdgcn_global_load_lds((const unsigned*)((const char*)(gbase) + (voff)[_i]), (LAS unsigned*)(lds + (bufoff) + ldsw + _i * 8192), 16, 0, 0); } while (0)
#define PG8_LDA(dst, b, h) do { _Pragma("unroll") for (int m = 0; m < 4; ++m) _Pragma("unroll") for (int k = 0; k < 2; ++k) dst[m][k] = *(const LAS bf16x8*)(lds + PG8_SA(b, h) + aoff + m * 2048 + k * 1024); } while (0)
#define PG8_LDB(dst, b, h) do { _Pragma("unroll") for (int n = 0; n < 2; ++n) _Pragma("unroll") for (int k = 0; k < 2; ++k) dst[n][k] = *(const LAS bf16x8*)(lds + PG8_SB(b, h) + boff + n * 2048 + k * 1024); } while (0)
#define PG8_MMA(ai, bj, At, Bt) do { __builtin_amdgcn_s_setprio(1); _Pragma("unroll") for (int m = 0; m < 4; ++m) _Pragma("unroll") for (int n = 0; n < 2; ++n) _Pragma("unroll") for (int k = 0; k < 2; ++k) \
        acc[ai][bj][m][n] = __builtin_amdgcn_mfma_f32_16x16x32_bf16(Bt[n][k], At[m][k], acc[ai][bj][m][n], 0, 0, 0); __builtin_amdgcn_s_setprio(0); } while (0)
#define PG8_WAIT_V(n) asm volatile("s_waitcnt vmcnt(" #n ")" ::: "memory")
#define PG8_WAIT_L(n) asm volatile("s_waitcnt lgkmcnt(" #n ")" ::: "memory")
#define PG8_BAR __builtin_amdgcn_s_barrier()
#define PG8_SCHED __builtin_amdgcn_sched_barrier(0)
    Unit cur, nxt; int ui = 0;
    if (!S.next(0, cur)) return;
    f32x4 acc[2][2][4][2];
#pragma unroll
    for (int a = 0; a < 2; ++a)
#pragma unroll
        for (int b = 0; b < 2; ++b)
#pragma unroll
            for (int m = 0; m < 4; ++m)
#pragma unroll
                for (int n = 0; n < 2; ++n) acc[a][b][m][n] = (f32x4){0.f, 0.f, 0.f, 0.f};
    bf16x8 At[4][2], B0[2][2], B1[2][2];
    const char* cA = S.a_base(g, cur); const char* cB = S.b_base(g, cur);
    unsigned va[2][2], vn[2][2];
#pragma unroll
    for (int h = 0; h < 2; ++h)
#pragma unroll
        for (int i = 0; i < 2; ++i) { int R, C; stage_rc(tid * 16 + i * 8192, R, C); va[h][i] = S.row_off(g, cur, h * HALF + R) + (unsigned)C * 2u; vn[h][i] = va[h][i]; }
    PG8_STAGE(PG8_SB(0, 0), cB, voffB); PG8_STAGE(PG8_SB(0, 1), cB + hstepB, voffB); PG8_STAGE(PG8_SA(0, 0), cA, va[0]); PG8_STAGE(PG8_SA(0, 1), cA, va[1]);
    if (wr == 1) PG8_BAR;
    PG8_WAIT_V(2); PG8_BAR;
    PG8_STAGE(PG8_SB(1, 0), cB + kstep, voffB); PG8_STAGE(PG8_SA(1, 0), cA + kstep, va[0]); PG8_STAGE(PG8_SB(1, 1), cB + hstepB + kstep, voffB);
    PG8_WAIT_V(6); PG8_BAR;
    for (;;) {
        const bool has_next = S.next(ui + 1, nxt);
        const char* nA = has_next ? S.a_base(g, nxt) : cA; const char* nB = has_next ? S.b_base(g, nxt) : cB;
        if (GATHER) {
            if (has_next) {
#pragma unroll
                for (int h = 0; h < 2; ++h)
#pragma unroll
                    for (int i = 0; i < 2; ++i) { int R, C; stage_rc(tid * 16 + i * 8192, R, C); vn[h][i] = S.row_off(g, nxt, h * HALF + R) + (unsigned)C * 2u; }
            } else {
#pragma unroll
                for (int h = 0; h < 2; ++h)
#pragma unroll
                    for (int i = 0; i < 2; ++i) vn[h][i] = va[h][i];
            }
        }
        for (int t = 0; t < nt; t += 2) {
            const bool last = (t == nt - 2);
            const char* a1 = cA + (size_t)(t + 1) * kstep;
            const char* a2 = last ? nA : cA + (size_t)(t + 2) * kstep; const char* b2 = last ? nB : cB + (size_t)(t + 2) * kstep;
            const char* a3 = a2 + kstep; const char* b3 = b2 + kstep;
            unsigned v2[2][2];
#pragma unroll
            for (int h = 0; h < 2; ++h)
#pragma unroll
                for (int i = 0; i < 2; ++i) v2[h][i] = (GATHER && last) ? vn[h][i] : va[h][i];
            PG8_LDB(B0, 0, 0); PG8_LDB(B1, 0, 1); PG8_SCHED; PG8_LDA(At, 0, 0); PG8_STAGE(PG8_SA(1, 1), a1, va[1]);
            PG8_WAIT_V(8); PG8_WAIT_L(0); PG8_BAR; PG8_MMA(0, 0, At, B0); PG8_MMA(0, 1, At, B1); PG8_BAR; PG8_SCHED;
            PG8_LDA(At, 0, 1); PG8_STAGE(PG8_SB(0, 0), b2, voffB); PG8_STAGE(PG8_SB(0, 1), b2 + hstepB, voffB); PG8_STAGE(PG8_SA(0, 0), a2, v2[0]);
            PG8_WAIT_V(8); PG8_WAIT_L(0); PG8_BAR; PG8_MMA(1, 0, At, B0); PG8_MMA(1, 1, At, B1); PG8_BAR; PG8_SCHED;
            PG8_LDB(B0, 1, 0); PG8_LDB(B1, 1, 1); PG8_SCHED; PG8_LDA(At, 1, 0); PG8_STAGE(PG8_SA(0, 1), a2, v2[1]);
            PG8_WAIT_V(8); PG8_WAIT_L(0); PG8_BAR; PG8_MMA(0, 0, At, B0); PG8_MMA(0, 1, At, B1); PG8_BAR; PG8_SCHED;
            PG8_LDA(At, 1, 1); PG8_STAGE(PG8_SB(1, 0), b3, voffB); PG8_STAGE(PG8_SB(1, 1), b3 + hstepB, voffB); PG8_STAGE(PG8_SA(1, 0), a3, v2[0]);
            PG8_WAIT_V(8); PG8_WAIT_L(0); PG8_BAR; PG8_MMA(1, 0, At, B0); PG8_MMA(1, 1, At, B1); PG8_BAR; PG8_SCHED;
        }
        if constexpr (ALIGN_EPI) { if (wr == 0) PG8_BAR; }
        { int l2 = (int)__builtin_amdgcn_mbcnt_hi(~0u, __builtin_amdgcn_mbcnt_lo(~0u, 0u)); asm volatile("" : "+v"(l2)); E(acc, cur, wr, wc, l2 & 15, l2 >> 4); }
        if (!has_next) break;
#pragma unroll
        for (int a = 0; a < 2; ++a)
#pragma unroll
            for (int b = 0; b < 2; ++b)
#pragma unroll
                for (int m = 0; m < 4; ++m)
#pragma unroll
                    for (int n = 0; n < 2; ++n) acc[a][b][m][n] = (f32x4){0.f, 0.f, 0.f, 0.f};
        cur = nxt; cA = nA; cB = nB; ++ui;
        if (GATHER) {
#pragma unroll
            for (int h = 0; h < 2; ++h)
#pragma unroll
                for (int i = 0; i < 2; ++i) va[h][i] = vn[h][i];
        }
        if constexpr (ALIGN_EPI) { if (wr == 1) PG8_BAR; }
    }
    PG8_WAIT_V(0);
    if constexpr (!ALIGN_EPI) { if (wr == 0) PG8_BAR; }
    PG8_BAR;
#undef PG8_SA
#undef PG8_SB
#undef PG8_STAGE
#undef PG8_LDA
#undef PG8_LDB
#undef PG8_MMA
#undef PG8_WAIT_V
#undef PG8_WAIT_L
#undef PG8_BAR
#undef PG8_SCHED
}
}

constexpr int DM = 1024, NB = 16, SEQ = 4096, NCTX = 256, SROW = SEQ + NCTX  , MROWS = NB * SROW  , NPAN = MROWS / 256  ;
constexpr int DIN = 2048, CONVCH = 4096, SSD_IN = 6208, NXBC = 4352  ;
constexpr int QW = 1024, KVW = 256, NQKV = 1536;
constexpr int DFF = 2816, NEXP = 8, DFFE = 3584;
constexpr float EPS = 1e-6f;
constexpr int MOE_CHUNK = 192;
constexpr int NWAVES = 8;

constexpr size_t MiB = 1u << 20;
constexpr size_t WS_CTL = 0, CTL_ZERO_BYTES = 1 * MiB;
constexpr size_t WS_MODV = 2 * MiB;
constexpr size_t WS_ROPE = 4 * MiB;
constexpr size_t WS_GATE = 5 * MiB;
constexpr size_t WS_RLIST = 6 * MiB;
constexpr size_t WS_W = 26 * MiB;
constexpr size_t W_SSD_STRIDE = 33 * MiB, W_WZ = 0, W_WIN = 4 * MiB, W_WOUT = 12 * MiB + MiB / 2, W_WUP = 16 * MiB + MiB / 2, W_WDN = 27 * MiB + MiB / 2;
constexpr size_t W_ATT0 = 66 * MiB, W_ATT_STRIDE = 5 * MiB, W_WQKV = 0, W_WO = 3 * MiB;
constexpr size_t WS_XR = 102 * MiB;
constexpr size_t WS_BIG = 238 * MiB;
constexpr size_t BIG_K = 136 * MiB, BIG_V = 170 * MiB, BIG_O = 204 * MiB, BIG_MW13 = 336 * MiB, BIG_MW2 = 448 * MiB;
static_assert((size_t)MOE_CHUNK * 256 * DFFE * 2 <= BIG_MW13 && BIG_O + 136 * MiB <= BIG_MW13 + 200 * MiB && BIG_MW2 + 56 * MiB <= 544 * MiB, "BIG region map");
constexpr size_t WS_Y = 782 * MiB;
constexpr size_t WS_DT = 1054 * MiB;
constexpr size_t WS_HALO = 1071 * MiB;
constexpr size_t WS_XCH = 1106 * MiB;
constexpr size_t WS_END = 1108 * MiB;
constexpr int CW_BAR = 4096;
constexpr int CW_CNT = 16384;
constexpr int CW_PAN = 32768;
constexpr int CW_TAIL = 106496;
static_assert(CW_PAN + 4 * 272 * 64 <= CW_TAIL && (CW_TAIL + 6 * 64 * 8 * 16) * 4 <= (int)CTL_ZERO_BYTES, "CTL words inside the memset region");

constexpr int RING_BYTES = 131072;
constexpr int PSCR_OFF = 131072;
constexpr int LDSCTL_OFF = 151552, MISC_OFF = LDSCTL_OFF + 320;
constexpr int LDS_BYTES = 155648;

#define RLX_AGENT __ATOMIC_RELAXED, __HIP_MEMORY_SCOPE_AGENT
#define LDS_WAIT() asm volatile("s_waitcnt lgkmcnt(0)" ::: "memory")
#define VM_WAIT() asm volatile("s_waitcnt vmcnt(0)" ::: "memory")
__device__ __forceinline__ unsigned f2bf(float f) { unsigned u = __builtin_bit_cast(unsigned, f); return (u + 0x7fffu + ((u >> 16) & 1u)) >> 16; }
__device__ __forceinline__ unsigned pk2(float lo, float hi) { return f2bf(lo) | (f2bf(hi) << 16); }
__device__ __forceinline__ float bf_lo(unsigned u) { return __builtin_bit_cast(float, u << 16); }
__device__ __forceinline__ float bf_hi(unsigned u) { return __builtin_bit_cast(float, u & 0xffff0000u); }
__device__ __forceinline__ float bf1(bf16_t h) { return __builtin_bit_cast(float, (unsigned)h << 16); }
__device__ __forceinline__ float siluf(float v) { return v * __builtin_amdgcn_rcpf(1.0f + __expf(-v)); }
__device__ __forceinline__ f32x2 silu2(f32x2 v) { const f32x2 t = v * (f32x2){-1.44269504088896340736f, -1.44269504088896340736f}; f32x2 e; e.x = __builtin_amdgcn_exp2f(t.x); e.y = __builtin_amdgcn_exp2f(t.y);
    const f32x2 d = e + (f32x2){1.0f, 1.0f}; f32x2 r; r.x = __builtin_amdgcn_rcpf(d.x); r.y = __builtin_amdgcn_rcpf(d.y); return v * r; }
__device__ __forceinline__ float shx(float v, int mask, int lane) { return __builtin_bit_cast(float, __builtin_amdgcn_ds_bpermute((lane ^ mask) << 2, __builtin_bit_cast(int, v))); }
__device__ __forceinline__ float wave_sum(float v, int lane) {
    (void)lane;
    v += __builtin_bit_cast(float, __builtin_amdgcn_update_dpp(0, __builtin_bit_cast(int, v), 0x111, 0xf, 0xf, true));
    v += __builtin_bit_cast(float, __builtin_amdgcn_update_dpp(0, __builtin_bit_cast(int, v), 0x112, 0xf, 0xf, true));
    v += __builtin_bit_cast(float, __builtin_amdgcn_update_dpp(0, __builtin_bit_cast(int, v), 0x114, 0xf, 0xf, true));
    v += __builtin_bit_cast(float, __builtin_amdgcn_update_dpp(0, __builtin_bit_cast(int, v), 0x118, 0xf, 0xf, true));
    v += __builtin_bit_cast(float, __builtin_amdgcn_update_dpp(0, __builtin_bit_cast(int, v), 0x142, 0xa, 0xf, false));
    v += __builtin_bit_cast(float, __builtin_amdgcn_update_dpp(0, __builtin_bit_cast(int, v), 0x143, 0xc, 0xf, false));
    return __builtin_bit_cast(float, __builtin_amdgcn_readlane(__builtin_bit_cast(int, v), 63));
}

__device__ __forceinline__ int lane_id() { return (int)__builtin_amdgcn_mbcnt_hi(~0u, __builtin_amdgcn_mbcnt_lo(~0u, 0u)); }
#define XB_TMO      128
#define XB_XCNT(j)  (256  + 64 * (j))
#define XB_XSUB(j)  (1280 + 64 * (j))
#define XB_XGEN(j)  (2304 + 64 * (j))
#define XB_TOP      3328
#define XB_TOPGEN   3392
#define XCD_BAR_WORDS 3456
#define XB_SPIN_CAP (1u << 18)

__device__ __forceinline__ unsigned xb_ld(unsigned* p)              { return __hip_atomic_load(p, __ATOMIC_RELAXED, __HIP_MEMORY_SCOPE_AGENT); }
__device__ __forceinline__ unsigned xb_add(unsigned* p, unsigned v) { return __hip_atomic_fetch_add(p, v, __ATOMIC_RELAXED, __HIP_MEMORY_SCOPE_AGENT); }
__device__ __forceinline__ unsigned xb_xcc_id() { return (unsigned)__builtin_amdgcn_s_getreg((3 << 11) | 20) & 0xFu; }
#define XB_SPIN(cond, bar) do { unsigned _sp = 0; while (cond) { __builtin_amdgcn_s_sleep(1); \
    if ((++_sp & 255u) == 0u) { if (xb_ld(&(bar)[XB_TMO])) break; if (_sp > XB_SPIN_CAP) { atomicAdd(&(bar)[XB_TMO], 1u); break; } } } } while (0)

struct XcdBarrier {
    unsigned* bar; unsigned x;
    volatile LAS unsigned* st;
    int wave0;
};
__device__ __forceinline__ XcdBarrier xcd_barrier_post(unsigned* bar, volatile LAS unsigned* st, int wave0) {
    XcdBarrier b; b.bar = bar; b.x = xb_xcc_id(); b.st = st; b.wave0 = wave0;
    if (wave0 == 0 && lane_id() == 0) (void)xb_add(&bar[XB_XCNT(b.x)], 1u);
    return b;
}
__device__ __forceinline__ void xcd_barrier_complete(unsigned* bar, unsigned x, unsigned& nloc, unsigned& nx) {
    const unsigned G = gridDim.x * gridDim.y * gridDim.z;
    unsigned sum, cnt, mine, sp = 0u;
    for (;;) {
        sum = 0u; cnt = 0u; mine = 0u;
#pragma unroll
        for (unsigned j = 0; j < 16; ++j) { const unsigned c = xb_ld(&bar[XB_XCNT(j)]); sum += c; cnt += (c > 0u) ? 1u : 0u; mine = (j == x) ? c : mine; }
        if (sum == G) break;
        __builtin_amdgcn_s_sleep(1);
        if ((++sp & 255u) == 0u) { if (xb_ld(&bar[XB_TMO])) break; if (sp > XB_SPIN_CAP) { atomicAdd(&bar[XB_TMO], 1u); break; } }
    }
    nloc = mine > 0u ? mine : 1u; nx = cnt > 0u ? cnt : 1u;
}
__device__ __forceinline__ void xcd_barrier(const XcdBarrier& b) {
    asm volatile("s_waitcnt vmcnt(0)" ::: "memory");
    __syncthreads();
    if (b.wave0 == 0 && lane_id() == 0) {
        unsigned* bar = b.bar;
        __builtin_amdgcn_s_waitcnt(0);
        unsigned nloc = b.st[0], nx = b.st[1];
        if (nloc == 0u) { xcd_barrier_complete(bar, b.x, nloc, nx); b.st[0] = nloc; b.st[1] = nx; }
        const unsigned old = xb_add(&bar[XB_XSUB(b.x)], 1u);
        const unsigned gen = old / nloc;
        if (old + 1u == (gen + 1u) * nloc) {
            __builtin_amdgcn_fence(__ATOMIC_RELEASE, "agent");
            asm volatile("s_waitcnt vmcnt(0)" ::: "memory");
            const unsigned og = xb_add(&bar[XB_TOP], 1u);
            const unsigned tg = og / nx;
            if (og + 1u == (tg + 1u) * nx) xb_add(&bar[XB_TOPGEN], 1u);
            else XB_SPIN(xb_ld(&bar[XB_TOPGEN]) == tg, bar);
            __builtin_amdgcn_fence(__ATOMIC_ACQUIRE, "agent");
            xb_add(&bar[XB_XGEN(b.x)], 1u);
            asm volatile("s_waitcnt vmcnt(0)" ::: "memory");
        } else {
            XB_SPIN(xb_ld(&bar[XB_XGEN(b.x)]) == gen, bar);
            __builtin_amdgcn_fence(__ATOMIC_ACQUIRE, "agent");
            asm volatile("s_waitcnt vmcnt(0)" ::: "memory");
        }
    }
    __syncthreads();
}

struct Args {
    const float *x, *c, *ctx, *c_ctx, *w_mod, *b_mod, *norm1_w, *norm2_w, *ssd_w_in, *ssd_conv_w, *ssd_conv_b, *ssd_dt_bias, *ssd_a_log, *ssd_d, *ssd_norm_w, *ssd_w_out,
                *attn_w_qkv, *attn_b_qkv, *attn_sink, *attn_w_o, *attn_b_o, *ffn_w1, *ffn_w3, *ffn_w2, *moe_router, *moe_w1, *moe_w3, *moe_w2, *final_norm_w;
    float* out; unsigned char* ws; int ph_lo, ph_hi;
};
struct Frame {
    LAS unsigned char* lds;
    int tid, lane, wave, G;
    unsigned char* ws; gu32* ctl; float* out;
    unsigned char* ws0; float* out0; int wave0;
};
__device__ __forceinline__ void phase_enter(Frame& F) { int l = lane_id(); asm volatile("" : "+v"(l)); F.lane = l; F.wave = F.wave0; F.tid = F.wave0 * 64 + l;
    unsigned char* w = F.ws0; float* o = F.out0; asm volatile("" : "+s"(w), "+s"(o)); F.ws = w; F.ctl = (gu32*)(w + WS_CTL); F.out = o; }
__device__ __forceinline__ void transpose_item(const float* W, int ldw, int col0, int ncb, int K, bf16_t* WT, int mode, int half, LAS float* scr, int item, int lane) {
    const int kb = item / ncb, nb = item - kb * ncb, k0 = 64 * kb, n0 = 64 * nb;
    const int lr = lane >> 4, lc = (lane & 15) * 4;
    f32x4 tv[16];
#pragma unroll
    for (int i = 0; i < 16; ++i) tv[i] = *(const GAS f32x4*)(W + (size_t)(k0 + 4 * i + lr) * ldw + col0 + n0 + lc);
#pragma unroll
    for (int i = 0; i < 16; ++i) { LAS float* d = scr + (4 * i + lr) * 65 + lc; d[0] = tv[i].x; d[1] = tv[i].y; d[2] = tv[i].z; d[3] = tv[i].w; }
    LDS_WAIT(); asm volatile("" ::: "memory");
    const int c = lane & 7;
#pragma unroll
    for (int j = 0; j < 8; ++j) { const int n = (lane >> 3) + 8 * j; const LAS float* s = scr + (8 * c) * 65 + n;
        u32x4 o; o.x = pk2(s[0 * 65], s[1 * 65]); o.y = pk2(s[2 * 65], s[3 * 65]); o.z = pk2(s[4 * 65], s[5 * 65]); o.w = pk2(s[6 * 65], s[7 * 65]);
        const int cl = n0 + n; const int drow = mode == 0 ? cl : ((cl >> 7) * 256 + half * 128 + (cl & 127));
        *(GAS u32x4*)(WT + (size_t)drow * K + k0 + 8 * c) = o; }
    LDS_WAIT(); asm volatile("" ::: "memory");
}
__device__ __forceinline__ void p0_prologue(Frame& F, const Args& A) {
    phase_enter(F);
    {
        LAS float* sc = (LAS float*)F.lds;
        LAS float* red = (LAS float*)(F.lds + 81920);
        for (int idx = F.tid; idx < 17 * 1024; idx += 512) { const int cb = idx >> 10, k = idx & 1023; const float v = cb < 16 ? A.c[cb * 1024 + k] : A.c_ctx[k]; sc[k * 20 + cb] = v / (1.0f + expf(-v)); }
        __syncthreads();
        float* MODV = (float*)(F.ws + WS_MODV);
        for (int item = blockIdx.x; item < 4 * 96; item += F.G) {
            const int i = item / 96, cblk = item - i * 96;
            const float* Wm = A.w_mod + (size_t)i * 1024 * 6144 + cblk * 64 + F.lane;
            float acc[17];
#pragma unroll
            for (int cb = 0; cb < 17; ++cb) acc[cb] = 0.f;
            const int k0 = F.wave * 128;
#pragma unroll 4
            for (int kk = 0; kk < 128; ++kk) { const int k = k0 + kk; const float w = Wm[(size_t)k * 6144]; const LAS float* s = sc + k * 20;
#pragma unroll
                for (int cb = 0; cb < 17; ++cb) acc[cb] += s[cb] * w; }
#pragma unroll
            for (int cb = 0; cb < 17; ++cb) red[(F.wave * 17 + cb) * 64 + F.lane] = acc[cb];
            __syncthreads();
            for (int idx = F.tid; idx < 17 * 64; idx += 512) { const int cb = idx >> 6, l = idx & 63; float s = 0.f;
#pragma unroll
                for (int w = 0; w < 8; ++w) s += red[(w * 17 + cb) * 64 + l];
                MODV[(size_t)(i * 17 + cb) * 6144 + cblk * 64 + l] = s + A.b_mod[i * 6144 + cblk * 64 + l]; }
            __syncthreads();
        }
    }
    if (blockIdx.x == 0) { float* RT = (float*)(F.ws + WS_ROPE);
        for (int idx = F.tid; idx < 1024; idx += 512) { const int id = idx >> 4, f = idx & 15; const float inv = __builtin_amdgcn_exp2f(-(float)f * (13.287712379549449f / 16.0f)); const float ang = (float)id * inv;
            RT[idx] = __cosf(ang); RT[1024 + idx] = __sinf(ang); } }
    __syncthreads();
    {
        LAS float* scr = (LAS float*)(F.lds + F.wave * 16896);
        const int gw = blockIdx.x * NWAVES + F.wave, NGW = F.G * NWAVES;
        constexpr int I1 = 16 * 32, I2 = 16 * 65, I3 = 32 * 16, I4 = 16 * 44, I5 = 16 * 44, I6 = 44 * 16, I7 = 16 * 24, I8 = 16 * 16, IPER = I1 + I2 + I3 + I4 + I5 + I6 + I7 + I8;
        for (int it = gw; it < 2 * IPER; it += NGW) {
            const int j = it / IPER; int r = it - j * IPER;
            unsigned char* wss = F.ws + WS_W + (size_t)j * W_SSD_STRIDE; unsigned char* wsa = F.ws + WS_W + W_ATT0 + (size_t)j * W_ATT_STRIDE;
            if (r < I1) { transpose_item(A.ssd_w_in + (size_t)j * 1024 * SSD_IN, SSD_IN, 0, 32, 1024, (bf16_t*)(wss + W_WZ), 0, 0, scr, r, F.lane); continue; } r -= I1;
            if (r < I2) { transpose_item(A.ssd_w_in + (size_t)j * 1024 * SSD_IN, SSD_IN, 2048, 65, 1024, (bf16_t*)(wss + W_WIN), 0, 0, scr, r, F.lane); continue; } r -= I2;
            if (r < I3) { transpose_item(A.ssd_w_out + (size_t)j * 2048 * 1024, 1024, 0, 16, 2048, (bf16_t*)(wss + W_WOUT), 0, 0, scr, r, F.lane); continue; } r -= I3;
            if (r < I4) { transpose_item(A.ffn_w1 + (size_t)j * 1024 * DFF, DFF, 0, 44, 1024, (bf16_t*)(wss + W_WUP), 1, 0, scr, r, F.lane); continue; } r -= I4;
            if (r < I5) { transpose_item(A.ffn_w3 + (size_t)j * 1024 * DFF, DFF, 0, 44, 1024, (bf16_t*)(wss + W_WUP), 1, 1, scr, r, F.lane); continue; } r -= I5;
            if (r < I6) { transpose_item(A.ffn_w2 + (size_t)j * DFF * 1024, 1024, 0, 16, DFF, (bf16_t*)(wss + W_WDN), 0, 0, scr, r, F.lane); continue; } r -= I6;
            if (r < I7) { transpose_item(A.attn_w_qkv + (size_t)j * 1024 * NQKV, NQKV, 0, 24, 1024, (bf16_t*)(wsa + W_WQKV), 0, 0, scr, r, F.lane); continue; } r -= I7;
            transpose_item(A.attn_w_o + (size_t)j * 1024 * 1024, 1024, 0, 16, 1024, (bf16_t*)(wsa + W_WO), 0, 0, scr, r, F.lane);
        }
        for (int j = 0; j < 2; ++j) { u32x4* z = (u32x4*)(F.ws + WS_W + (size_t)j * W_SSD_STRIDE + W_WIN + (size_t)4160 * 1024 * 2);
            for (int idx = blockIdx.x * 512 + F.tid; idx < 192 * 1024 * 2 / 16; idx += F.G * 512) z[idx] = (u32x4){0u, 0u, 0u, 0u}; }
    }
}
__device__ __forceinline__ void moe_convert(Frame& F, const Args& A, int j, int wg0, int nwg) {
    phase_enter(F);
    LAS float* scr = (LAS float*)(F.lds + F.wave * 16896);
    const int gw = ((int)blockIdx.x - wg0) * NWAVES + F.wave, NGW = nwg * NWAVES;
    constexpr int IE = 16 * 56, I2 = 56 * 16;
    bf16_t* MW13 = (bf16_t*)(F.ws + WS_BIG + BIG_MW13); bf16_t* MW2 = (bf16_t*)(F.ws + WS_BIG + BIG_MW2);
    for (int it = gw; it < 8 * (2 * IE + I2); it += NGW) {
        const int e = it / (2 * IE + I2); int r = it - e * (2 * IE + I2);
        const size_t we = (size_t)(j * 8 + e) * 1024 * DFFE;
        if (r < IE) { transpose_item(A.moe_w1 + we, DFFE, 0, 56, 1024, MW13 + (size_t)e * 7168 * 1024, 1, 0, scr, r, F.lane); continue; } r -= IE;
        if (r < IE) { transpose_item(A.moe_w3 + we, DFFE, 0, 56, 1024, MW13 + (size_t)e * 7168 * 1024, 1, 1, scr, r, F.lane); continue; } r -= IE;
        transpose_item(A.moe_w2 + we, 1024, 0, 16, DFFE, MW2 + (size_t)e * 1024 * DFFE, 0, 0, scr, r, F.lane);
    }
}

__device__ __forceinline__ void norm_phase(Frame& F, const Args& A, int i, int which, int mode) {
    phase_enter(F);
    const bool first = mode & 1, combine = mode & 2, route = mode & 4, fin = mode & 8, lastl = mode & 16;
    const float* MODV = (const float*)(F.ws + WS_MODV);
    bf16_t* H = (bf16_t*)F.out; bf16_t* XR = (bf16_t*)(F.ws + WS_XR);
    const bf16_t* EO = (const bf16_t*)(F.ws + WS_Y);
    LAS float* rt = (LAS float*)F.lds;
    LAS int* ents = (LAS int*)(F.lds + 32768);
    const int jm = i >> 1;
    if (route) { const float* rg = A.moe_router + (size_t)jm * 1024 * 8; for (int idx = F.tid; idx < 8192; idx += 512) rt[(idx & 7) * 1024 + (idx >> 3)] = rg[idx]; }
    __syncthreads();
    const float* nw = fin ? A.final_norm_w : ((which == 0 ? A.norm1_w : A.norm2_w) + i * 1024);
    unsigned* cnt = (unsigned*)(F.ctl + CW_CNT + (size_t)jm * 8 * 64);
    int* rlist = (int*)(F.ws + WS_RLIST); float* GATE = (float*)(F.ws + WS_GATE);
    int kk = -1;
    for (int ch = blockIdx.x; ch < MROWS / 32; ch += F.G) {
        ++kk;
        const int R0 = ch * 32, b = R0 / SROW, s0 = R0 - b * SROW; const bool isctx = s0 < NCTX; const int cond = isctx ? 16 : b;
        if (fin && isctx) continue;
        const bool do_route = route && !(lastl && isctx);
        const float* mv = MODV + (size_t)(i * 17 + cond) * 6144;
        f32x4 wv[4], shv[4], scv[4], g5[4];
#pragma unroll
        for (int j = 0; j < 4; ++j) { const int col = 4 * F.lane + 256 * j; wv[j] = *(const GAS f32x4*)(nw + col);
            if (!fin) { shv[j] = *(const GAS f32x4*)(mv + (which ? 3 : 0) * 1024 + col); scv[j] = *(const GAS f32x4*)(mv + (which ? 4 : 1) * 1024 + col); }
            if (combine) g5[j] = *(const GAS f32x4*)(MODV + (size_t)((i - 1) * 17 + cond) * 6144 + 5 * 1024 + col); }
        for (int rr = 0; rr < 4; ++rr) {
            const int R = R0 + F.wave * 4 + rr, s = s0 + F.wave * 4 + rr;
            bf16_t* xr = XR + (size_t)R * DM + 4 * F.lane;
            f32x4 v[4]; float ss = 0.f;
            if (first) { const float* src = isctx ? A.ctx + (size_t)(b * NCTX + s) * DM : A.x + (size_t)(b * SEQ + s - NCTX) * DM;
#pragma unroll
                for (int j = 0; j < 4; ++j) v[j] = *(const GAS f32x4*)(src + 4 * F.lane + 256 * j);
            } else {
#pragma unroll
                for (int j = 0; j < 4; ++j) { const u32x2 w = *(const GAS u32x2*)(xr + 256 * j); v[j] = (f32x4){bf_lo(w.x), bf_hi(w.x), bf_lo(w.y), bf_hi(w.y)}; }
            }
            if (combine) {
#pragma unroll
                for (int j = 0; j < 4; ++j) { const u32x2 e0 = *(const GAS u32x2*)(EO + (size_t)(2 * R) * DM + 4 * F.lane + 256 * j), e1 = *(const GAS u32x2*)(EO + (size_t)(2 * R + 1) * DM + 4 * F.lane + 256 * j);
                    f32x4 ev; ev.x = bf_lo(e0.x) + bf_lo(e1.x); ev.y = bf_hi(e0.x) + bf_hi(e1.x); ev.z = bf_lo(e0.y) + bf_lo(e1.y); ev.w = bf_hi(e0.y) + bf_hi(e1.y);
                    v[j] = v[j] + g5[j] * ev; }
                if (!fin) {
#pragma unroll
                    for (int j = 0; j < 4; ++j) { u32x2 o; o.x = pk2(v[j].x, v[j].y); o.y = pk2(v[j].z, v[j].w); *(GAS u32x2*)(xr + 256 * j) = o; }
                }
            }
#pragma unroll
            for (int j = 0; j < 4; ++j) ss += (v[j].x * v[j].x + v[j].y * v[j].y) + (v[j].z * v[j].z + v[j].w * v[j].w);
            const float rstd = 1.0f / sqrtf(wave_sum(ss, F.lane) * (1.0f / DM) + EPS);
            if (fin) { float* orow = F.out + (size_t)(b * SEQ + s - NCTX) * DM;
#pragma unroll
                for (int j = 0; j < 4; ++j) *(GAS f32x4*)(orow + 4 * F.lane + 256 * j) = v[j] * rstd * wv[j];
                continue;
            }
#pragma unroll
            for (int j = 0; j < 4; ++j) { v[j] = v[j] * rstd * wv[j] * (scv[j] + 1.0f) + shv[j];
                u32x2 o; o.x = pk2(v[j].x, v[j].y); o.y = pk2(v[j].z, v[j].w); *(GAS u32x2*)(H + (size_t)R * DM + 4 * F.lane + 256 * j) = o; }
            if (do_route) {
                float lg[8];
#pragma unroll
                for (int e = 0; e < 8; ++e) lg[e] = 0.f;
#pragma unroll
                for (int e = 0; e < 8; ++e)
#pragma unroll
                    for (int j = 0; j < 4; ++j) { const f32x4 r = *(const LAS f32x4*)(rt + e * 1024 + 4 * F.lane + 256 * j); lg[e] += (v[j].x * r.x + v[j].y * r.y) + (v[j].z * r.z + v[j].w * r.w); }
#pragma unroll
                for (int e = 0; e < 8; ++e) lg[e] = wave_sum(lg[e], F.lane);
                int i1 = 0; float v1 = lg[0];
#pragma unroll
                for (int e = 1; e < 8; ++e) if (lg[e] > v1) { v1 = lg[e]; i1 = e; }
                int i2 = -1; float v2 = -3.0e38f;
#pragma unroll
                for (int e = 0; e < 8; ++e) if (e != i1 && lg[e] > v2) { v2 = lg[e]; i2 = e; }
                const float g1 = 1.0f / (1.0f + expf(v2 - v1)), g2 = 1.0f - g1;
                if (F.lane == 0) { ents[(kk & 15) * 64 + (F.wave * 4 + rr) * 2] = i1; ents[(kk & 15) * 64 + (F.wave * 4 + rr) * 2 + 1] = i2; GATE[(size_t)R * 2] = g1; GATE[(size_t)R * 2 + 1] = g2; }
            } else if (route && F.lane == 0) { ents[(kk & 15) * 64 + (F.wave * 4 + rr) * 2] = -1; ents[(kk & 15) * 64 + (F.wave * 4 + rr) * 2 + 1] = -1; }
        }
    }
    if (route) {
        __syncthreads();
        if (F.wave == 0) {
            const int npass = kk + 1;
            int n[8];
#pragma unroll
            for (int ee = 0; ee < 8; ++ee) n[ee] = 0;
            for (int p = 0; p < npass; ++p) { const int e = ents[(p & 15) * 64 + F.lane];
#pragma unroll
                for (int ee = 0; ee < 8; ++ee) n[ee] += __popcll(__ballot(e == ee)); }
            int myn = n[0];
#pragma unroll
            for (int ee = 1; ee < 8; ++ee) myn = (F.lane == ee) ? n[ee] : myn;
            unsigned basel = 0u;
            if (F.lane < 8) basel = __hip_atomic_fetch_add(cnt + F.lane * 64, (unsigned)myn, RLX_AGENT);
            int off[8];
#pragma unroll
            for (int ee = 0; ee < 8; ++ee) off[ee] = __builtin_amdgcn_readlane((int)basel, ee);
            for (int p = 0; p < npass; ++p) { const int e = ents[(p & 15) * 64 + F.lane]; const int Rp = ((int)blockIdx.x + p * F.G) * 32;
#pragma unroll
                for (int ee = 0; ee < 8; ++ee) { const unsigned long long m = __ballot(e == ee);
                    if (e == ee) rlist[(size_t)ee * MROWS + off[ee] + __popcll(m & ((1ull << F.lane) - 1ull))] = (Rp + (F.lane >> 1)) * 2 + (F.lane & 1);
                    off[ee] += __popcll(m); } }
        }
        __syncthreads();
    }
}

struct EpiXbc {
    static constexpr bool PERM = true;
    bf16_t* XBC; float* DT; bf16_t* HALO;
    __device__ __forceinline__ void operator()(const f32x4 (&acc)[2][2][4][2], const pg8::Unit& u, int wr, int wc, int fr, int fq) const {
        const int row0 = u.pm * 256 + wr * 64 + fr;
        if (u.pn < 16) { const int col0 = u.pn * 256 + wc * 32 + 8 * fq;
#pragma unroll
            for (int ai = 0; ai < 2; ++ai)
#pragma unroll
                for (int m = 0; m < 4; ++m) { bf16_t* rowp = XBC + (size_t)(row0 + ai * 128 + m * 16) * CONVCH + col0;
#pragma unroll
                    for (int bj = 0; bj < 2; ++bj) { const f32x4 v0 = acc[ai][bj][m][0], v1 = acc[ai][bj][m][1]; u32x4 w; w.x = pg8::cvt_pk_bf16(v0[0], v0[1]); w.y = pg8::cvt_pk_bf16(v0[2], v0[3]); w.z = pg8::cvt_pk_bf16(v1[0], v1[1]); w.w = pg8::cvt_pk_bf16(v1[2], v1[3]);
                        *(GAS u32x4*)(rowp + bj * 128) = w;
                        const int rin = ai * 128 + wr * 64 + m * 16 + fr, rq = rin >> 6, rw = rin & 63;
                        if (rw < 2 || rw >= 62) *(GAS u32x4*)(HALO + ((size_t)u.pm * 16 + (rw < 2 ? (rq == 0 ? rw : 4 * rq + rw) : 4 * rq + rw - 60)) * CONVCH + col0 + bj * 128) = w; } }
        } else if (wc < 2) { const int c0 = wc * 32 + 8 * fq;
#pragma unroll
            for (int ai = 0; ai < 2; ++ai)
#pragma unroll
                for (int m = 0; m < 4; ++m) { float* p = DT + (size_t)(row0 + ai * 128 + m * 16) * 64 + c0; *(GAS f32x4*)p = acc[ai][0][m][0]; *(GAS f32x4*)(p + 4) = acc[ai][0][m][1]; }
        }
    }
};
struct EpiGate {
    static constexpr bool PERM = true;
    const bf16_t* Y; bf16_t* Gt; const float* nw; LAS float* P;
    __device__ __forceinline__ void operator()(f32x4 (&acc)[2][2][4][2], const pg8::Unit& u, int wr, int wc, int fr, int fq) const {
        const int row0 = u.pm * 256 + wr * 64 + fr, col0 = u.pn * 256 + wc * 32 + 8 * fq;
        u32x4 yq[2][4][2];
        { const GAS char* yb = (const GAS char*)(Y + (size_t)(u.pm * 256) * DIN + u.pn * 256); unsigned yo = (unsigned)((wr * 64 + fr) * DIN * 2); asm volatile("" : "+v"(yo));
#pragma unroll
          for (int ai = 0; ai < 2; ++ai)
#pragma unroll
            for (int m = 0; m < 4; ++m)
#pragma unroll
                for (int bj = 0; bj < 2; ++bj) { const int cg = bj * 128 + wc * 32 + 8 * fq; const int cy = ((cg >> 5) & 1) * 128 + (cg >> 6) * 32 + (cg & 31);
                    yq[ai][m][bj] = *(const GAS u32x4*)(yb + (size_t)(ai * 128 + m * 16) * DIN * 2 + yo + cy * 2); } }
#pragma unroll
        for (int ai = 0; ai < 2; ++ai)
#pragma unroll
            for (int m = 0; m < 4; ++m) { float ssq = 0.f;
#pragma unroll
                for (int bj = 0; bj < 2; ++bj) { const u32x4 yv = yq[ai][m][bj]; f32x4 z0 = acc[ai][bj][m][0], z1 = acc[ai][bj][m][1];
                    { const f32x2 a0 = silu2((f32x2){z0[0], z0[1]}) * (f32x2){bf_lo(yv.x), bf_hi(yv.x)}, a1 = silu2((f32x2){z0[2], z0[3]}) * (f32x2){bf_lo(yv.y), bf_hi(yv.y)}, a2 = silu2((f32x2){z1[0], z1[1]}) * (f32x2){bf_lo(yv.z), bf_hi(yv.z)}, a3 = silu2((f32x2){z1[2], z1[3]}) * (f32x2){bf_lo(yv.w), bf_hi(yv.w)};
                      z0[0] = a0.x; z0[1] = a0.y; z0[2] = a1.x; z0[3] = a1.y; z1[0] = a2.x; z1[1] = a2.y; z1[2] = a3.x; z1[3] = a3.y; }
                    ssq += (z0[0] * z0[0] + z0[1] * z0[1]) + (z0[2] * z0[2] + z0[3] * z0[3]) + (z1[0] * z1[0] + z1[1] * z1[1]) + (z1[2] * z1[2] + z1[3] * z1[3]);
                    acc[ai][bj][m][0] = z0; acc[ai][bj][m][1] = z1; }
                ssq += shx(ssq, 16, fq * 16 + fr); ssq += shx(ssq, 32, fq * 16 + fr);
                if (fq == 0) P[(ai * 128 + wr * 64 + m * 16 + fr) * 4 + wc] = ssq; }
        asm volatile("s_waitcnt lgkmcnt(0)" ::: "memory"); __builtin_amdgcn_s_barrier(); asm volatile("" ::: "memory");
        f32x4 nv[2][2];
#pragma unroll
        for (int bj = 0; bj < 2; ++bj) { nv[bj][0] = *(const GAS f32x4*)(nw + col0 + bj * 128); nv[bj][1] = *(const GAS f32x4*)(nw + col0 + bj * 128 + 4); }
#pragma unroll
        for (int ai = 0; ai < 2; ++ai)
#pragma unroll
            for (int m = 0; m < 4; ++m) { const f32x4 pp = *(const LAS f32x4*)(P + (ai * 128 + wr * 64 + m * 16 + fr) * 4); const float rstd = 1.0f / sqrtf(((pp.x + pp.y) + (pp.z + pp.w)) * (1.0f / 256.0f) + EPS);
                bf16_t* gp = Gt + (size_t)(row0 + ai * 128 + m * 16) * DIN + col0;
#pragma unroll
                for (int bj = 0; bj < 2; ++bj) { const f32x4 v0 = acc[ai][bj][m][0] * rstd * nv[bj][0], v1 = acc[ai][bj][m][1] * rstd * nv[bj][1];
                    u32x4 w; w.x = pg8::cvt_pk_bf16(v0[0], v0[1]); w.y = pg8::cvt_pk_bf16(v0[2], v0[3]); w.z = pg8::cvt_pk_bf16(v1[0], v1[1]); w.w = pg8::cvt_pk_bf16(v1[2], v1[3]);
                    *(GAS u32x4*)(gp + bj * 128) = w; } }
        asm volatile("s_waitcnt lgkmcnt(0)" ::: "memory");
    }
};
struct EpiResid {
    static constexpr bool PERM = true;
    bf16_t* XR; const float* modl; int gidx; const float* bias; const float* rd_x; const float* rd_ctx;
    __device__ __forceinline__ void operator()(const f32x4 (&acc)[2][2][4][2], const pg8::Unit& u, int wr, int wc, int fr, int fq) const {
        const int b = u.pm / 17, j = u.pm - b * 17, cond = j == 0 ? 16 : b;
        const GAS char* pbase = (const GAS char*)(XR + (size_t)u.pm * 256 * DM);
        unsigned lo = (unsigned)(((wr * 64 + fr) * DM + u.pn * 256 + wc * 32 + 8 * fq) * 2); asm volatile("" : "+v"(lo));
        const GAS char* ibase = (const GAS char*)(rd_x ? (j == 0 ? rd_ctx + (size_t)(b * NCTX) * DM : rd_x + (size_t)(b * SEQ + (j - 1) * 256) * DM) : nullptr);
        const GAS float* gv = (const GAS float*)(modl + (size_t)cond * 6144 + gidx * 1024 + u.pn * 256 + wc * 32 + 8 * fq);
        const GAS float* bp = (const GAS float*)(bias ? bias + u.pn * 256 + wc * 32 + 8 * fq : nullptr);
#pragma unroll
        for (int bj = 0; bj < 2; ++bj) {
            f32x4 g[2], bv[2];
#pragma unroll
            for (int n = 0; n < 2; ++n) { g[n] = *(const GAS f32x4*)(gv + bj * 128 + n * 4); bv[n] = bp ? *(const GAS f32x4*)(bp + bj * 128 + n * 4) : (f32x4){0.f, 0.f, 0.f, 0.f}; }
#pragma unroll
            for (int ai = 0; ai < 2; ++ai) {
                f32x4 o[4][2];
                if (rd_x) {
#pragma unroll
                    for (int m = 0; m < 4; ++m)
#pragma unroll
                        for (int n = 0; n < 2; ++n) o[m][n] = *(const GAS f32x4*)(ibase + (size_t)(ai * 128 + m * 16) * DM * 4 + 2 * lo + (bj * 128 + n * 4) * 4);
                } else {
                    u32x4 w[4];
#pragma unroll
                    for (int m = 0; m < 4; ++m) w[m] = *(const GAS u32x4*)(pbase + (size_t)(ai * 128 + m * 16) * DM * 2 + lo + bj * 256);
#pragma unroll
                    for (int m = 0; m < 4; ++m) { o[m][0] = (f32x4){bf_lo(w[m].x), bf_hi(w[m].x), bf_lo(w[m].y), bf_hi(w[m].y)}; o[m][1] = (f32x4){bf_lo(w[m].z), bf_hi(w[m].z), bf_lo(w[m].w), bf_hi(w[m].w)}; }
                }
#pragma unroll
                for (int m = 0; m < 4; ++m) { const f32x4 r0 = o[m][0] + g[0] * (acc[ai][bj][m][0] + bv[0]), r1 = o[m][1] + g[1] * (acc[ai][bj][m][1] + bv[1]);
                    u32x4 w; w.x = pg8::cvt_pk_bf16(r0[0], r0[1]); w.y = pg8::cvt_pk_bf16(r0[2], r0[3]); w.z = pg8::cvt_pk_bf16(r1[0], r1[1]); w.w = pg8::cvt_pk_bf16(r1[2], r1[3]);
                    *(GAS u32x4*)(pbase + (size_t)(ai * 128 + m * 16) * DM * 2 + lo + bj * 256) = w; }
                asm volatile("" ::: "memory");
            }
        }
    }
};
struct EpiResidNorm {
    static constexpr bool PERM = true;
    bf16_t* XR; const float* modl; int gidx; const float* bias; const float* rd_x; const float* rd_ctx;
    bf16_t* H; const float* nw; const float* modn; int sidx;
    unsigned* xbuf; unsigned* cnt; unsigned* tmo; LAS unsigned char* P;
    __device__ __forceinline__ void operator()(f32x4 (&acc)[2][2][4][2], const pg8::Unit& u, int wr, int wc, int fr, int fq) const {
        const int b = u.pm / 17, j = u.pm - b * 17, cond = j == 0 ? 16 : b, lane = fq * 16 + fr, wid = wr * 4 + wc;
        const GAS char* pbase = (const GAS char*)(XR + (size_t)u.pm * 256 * DM);
        unsigned lo = (unsigned)(((wr * 64 + fr) * DM + u.pn * 256 + wc * 32 + 8 * fq) * 2); asm volatile("" : "+v"(lo));
        const GAS char* ibase = (const GAS char*)(rd_x ? (j == 0 ? rd_ctx + (size_t)(b * NCTX) * DM : rd_x + (size_t)(b * SEQ + (j - 1) * 256) * DM) : nullptr);
        const int colv = u.pn * 256 + wc * 32 + 8 * fq;
        const GAS float* gv = (const GAS float*)(modl + (size_t)cond * 6144 + gidx * 1024 + colv);
        const GAS float* bp = (const GAS float*)(bias ? bias + colv : nullptr);
        LAS float* Pf = (LAS float*)P; LAS float* Sf = (LAS float*)(P + 4096); LAS unsigned* flag = (LAS unsigned*)(P + 5120);
#pragma unroll
        for (int bj = 0; bj < 2; ++bj) {
            f32x4 g[2], bv[2];
#pragma unroll
            for (int n = 0; n < 2; ++n) { g[n] = *(const GAS f32x4*)(gv + bj * 128 + n * 4); bv[n] = bp ? *(const GAS f32x4*)(bp + bj * 128 + n * 4) : (f32x4){0.f, 0.f, 0.f, 0.f}; }
#pragma unroll
            for (int ai = 0; ai < 2; ++ai) {
                f32x4 o[4][2];
                if (rd_x) {
#pragma unroll
                    for (int m = 0; m < 4; ++m)
#pragma unroll
                        for (int n = 0; n < 2; ++n) o[m][n] = *(const GAS f32x4*)(ibase + (size_t)(ai * 128 + m * 16) * DM * 4 + 2 * lo + (bj * 128 + n * 4) * 4);
                } else {
                    u32x4 w[4];
#pragma unroll
                    for (int m = 0; m < 4; ++m) w[m] = *(const GAS u32x4*)(pbase + (size_t)(ai * 128 + m * 16) * DM * 2 + lo + bj * 256);
#pragma unroll
                    for (int m = 0; m < 4; ++m) { o[m][0] = (f32x4){bf_lo(w[m].x), bf_hi(w[m].x), bf_lo(w[m].y), bf_hi(w[m].y)}; o[m][1] = (f32x4){bf_lo(w[m].z), bf_hi(w[m].z), bf_lo(w[m].w), bf_hi(w[m].w)}; }
                }
#pragma unroll
                for (int m = 0; m < 4; ++m) { const f32x4 r0 = o[m][0] + g[0] * (acc[ai][bj][m][0] + bv[0]), r1 = o[m][1] + g[1] * (acc[ai][bj][m][1] + bv[1]);
                    u32x4 w; w.x = pg8::cvt_pk_bf16(r0[0], r0[1]); w.y = pg8::cvt_pk_bf16(r0[2], r0[3]); w.z = pg8::cvt_pk_bf16(r1[0], r1[1]); w.w = pg8::cvt_pk_bf16(r1[2], r1[3]);
                    *(GAS u32x4*)(pbase + (size_t)(ai * 128 + m * 16) * DM * 2 + lo + bj * 256) = w; acc[ai][bj][m][0] = r0; acc[ai][bj][m][1] = r1; }
                asm volatile("" ::: "memory");
            }
        }
#pragma unroll
        for (int ai = 0; ai < 2; ++ai)
#pragma unroll
            for (int m = 0; m < 4; ++m) { float s = 0.f;
#pragma unroll
                for (int bj = 0; bj < 2; ++bj)
#pragma unroll
                    for (int n = 0; n < 2; ++n) { const f32x4 x = acc[ai][bj][m][n]; s += (x[0] * x[0] + x[1] * x[1]) + (x[2] * x[2] + x[3] * x[3]); }
                s += shx(s, 16, lane); s += shx(s, 32, lane);
                if (fq == 0) Pf[(ai * 128 + wr * 64 + m * 16 + fr) * 4 + wc] = s; }
        asm volatile("s_waitcnt lgkmcnt(0)" ::: "memory"); __builtin_amdgcn_s_barrier(); asm volatile("" ::: "memory");
        const int row = wid * 32 + (lane & 31);
        if (lane < 32) { const f32x4 pp = *(const LAS f32x4*)(Pf + row * 4); const float t = (pp.x + pp.y) + (pp.z + pp.w);
            __hip_atomic_store(xbuf + ((size_t)(u.pm * 256 + row) * 4 + u.pn), __builtin_bit_cast(unsigned, t), RLX_AGENT); }
        asm volatile("s_waitcnt vmcnt(0)" ::: "memory");
        if (lane == 0) __hip_atomic_fetch_add(cnt + 64 * u.pm, 1u, RLX_AGENT);
        if (wid == 0) { bool dead = false; unsigned sp = 0u;
            while ((unsigned)__builtin_amdgcn_readfirstlane((int)__hip_atomic_load(cnt + 64 * u.pm, RLX_AGENT)) < 32u) { __builtin_amdgcn_s_sleep(2);
                if ((++sp & 255u) == 0u) { if (__hip_atomic_load(tmo, RLX_AGENT) != 0u) { dead = true; break; } if (sp > (1u << 20)) { if (lane == 0) atomicAdd(tmo, 1u); dead = true; break; } } }
            __builtin_amdgcn_fence(__ATOMIC_ACQUIRE, "agent");
            if (lane == 0) flag[0] = dead ? 1u : 0u; }
        asm volatile("s_waitcnt vmcnt(0) lgkmcnt(0)" ::: "memory"); __builtin_amdgcn_s_barrier(); asm volatile("" ::: "memory");
        if (lane < 32) { const unsigned* sl = xbuf + (size_t)(u.pm * 256 + row) * 4; float t = 0.f;
#pragma unroll
            for (int q = 0; q < 4; ++q) t += __builtin_bit_cast(float, __hip_atomic_load(sl + q, RLX_AGENT));
            Sf[row] = 1.0f / sqrtf(t * (1.0f / DM) + EPS); }
        asm volatile("s_waitcnt vmcnt(0) lgkmcnt(0)" ::: "memory"); __builtin_amdgcn_s_barrier(); asm volatile("" ::: "memory");
        const GAS float* sh = (const GAS float*)(modn + (size_t)cond * 6144 + sidx * 1024 + colv); const GAS float* sc = sh + 1024; const GAS float* nwp = (const GAS float*)(nw + colv);
#pragma unroll
        for (int bj = 0; bj < 2; ++bj) {
            f32x4 a[2], d[2];
#pragma unroll
            for (int n = 0; n < 2; ++n) { a[n] = *(const GAS f32x4*)(nwp + bj * 128 + n * 4) * (*(const GAS f32x4*)(sc + bj * 128 + n * 4) + 1.0f); d[n] = *(const GAS f32x4*)(sh + bj * 128 + n * 4); }
#pragma unroll
            for (int ai = 0; ai < 2; ++ai)
#pragma unroll
                for (int m = 0; m < 4; ++m) { const int r = ai * 128 + wr * 64 + m * 16 + fr; const float rstd = Sf[r];
                    const f32x4 h0 = acc[ai][bj][m][0] * rstd * a[0] + d[0], h1 = acc[ai][bj][m][1] * rstd * a[1] + d[1];
                    u32x4 w; w.x = pg8::cvt_pk_bf16(h0[0], h0[1]); w.y = pg8::cvt_pk_bf16(h0[2], h0[3]); w.z = pg8::cvt_pk_bf16(h1[0], h1[1]); w.w = pg8::cvt_pk_bf16(h1[2], h1[3]);
                    *(GAS u32x4*)(H + (size_t)(u.pm * 256 + r) * DM + colv + bj * 128) = w; }
        }
        asm volatile("s_waitcnt lgkmcnt(0)" ::: "memory");
    }
};
template <class Inner> struct TailEpi {
    static constexpr bool PERM = Inner::PERM;
    Inner in; int ks; unsigned char* part; unsigned* cnt; unsigned* tmo;
    __device__ __forceinline__ void operator()(f32x4 (&acc)[2][2][4][2], const pg8::Unit& u, int wr, int wc, int fr, int fq) const {
        const int lane = fq * 16 + fr, wid = wr * 4 + wc, tu = ((u.pm - 256) & 15) * 4 + u.pn;
        unsigned* cw = cnt + (size_t)(tu * 8 + wid) * 16;
        if (ks != 0) {
            GAS char* p = (GAS char*)part + ((size_t)(((tu * 3 + ks - 1) * 8 + wid) * 32)) * 1024 + lane * 16;
#pragma unroll
            for (int a = 0; a < 2; ++a)
#pragma unroll
                for (int b = 0; b < 2; ++b)
#pragma unroll
                    for (int m = 0; m < 4; ++m)
#pragma unroll
                        for (int n = 0; n < 2; ++n) { const f32x4 v = acc[a][b][m][n]; GAS char* pq = p + (((a * 2 + b) * 4 + m) * 2 + n) * 1024;
                            asm volatile("global_store_dwordx4 %0, %1, off sc0 sc1" :: "v"(pq), "v"(v) : "memory"); }
            asm volatile("s_waitcnt vmcnt(0)" ::: "memory");
            if (lane == 0) __hip_atomic_fetch_add(cw, 1u, RLX_AGENT);
            return;
        }
        { unsigned sp = 0u;
          while ((unsigned)__builtin_amdgcn_readfirstlane((int)__hip_atomic_load(cw, RLX_AGENT)) < 3u) { __builtin_amdgcn_s_sleep(1);
              if ((++sp & 255u) == 0u) { if (__hip_atomic_load(tmo, RLX_AGENT) != 0u) break; if (sp > (1u << 20)) { if (lane == 0) atomicAdd(tmo, 1u); break; } } }
          __builtin_amdgcn_fence(__ATOMIC_ACQUIRE, "agent"); }
#pragma unroll
        for (int s = 0; s < 3; ++s) {
            const GAS char* p = (const GAS char*)part + ((size_t)(((tu * 3 + s) * 8 + wid) * 32)) * 1024 + lane * 16;
#pragma unroll
            for (int a = 0; a < 2; ++a)
#pragma unroll
                for (int b = 0; b < 2; ++b) { f32x4 v[4][2];
#pragma unroll
                    for (int m = 0; m < 4; ++m)
#pragma unroll
                        for (int n = 0; n < 2; ++n) v[m][n] = *(const GAS f32x4*)(p + (((a * 2 + b) * 4 + m) * 2 + n) * 1024);
#pragma unroll
                    for (int m = 0; m < 4; ++m)
#pragma unroll
                        for (int n = 0; n < 2; ++n) { acc[a][b][m][n] += v[m][n]; asm volatile("" : "+v"(acc[a][b][m][n]) :: "memory"); }
                }
        }
        in(acc, u, wr, wc, fr, fq);
    }
};
__device__ __forceinline__ void split4(int NT, int ks, int& t0, int& n) { const int ne = (NT / 8) * 2, ex = (NT - 4 * ne) / 2; n = ne + (ks < ex ? 2 : 0); t0 = ks * ne + 2 * (ks < ex ? ks : ex); }

struct EpiSwiglu {
    static constexpr bool PERM = true;
    bf16_t* ACT; int ldc;
    __device__ __forceinline__ void operator()(const f32x4 (&acc)[2][2][4][2], const pg8::Unit& u, int wr, int wc, int fr, int fq) const {
        const int row0 = u.pm * 256 + wr * 64 + fr, col0 = u.pn * 128 + wc * 32 + 8 * fq;
#pragma unroll
        for (int ai = 0; ai < 2; ++ai)
#pragma unroll
            for (int m = 0; m < 4; ++m) { const f32x4 g0 = acc[ai][0][m][0], g1 = acc[ai][0][m][1], u0 = acc[ai][1][m][0], u1 = acc[ai][1][m][1];
                const f32x2 o0 = silu2((f32x2){g0[0], g0[1]}) * (f32x2){u0[0], u0[1]}, o1 = silu2((f32x2){g0[2], g0[3]}) * (f32x2){u0[2], u0[3]}, o2 = silu2((f32x2){g1[0], g1[1]}) * (f32x2){u1[0], u1[1]}, o3 = silu2((f32x2){g1[2], g1[3]}) * (f32x2){u1[2], u1[3]};
                u32x4 w; w.x = pg8::cvt_pk_bf16(o0.x, o0.y); w.y = pg8::cvt_pk_bf16(o1.x, o1.y); w.z = pg8::cvt_pk_bf16(o2.x, o2.y); w.w = pg8::cvt_pk_bf16(o3.x, o3.y);
                *(GAS u32x4*)(ACT + (size_t)(row0 + ai * 128 + m * 16) * ldc + col0) = w; }
    }
};
struct EpiQkv {
    static constexpr bool PERM = false;
    bf16_t *Q, *Kb, *Vb; const LAS float* T;
    __device__ __forceinline__ void operator()(const f32x4 (&acc)[2][2][4][2], const pg8::Unit& u, int wr, int wc, int fr, int fq) const {
        const int b = u.pm / 17, j = u.pm - b * 17; const bool isctx = j == 0; const int pos0 = (j - 1) * 256;
        bf16_t* dst; int ld, cbase; float sc = 1.0f;
        if (u.pn < 4) { dst = Q; ld = QW; cbase = u.pn * 256; sc = 0.125f * 1.4426950408889634f;   } else if (u.pn == 4) { dst = Kb; ld = KVW; cbase = 0; } else { dst = Vb; ld = KVW; cbase = 0; }
        const bool dorope = !isctx && u.pn < 5; const int axis = wc & 1;
        const LAS float* bp = T + 2048 + u.pn * 256 + wc * 32 + 4 * fq;
        f32x4 bv[2][2];
#pragma unroll
        for (int bj = 0; bj < 2; ++bj)
#pragma unroll
            for (int n = 0; n < 2; ++n) bv[bj][n] = *(const LAS f32x4*)(bp + bj * 128 + n * 16);
#pragma unroll
        for (int ai = 0; ai < 2; ++ai)
#pragma unroll
            for (int m = 0; m < 4; ++m) { const int r = ai * 128 + wr * 64 + m * 16 + fr; const int pos = pos0 + r; const int id = axis ? (pos & 63) : (pos >> 6);
                f32x4 cs = (f32x4){1.f, 1.f, 1.f, 1.f}, sn = (f32x4){0.f, 0.f, 0.f, 0.f};
                if (dorope) { cs = *(const LAS f32x4*)(T + id * 16 + 4 * fq); sn = *(const LAS f32x4*)(T + 1024 + id * 16 + 4 * fq); }
                GAS bf16_t* rowp = (GAS bf16_t*)(dst + (size_t)(u.pm * 256 + r) * ld + cbase + wc * 32 + 4 * fq);
#pragma unroll
                for (int bj = 0; bj < 2; ++bj) { const f32x4 x0 = (acc[ai][bj][m][0] + bv[bj][0]) * sc, x1 = (acc[ai][bj][m][1] + bv[bj][1]) * sc;
                    const f32x4 o0 = x0 * cs - x1 * sn, o1 = x1 * cs + x0 * sn;
                    u32x2 w0, w1; w0.x = pg8::cvt_pk_bf16(o0[0], o0[1]); w0.y = pg8::cvt_pk_bf16(o0[2], o0[3]); w1.x = pg8::cvt_pk_bf16(o1[0], o1[1]); w1.y = pg8::cvt_pk_bf16(o1[2], o1[3]);
                    *(GAS u32x2*)(rowp + bj * 128) = w0; *(GAS u32x2*)(rowp + bj * 128 + 16) = w1; } }
    }
};

struct MoeOrder {
    pg8::StaticOrder so; int cs; int pp[9]; int cnt[8]; const int* rlist; size_t bstride; bool GATHER_A;
    __device__ __forceinline__ void locate(int pm, int& e, int& p, int& cn) const { const int gp = cs + pm; e = 0; int pbase = 0; cn = cnt[0];
#pragma unroll
        for (int k = 1; k < 8; ++k) { const bool ge = gp >= pp[k]; e += ge ? 1 : 0; pbase = ge ? pp[k] : pbase; cn = ge ? cnt[k] : cn; }
        p = gp - pbase; }
    __device__ bool next(int i, pg8::Unit& u) const { return so.next(i, u); }
    __device__ __forceinline__ const char* a_base(const pg8::Gemm& g, const pg8::Unit& u) const { return GATHER_A ? (const char*)g.A : (const char*)g.A + (size_t)u.pm * (size_t)(256 * 2) * g.lda; }
    __device__ __forceinline__ const char* b_base(const pg8::Gemm& g, const pg8::Unit& u) const { int e, p, cn; locate(u.pm, e, p, cn); return (const char*)g.Bt + (size_t)e * bstride + (size_t)u.pn * (size_t)(256 * 2) * g.K; }
    __device__ __forceinline__ unsigned row_off(const pg8::Gemm& g, const pg8::Unit& u, int r) const {
        if (!GATHER_A) return (unsigned)r * (unsigned)g.lda * 2u;
        int e, p, cn; locate(u.pm, e, p, cn); const int idx = p * 256 + r; const int tok = idx < cn ? (((const GAS int*)rlist)[(size_t)e * MROWS + idx] >> 1) : 0; return (unsigned)tok * (unsigned)g.lda * 2u; }
};
struct EpiMoeDown {
    static constexpr bool PERM = true;
    MoeOrder mo; bf16_t* EO; const float* GATE;
    __device__ __forceinline__ void operator()(const f32x4 (&acc)[2][2][4][2], const pg8::Unit& u, int wr, int wc, int fr, int fq) const {
        int e, p, cn; mo.locate(u.pm, e, p, cn); const GAS int* rl = (const GAS int*)(mo.rlist + (size_t)e * MROWS + p * 256);
        const int col0 = u.pn * 256 + wc * 32 + 8 * fq;
#pragma unroll
        for (int ai = 0; ai < 2; ++ai)
#pragma unroll
            for (int m = 0; m < 4; ++m) { const int r = ai * 128 + wr * 64 + m * 16 + fr;
                if (p * 256 + r < cn) { const int ent = rl[r]; const float gt = ((const GAS float*)GATE)[ent]; bf16_t* dp = EO + (size_t)ent * DM + col0;
#pragma unroll
                    for (int bj = 0; bj < 2; ++bj) { const f32x4 v0 = acc[ai][bj][m][0] * gt, v1 = acc[ai][bj][m][1] * gt; u32x4 w; w.x = pg8::cvt_pk_bf16(v0[0], v0[1]); w.y = pg8::cvt_pk_bf16(v0[2], v0[3]); w.z = pg8::cvt_pk_bf16(v1[0], v1[1]); w.w = pg8::cvt_pk_bf16(v1[2], v1[3]);
                        *(GAS u32x4*)(dp + bj * 128) = w; } } }
    }
};

typedef __bf16 bf16x2_t __attribute__((ext_vector_type(2)));
typedef short v4i16_t __attribute__((ext_vector_type(4)));
__device__ __forceinline__ unsigned cvtpk(float lo, float hi) { f32x2 v = {lo, hi}; bf16x2_t b = __builtin_convertvector(v, bf16x2_t); return __builtin_bit_cast(unsigned, b); }
__device__ __forceinline__ int crow(int r, int hi) { return (r & 3) + 8 * (r >> 2) + 4 * hi; }
__device__ __forceinline__ s16x4 vtr(const LAS unsigned char* p) { return __builtin_bit_cast(s16x4, __builtin_amdgcn_ds_read_tr16_b64_v4i16((LAS v4i16_t*)p)); }
#define MFMA32(a, b, c) __builtin_amdgcn_mfma_f32_32x32x16_bf16((a), (b), (c), 0, 0, 0)
__device__ __forceinline__ void conv_phase(Frame& F, const Args& A, int j) {
    phase_enter(F);
    bf16_t* XBC = (bf16_t*)(F.ws + WS_BIG); const bf16_t* HALO = (const bf16_t*)(F.ws + WS_HALO);
    const int lane = F.lane;
    const int gw = blockIdx.x * NWAVES + F.wave, NGW = F.G * NWAVES;
    for (int task = gw; task < NPAN * 32; task += NGW) {
        const int pm = task >> 5, q = (task >> 3) & 3, sl = task & 7, jj = pm % 17, c0 = sl * 512 + lane * 8;
        const bool top_zero = q == 0 && jj <= 1, bot_zero = q == 3 && (jj == 0 || jj == 16);
        const GAS bf16_t* htop = (const GAS bf16_t*)(HALO + (q == 0 ? ((size_t)(pm - 1) * 16 + 14) : ((size_t)pm * 16 + 4 * q - 2)) * CONVCH + c0);
        const GAS bf16_t* hbot = (const GAS bf16_t*)(HALO + (q == 3 ? ((size_t)(pm + 1) * 16 + 0) : ((size_t)pm * 16 + 4 * q + 4)) * CONVCH + c0);
        f32x2 cw[5][4], cbias[4];
#pragma unroll
        for (int k = 0; k < 5; ++k) { const f32x4 a0 = *(const GAS f32x4*)(A.ssd_conv_w + (size_t)(j * 5 + k) * CONVCH + c0), a1 = *(const GAS f32x4*)(A.ssd_conv_w + (size_t)(j * 5 + k) * CONVCH + c0 + 4);
            cw[k][0] = (f32x2){a0.x, a0.y}; cw[k][1] = (f32x2){a0.z, a0.w}; cw[k][2] = (f32x2){a1.x, a1.y}; cw[k][3] = (f32x2){a1.z, a1.w}; }
        { const f32x4 a0 = *(const GAS f32x4*)(A.ssd_conv_b + (size_t)j * CONVCH + c0), a1 = *(const GAS f32x4*)(A.ssd_conv_b + (size_t)j * CONVCH + c0 + 4);
            cbias[0] = (f32x2){a0.x, a0.y}; cbias[1] = (f32x2){a0.z, a0.w}; cbias[2] = (f32x2){a1.x, a1.y}; cbias[3] = (f32x2){a1.z, a1.w}; }
        GAS bf16_t* base = (GAS bf16_t*)(XBC + ((size_t)pm * 256 + q * 64) * CONVCH + c0);
        const u32x4 zero4 = (u32x4){0u, 0u, 0u, 0u};
        u32x4 win[12], pre[8];
        win[0] = top_zero ? zero4 : *(const GAS u32x4*)(htop);
        win[1] = top_zero ? zero4 : *(const GAS u32x4*)(htop + CONVCH);
#pragma unroll
        for (int r = 0; r < 10; ++r) win[2 + r] = *(const GAS u32x4*)(base + (size_t)r * CONVCH);
        for (int k = 0; k < 8; ++k) {
            if (k < 6) {
#pragma unroll
                for (int r = 0; r < 8; ++r) pre[r] = *(const GAS u32x4*)(base + (size_t)(8 * k + 10 + r) * CONVCH);
            } else if (k == 6) {
#pragma unroll
                for (int r = 0; r < 6; ++r) pre[r] = *(const GAS u32x4*)(base + (size_t)(58 + r) * CONVCH);
                pre[6] = bot_zero ? zero4 : *(const GAS u32x4*)(hbot);
                pre[7] = bot_zero ? zero4 : *(const GAS u32x4*)(hbot + CONVCH);
            }
#pragma unroll
            for (int o = 0; o < 8; ++o) {
                f32x2 r[4];
#pragma unroll
                for (int c = 0; c < 4; ++c) r[c] = cbias[c];
#pragma unroll
                for (int t = 0; t < 5; ++t) { const u32x4 w = win[o + t];
                    r[0] += cw[t][0] * (f32x2){bf_lo(w.x), bf_hi(w.x)}; r[1] += cw[t][1] * (f32x2){bf_lo(w.y), bf_hi(w.y)};
                    r[2] += cw[t][2] * (f32x2){bf_lo(w.z), bf_hi(w.z)}; r[3] += cw[t][3] * (f32x2){bf_lo(w.w), bf_hi(w.w)}; }
                const f32x2 s0 = silu2(r[0]), s1 = silu2(r[1]), s2 = silu2(r[2]), s3 = silu2(r[3]); u32x4 w; w.x = cvtpk(s0.x, s0.y); w.y = cvtpk(s1.x, s1.y); w.z = cvtpk(s2.x, s2.y); w.w = cvtpk(s3.x, s3.y);
                *(GAS u32x4*)(base + (size_t)(8 * k + o) * CONVCH) = w;
            }
#pragma unroll
            for (int r = 0; r < 4; ++r) win[r] = win[8 + r];
#pragma unroll
            for (int r = 0; r < 8; ++r) win[4 + r] = pre[r];
        }
    }
}

constexpr int SC_RS = 272;
constexpr int SC_TILE = 3 * 32 * SC_RS;
constexpr int SC_TB = 2 * SC_TILE;
constexpr int SC_YS = 2 * SC_TB;
constexpr int SC_WS = SC_YS + 2 * 16384;
constexpr int SC_RAW = 73728;
static_assert(SC_WS + 8 * 1024 <= LDSCTL_OFF, "scan LDS map");
template <int PH>
__device__ __forceinline__ void scan_phase(Frame& F, const Args& A, int j) {
    phase_enter(F);
    const bf16_t* XBC = (const bf16_t*)(F.ws + WS_BIG); const float* DT = (const float*)(F.ws + WS_DT); bf16_t* Y = (bf16_t*)(F.ws + WS_Y);
    const int lane = F.lane, wave = F.wave;
    for (int u0 = blockIdx.x; u0 < 256; u0 += F.G) {
        const int unit = (F.G == 256) ? ((u0 & 7) * 32 + (u0 >> 3)) : u0;
        const int b = unit >> 4, g = (unit >> 1) & 7, ph = unit & 1;
        const int srow = F.tid >> 4, sch = F.tid & 15;
        const int gcolB = 2048 + g * 128 + sch * 8, gcolC = 3072 + g * 128 + sch * 8, gcolX = g * 256 + (sch >> 2) * 64 + ph * 32 + (sch & 3) * 8;
        const int hh = wave >> 1, dir = wave & 1, c31 = lane & 31, hl = lane >> 5;
        const int trq = (lane & 15) >> 2, trp = lane & 3, trb = (lane >> 4) & 1;
        const int head = g * 4 + hh;
        const float Dk = A.ssd_d[(j * 2 + dir) * 32 + head], dtb = A.ssd_dt_bias[(j * 2 + dir) * 32 + head], aneg = -expf(A.ssd_a_log[(j * 2 + dir) * 32 + head]);
        LAS float* wsf = (LAS float*)(F.lds + SC_WS + wave * 1024);
        int offRow = dir * SC_TILE + c31 * SC_RS + 16 * hl;
        int offC4 = dir * SC_TILE + 32 * SC_RS + c31 * SC_RS + 8 * hl;
        int offTrX = dir * SC_TILE + 64 * SC_RS + trq * SC_RS + (hh * 32 + 16 * trb + 4 * trp) * 2;
        int offTrB = dir * SC_TILE + trq * SC_RS + (16 * trb + 4 * trp) * 2;
        int ysoff = (4 * hl) * 128 + hh * 32 + c31;
        asm volatile("" : "+v"(offRow), "+v"(offC4), "+v"(offTrX), "+v"(offTrB), "+v"(ysoff));
        f32x16 ST[4];
#pragma unroll
        for (int t = 0; t < 4; ++t)
#pragma unroll
            for (int e = 0; e < 16; ++e) ST[t][e] = 0.f;
#define SC_PF(pf, st_) do { const int st = (PH >= 2) ? 0 : (st_); const int cf_ = (st), cb_ = (st) < 8 ? 7 - (st) : 143 - (st); \
            _Pragma("unroll") for (int T = 0; T < 2; ++T) { const GAS bf16_t* rp = (const GAS bf16_t*)(XBC + (size_t)(b * SROW + (T ? cb_ : cf_) * 32 + srow) * CONVCH); \
                pf[T][0] = *(const GAS u32x4*)(rp + gcolB); pf[T][1] = *(const GAS u32x4*)(rp + gcolC); pf[T][2] = *(const GAS u32x4*)(rp + gcolX); } } while (0)
#define SC_DTLOAD(st) ((const GAS float*)DT)[(size_t)(b * SROW + (dir ? ((st) < 8 ? 7 - (st) : 143 - (st)) : (st)) * 32 + c31) * 64 + dir * 32 + head]
#define SC_WRITEOUT(st, PY) do { const int cf_ = (st), cb_ = (st) < 8 ? 7 - (st) : 143 - (st); \
            _Pragma("unroll") for (int T = 0; T < 2; ++T) { const int tok = F.tid >> 4, h4 = (F.tid >> 2) & 3, q4 = F.tid & 3, chunk = T ? cb_ : cf_; \
                const int other = T == 0 ? (chunk < 8 ? 7 - chunk : 143 - chunk) : chunk; \
                u32x4 v = *(const LAS u32x4*)(F.lds + SC_YS + (PY) * 16384 + T * 8192 + (tok * 128 + h4 * 32 + q4 * 8) * 2); \
                bf16_t* yp = Y + (size_t)(b * SROW + chunk * 32 + tok) * DIN + g * 256 + ph * 128 + h4 * 32 + q4 * 8; \
                if ((st) > other) { const u32x4 o = oldy[T]; \
                    v.x = pk2(bf_lo(o.x) + bf_lo(v.x), bf_hi(o.x) + bf_hi(v.x)); v.y = pk2(bf_lo(o.y) + bf_lo(v.y), bf_hi(o.y) + bf_hi(v.y)); \
                    v.z = pk2(bf_lo(o.z) + bf_lo(v.z), bf_hi(o.z) + bf_hi(v.z)); v.w = pk2(bf_lo(o.w) + bf_lo(v.w), bf_hi(o.w) + bf_hi(v.w)); } \
                if (PH == 0) *(GAS u32x4*)yp = v; else asm volatile("" :: "v"(v)); } } while (0)
        u32x4 pfE[2][3], pfO[2][3];
        SC_PF(pfE, 0); SC_PF(pfO, 1);
        float dtraw = SC_DTLOAD(0);
        u32x4 oldy[2] = {(u32x4){0u, 0u, 0u, 0u}, (u32x4){0u, 0u, 0u, 0u}};
        {
#pragma unroll
            for (int T = 0; T < 2; ++T)
#pragma unroll
                for (int a = 0; a < 3; ++a) *(LAS u32x4*)(F.lds + 0 * SC_TB + T * SC_TILE + a * (32 * SC_RS) + srow * SC_RS + sch * 16) = pfE[T][a];
            {
                const float xb = dtraw + dtb;
                const float dt = xb > 20.f ? xb : log1pf(__expf(xb)); const float dA = dt * aneg;
                float v = dA;
                v += __builtin_bit_cast(float, __builtin_amdgcn_update_dpp(0, __builtin_bit_cast(int, v), 0x111, 0xf, 0xf, true));
                v += __builtin_bit_cast(float, __builtin_amdgcn_update_dpp(0, __builtin_bit_cast(int, v), 0x112, 0xf, 0xf, true));
                v += __builtin_bit_cast(float, __builtin_amdgcn_update_dpp(0, __builtin_bit_cast(int, v), 0x114, 0xf, 0xf, true));
                v += __builtin_bit_cast(float, __builtin_amdgcn_update_dpp(0, __builtin_bit_cast(int, v), 0x118, 0xf, 0xf, true));
                v += __builtin_bit_cast(float, __builtin_amdgcn_update_dpp(0, __builtin_bit_cast(int, v), 0x142, 0xa, 0xf, false));
                const float tot = __builtin_bit_cast(float, __builtin_amdgcn_readlane(__builtin_bit_cast(int, v), 31));
                const float cum = dir ? (tot - v + dA) : v;
                if (hl == 0) { wsf[c31] = cum; wsf[32 + c31] = dt; wsf[64 + c31] = __expf(tot - cum) * dt; wsf[96 + c31] = __expf(cum); }
            }
        }
        SC_PF(pfE, 2); dtraw = SC_DTLOAD(1);
        for (int step2 = 0; step2 < 136; step2 += 2) {
          { const int step = step2;
            const int cf = step, cbk = step < 8 ? 7 - step : 143 - step;
            constexpr int P = 0; LAS float* wsfP = wsf + P * 128; LAS float* wsfN = wsf + (P ^ 1) * 128;
            __syncthreads();
            if (step > 0) SC_WRITEOUT(step - 1, P ^ 1);
            if (step + 1 < 136) {
#pragma unroll
            for (int T = 0; T < 2; ++T)
#pragma unroll
                for (int a = 0; a < 3; ++a) *(LAS u32x4*)(F.lds + (P ^ 1) * SC_TB + T * SC_TILE + a * (32 * SC_RS) + srow * SC_RS + sch * 16) = pfO[T][a];
            {
                const float xb = dtraw + dtb;
                const float dt = xb > 20.f ? xb : log1pf(__expf(xb)); const float dA = dt * aneg;
                float v = dA;
                v += __builtin_bit_cast(float, __builtin_amdgcn_update_dpp(0, __builtin_bit_cast(int, v), 0x111, 0xf, 0xf, true));
                v += __builtin_bit_cast(float, __builtin_amdgcn_update_dpp(0, __builtin_bit_cast(int, v), 0x112, 0xf, 0xf, true));
                v += __builtin_bit_cast(float, __builtin_amdgcn_update_dpp(0, __builtin_bit_cast(int, v), 0x114, 0xf, 0xf, true));
                v += __builtin_bit_cast(float, __builtin_amdgcn_update_dpp(0, __builtin_bit_cast(int, v), 0x118, 0xf, 0xf, true));
                v += __builtin_bit_cast(float, __builtin_amdgcn_update_dpp(0, __builtin_bit_cast(int, v), 0x142, 0xa, 0xf, false));
                const float tot = __builtin_bit_cast(float, __builtin_amdgcn_readlane(__builtin_bit_cast(int, v), 31));
                const float cum = dir ? (tot - v + dA) : v;
                if (hl == 0) { wsfN[c31] = cum; wsfN[32 + c31] = dt; wsfN[64 + c31] = __expf(tot - cum) * dt; wsfN[96 + c31] = __expf(cum); }
            }
            }
            if (step + 3 < 136) SC_PF(pfO, step + 3); if (step + 2 < 136) dtraw = SC_DTLOAD(step + 2);
#pragma unroll
            for (int T = 0; T < 2; ++T) {
                const int tok = F.tid >> 4, h4 = (F.tid >> 2) & 3, q4 = F.tid & 3, chunk = T ? cbk : cf;
                const int other = T == 0 ? (chunk < 8 ? 7 - chunk : 143 - chunk) : chunk;
                if (PH == 0 && step > other) oldy[T] = *(const GAS u32x4*)(Y + (size_t)(b * SROW + chunk * 32 + tok) * DIN + g * 256 + ph * 128 + h4 * 32 + q4 * 8);
            }
            if (PH < 3) {
                const LAS unsigned char* Bs = F.lds + P * SC_TB + dir * SC_TILE; const LAS unsigned char* Cs = Bs + 32 * SC_RS; const LAS unsigned char* xs = Bs + 64 * SC_RS;
                f32x16 gt;
#pragma unroll
                for (int e = 0; e < 16; ++e) gt[e] = 0.f;
#pragma unroll
                for (int s0 = 0; s0 < 8; s0 += 4) {
                    bf16x8 av[4], bv[4];
#pragma unroll
                    for (int s = 0; s < 4; ++s) { av[s] = *(const LAS bf16x8*)(F.lds + P * SC_TB + offRow + 32 * (s0 + s)); bv[s] = *(const LAS bf16x8*)(F.lds + P * SC_TB + offRow + 32 * SC_RS + 32 * (s0 + s)); }
                    __builtin_amdgcn_sched_barrier(0);
#pragma unroll
                    for (int s = 0; s < 4; ++s) gt = MFMA32(av[s], bv[s], gt);
                }
                const float cum_i = wsfP[c31];
                bf16x8 mk[2];
                {
                    float mv[16];
#pragma unroll
                    for (int q = 0; q < 4; ++q) { const f32x4 cj = *(const LAS f32x4*)(wsfP + 8 * q + 4 * hl), dj = *(const LAS f32x4*)(wsfP + 32 + 8 * q + 4 * hl);
#pragma unroll
                        for (int z = 0; z < 4; ++z) { const int jj = 8 * q + 4 * hl + z; const bool ok = dir ? (jj >= c31) : (jj <= c31);
                            float val = gt[4 * q + z] * __expf(ok ? (cum_i - cj[z]) : -INFINITY) * dj[z]; if (jj == c31) val += Dk; mv[4 * q + z] = val; } }
#pragma unroll
                    for (int s2 = 0; s2 < 2; ++s2) { u32x4 w; w.x = cvtpk(mv[8 * s2], mv[8 * s2 + 1]); w.y = cvtpk(mv[8 * s2 + 2], mv[8 * s2 + 3]); w.z = cvtpk(mv[8 * s2 + 4], mv[8 * s2 + 5]); w.w = cvtpk(mv[8 * s2 + 6], mv[8 * s2 + 7]); mk[s2] = __builtin_bit_cast(bf16x8, w); }
                }
                f32x16 ya;
#pragma unroll
                for (int e = 0; e < 16; ++e) ya[e] = 0.f;
#pragma unroll
                for (int t0 = 0; t0 < 4; t0 += 2) {
                    u32x2 cc[4][2];
#pragma unroll
                    for (int k = 0; k < 4; ++k) { const LAS unsigned char* cp = F.lds + P * SC_TB + offC4 + 64 * (t0 + (k >> 1)) + 32 * (k & 1); cc[k][0] = *(const LAS u32x2*)cp; cc[k][1] = *(const LAS u32x2*)(cp + 16); }
                    __builtin_amdgcn_sched_barrier(0);
#pragma unroll
                    for (int k = 0; k < 4; ++k) { const int t = t0 + (k >> 1), s2 = k & 1;
                        const bf16x8 ca = __builtin_bit_cast(bf16x8, (u32x4){cc[k][0].x, cc[k][0].y, cc[k][1].x, cc[k][1].y});
                        u32x4 w; w.x = cvtpk(ST[t][8 * s2], ST[t][8 * s2 + 1]); w.y = cvtpk(ST[t][8 * s2 + 2], ST[t][8 * s2 + 3]); w.z = cvtpk(ST[t][8 * s2 + 4], ST[t][8 * s2 + 5]); w.w = cvtpk(ST[t][8 * s2 + 6], ST[t][8 * s2 + 7]);
                        ya = MFMA32(ca, __builtin_bit_cast(bf16x8, w), ya);
                    }
                }
                f32x4 ecv[4]; s16x4 mlo[2], mhi[2];
#pragma unroll
                for (int q = 0; q < 4; ++q) ecv[q] = *(const LAS f32x4*)(wsfP + 96 + 8 * q + 4 * hl);
#pragma unroll
                for (int s2 = 0; s2 < 2; ++s2) { const LAS unsigned char* xp = F.lds + P * SC_TB + offTrX + (16 * s2) * SC_RS + hl * (4 * SC_RS); mlo[s2] = vtr(xp); mhi[s2] = vtr(xp + 8 * SC_RS); }
                __builtin_amdgcn_sched_barrier(0);
#pragma unroll
                for (int q = 0; q < 4; ++q) { const f32x4 ec = ecv[q]; ya[4 * q] *= ec.x; ya[4 * q + 1] *= ec.y; ya[4 * q + 2] *= ec.z; ya[4 * q + 3] *= ec.w; }
#pragma unroll
                for (int s2 = 0; s2 < 2; ++s2) { const s16x4 lo = mlo[s2], hi = mhi[s2];
                    ya = MFMA32(mk[s2], ((bf16x8){lo[0], lo[1], lo[2], lo[3], hi[0], hi[1], hi[2], hi[3]}), ya);
                }
                {
                    const float etot = dir ? wsfP[96] : wsfP[96 + 31];
                    s16x4 xlo[2], xhi[2]; f32x4 w0v[2], w1v[2];
#pragma unroll
                    for (int s2 = 0; s2 < 2; ++s2) { const LAS unsigned char* xp = F.lds + P * SC_TB + offTrX + (16 * s2) * SC_RS + hl * (8 * SC_RS); xlo[s2] = vtr(xp); xhi[s2] = vtr(xp + 4 * SC_RS);
                        w0v[s2] = *(const LAS f32x4*)(wsfP + 64 + 16 * s2 + 8 * hl); w1v[s2] = *(const LAS f32x4*)(wsfP + 64 + 16 * s2 + 8 * hl + 4); }
                    __builtin_amdgcn_sched_barrier(0);
#pragma unroll
                    for (int t = 0; t < 4; ++t)
#pragma unroll
                        for (int e = 0; e < 16; ++e) ST[t][e] *= etot;
#pragma unroll
                    for (int s2 = 0; s2 < 2; ++s2) {
                        const s16x4 lo = xlo[s2], hi = xhi[s2];
                        const f32x4 w0 = w0v[s2], w1 = w1v[s2];
                        u32x4 xw; xw.x = cvtpk(bf1((bf16_t)lo[0]) * w0.x, bf1((bf16_t)lo[1]) * w0.y); xw.y = cvtpk(bf1((bf16_t)lo[2]) * w0.z, bf1((bf16_t)lo[3]) * w0.w);
                        xw.z = cvtpk(bf1((bf16_t)hi[0]) * w1.x, bf1((bf16_t)hi[1]) * w1.y); xw.w = cvtpk(bf1((bf16_t)hi[2]) * w1.z, bf1((bf16_t)hi[3]) * w1.w);
                        const bf16x8 xb8 = __builtin_bit_cast(bf16x8, xw);
                        s16x4 blo[4], bhi[4];
#pragma unroll
                        for (int t = 0; t < 4; ++t) { const LAS unsigned char* bp = F.lds + P * SC_TB + offTrB + (16 * s2) * SC_RS + hl * (8 * SC_RS) + 64 * t; blo[t] = vtr(bp); bhi[t] = vtr(bp + 4 * SC_RS); }
                        __builtin_amdgcn_sched_barrier(0);
#pragma unroll
                        for (int t = 0; t < 4; ++t) ST[t] = MFMA32(((bf16x8){blo[t][0], blo[t][1], blo[t][2], blo[t][3], bhi[t][0], bhi[t][1], bhi[t][2], bhi[t][3]}), xb8, ST[t]);
                    }
                }
                LAS bf16_t* ys = (LAS bf16_t*)(F.lds + SC_YS + P * 16384 + dir * 8192) + ysoff;
#pragma unroll
                for (int e = 0; e < 16; e += 2) { const unsigned w = cvtpk(ya[e], ya[e + 1]); ys[((e & 3) + 8 * (e >> 2)) * 128] = (bf16_t)w; ys[((e & 3) + 1 + 8 * (e >> 2)) * 128] = (bf16_t)(w >> 16); }
            }
                  }
          { const int step = step2 + 1;
            const int cf = step, cbk = step < 8 ? 7 - step : 143 - step;
            constexpr int P = 1; LAS float* wsfP = wsf + P * 128; LAS float* wsfN = wsf + (P ^ 1) * 128;
            __syncthreads();
            if (step > 0) SC_WRITEOUT(step - 1, P ^ 1);
            if (step + 1 < 136) {
#pragma unroll
            for (int T = 0; T < 2; ++T)
#pragma unroll
                for (int a = 0; a < 3; ++a) *(LAS u32x4*)(F.lds + (P ^ 1) * SC_TB + T * SC_TILE + a * (32 * SC_RS) + srow * SC_RS + sch * 16) = pfE[T][a];
            {
                const float xb = dtraw + dtb;
                const float dt = xb > 20.f ? xb : log1pf(__expf(xb)); const float dA = dt * aneg;
                float v = dA;
                v += __builtin_bit_cast(float, __builtin_amdgcn_update_dpp(0, __builtin_bit_cast(int, v), 0x111, 0xf, 0xf, true));
                v += __builtin_bit_cast(float, __builtin_amdgcn_update_dpp(0, __builtin_bit_cast(int, v), 0x112, 0xf, 0xf, true));
                v += __builtin_bit_cast(float, __builtin_amdgcn_update_dpp(0, __builtin_bit_cast(int, v), 0x114, 0xf, 0xf, true));
                v += __builtin_bit_cast(float, __builtin_amdgcn_update_dpp(0, __builtin_bit_cast(int, v), 0x118, 0xf, 0xf, true));
                v += __builtin_bit_cast(float, __builtin_amdgcn_update_dpp(0, __builtin_bit_cast(int, v), 0x142, 0xa, 0xf, false));
                const float tot = __builtin_bit_cast(float, __builtin_amdgcn_readlane(__builtin_bit_cast(int, v), 31));
                const float cum = dir ? (tot - v + dA) : v;
                if (hl == 0) { wsfN[c31] = cum; wsfN[32 + c31] = dt; wsfN[64 + c31] = __expf(tot - cum) * dt; wsfN[96 + c31] = __expf(cum); }
            }
            }
            if (step + 3 < 136) SC_PF(pfE, step + 3); if (step + 2 < 136) dtraw = SC_DTLOAD(step + 2);
#pragma unroll
            for (int T = 0; T < 2; ++T) {
                const int tok = F.tid >> 4, h4 = (F.tid >> 2) & 3, q4 = F.tid & 3, chunk = T ? cbk : cf;
                const int other = T == 0 ? (chunk < 8 ? 7 - chunk : 143 - chunk) : chunk;
                if (PH == 0 && step > other) oldy[T] = *(const GAS u32x4*)(Y + (size_t)(b * SROW + chunk * 32 + tok) * DIN + g * 256 + ph * 128 + h4 * 32 + q4 * 8);
            }
            if (PH < 3) {
                const LAS unsigned char* Bs = F.lds + P * SC_TB + dir * SC_TILE; const LAS unsigned char* Cs = Bs + 32 * SC_RS; const LAS unsigned char* xs = Bs + 64 * SC_RS;
                f32x16 gt;
#pragma unroll
                for (int e = 0; e < 16; ++e) gt[e] = 0.f;
#pragma unroll
                for (int s0 = 0; s0 < 8; s0 += 4) {
                    bf16x8 av[4], bv[4];
#pragma unroll
                    for (int s = 0; s < 4; ++s) { av[s] = *(const LAS bf16x8*)(F.lds + P * SC_TB + offRow + 32 * (s0 + s)); bv[s] = *(const LAS bf16x8*)(F.lds + P * SC_TB + offRow + 32 * SC_RS + 32 * (s0 + s)); }
                    __builtin_amdgcn_sched_barrier(0);
#pragma unroll
                    for (int s = 0; s < 4; ++s) gt = MFMA32(av[s], bv[s], gt);
                }
                const float cum_i = wsfP[c31];
                bf16x8 mk[2];
                {
                    float mv[16];
#pragma unroll
                    for (int q = 0; q < 4; ++q) { const f32x4 cj = *(const LAS f32x4*)(wsfP + 8 * q + 4 * hl), dj = *(const LAS f32x4*)(wsfP + 32 + 8 * q + 4 * hl);
#pragma unroll
                        for (int z = 0; z < 4; ++z) { const int jj = 8 * q + 4 * hl + z; const bool ok = dir ? (jj >= c31) : (jj <= c31);
                            float val = gt[4 * q + z] * __expf(ok ? (cum_i - cj[z]) : -INFINITY) * dj[z]; if (jj == c31) val += Dk; mv[4 * q + z] = val; } }
#pragma unroll
                    for (int s2 = 0; s2 < 2; ++s2) { u32x4 w; w.x = cvtpk(mv[8 * s2], mv[8 * s2 + 1]); w.y = cvtpk(mv[8 * s2 + 2], mv[8 * s2 + 3]); w.z = cvtpk(mv[8 * s2 + 4], mv[8 * s2 + 5]); w.w = cvtpk(mv[8 * s2 + 6], mv[8 * s2 + 7]); mk[s2] = __builtin_bit_cast(bf16x8, w); }
                }
                f32x16 ya;
#pragma unroll
                for (int e = 0; e < 16; ++e) ya[e] = 0.f;
#pragma unroll
                for (int t0 = 0; t0 < 4; t0 += 2) {
                    u32x2 cc[4][2];
#pragma unroll
                    for (int k = 0; k < 4; ++k) { const LAS unsigned char* cp = F.lds + P * SC_TB + offC4 + 64 * (t0 + (k >> 1)) + 32 * (k & 1); cc[k][0] = *(const LAS u32x2*)cp; cc[k][1] = *(const LAS u32x2*)(cp + 16); }
                    __builtin_amdgcn_sched_barrier(0);
#pragma unroll
                    for (int k = 0; k < 4; ++k) { const int t = t0 + (k >> 1), s2 = k & 1;
                        const bf16x8 ca = __builtin_bit_cast(bf16x8, (u32x4){cc[k][0].x, cc[k][0].y, cc[k][1].x, cc[k][1].y});
                        u32x4 w; w.x = cvtpk(ST[t][8 * s2], ST[t][8 * s2 + 1]); w.y = cvtpk(ST[t][8 * s2 + 2], ST[t][8 * s2 + 3]); w.z = cvtpk(ST[t][8 * s2 + 4], ST[t][8 * s2 + 5]); w.w = cvtpk(ST[t][8 * s2 + 6], ST[t][8 * s2 + 7]);
                        ya = MFMA32(ca, __builtin_bit_cast(bf16x8, w), ya);
                    }
                }
                f32x4 ecv[4]; s16x4 mlo[2], mhi[2];
#pragma unroll
                for (int q = 0; q < 4; ++q) ecv[q] = *(const LAS f32x4*)(wsfP + 96 + 8 * q + 4 * hl);
#pragma unroll
                for (int s2 = 0; s2 < 2; ++s2) { const LAS unsigned char* xp = F.lds + P * SC_TB + offTrX + (16 * s2) * SC_RS + hl * (4 * SC_RS); mlo[s2] = vtr(xp); mhi[s2] = vtr(xp + 8 * SC_RS); }
                __builtin_amdgcn_sched_barrier(0);
#pragma unroll
                for (int q = 0; q < 4; ++q) { const f32x4 ec = ecv[q]; ya[4 * q] *= ec.x; ya[4 * q + 1] *= ec.y; ya[4 * q + 2] *= ec.z; ya[4 * q + 3] *= ec.w; }
#pragma unroll
                for (int s2 = 0; s2 < 2; ++s2) { const s16x4 lo = mlo[s2], hi = mhi[s2];
                    ya = MFMA32(mk[s2], ((bf16x8){lo[0], lo[1], lo[2], lo[3], hi[0], hi[1], hi[2], hi[3]}), ya);
                }
                {
                    const float etot = dir ? wsfP[96] : wsfP[96 + 31];
                    s16x4 xlo[2], xhi[2]; f32x4 w0v[2], w1v[2];
#pragma unroll
                    for (int s2 = 0; s2 < 2; ++s2) { const LAS unsigned char* xp = F.lds + P * SC_TB + offTrX + (16 * s2) * SC_RS + hl * (8 * SC_RS); xlo[s2] = vtr(xp); xhi[s2] = vtr(xp + 4 * SC_RS);
                        w0v[s2] = *(const LAS f32x4*)(wsfP + 64 + 16 * s2 + 8 * hl); w1v[s2] = *(const LAS f32x4*)(wsfP + 64 + 16 * s2 + 8 * hl + 4); }
                    __builtin_amdgcn_sched_barrier(0);
#pragma unroll
                    for (int t = 0; t < 4; ++t)
#pragma unroll
                        for (int e = 0; e < 16; ++e) ST[t][e] *= etot;
#pragma unroll
                    for (int s2 = 0; s2 < 2; ++s2) {
                        const s16x4 lo = xlo[s2], hi = xhi[s2];
                        const f32x4 w0 = w0v[s2], w1 = w1v[s2];
                        u32x4 xw; xw.x = cvtpk(bf1((bf16_t)lo[0]) * w0.x, bf1((bf16_t)lo[1]) * w0.y); xw.y = cvtpk(bf1((bf16_t)lo[2]) * w0.z, bf1((bf16_t)lo[3]) * w0.w);
                        xw.z = cvtpk(bf1((bf16_t)hi[0]) * w1.x, bf1((bf16_t)hi[1]) * w1.y); xw.w = cvtpk(bf1((bf16_t)hi[2]) * w1.z, bf1((bf16_t)hi[3]) * w1.w);
                        const bf16x8 xb8 = __builtin_bit_cast(bf16x8, xw);
                        s16x4 blo[4], bhi[4];
#pragma unroll
                        for (int t = 0; t < 4; ++t) { const LAS unsigned char* bp = F.lds + P * SC_TB + offTrB + (16 * s2) * SC_RS + hl * (8 * SC_RS) + 64 * t; blo[t] = vtr(bp); bhi[t] = vtr(bp + 4 * SC_RS); }
                        __builtin_amdgcn_sched_barrier(0);
#pragma unroll
                        for (int t = 0; t < 4; ++t) ST[t] = MFMA32(((bf16x8){blo[t][0], blo[t][1], blo[t][2], blo[t][3], bhi[t][0], bhi[t][1], bhi[t][2], bhi[t][3]}), xb8, ST[t]);
                    }
                }
                LAS bf16_t* ys = (LAS bf16_t*)(F.lds + SC_YS + P * 16384 + dir * 8192) + ysoff;
#pragma unroll
                for (int e = 0; e < 16; e += 2) { const unsigned w = cvtpk(ya[e], ya[e + 1]); ys[((e & 3) + 8 * (e >> 2)) * 128] = (bf16_t)w; ys[((e & 3) + 1 + 8 * (e >> 2)) * 128] = (bf16_t)(w >> 16); }
            }
                  }
        }
        VM_WAIT(); __syncthreads();
        SC_WRITEOUT(135, 1);
#undef SC_PF
#undef SC_DTLOAD
#undef SC_WRITEOUT
        __syncthreads();
    }
}

__device__ __forceinline__ void attn_phase(Frame& F, const Args& A, int ja, bool need_ctx, int nwg) {
    phase_enter(F);
    const bf16_t* Q = (const bf16_t*)(F.ws + WS_BIG); bf16_t* O = (bf16_t*)F.out;     const bf16_t* Kb = (const bf16_t*)(F.ws + WS_BIG + BIG_K); const bf16_t* Vb = (const bf16_t*)(F.ws + WS_BIG + BIG_V);
    LAS unsigned char* Kl = F.lds; LAS unsigned char* Vl = F.lds + 9216;
    const int nunits = 2048 + (need_ctx ? 128 : 0);
    const int lane = F.lane, r = F.wave >> 1, rh = F.wave & 1, c31 = lane & 31, hl = lane >> 5;
    const int prow = F.tid >> 3, ppc = F.tid & 7;
    const int trq = (lane & 15) >> 2, trp = lane & 3, trb = (lane >> 4) & 1;
    for (int unit = blockIdx.x; unit < nunits; unit += nwg) {
        int b, g, nblk; bool cq;
        if (unit < 2048) { b = unit >> 7; nblk = (unit >> 2) & 31; g = unit & 3; cq = false; } else { const int u2 = unit - 2048; b = u2 >> 3; nblk = (u2 >> 2) & 1; g = u2 & 3; cq = true; }
        const int qrow0 = b * SROW + (cq ? 128 * nblk : NCTX + 128 * nblk);
        const int start = 128 * nblk;
        bf16x8 qf[2][4];
#pragma unroll
        for (int qb = 0; qb < 2; ++qb)
#pragma unroll
            for (int s = 0; s < 4; ++s) qf[qb][s] = *(const GAS bf16x8*)(Q + (size_t)(qrow0 + 64 * rh + 32 * qb + c31) * QW + g * 256 + r * 64 + 16 * s + 8 * hl);
        const float sink = ((const GAS float*)A.attn_sink)[ja * 16 + g * 4 + r] * 1.4426950408889634f;
        float mrun[2] = {sink, sink}, lrun[2] = {1.f, 1.f};
        f32x16 ot[2][2];
#pragma unroll
        for (int db = 0; db < 2; ++db)
#pragma unroll
            for (int qb = 0; qb < 2; ++qb)
#pragma unroll
                for (int e = 0; e < 16; ++e) ot[db][qb][e] = 0.f;
        const int tt_lo = cq ? 0 : (nblk == 0 ? 2 : 0), tt_hi = cq ? 0 : (nblk == 31 ? 4 : 6);
        const int ntile = 4 + (tt_hi - tt_lo);
#define TILE_ROW0(t) ((t) < 4 ? b * SROW + 64 * (t) : b * SROW + NCTX + start - 128 + 64 * (tt_lo + (t) - 4))
        u32x4 kreg, vreg;
        { const int r0 = TILE_ROW0(0); kreg = *(const GAS u32x4*)(Kb + (size_t)(r0 + prow) * KVW + g * 64 + ppc * 8); vreg = *(const GAS u32x4*)(Vb + (size_t)(r0 + prow) * KVW + g * 64 + ppc * 8); }
        for (int t = 0; t < ntile; ++t) {
            __syncthreads();
            *(LAS u32x4*)(Kl + prow * 144 + ppc * 16) = kreg; *(LAS u32x4*)(Vl + prow * 144 + ppc * 16) = vreg;
            __syncthreads();
            if (t + 1 < ntile) { const int r0 = TILE_ROW0(t + 1); kreg = *(const GAS u32x4*)(Kb + (size_t)(r0 + prow) * KVW + g * 64 + ppc * 8); vreg = *(const GAS u32x4*)(Vb + (size_t)(r0 + prow) * KVW + g * 64 + ppc * 8); }
            const int dk0 = (t >= 4) ? (-128 + 64 * (tt_lo + t - 4)) - 64 * rh : 0;
            const bool tile_empty = (t >= 4) && (dk0 <= -192 || dk0 >= 192);
            const bool tile_mask = (t >= 4) && !tile_empty && (dk0 < -65 || dk0 > 65);
            if (!tile_empty) {
            f32x16 st[2][2];
            bf16x8 kf[2][4];
#pragma unroll
            for (int kb = 0; kb < 2; ++kb)
#pragma unroll
                for (int s = 0; s < 4; ++s) kf[kb][s] = *(const LAS bf16x8*)(Kl + (32 * kb + c31) * 144 + (16 * s + 8 * hl) * 2);
            __builtin_amdgcn_sched_barrier(0);
#pragma unroll
            for (int kb = 0; kb < 2; ++kb) {
#pragma unroll
                for (int qb = 0; qb < 2; ++qb)
#pragma unroll
                    for (int e = 0; e < 16; ++e) st[kb][qb][e] = 0.f;
#pragma unroll
                for (int s = 0; s < 4; ++s) { st[kb][0] = MFMA32(kf[kb][s], qf[0][s], st[kb][0]); st[kb][1] = MFMA32(kf[kb][s], qf[1][s], st[kb][1]); }
            }
            if (tile_mask) { const int kpos0 = start - 128 + 64 * (tt_lo + t - 4);
#pragma unroll
                for (int kb = 0; kb < 2; ++kb)
#pragma unroll
                    for (int qb = 0; qb < 2; ++qb) { const int qpos = start + 64 * rh + 32 * qb + c31;
#pragma unroll
                        for (int e = 0; e < 16; ++e) { const int d = qpos - (kpos0 + 32 * kb + crow(e, hl)); if (d > 128 || d < -128) st[kb][qb][e] = -INFINITY; } }
            }
#pragma unroll
            for (int qb = 0; qb < 2; ++qb) {
                float mx = st[0][qb][0];
#pragma unroll
                for (int kb = 0; kb < 2; ++kb)
#pragma unroll
                    for (int e = 0; e < 16; ++e) mx = fmaxf(mx, st[kb][qb][e]);
                mx = fmaxf(mx, shx(mx, 32, lane));
                const float mn = fmaxf(mrun[qb], mx);
                const bool grew = mn > mrun[qb];
                float rs = 0.f;
#pragma unroll
                for (int kb = 0; kb < 2; ++kb)
#pragma unroll
                    for (int e = 0; e < 16; ++e) { const float pv = __builtin_amdgcn_exp2f(st[kb][qb][e] - mn); st[kb][qb][e] = pv; rs += pv; }
                rs += shx(rs, 32, lane);
                if (__any(grew)) {
                    const float alpha = __builtin_amdgcn_exp2f(mrun[qb] - mn);
                    lrun[qb] = lrun[qb] * alpha + rs;
#pragma unroll
                    for (int db = 0; db < 2; ++db)
#pragma unroll
                        for (int e = 0; e < 16; ++e) ot[db][qb][e] *= alpha;
                } else lrun[qb] += rs;
                mrun[qb] = mn;
            }
#pragma unroll
            for (int kb = 0; kb < 2; ++kb)
#pragma unroll
                for (int s2 = 0; s2 < 2; ++s2) {
                    bf16x8 pk[2];
#pragma unroll
                    for (int qb = 0; qb < 2; ++qb) { u32x4 w; w.x = cvtpk(st[kb][qb][8 * s2 + 0], st[kb][qb][8 * s2 + 1]); w.y = cvtpk(st[kb][qb][8 * s2 + 2], st[kb][qb][8 * s2 + 3]);
                        w.z = cvtpk(st[kb][qb][8 * s2 + 4], st[kb][qb][8 * s2 + 5]); w.w = cvtpk(st[kb][qb][8 * s2 + 6], st[kb][qb][8 * s2 + 7]); pk[qb] = __builtin_bit_cast(bf16x8, w); }
#pragma unroll
                    for (int db = 0; db < 2; ++db) {
                        const LAS unsigned char* vp = Vl + (32 * kb + 16 * s2 + 4 * hl + trq) * 144 + (32 * db + 16 * trb + 4 * trp) * 2;
                        const s16x4 lo = vtr(vp), hi = vtr(vp + 8 * 144);
                        const bf16x8 va = (bf16x8){lo[0], lo[1], lo[2], lo[3], hi[0], hi[1], hi[2], hi[3]};
                        ot[db][0] = MFMA32(va, pk[0], ot[db][0]); ot[db][1] = MFMA32(va, pk[1], ot[db][1]);
                    }
                }
            }
        }
#undef TILE_ROW0
#pragma unroll
        for (int qb = 0; qb < 2; ++qb) { const float inv = 1.0f / lrun[qb]; bf16_t* op = O + (size_t)(qrow0 + 64 * rh + 32 * qb + c31) * QW + g * 256 + r * 64;
#pragma unroll
            for (int db = 0; db < 2; ++db)
#pragma unroll
                for (int gq = 0; gq < 4; ++gq) { u32x2 w; w.x = cvtpk(ot[db][qb][4 * gq] * inv, ot[db][qb][4 * gq + 1] * inv); w.y = cvtpk(ot[db][qb][4 * gq + 2] * inv, ot[db][qb][4 * gq + 3] * inv);
                    *(GAS u32x2*)(op + 32 * db + 8 * gq + 4 * hl) = w; } }
    }
    __syncthreads();
}


#ifndef PHMASK
#define PHMASK 0xFFFF
#endif
#define PHON(k) (((PHMASK) >> (k)) & 1)
#ifndef REPMASK
#define REPMASK 0x0
#endif
#define REP(k) (((REPMASK) >> (k)) & 1)
#ifndef MK_PER_PHASE
#define MK_PER_PHASE 0
#endif
#ifndef TIMER_LO
#define TIMER_LO 999
#define TIMER_HI 999
#endif
#define TIMER_ON (TIMER_LO < 999)
#define IN(k) (lo <= (k) && (k) < hi)
#define SEAM(k) do { if (IN(k) && IN((k) + 1)) { xcd_barrier(bar); } if (TIMER_ON) { const unsigned long long now_ = __builtin_amdgcn_s_memrealtime(); if ((k) >= TIMER_LO && (k) <= TIMER_HI) TM.acc += now_ - TM.prev; TM.prev = now_; } } while (0)
#define SITE_PTRS phase_enter(F); unsigned char* ws = F.ws; bf16_t* H = (bf16_t*)F.out; bf16_t* BIG = (bf16_t*)(ws + WS_BIG); const float* MODV = (const float*)(ws + WS_MODV); (void)H; (void)BIG; (void)MODV; \
        unsigned char* wss = ws + WS_W + (size_t)lp * W_SSD_STRIDE; unsigned char* wsa = ws + WS_W + W_ATT0 + (size_t)lp * W_ATT_STRIDE; (void)wss; (void)wsa;
struct Timer { unsigned long long prev, acc; };
template <int lp, int c> __device__ __forceinline__ void moe_chunk(Frame& F, const Args& A, const int lo, const int hi, const XcdBarrier& bar, LAS unsigned char* ring, Timer& TM) {
    constexpr int pb = 1 + lp * 20;
            const int pu = pb + 14 + 2 * c, pd = pu + 1;
            if (IN(pu) || IN(pd)) {
                SITE_PTRS
                MoeOrder mo;
                mo.pp[0] = 0;
#pragma unroll
                for (int e = 0; e < 8; ++e) { const int cn = __builtin_amdgcn_readfirstlane((int)__hip_atomic_load((unsigned*)(F.ctl + CW_CNT + (size_t)(lp * 8 + e) * 64), RLX_AGENT)); mo.cnt[e] = cn; mo.pp[e + 1] = mo.pp[e] + ((cn + 255) >> 8); }
                const int Ptot = mo.pp[8]; int nP = Ptot - c * MOE_CHUNK; nP = nP < 0 ? 0 : (nP > MOE_CHUNK ? MOE_CHUNK : nP);
                mo.cs = c * MOE_CHUNK; mo.rlist = (const int*)(ws + WS_RLIST);
                if (PHON(10) && IN(pu)) { mo.so.init(nP, 2 * DFFE / 256, F.G, (int)blockIdx.x); mo.GATHER_A = true; mo.bstride = (size_t)2 * DFFE * 1024 * 2;
                    pg8::Gemm g{H, (const bf16_t*)(ws + WS_BIG + BIG_MW13), 1024, 1024}; EpiSwiglu E{BIG, DFFE}; pg8::gemm_phase<EpiSwiglu, MoeOrder, true, true>(ring, g, mo, E, F.wave0); }
                SEAM(pu);
                if (PHON(11) && IN(pd)) { mo.so.init(nP, 4, F.G, (int)blockIdx.x); mo.GATHER_A = false; mo.bstride = (size_t)1024 * DFFE * 2;
                    pg8::Gemm g{BIG, (const bf16_t*)(ws + WS_BIG + BIG_MW2), DFFE, DFFE}; EpiMoeDown E{mo, (bf16_t*)(ws + WS_Y), (const float*)(ws + WS_GATE)}; pg8::gemm_phase<EpiMoeDown, MoeOrder, true, false>(ring, g, mo, E, F.wave0); }
            }
            SEAM(pd);
        }
template <int lp> __device__ __forceinline__ void layer_pair(Frame& F, const Args& A, const int lo, const int hi, const XcdBarrier& bar, LAS unsigned char* ring, Timer& TM) {
        const int pb = 1 + lp * 20, i0 = 2 * lp, i1 = 2 * lp + 1;
        if (PHON(1) && IN(pb + 0)) norm_phase(F, A, i0, 0, lp == 0 ? 1 : 2);
        SEAM(pb + 0);
        if (PHON(2) && IN(pb + 1)) { SITE_PTRS pg8::Gemm g{H, (const bf16_t*)(wss + W_WIN), 1024, 1024}; pg8::StaticOrder S; S.init(NPAN, NXBC / 256, F.G, (int)blockIdx.x);
            EpiXbc E{BIG, (float*)(ws + WS_DT), (bf16_t*)(ws + WS_HALO)}; pg8::gemm_phase<EpiXbc, pg8::StaticOrder, true, false>(ring, g, S, E, F.wave0); }
        SEAM(pb + 1);
        if (PHON(3) && IN(pb + 2)) conv_phase(F, A, lp);
        SEAM(pb + 2);
        if (PHON(3) && IN(pb + 3)) scan_phase<0>(F, A, lp);
        SEAM(pb + 3);
        if (PHON(4) && IN(pb + 4)) { SITE_PTRS pg8::Gemm g{H, (const bf16_t*)(wss + W_WZ), 1024, 1024}; pg8::StaticOrder S; S.init(NPAN, DIN / 256, F.G, (int)blockIdx.x);
            EpiGate E{(const bf16_t*)(ws + WS_Y), BIG, A.ssd_norm_w + (size_t)lp * DIN, (LAS float*)(F.lds + PSCR_OFF)}; pg8::gemm_phase<EpiGate, pg8::StaticOrder, true, false>(ring, g, S, E, F.wave0); }
        SEAM(pb + 4);
        if (PHON(5) && IN(pb + 5)) { SITE_PTRS pg8::Gemm g{BIG, (const bf16_t*)(wss + W_WOUT), DIN, DIN}; pg8::PanelOrder S; S.init(256, 4, F.G, (int)blockIdx.x);
            EpiResidNorm E{(bf16_t*)(ws + WS_XR), MODV + (size_t)i0 * 17 * 6144, 2, nullptr, lp == 0 ? A.x : nullptr, lp == 0 ? A.ctx : nullptr,
                           H, A.norm2_w + i0 * 1024, MODV + (size_t)i0 * 17 * 6144, 3, (unsigned*)(ws + WS_XCH), (unsigned*)(F.ctl + CW_PAN + (size_t)(lp * 2 + 0) * NPAN * 64), (unsigned*)(F.ctl + CW_BAR) + XB_TMO, F.lds + PSCR_OFF};
            pg8::gemm_phase<EpiResidNorm, pg8::PanelOrder, true, false>(ring, g, S, E, F.wave0);
            { const int ks = ((int)blockIdx.x >> 3) & 3; int t0, n; split4(DIN / 64, ks, t0, n); pg8::Gemm gt{g.A, g.Bt, DIN, n * 64, DIN}; pg8::TailOrder T{(int)blockIdx.x, 256, (unsigned)t0 * 128u};
              TailEpi<EpiResidNorm> TE{E, ks, ws + WS_Y, (unsigned*)(F.ctl + CW_TAIL + (size_t)(lp * 3 + 0) * 8192), (unsigned*)(F.ctl + CW_BAR) + XB_TMO};
              pg8::gemm_phase<TailEpi<EpiResidNorm>, pg8::TailOrder, true, false>(ring, gt, T, TE, F.wave0); } }
        SEAM(pb + 6);
        if (PHON(6) && IN(pb + 7)) { SITE_PTRS pg8::Gemm g{H, (const bf16_t*)(wss + W_WUP), 1024, 1024}; pg8::StaticOrder S; S.init(NPAN, 2 * DFF / 256, F.G, (int)blockIdx.x);
            EpiSwiglu E{BIG, DFF}; pg8::gemm_phase<EpiSwiglu, pg8::StaticOrder, true, false>(ring, g, S, E, F.wave0); }
        SEAM(pb + 7);
        if (PHON(5) && IN(pb + 8)) { SITE_PTRS pg8::Gemm g{BIG, (const bf16_t*)(wss + W_WDN), DFF, DFF}; pg8::PanelOrder S; S.init(256, 4, F.G, (int)blockIdx.x);
            EpiResidNorm E{(bf16_t*)(ws + WS_XR), MODV + (size_t)i0 * 17 * 6144, 5, nullptr, nullptr, nullptr,
                           H, A.norm1_w + i1 * 1024, MODV + (size_t)i1 * 17 * 6144, 0, (unsigned*)(ws + WS_XCH), (unsigned*)(F.ctl + CW_PAN + (size_t)(lp * 2 + 1) * NPAN * 64), (unsigned*)(F.ctl + CW_BAR) + XB_TMO, F.lds + PSCR_OFF};
            pg8::gemm_phase<EpiResidNorm, pg8::PanelOrder, true, false>(ring, g, S, E, F.wave0);
            { const int ks = ((int)blockIdx.x >> 3) & 3; int t0, n; split4(DFF / 64, ks, t0, n); pg8::Gemm gt{g.A, g.Bt, DFF, n * 64, DFF}; pg8::TailOrder T{(int)blockIdx.x, 256, (unsigned)t0 * 128u};
              TailEpi<EpiResidNorm> TE{E, ks, ws + WS_Y, (unsigned*)(F.ctl + CW_TAIL + (size_t)(lp * 3 + 1) * 8192), (unsigned*)(F.ctl + CW_BAR) + XB_TMO};
              pg8::gemm_phase<TailEpi<EpiResidNorm>, pg8::TailOrder, true, false>(ring, gt, T, TE, F.wave0); } }
        SEAM(pb + 9);
        if (PHON(7) && IN(pb + 10)) { SITE_PTRS pg8::Gemm g{H, (const bf16_t*)(wsa + W_WQKV), 1024, 1024}; pg8::StaticOrder S; S.init(NPAN, NQKV / 256, F.G, (int)blockIdx.x);
            LAS float* qt = (LAS float*)(F.lds + PSCR_OFF);
            { const float* rp = (const float*)(ws + WS_ROPE); const float* bq = A.attn_b_qkv + (size_t)lp * NQKV; for (int idx = F.tid; idx < 3584; idx += 512) qt[idx] = idx < 2048 ? rp[idx] : bq[idx - 2048]; }
            __syncthreads();
            EpiQkv E{BIG, (bf16_t*)(ws + WS_BIG + BIG_K), (bf16_t*)(ws + WS_BIG + BIG_V), qt};
            pg8::gemm_phase<EpiQkv, pg8::StaticOrder, true, false>(ring, g, S, E, F.wave0); }
        SEAM(pb + 10);
        if (PHON(8) && IN(pb + 11)) { const int nconv = F.G >= 9996 ? 48 : 0;
            if ((int)blockIdx.x < F.G - nconv) attn_phase(F, A, lp, lp == 0, F.G - nconv); else moe_convert(F, A, lp, F.G - nconv, nconv); }
        SEAM(pb + 11);
        if (PHON(5) && IN(pb + 12)) { SITE_PTRS pg8::Gemm g{H, (const bf16_t*)(wsa + W_WO), 1024, 1024};
            EpiResid E{(bf16_t*)(ws + WS_XR), MODV + (size_t)i1 * 17 * 6144, 2, A.attn_b_o + (size_t)lp * 1024, nullptr, nullptr};
            if (lp == 1) { pg8::LatentOrder S; S.init(NPAN - NB, 4, F.G, (int)blockIdx.x); pg8::gemm_phase<EpiResid, pg8::LatentOrder, true, false>(ring, g, S, E, F.wave0); }
            else { pg8::StaticOrder S; S.init(256, 4, F.G, (int)blockIdx.x); pg8::gemm_phase<EpiResid, pg8::StaticOrder, true, false>(ring, g, S, E, F.wave0);
                const int ks = ((int)blockIdx.x >> 3) & 3; int t0, n; split4(1024 / 64, ks, t0, n); pg8::Gemm gt{g.A, g.Bt, 1024, n * 64, 1024}; pg8::TailOrder T{(int)blockIdx.x, 256, (unsigned)t0 * 128u};
                TailEpi<EpiResid> TE{E, ks, ws + WS_Y, (unsigned*)(F.ctl + CW_TAIL + (size_t)(lp * 3 + 2) * 8192), (unsigned*)(F.ctl + CW_BAR) + XB_TMO};
                pg8::gemm_phase<TailEpi<EpiResid>, pg8::TailOrder, true, false>(ring, gt, T, TE, F.wave0); } }
        SEAM(pb + 12);
        if (PHON(9) && IN(pb + 13)) { norm_phase(F, A, i1, 1, 4 | (lp == 1 ? 16 : 0)); if (F.G < 9996) { __syncthreads(); moe_convert(F, A, lp, 0, F.G); } }
        SEAM(pb + 13);
    moe_chunk<lp, 0>(F, A, lo, hi, bar, ring, TM); moe_chunk<lp, 1>(F, A, lo, hi, bar, ring, TM); moe_chunk<lp, 2>(F, A, lo, hi, bar, ring, TM);
}
constexpr int N_PHASES = 42;
__global__ void __launch_bounds__(NWAVES * 64, 2) fwd_kernel(Args A) {
    extern __shared__ __attribute__((aligned(16))) unsigned char lds_raw[];
    Frame F;
    F.lds = (LAS unsigned char*)lds_raw;
    F.tid = threadIdx.x; F.lane = F.tid & 63; F.wave = __builtin_amdgcn_readfirstlane(F.tid >> 6); F.wave0 = F.wave; F.G = gridDim.x;
    F.ws0 = A.ws; F.out0 = A.out; F.ws = A.ws; F.ctl = (gu32*)(A.ws + WS_CTL); F.out = A.out;
    volatile LAS unsigned* MISC = (volatile LAS unsigned*)(F.lds + MISC_OFF);
    for (int u = F.tid; u < (LDS_BYTES - LDSCTL_OFF) / 4; u += NWAVES * 64) ((LAS unsigned*)(F.lds + LDSCTL_OFF))[u] = 0u;
    __syncthreads();
    const int lo = A.ph_lo, hi = A.ph_hi;
    XcdBarrier bar; bar.bar = (unsigned*)(F.ctl + CW_BAR); bar.x = 0; bar.st = MISC + 8; bar.wave0 = F.wave0;
    if (hi - lo > 1) bar = xcd_barrier_post((unsigned*)(F.ctl + CW_BAR), MISC + 8, F.wave0);
    LAS unsigned char* ring = F.lds;

    Timer TM; TM.prev = TIMER_ON ? __builtin_amdgcn_s_memrealtime() : 0ull; TM.acc = 0ull;
    if (PHON(0) && IN(0)) { p0_prologue(F, A); }
    SEAM(0);
    layer_pair<0>(F, A, lo, hi, bar, ring, TM);
    layer_pair<1>(F, A, lo, hi, bar, ring, TM);
    if (PHON(1) && IN(41)) {
        norm_phase(F, A, 4, 0, 2 | 8);
        if (xb_ld((unsigned*)(F.ctl + CW_BAR) + XB_TMO) != 0u) {
            const float qn = __builtin_nanf("");
            for (size_t idx = (size_t)blockIdx.x * 512 + F.tid; idx < (size_t)NB * SEQ * DM / 4; idx += (size_t)F.G * 512) ((f32x4*)A.out)[idx] = (f32x4){qn, qn, qn, qn};
        }
    }
    if (TIMER_ON) { const unsigned long long now_ = __builtin_amdgcn_s_memrealtime(); if (41 >= TIMER_LO && 41 <= TIMER_HI) TM.acc += now_ - TM.prev;
        if (blockIdx.x == 0) { const unsigned long long tgt = now_ + TM.acc; while (__builtin_amdgcn_s_memrealtime() < tgt) __builtin_amdgcn_s_sleep(8); } }
#undef IN
#undef SEAM
}

extern "C" void kernel_launch(void* const* d_in, const int* in_sizes, int n_in, void* d_out, int out_size, void* d_ws, size_t ws_size, hipStream_t stream) {
    static int grid = 0;
    if (grid == 0) {
        if (n_in != 29 || in_sizes[0] != NB * SEQ * DM || out_size != NB * SEQ * DM || ws_size < WS_END) {
            fprintf(stderr, "kernel_launch: unexpected problem: n_in %d, in0 %d, out %d, ws %zu (need %zu); nothing launched\n", n_in, n_in > 0 ? in_sizes[0] : -1, out_size, ws_size, (size_t)WS_END); grid = -1; return; }
        int dev = 0, cus = 0, per_cu = 0;
        if (hipGetDevice(&dev) != hipSuccess || hipDeviceGetAttribute(&cus, hipDeviceAttributeMultiprocessorCount, dev) != hipSuccess) { fprintf(stderr, "kernel_launch: device query failed\n"); grid = -1; return; }
        if (hipFuncSetAttribute((const void*)fwd_kernel, hipFuncAttributeMaxDynamicSharedMemorySize, LDS_BYTES) != hipSuccess) { fprintf(stderr, "kernel_launch: hipFuncSetAttribute failed\n"); grid = -1; return; }
        if (hipOccupancyMaxActiveBlocksPerMultiprocessor(&per_cu, (const void*)fwd_kernel, NWAVES * 64, LDS_BYTES) != hipSuccess || per_cu < 1)
            fprintf(stderr, "kernel_launch: note: occupancy query reports %d workgroups per CU\n", per_cu);
        (void)hipGetLastError();
        if (cus != 256) { fprintf(stderr, "kernel_launch: the unit orders of this kernel are written for 256 CUs (found %d); nothing launched\n", cus); grid = -1; return; }
        grid = cus;
    }
    if (grid < 0) return;
    if (hipMemsetAsync((char*)d_ws + WS_CTL, 0, CTL_ZERO_BYTES, stream) != hipSuccess) { fprintf(stderr, "kernel_launch: memset failed\n"); return; }
    Args a{};
    const float** ap = (const float**)&a;
    for (int i = 0; i < 29; ++i) ap[i] = (const float*)d_in[i];
    a.out = (float*)d_out; a.ws = (unsigned char*)d_ws;
#if MK_PER_PHASE
    for (int k = 0; k < N_PHASES; ++k) { a.ph_lo = k; a.ph_hi = k + 1; hipLaunchKernelGGL(fwd_kernel, dim3(grid), dim3(NWAVES * 64), LDS_BYTES, stream, a); }
#else
    a.ph_lo = 0; a.ph_hi = N_PHASES;
    hipLaunchKernelGGL(fwd_kernel, dim3(grid), dim3(NWAVES * 64), LDS_BYTES, stream, a);
#endif
    const hipError_t le = hipPeekAtLastError();
    if (le != hipSuccess) fprintf(stderr, "kernel_launch: launch failed: %s\n", hipGetErrorName(le));
}
```
